# Optimizing an MI355X kernel written in HIP

```python
import jax, jax.numpy as jnp
from jax import lax
import numpy as np

D_MODEL = 2048
BATCH = 4
SEQ = 2048
DEPTH = 4

GRID_W = 64
CTX_LEN = 256
EPS = 1e-6
N_BRANCH = 3
W_BRANCH = D_MODEL
LRU_BLOCKS = 16
LRU_BS = W_BRANCH // LRU_BLOCKS
CONV_W = 4
CONV_PAD_L = 2
LRU_C = 8.0
ML_HEADS = 8
ML_HD = W_BRANCH // ML_HEADS
ML_CHUNK = 64
M_INIT = -1e30
ATT_HD = 128
ATT_HEADS = W_BRANCH // ATT_HD
ATT_KV = 4
GQA = ATT_HEADS // ATT_KV
W_KV = ATT_KV * ATT_HD
Q_BLOCK = 128
ROPE_THETA = 10000.0
IN_SIZES = (W_BRANCH, W_BRANCH,
            W_BRANCH, W_BRANCH, W_BRANCH, W_BRANCH, W_BRANCH, 4 * ML_HEADS,
            W_BRANCH, W_KV, W_KV, W_BRANCH,
            N_BRANCH * D_MODEL)
N_IN = sum(IN_SIZES)

kernel_name = "hybrid_rglru_mlstm_gqa_prefix_dit"


def rmsnorm(x, g):
    xf = x.astype(jnp.float32)
    y = xf * lax.rsqrt(jnp.mean(xf * xf, axis=-1, keepdims=True) + EPS)
    return y * g.astype(jnp.float32)


def split_proj(p):
    parts, off = [], 0
    for n in IN_SIZES:
        parts.append(p[..., off:off + n])
        off += n
    return parts


def conv_centred(x, w, b):
    T = x.shape[1]
    xp = jnp.pad(x.astype(jnp.float32), ((0, 0), (CONV_PAD_L, CONV_W - 1 - CONV_PAD_L), (0, 0)))
    out = b.astype(jnp.float32)
    for k in range(CONV_W):
        out = out + xp[:, k:k + T] * w[k]
    return out


def blockdiag(x, w, b):
    xb = x.reshape(x.shape[0], x.shape[1], LRU_BLOCKS, LRU_BS)
    return jnp.einsum('btnc,ncd->btnd', xb, w).reshape(x.shape) + b


def linear_scan(a, bx, h0, reverse):
    def comb(e1, e2):
        a1, b1 = e1
        a2, b2 = e2
        return a1 * a2, a2 * b1 + b2
    A, Bc = lax.associative_scan(comb, (a, bx), axis=1, reverse=reverse)
    return A * h0[:, None] + Bc


def rglru(xc, wr, br, wi, bi, lam, h0, reverse):
    r = jax.nn.sigmoid(blockdiag(xc, wr, br))
    i = jax.nn.sigmoid(blockdiag(xc, wi, bi))
    log_a = -LRU_C * r * jax.nn.softplus(-lam)
    a = jnp.exp(log_a)
    mult = jnp.sqrt(-jnp.expm1(2.0 * log_a))
    h = linear_scan(a, mult * (i * xc), h0, reverse)
    final = h[:, 0] if reverse else h[:, -1]
    return h, final


def mlstm_chunkwise(q, k, v, ig, lf, state, with_out):
    B, H, T, d = q.shape
    nc = T // ML_CHUNK

    def to_chunks(a):
        return jnp.moveaxis(a.reshape(B, H, nc, ML_CHUNK, *a.shape[3:]), 2, 0)

    causal = jnp.tril(jnp.ones((ML_CHUNK, ML_CHUNK), dtype=bool))

    def step(carry, inp):
        C, n, m = carry
        qc, kc, vc, ic, fc = inp
        b = jnp.cumsum(fc, axis=-1)
        out = None
        if with_out:
            logD = jnp.where(causal, b[..., :, None] - b[..., None, :] + ic[..., None, :], -jnp.inf)
            m_inter = b + m[..., None]
            m_t = jnp.maximum(jnp.max(logD, axis=-1), m_inter)
            Dm = jnp.exp(logD - m_t[..., None])
            w_inter = jnp.exp(m_inter - m_t)
            s = jnp.einsum('bhtd,bhsd->bhts', qc, kc) * Dm
            num = jnp.einsum('bhts,bhse->bhte', s, vc) + w_inter[..., None] * jnp.einsum('bhtd,bhde->bhte', qc, C)
            den = jnp.sum(s, axis=-1) + w_inter * jnp.einsum('bhtd,bhd->bht', qc, n)
            out = num / jnp.maximum(jnp.abs(den), jnp.exp(-m_t))[..., None]
        bL = b[..., -1]
        log_w = bL[..., None] - b + ic
        m_new = jnp.maximum(bL + m, jnp.max(log_w, axis=-1))
        wk = jnp.exp(log_w - m_new[..., None])
        decay = jnp.exp(bL + m - m_new)
        C_new = decay[..., None, None] * C + jnp.einsum('bhs,bhsd,bhse->bhde', wk, kc, vc)
        n_new = decay[..., None] * n + jnp.einsum('bhs,bhsd->bhd', wk, kc)
        return (C_new, n_new, m_new), out

    state, hs = lax.scan(step, state, tuple(to_chunks(a) for a in (q, k, v, ig, lf)))
    h = jnp.moveaxis(hs, 0, 2).reshape(B, H, T, d) if with_out else None
    return h, state


def axial_rope_tables(row, col):
    n_freq = ATT_HD // 4
    inv = 1.0 / (ROPE_THETA ** (jnp.arange(n_freq, dtype=jnp.float32) / n_freq))
    ang = jnp.concatenate([row.astype(jnp.float32)[:, None] * inv,
                           col.astype(jnp.float32)[:, None] * inv], axis=-1)
    return jnp.cos(ang), jnp.sin(ang)


def rope_2d(x, cos, sin):
    half = ATT_HD // 2
    x1, x2 = x[..., :half], x[..., half:]
    return jnp.concatenate([x1 * cos - x2 * sin, x2 * cos + x1 * sin], axis=-1)


def attend_latent(q, k, v, k_ctx, v_ctx):
    B, H, S, d = q.shape
    keys = jnp.concatenate([k, k_ctx], axis=2)
    vals = jnp.concatenate([v, v_ctx], axis=2)
    nb = S // Q_BLOCK
    qb = q.reshape(B, ATT_KV, GQA, nb, Q_BLOCK, d).transpose(3, 0, 1, 2, 4, 5)

    def block(qi):
        s = jnp.einsum('bkgqd,bktd->bkgqt', qi, keys).astype(jnp.float32) * (ATT_HD ** -0.5)
        p = jax.nn.softmax(s, axis=-1)
        return jnp.einsum('bkgqt,bktd->bkgqd', p.astype(vals.dtype), vals)

    o = lax.map(block, qb)
    return o.transpose(1, 0, 4, 2, 3, 5).reshape(B, S, H * d)


def attend_ctx(q, k, v):
    B, H, C, d = q.shape
    qg = q.reshape(B, ATT_KV, GQA, C, d)
    s = jnp.einsum('bkgqd,bktd->bkgqt', qg, k).astype(jnp.float32) * (ATT_HD ** -0.5)
    p = jax.nn.softmax(s, axis=-1)
    o = jnp.einsum('bkgqt,bktd->bkgqd', p.astype(v.dtype), v)
    return o.transpose(0, 3, 1, 2, 4).reshape(B, C, H * d)


def hybrid_mixer(hx, hc, need_ctx, w_in, lru_conv_w, lru_conv_b, lru_wr, lru_br, lru_wi, lru_bi,
                 lru_lam, ml_gate_b, ml_norm, q_norm, k_norm, w_br, w_out, cos, sin):
    B = hx.shape[0]
    px = split_proj(hx @ w_in)
    pc = split_proj(hc @ w_in)

    xl = conv_centred(px[0], lru_conv_w, lru_conv_b)
    xcl = conv_centred(pc[0], lru_conv_w, lru_conv_b)
    zero = jnp.zeros((B, W_BRANCH), jnp.float32)
    lru_x, lru_c = 0.0, 0.0
    for dr, rev in enumerate((False, True)):
        h_c, fin = rglru(xcl, lru_wr[dr], lru_br[dr], lru_wi[dr], lru_bi[dr], lru_lam[dr], zero, rev)
        h_x, _ = rglru(xl, lru_wr[dr], lru_br[dr], lru_wi[dr], lru_bi[dr], lru_lam[dr], fin, rev)
        lru_x = lru_x + h_x
        if need_ctx:
            lru_c = lru_c + h_c
    y_lru_x = lru_x * jax.nn.silu(px[1])

    def ml_heads(a):
        return a.reshape(B, a.shape[1], ML_HEADS, ML_HD).transpose(0, 2, 1, 3).astype(jnp.float32)

    def ml_gates(a):
        g = a.reshape(B, a.shape[1], 2, 2, ML_HEADS).astype(jnp.float32) + ml_gate_b
        return g.transpose(2, 3, 0, 4, 1)

    qmx, kmx, vmx = ml_heads(px[2]), ml_heads(px[3]) * (ML_HD ** -0.5), ml_heads(px[4])
    qmc, kmc, vmc = ml_heads(pc[2]), ml_heads(pc[3]) * (ML_HD ** -0.5), ml_heads(pc[4])
    gx, gc = ml_gates(px[7]), ml_gates(pc[7])
    ml_x, ml_c = 0.0, 0.0
    for dr in range(2):
        fl = (lambda a: jnp.flip(a, axis=2)) if dr == 1 else (lambda a: a)
        st0 = (jnp.zeros((B, ML_HEADS, ML_HD, ML_HD), jnp.float32),
               jnp.zeros((B, ML_HEADS, ML_HD), jnp.float32),
               jnp.full((B, ML_HEADS), M_INIT, jnp.float32))
        h_c, st = mlstm_chunkwise(fl(qmc), fl(kmc), fl(vmc), fl(gc[dr, 0]),
                                  fl(jax.nn.log_sigmoid(gc[dr, 1])), st0, need_ctx)
        h_x, _ = mlstm_chunkwise(fl(qmx), fl(kmx), fl(vmx), fl(gx[dr, 0]),
                                 fl(jax.nn.log_sigmoid(gx[dr, 1])), st, True)
        ml_x = ml_x + fl(h_x)
        if need_ctx:
            ml_c = ml_c + fl(h_c)

    def ml_out(h, o, z):
        T = h.shape[2]
        h = jax.nn.sigmoid(o.astype(jnp.float32)) * h.transpose(0, 2, 1, 3).reshape(B, T, W_BRANCH)
        h = rmsnorm(h.reshape(B, T, ML_HEADS, ML_HD), ml_norm.reshape(ML_HEADS, ML_HD)).reshape(B, T, W_BRANCH)
        return h * jax.nn.silu(z)

    y_ml_x = ml_out(ml_x, px[5], px[6])

    def att_heads(a, H):
        return a.reshape(B, a.shape[1], H, ATT_HD).transpose(0, 2, 1, 3)

    qax = rope_2d(rmsnorm(att_heads(px[8], ATT_HEADS), q_norm), cos, sin)
    kax = rope_2d(rmsnorm(att_heads(px[9], ATT_KV), k_norm), cos, sin)
    vax = att_heads(px[10], ATT_KV).astype(jnp.float32)
    kac = rmsnorm(att_heads(pc[9], ATT_KV), k_norm)
    vac = att_heads(pc[10], ATT_KV).astype(jnp.float32)
    y_att_x = attend_latent(qax, kax, vax, kac, vac) * jax.nn.silu(px[11])

    def merge(ys, gate_logits):
        Y = jnp.stack(ys, axis=2)
        proj = jnp.einsum('btnw,nwd->btnd', Y, w_br)
        g = jax.nn.sigmoid(gate_logits.reshape(B, gate_logits.shape[1], N_BRANCH, D_MODEL))
        return jnp.einsum('btd,de->bte', jnp.sum(g * proj, axis=2), w_out)

    yx = merge([y_lru_x, y_ml_x, y_att_x], px[12])
    yc = None
    if need_ctx:
        y_lru_c = lru_c * jax.nn.silu(pc[1])
        y_ml_c = ml_out(ml_c, pc[5], pc[6])
        qac = rmsnorm(att_heads(pc[8], ATT_HEADS), q_norm)
        y_att_c = attend_ctx(qac, kac, vac) * jax.nn.silu(pc[11])
        yc = merge([y_lru_c, y_ml_c, y_att_c], pc[12])
    return yx, yc


def setup_inputs(seed: int = 0) -> dict:
    key = jax.random.key(seed)
    ks = jax.random.split(key, 24)
    f32 = jnp.float32
    D = D_MODEL

    def nrm(k, shape, scale):
        return jax.random.normal(k, shape, f32) * scale

    u = jax.random.uniform(ks[15], (DEPTH, 2, W_BRANCH), f32, 0.9, 0.999)
    a0 = u ** (1.0 / LRU_C)
    ml_i_b = nrm(ks[16], (DEPTH, 2, ML_HEADS), 0.1)
    ml_f_b = jnp.linspace(3.0, 6.0, ML_HEADS, dtype=f32) + nrm(ks[17], (DEPTH, 2, ML_HEADS), 0.1)
    return {
        "x": nrm(ks[0], (BATCH, SEQ, D), 1.0),
        "c": nrm(ks[1], (BATCH, D), 1.0),
        "ctx": nrm(ks[2], (BATCH, CTX_LEN, D), 1.0),
        "c_ctx": nrm(ks[3], (D,), 1.0),
        "ada_w": nrm(ks[4], (DEPTH, D, 3 * D), 0.5 * D ** -0.5),
        "ada_b": nrm(ks[5], (DEPTH, 3 * D), 0.02),
        "norm_pre": 1.0 + nrm(ks[6], (DEPTH, D), 0.05),
        "norm_post": 1.0 + nrm(ks[7], (DEPTH, D), 0.05),
        "w_in": nrm(ks[8], (DEPTH, D, N_IN), D ** -0.5),
        "lru_conv_w": nrm(ks[9], (DEPTH, CONV_W, W_BRANCH), CONV_W ** -0.5),
        "lru_conv_b": nrm(ks[10], (DEPTH, W_BRANCH), 0.02),
        "lru_wr": nrm(ks[11], (DEPTH, 2, LRU_BLOCKS, LRU_BS, LRU_BS), LRU_BS ** -0.5),
        "lru_br": nrm(ks[12], (DEPTH, 2, W_BRANCH), 0.02),
        "lru_wi": nrm(ks[13], (DEPTH, 2, LRU_BLOCKS, LRU_BS, LRU_BS), LRU_BS ** -0.5),
        "lru_bi": nrm(ks[14], (DEPTH, 2, W_BRANCH), 0.02),
        "lru_lam": jnp.log(a0) - jnp.log1p(-a0),
        "ml_gate_b": jnp.stack([ml_i_b, ml_f_b], axis=2),
        "ml_norm": 1.0 + nrm(ks[18], (DEPTH, W_BRANCH), 0.05),
        "q_norm": 1.0 + nrm(ks[19], (DEPTH, ATT_HD), 0.05),
        "k_norm": 1.0 + nrm(ks[20], (DEPTH, ATT_HD), 0.05),
        "w_br": nrm(ks[21], (DEPTH, N_BRANCH, W_BRANCH, D), W_BRANCH ** -0.5),
        "w_out": nrm(ks[22], (DEPTH, D, D), D ** -0.5),
    }


def reference(x, c, ctx, c_ctx, ada_w, ada_b, norm_pre, norm_post, w_in, lru_conv_w, lru_conv_b,
              lru_wr, lru_br, lru_wi, lru_bi, lru_lam, ml_gate_b, ml_norm, q_norm, k_norm, w_br, w_out):
    S = x.shape[1]
    rows = S // GRID_W
    row = jnp.repeat(jnp.arange(rows, dtype=jnp.int32), GRID_W)
    col = jnp.tile(jnp.arange(GRID_W, dtype=jnp.int32), rows)
    cos, sin = axial_rope_tables(row, col)
    u = ctx
    for l in range(DEPTH):
        need_ctx = l < DEPTH - 1
        shift_x, scale_x, gate_x = jnp.split(jax.nn.silu(c) @ ada_w[l] + ada_b[l], 3, axis=-1)
        shift_c, scale_c, gate_c = jnp.split(jax.nn.silu(c_ctx) @ ada_w[l] + ada_b[l], 3, axis=-1)
        hx = rmsnorm(x, norm_pre[l]) * (1.0 + scale_x[:, None]) + shift_x[:, None]
        hc = rmsnorm(u, norm_pre[l]) * (1.0 + scale_c) + shift_c
        yx, yc = hybrid_mixer(hx.astype(x.dtype), hc.astype(x.dtype), need_ctx, w_in[l], lru_conv_w[l],
                              lru_conv_b[l], lru_wr[l], lru_br[l], lru_wi[l], lru_bi[l], lru_lam[l],
                              ml_gate_b[l], ml_norm[l], q_norm[l], k_norm[l], w_br[l], w_out[l], cos, sin)
        x = (x + gate_x[:, None] * rmsnorm(yx, norm_post[l])).astype(x.dtype)
        if need_ctx:
            u = (u + gate_c * rmsnorm(yc, norm_post[l])).astype(u.dtype)
    return x
```

```cpp
#include <hip/hip_runtime.h>
#include <hip/hip_bf16.h>
#include <cstdio>
#include <cstdint>

constexpr int DM = 2048, NBATCH = 4, SEQ = 2048, CTXL = 256, TPB = SEQ + CTXL  , MROWS = NBATCH * TPB  , DEPTH = 4;
constexpr int NIN = 25632, NP = 25600;
constexpr int C_LX = 0, C_LZ = 2048, C_MQ = 4096, C_MK = 6144, C_MV = 8192, C_MO = 10240, C_MZ = 12288, C_AQ = 14336, C_AK = 16384, C_AV = 16896, C_AZ = 17408, C_MG = 19456;
constexpr float EPS = 1e-6f;
namespace pg8 {
#define PG8_LAS __attribute__((address_space(3)))
typedef unsigned short bf16_t;
typedef short bf16x8 __attribute__((ext_vector_type(8)));
typedef float f32x4 __attribute__((ext_vector_type(4)));
typedef unsigned u32x4 __attribute__((ext_vector_type(4)));
constexpr int BM = 256, BK = 64, HALF = 128, HTB = HALF * BK * 2  , STAGE_BYTES = 8 * HTB, NXCD = 8, WGM = 8;

__host__ __device__ __forceinline__ int lds_byte(int r, int c) { const int st = (r >> 4) * 2 + (c >> 5), rr = r & 15, cc = c & 31, ob = rr * 64 + cc * 2; return st * 1024 + (ob ^ (((ob >> 9) & 1) << 5)); }
__host__ __device__ __forceinline__ void stage_rc(int b, int& R, int& C) { const int st = b / 1024, sb = b % 1024, swz = sb ^ (((sb >> 9) & 1) << 5); R = (st >> 1) * 16 + swz / 64; C = (st & 1) * 32 + (swz % 64) / 2; }
__host__ __device__ __forceinline__ int perm32(int rho) { const int n = rho >> 4, i = rho & 15; return 8 * (i >> 2) + 4 * n + (i & 3); }

struct Unit { int pm, pn, z; };
struct Gemm { const bf16_t* A; const bf16_t* Bt; int M, N, K; size_t zA, zB; };

struct StaticOrder {
    int nM, nN, nwg, G, c;
    __host__ __device__ void init(int M, int N, int G_, int c_) { nM = M / BM; nN = N / BM; nwg = nM * nN; G = G_; c = c_; }
    __host__ __device__ bool next(int i, Unit& u) const {
        const long L = (long)i * G + c; if (L >= nwg) return false;
        int wgid = (int)L; { const int q = nwg / NXCD, r = nwg % NXCD, xcd = wgid % NXCD, off = wgid / NXCD; wgid = (xcd < r ? xcd * (q + 1) : r * (q + 1) + (xcd - r) * q) + off; }
        const int nig = WGM * nN, gid = wgid / nig, fm = gid * WGM, gsz = (nM - fm) < WGM ? (nM - fm) : WGM;
        u.pm = fm + ((wgid % nig) % gsz); u.pn = (wgid % nig) / gsz; u.z = 0; return true;
    }
    __device__ __forceinline__ void a_ready(const Unit&) const {}
    __device__ __forceinline__ void done(const Unit&) const {}
};
struct MergeOrder : StaticOrder {
    __host__ __device__ bool next(int i, Unit& u) const { const int it = i / 3; if (!StaticOrder::next(it, u)) return false; u.z = i - 3 * it; return true; }
};

__device__ __forceinline__ unsigned cvt_pk_bf16(float lo, float hi) { unsigned r; asm volatile("v_cvt_pk_bf16_f32 %0, %1, %2" : "=v"(r) : "v"(lo), "v"(hi)); return r; }
__device__ __forceinline__ float bflo(unsigned w) { return __uint_as_float(w << 16); }
__device__ __forceinline__ float bfhi(unsigned w) { return __uint_as_float(w & 0xffff0000u); }
__device__ __forceinline__ float sigmoid_f(float x) { return __builtin_amdgcn_rcpf(1.f + __expf(-x)); }

struct EpiF32 {
    static constexpr bool PERM = false, AFTER_DRAIN = false;
    float* C; int ldc;
    __device__ __forceinline__ void operator()(const f32x4 (&acc)[2][2][4][2], const Unit& u, int wr, int wc, int fr, int fq) const {
        const int row0 = u.pm * BM + wr * 64 + fr, col0 = u.pn * BM + wc * 32 + 4 * fq;
#pragma unroll
        for (int ai = 0; ai < 2; ++ai)
#pragma unroll
            for (int m = 0; m < 4; ++m) { float* rowp = C + (size_t)(row0 + ai * HALF + m * 16) * ldc + col0;
#pragma unroll
                for (int bj = 0; bj < 2; ++bj)
#pragma unroll
                    for (int n = 0; n < 2; ++n) *(f32x4*)(rowp + bj * HALF + n * 16) = acc[ai][bj][m][n]; }
    }
};
struct EpiIn {
    static constexpr bool PERM = true, AFTER_DRAIN = false;
    bf16_t* O;
    __device__ __forceinline__ void operator()(const f32x4 (&acc)[2][2][4][2], const Unit& u, int wr, int wc, int fr, int fq) const {
        const int row0 = u.pm * BM + wr * 64 + fr, col0 = u.pn * BM + wc * 32 + 8 * fq, pn = u.pn;
        int act = 0;
        if ((pn >= 8 && pn < 16) || (pn >= 48 && pn < 56) || (pn >= 68 && pn < 76)) act = 1;
        else if ((pn >= 40 && pn < 48) || pn >= 76) act = 2;
        else if (pn >= 24 && pn < 32) act = 3;
#pragma unroll
        for (int ai = 0; ai < 2; ++ai)
#pragma unroll
            for (int m = 0; m < 4; ++m) { bf16_t* rowp = O + (size_t)(row0 + ai * HALF + m * 16) * NP + col0;
#pragma unroll
                for (int bj = 0; bj < 2; ++bj) { f32x4 v0 = acc[ai][bj][m][0], v1 = acc[ai][bj][m][1];
                    if (act == 1) {
#pragma unroll
                        for (int j = 0; j < 4; ++j) { v0[j] = v0[j] * sigmoid_f(v0[j]); v1[j] = v1[j] * sigmoid_f(v1[j]); } }
                    else if (act == 2) {
#pragma unroll
                        for (int j = 0; j < 4; ++j) { v0[j] = sigmoid_f(v0[j]); v1[j] = sigmoid_f(v1[j]); } }
                    else if (act == 3) { v0 = v0 * 0.0625f; v1 = v1 * 0.0625f; }
                    u32x4 w; w.x = cvt_pk_bf16(v0[0], v0[1]); w.y = cvt_pk_bf16(v0[2], v0[3]); w.z = cvt_pk_bf16(v1[0], v1[1]); w.w = cvt_pk_bf16(v1[2], v1[3]);
                    *(u32x4*)(rowp + bj * HALF) = w; } }
    }
};
struct EpiMerge {
    static constexpr bool PERM = true, AFTER_DRAIN = false;
    const bf16_t* P; float* ACC; bf16_t* G2;
    __device__ __forceinline__ void operator()(const f32x4 (&acc)[2][2][4][2], const Unit& u, int wr, int wc, int fr, int fq) const {
        const int row0 = u.pm * BM + wr * 64 + fr, col0 = u.pn * BM + wc * 32 + 8 * fq, z = u.z;
#pragma unroll
        for (int ai = 0; ai < 2; ++ai)
#pragma unroll
            for (int m = 0; m < 4; ++m) { const size_t r = (size_t)(row0 + ai * HALF + m * 16);
#pragma unroll
                for (int bj = 0; bj < 2; ++bj) { const int c = col0 + bj * HALF;
                    const u32x4 g = *(const u32x4*)(P + r * NP + C_MG + z * DM + c);
                    f32x4 v0 = acc[ai][bj][m][0], v1 = acc[ai][bj][m][1];
                    v0[0] *= bflo(g.x); v0[1] *= bfhi(g.x); v0[2] *= bflo(g.y); v0[3] *= bfhi(g.y);
                    v1[0] *= bflo(g.z); v1[1] *= bfhi(g.z); v1[2] *= bflo(g.w); v1[3] *= bfhi(g.w);
                    float* ap = ACC + r * DM + c;
                    if (z > 0) { v0 = v0 + *(const f32x4*)ap; v1 = v1 + *(const f32x4*)(ap + 4); }
                    if (z < 2) { *(f32x4*)ap = v0; *(f32x4*)(ap + 4) = v1; }
                    else { u32x4 w; w.x = cvt_pk_bf16(v0[0], v0[1]); w.y = cvt_pk_bf16(v0[2], v0[3]); w.z = cvt_pk_bf16(v1[0], v1[1]); w.w = cvt_pk_bf16(v1[2], v1[3]);
                        *(u32x4*)(G2 + r * DM + c) = w; } } }
    }
};
template <class Epi, class Sched, bool ALIGN_EPI = false, bool SP2 = false>
__device__ __forceinline__ void gemm_phase(PG8_LAS unsigned char* lds, const Gemm g, const Sched& S, const Epi& E) {
    int tid = threadIdx.x; asm volatile("" : "+v"(tid));
    const int wid = __builtin_amdgcn_readfirstlane(tid >> 6), lane = tid & 63, wr = wid >> 2, wc = wid & 3, fr = lane & 15, fq = lane >> 4;
    const int K = g.K, nt = K / BK;
    unsigned voffA[2], voffB[2];
#pragma unroll
    for (int i = 0; i < 2; ++i) { int R, C; stage_rc(tid * 16 + i * 8192, R, C); const int Rb = Epi::PERM ? ((R & ~31) + perm32(R & 31)) : R;
        voffA[i] = (unsigned)(R * K + C) * 2u; voffB[i] = (unsigned)(Rb * K + C) * 2u; }
    const size_t kstep = (size_t)(BK * 2);
    const size_t hstep = (size_t)HALF * K * 2;
    const size_t tstep = 2 * hstep;
    const unsigned ldsw = (unsigned)wid * 1024u;
    const int aoff = lds_byte(wr * 64 + fr, fq * 8), boff = lds_byte(wc * 32 + fr, fq * 8);
#define PG8_SA(b, h) (((b) * 2 + (h)) * HTB)
#define PG8_SB(b, h) ((4 + (b) * 2 + (h)) * HTB)
#define PG8_STAGE(bufoff, gbase, voff) do { _Pragma("unroll") for (int _i = 0; _i < 2; ++_i) \
        __builtin_amdgcn_global_load_lds((const unsigned*)((const char*)(gbase) + (voff)[_i]), (PG8_LAS unsigned*)(lds + (bufoff) + ldsw + _i * 8192), 16, 0, 0); } while (0)
#define PG8_LDA(dst, b, h) do { _Pragma("unroll") for (int m = 0; m < 4; ++m) _Pragma("unroll") for (int k = 0; k < 2; ++k) dst[m][k] = *(const PG8_LAS bf16x8*)(lds + PG8_SA(b, h) + aoff + m * 2048 + k * 1024); } while (0)
#define PG8_LDB(dst, b, h) do { _Pragma("unroll") for (int n = 0; n < 2; ++n) _Pragma("unroll") for (int k = 0; k < 2; ++k) dst[n][k] = *(const PG8_LAS bf16x8*)(lds + PG8_SB(b, h) + boff + n * 2048 + k * 1024); } while (0)
#define PG8_MMA(ai, bj, At, Bt) do { __builtin_amdgcn_s_setprio(1); _Pragma("unroll") for (int m = 0; m < 4; ++m) _Pragma("unroll") for (int n = 0; n < 2; ++n) _Pragma("unroll") for (int k = 0; k < 2; ++k) \
        acc[ai][bj][m][n] = __builtin_amdgcn_mfma_f32_16x16x32_bf16(Bt[n][k], At[m][k], acc[ai][bj][m][n], 0, 0, 0); __builtin_amdgcn_s_setprio(0); } while (0)
#define PG8_WAIT_V(n) asm volatile("s_waitcnt vmcnt(" #n ")" ::: "memory")
#define PG8_WAIT_L(n) asm volatile("s_waitcnt lgkmcnt(" #n ")" ::: "memory")
#define PG8_BAR __builtin_amdgcn_s_barrier()
#define PG8_SCHED __builtin_amdgcn_sched_barrier(0)
    Unit cur, nxt; int ui = 0;
    if (!S.next(0, cur)) return;
    f32x4 acc[2][2][4][2];
#pragma unroll
    for (int a = 0; a < 2; ++a)
#pragma unroll
        for (int b = 0; b < 2; ++b)
#pragma unroll
            for (int m = 0; m < 4; ++m)
#pragma unroll
                for (int n = 0; n < 2; ++n) acc[a][b][m][n] = (f32x4){0.f, 0.f, 0.f, 0.f};
    bf16x8 At[4][2], B0[2][2], B1[2][2];
    const char* cA = (const char*)g.A + (size_t)cur.z * g.zA + (size_t)cur.pm * tstep; const char* cB = (const char*)g.Bt + (size_t)cur.z * g.zB + (size_t)cur.pn * tstep;
    S.a_ready(cur);
    if constexpr (SP2) {
        PG8_STAGE(PG8_SB(0, 0), cB, voffB); PG8_STAGE(PG8_SB(0, 1), cB + hstep, voffB); PG8_STAGE(PG8_SA(0, 0), cA, voffA); PG8_STAGE(PG8_SA(0, 1), cA + hstep, voffA);
        if (wr == 1) PG8_BAR;
        PG8_WAIT_V(2); PG8_BAR;
        PG8_STAGE(PG8_SB(1, 0), cB + kstep, voffB); PG8_STAGE(PG8_SA(1, 0), cA + kstep, voffA); PG8_STAGE(PG8_SB(1, 1), cB + hstep + kstep, voffB);
        PG8_WAIT_V(6); PG8_BAR;
    } else {
        PG8_STAGE(PG8_SB(0, 0), cB, voffB); PG8_STAGE(PG8_SA(0, 0), cA, voffA); PG8_STAGE(PG8_SB(0, 1), cB + hstep, voffB); PG8_STAGE(PG8_SA(0, 1), cA + hstep, voffA);
        if (wr == 1) PG8_BAR;
        PG8_WAIT_V(4); PG8_BAR;
        PG8_STAGE(PG8_SB(1, 0), cB + kstep, voffB); PG8_STAGE(PG8_SA(1, 0), cA + kstep, voffA); PG8_STAGE(PG8_SB(1, 1), cB + hstep + kstep, voffB);
        PG8_WAIT_V(6); PG8_BAR;
    }
    for (;;) {
        const bool has_next = S.next(ui + 1, nxt);
        const char* nA = has_next ? (const char*)g.A + (size_t)nxt.z * g.zA + (size_t)nxt.pm * tstep : cA; const char* nB = has_next ? (const char*)g.Bt + (size_t)nxt.z * g.zB + (size_t)nxt.pn * tstep : cB;
        for (int t = 0; t < nt; t += 2) {
            const bool last = (t == nt - 2);
            const char* a1 = cA + (size_t)(t + 1) * kstep;
            const char* a2 = last ? nA : cA + (size_t)(t + 2) * kstep; const char* b2 = last ? nB : cB + (size_t)(t + 2) * kstep;
            const char* a3 = a2 + kstep; const char* b3 = b2 + kstep;
            if (last && has_next) S.a_ready(nxt);
            if constexpr (SP2) {
            PG8_LDB(B0, 0, 0); PG8_LDB(B1, 0, 1); PG8_SCHED; PG8_LDA(At, 0, 0); PG8_STAGE(PG8_SA(1, 1), a1 + hstep, voffA);
            PG8_WAIT_V(8); PG8_WAIT_L(0); PG8_BAR; PG8_MMA(0, 0, At, B0); PG8_MMA(0, 1, At, B1); PG8_BAR; PG8_SCHED;
            PG8_LDA(At, 0, 1); PG8_STAGE(PG8_SB(0, 0), b2, voffB); PG8_STAGE(PG8_SB(0, 1), b2 + hstep, voffB); PG8_STAGE(PG8_SA(0, 0), a2, voffA);
            PG8_WAIT_V(8); PG8_WAIT_L(0); PG8_BAR; PG8_MMA(1, 0, At, B0); PG8_MMA(1, 1, At, B1); PG8_BAR; PG8_SCHED;
            PG8_LDB(B0, 1, 0); PG8_LDB(B1, 1, 1); PG8_SCHED; PG8_LDA(At, 1, 0); PG8_STAGE(PG8_SA(0, 1), a2 + hstep, voffA);
            PG8_WAIT_V(8); PG8_WAIT_L(0); PG8_BAR; PG8_MMA(0, 0, At, B0); PG8_MMA(0, 1, At, B1); PG8_BAR; PG8_SCHED;
            PG8_LDA(At, 1, 1); PG8_STAGE(PG8_SB(1, 0), b3, voffB); PG8_STAGE(PG8_SB(1, 1), b3 + hstep, voffB); PG8_STAGE(PG8_SA(1, 0), a3, voffA);
            PG8_WAIT_V(8); PG8_WAIT_L(0); PG8_BAR; PG8_MMA(1, 0, At, B0); PG8_MMA(1, 1, At, B1); PG8_BAR; PG8_SCHED;
            } else {
            PG8_LDB(B0, 0, 0); PG8_SCHED; PG8_LDA(At, 0, 0); PG8_STAGE(PG8_SA(1, 1), a1 + hstep, voffA);
            PG8_WAIT_L(8); PG8_BAR; PG8_WAIT_L(0); PG8_MMA(0, 0, At, B0); PG8_BAR; PG8_SCHED;
            PG8_LDB(B1, 0, 1); PG8_STAGE(PG8_SB(0, 0), b2, voffB);
            PG8_BAR; PG8_WAIT_L(0); PG8_MMA(0, 1, At, B1); PG8_BAR;
            PG8_LDA(At, 0, 1); PG8_STAGE(PG8_SA(0, 0), a2, voffA);
            PG8_BAR; PG8_WAIT_L(0); PG8_MMA(1, 0, At, B0); PG8_BAR; PG8_SCHED;
            PG8_STAGE(PG8_SB(0, 1), b2 + hstep, voffB);
            PG8_WAIT_V(6); PG8_BAR; PG8_MMA(1, 1, At, B1); PG8_BAR;
            PG8_LDB(B0, 1, 0); PG8_SCHED; PG8_LDA(At, 1, 0); PG8_STAGE(PG8_SA(0, 1), a2 + hstep, voffA);
            PG8_WAIT_L(8); PG8_BAR; PG8_WAIT_L(0); PG8_MMA(0, 0, At, B0); PG8_BAR; PG8_SCHED;
            PG8_LDB(B1, 1, 1); PG8_STAGE(PG8_SB(1, 0), b3, voffB);
            PG8_BAR; PG8_WAIT_L(0); PG8_MMA(0, 1, At, B1); PG8_BAR;
            PG8_LDA(At, 1, 1); PG8_STAGE(PG8_SA(1, 0), a3, voffA);
            PG8_BAR; PG8_WAIT_L(0); PG8_MMA(1, 0, At, B0); PG8_BAR; PG8_SCHED;
            PG8_STAGE(PG8_SB(1, 1), b3 + hstep, voffB);
            PG8_WAIT_V(6); PG8_BAR; PG8_MMA(1, 1, At, B1); PG8_BAR;
            }
        }
        if constexpr (ALIGN_EPI) { if (wr == 0) PG8_BAR; }
        if constexpr (!Epi::AFTER_DRAIN) { E(acc, cur, wr, wc, fr, fq); S.done(cur); }
        if (!has_next) break;
#pragma unroll
        for (int a = 0; a < 2; ++a)
#pragma unroll
            for (int b = 0; b < 2; ++b)
#pragma unroll
                for (int m = 0; m < 4; ++m)
#pragma unroll
                    for (int n = 0; n < 2; ++n) acc[a][b][m][n] = (f32x4){0.f, 0.f, 0.f, 0.f};
        cur = nxt; cA = nA; cB = nB; ++ui;
        if constexpr (ALIGN_EPI) { if (wr == 1) PG8_BAR; }
    }
    PG8_WAIT_V(0);
    if constexpr (!ALIGN_EPI) { if (wr == 0) PG8_BAR; }
    PG8_BAR;
    if constexpr (Epi::AFTER_DRAIN) { E.fused(acc, cur, wr, wc, fr, fq, lds, wid, lane); S.done(cur); }
#undef PG8_SA
#undef PG8_SB
#undef PG8_STAGE
#undef PG8_LDA
#undef PG8_LDB
#undef PG8_MMA
#undef PG8_WAIT_V
#undef PG8_WAIT_L
#undef PG8_BAR
#undef PG8_SCHED
}
}

namespace att {
using bf16 = __hip_bfloat16;
constexpr int   D = 128, NW = 8, QBLK = 32, KVBLK = 64;
constexpr float SCALE = 0.088388347648318440f;
constexpr float THR = 8.f;
#ifndef ATT_SDEPTH
#define ATT_SDEPTH 1
#endif
constexpr int SDEPTH = ATT_SDEPTH;
constexpr int LDQ = NP, LDK = NP, LDO = DM;
constexpr size_t SHM_V = KVBLK * D * 2, SHM_K = KVBLK * D * 2, SHM_ATTN = 2 * SHM_V + 2 * SHM_K + NW * 64 * 4;
constexpr int OST_OFF = 69632, OST_END = OST_OFF + NW * 32 * 272;
using bf16x8 = __attribute__((ext_vector_type(8))) short;
using s16x4  = __attribute__((ext_vector_type(4))) short;
using f32x16 = __attribute__((ext_vector_type(16))) float;
using f32x4  = __attribute__((ext_vector_type(4))) float;
using u32x4  = __attribute__((ext_vector_type(4))) unsigned;
#define KSWZ(row, colB) ((row) * 256 + ((colB) ^ (((row) & 7) << 4)))
#define SBAR() __builtin_amdgcn_sched_barrier(0)
__device__ __forceinline__ int crow(int r, int hi) { return (r & 3) + 8 * (r >> 2) + 4 * hi; }
__device__ __forceinline__ unsigned cvtpk(float lo, float hi) { unsigned r; asm volatile("v_cvt_pk_bf16_f32 %0, %1, %2" : "=v"(r) : "v"(lo), "v"(hi)); return r; }
__device__ __forceinline__ bf16x8 ld8(const bf16* p) { return *reinterpret_cast<const bf16x8*>(p); }

__device__ __forceinline__ void partialSM(f32x16& p0, f32x16& p1, float& m_reg, float& mn, float& alpha) {
  constexpr float C = SCALE * 1.4426950408889634f;
  float pmax = p0[0];
#pragma unroll
  for (int r = 1; r < 16; ++r) pmax = fmaxf(pmax, p0[r]);
#pragma unroll
  for (int r = 0; r < 16; ++r) pmax = fmaxf(pmax, p1[r]);
  { auto rr = __builtin_amdgcn_permlane32_swap(__float_as_uint(pmax), __float_as_uint(pmax), false, false);
    pmax = fmaxf(__uint_as_float(rr[0]), __uint_as_float(rr[1])); }
  if (__builtin_expect(__all(pmax - m_reg <= THR / SCALE), 1)) { mn = m_reg; alpha = 1.f; }
  else { mn = fmaxf(m_reg, pmax); alpha = __builtin_amdgcn_exp2f((m_reg - mn) * C); m_reg = mn; }
  float mnC = -mn * C;
#pragma unroll
  for (int r = 0; r < 16; ++r) p0[r] = fmaf(p0[r], C, mnC);
#pragma unroll
  for (int r = 0; r < 16; ++r) p1[r] = fmaf(p1[r], C, mnC);
#pragma unroll
  for (int r = 0; r < 16; ++r) p0[r] = __builtin_amdgcn_exp2f(p0[r]);
}
__device__ __forceinline__ void finishSM(f32x16& p0, f32x16& p1, float alpha, float& l_reg, bf16x8& pa0, bf16x8& pa1, bf16x8& pa2, bf16x8& pa3) {
#pragma unroll
  for (int r = 0; r < 16; ++r) p1[r] = __builtin_amdgcn_exp2f(p1[r]);
  float ps = 0;
#pragma unroll
  for (int r = 0; r < 16; ++r) ps += p0[r];
#pragma unroll
  for (int r = 0; r < 16; ++r) ps += p1[r];
  { auto rr = __builtin_amdgcn_permlane32_swap(__float_as_uint(ps), __float_as_uint(ps), false, false);
    ps = __uint_as_float(rr[0]) + __uint_as_float(rr[1]); }
  l_reg = l_reg * alpha + ps;
#define PK4(P, BASE, OUT) do { unsigned a0 = cvtpk(P[BASE + 0], P[BASE + 1]), a1 = cvtpk(P[BASE + 2], P[BASE + 3]);   \
    unsigned b0 = cvtpk(P[BASE + 4], P[BASE + 5]), b1 = cvtpk(P[BASE + 6], P[BASE + 7]);                              \
    auto r0 = __builtin_amdgcn_permlane32_swap(a0, b0, false, false); auto r1 = __builtin_amdgcn_permlane32_swap(a1, b1, false, false); \
    u32x4 w = {r0[0], r1[0], r0[1], r1[1]}; OUT = *reinterpret_cast<bf16x8*>(&w); } while (0)
  PK4(p0, 0, pa0); PK4(p0, 8, pa1); PK4(p1, 0, pa2); PK4(p1, 8, pa3);
#undef PK4
}
__device__ __forceinline__ void qkt(f32x16& p0, f32x16& p1, const bf16* Ks, const bf16x8* qr, int r32, int hi) {
  p0 = f32x16{}; p1 = f32x16{};
#pragma unroll
  for (int d0 = 0; d0 < 8; ++d0) { int cb = (d0 * 16 + hi * 8) * 2;
    bf16x8 b0 = *reinterpret_cast<const bf16x8*>((const char*)Ks + KSWZ(r32, cb));
    bf16x8 b1 = *reinterpret_cast<const bf16x8*>((const char*)Ks + KSWZ(32 + r32, cb));
    p0 = __builtin_amdgcn_mfma_f32_32x32x16_bf16(b0, qr[d0], p0, 0, 0, 0);
    p1 = __builtin_amdgcn_mfma_f32_32x32x16_bf16(b1, qr[d0], p1, 0, 0, 0); }
}
__device__ __forceinline__ int v_st(int k, int c) { const int kk = (k & ~0xC) | ((k & 4) << 1) | ((k & 8) >> 1); return ((kk >> 3) * 4 + (c >> 5)) * 512 + ((kk & 7) * 32 + (c & 31)) * 2; }
__device__ __forceinline__ int v_rd_base(int lane) { return ((lane & 3) << 3) | (((lane >> 2) & 3) << 6) | (((lane >> 4) & 1) << 5) | (((lane >> 5) & 1) << 8); }
constexpr int v_rd_off(int d0, int ks, int half) { return d0 * 512 + ks * 4096 + half * 2048; }
template <int OFF> __device__ __forceinline__ s16x4 tr_read(int vb) {
  s16x4 r; asm volatile("ds_read_b64_tr_b16 %0, %1 offset:%2" : "=&v"(r) : "v"(vb), "i"(OFF) : "memory"); return r;
}
template <int D0> __device__ __forceinline__ void pv_one(f32x16& od, int vb, bf16x8 pa0, bf16x8 pa1, bf16x8 pa2, bf16x8 pa3) {
  const s16x4 l0 = tr_read<v_rd_off(D0, 0, 0)>(vb), h0 = tr_read<v_rd_off(D0, 0, 1)>(vb), l1 = tr_read<v_rd_off(D0, 1, 0)>(vb), h1 = tr_read<v_rd_off(D0, 1, 1)>(vb);
  const s16x4 l2 = tr_read<v_rd_off(D0, 2, 0)>(vb), h2 = tr_read<v_rd_off(D0, 2, 1)>(vb), l3 = tr_read<v_rd_off(D0, 3, 0)>(vb), h3 = tr_read<v_rd_off(D0, 3, 1)>(vb);
  asm volatile("s_waitcnt lgkmcnt(0)" ::: "memory"); SBAR();
#define PK(L, H) (bf16x8){L[0], L[1], L[2], L[3], H[0], H[1], H[2], H[3]}
  od = __builtin_amdgcn_mfma_f32_32x32x16_bf16(pa0, PK(l0, h0), od, 0, 0, 0);
  od = __builtin_amdgcn_mfma_f32_32x32x16_bf16(pa1, PK(l1, h1), od, 0, 0, 0);
  od = __builtin_amdgcn_mfma_f32_32x32x16_bf16(pa2, PK(l2, h2), od, 0, 0, 0);
  od = __builtin_amdgcn_mfma_f32_32x32x16_bf16(pa3, PK(l3, h3), od, 0, 0, 0);
#undef PK
}
__device__ __forceinline__ void pv_d0(f32x16* o, int vb, bf16x8 pa0, bf16x8 pa1, bf16x8 pa2, bf16x8 pa3) {
  pv_one<0>(o[0], vb, pa0, pa1, pa2, pa3); pv_one<1>(o[1], vb, pa0, pa1, pa2, pa3); pv_one<2>(o[2], vb, pa0, pa1, pa2, pa3); pv_one<3>(o[3], vb, pa0, pa1, pa2, pa3);
}

__device__ __forceinline__ void attn_unit(const bf16* __restrict__ Qb, const bf16* __restrict__ Kh, const bf16* __restrict__ Vh, const bf16* __restrict__ Zb,
                                          bf16* __restrict__ Ob, int seq, char* lds, const float* __restrict__ qn, const float* __restrict__ cs, const float* __restrict__ sn) {
  int tid = threadIdx.x; asm volatile("" : "+v"(tid));
  int wid = tid >> 6, lane = tid & 63, r32 = lane & 31, hi = lane >> 5;
  bf16* V_lds = (bf16*)lds; bf16* K_lds = (bf16*)(lds + 2 * SHM_V);
  float* ws = (float*)(lds + 2 * SHM_V + 2 * SHM_K) + wid * 64; float* li_l = ws; float* al_l = ws + 32;
  float m_reg = -1e30f, l_reg = 0; f32x16 o[4] = {}; bf16x8 qr[8];
  {
    const bf16* Qw = Qb + (long)(wid * QBLK + r32) * LDQ + hi * 8;
    float ss = 0.f;
#pragma unroll
    for (int d0 = 0; d0 < 8; ++d0) { const u32x4 w = *reinterpret_cast<const u32x4*>(Qw + d0 * 16); qr[d0] = __builtin_bit_cast(bf16x8, w);
#pragma unroll
      for (int e = 0; e < 4; ++e) { const float lo = __uint_as_float(w[e] << 16), hh = __uint_as_float(w[e] & 0xffff0000u); ss += lo * lo + hh * hh; } }
    ss += __shfl_xor(ss, 32);
    const float rs = rsqrtf(ss * (1.f / 128.f) + EPS);
    const float* cp = cs ? cs + (long)(wid * QBLK + r32) * 64 + hi * 8 : nullptr; const float* sp = cs ? sn + (long)(wid * QBLK + r32) * 64 + hi * 8 : nullptr;
#pragma unroll
    for (int d0 = 0; d0 < 4; ++d0) {
      const u32x4 wa = __builtin_bit_cast(u32x4, qr[d0]), wb = __builtin_bit_cast(u32x4, qr[d0 + 4]); float x1[8], x2[8];
#pragma unroll
      for (int e = 0; e < 4; ++e) { x1[2 * e] = __uint_as_float(wa[e] << 16); x1[2 * e + 1] = __uint_as_float(wa[e] & 0xffff0000u); x2[2 * e] = __uint_as_float(wb[e] << 16); x2[2 * e + 1] = __uint_as_float(wb[e] & 0xffff0000u); }
      const f32x4 ga0 = *reinterpret_cast<const f32x4*>(qn + d0 * 16 + hi * 8), ga1 = *reinterpret_cast<const f32x4*>(qn + d0 * 16 + hi * 8 + 4);
      const f32x4 gb0 = *reinterpret_cast<const f32x4*>(qn + 64 + d0 * 16 + hi * 8), gb1 = *reinterpret_cast<const f32x4*>(qn + 64 + d0 * 16 + hi * 8 + 4);
#pragma unroll
      for (int e = 0; e < 8; ++e) { x1[e] *= rs * (e < 4 ? ga0[e & 3] : ga1[e & 3]); x2[e] *= rs * (e < 4 ? gb0[e & 3] : gb1[e & 3]); }
      if (cs) {
        const f32x4 c0 = *reinterpret_cast<const f32x4*>(cp + d0 * 16), c1 = *reinterpret_cast<const f32x4*>(cp + d0 * 16 + 4);
        const f32x4 s0 = *reinterpret_cast<const f32x4*>(sp + d0 * 16), s1 = *reinterpret_cast<const f32x4*>(sp + d0 * 16 + 4);
#pragma unroll
        for (int e = 0; e < 8; ++e) { const float c = e < 4 ? c0[e & 3] : c1[e & 3], sv = e < 4 ? s0[e & 3] : s1[e & 3];
          const float a = x1[e], bq = x2[e]; x1[e] = a * c - bq * sv; x2[e] = bq * c + a * sv; }
      }
      const u32x4 oa = {cvtpk(x1[0], x1[1]), cvtpk(x1[2], x1[3]), cvtpk(x1[4], x1[5]), cvtpk(x1[6], x1[7])}, ob = {cvtpk(x2[0], x2[1]), cvtpk(x2[2], x2[3]), cvtpk(x2[4], x2[5]), cvtpk(x2[6], x2[7])};
      qr[d0] = __builtin_bit_cast(bf16x8, oa); qr[d0 + 4] = __builtin_bit_cast(bf16x8, ob);
      asm volatile("" ::: "memory");
    }
  }
  const int sr = tid >> 4, sc = (tid & 15) * 8, vst0 = v_st(sr, sc), vst1 = v_st(32 + sr, sc);
  const int vb0 = (int)(uintptr_t)V_lds + v_rd_base(lane);
  struct { bf16x8 vs0, vs1, ks0, ks1; } sr_[SDEPTH];
#define SLOAD(i, k0) do { sr_[i].vs0 = ld8(&Vh[(long)((k0) + sr) * LDK + sc]); sr_[i].vs1 = ld8(&Vh[(long)((k0) + 32 + sr) * LDK + sc]); \
    sr_[i].ks0 = ld8(&Kh[(long)((k0) + sr) * LDK + sc]); sr_[i].ks1 = ld8(&Kh[(long)((k0) + 32 + sr) * LDK + sc]); } while (0)
#define SWRITE(b, i) do { *(bf16x8*)((char*)V_lds + (b) * SHM_V + vst0) = sr_[i].vs0;          \
    *(bf16x8*)((char*)V_lds + (b) * SHM_V + vst1) = sr_[i].vs1; int kc = sc * 2;               \
    *(bf16x8*)((char*)K_lds + (b) * SHM_K + KSWZ(sr, kc)) = sr_[i].ks0;                       \
    *(bf16x8*)((char*)K_lds + (b) * SHM_K + KSWZ(32 + sr, kc)) = sr_[i].ks1; } while (0)
#define SWAIT() do { if constexpr (SDEPTH == 2) asm volatile("s_waitcnt vmcnt(4)" ::: "memory"); else asm volatile("s_waitcnt vmcnt(0)" ::: "memory"); } while (0)
#define RESC(a) do { if (__any((a) < 1.f)) { if (hi == 0) al_l[r32] = (a); asm volatile("s_waitcnt lgkmcnt(0)" ::: "memory"); \
    _Pragma("unroll") for (int d = 0; d < 4; ++d) _Pragma("unroll") for (int r = 0; r < 16; ++r) o[d][r] *= al_l[crow(r, hi)]; } } while (0)
  f32x16 pA0, pA1, pB0, pB1; float mnA, mnB, alA, alB; bf16x8 pa0, pa1, pa2, pa3; const int NT = seq / KVBLK;
  constexpr int SE = 0, SO = SDEPTH - 1;
  SLOAD(SE, 0); asm volatile("s_waitcnt vmcnt(0)" ::: "memory"); SWRITE(0, SE); __syncthreads();
  qkt(pA0, pA1, K_lds, qr, r32, hi); partialSM(pA0, pA1, m_reg, mnA, alA);
  SLOAD(SO, KVBLK); if constexpr (SDEPTH == 2) { if (2 < NT) SLOAD(SE, 2 * KVBLK); }
  SWAIT(); SWRITE(1, SO); __syncthreads();
  for (int j = 1; j + 1 < NT; j += 2) {
    SBAR(); qkt(pB0, pB1, (bf16*)((char*)K_lds + SHM_K), qr, r32, hi);
    finishSM(pA0, pA1, alA, l_reg, pa0, pa1, pa2, pa3); SBAR();
    SLOAD(SO, (j + SDEPTH) * KVBLK); SBAR();
    pv_d0(o, vb0, pa0, pa1, pa2, pa3); partialSM(pB0, pB1, m_reg, mnB, alB);
    __syncthreads(); SWAIT(); SWRITE(0, SE);
    RESC(alB); __syncthreads();
    SBAR(); qkt(pA0, pA1, K_lds, qr, r32, hi);
    finishSM(pB0, pB1, alB, l_reg, pa0, pa1, pa2, pa3); SBAR();
    if (SDEPTH == 1 || j + 3 < NT) SLOAD(SE, (j + 1 + SDEPTH) * KVBLK); SBAR();
    pv_d0(o, vb0 + (int)SHM_V, pa0, pa1, pa2, pa3); partialSM(pA0, pA1, m_reg, mnA, alA);
    __syncthreads(); SWAIT(); SWRITE(1, SO);
    RESC(alA); __syncthreads();
  }
  SBAR(); qkt(pB0, pB1, (bf16*)((char*)K_lds + SHM_K), qr, r32, hi);
  finishSM(pA0, pA1, alA, l_reg, pa0, pa1, pa2, pa3); SBAR();
  pv_d0(o, vb0, pa0, pa1, pa2, pa3); partialSM(pB0, pB1, m_reg, mnB, alB);
  __syncthreads(); RESC(alB);
  finishSM(pB0, pB1, alB, l_reg, pa0, pa1, pa2, pa3); SBAR();
  pv_d0(o, vb0 + (int)SHM_V, pa0, pa1, pa2, pa3);
  if (hi == 0) li_l[r32] = l_reg; asm volatile("s_waitcnt lgkmcnt(0)" ::: "memory");
  { int tz = threadIdx.x; asm volatile("" : "+v"(tz)); wid = tz >> 6; lane = tz & 63; r32 = lane & 31; hi = lane >> 5; }
  float rli[16];
#pragma unroll
  for (int r = 0; r < 16; ++r) rli[r] = __builtin_amdgcn_rcpf(li_l[crow(r, hi)]);
  char* ost = lds + OST_OFF + wid * (32 * 272);
#pragma unroll
  for (int r = 0; r < 16; ++r) { const int orow = crow(r, hi);
#pragma unroll
    for (int d0 = 0; d0 < 4; ++d0) *(bf16*)(ost + orow * 272 + (d0 * 32 + r32) * 2) = __float2bfloat16(o[d0][r] * rli[r]); }
  asm volatile("s_waitcnt lgkmcnt(0)" ::: "memory");
  bf16* Ow = Ob + (long)(wid * QBLK) * LDO; const bf16* Zw = Zb + (long)(wid * QBLK) * LDQ;
#pragma unroll
  for (int hb = 0; hb < 2; ++hb) {
    u32x4 ov[4], zv[4];
#pragma unroll
    for (int i = 0; i < 4; ++i) { const int c = (hb * 4 + i) * 64 + lane, row = c >> 4, col = (c & 15) * 8;
      ov[i] = *reinterpret_cast<const u32x4*>(ost + row * 272 + col * 2); zv[i] = *reinterpret_cast<const u32x4*>(Zw + (long)row * LDQ + col); }
#pragma unroll
    for (int i = 0; i < 4; ++i) { const int c = (hb * 4 + i) * 64 + lane, row = c >> 4, col = (c & 15) * 8; u32x4 w;
#pragma unroll
      for (int e = 0; e < 4; ++e) { const unsigned a = ov[i][e], z = zv[i][e];
        w[e] = cvtpk(__uint_as_float(a << 16) * __uint_as_float(z << 16), __uint_as_float(a & 0xffff0000u) * __uint_as_float(z & 0xffff0000u)); }
      *reinterpret_cast<u32x4*>(Ow + (long)row * LDO + col) = w; }
  }
  __syncthreads();
#undef SLOAD
#undef SWRITE
#undef SWAIT
#undef RESC
}
}

constexpr int NWAVES = 8;
#ifndef MK_N_LAUNCHES
#define MK_N_LAUNCHES 30
#endif
constexpr int PH_PER_LAYER = 7, N_PHASES = 2 + DEPTH * PH_PER_LAYER;
constexpr size_t MiB = 1u << 20;
constexpr size_t WS_CTL = 0, CTL_ZERO_BYTES = 1 * MiB;
constexpr size_t WS_MOD = 1 * MiB;
constexpr size_t WS_ROPE = WS_MOD + MiB / 2;
constexpr size_t WS_WG = 3 * MiB;
constexpr size_t WS_WLRU = 4 * MiB;
constexpr size_t WS_WOUT = 12 * MiB;
constexpr size_t WS_WBR = 44 * MiB;
constexpr size_t WS_WIN = 140 * MiB;
constexpr size_t WS_X = 540 * MiB;
constexpr size_t WS_Y = 612 * MiB;
constexpr size_t WS_H = 684 * MiB;
constexpr size_t WS_G2 = 720 * MiB;
constexpr size_t WS_YB = 756 * MiB;
constexpr size_t WS_ACC = 864 * MiB;
constexpr size_t WS_GT = 936 * MiB;
constexpr size_t WS_MH = 938 * MiB;
constexpr size_t WS_P = 1082 * MiB;
constexpr size_t WS_LA = 1532 * MiB;
constexpr size_t WS_LB = 1676 * MiB;
constexpr size_t WS_HL = 1820 * MiB;
constexpr size_t WS_END = 1964 * MiB;
constexpr int CW_BAR = 4096;
constexpr int RING_BYTES = 131072, LDS_BYTES = 147456, MISC_OFF = LDS_BYTES - 256;
static_assert(att::OST_END <= MISC_OFF, "LDS map");

#define GAS __attribute__((address_space(1)))
#define LAS __attribute__((address_space(3)))
typedef unsigned short bf16_t;
typedef unsigned v4u __attribute__((ext_vector_type(4)));
typedef unsigned v2u __attribute__((ext_vector_type(2)));
typedef float f32x4 __attribute__((ext_vector_type(4)));
#define LDS_WAIT() asm volatile("s_waitcnt lgkmcnt(0)" ::: "memory")
__device__ __forceinline__ unsigned f2bf(float f) { unsigned u = __builtin_bit_cast(unsigned, f); return (u + 0x7fffu + ((u >> 16) & 1u)) >> 16; }
__device__ __forceinline__ unsigned pk2(float lo, float hi) { return f2bf(lo) | (f2bf(hi) << 16); }
__device__ __forceinline__ float bf2f(bf16_t b) { return __uint_as_float((unsigned)b << 16); }
__device__ __forceinline__ float blo(unsigned w) { return __uint_as_float(w << 16); }
__device__ __forceinline__ float bhi(unsigned w) { return __uint_as_float(w & 0xffff0000u); }
__device__ __forceinline__ float wave_sum(float v) {
#pragma unroll
    for (int o = 1; o < 64; o <<= 1) v += __shfl_xor(v, o);
    return v;
}
#define XB_TMO      128
#define XB_XCNT(j)  (256  + 64 * (j))
#define XB_XSUB(j)  (1280 + 64 * (j))
#define XB_XGEN(j)  (2304 + 64 * (j))
#define XB_TOP      3328
#define XB_TOPGEN   3392
#define XCD_BAR_WORDS 3456
#define XB_SPIN_CAP (1u << 18)

__device__ __forceinline__ unsigned xb_ld(unsigned* p)              { return __hip_atomic_load(p, __ATOMIC_RELAXED, __HIP_MEMORY_SCOPE_AGENT); }
__device__ __forceinline__ unsigned xb_add(unsigned* p, unsigned v) { return __hip_atomic_fetch_add(p, v, __ATOMIC_RELAXED, __HIP_MEMORY_SCOPE_AGENT); }
__device__ __forceinline__ unsigned xb_xcc_id() { return (unsigned)__builtin_amdgcn_s_getreg((3 << 11) | 20) & 0xFu; }
#define XB_SPIN(cond, bar) do { unsigned _sp = 0; while (cond) { __builtin_amdgcn_s_sleep(1); \
    if ((++_sp & 255u) == 0u) { if (xb_ld(&(bar)[XB_TMO])) break; if (_sp > XB_SPIN_CAP) { atomicAdd(&(bar)[XB_TMO], 1u); break; } } } } while (0)

struct XcdBarrier {
    unsigned* bar; unsigned x;
    volatile LAS unsigned* st;
};

__device__ __forceinline__ XcdBarrier xcd_barrier_post(unsigned* bar, volatile LAS unsigned* st) {
    XcdBarrier b; b.bar = bar; b.x = xb_xcc_id(); b.st = st;
    if (threadIdx.x == 0) (void)xb_add(&bar[XB_XCNT(b.x)], 1u);
    return b;
}
__device__ __forceinline__ void xcd_barrier_complete(unsigned* bar, unsigned x, unsigned& nloc, unsigned& nx) {
    const unsigned G = gridDim.x * gridDim.y * gridDim.z;
    unsigned sum, cnt, mine, sp = 0u;
    for (;;) {
        sum = 0u; cnt = 0u; mine = 0u;
#pragma unroll
        for (unsigned j = 0; j < 16; ++j) { const unsigned c = xb_ld(&bar[XB_XCNT(j)]); sum += c; cnt += (c > 0u) ? 1u : 0u; mine = (j == x) ? c : mine; }
        if (sum == G) break;
        __builtin_amdgcn_s_sleep(1);
        if ((++sp & 255u) == 0u) { if (xb_ld(&bar[XB_TMO])) break; if (sp > XB_SPIN_CAP) { atomicAdd(&bar[XB_TMO], 1u); break; } }
    }
    nloc = mine > 0u ? mine : 1u; nx = cnt > 0u ? cnt : 1u;
}

__device__ __forceinline__ void xcd_barrier(const XcdBarrier& b) {
    asm volatile("s_waitcnt vmcnt(0)" ::: "memory");
    __syncthreads();
    if (threadIdx.x == 0) {
        unsigned* bar = b.bar;
        __builtin_amdgcn_s_waitcnt(0);
        unsigned nloc = b.st[0], nx = b.st[1];
        if (nloc == 0u) { xcd_barrier_complete(bar, b.x, nloc, nx); b.st[0] = nloc; b.st[1] = nx; }
        const unsigned old = xb_add(&bar[XB_XSUB(b.x)], 1u);
        const unsigned gen = old / nloc;
        if (old + 1u == (gen + 1u) * nloc) {
            __builtin_amdgcn_fence(__ATOMIC_RELEASE, "agent");
            asm volatile("s_waitcnt vmcnt(0)" ::: "memory");
            const unsigned og = xb_add(&bar[XB_TOP], 1u);
            const unsigned tg = og / nx;
            if (og + 1u == (tg + 1u) * nx) xb_add(&bar[XB_TOPGEN], 1u);
            else XB_SPIN(xb_ld(&bar[XB_TOPGEN]) == tg, bar);
            __builtin_amdgcn_fence(__ATOMIC_ACQUIRE, "agent");
            xb_add(&bar[XB_XGEN(b.x)], 1u);
            asm volatile("s_waitcnt vmcnt(0)" ::: "memory");
        } else {
            XB_SPIN(xb_ld(&bar[XB_XGEN(b.x)]) == gen, bar);
            __builtin_amdgcn_fence(__ATOMIC_ACQUIRE, "agent");
            asm volatile("s_waitcnt vmcnt(0)" ::: "memory");
        }
    }
    __syncthreads();
}

struct Args { const float* in[22]; float* out; unsigned char* ws; int ph_lo, ph_hi; };
typedef const __attribute__((address_space(4))) Args CArgs;
#define KIN(k) ((const float*)ka->in[k])
#define WSF(off) ((float*)(ka->ws + (off)))
#define WSB(off) ((bf16_t*)(ka->ws + (off)))
#define KA() ({ CArgs* _k = ka0; asm volatile("" : "+s"(_k)); _k; })
__device__ __forceinline__ int tid_fresh() { int t = threadIdx.x; asm volatile("" : "+v"(t)); return t; }
struct Frame {
    LAS unsigned char* lds; char* ldsg;
    int tid, lane, wave, G, wg;
};

__device__ __forceinline__ void transpose_item(const float* W, int ldw, int col0, int k0, bf16_t* WT, int ldt, int drow0, LAS float* scr, int lane) {
#pragma unroll 8
    for (int i = 0; i < 32; ++i) { const int kk = 2 * i + (lane >> 5); scr[kk * 33 + (lane & 31)] = W[(size_t)(k0 + kk) * ldw + col0 + (lane & 31)]; }
    LDS_WAIT(); asm volatile("" ::: "memory");
    const int c = lane & 7;
#pragma unroll
    for (int j = 0; j < 4; ++j) { const int n = (lane >> 3) + 8 * j; const LAS float* s = scr + (8 * c) * 33 + n;
        v4u o; o.x = pk2(s[0 * 33], s[1 * 33]); o.y = pk2(s[2 * 33], s[3 * 33]); o.z = pk2(s[4 * 33], s[5 * 33]); o.w = pk2(s[6 * 33], s[7 * 33]);
        *(v4u*)(WT + (size_t)(drow0 + n) * ldt + k0 + 8 * c) = o; }
    LDS_WAIT(); asm volatile("" ::: "memory");
}
__device__ __forceinline__ void p_prologue(Frame& F, CArgs* ka) {
    const int tid = tid_fresh(), lane = tid & 63, wave = __builtin_amdgcn_readfirstlane(tid >> 6); (void)lane; (void)wave;
    LAS float* scr = (LAS float*)(F.lds + wave * 8704);
    const int gw = F.wg * NWAVES + wave, NGW = F.G * NWAVES;
    constexpr int I_IN = 32 * 800, I_G = 32, I_BR = 3 * 2048, I_OUT = 2048, I_LRU = 2 * 2 * 16 * 8, I_LAYER = I_IN + I_G + I_BR + I_OUT + I_LRU;
    for (int it = gw; it < DEPTH * I_LAYER; it += NGW) {
        const int l = it / I_LAYER; int r = it - l * I_LAYER;
        if (r < I_IN) { const int kb = r / 800, nb = r - kb * 800, n0 = nb * 32, sc = n0 < 14336 ? n0 : n0 + 32;
            transpose_item(KIN(8) + (size_t)l * DM * NIN, NIN, sc, kb * 64, WSB(WS_WIN) + (size_t)l * NP * DM, DM, n0, scr, lane); continue; }
        r -= I_IN;
        if (r < I_G) { transpose_item(KIN(8) + (size_t)l * DM * NIN, NIN, 14336, r * 64, WSB(WS_WG) + (size_t)l * 32 * DM, DM, 0, scr, lane); continue; }
        r -= I_G;
        if (r < I_BR) { const int z = r / 2048, q = r - z * 2048, kb = q / 64, nb = q - kb * 64;
            transpose_item(KIN(20) + ((size_t)l * 3 + z) * DM * DM, DM, nb * 32, kb * 64, WSB(WS_WBR) + ((size_t)l * 3 + z) * DM * DM, DM, nb * 32, scr, lane); continue; }
        r -= I_BR;
        if (r < I_OUT) { const int kb = r / 64, nb = r - kb * 64;
            transpose_item(KIN(21) + (size_t)l * DM * DM, DM, nb * 32, kb * 64, WSB(WS_WOUT) + (size_t)l * DM * DM, DM, nb * 32, scr, lane); continue; }
        r -= I_OUT;
        { const int q = r & 7, mt = r >> 3, blk = mt & 15, gate = (mt >> 4) & 1, dr = mt >> 5, kb = q >> 2, nb = q & 3;
          const float* src = (gate ? KIN(13) : KIN(11)) + (((size_t)l * 2 + dr) * 16 + blk) * 16384;
          transpose_item(src, 128, nb * 32, kb * 64, WSB(WS_WLRU) + ((((size_t)l * 2 + dr) * 2 + gate) * 16 + blk) * 16384, 128, nb * 32, scr, lane); }
    }
    for (int i = F.wg * 512 + tid; i < SEQ * 64; i += F.G * 512) { const int t = i >> 6, j = i & 63;
        const float inv = 1.0f / powf(10000.0f, (float)(j & 31) * (1.0f / 32.0f)); const float pos = (float)(j < 32 ? (t >> 6) : (t & 63)); const float ang = pos * inv;
        WSF(WS_ROPE)[i] = cosf(ang); WSF(WS_ROPE)[SEQ * 64 + i] = sinf(ang); }
    __syncthreads();
    LAS float* sc = (LAS float*)(F.lds + 73728);
    LAS float* red = (LAS float*)(F.lds + 73728 + 5 * 2048 * 4);
    for (int i = tid; i < 5 * DM; i += 512) { const int bi = i >> 11, k = i & 2047; const float v = bi < 4 ? KIN(1)[bi * DM + k] : KIN(3)[k]; sc[i] = v / (1.f + expf(-v)); }
    __syncthreads();
    for (int it = F.wg; it < DEPTH * 192; it += F.G) { const int l = it / 192, j0 = (it - l * 192) * 32, cj = tid & 31, ks = tid >> 5;
        float a0 = 0.f, a1 = 0.f, a2 = 0.f, a3 = 0.f, a4 = 0.f; const float* w = KIN(4) + (size_t)l * DM * 3 * DM + j0 + cj;
        for (int k = ks * 128; k < ks * 128 + 128; ++k) { const float wv = w[(size_t)k * (3 * DM)]; a0 += sc[k] * wv; a1 += sc[2048 + k] * wv; a2 += sc[4096 + k] * wv; a3 += sc[6144 + k] * wv; a4 += sc[8192 + k] * wv; }
        red[(ks * 5 + 0) * 32 + cj] = a0; red[(ks * 5 + 1) * 32 + cj] = a1; red[(ks * 5 + 2) * 32 + cj] = a2; red[(ks * 5 + 3) * 32 + cj] = a3; red[(ks * 5 + 4) * 32 + cj] = a4;
        __syncthreads();
        if (tid < 160) { const int bi = tid >> 5, c = tid & 31; float s = KIN(5)[(size_t)l * 3 * DM + j0 + c];
            for (int q = 0; q < 16; ++q) s += red[(q * 5 + bi) * 32 + c];
            WSF(WS_MOD)[((size_t)l * 5 + bi) * (3 * DM) + j0 + c] = s; }
        __syncthreads();
    }
}

__device__ __forceinline__ void p_norm(Frame& F, CArgs* ka, int l) {
    const int tid = tid_fresh(), lane = tid & 63, wave = __builtin_amdgcn_readfirstlane(tid >> 6); (void)lane; (void)wave;
    const int gw = F.wg * NWAVES + wave, NGW = F.G * NWAVES;
    for (int r = gw; r < MROWS; r += NGW) {
        const int b = r / TPB, t = r - b * TPB; const bool isctx = t >= SEQ; const int bi = isctx ? 4 : b;
        if (l == DEPTH && isctx) continue;
        f32x4 v[8];
        if (l == 0) { const float* src = isctx ? KIN(2) + ((size_t)b * CTXL + (t - SEQ)) * DM : KIN(0) + ((size_t)b * SEQ + t) * DM;
#pragma unroll
            for (int j = 0; j < 8; ++j) v[j] = *(const f32x4*)(src + j * 256 + lane * 4);
        } else {
            const float* yr = WSF(WS_Y) + (size_t)r * DM; const float* xr = WSF(WS_X) + (size_t)r * DM; f32x4 y[8]; float ss = 0.f;
#pragma unroll
            for (int j = 0; j < 8; ++j) { y[j] = *(const f32x4*)(yr + j * 256 + lane * 4); ss += y[j].x * y[j].x + y[j].y * y[j].y + y[j].z * y[j].z + y[j].w * y[j].w; }
            const float rs = rsqrtf(wave_sum(ss) * (1.f / DM) + EPS);
            const float* gate = WSF(WS_MOD) + ((size_t)(l - 1) * 5 + bi) * (3 * DM) + 2 * DM; const float* npost = KIN(7) + (size_t)(l - 1) * DM;
#pragma unroll
            for (int j = 0; j < 8; ++j) { const int c = j * 256 + lane * 4; const f32x4 g = *(const f32x4*)(gate + c), w = *(const f32x4*)(npost + c), xv = *(const f32x4*)(xr + c);
                v[j] = xv + g * (y[j] * rs * w); }
        }
        if (l == DEPTH) { float* o = (ka->out) + ((size_t)b * SEQ + t) * DM;
#pragma unroll
            for (int j = 0; j < 8; ++j) *(f32x4*)(o + j * 256 + lane * 4) = v[j];
            continue; }
        float* xo = WSF(WS_X) + (size_t)r * DM; float ss = 0.f;
#pragma unroll
        for (int j = 0; j < 8; ++j) { *(f32x4*)(xo + j * 256 + lane * 4) = v[j]; ss += v[j].x * v[j].x + v[j].y * v[j].y + v[j].z * v[j].z + v[j].w * v[j].w; }
        const float rs = rsqrtf(wave_sum(ss) * (1.f / DM) + EPS);
        const float* shift = WSF(WS_MOD) + ((size_t)l * 5 + bi) * (3 * DM); const float* scale = shift + DM; const float* npre = KIN(6) + (size_t)l * DM;
        bf16_t* ho = WSB(WS_H) + (size_t)r * DM;
#pragma unroll
        for (int j = 0; j < 8; ++j) { const int c = j * 256 + lane * 4; const f32x4 sh = *(const f32x4*)(shift + c), scv = *(const f32x4*)(scale + c), w = *(const f32x4*)(npre + c);
            const f32x4 h = v[j] * rs * w * (scv + 1.f) + sh; v2u o; o.x = pk2(h.x, h.y); o.y = pk2(h.z, h.w); *(v2u*)(ho + c) = o; }
    }
}

__device__ __forceinline__ void p_prep(Frame& F, CArgs* ka, int l) {
    const int tid = tid_fresh(), lane = tid & 63, wave = __builtin_amdgcn_readfirstlane(tid >> 6); (void)lane; (void)wave;
    const int gw = F.wg * NWAVES + wave, NGW = F.G * NWAVES;
    for (int it = gw; it < MROWS * 4; it += NGW) { const int r = it >> 2, j = it & 3, b = r / TPB, t = r - b * TPB;
        bf16_t* kp = WSB(WS_P) + (size_t)r * NP + C_AK + j * 128; const float k1 = bf2f(kp[lane]), k2 = bf2f(kp[lane + 64]);
        const float rs = rsqrtf(wave_sum(k1 * k1 + k2 * k2) * (1.f / 128.f) + EPS);
        float n1 = k1 * rs * KIN(19)[l * 128 + lane], n2 = k2 * rs * KIN(19)[l * 128 + 64 + lane];
        if (t < SEQ) { const float c = WSF(WS_ROPE)[t * 64 + lane], s = WSF(WS_ROPE)[SEQ * 64 + t * 64 + lane]; const float o1 = n1 * c - n2 * s, o2 = n2 * c + n1 * s; n1 = o1; n2 = o2; }
        kp[lane] = (bf16_t)f2bf(n1); kp[lane + 64] = (bf16_t)f2bf(n2); }
    for (int r = gw; r < MROWS; r += NGW) { const int c = lane & 31, hf = lane >> 5;
        const bf16_t* hp = WSB(WS_H) + (size_t)r * DM + hf * 1024; const bf16_t* wp = WSB(WS_WG) + ((size_t)l * 32 + c) * DM + hf * 1024; float s = 0.f;
        for (int k = 0; k < 1024; k += 8) { const v4u a = *(const v4u*)(hp + k), w = *(const v4u*)(wp + k);
            s += blo(a.x) * blo(w.x) + bhi(a.x) * bhi(w.x) + blo(a.y) * blo(w.y) + bhi(a.y) * bhi(w.y) + blo(a.z) * blo(w.z) + bhi(a.z) * bhi(w.z) + blo(a.w) * blo(w.w) + bhi(a.w) * bhi(w.w); }
        s += __shfl_xor(s, 32); s += KIN(16)[l * 32 + c];
        if ((c >> 3) & 1) s = fminf(s, 0.f) - log1pf(expf(-fabsf(s)));
        if (hf == 0) WSF(WS_GT)[(size_t)r * 32 + c] = s; }
    LAS float* xs = (LAS float*)F.lds;
    for (int it = F.wg; it < (MROWS / 16) * 16; it += F.G) { const int rt = it >> 4, blk = it & 15;
        __syncthreads();
#pragma unroll
        for (int j = 0; j < 4; ++j) { const int idx = tid + 512 * j, rr = idx >> 7, c = idx & 127, r = rt * 16 + rr, b = r / TPB, t = r - b * TPB, ch = blk * 128 + c;
            const int lo = t < SEQ ? 0 : SEQ, hi = t < SEQ ? SEQ : TPB; float a = KIN(10)[l * DM + ch];
#pragma unroll
            for (int k = 0; k < 4; ++k) { const int tt = t + k - 2; if (tt >= lo && tt < hi) a += KIN(9)[((size_t)l * 4 + k) * DM + ch] * bf2f(WSB(WS_P)[((size_t)b * TPB + tt) * NP + C_LX + ch]); }
            xs[rr * 128 + c] = a; }
        __syncthreads();
        const int co = tid & 127, r0 = tid >> 7, ch = blk * 128 + co;
#pragma unroll 1
        for (int dr = 0; dr < 2; ++dr) {
            const float* wr = KIN(11) + (((size_t)l * 2 + dr) * 16 + blk) * 16384 + co; const float* wi = KIN(13) + (((size_t)l * 2 + dr) * 16 + blk) * 16384 + co;
            float ar[4], ai[4];
#pragma unroll
            for (int j = 0; j < 4; ++j) { ar[j] = KIN(12)[((size_t)l * 2 + dr) * DM + ch]; ai[j] = KIN(14)[((size_t)l * 2 + dr) * DM + ch]; }
            for (int c = 0; c < 128; ++c) { const float w0 = wr[c * 128], w1 = wi[c * 128];
#pragma unroll
                for (int j = 0; j < 4; ++j) { const float xv = xs[(r0 + 4 * j) * 128 + c]; ar[j] += xv * w0; ai[j] += xv * w1; } }
            const float lam = KIN(15)[((size_t)l * 2 + dr) * DM + ch], sp = log1pf(expf(-lam));
#pragma unroll
            for (int j = 0; j < 4; ++j) { const int r = rt * 16 + r0 + 4 * j; const float rg = 1.f / (1.f + expf(-ar[j])), ig = 1.f / (1.f + expf(-ai[j]));
                const float log_a = -8.f * rg * sp, a = expf(log_a), mult = sqrtf(-expm1f(2.f * log_a));
                WSF(WS_LA)[((size_t)dr * MROWS + r) * DM + ch] = a; WSF(WS_LB)[((size_t)dr * MROWS + r) * DM + ch] = mult * ig * xs[(r0 + 4 * j) * 128 + co]; }
        }
    }
    __syncthreads();
}

__device__ __forceinline__ void p_attention(Frame& F, CArgs* ka, int l, bool need_ctx) {
    using att::bf16;
    const int n_lat = NBATCH * 16 * 8, n_all = n_lat + (need_ctx ? NBATCH * 16 : 0);
    for (int u = F.wg; u < n_all; u += F.G) {
        int b, h, q0, k0, seq; const float *cs = nullptr, *sn = nullptr;
        if (u < n_lat) { const int qb = u & 7; h = (u >> 3) & 15; b = u >> 7; q0 = qb * 256; k0 = 0; seq = TPB; cs = WSF(WS_ROPE) + (size_t)q0 * 64; sn = WSF(WS_ROPE) + (size_t)SEQ * 64 + (size_t)q0 * 64; }
        else { const int v = u - n_lat; h = v & 15; b = v >> 4; q0 = SEQ; k0 = SEQ; seq = CTXL; }
        const size_t rq = (size_t)b * TPB + q0, rk = (size_t)b * TPB + k0; const int kvh = h >> 2;
        att::attn_unit((const bf16*)(WSB(WS_P) + rq * NP + C_AQ + h * 128), (const bf16*)(WSB(WS_P) + rk * NP + C_AK + kvh * 128), (const bf16*)(WSB(WS_P) + rk * NP + C_AV + kvh * 128),
                       (const bf16*)(WSB(WS_P) + rq * NP + C_AZ + h * 128), (bf16*)(WSB(WS_YB) + ((size_t)2 * MROWS + rq) * DM + h * 128), seq, F.ldsg, KIN(18) + l * 128, cs, sn);
    }
}
__device__ __forceinline__ int seq_row(int s, int dir) { return s < CTXL ? SEQ + (dir ? CTXL - 1 - s : s) : (dir ? SEQ - 1 - (s - CTXL) : s - CTXL); }
__device__ __forceinline__ void p_mlstm_naive(Frame& F, CArgs* ka, int l) {
    const int tid = tid_fresh(), lane = tid & 63, wave = __builtin_amdgcn_readfirstlane(tid >> 6); (void)lane; (void)wave;
    LAS float* sq = (LAS float*)F.lds; LAS float* sk = sq + 256; LAS float* rn = sk + 256; LAS float* rd = rn + 512;
    const int e = tid & 63, dg = tid >> 6;
    for (int u = F.wg; u < 256; u += F.G) { const int es = u & 3, dir = (u >> 2) & 1, h = (u >> 3) & 7, b = u >> 6;
        float C[32], n[32];
#pragma unroll
        for (int i = 0; i < 32; ++i) { C[i] = 0.f; n[i] = 0.f; }
        float m = -1e30f;
        const int lcol = tid < 64 ? C_MQ + h * 256 + tid * 4 : C_MK + h * 256 + (tid - 64) * 4, vcol = C_MV + h * 256 + es * 64 + e;
        v2u pqk = {0u, 0u}; bf16_t pv; float gi, gf;
        { const size_t r = (size_t)b * TPB + seq_row(0, dir); if (tid < 128) pqk = *(const v2u*)(WSB(WS_P) + r * NP + lcol); pv = WSB(WS_P)[r * NP + vcol]; gi = WSF(WS_GT)[r * 32 + dir * 16 + h]; gf = WSF(WS_GT)[r * 32 + dir * 16 + 8 + h]; }
        __syncthreads();
        for (int s = 0; s < TPB; ++s) {
            const size_t r = (size_t)b * TPB + seq_row(s, dir);
            if (tid < 128) { LAS float* d = (tid < 64 ? sq : sk) + (tid & 63) * 4; d[0] = blo(pqk.x); d[1] = bhi(pqk.x); d[2] = blo(pqk.y); d[3] = bhi(pqk.y); }
            const float vv = bf2f(pv), iv = gi, lf = gf;
            __syncthreads();
            if (s + 1 < TPB) { const size_t r2 = (size_t)b * TPB + seq_row(s + 1, dir); if (tid < 128) pqk = *(const v2u*)(WSB(WS_P) + r2 * NP + lcol); pv = WSB(WS_P)[r2 * NP + vcol]; gi = WSF(WS_GT)[r2 * 32 + dir * 16 + h]; gf = WSF(WS_GT)[r2 * 32 + dir * 16 + 8 + h]; }
            const float mnew = fmaxf(lf + m, iv), fw = expf(lf + m - mnew), iw = expf(iv - mnew); m = mnew;
            float pn = 0.f, pd = 0.f;
#pragma unroll
            for (int dd = 0; dd < 32; ++dd) { const float kd = sk[dg * 32 + dd], qd = sq[dg * 32 + dd]; C[dd] = fw * C[dd] + iw * kd * vv; n[dd] = fw * n[dd] + iw * kd; pn += qd * C[dd]; pd += qd * n[dd]; }
            rn[dg * 64 + e] = pn; rd[dg * 64 + e] = pd;
            __syncthreads();
            if (dg == 0) { float num = 0.f, den = 0.f;
#pragma unroll
                for (int g = 0; g < 8; ++g) { num += rn[g * 64 + e]; den += rd[g * 64 + e]; }
                WSF(WS_MH)[((size_t)dir * MROWS + r) * DM + h * 256 + es * 64 + e] = num / fmaxf(fabsf(den), expf(-m)); }
        }
        __syncthreads();
    }
}
__device__ __forceinline__ void p_lru_scan_naive(Frame& F, CArgs* ka) {
    const int tid = tid_fresh(), lane = tid & 63, wave = __builtin_amdgcn_readfirstlane(tid >> 6); (void)lane; (void)wave;
    if (wave != 0) return;
    for (int cw = F.wg; cw < 256; cw += F.G) { const int combo = cw * 64 + lane, b = combo >> 12, dir = (combo >> 11) & 1, ch = combo & 2047;
        const float* A = WSF(WS_LA) + (size_t)dir * MROWS * DM + ch; const float* Bx = WSF(WS_LB) + (size_t)dir * MROWS * DM + ch; float* Ho = WSF(WS_HL) + (size_t)dir * MROWS * DM + ch; float h = 0.f;
#pragma unroll 8
        for (int s = 0; s < TPB; ++s) { const size_t r = (size_t)b * TPB + seq_row(s, dir); h = A[r * DM] * h + Bx[r * DM]; Ho[r * DM] = h; }
    }
}

__device__ __forceinline__ void p_mlout(Frame& F, CArgs* ka, int l) {
    const int tid = tid_fresh(), lane = tid & 63, wave = __builtin_amdgcn_readfirstlane(tid >> 6); (void)lane; (void)wave;
    const int gw = F.wg * NWAVES + wave, NGW = F.G * NWAVES;
    for (int r = gw; r < MROWS; r += NGW) {
        const bf16_t* pr = WSB(WS_P) + (size_t)r * NP;
#pragma unroll 2
        for (int h = 0; h < 8; ++h) { const int col = h * 256 + lane * 4;
            const f32x4 a = *(const f32x4*)(WSF(WS_MH) + (size_t)r * DM + col), bb = *(const f32x4*)(WSF(WS_MH) + ((size_t)MROWS + r) * DM + col);
            const v2u ow = *(const v2u*)(pr + C_MO + col), zw = *(const v2u*)(pr + C_MZ + col); const f32x4 g = *(const f32x4*)(KIN(17) + (size_t)l * DM + col);
            f32x4 v = a + bb; v.x *= blo(ow.x); v.y *= bhi(ow.x); v.z *= blo(ow.y); v.w *= bhi(ow.y);
            const float rs = rsqrtf(wave_sum(v.x * v.x + v.y * v.y + v.z * v.z + v.w * v.w) * (1.f / 256.f) + EPS);
            v2u o; o.x = pk2(v.x * rs * g.x * blo(zw.x), v.y * rs * g.y * bhi(zw.x)); o.y = pk2(v.z * rs * g.z * blo(zw.y), v.w * rs * g.w * bhi(zw.y));
            *(v2u*)(WSB(WS_YB) + ((size_t)MROWS + r) * DM + col) = o; }
#pragma unroll 2
        for (int j = 0; j < 8; ++j) { const int col = j * 256 + lane * 4;
            const f32x4 a = *(const f32x4*)(WSF(WS_HL) + (size_t)r * DM + col), bb = *(const f32x4*)(WSF(WS_HL) + ((size_t)MROWS + r) * DM + col); const v2u zw = *(const v2u*)(pr + C_LZ + col);
            const f32x4 v = a + bb; v2u o; o.x = pk2(v.x * blo(zw.x), v.y * bhi(zw.x)); o.y = pk2(v.z * blo(zw.y), v.w * bhi(zw.y));
            *(v2u*)(WSB(WS_YB) + (size_t)r * DM + col) = o; }
    }
}

__global__ void __launch_bounds__(NWAVES * 64, 2) fwd(Args args) {
    extern __shared__ __attribute__((aligned(16))) unsigned char lds[];
    Frame F;
    F.lds = (LAS unsigned char*)lds; F.ldsg = (char*)lds;
    F.tid = threadIdx.x; F.lane = F.tid & 63; F.wave = __builtin_amdgcn_readfirstlane(F.tid >> 6); F.G = gridDim.x; F.wg = blockIdx.x;
    CArgs* const ka0 = (CArgs*)__builtin_amdgcn_kernarg_segment_ptr();
    unsigned char* ws; { CArgs* ka = ka0; ws = ka->ws; }
    volatile LAS unsigned* MISC = (volatile LAS unsigned*)(F.lds + MISC_OFF);
    if (F.tid < 64) ((LAS unsigned*)(F.lds + MISC_OFF))[F.tid] = 0u;
    __syncthreads();
    const int lo = ka0->ph_lo, hi = ka0->ph_hi;
    XcdBarrier bar; bar.bar = (unsigned*)(ws + WS_CTL) + CW_BAR; bar.x = 0; bar.st = nullptr;
    if (hi - lo > 1) bar = xcd_barrier_post((unsigned*)(ws + WS_CTL) + CW_BAR, MISC + 8);
#define IN(k) (lo <= (k) && (k) < hi)
#define SEAM(k) do { if ((k) + 1 < hi) xcd_barrier(bar); } while (0)

    if (IN(0)) { p_prologue(F, KA()); SEAM(0); }
#pragma unroll 1
    for (int l = 0; l < DEPTH; ++l) {
        const int base = 1 + l * PH_PER_LAYER; const bool need_ctx = l < DEPTH - 1;
        if (IN(base + 0)) { p_norm(F, KA(), l); SEAM(base + 0); }
        if (IN(base + 1)) {
            CArgs* ka = KA(); pg8::Gemm g{WSB(WS_H), WSB(WS_WIN) + (size_t)l * NP * DM, MROWS, NP, DM, 0, 0}; pg8::StaticOrder S; S.init(MROWS, NP, F.G, F.wg);
            pg8::EpiIn E{WSB(WS_P)};
            pg8::gemm_phase<pg8::EpiIn, pg8::StaticOrder, true, true>(F.lds, g, S, E);
            SEAM(base + 1);
        }
        if (IN(base + 2)) { p_prep(F, KA(), l); SEAM(base + 2); }
        if (IN(base + 3)) { p_attention(F, KA(), l, need_ctx); p_mlstm_naive(F, KA(), l); p_lru_scan_naive(F, KA()); SEAM(base + 3); }
        if (IN(base + 4)) { p_mlout(F, KA(), l); SEAM(base + 4); }
        if (IN(base + 5)) {
            CArgs* ka = KA(); pg8::Gemm g{WSB(WS_YB), WSB(WS_WBR) + (size_t)l * 3 * DM * DM, MROWS, DM, DM, (size_t)MROWS * DM * 2, (size_t)DM * DM * 2}; pg8::MergeOrder S; S.init(MROWS, DM, F.G, F.wg);
            pg8::EpiMerge E{WSB(WS_P), WSF(WS_ACC), WSB(WS_G2)};
            pg8::gemm_phase<pg8::EpiMerge, pg8::MergeOrder, true, true>(F.lds, g, S, E);
            SEAM(base + 5);
        }
        if (IN(base + 6)) {
            CArgs* ka = KA(); pg8::Gemm g{WSB(WS_G2), WSB(WS_WOUT) + (size_t)l * DM * DM, MROWS, DM, DM, 0, 0}; pg8::StaticOrder S; S.init(MROWS, DM, F.G, F.wg);
            pg8::EpiF32 E{WSF(WS_Y), DM};
            pg8::gemm_phase<pg8::EpiF32, pg8::StaticOrder, true, true>(F.lds, g, S, E);
            SEAM(base + 6);
        }
    }
    if (IN(N_PHASES - 1)) p_norm(F, KA(), DEPTH);
#undef IN
#undef SEAM
}

extern "C" void kernel_launch(void* const* d_in, const int* in_sizes, int n_in, void* d_out, int out_size, void* d_ws, size_t ws_size, hipStream_t stream) {
    static int grid = 0;
    if (grid == 0) {
        if (n_in != 22 || in_sizes[0] != NBATCH * SEQ * DM || out_size != NBATCH * SEQ * DM || ws_size < WS_END) {
            fprintf(stderr, "kernel_launch: unexpected shapes: n_in %d in0 %d out %d ws %zu (need %zu)\n", n_in, n_in > 0 ? in_sizes[0] : -1, out_size, ws_size, (size_t)WS_END); grid = -1; return; }
        int dev = 0, cus = 0, per_cu = 0;
        if (hipGetDevice(&dev) != hipSuccess || hipDeviceGetAttribute(&cus, hipDeviceAttributeMultiprocessorCount, dev) != hipSuccess) { fprintf(stderr, "kernel_launch: device query failed\n"); grid = -1; return; }
        if (hipFuncSetAttribute((const void*)fwd, hipFuncAttributeMaxDynamicSharedMemorySize, LDS_BYTES) != hipSuccess) { fprintf(stderr, "kernel_launch: hipFuncSetAttribute failed\n"); grid = -1; return; }
        if (hipOccupancyMaxActiveBlocksPerMultiprocessor(&per_cu, (const void*)fwd, NWAVES * 64, LDS_BYTES) != hipSuccess || per_cu < 1)
            fprintf(stderr, "kernel_launch: note: occupancy query reports %d workgroups per CU\n", per_cu);
        (void)hipGetLastError();
        grid = cus;
    }
    if (grid < 0) return;
    if (hipMemsetAsync((char*)d_ws + WS_CTL, 0, CTL_ZERO_BYTES, stream) != hipSuccess) { fprintf(stderr, "kernel_launch: memset failed\n"); return; }
    Args a{};
    for (int i = 0; i < 22; ++i) a.in[i] = (const float*)d_in[i];
    a.out = (float*)d_out; a.ws = (unsigned char*)d_ws;
    if (MK_N_LAUNCHES == 1) { a.ph_lo = 0; a.ph_hi = N_PHASES; hipLaunchKernelGGL(fwd, dim3(grid), dim3(NWAVES * 64), LDS_BYTES, stream, a); }
    else for (int k = 0; k < N_PHASES; ++k) { a.ph_lo = k; a.ph_hi = k + 1; hipLaunchKernelGGL(fwd, dim3(grid), dim3(NWAVES * 64), LDS_BYTES, stream, a); }
    const hipError_t le = hipPeekAtLastError();
    if (le != hipSuccess) fprintf(stderr, "kernel_launch: launch failed: %s\n", hipGetErrorName(le));
}
```

```cpp
#include <hip/hip_runtime.h>
#include <hip/hip_bf16.h>
#include <cstdio>
#include <cstdint>

constexpr int DM = 2048, NBATCH = 4, SEQ = 2048, CTXL = 256, TPB = SEQ + CTXL  , MROWS = NBATCH * TPB  , DEPTH = 4;
constexpr int NIN = 25632, NP = 25600;
constexpr int C_LX = 0, C_LZ = 2048, C_MQ = 4096, C_MK = 6144, C_MV = 8192, C_MO = 10240, C_MZ = 12288, C_AQ = 14336, C_AK = 16384, C_AV = 16896, C_AZ = 17408, C_MG = 19456;
constexpr float EPS = 1e-6f;
namespace pg8 {
#define PG8_LAS __attribute__((address_space(3)))
typedef unsigned short bf16_t;
typedef short bf16x8 __attribute__((ext_vector_type(8)));
typedef float f32x4 __attribute__((ext_vector_type(4)));
typedef unsigned u32x4 __attribute__((ext_vector_type(4)));
constexpr int BM = 256, BK = 64, HALF = 128, HTB = HALF * BK * 2  , STAGE_BYTES = 8 * HTB, NXCD = 8, WGM = 8;

__host__ __device__ __forceinline__ int lds_byte(int r, int c) { const int st = (r >> 4) * 2 + (c >> 5), rr = r & 15, cc = c & 31, ob = rr * 64 + cc * 2; return st * 1024 + (ob ^ (((ob >> 9) & 1) << 5)); }
__host__ __device__ __forceinline__ void stage_rc(int b, int& R, int& C) { const int st = b / 1024, sb = b % 1024, swz = sb ^ (((sb >> 9) & 1) << 5); R = (st >> 1) * 16 + swz / 64; C = (st & 1) * 32 + (swz % 64) / 2; }
__host__ __device__ __forceinline__ int perm32(int rho) { const int n = rho >> 4, i = rho & 15; return 8 * (i >> 2) + 4 * n + (i & 3); }

struct Unit { int pm, pn, z; };
struct Gemm { const bf16_t* A; const bf16_t* Bt; int M, N, K; size_t zA, zB; };

struct StaticOrder {
    int nM, nN, nwg, G, c;
    __host__ __device__ void init(int M, int N, int G_, int c_) { nM = M / BM; nN = N / BM; nwg = nM * nN; G = G_; c = c_; }
    __host__ __device__ bool next(int i, Unit& u) const {
        const long L = (long)i * G + c; if (L >= nwg) return false;
        int wgid = (int)L; { const int q = nwg / NXCD, r = nwg % NXCD, xcd = wgid % NXCD, off = wgid / NXCD; wgid = (xcd < r ? xcd * (q + 1) : r * (q + 1) + (xcd - r) * q) + off; }
        const int nig = WGM * nN, gid = wgid / nig, fm = gid * WGM, gsz = (nM - fm) < WGM ? (nM - fm) : WGM;
        u.pm = fm + ((wgid % nig) % gsz); u.pn = (wgid % nig) / gsz; u.z = 0; return true;
    }
    __device__ __forceinline__ void a_ready(const Unit&) const {}
    __device__ __forceinline__ void done(const Unit&) const {}
};
struct MergeOrder : StaticOrder {
    __host__ __device__ bool next(int i, Unit& u) const { const int it = i / 3; if (!StaticOrder::next(it, u)) return false; u.z = i - 3 * it; return true; }
};

__device__ __forceinline__ unsigned cvt_pk_bf16(float lo, float hi) { unsigned r; asm volatile("v_cvt_pk_bf16_f32 %0, %1, %2" : "=v"(r) : "v"(lo), "v"(hi)); return r; }
__device__ __forceinline__ float bflo(unsigned w) { return __uint_as_float(w << 16); }
__device__ __forceinline__ float bfhi(unsigned w) { return __uint_as_float(w & 0xffff0000u); }
__device__ __forceinline__ float sigmoid_f(float x) { return __builtin_amdgcn_rcpf(1.f + __expf(-x)); }

struct EpiF32 {
    static constexpr bool PERM = false, AFTER_DRAIN = false;
    float* C; int ldc;
    __device__ __forceinline__ void operator()(const f32x4 (&acc)[2][2][4][2], const Unit& u, int wr, int wc, int fr, int fq) const {
        const int row0 = u.pm * BM + wr * 64 + fr, col0 = u.pn * BM + wc * 32 + 4 * fq;
#pragma unroll
        for (int ai = 0; ai < 2; ++ai)
#pragma unroll
            for (int m = 0; m < 4; ++m) { float* rowp = C + (size_t)(row0 + ai * HALF + m * 16) * ldc + col0;
#pragma unroll
                for (int bj = 0; bj < 2; ++bj)
#pragma unroll
                    for (int n = 0; n < 2; ++n) *(f32x4*)(rowp + bj * HALF + n * 16) = acc[ai][bj][m][n]; }
    }
};
struct EpiIn {
    static constexpr bool PERM = true, AFTER_DRAIN = false;
    bf16_t* O;
    __device__ __forceinline__ void operator()(const f32x4 (&acc)[2][2][4][2], const Unit& u, int wr, int wc, int fr, int fq) const {
        const int row0 = u.pm * BM + wr * 64 + fr, col0 = u.pn * BM + wc * 32 + 8 * fq, pn = u.pn;
        int act = 0;
        if ((pn >= 8 && pn < 16) || (pn >= 48 && pn < 56) || (pn >= 68 && pn < 76)) act = 1;
        else if ((pn >= 40 && pn < 48) || pn >= 76) act = 2;
        else if (pn >= 24 && pn < 32) act = 3;
#pragma unroll
        for (int ai = 0; ai < 2; ++ai)
#pragma unroll
            for (int m = 0; m < 4; ++m) { bf16_t* rowp = O + (size_t)(row0 + ai * HALF + m * 16) * NP + col0;
#pragma unroll
                for (int bj = 0; bj < 2; ++bj) { f32x4 v0 = acc[ai][bj][m][0], v1 = acc[ai][bj][m][1];
                    if (act == 1) {
#pragma unroll
                        for (int j = 0; j < 4; ++j) { v0[j] = v0[j] * sigmoid_f(v0[j]); v1[j] = v1[j] * sigmoid_f(v1[j]); } }
                    else if (act == 2) {
#pragma unroll
                        for (int j = 0; j < 4; ++j) { v0[j] = sigmoid_f(v0[j]); v1[j] = sigmoid_f(v1[j]); } }
                    else if (act == 3) { v0 = v0 * 0.0625f; v1 = v1 * 0.0625f; }
                    u32x4 w; w.x = cvt_pk_bf16(v0[0], v0[1]); w.y = cvt_pk_bf16(v0[2], v0[3]); w.z = cvt_pk_bf16(v1[0], v1[1]); w.w = cvt_pk_bf16(v1[2], v1[3]);
                    *(u32x4*)(rowp + bj * HALF) = w; } }
    }
};
struct EpiMerge {
    static constexpr bool PERM = true, AFTER_DRAIN = false;
    const bf16_t* P; float* ACC; bf16_t* G2;
    __device__ __forceinline__ void operator()(const f32x4 (&acc)[2][2][4][2], const Unit& u, int wr, int wc, int fr, int fq) const {
        const int row0 = u.pm * BM + wr * 64 + fr, col0 = u.pn * BM + wc * 32 + 8 * fq, z = u.z;
#pragma unroll
        for (int ai = 0; ai < 2; ++ai)
#pragma unroll
            for (int m = 0; m < 4; ++m) { const size_t r = (size_t)(row0 + ai * HALF + m * 16);
#pragma unroll
                for (int bj = 0; bj < 2; ++bj) { const int c = col0 + bj * HALF;
                    const u32x4 g = *(const u32x4*)(P + r * NP + C_MG + z * DM + c);
                    f32x4 v0 = acc[ai][bj][m][0], v1 = acc[ai][bj][m][1];
                    v0[0] *= bflo(g.x); v0[1] *= bfhi(g.x); v0[2] *= bflo(g.y); v0[3] *= bfhi(g.y);
                    v1[0] *= bflo(g.z); v1[1] *= bfhi(g.z); v1[2] *= bflo(g.w); v1[3] *= bfhi(g.w);
                    float* ap = ACC + r * DM + c;
                    if (z > 0) { v0 = v0 + *(const f32x4*)ap; v1 = v1 + *(const f32x4*)(ap + 4); }
                    if (z < 2) { *(f32x4*)ap = v0; *(f32x4*)(ap + 4) = v1; }
                    else { u32x4 w; w.x = cvt_pk_bf16(v0[0], v0[1]); w.y = cvt_pk_bf16(v0[2], v0[3]); w.z = cvt_pk_bf16(v1[0], v1[1]); w.w = cvt_pk_bf16(v1[2], v1[3]);
                        *(u32x4*)(G2 + r * DM + c) = w; } } }
    }
};
template <class Epi, class Sched, bool ALIGN_EPI = false, bool SP2 = false>
__device__ __forceinline__ void gemm_phase(PG8_LAS unsigned char* lds, const Gemm g, const Sched& S, const Epi& E) {
    int tid = threadIdx.x; asm volatile("" : "+v"(tid));
    const int wid = __builtin_amdgcn_readfirstlane(tid >> 6), lane = tid & 63, wr = wid >> 2, wc = wid & 3, fr = lane & 15, fq = lane >> 4;
    const int K = g.K, nt = K / BK;
    unsigned voffA[2], voffB[2];
#pragma unroll
    for (int i = 0; i < 2; ++i) { int R, C; stage_rc(tid * 16 + i * 8192, R, C); const int Rb = Epi::PERM ? ((R & ~31) + perm32(R & 31)) : R;
        voffA[i] = (unsigned)(R * K + C) * 2u; voffB[i] = (unsigned)(Rb * K + C) * 2u; }
    const size_t kstep = (size_t)(BK * 2);
    const size_t hstep = (size_t)HALF * K * 2;
    const size_t tstep = 2 * hstep;
    const unsigned ldsw = (unsigned)wid * 1024u;
    const int aoff = lds_byte(wr * 64 + fr, fq * 8), boff = lds_byte(wc * 32 + fr, fq * 8);
#define PG8_SA(b, h) (((b) * 2 + (h)) * HTB)
#define PG8_SB(b, h) ((4 + (b) * 2 + (h)) * HTB)
#define PG8_STAGE(bufoff, gbase, voff) do { _Pragma("unroll") for (int _i = 0; _i < 2; ++_i) \
        __builtin_amdgcn_global_load_lds((const unsigned*)((const char*)(gbase) + (voff)[_i]), (PG8_LAS unsigned*)(lds + (bufoff) + ldsw + _i * 8192), 16, 0, 0); } while (0)
#define PG8_LDA(dst, b, h) do { _Pragma("unroll") for (int m = 0; m < 4; ++m) _Pragma("unroll") for (int k = 0; k < 2; ++k) dst[m][k] = *(const PG8_LAS bf16x8*)(lds + PG8_SA(b, h) + aoff + m * 2048 + k * 1024); } while (0)
#define PG8_LDB(dst, b, h) do { _Pragma("unroll") for (int n = 0; n < 2; ++n) _Pragma("unroll") for (int k = 0; k < 2; ++k) dst[n][k] = *(const PG8_LAS bf16x8*)(lds + PG8_SB(b, h) + boff + n * 2048 + k * 1024); } while (0)
#define PG8_MMA(ai, bj, At, Bt) do { __builtin_amdgcn_s_setprio(1); _Pragma("unroll") for (int m = 0; m < 4; ++m) _Pragma("unroll") for (int n = 0; n < 2; ++n) _Pragma("unroll") for (int k = 0; k < 2; ++k) \
        acc[ai][bj][m][n] = __builtin_amdgcn_mfma_f32_16x16x32_bf16(Bt[n][k], At[m][k], acc[ai][bj][m][n], 0, 0, 0); __builtin_amdgcn_s_setprio(0); } while (0)
#define PG8_WAIT_V(n) asm volatile("s_waitcnt vmcnt(" #n ")" ::: "memory")
#define PG8_WAIT_L(n) asm volatile("s_waitcnt lgkmcnt(" #n ")" ::: "memory")
#define PG8_BAR __builtin_amdgcn_s_barrier()
#define PG8_SCHED __builtin_amdgcn_sched_barrier(0)
    Unit cur, nxt; int ui = 0;
    if (!S.next(0, cur)) return;
    f32x4 acc[2][2][4][2];
#pragma unroll
    for (int a = 0; a < 2; ++a)
#pragma unroll
        for (int b = 0; b < 2; ++b)
#pragma unroll
            for (int m = 0; m < 4; ++m)
#pragma unroll
                for (int n = 0; n < 2; ++n) acc[a][b][m][n] = (f32x4){0.f, 0.f, 0.f, 0.f};
    bf16x8 At[4][2], B0[2][2], B1[2][2];
    const char* cA = (const char*)g.A + (size_t)cur.z * g.zA + (size_t)cur.pm * tstep; const char* cB = (const char*)g.Bt + (size_t)cur.z * g.zB + (size_t)cur.pn * tstep;
    S.a_ready(cur);
    if constexpr (SP2) {
        PG8_STAGE(PG8_SB(0, 0), cB, voffB); PG8_STAGE(PG8_SB(0, 1), cB + hstep, voffB); PG8_STAGE(PG8_SA(0, 0), cA, voffA); PG8_STAGE(PG8_SA(0, 1), cA + hstep, voffA);
        if (wr == 1) PG8_BAR;
        PG8_WAIT_V(2); PG8_BAR;
        PG8_STAGE(PG8_SB(1, 0), cB + kstep, voffB); PG8_STAGE(PG8_SA(1, 0), cA + kstep, voffA); PG8_STAGE(PG8_SB(1, 1), cB + hstep + kstep, voffB);
        PG8_WAIT_V(6); PG8_BAR;
    } else {
        PG8_STAGE(PG8_SB(0, 0), cB, voffB); PG8_STAGE(PG8_SA(0, 0), cA, voffA); PG8_STAGE(PG8_SB(0, 1), cB + hstep, voffB); PG8_STAGE(PG8_SA(0, 1), cA + hstep, voffA);
        if (wr == 1) PG8_BAR;
        PG8_WAIT_V(4); PG8_BAR;
        PG8_STAGE(PG8_SB(1, 0), cB + kstep, voffB); PG8_STAGE(PG8_SA(1, 0), cA + kstep, voffA); PG8_STAGE(PG8_SB(1, 1), cB + hstep + kstep, voffB);
        PG8_WAIT_V(6); PG8_BAR;
    }
    for (;;) {
        const bool has_next = S.next(ui + 1, nxt);
        const char* nA = has_next ? (const char*)g.A + (size_t)nxt.z * g.zA + (size_t)nxt.pm * tstep : cA; const char* nB = has_next ? (const char*)g.Bt + (size_t)nxt.z * g.zB + (size_t)nxt.pn * tstep : cB;
        for (int t = 0; t < nt; t += 2) {
            const bool last = (t == nt - 2);
            const char* a1 = cA + (size_t)(t + 1) * kstep;
            const char* a2 = last ? nA : cA + (size_t)(t + 2) * kstep; const char* b2 = last ? nB : cB + (size_t)(t + 2) * kstep;
            const char* a3 = a2 + kstep; const char* b3 = b2 + kstep;
            if (last && has_next) S.a_ready(nxt);
            if constexpr (SP2) {
            PG8_LDB(B0, 0, 0); PG8_LDB(B1, 0, 1); PG8_SCHED; PG8_LDA(At, 0, 0); PG8_STAGE(PG8_SA(1, 1), a1 + hstep, voffA);
            PG8_WAIT_V(8); PG8_WAIT_L(0); PG8_BAR; PG8_MMA(0, 0, At, B0); PG8_MMA(0, 1, At, B1); PG8_BAR; PG8_SCHED;
            PG8_LDA(At, 0, 1); PG8_STAGE(PG8_SB(0, 0), b2, voffB); PG8_STAGE(PG8_SB(0, 1), b2 + hstep, voffB); PG8_STAGE(PG8_SA(0, 0), a2, voffA);
            PG8_WAIT_V(8); PG8_WAIT_L(0); PG8_BAR; PG8_MMA(1, 0, At, B0); PG8_MMA(1, 1, At, B1); PG8_BAR; PG8_SCHED;
            PG8_LDB(B0, 1, 0); PG8_LDB(B1, 1, 1); PG8_SCHED; PG8_LDA(At, 1, 0); PG8_STAGE(PG8_SA(0, 1), a2 + hstep, voffA);
            PG8_WAIT_V(8); PG8_WAIT_L(0); PG8_BAR; PG8_MMA(0, 0, At, B0); PG8_MMA(0, 1, At, B1); PG8_BAR; PG8_SCHED;
            PG8_LDA(At, 1, 1); PG8_STAGE(PG8_SB(1, 0), b3, voffB); PG8_STAGE(PG8_SB(1, 1), b3 + hstep, voffB); PG8_STAGE(PG8_SA(1, 0), a3, voffA);
            PG8_WAIT_V(8); PG8_WAIT_L(0); PG8_BAR; PG8_MMA(1, 0, At, B0); PG8_MMA(1, 1, At, B1); PG8_BAR; PG8_SCHED;
            } else {
            PG8_LDB(B0, 0, 0); PG8_SCHED; PG8_LDA(At, 0, 0); PG8_STAGE(PG8_SA(1, 1), a1 + hstep, voffA);
            PG8_WAIT_L(8); PG8_BAR; PG8_WAIT_L(0); PG8_MMA(0, 0, At, B0); PG8_BAR; PG8_SCHED;
            PG8_LDB(B1, 0, 1); PG8_STAGE(PG8_SB(0, 0), b2, voffB);
            PG8_BAR; PG8_WAIT_L(0); PG8_MMA(0, 1, At, B1); PG8_BAR;
            PG8_LDA(At, 0, 1); PG8_STAGE(PG8_SA(0, 0), a2, voffA);
            PG8_BAR; PG8_WAIT_L(0); PG8_MMA(1, 0, At, B0); PG8_BAR; PG8_SCHED;
            PG8_STAGE(PG8_SB(0, 1), b2 + hstep, voffB);
            PG8_WAIT_V(6); PG8_BAR; PG8_MMA(1, 1, At, B1); PG8_BAR;
            PG8_LDB(B0, 1, 0); PG8_SCHED; PG8_LDA(At, 1, 0); PG8_STAGE(PG8_SA(0, 1), a2 + hstep, voffA);
            PG8_WAIT_L(8); PG8_BAR; PG8_WAIT_L(0); PG8_MMA(0, 0, At, B0); PG8_BAR; PG8_SCHED;
            PG8_LDB(B1, 1, 1); PG8_STAGE(PG8_SB(1, 0), b3, voffB);
            PG8_BAR; PG8_WAIT_L(0); PG8_MMA(0, 1, At, B1); PG8_BAR;
            PG8_LDA(At, 1, 1); PG8_STAGE(PG8_SA(1, 0), a3, voffA);
            PG8_BAR; PG8_WAIT_L(0); PG8_MMA(1, 0, At, B0); PG8_BAR; PG8_SCHED;
            PG8_STAGE(PG8_SB(1, 1), b3 + hstep, voffB);
            PG8_WAIT_V(6); PG8_BAR; PG8_MMA(1, 1, At, B1); PG8_BAR;
            }
        }
        if constexpr (ALIGN_EPI) { if (wr == 0) PG8_BAR; }
        if constexpr (!Epi::AFTER_DRAIN) { E(acc, cur, wr, wc, fr, fq); S.done(cur); }
        if (!has_next) break;
#pragma unroll
        for (int a = 0; a < 2; ++a)
#pragma unroll
            for (int b = 0; b < 2; ++b)
#pragma unroll
                for (int m = 0; m < 4; ++m)
#pragma unroll
                    for (int n = 0; n < 2; ++n) acc[a][b][m][n] = (f32x4){0.f, 0.f, 0.f, 0.f};
        cur = nxt; cA = nA; cB = nB; ++ui;
        if constexpr (ALIGN_EPI) { if (wr == 1) PG8_BAR; }
    }
    PG8_WAIT_V(0);
    if constexpr (!ALIGN_EPI) { if (wr == 0) PG8_BAR; }
    PG8_BAR;
    if constexpr (Epi::AFTER_DRAIN) { E.fused(acc, cur, wr, wc, fr, fq, lds, wid, lane); S.done(cur); }
#undef PG8_SA
#undef PG8_SB
#undef PG8_STAGE
#undef PG8_LDA
#undef PG8_LDB
#undef PG8_MMA
#undef PG8_WAIT_V
#undef PG8_WAIT_L
#undef PG8_BAR
#undef PG8_SCHED
}
}

namespace att {
using bf16 = __hip_bfloat16;
constexpr int   D = 128, NW = 8, QBLK = 32, KVBLK = 64;
constexpr float SCALE = 0.088388347648318440f;
constexpr float THR = 8.f;
#ifndef ATT_SDEPTH
#define ATT_SDEPTH 1
#endif
constexpr int SDEPTH = ATT_SDEPTH;
constexpr int LDQ = NP, LDK = NP, LDO = DM;
constexpr size_t SHM_V = KVBLK * D * 2, SHM_K = KVBLK * D * 2, SHM_ATTN = 2 * SHM_V + 2 * SHM_K + NW * 64 * 4;
constexpr int OST_OFF = 69632, OST_END = OST_OFF + NW * 32 * 272;
using bf16x8 = __attribute__((ext_vector_type(8))) short;
using s16x4  = __attribute__((ext_vector_type(4))) short;
using f32x16 = __attribute__((ext_vector_type(16))) float;
using f32x4  = __attribute__((ext_vector_type(4))) float;
using u32x4  = __attribute__((ext_vector_type(4))) unsigned;
#define KSWZ(row, colB) ((row) * 256 + ((colB) ^ (((row) & 7) << 4)))
#define SBAR() __builtin_amdgcn_sched_barrier(0)
__device__ __forceinline__ int crow(int r, int hi) { return (r & 3) + 8 * (r >> 2) + 4 * hi; }
__device__ __forceinline__ unsigned cvtpk(float lo, float hi) { unsigned r; asm volatile("v_cvt_pk_bf16_f32 %0, %1, %2" : "=v"(r) : "v"(lo), "v"(hi)); return r; }
__device__ __forceinline__ bf16x8 ld8(const bf16* p) { return *reinterpret_cast<const bf16x8*>(p); }

__device__ __forceinline__ void partialSM(f32x16& p0, f32x16& p1, float& m_reg, float& mn, float& alpha) {
  constexpr float C = SCALE * 1.4426950408889634f;
  float pmax = p0[0];
#pragma unroll
  for (int r = 1; r < 16; ++r) pmax = fmaxf(pmax, p0[r]);
#pragma unroll
  for (int r = 0; r < 16; ++r) pmax = fmaxf(pmax, p1[r]);
  { auto rr = __builtin_amdgcn_permlane32_swap(__float_as_uint(pmax), __float_as_uint(pmax), false, false);
    pmax = fmaxf(__uint_as_float(rr[0]), __uint_as_float(rr[1])); }
  if (__builtin_expect(__all(pmax - m_reg <= THR / SCALE), 1)) { mn = m_reg; alpha = 1.f; }
  else { mn = fmaxf(m_reg, pmax); alpha = __builtin_amdgcn_exp2f((m_reg - mn) * C); m_reg = mn; }
  float mnC = -mn * C;
#pragma unroll
  for (int r = 0; r < 16; ++r) p0[r] = fmaf(p0[r], C, mnC);
#pragma unroll
  for (int r = 0; r < 16; ++r) p1[r] = fmaf(p1[r], C, mnC);
#pragma unroll
  for (int r = 0; r < 16; ++r) p0[r] = __builtin_amdgcn_exp2f(p0[r]);
}
__device__ __forceinline__ void finishSM(f32x16& p0, f32x16& p1, float alpha, float& l_reg, bf16x8& pa0, bf16x8& pa1, bf16x8& pa2, bf16x8& pa3) {
#pragma unroll
  for (int r = 0; r < 16; ++r) p1[r] = __builtin_amdgcn_exp2f(p1[r]);
  float ps = 0;
#pragma unroll
  for (int r = 0; r < 16; ++r) ps += p0[r];
#pragma unroll
  for (int r = 0; r < 16; ++r) ps += p1[r];
  { auto rr = __builtin_amdgcn_permlane32_swap(__float_as_uint(ps), __float_as_uint(ps), false, false);
    ps = __uint_as_float(rr[0]) + __uint_as_float(rr[1]); }
  l_reg = l_reg * alpha + ps;
#define PK4(P, BASE, OUT) do { unsigned a0 = cvtpk(P[BASE + 0], P[BASE + 1]), a1 = cvtpk(P[BASE + 2], P[BASE + 3]);   \
    unsigned b0 = cvtpk(P[BASE + 4], P[BASE + 5]), b1 = cvtpk(P[BASE + 6], P[BASE + 7]);                              \
    auto r0 = __builtin_amdgcn_permlane32_swap(a0, b0, false, false); auto r1 = __builtin_amdgcn_permlane32_swap(a1, b1, false, false); \
    u32x4 w = {r0[0], r1[0], r0[1], r1[1]}; OUT = *reinterpret_cast<bf16x8*>(&w); } while (0)
  PK4(p0, 0, pa0); PK4(p0, 8, pa1); PK4(p1, 0, pa2); PK4(p1, 8, pa3);
#undef PK4
}
__device__ __forceinline__ void qkt(f32x16& p0, f32x16& p1, const bf16* Ks, const bf16x8* qr, int r32, int hi) {
  p0 = f32x16{}; p1 = f32x16{};
#pragma unroll
  for (int d0 = 0; d0 < 8; ++d0) { int cb = (d0 * 16 + hi * 8) * 2;
    bf16x8 b0 = *reinterpret_cast<const bf16x8*>((const char*)Ks + KSWZ(r32, cb));
    bf16x8 b1 = *reinterpret_cast<const bf16x8*>((const char*)Ks + KSWZ(32 + r32, cb));
    p0 = __builtin_amdgcn_mfma_f32_32x32x16_bf16(b0, qr[d0], p0, 0, 0, 0);
    p1 = __builtin_amdgcn_mfma_f32_32x32x16_bf16(b1, qr[d0], p1, 0, 0, 0); }
}
__device__ __forceinline__ int v_st(int k, int c) { const int kk = (k & ~0xC) | ((k & 4) << 1) | ((k & 8) >> 1); return ((kk >> 3) * 4 + (c >> 5)) * 512 + ((kk & 7) * 32 + (c & 31)) * 2; }
__device__ __forceinline__ int v_rd_base(int lane) { return ((lane & 3) << 3) | (((lane >> 2) & 3) << 6) | (((lane >> 4) & 1) << 5) | (((lane >> 5) & 1) << 8); }
constexpr int v_rd_off(int d0, int ks, int half) { return d0 * 512 + ks * 4096 + half * 2048; }
template <int OFF> __device__ __forceinline__ s16x4 tr_read(int vb) {
  s16x4 r; asm volatile("ds_read_b64_tr_b16 %0, %1 offset:%2" : "=&v"(r) : "v"(vb), "i"(OFF) : "memory"); return r;
}
template <int D0> __device__ __forceinline__ void pv_one(f32x16& od, int vb, bf16x8 pa0, bf16x8 pa1, bf16x8 pa2, bf16x8 pa3) {
  const s16x4 l0 = tr_read<v_rd_off(D0, 0, 0)>(vb), h0 = tr_read<v_rd_off(D0, 0, 1)>(vb), l1 = tr_read<v_rd_off(D0, 1, 0)>(vb), h1 = tr_read<v_rd_off(D0, 1, 1)>(vb);
  const s16x4 l2 = tr_read<v_rd_off(D0, 2, 0)>(vb), h2 = tr_read<v_rd_off(D0, 2, 1)>(vb), l3 = tr_read<v_rd_off(D0, 3, 0)>(vb), h3 = tr_read<v_rd_off(D0, 3, 1)>(vb);
  asm volatile("s_waitcnt lgkmcnt(0)" ::: "memory"); SBAR();
#define PK(L, H) (bf16x8){L[0], L[1], L[2], L[3], H[0], H[1], H[2], H[3]}
  od = __builtin_amdgcn_mfma_f32_32x32x16_bf16(pa0, PK(l0, h0), od, 0, 0, 0);
  od = __builtin_amdgcn_mfma_f32_32x32x16_bf16(pa1, PK(l1, h1), od, 0, 0, 0);
  od = __builtin_amdgcn_mfma_f32_32x32x16_bf16(pa2, PK(l2, h2), od, 0, 0, 0);
  od = __builtin_amdgcn_mfma_f32_32x32x16_bf16(pa3, PK(l3, h3), od, 0, 0, 0);
#undef PK
}
__device__ __forceinline__ void pv_d0(f32x16* o, int vb, bf16x8 pa0, bf16x8 pa1, bf16x8 pa2, bf16x8 pa3) {
  pv_one<0>(o[0], vb, pa0, pa1, pa2, pa3); pv_one<1>(o[1], vb, pa0, pa1, pa2, pa3); pv_one<2>(o[2], vb, pa0, pa1, pa2, pa3); pv_one<3>(o[3], vb, pa0, pa1, pa2, pa3);
}

__device__ __forceinline__ void attn_unit(const bf16* __restrict__ Qb, const bf16* __restrict__ Kh, const bf16* __restrict__ Vh, const bf16* __restrict__ Zb,
                                          bf16* __restrict__ Ob, int seq, char* lds, const float* __restrict__ qn, const float* __restrict__ cs, const float* __restrict__ sn) {
  int tid = threadIdx.x; asm volatile("" : "+v"(tid));
  int wid = tid >> 6, lane = tid & 63, r32 = lane & 31, hi = lane >> 5;
  bf16* V_lds = (bf16*)lds; bf16* K_lds = (bf16*)(lds + 2 * SHM_V);
  float* ws = (float*)(lds + 2 * SHM_V + 2 * SHM_K) + wid * 64; float* li_l = ws; float* al_l = ws + 32;
  float m_reg = -1e30f, l_reg = 0; f32x16 o[4] = {}; bf16x8 qr[8];
  {
    const bf16* Qw = Qb + (long)(wid * QBLK + r32) * LDQ + hi * 8;
    float ss = 0.f;
#pragma unroll
    for (int d0 = 0; d0 < 8; ++d0) { const u32x4 w = *reinterpret_cast<const u32x4*>(Qw + d0 * 16); qr[d0] = __builtin_bit_cast(bf16x8, w);
#pragma unroll
      for (int e = 0; e < 4; ++e) { const float lo = __uint_as_float(w[e] << 16), hh = __uint_as_float(w[e] & 0xffff0000u); ss += lo * lo + hh * hh; } }
    ss += __shfl_xor(ss, 32);
    const float rs = rsqrtf(ss * (1.f / 128.f) + EPS);
    const float* cp = cs ? cs + (long)(wid * QBLK + r32) * 64 + hi * 8 : nullptr; const float* sp = cs ? sn + (long)(wid * QBLK + r32) * 64 + hi * 8 : nullptr;
#pragma unroll
    for (int d0 = 0; d0 < 4; ++d0) {
      const u32x4 wa = __builtin_bit_cast(u32x4, qr[d0]), wb = __builtin_bit_cast(u32x4, qr[d0 + 4]); float x1[8], x2[8];
#pragma unroll
      for (int e = 0; e < 4; ++e) { x1[2 * e] = __uint_as_float(wa[e] << 16); x1[2 * e + 1] = __uint_as_float(wa[e] & 0xffff0000u); x2[2 * e] = __uint_as_float(wb[e] << 16); x2[2 * e + 1] = __uint_as_float(wb[e] & 0xffff0000u); }
      const f32x4 ga0 = *reinterpret_cast<const f32x4*>(qn + d0 * 16 + hi * 8), ga1 = *reinterpret_cast<const f32x4*>(qn + d0 * 16 + hi * 8 + 4);
      const f32x4 gb0 = *reinterpret_cast<const f32x4*>(qn + 64 + d0 * 16 + hi * 8), gb1 = *reinterpret_cast<const f32x4*>(qn + 64 + d0 * 16 + hi * 8 + 4);
#pragma unroll
      for (int e = 0; e < 8; ++e) { x1[e] *= rs * (e < 4 ? ga0[e & 3] : ga1[e & 3]); x2[e] *= rs * (e < 4 ? gb0[e & 3] : gb1[e & 3]); }
      if (cs) {
        const f32x4 c0 = *reinterpret_cast<const f32x4*>(cp + d0 * 16), c1 = *reinterpret_cast<const f32x4*>(cp + d0 * 16 + 4);
        const f32x4 s0 = *reinterpret_cast<const f32x4*>(sp + d0 * 16), s1 = *reinterpret_cast<const f32x4*>(sp + d0 * 16 + 4);
#pragma unroll
        for (int e = 0; e < 8; ++e) { const float c = e < 4 ? c0[e & 3] : c1[e & 3], sv = e < 4 ? s0[e & 3] : s1[e & 3];
          const float a = x1[e], bq = x2[e]; x1[e] = a * c - bq * sv; x2[e] = bq * c + a * sv; }
      }
      const u32x4 oa = {cvtpk(x1[0], x1[1]), cvtpk(x1[2], x1[3]), cvtpk(x1[4], x1[5]), cvtpk(x1[6], x1[7])}, ob = {cvtpk(x2[0], x2[1]), cvtpk(x2[2], x2[3]), cvtpk(x2[4], x2[5]), cvtpk(x2[6], x2[7])};
      qr[d0] = __builtin_bit_cast(bf16x8, oa); qr[d0 + 4] = __builtin_bit_cast(bf16x8, ob);
      asm volatile("" ::: "memory");
    }
  }
  const int sr = tid >> 4, sc = (tid & 15) * 8, vst0 = v_st(sr, sc), vst1 = v_st(32 + sr, sc);
  const int vb0 = (int)(uintptr_t)V_lds + v_rd_base(lane);
  struct { bf16x8 vs0, vs1, ks0, ks1; } sr_[SDEPTH];
#define SLOAD(i, k0) do { sr_[i].vs0 = ld8(&Vh[(long)((k0) + sr) * LDK + sc]); sr_[i].vs1 = ld8(&Vh[(long)((k0) + 32 + sr) * LDK + sc]); \
    sr_[i].ks0 = ld8(&Kh[(long)((k0) + sr) * LDK + sc]); sr_[i].ks1 = ld8(&Kh[(long)((k0) + 32 + sr) * LDK + sc]); } while (0)
#define SWRITE(b, i) do { *(bf16x8*)((char*)V_lds + (b) * SHM_V + vst0) = sr_[i].vs0;          \
    *(bf16x8*)((char*)V_lds + (b) * SHM_V + vst1) = sr_[i].vs1; int kc = sc * 2;               \
    *(bf16x8*)((char*)K_lds + (b) * SHM_K + KSWZ(sr, kc)) = sr_[i].ks0;                       \
    *(bf16x8*)((char*)K_lds + (b) * SHM_K + KSWZ(32 + sr, kc)) = sr_[i].ks1; } while (0)
#define SWAIT() do { if constexpr (SDEPTH == 2) asm volatile("s_waitcnt vmcnt(4)" ::: "memory"); else asm volatile("s_waitcnt vmcnt(0)" ::: "memory"); } while (0)
#define RESC(a) do { if (__any((a) < 1.f)) { if (hi == 0) al_l[r32] = (a); asm volatile("s_waitcnt lgkmcnt(0)" ::: "memory"); \
    _Pragma("unroll") for (int d = 0; d < 4; ++d) _Pragma("unroll") for (int r = 0; r < 16; ++r) o[d][r] *= al_l[crow(r, hi)]; } } while (0)
  f32x16 pA0, pA1, pB0, pB1; float mnA, mnB, alA, alB; bf16x8 pa0, pa1, pa2, pa3; const int NT = seq / KVBLK;
  constexpr int SE = 0, SO = SDEPTH - 1;
  SLOAD(SE, 0); asm volatile("s_waitcnt vmcnt(0)" ::: "memory"); SWRITE(0, SE); __syncthreads();
  qkt(pA0, pA1, K_lds, qr, r32, hi); partialSM(pA0, pA1, m_reg, mnA, alA);
  SLOAD(SO, KVBLK); if constexpr (SDEPTH == 2) { if (2 < NT) SLOAD(SE, 2 * KVBLK); }
  SWAIT(); SWRITE(1, SO); __syncthreads();
  for (int j = 1; j + 1 < NT; j += 2) {
    SBAR(); qkt(pB0, pB1, (bf16*)((char*)K_lds + SHM_K), qr, r32, hi);
    finishSM(pA0, pA1, alA, l_reg, pa0, pa1, pa2, pa3); SBAR();
    SLOAD(SO, (j + SDEPTH) * KVBLK); SBAR();
    pv_d0(o, vb0, pa0, pa1, pa2, pa3); partialSM(pB0, pB1, m_reg, mnB, alB);
    __syncthreads(); SWAIT(); SWRITE(0, SE);
    RESC(alB); __syncthreads();
    SBAR(); qkt(pA0, pA1, K_lds, qr, r32, hi);
    finishSM(pB0, pB1, alB, l_reg, pa0, pa1, pa2, pa3); SBAR();
    if (SDEPTH == 1 || j + 3 < NT) SLOAD(SE, (j + 1 + SDEPTH) * KVBLK); SBAR();
    pv_d0(o, vb0 + (int)SHM_V, pa0, pa1, pa2, pa3); partialSM(pA0, pA1, m_reg, mnA, alA);
    __syncthreads(); SWAIT(); SWRITE(1, SO);
    RESC(alA); __syncthreads();
  }
  SBAR(); qkt(pB0, pB1, (bf16*)((char*)K_lds + SHM_K), qr, r32, hi);
  finishSM(pA0, pA1, alA, l_reg, pa0, pa1, pa2, pa3); SBAR();
  pv_d0(o, vb0, pa0, pa1, pa2, pa3); partialSM(pB0, pB1, m_reg, mnB, alB);
  __syncthreads(); RESC(alB);
  finishSM(pB0, pB1, alB, l_reg, pa0, pa1, pa2, pa3); SBAR();
  pv_d0(o, vb0 + (int)SHM_V, pa0, pa1, pa2, pa3);
  if (hi == 0) li_l[r32] = l_reg; asm volatile("s_waitcnt lgkmcnt(0)" ::: "memory");
  { int tz = threadIdx.x; asm volatile("" : "+v"(tz)); wid = tz >> 6; lane = tz & 63; r32 = lane & 31; hi = lane >> 5; }
  float rli[16];
#pragma unroll
  for (int r = 0; r < 16; ++r) rli[r] = __builtin_amdgcn_rcpf(li_l[crow(r, hi)]);
  char* ost = lds + OST_OFF + wid * (32 * 272);
#pragma unroll
  for (int r = 0; r < 16; ++r) { const int orow = crow(r, hi);
#pragma unroll
    for (int d0 = 0; d0 < 4; ++d0) *(bf16*)(ost + orow * 272 + (d0 * 32 + r32) * 2) = __float2bfloat16(o[d0][r] * rli[r]); }
  asm volatile("s_waitcnt lgkmcnt(0)" ::: "memory");
  bf16* Ow = Ob + (long)(wid * QBLK) * LDO; const bf16* Zw = Zb + (long)(wid * QBLK) * LDQ;
#pragma unroll
  for (int hb = 0; hb < 2; ++hb) {
    u32x4 ov[4], zv[4];
#pragma unroll
    for (int i = 0; i < 4; ++i) { const int c = (hb * 4 + i) * 64 + lane, row = c >> 4, col = (c & 15) * 8;
      ov[i] = *reinterpret_cast<const u32x4*>(ost + row * 272 + col * 2); zv[i] = *reinterpret_cast<const u32x4*>(Zw + (long)row * LDQ + col); }
#pragma unroll
    for (int i = 0; i < 4; ++i) { const int c = (hb * 4 + i) * 64 + lane, row = c >> 4, col = (c & 15) * 8; u32x4 w;
#pragma unroll
      for (int e = 0; e < 4; ++e) { const unsigned a = ov[i][e], z = zv[i][e];
        w[e] = cvtpk(__uint_as_float(a << 16) * __uint_as_float(z << 16), __uint_as_float(a & 0xffff0000u) * __uint_as_float(z & 0xffff0000u)); }
      *reinterpret_cast<u32x4*>(Ow + (long)row * LDO + col) = w; }
  }
  __syncthreads();
#undef SLOAD
#undef SWRITE
#undef SWAIT
#undef RESC
}
}

constexpr int NWAVES = 8;
#ifndef MK_N_LAUNCHES
#define MK_N_LAUNCHES 1
#endif
constexpr int PH_PER_LAYER = 7, N_PHASES = 2 + DEPTH * PH_PER_LAYER;
constexpr size_t MiB = 1u << 20;
constexpr size_t WS_CTL = 0, CTL_ZERO_BYTES = 1 * MiB;
constexpr size_t WS_MOD = 1 * MiB;
constexpr size_t WS_ROPE = WS_MOD + MiB / 2;
constexpr size_t WS_WG = 3 * MiB;
constexpr size_t WS_WLRU = 4 * MiB;
constexpr size_t WS_WOUT = 12 * MiB;
constexpr size_t WS_WBR = 44 * MiB;
constexpr size_t WS_WIN = 140 * MiB;
constexpr size_t WS_X = 540 * MiB;
constexpr size_t WS_Y = 612 * MiB;
constexpr size_t WS_H = 684 * MiB;
constexpr size_t WS_G2 = 720 * MiB;
constexpr size_t WS_YB = 756 * MiB;
constexpr size_t WS_ACC = 864 * MiB;
constexpr size_t WS_GT = 936 * MiB;
constexpr size_t WS_MH = 938 * MiB;
constexpr size_t WS_P = 1082 * MiB;
constexpr size_t WS_LA = 1532 * MiB;
constexpr size_t WS_LB = 1676 * MiB;
constexpr size_t WS_HL = 1820 * MiB;
constexpr size_t WS_END = 1964 * MiB;
constexpr int CW_BAR = 4096;
constexpr int RING_BYTES = 131072, LDS_BYTES = 147456, MISC_OFF = LDS_BYTES - 256;
static_assert(att::OST_END <= MISC_OFF, "LDS map");

#define GAS __attribute__((address_space(1)))
#define LAS __attribute__((address_space(3)))
typedef unsigned short bf16_t;
typedef unsigned v4u __attribute__((ext_vector_type(4)));
typedef unsigned v2u __attribute__((ext_vector_type(2)));
typedef float f32x4 __attribute__((ext_vector_type(4)));
#define LDS_WAIT() asm volatile("s_waitcnt lgkmcnt(0)" ::: "memory")
__device__ __forceinline__ unsigned f2bf(float f) { unsigned u = __builtin_bit_cast(unsigned, f); return (u + 0x7fffu + ((u >> 16) & 1u)) >> 16; }
__device__ __forceinline__ unsigned pk2(float lo, float hi) { return f2bf(lo) | (f2bf(hi) << 16); }
__device__ __forceinline__ float bf2f(bf16_t b) { return __uint_as_float((unsigned)b << 16); }
__device__ __forceinline__ float blo(unsigned w) { return __uint_as_float(w << 16); }
__device__ __forceinline__ float bhi(unsigned w) { return __uint_as_float(w & 0xffff0000u); }
__device__ __forceinline__ float wave_sum(float v) {
#pragma unroll
    for (int o = 1; o < 64; o <<= 1) v += __shfl_xor(v, o);
    return v;
}
#define XB_TMO      128
#define XB_XCNT(j)  (256  + 64 * (j))
#define XB_XSUB(j)  (1280 + 64 * (j))
#define XB_XGEN(j)  (2304 + 64 * (j))
#define XB_TOP      3328
#define XB_TOPGEN   3392
#define XCD_BAR_WORDS 3456
#define XB_SPIN_CAP (1u << 18)

__device__ __forceinline__ unsigned xb_ld(unsigned* p)              { return __hip_atomic_load(p, __ATOMIC_RELAXED, __HIP_MEMORY_SCOPE_AGENT); }
__device__ __forceinline__ unsigned xb_add(unsigned* p, unsigned v) { return __hip_atomic_fetch_add(p, v, __ATOMIC_RELAXED, __HIP_MEMORY_SCOPE_AGENT); }
__device__ __forceinline__ unsigned xb_xcc_id() { return (unsigned)__builtin_amdgcn_s_getreg((3 << 11) | 20) & 0xFu; }
#define XB_SPIN(cond, bar) do { unsigned _sp = 0; while (cond) { __builtin_amdgcn_s_sleep(1); \
    if ((++_sp & 255u) == 0u) { if (xb_ld(&(bar)[XB_TMO])) break; if (_sp > XB_SPIN_CAP) { atomicAdd(&(bar)[XB_TMO], 1u); break; } } } } while (0)

struct XcdBarrier {
    unsigned* bar; unsigned x;
    volatile LAS unsigned* st;
};

__device__ __forceinline__ XcdBarrier xcd_barrier_post(unsigned* bar, volatile LAS unsigned* st) {
    XcdBarrier b; b.bar = bar; b.x = xb_xcc_id(); b.st = st;
    if (threadIdx.x == 0) (void)xb_add(&bar[XB_XCNT(b.x)], 1u);
    return b;
}
__device__ __forceinline__ void xcd_barrier_complete(unsigned* bar, unsigned x, unsigned& nloc, unsigned& nx) {
    const unsigned G = gridDim.x * gridDim.y * gridDim.z;
    unsigned sum, cnt, mine, sp = 0u;
    for (;;) {
        sum = 0u; cnt = 0u; mine = 0u;
#pragma unroll
        for (unsigned j = 0; j < 16; ++j) { const unsigned c = xb_ld(&bar[XB_XCNT(j)]); sum += c; cnt += (c > 0u) ? 1u : 0u; mine = (j == x) ? c : mine; }
        if (sum == G) break;
        __builtin_amdgcn_s_sleep(1);
        if ((++sp & 255u) == 0u) { if (xb_ld(&bar[XB_TMO])) break; if (sp > XB_SPIN_CAP) { atomicAdd(&bar[XB_TMO], 1u); break; } }
    }
    nloc = mine > 0u ? mine : 1u; nx = cnt > 0u ? cnt : 1u;
}

__device__ __forceinline__ void xcd_barrier(const XcdBarrier& b) {
    asm volatile("s_waitcnt vmcnt(0)" ::: "memory");
    __syncthreads();
    if (threadIdx.x == 0) {
        unsigned* bar = b.bar;
        __builtin_amdgcn_s_waitcnt(0);
        unsigned nloc = b.st[0], nx = b.st[1];
        if (nloc == 0u) { xcd_barrier_complete(bar, b.x, nloc, nx); b.st[0] = nloc; b.st[1] = nx; }
        const unsigned old = xb_add(&bar[XB_XSUB(b.x)], 1u);
        const unsigned gen = old / nloc;
        if (old + 1u == (gen + 1u) * nloc) {
            __builtin_amdgcn_fence(__ATOMIC_RELEASE, "agent");
            asm volatile("s_waitcnt vmcnt(0)" ::: "memory");
            const unsigned og = xb_add(&bar[XB_TOP], 1u);
            const unsigned tg = og / nx;
            if (og + 1u == (tg + 1u) * nx) xb_add(&bar[XB_TOPGEN], 1u);
            else XB_SPIN(xb_ld(&bar[XB_TOPGEN]) == tg, bar);
            __builtin_amdgcn_fence(__ATOMIC_ACQUIRE, "agent");
            xb_add(&bar[XB_XGEN(b.x)], 1u);
            asm volatile("s_waitcnt vmcnt(0)" ::: "memory");
        } else {
            XB_SPIN(xb_ld(&bar[XB_XGEN(b.x)]) == gen, bar);
            __builtin_amdgcn_fence(__ATOMIC_ACQUIRE, "agent");
            asm volatile("s_waitcnt vmcnt(0)" ::: "memory");
        }
    }
    __syncthreads();
}

struct Args { const float* in[22]; float* out; unsigned char* ws; int ph_lo, ph_hi; };
typedef const __attribute__((address_space(4))) Args CArgs;
#define KIN(k) ((const float*)ka->in[k])
#define WSF(off) ((float*)(ka->ws + (off)))
#define WSB(off) ((bf16_t*)(ka->ws + (off)))
#define KA() ({ CArgs* _k = ka0; asm volatile("" : "+s"(_k)); _k; })
__device__ __forceinline__ int tid_fresh() { int t = threadIdx.x; asm volatile("" : "+v"(t)); return t; }
struct Frame {
    LAS unsigned char* lds; char* ldsg;
    int tid, lane, wave, G, wg;
};

__device__ __forceinline__ void transpose_item(const float* W, int ldw, int col0, int k0, bf16_t* WT, int ldt, int drow0, LAS float* scr, int lane) {
#pragma unroll 8
    for (int i = 0; i < 32; ++i) { const int kk = 2 * i + (lane >> 5); scr[kk * 33 + (lane & 31)] = W[(size_t)(k0 + kk) * ldw + col0 + (lane & 31)]; }
    LDS_WAIT(); asm volatile("" ::: "memory");
    const int c = lane & 7;
#pragma unroll
    for (int j = 0; j < 4; ++j) { const int n = (lane >> 3) + 8 * j; const LAS float* s = scr + (8 * c) * 33 + n;
        v4u o; o.x = pk2(s[0 * 33], s[1 * 33]); o.y = pk2(s[2 * 33], s[3 * 33]); o.z = pk2(s[4 * 33], s[5 * 33]); o.w = pk2(s[6 * 33], s[7 * 33]);
        *(v4u*)(WT + (size_t)(drow0 + n) * ldt + k0 + 8 * c) = o; }
    LDS_WAIT(); asm volatile("" ::: "memory");
}
__device__ __forceinline__ void p_prologue(Frame& F, CArgs* ka) {
    const int tid = tid_fresh(), lane = tid & 63, wave = __builtin_amdgcn_readfirstlane(tid >> 6); (void)lane; (void)wave;
    LAS float* scr = (LAS float*)(F.lds + wave * 8704);
    const int gw = F.wg * NWAVES + wave, NGW = F.G * NWAVES;
    constexpr int I_IN = 32 * 800, I_G = 32, I_BR = 3 * 2048, I_OUT = 2048, I_LRU = 2 * 2 * 16 * 8, I_LAYER = I_IN + I_G + I_BR + I_OUT + I_LRU;
    for (int it = gw; it < DEPTH * I_LAYER; it += NGW) {
        const int l = it / I_LAYER; int r = it - l * I_LAYER;
        if (r < I_IN) { const int kb = r / 800, nb = r - kb * 800, n0 = nb * 32, sc = n0 < 14336 ? n0 : n0 + 32;
            transpose_item(KIN(8) + (size_t)l * DM * NIN, NIN, sc, kb * 64, WSB(WS_WIN) + (size_t)l * NP * DM, DM, n0, scr, lane); continue; }
        r -= I_IN;
        if (r < I_G) { transpose_item(KIN(8) + (size_t)l * DM * NIN, NIN, 14336, r * 64, WSB(WS_WG) + (size_t)l * 32 * DM, DM, 0, scr, lane); continue; }
        r -= I_G;
        if (r < I_BR) { const int z = r / 2048, q = r - z * 2048, kb = q / 64, nb = q - kb * 64;
            transpose_item(KIN(20) + ((size_t)l * 3 + z) * DM * DM, DM, nb * 32, kb * 64, WSB(WS_WBR) + ((size_t)l * 3 + z) * DM * DM, DM, nb * 32, scr, lane); continue; }
        r -= I_BR;
        if (r < I_OUT) { const int kb = r / 64, nb = r - kb * 64;
            transpose_item(KIN(21) + (size_t)l * DM * DM, DM, nb * 32, kb * 64, WSB(WS_WOUT) + (size_t)l * DM * DM, DM, nb * 32, scr, lane); continue; }
        r -= I_OUT;
        { const int q = r & 7, mt = r >> 3, blk = mt & 15, gate = (mt >> 4) & 1, dr = mt >> 5, kb = q >> 2, nb = q & 3;
          const float* src = (gate ? KIN(13) : KIN(11)) + (((size_t)l * 2 + dr) * 16 + blk) * 16384;
          transpose_item(src, 128, nb * 32, kb * 64, WSB(WS_WLRU) + ((((size_t)l * 2 + dr) * 2 + gate) * 16 + blk) * 16384, 128, nb * 32, scr, lane); }
    }
    for (int i = F.wg * 512 + tid; i < SEQ * 64; i += F.G * 512) { const int t = i >> 6, j = i & 63;
        const float inv = 1.0f / powf(10000.0f, (float)(j & 31) * (1.0f / 32.0f)); const float pos = (float)(j < 32 ? (t >> 6) : (t & 63)); const float ang = pos * inv;
        WSF(WS_ROPE)[i] = cosf(ang); WSF(WS_ROPE)[SEQ * 64 + i] = sinf(ang); }
    __syncthreads();
    LAS float* sc = (LAS float*)(F.lds + 73728);
    LAS float* red = (LAS float*)(F.lds + 73728 + 5 * 2048 * 4);
    for (int i = tid; i < 5 * DM; i += 512) { const int bi = i >> 11, k = i & 2047; const float v = bi < 4 ? KIN(1)[bi * DM + k] : KIN(3)[k]; sc[i] = v / (1.f + expf(-v)); }
    __syncthreads();
    for (int it = F.wg; it < DEPTH * 192; it += F.G) { const int l = it / 192, j0 = (it - l * 192) * 32, cj = tid & 31, ks = tid >> 5;
        float a0 = 0.f, a1 = 0.f, a2 = 0.f, a3 = 0.f, a4 = 0.f; const float* w = KIN(4) + (size_t)l * DM * 3 * DM + j0 + cj;
        for (int k = ks * 128; k < ks * 128 + 128; ++k) { const float wv = w[(size_t)k * (3 * DM)]; a0 += sc[k] * wv; a1 += sc[2048 + k] * wv; a2 += sc[4096 + k] * wv; a3 += sc[6144 + k] * wv; a4 += sc[8192 + k] * wv; }
        red[(ks * 5 + 0) * 32 + cj] = a0; red[(ks * 5 + 1) * 32 + cj] = a1; red[(ks * 5 + 2) * 32 + cj] = a2; red[(ks * 5 + 3) * 32 + cj] = a3; red[(ks * 5 + 4) * 32 + cj] = a4;
        __syncthreads();
        if (tid < 160) { const int bi = tid >> 5, c = tid & 31; float s = KIN(5)[(size_t)l * 3 * DM + j0 + c];
            for (int q = 0; q < 16; ++q) s += red[(q * 5 + bi) * 32 + c];
            WSF(WS_MOD)[((size_t)l * 5 + bi) * (3 * DM) + j0 + c] = s; }
        __syncthreads();
    }
}

__device__ __forceinline__ void p_norm(Frame& F, CArgs* ka, int l) {
    const int tid = tid_fresh(), lane = tid & 63, wave = __builtin_amdgcn_readfirstlane(tid >> 6); (void)lane; (void)wave;
    const int gw = F.wg * NWAVES + wave, NGW = F.G * NWAVES;
    for (int r = gw; r < MROWS; r += NGW) {
        const int b = r / TPB, t = r - b * TPB; const bool isctx = t >= SEQ; const int bi = isctx ? 4 : b;
        if (l == DEPTH && isctx) continue;
        f32x4 v[8];
        if (l == 0) { const float* src = isctx ? KIN(2) + ((size_t)b * CTXL + (t - SEQ)) * DM : KIN(0) + ((size_t)b * SEQ + t) * DM;
#pragma unroll
            for (int j = 0; j < 8; ++j) v[j] = *(const f32x4*)(src + j * 256 + lane * 4);
        } else {
            const float* yr = WSF(WS_Y) + (size_t)r * DM; const float* xr = WSF(WS_X) + (size_t)r * DM; f32x4 y[8]; float ss = 0.f;
#pragma unroll
            for (int j = 0; j < 8; ++j) { y[j] = *(const f32x4*)(yr + j * 256 + lane * 4); ss += y[j].x * y[j].x + y[j].y * y[j].y + y[j].z * y[j].z + y[j].w * y[j].w; }
            const float rs = rsqrtf(wave_sum(ss) * (1.f / DM) + EPS);
            const float* gate = WSF(WS_MOD) + ((size_t)(l - 1) * 5 + bi) * (3 * DM) + 2 * DM; const float* npost = KIN(7) + (size_t)(l - 1) * DM;
#pragma unroll
            for (int j = 0; j < 8; ++j) { const int c = j * 256 + lane * 4; const f32x4 g = *(const f32x4*)(gate + c), w = *(const f32x4*)(npost + c), xv = *(const f32x4*)(xr + c);
                v[j] = xv + g * (y[j] * rs * w); }
        }
        if (l == DEPTH) { float* o = (ka->out) + ((size_t)b * SEQ + t) * DM;
#pragma unroll
            for (int j = 0; j < 8; ++j) *(f32x4*)(o + j * 256 + lane * 4) = v[j];
            continue; }
        float* xo = WSF(WS_X) + (size_t)r * DM; float ss = 0.f;
#pragma unroll
        for (int j = 0; j < 8; ++j) { *(f32x4*)(xo + j * 256 + lane * 4) = v[j]; ss += v[j].x * v[j].x + v[j].y * v[j].y + v[j].z * v[j].z + v[j].w * v[j].w; }
        const float rs = rsqrtf(wave_sum(ss) * (1.f / DM) + EPS);
        const float* shift = WSF(WS_MOD) + ((size_t)l * 5 + bi) * (3 * DM); const float* scale = shift + DM; const float* npre = KIN(6) + (size_t)l * DM;
        bf16_t* ho = WSB(WS_H) + (size_t)r * DM;
#pragma unroll
        for (int j = 0; j < 8; ++j) { const int c = j * 256 + lane * 4; const f32x4 sh = *(const f32x4*)(shift + c), scv = *(const f32x4*)(scale + c), w = *(const f32x4*)(npre + c);
            const f32x4 h = v[j] * rs * w * (scv + 1.f) + sh; v2u o; o.x = pk2(h.x, h.y); o.y = pk2(h.z, h.w); *(v2u*)(ho + c) = o; }
    }
}

__device__ __forceinline__ void p_prep(Frame& F, CArgs* ka, int l) {
    const int tid = tid_fresh(), lane = tid & 63, wave = __builtin_amdgcn_readfirstlane(tid >> 6); (void)lane; (void)wave;
    const int gw = F.wg * NWAVES + wave, NGW = F.G * NWAVES;
    for (int it = gw; it < MROWS * 4; it += NGW) { const int r = it >> 2, j = it & 3, b = r / TPB, t = r - b * TPB;
        bf16_t* kp = WSB(WS_P) + (size_t)r * NP + C_AK + j * 128; const float k1 = bf2f(kp[lane]), k2 = bf2f(kp[lane + 64]);
        const float rs = rsqrtf(wave_sum(k1 * k1 + k2 * k2) * (1.f / 128.f) + EPS);
        float n1 = k1 * rs * KIN(19)[l * 128 + lane], n2 = k2 * rs * KIN(19)[l * 128 + 64 + lane];
        if (t < SEQ) { const float c = WSF(WS_ROPE)[t * 64 + lane], s = WSF(WS_ROPE)[SEQ * 64 + t * 64 + lane]; const float o1 = n1 * c - n2 * s, o2 = n2 * c + n1 * s; n1 = o1; n2 = o2; }
        kp[lane] = (bf16_t)f2bf(n1); kp[lane + 64] = (bf16_t)f2bf(n2); }
    for (int r = gw; r < MROWS; r += NGW) { const int c = lane & 31, hf = lane >> 5;
        const bf16_t* hp = WSB(WS_H) + (size_t)r * DM + hf * 1024; const bf16_t* wp = WSB(WS_WG) + ((size_t)l * 32 + c) * DM + hf * 1024; float s = 0.f;
        for (int k = 0; k < 1024; k += 8) { const v4u a = *(const v4u*)(hp + k), w = *(const v4u*)(wp + k);
            s += blo(a.x) * blo(w.x) + bhi(a.x) * bhi(w.x) + blo(a.y) * blo(w.y) + bhi(a.y) * bhi(w.y) + blo(a.z) * blo(w.z) + bhi(a.z) * bhi(w.z) + blo(a.w) * blo(w.w) + bhi(a.w) * bhi(w.w); }
        s += __shfl_xor(s, 32); s += KIN(16)[l * 32 + c];
        if ((c >> 3) & 1) s = fminf(s, 0.f) - log1pf(expf(-fabsf(s)));
        if (hf == 0) WSF(WS_GT)[(size_t)r * 32 + c] = s; }
}

__device__ __forceinline__ void p_lru_gates_naive(Frame& F, CArgs* ka, int l) {
    const int tid = tid_fresh(); (void)tid;
    LAS float* xs = (LAS float*)F.lds;
    for (int it = F.wg; it < (MROWS / 16) * 16; it += F.G) { const int rt = it >> 4, blk = it & 15;
        __syncthreads();
#pragma unroll
        for (int j = 0; j < 4; ++j) { const int idx = tid + 512 * j, rr = idx >> 7, c = idx & 127, r = rt * 16 + rr, b = r / TPB, t = r - b * TPB, ch = blk * 128 + c;
            const int lo = t < SEQ ? 0 : SEQ, hi = t < SEQ ? SEQ : TPB; float a = KIN(10)[l * DM + ch];
#pragma unroll
            for (int k = 0; k < 4; ++k) { const int tt = t + k - 2; if (tt >= lo && tt < hi) a += KIN(9)[((size_t)l * 4 + k) * DM + ch] * bf2f(WSB(WS_P)[((size_t)b * TPB + tt) * NP + C_LX + ch]); }
            xs[rr * 128 + c] = a; }
        __syncthreads();
        const int co = tid & 127, r0 = tid >> 7, ch = blk * 128 + co;
#pragma unroll 1
        for (int dr = 0; dr < 2; ++dr) {
            const float* wr = KIN(11) + (((size_t)l * 2 + dr) * 16 + blk) * 16384 + co; const float* wi = KIN(13) + (((size_t)l * 2 + dr) * 16 + blk) * 16384 + co;
            float ar[4], ai[4];
#pragma unroll
            for (int j = 0; j < 4; ++j) { ar[j] = KIN(12)[((size_t)l * 2 + dr) * DM + ch]; ai[j] = KIN(14)[((size_t)l * 2 + dr) * DM + ch]; }
            for (int c = 0; c < 128; ++c) { const float w0 = wr[c * 128], w1 = wi[c * 128];
#pragma unroll
                for (int j = 0; j < 4; ++j) { const float xv = xs[(r0 + 4 * j) * 128 + c]; ar[j] += xv * w0; ai[j] += xv * w1; } }
            const float lam = KIN(15)[((size_t)l * 2 + dr) * DM + ch], sp = log1pf(expf(-lam));
#pragma unroll
            for (int j = 0; j < 4; ++j) { const int r = rt * 16 + r0 + 4 * j; const float rg = 1.f / (1.f + expf(-ar[j])), ig = 1.f / (1.f + expf(-ai[j]));
                const float log_a = -8.f * rg * sp, a = expf(log_a), mult = sqrtf(-expm1f(2.f * log_a));
                WSF(WS_LA)[((size_t)dr * MROWS + r) * DM + ch] = a; WSF(WS_LB)[((size_t)dr * MROWS + r) * DM + ch] = mult * ig * xs[(r0 + 4 * j) * 128 + co]; }
        }
    }
    __syncthreads();
}

__device__ __forceinline__ void p_attention(Frame& F, CArgs* ka, int l, bool need_ctx) {
    using att::bf16;
    const int n_lat = NBATCH * 16 * 8, n_all = n_lat + (need_ctx ? NBATCH * 16 : 0);
    for (int u = F.wg; u < n_all; u += F.G) {
        int b, h, q0, k0, seq; const float *cs = nullptr, *sn = nullptr;
        if (u < n_lat) { const int qb = u & 7; h = (u >> 3) & 15; b = u >> 7; q0 = qb * 256; k0 = 0; seq = TPB; cs = WSF(WS_ROPE) + (size_t)q0 * 64; sn = WSF(WS_ROPE) + (size_t)SEQ * 64 + (size_t)q0 * 64; }
        else { const int v = u - n_lat; h = v & 15; b = v >> 4; q0 = SEQ; k0 = SEQ; seq = CTXL; }
        const size_t rq = (size_t)b * TPB + q0, rk = (size_t)b * TPB + k0; const int kvh = h >> 2;
        att::attn_unit((const bf16*)(WSB(WS_P) + rq * NP + C_AQ + h * 128), (const bf16*)(WSB(WS_P) + rk * NP + C_AK + kvh * 128), (const bf16*)(WSB(WS_P) + rk * NP + C_AV + kvh * 128),
                       (const bf16*)(WSB(WS_P) + rq * NP + C_AZ + h * 128), (bf16*)(WSB(WS_YB) + ((size_t)2 * MROWS + rq) * DM + h * 128), seq, F.ldsg, KIN(18) + l * 128, cs, sn);
    }
}
__device__ __forceinline__ int seq_row(int s, int dir) { return s < CTXL ? SEQ + (dir ? CTXL - 1 - s : s) : (dir ? SEQ - 1 - (s - CTXL) : s - CTXL); }
__device__ __forceinline__ void p_mlstm_naive(Frame& F, CArgs* ka, int l) {
    const int tid = tid_fresh(), lane = tid & 63, wave = __builtin_amdgcn_readfirstlane(tid >> 6); (void)lane; (void)wave;
    LAS float* sq = (LAS float*)F.lds; LAS float* sk = sq + 256; LAS float* rn = sk + 256; LAS float* rd = rn + 512;
    const int e = tid & 63, dg = tid >> 6;
    for (int u = F.wg; u < 256; u += F.G) { const int es = u & 3, dir = (u >> 2) & 1, h = (u >> 3) & 7, b = u >> 6;
        float C[32], n[32];
#pragma unroll
        for (int i = 0; i < 32; ++i) { C[i] = 0.f; n[i] = 0.f; }
        float m = -1e30f;
        const int lcol = tid < 64 ? C_MQ + h * 256 + tid * 4 : C_MK + h * 256 + (tid - 64) * 4, vcol = C_MV + h * 256 + es * 64 + e;
        v2u pqk = {0u, 0u}; bf16_t pv; float gi, gf;
        { const size_t r = (size_t)b * TPB + seq_row(0, dir); if (tid < 128) pqk = *(const v2u*)(WSB(WS_P) + r * NP + lcol); pv = WSB(WS_P)[r * NP + vcol]; gi = WSF(WS_GT)[r * 32 + dir * 16 + h]; gf = WSF(WS_GT)[r * 32 + dir * 16 + 8 + h]; }
        __syncthreads();
        for (int s = 0; s < TPB; ++s) {
            const size_t r = (size_t)b * TPB + seq_row(s, dir);
            if (tid < 128) { LAS float* d = (tid < 64 ? sq : sk) + (tid & 63) * 4; d[0] = blo(pqk.x); d[1] = bhi(pqk.x); d[2] = blo(pqk.y); d[3] = bhi(pqk.y); }
            const float vv = bf2f(pv), iv = gi, lf = gf;
            __syncthreads();
            if (s + 1 < TPB) { const size_t r2 = (size_t)b * TPB + seq_row(s + 1, dir); if (tid < 128) pqk = *(const v2u*)(WSB(WS_P) + r2 * NP + lcol); pv = WSB(WS_P)[r2 * NP + vcol]; gi = WSF(WS_GT)[r2 * 32 + dir * 16 + h]; gf = WSF(WS_GT)[r2 * 32 + dir * 16 + 8 + h]; }
            const float mnew = fmaxf(lf + m, iv), fw = expf(lf + m - mnew), iw = expf(iv - mnew); m = mnew;
            float pn = 0.f, pd = 0.f;
#pragma unroll
            for (int dd = 0; dd < 32; ++dd) { const float kd = sk[dg * 32 + dd], qd = sq[dg * 32 + dd]; C[dd] = fw * C[dd] + iw * kd * vv; n[dd] = fw * n[dd] + iw * kd; pn += qd * C[dd]; pd += qd * n[dd]; }
            rn[dg * 64 + e] = pn; rd[dg * 64 + e] = pd;
            __syncthreads();
            if (dg == 0) { float num = 0.f, den = 0.f;
#pragma unroll
                for (int g = 0; g < 8; ++g) { num += rn[g * 64 + e]; den += rd[g * 64 + e]; }
                WSF(WS_MH)[((size_t)dir * MROWS + r) * DM + h * 256 + es * 64 + e] = num / fmaxf(fabsf(den), expf(-m)); }
        }
        __syncthreads();
    }
}
__device__ __forceinline__ void p_lru_scan_naive(Frame& F, CArgs* ka) {
    const int tid = tid_fresh(), lane = tid & 63, wave = __builtin_amdgcn_readfirstlane(tid >> 6); (void)lane; (void)wave;
    if (wave != 0) return;
    for (int cw = F.wg; cw < 256; cw += F.G) { const int combo = cw * 64 + lane, b = combo >> 12, dir = (combo >> 11) & 1, ch = combo & 2047;
        const float* A = WSF(WS_LA) + (size_t)dir * MROWS * DM + ch; const float* Bx = WSF(WS_LB) + (size_t)dir * MROWS * DM + ch; float* Ho = WSF(WS_HL) + (size_t)dir * MROWS * DM + ch; float h = 0.f;
#pragma unroll 8
        for (int s = 0; s < TPB; ++s) { const size_t r = (size_t)b * TPB + seq_row(s, dir); h = A[r * DM] * h + Bx[r * DM]; Ho[r * DM] = h; }
    }
}

__device__ __forceinline__ void p_mlout(Frame& F, CArgs* ka, int l) {
    const int tid = tid_fresh(), lane = tid & 63, wave = __builtin_amdgcn_readfirstlane(tid >> 6); (void)lane; (void)wave;
    const int gw = F.wg * NWAVES + wave, NGW = F.G * NWAVES;
    for (int r = gw; r < MROWS; r += NGW) {
        const bf16_t* pr = WSB(WS_P) + (size_t)r * NP;
#pragma unroll 2
        for (int h = 0; h < 8; ++h) { const int col = h * 256 + lane * 4;
            const f32x4 a = *(const f32x4*)(WSF(WS_MH) + (size_t)r * DM + col), bb = *(const f32x4*)(WSF(WS_MH) + ((size_t)MROWS + r) * DM + col);
            const v2u ow = *(const v2u*)(pr + C_MO + col), zw = *(const v2u*)(pr + C_MZ + col); const f32x4 g = *(const f32x4*)(KIN(17) + (size_t)l * DM + col);
            f32x4 v = a + bb; v.x *= blo(ow.x); v.y *= bhi(ow.x); v.z *= blo(ow.y); v.w *= bhi(ow.y);
            const float rs = rsqrtf(wave_sum(v.x * v.x + v.y * v.y + v.z * v.z + v.w * v.w) * (1.f / 256.f) + EPS);
            v2u o; o.x = pk2(v.x * rs * g.x * blo(zw.x), v.y * rs * g.y * bhi(zw.x)); o.y = pk2(v.z * rs * g.z * blo(zw.y), v.w * rs * g.w * bhi(zw.y));
            *(v2u*)(WSB(WS_YB) + ((size_t)MROWS + r) * DM + col) = o; }
    }
}

__device__ __forceinline__ void p_lru_combine_naive(Frame& F, CArgs* ka) {
    const int tid = tid_fresh(), lane = tid & 63, wave = __builtin_amdgcn_readfirstlane(tid >> 6);
    const int gw = F.wg * NWAVES + wave, NGW = F.G * NWAVES;
    for (int r = gw; r < MROWS; r += NGW) {
        const bf16_t* pr = WSB(WS_P) + (size_t)r * NP;
#pragma unroll 2
        for (int j = 0; j < 8; ++j) { const int col = j * 256 + lane * 4;
            const f32x4 a = *(const f32x4*)(WSF(WS_HL) + (size_t)r * DM + col), bb = *(const f32x4*)(WSF(WS_HL) + ((size_t)MROWS + r) * DM + col); const v2u zw = *(const v2u*)(pr + C_LZ + col);
            const f32x4 v = a + bb; v2u o; o.x = pk2(v.x * blo(zw.x), v.y * bhi(zw.x)); o.y = pk2(v.z * blo(zw.y), v.w * bhi(zw.y));
            *(v2u*)(WSB(WS_YB) + (size_t)r * DM + col) = o; }
    }
}
#ifndef USE_NAIVE_ML
#define USE_NAIVE_ML 0
#endif
#ifndef USE_NAIVE_LRU
#define USE_NAIVE_LRU 0
#endif

namespace ml {
typedef short bf16x8 __attribute__((ext_vector_type(8)));
constexpr int KS_OFF = 0, KS_PITCH = 528;
constexpr int KT_OFF = KS_OFF + 64 * KS_PITCH, KT_PITCH = 144;
constexpr int VT_OFF = KT_OFF + 256 * KT_PITCH, VT_PITCH = 144;
constexpr int ST_OFF = VT_OFF + 80 * VT_PITCH, ST_PITCH = 144;
constexpr int CT_OFF = ST_OFF + 64 * ST_PITCH, CT_PITCH = 528;
constexpr int TAB_OFF = CT_OFF + 80 * CT_PITCH;
constexpr int END_OFF = TAB_OFF + 1024;
static_assert(END_OFF <= MISC_OFF, "mLSTM LDS map");
#define ML_MFMA(a, b, c) __builtin_amdgcn_mfma_f32_16x16x32_bf16((a), (b), (c), 0, 0, 0)
__device__ __forceinline__ int chunk_of(int k, int dir) { return k < 4 ? (dir ? 35 - k : 32 + k) : (dir ? 31 - (k - 4) : k - 4); }

__device__ __forceinline__ void mlstm_unit(Frame& F, CArgs* ka, int u, bool need_ctx) {
    const int tid = tid_fresh(), lane = tid & 63, w = __builtin_amdgcn_readfirstlane(tid >> 6), c16 = lane & 15, q = lane >> 4;
    const int es = u & 3, dir = (u >> 2) & 1, h = (u >> 3) & 7, b = u >> 6;
    LAS unsigned char* L = F.lds;
    const bf16_t* P = WSB(WS_P); const float* GT = WSF(WS_GT); float* MH = WSF(WS_MH) + (size_t)dir * MROWS * DM;
    LAS float* TABg = (LAS float*)(L + TAB_OFF); LAS float* TABmm = TABg + 64; LAS float* TABbc = TABg + 128; LAS float* DEN = TABg + 192;
    __syncthreads();
    for (int i = tid; i < 80 * CT_PITCH / 16; i += 512) *(LAS v4u*)(L + CT_OFF + i * 16) = (v4u){0u, 0u, 0u, 0u};
    for (int i = tid; i < 16 * 64; i += 512) { const int e = 64 + (i >> 6), s = i & 63; *(LAS bf16_t*)(L + VT_OFF + e * VT_PITCH + s * 2) = (bf16_t)(e == 64 ? 0x3F80 : 0); }
    f32x4 C[2][5];
#pragma unroll
    for (int a = 0; a < 2; ++a)
#pragma unroll
        for (int e = 0; e < 5; ++e) C[a][e] = (f32x4){0.f, 0.f, 0.f, 0.f};
    float m = -1e30f;
    const int tn = w & 3, wh = w >> 2;
    const int ks_s = tid >> 5, ks_dp = tid & 31, v_s = tid >> 3, v_ep = tid & 7;
    v4u kraw[4], vraw; bf16x8 Qf[8]; float gi, gf;
#define ML_ROW(base, j) ((size_t)(base) + (dir ? 63 - (j) : (j)))
#define ML_LOAD_KVG(k) do { const int _base = b * TPB + chunk_of((k), dir) * 64; \
        _Pragma("unroll") for (int i = 0; i < 4; ++i) kraw[i] = *(const v4u*)(P + ML_ROW(_base, ks_s + 16 * i) * NP + C_MK + h * 256 + ks_dp * 8); \
        vraw = *(const v4u*)(P + ML_ROW(_base, v_s) * NP + C_MV + h * 256 + es * 64 + v_ep * 8); \
        gi = GT[ML_ROW(_base, lane) * 32 + dir * 16 + h]; gf = GT[ML_ROW(_base, lane) * 32 + dir * 16 + 8 + h]; } while (0)
#define ML_LOAD_Q(k) do { const int _base = b * TPB + chunk_of((k), dir) * 64; const bf16_t* _qp = P + ML_ROW(_base, tn * 16 + c16) * NP + C_MQ + h * 256 + q * 8; \
        _Pragma("unroll") for (int ks = 0; ks < 8; ++ks) Qf[ks] = *(const bf16x8*)(_qp + ks * 32); } while (0)
    ML_LOAD_KVG(0); ML_LOAD_Q(0);
#pragma unroll 1
    for (int k = 0; k < 36; ++k) {
        const int base = b * TPB + chunk_of(k, dir) * 64; const bool do_out = need_ctx || k >= 4;
        float bc = gf;
#pragma unroll
        for (int o = 1; o < 64; o <<= 1) { const float v = __shfl_up(bc, o); if (lane >= o) bc += v; }
        const float g = gi - bc; float pm = g;
#pragma unroll
        for (int o = 1; o < 64; o <<= 1) { const float v = __shfl_up(pm, o); if (lane >= o) pm = fmaxf(pm, v); }
        const float mm = fmaxf(pm, m), bL = __shfl(bc, 63), mm63 = __shfl(mm, 63), wk = __expf(g - mm63);
        if (w == 0) { TABg[lane] = g; TABmm[lane] = mm; TABbc[lane] = bc; }
#pragma unroll
        for (int i = 0; i < 4; ++i) *(LAS v4u*)(L + KS_OFF + (ks_s + 16 * i) * KS_PITCH + ks_dp * 16) = kraw[i];
#pragma unroll
        for (int e = 0; e < 4; ++e) { const unsigned x = vraw[e];
            *(LAS bf16_t*)(L + VT_OFF + (v_ep * 8 + 2 * e) * VT_PITCH + v_s * 2) = (bf16_t)(x & 0xffffu); *(LAS bf16_t*)(L + VT_OFF + (v_ep * 8 + 2 * e + 1) * VT_PITCH + v_s * 2) = (bf16_t)(x >> 16); }
        __syncthreads();
        if (k + 1 < 36) ML_LOAD_KVG(k + 1);
        { const int d = tid & 255, sh = w >> 2;
#pragma unroll
          for (int gq = 0; gq < 4; ++gq) { const int s0 = sh * 32 + gq * 8; float kv[8];
#pragma unroll
            for (int i = 0; i < 8; ++i) kv[i] = bf2f(*(const LAS bf16_t*)(L + KS_OFF + (s0 + i) * KS_PITCH + d * 2)) * __builtin_bit_cast(float, __builtin_amdgcn_readlane(__builtin_bit_cast(int, wk), s0 + i));
            v4u o; o.x = pk2(kv[0], kv[1]); o.y = pk2(kv[2], kv[3]); o.z = pk2(kv[4], kv[5]); o.w = pk2(kv[6], kv[7]);
            *(LAS v4u*)(L + KT_OFF + d * KT_PITCH + s0 * 2) = o; } }
        const int t = tn * 16 + c16;
        if (do_out) {
            const float mmt = TABmm[t];
#pragma unroll
            for (int si = 0; si < 2; ++si) { const int sm = wh * 2 + si; v2u o = {0u, 0u};
                if (sm <= tn) { f32x4 acc = {0.f, 0.f, 0.f, 0.f};
#pragma unroll
                    for (int ks = 0; ks < 8; ++ks) { const bf16x8 a = *(const LAS bf16x8*)(L + KS_OFF + (sm * 16 + c16) * KS_PITCH + (ks * 32 + q * 8) * 2); acc = ML_MFMA(a, Qf[ks], acc); }
                    float v[4];
#pragma unroll
                    for (int j = 0; j < 4; ++j) { const int s = sm * 16 + q * 4 + j; v[j] = s <= t ? acc[j] * __expf(TABg[s] - mmt) : 0.f; }
                    o.x = pk2(v[0], v[1]); o.y = pk2(v[2], v[3]); }
                *(LAS v2u*)(L + ST_OFF + t * ST_PITCH + (sm * 16 + q * 4) * 2) = o; }
        }
        __syncthreads();
        f32x4 num0 = {0.f, 0.f, 0.f, 0.f}, num1 = {0.f, 0.f, 0.f, 0.f};
        if (do_out) {
            const float wi = __expf(m - TABmm[t]);
#pragma unroll
            for (int ei = 0; ei < 3; ++ei) { if (ei == 2 && wh != 0) break; const int em = ei < 2 ? wh * 2 + ei : 4;
                f32x4 a1 = {0.f, 0.f, 0.f, 0.f}, a2 = {0.f, 0.f, 0.f, 0.f};
#pragma unroll
                for (int ks = 0; ks < 2; ++ks) { const bf16x8 a = *(const LAS bf16x8*)(L + VT_OFF + (em * 16 + c16) * VT_PITCH + (ks * 32 + q * 8) * 2), bb = *(const LAS bf16x8*)(L + ST_OFF + t * ST_PITCH + (ks * 32 + q * 8) * 2);
                    a1 = ML_MFMA(a, bb, a1); }
#pragma unroll
                for (int ks = 0; ks < 8; ++ks) { const bf16x8 a = *(const LAS bf16x8*)(L + CT_OFF + (em * 16 + c16) * CT_PITCH + (ks * 32 + q * 8) * 2); a2 = ML_MFMA(a, Qf[ks], a2); }
                const f32x4 nv = a1 + a2 * wi;
                if (ei == 0) num0 = nv; else if (ei == 1) num1 = nv;
                else if (q == 0) DEN[t] = fmaxf(fabsf(nv[0]), __expf(-(TABbc[t] + TABmm[t]))); }
        }
        if (k + 1 < 36) ML_LOAD_Q(k + 1);
        __syncthreads();
        if (do_out) { const float rd = 1.f / DEN[t]; float* op = MH + ML_ROW(base, t) * DM + h * 256 + es * 64 + q * 4;
            *(f32x4*)(op + (wh * 2) * 16) = num0 * rd; *(f32x4*)(op + (wh * 2 + 1) * 16) = num1 * rd; }
        { const float decay = __expf(m - mm63);
#pragma unroll
          for (int di = 0; di < 2; ++di) {
            bf16x8 a[2];
#pragma unroll
            for (int ks = 0; ks < 2; ++ks) a[ks] = *(const LAS bf16x8*)(L + KT_OFF + ((2 * w + di) * 16 + c16) * KT_PITCH + (ks * 32 + q * 8) * 2);
#pragma unroll
            for (int en = 0; en < 5; ++en) { f32x4 c = C[di][en] * decay;
#pragma unroll
                for (int ks = 0; ks < 2; ++ks) { const bf16x8 bb = *(const LAS bf16x8*)(L + VT_OFF + (en * 16 + c16) * VT_PITCH + (ks * 32 + q * 8) * 2); c = ML_MFMA(a[ks], bb, c); }
                C[di][en] = c; v2u o; o.x = pk2(c[0], c[1]); o.y = pk2(c[2], c[3]);
                *(LAS v2u*)(L + CT_OFF + (en * 16 + c16) * CT_PITCH + ((2 * w + di) * 16 + q * 4) * 2) = o; } }
          m = bL + mm63; }
        __syncthreads();
    }
#undef ML_ROW
#undef ML_LOAD_KVG
#undef ML_LOAD_Q
}
}

namespace lru {
typedef short bf16x8 __attribute__((ext_vector_type(8)));
constexpr int XB_OFF = 0, XB_PITCH = 272;
constexpr int XF_OFF = XB_OFF + 64 * XB_PITCH, XF_PITCH = 528;
constexpr int YO_OFF = XF_OFF + 64 * XF_PITCH, YO_PITCH = 528;
constexpr int HIN_OFF = YO_OFF + 64 * YO_PITCH;
constexpr int END_OFF = HIN_OFF + 9 * 2 * 128 * 4;
static_assert(END_OFF <= MISC_OFF, "LRU LDS map");
#define LRU_COMPOSE(A, B, a2, b2) do { B = (a2) * B + (b2); A = (a2) * A; } while (0)

template <bool FINAL>
__device__ __forceinline__ void lru_unit(Frame& F, CArgs* ka, int l, int b, int chunk, int blk, int hslot) {
    const int tid = tid_fresh(), lane = tid & 63, w = __builtin_amdgcn_readfirstlane(tid >> 6), c16 = lane & 15, q = lane >> 4;
    LAS unsigned char* L = F.lds; const bf16_t* P = WSB(WS_P);
    const int t0 = chunk * 64, lo = chunk < 32 ? 0 : SEQ, hi = chunk < 32 ? SEQ : TPB; const size_t rb = (size_t)b * TPB;
    __syncthreads();
    {
      const int cg = tid & 15, rg = tid >> 4, ch0 = blk * 128 + cg * 8; float xin[5][8];
#pragma unroll
      for (int i = 0; i < 5; ++i) { const int tt = t0 + 2 * rg - 2 + i; v4u r = {0u, 0u, 0u, 0u}; if (tt >= lo && tt < hi) r = *(const v4u*)(P + (rb + tt) * NP + C_LX + ch0);
#pragma unroll
          for (int e = 0; e < 4; ++e) { xin[i][2 * e] = blo(r[e]); xin[i][2 * e + 1] = bhi(r[e]); } }
      float o0[8], o1[8]; const float* cw = KIN(9) + (size_t)l * 4 * DM + ch0; const float* cb = KIN(10) + (size_t)l * DM + ch0;
#pragma unroll
      for (int e = 0; e < 8; ++e) { o0[e] = cb[e]; o1[e] = cb[e]; }
#pragma unroll
      for (int kk = 0; kk < 4; ++kk)
#pragma unroll
          for (int e = 0; e < 8; ++e) { const float wv = cw[kk * DM + e]; o0[e] += wv * xin[kk][e]; o1[e] += wv * xin[kk + 1][e]; }
      v4u p0, p1; p0.x = pk2(o0[0], o0[1]); p0.y = pk2(o0[2], o0[3]); p0.z = pk2(o0[4], o0[5]); p0.w = pk2(o0[6], o0[7]); p1.x = pk2(o1[0], o1[1]); p1.y = pk2(o1[2], o1[3]); p1.z = pk2(o1[4], o1[5]); p1.w = pk2(o1[6], o1[7]);
      *(LAS v4u*)(L + XB_OFF + (2 * rg) * XB_PITCH + cg * 16) = p0; *(LAS v4u*)(L + XB_OFF + (2 * rg + 1) * XB_PITCH + cg * 16) = p1;
      LAS float* f0 = (LAS float*)(L + XF_OFF + (2 * rg) * XF_PITCH + cg * 32); LAS float* f1 = (LAS float*)(L + XF_OFF + (2 * rg + 1) * XF_PITCH + cg * 32);
      *(LAS f32x4*)f0 = (f32x4){o0[0], o0[1], o0[2], o0[3]}; *(LAS f32x4*)(f0 + 4) = (f32x4){o0[4], o0[5], o0[6], o0[7]};
      *(LAS f32x4*)f1 = (f32x4){o1[0], o1[1], o1[2], o1[3]}; *(LAS f32x4*)(f1 + 4) = (f32x4){o1[4], o1[5], o1[6], o1[7]}; }
    __syncthreads();
    f32x4 acc[4][4];
#pragma unroll
    for (int g = 0; g < 4; ++g)
#pragma unroll
        for (int tm = 0; tm < 4; ++tm) acc[g][tm] = (f32x4){0.f, 0.f, 0.f, 0.f};
    const bf16_t* Wt = WSB(WS_WLRU) + (size_t)l * 4 * 16 * 16384 + ((size_t)blk * 128 + 16 * w + c16) * 128 + q * 8;
#pragma unroll
    for (int ks = 0; ks < 4; ++ks) { bf16x8 a[4], bw[4];
#pragma unroll
        for (int tm = 0; tm < 4; ++tm) a[tm] = *(const LAS bf16x8*)(L + XB_OFF + (tm * 16 + c16) * XB_PITCH + (ks * 32 + q * 8) * 2);
#pragma unroll
        for (int g = 0; g < 4; ++g) bw[g] = *(const bf16x8*)(Wt + (size_t)g * 16 * 16384 + ks * 32);
#pragma unroll
        for (int g = 0; g < 4; ++g)
#pragma unroll
            for (int tm = 0; tm < 4; ++tm) acc[g][tm] = __builtin_amdgcn_mfma_f32_16x16x32_bf16(a[tm], bw[g], acc[g][tm], 0, 0, 0); }
    const int chl = 16 * w + c16, ch = blk * 128 + chl;
#pragma unroll
    for (int dr = 0; dr < 2; ++dr) { const float br = KIN(12)[((size_t)l * 2 + dr) * DM + ch], bi = KIN(14)[((size_t)l * 2 + dr) * DM + ch], sp = log1pf(__expf(-KIN(15)[((size_t)l * 2 + dr) * DM + ch]));
#pragma unroll
        for (int tm = 0; tm < 4; ++tm)
#pragma unroll
            for (int j = 0; j < 4; ++j) { const int t = tm * 16 + q * 4 + j; const float xv = *(const LAS float*)(L + XF_OFF + t * XF_PITCH + chl * 4);
                const float rg = pg8::sigmoid_f(acc[2 * dr][tm][j] + br), ig = pg8::sigmoid_f(acc[2 * dr + 1][tm][j] + bi), la = -8.f * rg * sp;
                acc[2 * dr][tm][j] = __expf(la); acc[2 * dr + 1][tm][j] = sqrtf(fmaxf(-expm1f(2.f * la), 0.f)) * ig * xv; } }
    if constexpr (!FINAL) {
        float2* AGG = (float2*)WSF(WS_LA);
        { float TA = 1.f, TB = 0.f;
#pragma unroll
          for (int tm = 0; tm < 4; ++tm) { float sa = 1.f, sb = 0.f;
#pragma unroll
            for (int j = 0; j < 4; ++j) LRU_COMPOSE(sa, sb, acc[0][tm][j], acc[1][tm][j]);
#pragma unroll
            for (int qq = 0; qq < 4; ++qq) { const float xa = __shfl(sa, c16 + 16 * qq), xb = __shfl(sb, c16 + 16 * qq); LRU_COMPOSE(TA, TB, xa, xb); } }
          if (q == 0) AGG[(((size_t)b * 36 + chunk) * 2 + 0) * DM + ch] = make_float2(TA, TB); }
        { float TA = 1.f, TB = 0.f;
#pragma unroll
          for (int tm = 3; tm >= 0; --tm) { float sa = 1.f, sb = 0.f;
#pragma unroll
            for (int j = 3; j >= 0; --j) LRU_COMPOSE(sa, sb, acc[2][tm][j], acc[3][tm][j]);
#pragma unroll
            for (int qq = 3; qq >= 0; --qq) { const float xa = __shfl(sa, c16 + 16 * qq), xb = __shfl(sb, c16 + 16 * qq); LRU_COMPOSE(TA, TB, xa, xb); } }
          if (q == 0) AGG[(((size_t)b * 36 + chunk) * 2 + 1) * DM + ch] = make_float2(TA, TB); }
    } else {
        const LAS float* HIN = (const LAS float*)(L + HIN_OFF) + hslot * 256;
        f32x4 out[4];
        { float H = HIN[chl];
#pragma unroll
          for (int tm = 0; tm < 4; ++tm) { float sa = 1.f, sb = 0.f;
#pragma unroll
            for (int j = 0; j < 4; ++j) LRU_COMPOSE(sa, sb, acc[0][tm][j], acc[1][tm][j]);
            float ea = 1.f, eb = 0.f, ta = 1.f, tb = 0.f;
#pragma unroll
            for (int qq = 0; qq < 4; ++qq) { const float xa = __shfl(sa, c16 + 16 * qq), xb = __shfl(sb, c16 + 16 * qq); if (qq == q) { ea = ta; eb = tb; } LRU_COMPOSE(ta, tb, xa, xb); }
            float hs = ea * H + eb;
#pragma unroll
            for (int j = 0; j < 4; ++j) { hs = acc[0][tm][j] * hs + acc[1][tm][j]; out[tm][j] = hs; }
            H = ta * H + tb; } }
        { float H = HIN[128 + chl];
#pragma unroll
          for (int tm = 3; tm >= 0; --tm) { float sa = 1.f, sb = 0.f;
#pragma unroll
            for (int j = 3; j >= 0; --j) LRU_COMPOSE(sa, sb, acc[2][tm][j], acc[3][tm][j]);
            float ea = 1.f, eb = 0.f, ta = 1.f, tb = 0.f;
#pragma unroll
            for (int qq = 3; qq >= 0; --qq) { const float xa = __shfl(sa, c16 + 16 * qq), xb = __shfl(sb, c16 + 16 * qq); if (qq == q) { ea = ta; eb = tb; } LRU_COMPOSE(ta, tb, xa, xb); }
            float hs = ea * H + eb;
#pragma unroll
            for (int j = 3; j >= 0; --j) { hs = acc[2][tm][j] * hs + acc[3][tm][j]; out[tm][j] += hs; }
            H = ta * H + tb; } }
#pragma unroll
        for (int tm = 0; tm < 4; ++tm)
#pragma unroll
            for (int j = 0; j < 4; ++j) *(LAS float*)(L + YO_OFF + (tm * 16 + q * 4 + j) * YO_PITCH + chl * 4) = out[tm][j];
        __syncthreads();
        bf16_t* YB0 = WSB(WS_YB);
#pragma unroll
        for (int i = 0; i < 2; ++i) { const int cidx = tid + 512 * i, row = cidx >> 4, cg = cidx & 15; const size_t rgl = rb + t0 + row;
            const f32x4 y0 = *(const LAS f32x4*)(L + YO_OFF + row * YO_PITCH + cg * 32), y1 = *(const LAS f32x4*)(L + YO_OFF + row * YO_PITCH + cg * 32 + 16);
            const v4u z = *(const v4u*)(P + rgl * NP + C_LZ + blk * 128 + cg * 8);
            v4u o; o.x = pk2(y0[0] * blo(z.x), y0[1] * bhi(z.x)); o.y = pk2(y0[2] * blo(z.y), y0[3] * bhi(z.y)); o.z = pk2(y1[0] * blo(z.z), y1[1] * bhi(z.z)); o.w = pk2(y1[2] * blo(z.w), y1[3] * bhi(z.w));
            *(v4u*)(YB0 + rgl * DM + blk * 128 + cg * 8) = o; }
    }
}
__device__ __forceinline__ void p_lru_agg(Frame& F, CArgs* ka, int l) {
    for (int u = F.wg; u < NBATCH * 36 * 16; u += F.G) { const int blk = u & 15, cc = (u >> 4) % 36, b = u / 576; lru_unit<false>(F, ka, l, b, cc, blk, 0); }
}
__device__ __forceinline__ void p_lru_final(Frame& F, CArgs* ka, int l) {
    for (int v = F.wg; v < 256; v += F.G) { const int b = v >> 6, blk = (v >> 2) & 15, qt = v & 3;
        const int tid = tid_fresh();
        __syncthreads();
        if (tid < 256) { const int dirx = tid >> 7, chl = tid & 127; const float2* AGG = (const float2*)WSF(WS_LA) + ((size_t)b * 36 * 2 + dirx) * DM + blk * 128 + chl;
            LAS float* HIN = (LAS float*)(F.lds + HIN_OFF); float hcar = 0.f;
#pragma unroll 12
            for (int k = 0; k < 36; ++k) { const int cidx = ml::chunk_of(k, dirx); const float2 ab = AGG[(size_t)cidx * 2 * DM];
                const int sl = cidx - qt * 9; if (sl >= 0 && sl < 9) HIN[sl * 256 + dirx * 128 + chl] = hcar;
                hcar = ab.x * hcar + ab.y; } }
        __syncthreads();
        for (int i = 0; i < 9; ++i) lru_unit<true>(F, ka, l, b, qt * 9 + i, blk, i);
    }
}
}

__global__ void __launch_bounds__(NWAVES * 64, 2) fwd(Args args) {
    extern __shared__ __attribute__((aligned(16))) unsigned char lds[];
    Frame F;
    F.lds = (LAS unsigned char*)lds; F.ldsg = (char*)lds;
    F.tid = threadIdx.x; F.lane = F.tid & 63; F.wave = __builtin_amdgcn_readfirstlane(F.tid >> 6); F.G = gridDim.x; F.wg = blockIdx.x;
    CArgs* const ka0 = (CArgs*)__builtin_amdgcn_kernarg_segment_ptr();
    unsigned char* ws; { CArgs* ka = ka0; ws = ka->ws; }
    volatile LAS unsigned* MISC = (volatile LAS unsigned*)(F.lds + MISC_OFF);
    if (F.tid < 64) ((LAS unsigned*)(F.lds + MISC_OFF))[F.tid] = 0u;
    __syncthreads();
    const int lo = ka0->ph_lo, hi = ka0->ph_hi;
    XcdBarrier bar; bar.bar = (unsigned*)(ws + WS_CTL) + CW_BAR; bar.x = 0; bar.st = nullptr;
    if (hi - lo > 1) bar = xcd_barrier_post((unsigned*)(ws + WS_CTL) + CW_BAR, MISC + 8);
#define IN(k) (lo <= (k) && (k) < hi)
#define SEAM(k) do { if ((k) + 1 < hi) xcd_barrier(bar); } while (0)

    if (IN(0)) { p_prologue(F, KA()); SEAM(0); }
#pragma unroll 1
    for (int l = 0; l < DEPTH; ++l) {
        const int base = 1 + l * PH_PER_LAYER; const bool need_ctx = l < DEPTH - 1;
        if (IN(base + 0)) { p_norm(F, KA(), l); SEAM(base + 0); }
        if (IN(base + 1)) {
            CArgs* ka = KA(); pg8::Gemm g{WSB(WS_H), WSB(WS_WIN) + (size_t)l * NP * DM, MROWS, NP, DM, 0, 0}; pg8::StaticOrder S; S.init(MROWS, NP, F.G, F.wg);
            pg8::EpiIn E{WSB(WS_P)};
            pg8::gemm_phase<pg8::EpiIn, pg8::StaticOrder, true, true>(F.lds, g, S, E);
            SEAM(base + 1);
        }
        if (IN(base + 2)) { p_prep(F, KA(), l);
#if USE_NAIVE_LRU
            p_lru_gates_naive(F, KA(), l);
#endif
            SEAM(base + 2); }
        if (IN(base + 3)) { p_attention(F, KA(), l, need_ctx);
#if USE_NAIVE_ML
            p_mlstm_naive(F, KA(), l);
#else
            for (int u = F.wg; u < 256; u += F.G) ml::mlstm_unit(F, KA(), u, need_ctx);
#endif
#if USE_NAIVE_LRU
            p_lru_scan_naive(F, KA());
#else
            lru::p_lru_agg(F, KA(), l);
#endif
            SEAM(base + 3); }
        if (IN(base + 4)) { p_mlout(F, KA(), l);
#if USE_NAIVE_LRU
            p_lru_combine_naive(F, KA());
#else
            lru::p_lru_final(F, KA(), l);
#endif
            SEAM(base + 4); }
        if (IN(base + 5)) {
            CArgs* ka = KA(); pg8::Gemm g{WSB(WS_YB), WSB(WS_WBR) + (size_t)l * 3 * DM * DM, MROWS, DM, DM, (size_t)MROWS * DM * 2, (size_t)DM * DM * 2}; pg8::MergeOrder S; S.init(MROWS, DM, F.G, F.wg);
            pg8::EpiMerge E{WSB(WS_P), WSF(WS_ACC), WSB(WS_G2)};
            pg8::gemm_phase<pg8::EpiMerge, pg8::MergeOrder, true, true>(F.lds, g, S, E);
            SEAM(base + 5);
        }
        if (IN(base + 6)) {
            CArgs* ka = KA(); pg8::Gemm g{WSB(WS_G2), WSB(WS_WOUT) + (size_t)l * DM * DM, MROWS, DM, DM, 0, 0}; pg8::StaticOrder S; S.init(MROWS, DM, F.G, F.wg);
            pg8::EpiF32 E{WSF(WS_Y), DM};
            pg8::gemm_phase<pg8::EpiF32, pg8::StaticOrder, true, true>(F.lds, g, S, E);
            SEAM(base + 6);
        }
    }
    if (IN(N_PHASES - 1)) p_norm(F, KA(), DEPTH);
#undef IN
#undef SEAM
}

extern "C" void kernel_launch(void* const* d_in, const int* in_sizes, int n_in, void* d_out, int out_size, void* d_ws, size_t ws_size, hipStream_t stream) {
    static int grid = 0;
    if (grid == 0) {
        if (n_in != 22 || in_sizes[0] != NBATCH * SEQ * DM || out_size != NBATCH * SEQ * DM || ws_size < WS_END) {
            fprintf(stderr, "kernel_launch: unexpected shapes: n_in %d in0 %d out %d ws %zu (need %zu)\n", n_in, n_in > 0 ? in_sizes[0] : -1, out_size, ws_size, (size_t)WS_END); grid = -1; return; }
        int dev = 0, cus = 0, per_cu = 0;
        if (hipGetDevice(&dev) != hipSuccess || hipDeviceGetAttribute(&cus, hipDeviceAttributeMultiprocessorCount, dev) != hipSuccess) { fprintf(stderr, "kernel_launch: device query failed\n"); grid = -1; return; }
        if (hipFuncSetAttribute((const void*)fwd, hipFuncAttributeMaxDynamicSharedMemorySize, LDS_BYTES) != hipSuccess) { fprintf(stderr, "kernel_launch: hipFuncSetAttribute failed\n"); grid = -1; return; }
        if (hipOccupancyMaxActiveBlocksPerMultiprocessor(&per_cu, (const void*)fwd, NWAVES * 64, LDS_BYTES) != hipSuccess || per_cu < 1)
            fprintf(stderr, "kernel_launch: note: occupancy query reports %d workgroups per CU\n", per_cu);
        (void)hipGetLastError();
        grid = cus;
    }
    if (grid < 0) return;
    if (hipMemsetAsync((char*)d_ws + WS_CTL, 0, CTL_ZERO_BYTES, stream) != hipSuccess) { fprintf(stderr, "kernel_launch: memset failed\n"); return; }
    Args a{};
    for (int i = 0; i < 22; ++i) a.in[i] = (const float*)d_in[i];
    a.out = (float*)d_out; a.ws = (unsigned char*)d_ws;
    if (MK_N_LAUNCHES == 1) { a.ph_lo = 0; a.ph_hi = N_PHASES; hipLaunchKernelGGL(fwd, dim3(grid), dim3(NWAVES * 64), LDS_BYTES, stream, a); }
    else for (int k = 0; k < N_PHASES; ++k) { a.ph_lo = k; a.ph_hi = k + 1; hipLaunchKernelGGL(fwd, dim3(grid), dim3(NWAVES * 64), LDS_BYTES, stream, a); }
    const hipError_t le = hipPeekAtLastError();
    if (le != hipSuccess) fprintf(stderr, "kernel_launch: launch failed: %s\n", hipGetErrorName(le));
}
```

```cpp
#include <hip/hip_runtime.h>
#include <hip/hip_bf16.h>
#include <cstdio>
#include <cstdint>

constexpr int DM = 2048, NBATCH = 4, SEQ = 2048, CTXL = 256, TPB = SEQ + CTXL  , MROWS = NBATCH * TPB  , DEPTH = 4;
constexpr int NIN = 25632, NP = 25600;
constexpr int C_LX = 0, C_LZ = 2048, C_MQ = 4096, C_MK = 6144, C_MV = 8192, C_MO = 10240, C_MZ = 12288, C_AQ = 14336, C_AK = 16384, C_AV = 16896, C_AZ = 17408, C_MG = 19456;
constexpr float EPS = 1e-6f;
namespace pg8 {
#define PG8_LAS __attribute__((address_space(3)))
typedef unsigned short bf16_t;
typedef short bf16x8 __attribute__((ext_vector_type(8)));
typedef float f32x4 __attribute__((ext_vector_type(4)));
typedef unsigned u32x4 __attribute__((ext_vector_type(4)));
constexpr int BM = 256, BK = 64, HALF = 128, HTB = HALF * BK * 2  , STAGE_BYTES = 8 * HTB, NXCD = 8, WGM = 8;

__host__ __device__ __forceinline__ int lds_byte(int r, int c) { const int st = (r >> 4) * 2 + (c >> 5), rr = r & 15, cc = c & 31, ob = rr * 64 + cc * 2; return st * 1024 + (ob ^ (((ob >> 9) & 1) << 5)); }
__host__ __device__ __forceinline__ void stage_rc(int b, int& R, int& C) { const int st = b / 1024, sb = b % 1024, swz = sb ^ (((sb >> 9) & 1) << 5); R = (st >> 1) * 16 + swz / 64; C = (st & 1) * 32 + (swz % 64) / 2; }
__host__ __device__ __forceinline__ int perm32(int rho) { const int n = rho >> 4, i = rho & 15; return 8 * (i >> 2) + 4 * n + (i & 3); }

struct Unit { int pm, pn, z; };
struct Gemm { const bf16_t* A; const bf16_t* Bt; int M, N, K; size_t zA, zB; };

struct StaticOrder {
    int nM, nN, nwg, G, c;
    __host__ __device__ void init(int M, int N, int G_, int c_, int tileN = BM) { nM = M / BM; nN = N / tileN; nwg = nM * nN; G = G_; c = c_; }
    __host__ __device__ bool next(int i, Unit& u) const {
        const long L = (long)i * G + c; if (L >= nwg) return false;
        int wgid = (int)L; { const int q = nwg / NXCD, r = nwg % NXCD, xcd = wgid % NXCD, off = wgid / NXCD; wgid = (xcd < r ? xcd * (q + 1) : r * (q + 1) + (xcd - r) * q) + off; }
        const int nig = WGM * nN, gid = wgid / nig, fm = gid * WGM, gsz = (nM - fm) < WGM ? (nM - fm) : WGM;
        u.pm = fm + ((wgid % nig) % gsz); u.pn = (wgid % nig) / gsz; u.z = 0; return true;
    }
    __device__ __forceinline__ void a_ready(const Unit&) const {}
    __device__ __forceinline__ void done(const Unit&) const {}
};
struct MergeOrder : StaticOrder {
    __host__ __device__ bool next(int i, Unit& u) const { const int it = i / 3; if (!StaticOrder::next(it, u)) return false; u.z = i - 3 * it; return true; }
};

__device__ __forceinline__ unsigned cvt_pk_bf16(float lo, float hi) { unsigned r; asm volatile("v_cvt_pk_bf16_f32 %0, %1, %2" : "=v"(r) : "v"(lo), "v"(hi)); return r; }
__device__ __forceinline__ float bflo(unsigned w) { return __uint_as_float(w << 16); }
__device__ __forceinline__ float bfhi(unsigned w) { return __uint_as_float(w & 0xffff0000u); }
__device__ __forceinline__ float sigmoid_f(float x) { return __builtin_amdgcn_rcpf(1.f + __expf(-x)); }

template <bool NHALF> struct EpiF32 {
    static constexpr bool PERM = false, AFTER_DRAIN = false;
    float* C; int ldc;
    __device__ __forceinline__ void operator()(const f32x4 (&acc)[2][2][4][2], const Unit& u, int wr, int wc, int fr, int fq) const {
        const int row0 = u.pm * BM + wr * 64 + fr, col0 = u.pn * (NHALF ? HALF : BM) + wc * 32 + 4 * fq;
#pragma unroll
        for (int ai = 0; ai < 2; ++ai)
#pragma unroll
            for (int m = 0; m < 4; ++m) { float* rowp = C + (size_t)(row0 + ai * HALF + m * 16) * ldc + col0;
#pragma unroll
                for (int bj = 0; bj < (NHALF ? 1 : 2); ++bj)
#pragma unroll
                    for (int n = 0; n < 2; ++n) *(f32x4*)(rowp + bj * HALF + n * 16) = acc[ai][bj][m][n]; }
    }
};
struct EpiIn {
    static constexpr bool PERM = true, AFTER_DRAIN = false;
    bf16_t* O;
    __device__ __forceinline__ void operator()(const f32x4 (&acc)[2][2][4][2], const Unit& u, int wr, int wc, int fr, int fq) const {
        const int row0 = u.pm * BM + wr * 64 + fr, col0 = u.pn * BM + wc * 32 + 8 * fq, pn = u.pn;
        int act = 0;
        if ((pn >= 8 && pn < 16) || (pn >= 48 && pn < 56) || (pn >= 68 && pn < 76)) act = 1;
        else if ((pn >= 40 && pn < 48) || pn >= 76) act = 2;
        else if (pn >= 24 && pn < 32) act = 3;
#pragma unroll
        for (int ai = 0; ai < 2; ++ai)
#pragma unroll
            for (int m = 0; m < 4; ++m) { bf16_t* rowp = O + (size_t)(row0 + ai * HALF + m * 16) * NP + col0;
#pragma unroll
                for (int bj = 0; bj < 2; ++bj) { f32x4 v0 = acc[ai][bj][m][0], v1 = acc[ai][bj][m][1];
                    if (act == 1) {
#pragma unroll
                        for (int j = 0; j < 4; ++j) { v0[j] = v0[j] * sigmoid_f(v0[j]); v1[j] = v1[j] * sigmoid_f(v1[j]); } }
                    else if (act == 2) {
#pragma unroll
                        for (int j = 0; j < 4; ++j) { v0[j] = sigmoid_f(v0[j]); v1[j] = sigmoid_f(v1[j]); } }
                    else if (act == 3) { v0 = v0 * 0.0625f; v1 = v1 * 0.0625f; }
                    u32x4 w; w.x = cvt_pk_bf16(v0[0], v0[1]); w.y = cvt_pk_bf16(v0[2], v0[3]); w.z = cvt_pk_bf16(v1[0], v1[1]); w.w = cvt_pk_bf16(v1[2], v1[3]);
                    *(u32x4*)(rowp + bj * HALF) = w; } }
    }
};
template <bool NHALF> struct EpiMerge {
    static constexpr bool PERM = true, AFTER_DRAIN = false;
    const bf16_t* P; float* ACC; bf16_t* G2;
    __device__ __forceinline__ void operator()(const f32x4 (&acc)[2][2][4][2], const Unit& u, int wr, int wc, int fr, int fq) const {
        const int row0 = u.pm * BM + wr * 64 + fr, col0 = u.pn * (NHALF ? HALF : BM) + wc * 32 + 8 * fq, z = u.z;
#pragma unroll
        for (int ai = 0; ai < 2; ++ai)
#pragma unroll
            for (int m = 0; m < 4; ++m) { const size_t r = (size_t)(row0 + ai * HALF + m * 16);
#pragma unroll
                for (int bj = 0; bj < (NHALF ? 1 : 2); ++bj) { const int c = col0 + bj * HALF;
                    const u32x4 g = *(const u32x4*)(P + r * NP + C_MG + z * DM + c);
                    f32x4 v0 = acc[ai][bj][m][0], v1 = acc[ai][bj][m][1];
                    v0[0] *= bflo(g.x); v0[1] *= bfhi(g.x); v0[2] *= bflo(g.y); v0[3] *= bfhi(g.y);
                    v1[0] *= bflo(g.z); v1[1] *= bfhi(g.z); v1[2] *= bflo(g.w); v1[3] *= bfhi(g.w);
                    float* ap = ACC + r * DM + c;
                    if (z > 0) { v0 = v0 + *(const f32x4*)ap; v1 = v1 + *(const f32x4*)(ap + 4); }
                    if (z < 2) { *(f32x4*)ap = v0; *(f32x4*)(ap + 4) = v1; }
                    else { u32x4 w; w.x = cvt_pk_bf16(v0[0], v0[1]); w.y = cvt_pk_bf16(v0[2], v0[3]); w.z = cvt_pk_bf16(v1[0], v1[1]); w.w = cvt_pk_bf16(v1[2], v1[3]);
                        *(u32x4*)(G2 + r * DM + c) = w; } } }
    }
};
template <class Epi, class Sched, bool ALIGN_EPI = false, bool SP2 = false, bool NHALF = false>
__device__ __forceinline__ void gemm_phase(PG8_LAS unsigned char* lds, const Gemm g, const Sched& S, const Epi& E) {
    int tid = threadIdx.x; asm volatile("" : "+v"(tid));
    const int wid = __builtin_amdgcn_readfirstlane(tid >> 6), lane = tid & 63, wr = wid >> 2, wc = wid & 3, fr = lane & 15, fq = lane >> 4;
    const int K = g.K, nt = K / BK;
    unsigned voffA[2], voffB[2];
#pragma unroll
    for (int i = 0; i < 2; ++i) { int R, C; stage_rc(tid * 16 + i * 8192, R, C); const int Rb = Epi::PERM ? ((R & ~31) + perm32(R & 31)) : R;
        voffA[i] = (unsigned)(R * K + C) * 2u; voffB[i] = (unsigned)(Rb * K + C) * 2u; }
    const size_t kstep = (size_t)(BK * 2);
    const size_t hstep = (size_t)HALF * K * 2;
    const size_t tstep = 2 * hstep;
    const size_t hsB = NHALF ? 0 : hstep, tstepB = NHALF ? hstep : tstep; static_assert(!NHALF || SP2, "NHALF is implemented for the SP2 loop");
    const unsigned ldsw = (unsigned)wid * 1024u;
    const int aoff = lds_byte(wr * 64 + fr, fq * 8), boff = lds_byte(wc * 32 + fr, fq * 8);
#define PG8_SA(b, h) (((b) * 2 + (h)) * HTB)
#define PG8_SB(b, h) ((4 + (b) * 2 + (h)) * HTB)
#define PG8_STAGE(bufoff, gbase, voff) do { _Pragma("unroll") for (int _i = 0; _i < 2; ++_i) \
        __builtin_amdgcn_global_load_lds((const unsigned*)((const char*)(gbase) + (voff)[_i]), (PG8_LAS unsigned*)(lds + (bufoff) + ldsw + _i * 8192), 16, 0, 0); } while (0)
#define PG8_LDA(dst, b, h) do { _Pragma("unroll") for (int m = 0; m < 4; ++m) _Pragma("unroll") for (int k = 0; k < 2; ++k) dst[m][k] = *(const PG8_LAS bf16x8*)(lds + PG8_SA(b, h) + aoff + m * 2048 + k * 1024); } while (0)
#define PG8_LDB(dst, b, h) do { _Pragma("unroll") for (int n = 0; n < 2; ++n) _Pragma("unroll") for (int k = 0; k < 2; ++k) dst[n][k] = *(const PG8_LAS bf16x8*)(lds + PG8_SB(b, h) + boff + n * 2048 + k * 1024); } while (0)
#define PG8_MMA(ai, bj, At, Bt) do { __builtin_amdgcn_s_setprio(1); _Pragma("unroll") for (int m = 0; m < 4; ++m) _Pragma("unroll") for (int n = 0; n < 2; ++n) _Pragma("unroll") for (int k = 0; k < 2; ++k) \
        acc[ai][bj][m][n] = __builtin_amdgcn_mfma_f32_16x16x32_bf16(Bt[n][k], At[m][k], acc[ai][bj][m][n], 0, 0, 0); __builtin_amdgcn_s_setprio(0); } while (0)
#define PG8_WAIT_V(n) asm volatile("s_waitcnt vmcnt(" #n ")" ::: "memory")
#define PG8_WAIT_L(n) asm volatile("s_waitcnt lgkmcnt(" #n ")" ::: "memory")
#define PG8_BAR __builtin_amdgcn_s_barrier()
#define PG8_SCHED __builtin_amdgcn_sched_barrier(0)
    Unit cur, nxt; int ui = 0;
    if (!S.next(0, cur)) return;
    f32x4 acc[2][2][4][2];
#pragma unroll
    for (int a = 0; a < 2; ++a)
#pragma unroll
        for (int b = 0; b < 2; ++b)
#pragma unroll
            for (int m = 0; m < 4; ++m)
#pragma unroll
                for (int n = 0; n < 2; ++n) acc[a][b][m][n] = (f32x4){0.f, 0.f, 0.f, 0.f};
    bf16x8 At[4][2], B0[2][2], B1[2][2];
    const char* cA = (const char*)g.A + (size_t)cur.z * g.zA + (size_t)cur.pm * tstep; const char* cB = (const char*)g.Bt + (size_t)cur.z * g.zB + (size_t)cur.pn * tstepB;
    S.a_ready(cur);
    if constexpr (SP2) {
        PG8_STAGE(PG8_SB(0, 0), cB, voffB); PG8_STAGE(PG8_SB(0, 1), cB + hsB, voffB); PG8_STAGE(PG8_SA(0, 0), cA, voffA); PG8_STAGE(PG8_SA(0, 1), cA + hstep, voffA);
        if (wr == 1) PG8_BAR;
        PG8_WAIT_V(2); PG8_BAR;
        PG8_STAGE(PG8_SB(1, 0), cB + kstep, voffB); PG8_STAGE(PG8_SA(1, 0), cA + kstep, voffA); PG8_STAGE(PG8_SB(1, 1), cB + hsB + kstep, voffB);
        PG8_WAIT_V(6); PG8_BAR;
    } else {
        PG8_STAGE(PG8_SB(0, 0), cB, voffB); PG8_STAGE(PG8_SA(0, 0), cA, voffA); PG8_STAGE(PG8_SB(0, 1), cB + hstep, voffB); PG8_STAGE(PG8_SA(0, 1), cA + hstep, voffA);
        if (wr == 1) PG8_BAR;
        PG8_WAIT_V(4); PG8_BAR;
        PG8_STAGE(PG8_SB(1, 0), cB + kstep, voffB); PG8_STAGE(PG8_SA(1, 0), cA + kstep, voffA); PG8_STAGE(PG8_SB(1, 1), cB + hstep + kstep, voffB);
        PG8_WAIT_V(6); PG8_BAR;
    }
    for (;;) {
        const bool has_next = S.next(ui + 1, nxt);
        const char* nA = has_next ? (const char*)g.A + (size_t)nxt.z * g.zA + (size_t)nxt.pm * tstep : cA; const char* nB = has_next ? (const char*)g.Bt + (size_t)nxt.z * g.zB + (size_t)nxt.pn * tstepB : cB;
        for (int t = 0; t < nt; t += 2) {
            const bool last = (t == nt - 2);
            const char* a1 = cA + (size_t)(t + 1) * kstep;
            const char* a2 = last ? nA : cA + (size_t)(t + 2) * kstep; const char* b2 = last ? nB : cB + (size_t)(t + 2) * kstep;
            const char* a3 = a2 + kstep; const char* b3 = b2 + kstep;
            if (last && has_next) S.a_ready(nxt);
            if constexpr (SP2) {
            PG8_LDB(B0, 0, 0); if constexpr (!NHALF) PG8_LDB(B1, 0, 1); PG8_SCHED; PG8_LDA(At, 0, 0); PG8_STAGE(PG8_SA(1, 1), a1 + hstep, voffA);
            PG8_WAIT_V(8); PG8_WAIT_L(0); PG8_BAR; PG8_MMA(0, 0, At, B0); if constexpr (!NHALF) PG8_MMA(0, 1, At, B1); PG8_BAR; PG8_SCHED;
            PG8_LDA(At, 0, 1); PG8_STAGE(PG8_SB(0, 0), b2, voffB); PG8_STAGE(PG8_SB(0, 1), b2 + hsB, voffB); PG8_STAGE(PG8_SA(0, 0), a2, voffA);
            PG8_WAIT_V(8); PG8_WAIT_L(0); PG8_BAR; PG8_MMA(1, 0, At, B0); if constexpr (!NHALF) PG8_MMA(1, 1, At, B1); PG8_BAR; PG8_SCHED;
            PG8_LDB(B0, 1, 0); if constexpr (!NHALF) PG8_LDB(B1, 1, 1); PG8_SCHED; PG8_LDA(At, 1, 0); PG8_STAGE(PG8_SA(0, 1), a2 + hstep, voffA);
            PG8_WAIT_V(8); PG8_WAIT_L(0); PG8_BAR; PG8_MMA(0, 0, At, B0); if constexpr (!NHALF) PG8_MMA(0, 1, At, B1); PG8_BAR; PG8_SCHED;
            PG8_LDA(At, 1, 1); PG8_STAGE(PG8_SB(1, 0), b3, voffB); PG8_STAGE(PG8_SB(1, 1), b3 + hsB, voffB); PG8_STAGE(PG8_SA(1, 0), a3, voffA);
            PG8_WAIT_V(8); PG8_WAIT_L(0); PG8_BAR; PG8_MMA(1, 0, At, B0); if constexpr (!NHALF) PG8_MMA(1, 1, At, B1); PG8_BAR; PG8_SCHED;
            } else {
            PG8_LDB(B0, 0, 0); PG8_SCHED; PG8_LDA(At, 0, 0); PG8_STAGE(PG8_SA(1, 1), a1 + hstep, voffA);
            PG8_WAIT_L(8); PG8_BAR; PG8_WAIT_L(0); PG8_MMA(0, 0, At, B0); PG8_BAR; PG8_SCHED;
            PG8_LDB(B1, 0, 1); PG8_STAGE(PG8_SB(0, 0), b2, voffB);
            PG8_BAR; PG8_WAIT_L(0); PG8_MMA(0, 1, At, B1); PG8_BAR;
            PG8_LDA(At, 0, 1); PG8_STAGE(PG8_SA(0, 0), a2, voffA);
            PG8_BAR; PG8_WAIT_L(0); PG8_MMA(1, 0, At, B0); PG8_BAR; PG8_SCHED;
            PG8_STAGE(PG8_SB(0, 1), b2 + hstep, voffB);
            PG8_WAIT_V(6); PG8_BAR; PG8_MMA(1, 1, At, B1); PG8_BAR;
            PG8_LDB(B0, 1, 0); PG8_SCHED; PG8_LDA(At, 1, 0); PG8_STAGE(PG8_SA(0, 1), a2 + hstep, voffA);
            PG8_WAIT_L(8); PG8_BAR; PG8_WAIT_L(0); PG8_MMA(0, 0, At, B0); PG8_BAR; PG8_SCHED;
            PG8_LDB(B1, 1, 1); PG8_STAGE(PG8_SB(1, 0), b3, voffB);
            PG8_BAR; PG8_WAIT_L(0); PG8_MMA(0, 1, At, B1); PG8_BAR;
            PG8_LDA(At, 1, 1); PG8_STAGE(PG8_SA(1, 0), a3, voffA);
            PG8_BAR; PG8_WAIT_L(0); PG8_MMA(1, 0, At, B0); PG8_BAR; PG8_SCHED;
            PG8_STAGE(PG8_SB(1, 1), b3 + hstep, voffB);
            PG8_WAIT_V(6); PG8_BAR; PG8_MMA(1, 1, At, B1); PG8_BAR;
            }
        }
        if constexpr (ALIGN_EPI) { if (wr == 0) PG8_BAR; }
        if constexpr (!Epi::AFTER_DRAIN) { E(acc, cur, wr, wc, fr, fq); S.done(cur); }
        if (!has_next) break;
#pragma unroll
        for (int a = 0; a < 2; ++a)
#pragma unroll
            for (int b = 0; b < 2; ++b)
#pragma unroll
                for (int m = 0; m < 4; ++m)
#pragma unroll
                    for (int n = 0; n < 2; ++n) acc[a][b][m][n] = (f32x4){0.f, 0.f, 0.f, 0.f};
        cur = nxt; cA = nA; cB = nB; ++ui;
        if constexpr (ALIGN_EPI) { if (wr == 1) PG8_BAR; }
    }
    PG8_WAIT_V(0);
    if constexpr (!ALIGN_EPI) { if (wr == 0) PG8_BAR; }
    PG8_BAR;
    if constexpr (Epi::AFTER_DRAIN) { E.fused(acc, cur, wr, wc, fr, fq, lds, wid, lane); S.done(cur); }
#undef PG8_SA
#undef PG8_SB
#undef PG8_STAGE
#undef PG8_LDA
#undef PG8_LDB
#undef PG8_MMA
#undef PG8_WAIT_V
#undef PG8_WAIT_L
#undef PG8_BAR
#undef PG8_SCHED
}
}

namespace att {
using bf16 = __hip_bfloat16;
constexpr int   D = 128, NW = 8, QBLK = 32, KVBLK = 64;
constexpr float SCALE = 0.088388347648318440f;
constexpr float THR = 8.f;
#ifndef ATT_SDEPTH
#define ATT_SDEPTH 1
#endif
constexpr int SDEPTH = ATT_SDEPTH;
constexpr int LDQ = NP, LDK = NP, LDO = DM;
constexpr size_t SHM_V = KVBLK * D * 2, SHM_K = KVBLK * D * 2, SHM_ATTN = 2 * SHM_V + 2 * SHM_K + NW * 64 * 4;
constexpr int OST_OFF = 69632, OST_END = OST_OFF + NW * 32 * 272;
using bf16x8 = __attribute__((ext_vector_type(8))) short;
using s16x4  = __attribute__((ext_vector_type(4))) short;
using f32x16 = __attribute__((ext_vector_type(16))) float;
using f32x4  = __attribute__((ext_vector_type(4))) float;
using u32x4  = __attribute__((ext_vector_type(4))) unsigned;
#define KSWZ(row, colB) ((row) * 256 + ((colB) ^ (((row) & 7) << 4)))
#define SBAR() __builtin_amdgcn_sched_barrier(0)
__device__ __forceinline__ int crow(int r, int hi) { return (r & 3) + 8 * (r >> 2) + 4 * hi; }
__device__ __forceinline__ unsigned cvtpk(float lo, float hi) { unsigned r; asm volatile("v_cvt_pk_bf16_f32 %0, %1, %2" : "=v"(r) : "v"(lo), "v"(hi)); return r; }
__device__ __forceinline__ bf16x8 ld8(const bf16* p) { return *reinterpret_cast<const bf16x8*>(p); }

__device__ __forceinline__ void partialSM(f32x16& p0, f32x16& p1, float& m_reg, float& mn, float& alpha) {
  constexpr float C = SCALE * 1.4426950408889634f;
  float pmax = p0[0];
#pragma unroll
  for (int r = 1; r < 16; ++r) pmax = fmaxf(pmax, p0[r]);
#pragma unroll
  for (int r = 0; r < 16; ++r) pmax = fmaxf(pmax, p1[r]);
  { auto rr = __builtin_amdgcn_permlane32_swap(__float_as_uint(pmax), __float_as_uint(pmax), false, false);
    pmax = fmaxf(__uint_as_float(rr[0]), __uint_as_float(rr[1])); }
  if (__builtin_expect(__all(pmax - m_reg <= THR / SCALE), 1)) { mn = m_reg; alpha = 1.f; }
  else { mn = fmaxf(m_reg, pmax); alpha = __builtin_amdgcn_exp2f((m_reg - mn) * C); m_reg = mn; }
  float mnC = -mn * C;
#pragma unroll
  for (int r = 0; r < 16; ++r) p0[r] = fmaf(p0[r], C, mnC);
#pragma unroll
  for (int r = 0; r < 16; ++r) p1[r] = fmaf(p1[r], C, mnC);
#pragma unroll
  for (int r = 0; r < 16; ++r) p0[r] = __builtin_amdgcn_exp2f(p0[r]);
}
__device__ __forceinline__ void finishSM(f32x16& p0, f32x16& p1, float alpha, float& l_reg, bf16x8& pa0, bf16x8& pa1, bf16x8& pa2, bf16x8& pa3) {
#pragma unroll
  for (int r = 0; r < 16; ++r) p1[r] = __builtin_amdgcn_exp2f(p1[r]);
  float ps = 0;
#pragma unroll
  for (int r = 0; r < 16; ++r) ps += p0[r];
#pragma unroll
  for (int r = 0; r < 16; ++r) ps += p1[r];
  { auto rr = __builtin_amdgcn_permlane32_swap(__float_as_uint(ps), __float_as_uint(ps), false, false);
    ps = __uint_as_float(rr[0]) + __uint_as_float(rr[1]); }
  l_reg = l_reg * alpha + ps;
#define PK4(P, BASE, OUT) do { unsigned a0 = cvtpk(P[BASE + 0], P[BASE + 1]), a1 = cvtpk(P[BASE + 2], P[BASE + 3]);   \
    unsigned b0 = cvtpk(P[BASE + 4], P[BASE + 5]), b1 = cvtpk(P[BASE + 6], P[BASE + 7]);                              \
    auto r0 = __builtin_amdgcn_permlane32_swap(a0, b0, false, false); auto r1 = __builtin_amdgcn_permlane32_swap(a1, b1, false, false); \
    u32x4 w = {r0[0], r1[0], r0[1], r1[1]}; OUT = *reinterpret_cast<bf16x8*>(&w); } while (0)
  PK4(p0, 0, pa0); PK4(p0, 8, pa1); PK4(p1, 0, pa2); PK4(p1, 8, pa3);
#undef PK4
}
__device__ __forceinline__ void qkt(f32x16& p0, f32x16& p1, const bf16* Ks, const bf16x8* qr, int r32, int hi) {
  p0 = f32x16{}; p1 = f32x16{};
#pragma unroll
  for (int d0 = 0; d0 < 8; ++d0) { int cb = (d0 * 16 + hi * 8) * 2;
    bf16x8 b0 = *reinterpret_cast<const bf16x8*>((const char*)Ks + KSWZ(r32, cb));
    bf16x8 b1 = *reinterpret_cast<const bf16x8*>((const char*)Ks + KSWZ(32 + r32, cb));
    p0 = __builtin_amdgcn_mfma_f32_32x32x16_bf16(b0, qr[d0], p0, 0, 0, 0);
    p1 = __builtin_amdgcn_mfma_f32_32x32x16_bf16(b1, qr[d0], p1, 0, 0, 0); }
}
__device__ __forceinline__ int v_st(int k, int c) { const int kk = (k & ~0xC) | ((k & 4) << 1) | ((k & 8) >> 1); return ((kk >> 3) * 4 + (c >> 5)) * 512 + ((kk & 7) * 32 + (c & 31)) * 2; }
__device__ __forceinline__ int v_rd_base(int lane) { return ((lane & 3) << 3) | (((lane >> 2) & 3) << 6) | (((lane >> 4) & 1) << 5) | (((lane >> 5) & 1) << 8); }
constexpr int v_rd_off(int d0, int ks, int half) { return d0 * 512 + ks * 4096 + half * 2048; }
template <int OFF> __device__ __forceinline__ s16x4 tr_read(int vb) {
  s16x4 r; asm volatile("ds_read_b64_tr_b16 %0, %1 offset:%2" : "=&v"(r) : "v"(vb), "i"(OFF) : "memory"); return r;
}
template <int D0> __device__ __forceinline__ void pv_one(f32x16& od, int vb, bf16x8 pa0, bf16x8 pa1, bf16x8 pa2, bf16x8 pa3) {
  const s16x4 l0 = tr_read<v_rd_off(D0, 0, 0)>(vb), h0 = tr_read<v_rd_off(D0, 0, 1)>(vb), l1 = tr_read<v_rd_off(D0, 1, 0)>(vb), h1 = tr_read<v_rd_off(D0, 1, 1)>(vb);
  const s16x4 l2 = tr_read<v_rd_off(D0, 2, 0)>(vb), h2 = tr_read<v_rd_off(D0, 2, 1)>(vb), l3 = tr_read<v_rd_off(D0, 3, 0)>(vb), h3 = tr_read<v_rd_off(D0, 3, 1)>(vb);
  asm volatile("s_waitcnt lgkmcnt(0)" ::: "memory"); SBAR();
#define PK(L, H) (bf16x8){L[0], L[1], L[2], L[3], H[0], H[1], H[2], H[3]}
  od = __builtin_amdgcn_mfma_f32_32x32x16_bf16(pa0, PK(l0, h0), od, 0, 0, 0);
  od = __builtin_amdgcn_mfma_f32_32x32x16_bf16(pa1, PK(l1, h1), od, 0, 0, 0);
  od = __builtin_amdgcn_mfma_f32_32x32x16_bf16(pa2, PK(l2, h2), od, 0, 0, 0);
  od = __builtin_amdgcn_mfma_f32_32x32x16_bf16(pa3, PK(l3, h3), od, 0, 0, 0);
#undef PK
}
__device__ __forceinline__ void pv_d0(f32x16* o, int vb, bf16x8 pa0, bf16x8 pa1, bf16x8 pa2, bf16x8 pa3) {
  pv_one<0>(o[0], vb, pa0, pa1, pa2, pa3); pv_one<1>(o[1], vb, pa0, pa1, pa2, pa3); pv_one<2>(o[2], vb, pa0, pa1, pa2, pa3); pv_one<3>(o[3], vb, pa0, pa1, pa2, pa3);
}

__device__ __forceinline__ void attn_unit(const bf16* __restrict__ Qb, const bf16* __restrict__ Kh, const bf16* __restrict__ Vh, const bf16* __restrict__ Zb,
                                          bf16* __restrict__ Ob, int seq, char* lds, const float* __restrict__ qn, const float* __restrict__ cs, const float* __restrict__ sn) {
  int tid = threadIdx.x; asm volatile("" : "+v"(tid));
  int wid = tid >> 6, lane = tid & 63, r32 = lane & 31, hi = lane >> 5;
  bf16* V_lds = (bf16*)lds; bf16* K_lds = (bf16*)(lds + 2 * SHM_V);
  float* ws = (float*)(lds + 2 * SHM_V + 2 * SHM_K) + wid * 64; float* li_l = ws; float* al_l = ws + 32;
  float m_reg = -1e30f, l_reg = 0; f32x16 o[4] = {}; bf16x8 qr[8];
  {
    const bf16* Qw = Qb + (long)(wid * QBLK + r32) * LDQ + hi * 8;
    float ss = 0.f;
#pragma unroll
    for (int d0 = 0; d0 < 8; ++d0) { const u32x4 w = *reinterpret_cast<const u32x4*>(Qw + d0 * 16); qr[d0] = __builtin_bit_cast(bf16x8, w);
#pragma unroll
      for (int e = 0; e < 4; ++e) { const float lo = __uint_as_float(w[e] << 16), hh = __uint_as_float(w[e] & 0xffff0000u); ss += lo * lo + hh * hh; } }
    { auto rr = __builtin_amdgcn_permlane32_swap(__float_as_uint(ss), __float_as_uint(ss), false, false); ss = __uint_as_float(rr[0]) + __uint_as_float(rr[1]); }
    const float rs = rsqrtf(ss * (1.f / 128.f) + EPS);
    const float* cp = cs ? cs + (long)(wid * QBLK + r32) * 64 + hi * 8 : nullptr; const float* sp = cs ? sn + (long)(wid * QBLK + r32) * 64 + hi * 8 : nullptr;
#pragma unroll
    for (int d0 = 0; d0 < 4; ++d0) {
      const u32x4 wa = __builtin_bit_cast(u32x4, qr[d0]), wb = __builtin_bit_cast(u32x4, qr[d0 + 4]); float x1[8], x2[8];
#pragma unroll
      for (int e = 0; e < 4; ++e) { x1[2 * e] = __uint_as_float(wa[e] << 16); x1[2 * e + 1] = __uint_as_float(wa[e] & 0xffff0000u); x2[2 * e] = __uint_as_float(wb[e] << 16); x2[2 * e + 1] = __uint_as_float(wb[e] & 0xffff0000u); }
      const f32x4 ga0 = *reinterpret_cast<const f32x4*>(qn + d0 * 16 + hi * 8), ga1 = *reinterpret_cast<const f32x4*>(qn + d0 * 16 + hi * 8 + 4);
      const f32x4 gb0 = *reinterpret_cast<const f32x4*>(qn + 64 + d0 * 16 + hi * 8), gb1 = *reinterpret_cast<const f32x4*>(qn + 64 + d0 * 16 + hi * 8 + 4);
#pragma unroll
      for (int e = 0; e < 8; ++e) { x1[e] *= rs * (e < 4 ? ga0[e & 3] : ga1[e & 3]); x2[e] *= rs * (e < 4 ? gb0[e & 3] : gb1[e & 3]); }
      if (cs) {
        const f32x4 c0 = *reinterpret_cast<const f32x4*>(cp + d0 * 16), c1 = *reinterpret_cast<const f32x4*>(cp + d0 * 16 + 4);
        const f32x4 s0 = *reinterpret_cast<const f32x4*>(sp + d0 * 16), s1 = *reinterpret_cast<const f32x4*>(sp + d0 * 16 + 4);
#pragma unroll
        for (int e = 0; e < 8; ++e) { const float c = e < 4 ? c0[e & 3] : c1[e & 3], sv = e < 4 ? s0[e & 3] : s1[e & 3];
          const float a = x1[e], bq = x2[e]; x1[e] = a * c - bq * sv; x2[e] = bq * c + a * sv; }
      }
      const u32x4 oa = {cvtpk(x1[0], x1[1]), cvtpk(x1[2], x1[3]), cvtpk(x1[4], x1[5]), cvtpk(x1[6], x1[7])}, ob = {cvtpk(x2[0], x2[1]), cvtpk(x2[2], x2[3]), cvtpk(x2[4], x2[5]), cvtpk(x2[6], x2[7])};
      qr[d0] = __builtin_bit_cast(bf16x8, oa); qr[d0 + 4] = __builtin_bit_cast(bf16x8, ob);
      asm volatile("" ::: "memory");
    }
  }
  const int sr = tid >> 4, sc = (tid & 15) * 8, vst0 = v_st(sr, sc), vst1 = v_st(32 + sr, sc);
  const int vb0 = (int)(uintptr_t)V_lds + v_rd_base(lane);
  struct { bf16x8 vs0, vs1, ks0, ks1; } sr_[SDEPTH];
#define SLOAD(i, k0) do { sr_[i].vs0 = ld8(&Vh[(long)((k0) + sr) * LDK + sc]); sr_[i].vs1 = ld8(&Vh[(long)((k0) + 32 + sr) * LDK + sc]); \
    sr_[i].ks0 = ld8(&Kh[(long)((k0) + sr) * LDK + sc]); sr_[i].ks1 = ld8(&Kh[(long)((k0) + 32 + sr) * LDK + sc]); } while (0)
#define SWRITE(b, i) do { *(bf16x8*)((char*)V_lds + (b) * SHM_V + vst0) = sr_[i].vs0;          \
    *(bf16x8*)((char*)V_lds + (b) * SHM_V + vst1) = sr_[i].vs1; int kc = sc * 2;               \
    *(bf16x8*)((char*)K_lds + (b) * SHM_K + KSWZ(sr, kc)) = sr_[i].ks0;                       \
    *(bf16x8*)((char*)K_lds + (b) * SHM_K + KSWZ(32 + sr, kc)) = sr_[i].ks1; } while (0)
#define SWAIT() do { if constexpr (SDEPTH == 2) asm volatile("s_waitcnt vmcnt(4)" ::: "memory"); else asm volatile("s_waitcnt vmcnt(0)" ::: "memory"); } while (0)
#define RESC(a) do { if (__any((a) < 1.f)) { if (hi == 0) al_l[r32] = (a); asm volatile("s_waitcnt lgkmcnt(0)" ::: "memory"); \
    _Pragma("unroll") for (int d = 0; d < 4; ++d) _Pragma("unroll") for (int r = 0; r < 16; ++r) o[d][r] *= al_l[crow(r, hi)]; } } while (0)
  f32x16 pA0, pA1, pB0, pB1; float mnA, mnB, alA, alB; bf16x8 pa0, pa1, pa2, pa3; const int NT = seq / KVBLK;
  constexpr int SE = 0, SO = SDEPTH - 1;
  SLOAD(SE, 0); asm volatile("s_waitcnt vmcnt(0)" ::: "memory"); SWRITE(0, SE); __syncthreads();
  qkt(pA0, pA1, K_lds, qr, r32, hi); partialSM(pA0, pA1, m_reg, mnA, alA);
  SLOAD(SO, KVBLK); if constexpr (SDEPTH == 2) { if (2 < NT) SLOAD(SE, 2 * KVBLK); }
  SWAIT(); SWRITE(1, SO); __syncthreads();
  for (int j = 1; j + 1 < NT; j += 2) {
    SBAR(); qkt(pB0, pB1, (bf16*)((char*)K_lds + SHM_K), qr, r32, hi);
    finishSM(pA0, pA1, alA, l_reg, pa0, pa1, pa2, pa3); SBAR();
    SLOAD(SO, (j + SDEPTH) * KVBLK); SBAR();
    pv_d0(o, vb0, pa0, pa1, pa2, pa3); partialSM(pB0, pB1, m_reg, mnB, alB);
    __syncthreads(); SWAIT(); SWRITE(0, SE);
    RESC(alB); __syncthreads();
    SBAR(); qkt(pA0, pA1, K_lds, qr, r32, hi);
    finishSM(pB0, pB1, alB, l_reg, pa0, pa1, pa2, pa3); SBAR();
    if (SDEPTH == 1 || j + 3 < NT) SLOAD(SE, (j + 1 + SDEPTH) * KVBLK); SBAR();
    pv_d0(o, vb0 + (int)SHM_V, pa0, pa1, pa2, pa3); partialSM(pA0, pA1, m_reg, mnA, alA);
    __syncthreads(); SWAIT(); SWRITE(1, SO);
    RESC(alA); __syncthreads();
  }
  SBAR(); qkt(pB0, pB1, (bf16*)((char*)K_lds + SHM_K), qr, r32, hi);
  finishSM(pA0, pA1, alA, l_reg, pa0, pa1, pa2, pa3); SBAR();
  pv_d0(o, vb0, pa0, pa1, pa2, pa3); partialSM(pB0, pB1, m_reg, mnB, alB);
  __syncthreads(); RESC(alB);
  finishSM(pB0, pB1, alB, l_reg, pa0, pa1, pa2, pa3); SBAR();
  pv_d0(o, vb0 + (int)SHM_V, pa0, pa1, pa2, pa3);
  if (hi == 0) li_l[r32] = l_reg; asm volatile("s_waitcnt lgkmcnt(0)" ::: "memory");
  { int tz = threadIdx.x; asm volatile("" : "+v"(tz)); wid = tz >> 6; lane = tz & 63; r32 = lane & 31; hi = lane >> 5; }
  float rli[16];
#pragma unroll
  for (int r = 0; r < 16; ++r) rli[r] = __builtin_amdgcn_rcpf(li_l[crow(r, hi)]);
  char* ost = lds + OST_OFF + wid * (32 * 272);
#pragma unroll
  for (int r = 0; r < 16; ++r) { const int orow = crow(r, hi);
#pragma unroll
    for (int d0 = 0; d0 < 4; ++d0) *(bf16*)(ost + orow * 272 + (d0 * 32 + r32) * 2) = __float2bfloat16(o[d0][r] * rli[r]); }
  asm volatile("s_waitcnt lgkmcnt(0)" ::: "memory");
  bf16* Ow = Ob + (long)(wid * QBLK) * LDO; const bf16* Zw = Zb + (long)(wid * QBLK) * LDQ;
#pragma unroll
  for (int hb = 0; hb < 2; ++hb) {
    u32x4 ov[4], zv[4];
#pragma unroll
    for (int i = 0; i < 4; ++i) { const int c = (hb * 4 + i) * 64 + lane, row = c >> 4, col = (c & 15) * 8;
      ov[i] = *reinterpret_cast<const u32x4*>(ost + row * 272 + col * 2); zv[i] = *reinterpret_cast<const u32x4*>(Zw + (long)row * LDQ + col); }
#pragma unroll
    for (int i = 0; i < 4; ++i) { const int c = (hb * 4 + i) * 64 + lane, row = c >> 4, col = (c & 15) * 8; u32x4 w;
#pragma unroll
      for (int e = 0; e < 4; ++e) { const unsigned a = ov[i][e], z = zv[i][e];
        w[e] = cvtpk(__uint_as_float(a << 16) * __uint_as_float(z << 16), __uint_as_float(a & 0xffff0000u) * __uint_as_float(z & 0xffff0000u)); }
      *reinterpret_cast<u32x4*>(Ow + (long)row * LDO + col) = w; }
  }
  __syncthreads();
#undef SLOAD
#undef SWRITE
#undef SWAIT
#undef RESC
}
}

constexpr int NWAVES = 8;
#ifndef MK_N_LAUNCHES
#define MK_N_LAUNCHES 1
#endif
constexpr int PH_PER_LAYER = 7, N_PHASES = 2 + DEPTH * PH_PER_LAYER;
constexpr size_t MiB = 1u << 20;
constexpr size_t WS_CTL = 0, CTL_ZERO_BYTES = 1 * MiB;
constexpr size_t WS_MOD = 1 * MiB;
constexpr size_t WS_ROPE = WS_MOD + MiB / 2;
constexpr size_t WS_WG = 3 * MiB;
constexpr size_t WS_WLRU = 4 * MiB;
constexpr size_t WS_WOUT = 12 * MiB;
constexpr size_t WS_WBR = 44 * MiB;
constexpr size_t WS_WIN = 140 * MiB;
constexpr size_t WS_X = 540 * MiB;
constexpr size_t WS_Y = 612 * MiB;
constexpr size_t WS_H = 684 * MiB;
constexpr size_t WS_G2 = 720 * MiB;
constexpr size_t WS_YB = 756 * MiB;
constexpr size_t WS_ACC = 864 * MiB;
constexpr size_t WS_GT = 936 * MiB;
constexpr size_t WS_MH = 938 * MiB;
constexpr size_t WS_P = 1082 * MiB;
constexpr size_t WS_LA = 1532 * MiB;
constexpr size_t WS_LB = 1676 * MiB;
constexpr size_t WS_HL = 1820 * MiB;
constexpr size_t WS_GSC = 1964 * MiB;
constexpr size_t WS_END = 1968 * MiB;
constexpr int CW_BAR = 4096;
constexpr int RING_BYTES = 131072, LDS_BYTES = 147456, MISC_OFF = LDS_BYTES - 256;
static_assert(att::OST_END <= MISC_OFF, "LDS map");

#define GAS __attribute__((address_space(1)))
#define LAS __attribute__((address_space(3)))
typedef unsigned short bf16_t;
typedef unsigned v4u __attribute__((ext_vector_type(4)));
typedef unsigned v2u __attribute__((ext_vector_type(2)));
typedef float f32x4 __attribute__((ext_vector_type(4)));
#define LDS_WAIT() asm volatile("s_waitcnt lgkmcnt(0)" ::: "memory")
__device__ __forceinline__ unsigned f2bf(float f) { unsigned u = __builtin_bit_cast(unsigned, f); return (u + 0x7fffu + ((u >> 16) & 1u)) >> 16; }
__device__ __forceinline__ unsigned pk2(float lo, float hi) { return f2bf(lo) | (f2bf(hi) << 16); }
__device__ __forceinline__ float bf2f(bf16_t b) { return __uint_as_float((unsigned)b << 16); }
__device__ __forceinline__ float blo(unsigned w) { return __uint_as_float(w << 16); }
__device__ __forceinline__ float bhi(unsigned w) { return __uint_as_float(w & 0xffff0000u); }
__device__ __forceinline__ float lane_get(float v, int src) { return __builtin_bit_cast(float, __builtin_amdgcn_ds_bpermute(src << 2, __builtin_bit_cast(int, v))); }
__device__ __forceinline__ float lane_xor(float v, int mask, int lane) { return lane_get(v, lane ^ mask); }
__device__ __forceinline__ float lane_up(float v, int delta, int lane) { return lane_get(v, lane >= delta ? lane - delta : lane); }
__device__ __forceinline__ float wave_sum(float v, int lane) {
#pragma unroll
    for (int o = 1; o < 64; o <<= 1) v += lane_xor(v, o, lane);
    return v;
}
#define XB_TMO      128
#define XB_XCNT(j)  (256  + 64 * (j))
#define XB_XSUB(j)  (1280 + 64 * (j))
#define XB_XGEN(j)  (2304 + 64 * (j))
#define XB_TOP      3328
#define XB_TOPGEN   3392
#define XCD_BAR_WORDS 3456
#define XB_SPIN_CAP (1u << 18)

__device__ __forceinline__ unsigned xb_ld(unsigned* p)              { return __hip_atomic_load(p, __ATOMIC_RELAXED, __HIP_MEMORY_SCOPE_AGENT); }
__device__ __forceinline__ unsigned xb_add(unsigned* p, unsigned v) { return __hip_atomic_fetch_add(p, v, __ATOMIC_RELAXED, __HIP_MEMORY_SCOPE_AGENT); }
__device__ __forceinline__ unsigned xb_xcc_id() { return (unsigned)__builtin_amdgcn_s_getreg((3 << 11) | 20) & 0xFu; }
#define XB_SPIN(cond, bar) do { unsigned _sp = 0; while (cond) { __builtin_amdgcn_s_sleep(1); \
    if ((++_sp & 255u) == 0u) { if (xb_ld(&(bar)[XB_TMO])) break; if (_sp > XB_SPIN_CAP) { atomicAdd(&(bar)[XB_TMO], 1u); break; } } } } while (0)

struct XcdBarrier {
    unsigned* bar; unsigned x;
    volatile LAS unsigned* st;
};

__device__ __forceinline__ XcdBarrier xcd_barrier_post(unsigned* bar, volatile LAS unsigned* st) {
    XcdBarrier b; b.bar = bar; b.x = xb_xcc_id(); b.st = st;
    if (threadIdx.x == 0) (void)xb_add(&bar[XB_XCNT(b.x)], 1u);
    return b;
}
__device__ __forceinline__ void xcd_barrier_complete(unsigned* bar, unsigned x, unsigned& nloc, unsigned& nx) {
    const unsigned G = gridDim.x * gridDim.y * gridDim.z;
    unsigned sum, cnt, mine, sp = 0u;
    for (;;) {
        sum = 0u; cnt = 0u; mine = 0u;
#pragma unroll
        for (unsigned j = 0; j < 16; ++j) { const unsigned c = xb_ld(&bar[XB_XCNT(j)]); sum += c; cnt += (c > 0u) ? 1u : 0u; mine = (j == x) ? c : mine; }
        if (sum == G) break;
        __builtin_amdgcn_s_sleep(1);
        if ((++sp & 255u) == 0u) { if (xb_ld(&bar[XB_TMO])) break; if (sp > XB_SPIN_CAP) { atomicAdd(&bar[XB_TMO], 1u); break; } }
    }
    nloc = mine > 0u ? mine : 1u; nx = cnt > 0u ? cnt : 1u;
}

__device__ __forceinline__ void xcd_barrier(const XcdBarrier& b) {
    asm volatile("s_waitcnt vmcnt(0)" ::: "memory");
    __syncthreads();
    if (threadIdx.x == 0) {
        unsigned* bar = b.bar;
        __builtin_amdgcn_s_waitcnt(0);
        unsigned nloc = b.st[0], nx = b.st[1];
        if (nloc == 0u) { xcd_barrier_complete(bar, b.x, nloc, nx); b.st[0] = nloc; b.st[1] = nx; }
        const unsigned old = xb_add(&bar[XB_XSUB(b.x)], 1u);
        const unsigned gen = old / nloc;
        if (old + 1u == (gen + 1u) * nloc) {
            __builtin_amdgcn_fence(__ATOMIC_RELEASE, "agent");
            asm volatile("s_waitcnt vmcnt(0)" ::: "memory");
            const unsigned og = xb_add(&bar[XB_TOP], 1u);
            const unsigned tg = og / nx;
            if (og + 1u == (tg + 1u) * nx) xb_add(&bar[XB_TOPGEN], 1u);
            else XB_SPIN(xb_ld(&bar[XB_TOPGEN]) == tg, bar);
            __builtin_amdgcn_fence(__ATOMIC_ACQUIRE, "agent");
            xb_add(&bar[XB_XGEN(b.x)], 1u);
            asm volatile("s_waitcnt vmcnt(0)" ::: "memory");
        } else {
            XB_SPIN(xb_ld(&bar[XB_XGEN(b.x)]) == gen, bar);
            __builtin_amdgcn_fence(__ATOMIC_ACQUIRE, "agent");
            asm volatile("s_waitcnt vmcnt(0)" ::: "memory");
        }
    }
    __syncthreads();
}

struct Args { const float* in[22]; float* out; unsigned char* ws; int ph_lo, ph_hi; };
typedef const __attribute__((address_space(4))) Args CArgs;
#define KIN(k) ((const float*)ka->in[k])
#define WSF(off) ((float*)(ka->ws + (off)))
#define WSB(off) ((bf16_t*)(ka->ws + (off)))
#define KA() ({ CArgs* _k = ka0; asm volatile("" : "+s"(_k)); _k; })
__device__ __forceinline__ int tid_fresh() { int t = threadIdx.x; asm volatile("" : "+v"(t)); return t; }
struct Frame {
    LAS unsigned char* lds; char* ldsg;
    int tid, lane, wave, G, wg;
};

__device__ __forceinline__ void transpose_item(const float* W, int ldw, int col0, int k0, bf16_t* WT, int ldt, int drow0, LAS float* scr, int lane) {
#pragma unroll 8
    for (int i = 0; i < 32; ++i) { const int kk = 2 * i + (lane >> 5); scr[kk * 33 + (lane & 31)] = __builtin_nontemporal_load(W + (size_t)(k0 + kk) * ldw + col0 + (lane & 31)); }
    LDS_WAIT(); asm volatile("" ::: "memory");
    const int c = lane & 7;
#pragma unroll
    for (int j = 0; j < 4; ++j) { const int n = (lane >> 3) + 8 * j; const LAS float* s = scr + (8 * c) * 33 + n;
        v4u o; o.x = pk2(s[0 * 33], s[1 * 33]); o.y = pk2(s[2 * 33], s[3 * 33]); o.z = pk2(s[4 * 33], s[5 * 33]); o.w = pk2(s[6 * 33], s[7 * 33]);
        *(v4u*)(WT + (size_t)(drow0 + n) * ldt + k0 + 8 * c) = o; }
    LDS_WAIT(); asm volatile("" ::: "memory");
}
__device__ __forceinline__ void p_convert(Frame& F, CArgs* ka, int l, int wv, int nwv) {
    const int tid = tid_fresh(), lane = tid & 63, wave = __builtin_amdgcn_readfirstlane(tid >> 6);
    LAS float* scr = (LAS float*)(F.lds + wave * 8704);
    constexpr int I_IN = 32 * 800, I_G = 32, I_BR = 3 * 2048, I_OUT = 2048, I_LRU = 2 * 2 * 16 * 8, I_LAYER = I_IN + I_G + I_BR + I_OUT + I_LRU;
    for (int it = wv; it < I_LAYER; it += nwv) {
        int r = it;
        if (r < I_IN) { const int kb = r / 800, nb = r - kb * 800, n0 = nb * 32, sc = n0 < 14336 ? n0 : n0 + 32;
            transpose_item(KIN(8) + (size_t)l * DM * NIN, NIN, sc, kb * 64, WSB(WS_WIN) + (size_t)l * NP * DM, DM, n0, scr, lane); continue; }
        r -= I_IN;
        if (r < I_G) { transpose_item(KIN(8) + (size_t)l * DM * NIN, NIN, 14336, r * 64, WSB(WS_WG) + (size_t)l * 32 * DM, DM, 0, scr, lane); continue; }
        r -= I_G;
        if (r < I_BR) { const int z = r / 2048, q = r - z * 2048, kb = q / 64, nb = q - kb * 64;
            transpose_item(KIN(20) + ((size_t)l * 3 + z) * DM * DM, DM, nb * 32, kb * 64, WSB(WS_WBR) + ((size_t)l * 3 + z) * DM * DM, DM, nb * 32, scr, lane); continue; }
        r -= I_BR;
        if (r < I_OUT) { const int kb = r / 64, nb = r - kb * 64;
            transpose_item(KIN(21) + (size_t)l * DM * DM, DM, nb * 32, kb * 64, WSB(WS_WOUT) + (size_t)l * DM * DM, DM, nb * 32, scr, lane); continue; }
        r -= I_OUT;
        { const int q = r & 7, mt = r >> 3, blk = mt & 15, gate = (mt >> 4) & 1, dr = mt >> 5, kb = q >> 2, nb = q & 3;
          const float* src = (gate ? KIN(13) : KIN(11)) + (((size_t)l * 2 + dr) * 16 + blk) * 16384;
          transpose_item(src, 128, nb * 32, kb * 64, WSB(WS_WLRU) + ((((size_t)l * 2 + dr) * 2 + gate) * 16 + blk) * 16384, 128, nb * 32, scr, lane); }
    }
}
__device__ __forceinline__ void p_prologue(Frame& F, CArgs* ka) {
    const int tid = tid_fresh(), lane = tid & 63, wave = __builtin_amdgcn_readfirstlane(tid >> 6); (void)lane; (void)wave;
    for (int i = F.wg * 512 + tid; i < SEQ * 64; i += F.G * 512) { const int t = i >> 6, j = i & 63;
        const float inv = 1.0f / powf(10000.0f, (float)(j & 31) * (1.0f / 32.0f)); const float pos = (float)(j < 32 ? (t >> 6) : (t & 63)); const float ang = pos * inv;
        WSF(WS_ROPE)[i] = cosf(ang); WSF(WS_ROPE)[SEQ * 64 + i] = sinf(ang); }
    __syncthreads();
    LAS float* sc = (LAS float*)(F.lds + 73728);
    LAS float* red = (LAS float*)(F.lds + 73728 + 5 * 2048 * 4);
    for (int i = tid; i < 5 * DM; i += 512) { const int bi = i >> 11, k = i & 2047; const float v = bi < 4 ? KIN(1)[bi * DM + k] : KIN(3)[k]; sc[i] = v / (1.f + expf(-v)); }
    __syncthreads();
    for (int it = F.wg; it < DEPTH * 192; it += F.G) { const int l = it / 192, j0 = (it - l * 192) * 32, cj = tid & 31, ks = tid >> 5;
        float a0 = 0.f, a1 = 0.f, a2 = 0.f, a3 = 0.f, a4 = 0.f; const float* w = KIN(4) + (size_t)l * DM * 3 * DM + j0 + cj;
        for (int k = ks * 128; k < ks * 128 + 128; ++k) { const float wv = w[(size_t)k * (3 * DM)]; a0 += sc[k] * wv; a1 += sc[2048 + k] * wv; a2 += sc[4096 + k] * wv; a3 += sc[6144 + k] * wv; a4 += sc[8192 + k] * wv; }
        red[(ks * 5 + 0) * 32 + cj] = a0; red[(ks * 5 + 1) * 32 + cj] = a1; red[(ks * 5 + 2) * 32 + cj] = a2; red[(ks * 5 + 3) * 32 + cj] = a3; red[(ks * 5 + 4) * 32 + cj] = a4;
        __syncthreads();
        if (tid < 160) { const int bi = tid >> 5, c = tid & 31; float s = KIN(5)[(size_t)l * 3 * DM + j0 + c];
            for (int q = 0; q < 16; ++q) s += red[(q * 5 + bi) * 32 + c];
            WSF(WS_MOD)[((size_t)l * 5 + bi) * (3 * DM) + j0 + c] = s; }
        __syncthreads();
    }
}

__device__ __forceinline__ void p_norm(Frame& F, CArgs* ka, int l) {
    const int tid = tid_fresh(), lane = tid & 63, wave = __builtin_amdgcn_readfirstlane(tid >> 6); (void)lane; (void)wave;
    const int gw = F.wg * NWAVES + wave, NGW = F.G * NWAVES;
    for (int r = gw; r < MROWS; r += NGW) {
        const int b = r / TPB, t = r - b * TPB; const bool isctx = t >= SEQ; const int bi = isctx ? 4 : b;
        if (l == DEPTH && isctx) continue;
        f32x4 v[8];
        if (l == 0) { const float* src = isctx ? KIN(2) + ((size_t)b * CTXL + (t - SEQ)) * DM : KIN(0) + ((size_t)b * SEQ + t) * DM;
#pragma unroll
            for (int j = 0; j < 8; ++j) v[j] = *(const f32x4*)(src + j * 256 + lane * 4);
        } else {
            const float* yr = WSF(WS_Y) + (size_t)r * DM; const float* xr = WSF(WS_X) + (size_t)r * DM; f32x4 y[8]; float ss = 0.f;
#pragma unroll
            for (int j = 0; j < 8; ++j) { y[j] = *(const f32x4*)(yr + j * 256 + lane * 4); ss += y[j].x * y[j].x + y[j].y * y[j].y + y[j].z * y[j].z + y[j].w * y[j].w; }
            const float rs = rsqrtf(wave_sum(ss, lane) * (1.f / DM) + EPS);
            const float* gate = WSF(WS_MOD) + ((size_t)(l - 1) * 5 + bi) * (3 * DM) + 2 * DM; const float* npost = KIN(7) + (size_t)(l - 1) * DM;
#pragma unroll
            for (int j = 0; j < 8; ++j) { const int c = j * 256 + lane * 4; const f32x4 g = *(const f32x4*)(gate + c), w = *(const f32x4*)(npost + c), xv = *(const f32x4*)(xr + c);
                v[j] = xv + g * (y[j] * rs * w); }
        }
        if (l == DEPTH) { float* o = (ka->out) + ((size_t)b * SEQ + t) * DM;
#pragma unroll
            for (int j = 0; j < 8; ++j) *(f32x4*)(o + j * 256 + lane * 4) = v[j];
            continue; }
        float* xo = WSF(WS_X) + (size_t)r * DM; float ss = 0.f;
#pragma unroll
        for (int j = 0; j < 8; ++j) { *(f32x4*)(xo + j * 256 + lane * 4) = v[j]; ss += v[j].x * v[j].x + v[j].y * v[j].y + v[j].z * v[j].z + v[j].w * v[j].w; }
        const float rs = rsqrtf(wave_sum(ss, lane) * (1.f / DM) + EPS);
        const float* shift = WSF(WS_MOD) + ((size_t)l * 5 + bi) * (3 * DM); const float* scale = shift + DM; const float* npre = KIN(6) + (size_t)l * DM;
        bf16_t* ho = WSB(WS_H) + (size_t)r * DM;
#pragma unroll
        for (int j = 0; j < 8; ++j) { const int c = j * 256 + lane * 4; const f32x4 sh = *(const f32x4*)(shift + c), scv = *(const f32x4*)(scale + c), w = *(const f32x4*)(npre + c);
            const f32x4 h = v[j] * rs * w * (scv + 1.f) + sh; v2u o; o.x = pk2(h.x, h.y); o.y = pk2(h.z, h.w); *(v2u*)(ho + c) = o; }
    }
}

__device__ __forceinline__ void p_prep(Frame& F, CArgs* ka, int l) {
    const int tid = tid_fresh(), lane = tid & 63, wave = __builtin_amdgcn_readfirstlane(tid >> 6), c16 = lane & 15, q = lane >> 4;
    typedef short bf16x8 __attribute__((ext_vector_type(8)));
    LAS float* GL = (LAS float*)F.lds;
    const bf16_t* H = WSB(WS_H); const bf16_t* WG = WSB(WS_WG) + (size_t)l * 32 * DM; float* GT = WSF(WS_GT); f32x4* GSC = (f32x4*)WSF(WS_GSC);
    for (int task = F.wg; task < NBATCH * 36; task += F.G) { const int b = task / 36, chunk = task - b * 36; const size_t row0 = (size_t)b * TPB + chunk * 64;
        __syncthreads();
        { const int rb = wave & 3, kh = wave >> 2; f32x4 a0 = {0.f, 0.f, 0.f, 0.f}, a1 = {0.f, 0.f, 0.f, 0.f};
          const bf16_t* hp = H + (row0 + rb * 16 + c16) * DM + kh * 1024 + q * 8; const bf16_t* w0 = WG + (size_t)c16 * DM + kh * 1024 + q * 8; const bf16_t* w1 = w0 + 16 * DM;
#pragma unroll 8
          for (int ks = 0; ks < 32; ++ks) { const bf16x8 av = *(const bf16x8*)(hp + ks * 32), b0 = *(const bf16x8*)(w0 + ks * 32), b1 = *(const bf16x8*)(w1 + ks * 32);
              a0 = __builtin_amdgcn_mfma_f32_16x16x32_bf16(av, b0, a0, 0, 0, 0); a1 = __builtin_amdgcn_mfma_f32_16x16x32_bf16(av, b1, a1, 0, 0, 0); }
#pragma unroll
          for (int j = 0; j < 4; ++j) { GL[(kh * 64 + rb * 16 + q * 4 + j) * 33 + c16] = a0[j]; GL[(kh * 64 + rb * 16 + q * 4 + j) * 33 + 16 + c16] = a1[j]; } }
        __syncthreads();
#pragma unroll
        for (int i = 0; i < 4; ++i) { const int idx = tid + 512 * i, r = idx >> 5, c = idx & 31; float s = GL[r * 33 + c] + GL[(64 + r) * 33 + c] + KIN(16)[l * 32 + c];
            if ((c >> 3) & 1) s = fminf(s, 0.f) - log1pf(expf(-fabsf(s)));
            GL[r * 33 + c] = s; GT[(row0 + r) * 32 + c] = s; }
        __syncthreads();
#pragma unroll
        for (int pi = 0; pi < 2; ++pi) { const int p = wave * 2 + pi, dir = p >> 3, h = p & 7, rl = dir ? 63 - lane : lane;
            const float gi = GL[rl * 33 + dir * 16 + h]; float bc = GL[rl * 33 + dir * 16 + 8 + h];
#pragma unroll
            for (int o = 1; o < 64; o <<= 1) { const float v = lane_up(bc, o, lane); if (lane >= o) bc += v; }
            const float g = gi - bc; float pm = g;
#pragma unroll
            for (int o = 1; o < 64; o <<= 1) { const float v = lane_up(pm, o, lane); if (lane >= o) pm = fmaxf(pm, v); }
            GSC[((((size_t)b * 2 + dir) * 8 + h) * 36 + chunk) * 64 + lane] = (f32x4){bc, g, pm, 0.f}; }
    }
    const int gw = F.wg * NWAVES + wave, NGW = F.G * NWAVES; const int sub = lane & 15;
    f32x4 kn0 = *(const f32x4*)(KIN(19) + l * 128 + sub * 8), kn1 = *(const f32x4*)(KIN(19) + l * 128 + sub * 8 + 4);
    for (int r = gw; r < MROWS; r += NGW) { const int b = r / TPB, t = r - b * TPB;
        bf16_t* kp = WSB(WS_P) + (size_t)r * NP + C_AK + lane * 8; const v4u raw = *(const v4u*)kp; float v[8];
#pragma unroll
        for (int e = 0; e < 4; ++e) { v[2 * e] = blo(raw[e]); v[2 * e + 1] = bhi(raw[e]); }
        float ss = 0.f;
#pragma unroll
        for (int e = 0; e < 8; ++e) ss += v[e] * v[e];
        ss += lane_xor(ss, 1, lane); ss += lane_xor(ss, 2, lane); ss += lane_xor(ss, 4, lane); ss += lane_xor(ss, 8, lane);
        const float rs = rsqrtf(ss * (1.f / 128.f) + EPS);
#pragma unroll
        for (int e = 0; e < 8; ++e) v[e] *= rs * (e < 4 ? kn0[e & 3] : kn1[e & 3]);
        if (t < SEQ) { const int i0 = (sub & 7) * 8; const float* cp = WSF(WS_ROPE) + (size_t)t * 64 + i0; const float* sp = cp + SEQ * 64;
            const f32x4 c0 = *(const f32x4*)cp, c1 = *(const f32x4*)(cp + 4), s0 = *(const f32x4*)sp, s1 = *(const f32x4*)(sp + 4); const bool upper = (sub & 8) != 0;
#pragma unroll
            for (int e = 0; e < 8; ++e) { const float o = lane_xor(v[e], 8, lane), c = e < 4 ? c0[e & 3] : c1[e & 3], sn = e < 4 ? s0[e & 3] : s1[e & 3];
                v[e] = upper ? v[e] * c + o * sn : v[e] * c - o * sn; } }
        v4u ov; ov.x = pk2(v[0], v[1]); ov.y = pk2(v[2], v[3]); ov.z = pk2(v[4], v[5]); ov.w = pk2(v[6], v[7]);
        *(v4u*)kp = ov; }
}

__device__ __forceinline__ void p_lru_gates_naive(Frame& F, CArgs* ka, int l) {
    const int tid = tid_fresh(); (void)tid;
    LAS float* xs = (LAS float*)F.lds;
    for (int it = F.wg; it < (MROWS / 16) * 16; it += F.G) { const int rt = it >> 4, blk = it & 15;
        __syncthreads();
#pragma unroll
        for (int j = 0; j < 4; ++j) { const int idx = tid + 512 * j, rr = idx >> 7, c = idx & 127, r = rt * 16 + rr, b = r / TPB, t = r - b * TPB, ch = blk * 128 + c;
            const int lo = t < SEQ ? 0 : SEQ, hi = t < SEQ ? SEQ : TPB; float a = KIN(10)[l * DM + ch];
#pragma unroll
            for (int k = 0; k < 4; ++k) { const int tt = t + k - 2; if (tt >= lo && tt < hi) a += KIN(9)[((size_t)l * 4 + k) * DM + ch] * bf2f(WSB(WS_P)[((size_t)b * TPB + tt) * NP + C_LX + ch]); }
            xs[rr * 128 + c] = a; }
        __syncthreads();
        const int co = tid & 127, r0 = tid >> 7, ch = blk * 128 + co;
#pragma unroll 1
        for (int dr = 0; dr < 2; ++dr) {
            const float* wr = KIN(11) + (((size_t)l * 2 + dr) * 16 + blk) * 16384 + co; const float* wi = KIN(13) + (((size_t)l * 2 + dr) * 16 + blk) * 16384 + co;
            float ar[4], ai[4];
#pragma unroll
            for (int j = 0; j < 4; ++j) { ar[j] = KIN(12)[((size_t)l * 2 + dr) * DM + ch]; ai[j] = KIN(14)[((size_t)l * 2 + dr) * DM + ch]; }
            for (int c = 0; c < 128; ++c) { const float w0 = wr[c * 128], w1 = wi[c * 128];
#pragma unroll
                for (int j = 0; j < 4; ++j) { const float xv = xs[(r0 + 4 * j) * 128 + c]; ar[j] += xv * w0; ai[j] += xv * w1; } }
            const float lam = KIN(15)[((size_t)l * 2 + dr) * DM + ch], sp = log1pf(expf(-lam));
#pragma unroll
            for (int j = 0; j < 4; ++j) { const int r = rt * 16 + r0 + 4 * j; const float rg = 1.f / (1.f + expf(-ar[j])), ig = 1.f / (1.f + expf(-ai[j]));
                const float log_a = -8.f * rg * sp, a = expf(log_a), mult = sqrtf(-expm1f(2.f * log_a));
                WSF(WS_LA)[((size_t)dr * MROWS + r) * DM + ch] = a; WSF(WS_LB)[((size_t)dr * MROWS + r) * DM + ch] = mult * ig * xs[(r0 + 4 * j) * 128 + co]; }
        }
    }
    __syncthreads();
}

__device__ __forceinline__ void p_attention(Frame& F, CArgs* ka, int l, bool need_ctx) {
    using att::bf16;
    const int n_lat = NBATCH * 16 * 8, n_all = n_lat + (need_ctx ? NBATCH * 16 : 0);
    for (int u = F.wg; u < n_all; u += F.G) {
        int b, h, q0, k0, seq; const float *cs = nullptr, *sn = nullptr;
        if (u < n_lat) { const int qb = u & 7; h = (u >> 3) & 15; b = u >> 7; q0 = qb * 256; k0 = 0; seq = TPB; cs = WSF(WS_ROPE) + (size_t)q0 * 64; sn = WSF(WS_ROPE) + (size_t)SEQ * 64 + (size_t)q0 * 64; }
        else { const int v = u - n_lat; h = v & 15; b = v >> 4; q0 = SEQ; k0 = SEQ; seq = CTXL; }
        const size_t rq = (size_t)b * TPB + q0, rk = (size_t)b * TPB + k0; const int kvh = h >> 2;
        att::attn_unit((const bf16*)(WSB(WS_P) + rq * NP + C_AQ + h * 128), (const bf16*)(WSB(WS_P) + rk * NP + C_AK + kvh * 128), (const bf16*)(WSB(WS_P) + rk * NP + C_AV + kvh * 128),
                       (const bf16*)(WSB(WS_P) + rq * NP + C_AZ + h * 128), (bf16*)(WSB(WS_YB) + ((size_t)2 * MROWS + rq) * DM + h * 128), seq, F.ldsg, KIN(18) + l * 128, cs, sn);
    }
}
__device__ __forceinline__ int seq_row(int s, int dir) { return s < CTXL ? SEQ + (dir ? CTXL - 1 - s : s) : (dir ? SEQ - 1 - (s - CTXL) : s - CTXL); }
__device__ __forceinline__ void p_mlstm_naive(Frame& F, CArgs* ka, int l) {
    const int tid = tid_fresh(), lane = tid & 63, wave = __builtin_amdgcn_readfirstlane(tid >> 6); (void)lane; (void)wave;
    LAS float* sq = (LAS float*)F.lds; LAS float* sk = sq + 256; LAS float* rn = sk + 256; LAS float* rd = rn + 512;
    const int e = tid & 63, dg = tid >> 6;
    for (int u = F.wg; u < 256; u += F.G) { const int es = u & 3, dir = (u >> 2) & 1, h = (u >> 3) & 7, b = u >> 6;
        float C[32], n[32];
#pragma unroll
        for (int i = 0; i < 32; ++i) { C[i] = 0.f; n[i] = 0.f; }
        float m = -1e30f;
        const int lcol = tid < 64 ? C_MQ + h * 256 + tid * 4 : C_MK + h * 256 + (tid - 64) * 4, vcol = C_MV + h * 256 + es * 64 + e;
        v2u pqk = {0u, 0u}; bf16_t pv; float gi, gf;
        { const size_t r = (size_t)b * TPB + seq_row(0, dir); if (tid < 128) pqk = *(const v2u*)(WSB(WS_P) + r * NP + lcol); pv = WSB(WS_P)[r * NP + vcol]; gi = WSF(WS_GT)[r * 32 + dir * 16 + h]; gf = WSF(WS_GT)[r * 32 + dir * 16 + 8 + h]; }
        __syncthreads();
        for (int s = 0; s < TPB; ++s) {
            const size_t r = (size_t)b * TPB + seq_row(s, dir);
            if (tid < 128) { LAS float* d = (tid < 64 ? sq : sk) + (tid & 63) * 4; d[0] = blo(pqk.x); d[1] = bhi(pqk.x); d[2] = blo(pqk.y); d[3] = bhi(pqk.y); }
            const float vv = bf2f(pv), iv = gi, lf = gf;
            __syncthreads();
            if (s + 1 < TPB) { const size_t r2 = (size_t)b * TPB + seq_row(s + 1, dir); if (tid < 128) pqk = *(const v2u*)(WSB(WS_P) + r2 * NP + lcol); pv = WSB(WS_P)[r2 * NP + vcol]; gi = WSF(WS_GT)[r2 * 32 + dir * 16 + h]; gf = WSF(WS_GT)[r2 * 32 + dir * 16 + 8 + h]; }
            const float mnew = fmaxf(lf + m, iv), fw = expf(lf + m - mnew), iw = expf(iv - mnew); m = mnew;
            float pn = 0.f, pd = 0.f;
#pragma unroll
            for (int dd = 0; dd < 32; ++dd) { const float kd = sk[dg * 32 + dd], qd = sq[dg * 32 + dd]; C[dd] = fw * C[dd] + iw * kd * vv; n[dd] = fw * n[dd] + iw * kd; pn += qd * C[dd]; pd += qd * n[dd]; }
            rn[dg * 64 + e] = pn; rd[dg * 64 + e] = pd;
            __syncthreads();
            if (dg == 0) { float num = 0.f, den = 0.f;
#pragma unroll
                for (int g = 0; g < 8; ++g) { num += rn[g * 64 + e]; den += rd[g * 64 + e]; }
                WSF(WS_MH)[((size_t)dir * MROWS + r) * DM + h * 256 + es * 64 + e] = num / fmaxf(fabsf(den), expf(-m)); }
        }
        __syncthreads();
    }
}
__device__ __forceinline__ void p_lru_scan_naive(Frame& F, CArgs* ka) {
    const int tid = tid_fresh(), lane = tid & 63, wave = __builtin_amdgcn_readfirstlane(tid >> 6); (void)lane; (void)wave;
    if (wave != 0) return;
    for (int cw = F.wg; cw < 256; cw += F.G) { const int combo = cw * 64 + lane, b = combo >> 12, dir = (combo >> 11) & 1, ch = combo & 2047;
        const float* A = WSF(WS_LA) + (size_t)dir * MROWS * DM + ch; const float* Bx = WSF(WS_LB) + (size_t)dir * MROWS * DM + ch; float* Ho = WSF(WS_HL) + (size_t)dir * MROWS * DM + ch; float h = 0.f;
#pragma unroll 8
        for (int s = 0; s < TPB; ++s) { const size_t r = (size_t)b * TPB + seq_row(s, dir); h = A[r * DM] * h + Bx[r * DM]; Ho[r * DM] = h; }
    }
}

__device__ __forceinline__ void p_mlout(Frame& F, CArgs* ka, int l) {
    const int tid = tid_fresh(), lane = tid & 63, wave = __builtin_amdgcn_readfirstlane(tid >> 6); (void)lane; (void)wave;
    const int gw = F.wg * NWAVES + wave, NGW = F.G * NWAVES;
    for (int r = gw; r < MROWS; r += NGW) {
        const bf16_t* pr = WSB(WS_P) + (size_t)r * NP;
#pragma unroll 2
        for (int h = 0; h < 8; ++h) { const int col = h * 256 + lane * 4;
            const f32x4 a = *(const f32x4*)(WSF(WS_MH) + (size_t)r * DM + col), bb = *(const f32x4*)(WSF(WS_MH) + ((size_t)MROWS + r) * DM + col);
            const v2u ow = *(const v2u*)(pr + C_MO + col), zw = *(const v2u*)(pr + C_MZ + col); const f32x4 g = *(const f32x4*)(KIN(17) + (size_t)l * DM + col);
            f32x4 v = a + bb; v.x *= blo(ow.x); v.y *= bhi(ow.x); v.z *= blo(ow.y); v.w *= bhi(ow.y);
            const float rs = rsqrtf(wave_sum(v.x * v.x + v.y * v.y + v.z * v.z + v.w * v.w, lane) * (1.f / 256.f) + EPS);
            v2u o; o.x = pk2(v.x * rs * g.x * blo(zw.x), v.y * rs * g.y * bhi(zw.x)); o.y = pk2(v.z * rs * g.z * blo(zw.y), v.w * rs * g.w * bhi(zw.y));
            *(v2u*)(WSB(WS_YB) + ((size_t)MROWS + r) * DM + col) = o; }
    }
}

__device__ __forceinline__ void p_lru_combine_naive(Frame& F, CArgs* ka) {
    const int tid = tid_fresh(), lane = tid & 63, wave = __builtin_amdgcn_readfirstlane(tid >> 6);
    const int gw = F.wg * NWAVES + wave, NGW = F.G * NWAVES;
    for (int r = gw; r < MROWS; r += NGW) {
        const bf16_t* pr = WSB(WS_P) + (size_t)r * NP;
#pragma unroll 2
        for (int j = 0; j < 8; ++j) { const int col = j * 256 + lane * 4;
            const f32x4 a = *(const f32x4*)(WSF(WS_HL) + (size_t)r * DM + col), bb = *(const f32x4*)(WSF(WS_HL) + ((size_t)MROWS + r) * DM + col); const v2u zw = *(const v2u*)(pr + C_LZ + col);
            const f32x4 v = a + bb; v2u o; o.x = pk2(v.x * blo(zw.x), v.y * bhi(zw.x)); o.y = pk2(v.z * blo(zw.y), v.w * bhi(zw.y));
            *(v2u*)(WSB(WS_YB) + (size_t)r * DM + col) = o; }
    }
}
#ifndef USE_NAIVE_ML
#define USE_NAIVE_ML 0
#endif
#ifndef USE_NAIVE_LRU
#define USE_NAIVE_LRU 0
#endif

namespace ml {
typedef short bf16x8 __attribute__((ext_vector_type(8)));
constexpr int KS_OFF = 0, KS_PITCH = 528;
constexpr int KT_OFF = KS_OFF + 64 * KS_PITCH, KT_PITCH = 144;
constexpr int VT_OFF = KT_OFF + 256 * KT_PITCH, VT_PITCH = 144;
constexpr int ST_OFF = VT_OFF + 80 * VT_PITCH, ST_PITCH = 144;
constexpr int CT_OFF = ST_OFF + 64 * ST_PITCH, CT_PITCH = 528;
constexpr int TAB_OFF = CT_OFF + 80 * CT_PITCH;
constexpr int END_OFF = TAB_OFF + 1024;
static_assert(END_OFF <= MISC_OFF, "mLSTM LDS map");
#define ML_MFMA(a, b, c) __builtin_amdgcn_mfma_f32_16x16x32_bf16((a), (b), (c), 0, 0, 0)
__device__ __forceinline__ int chunk_of(int k, int dir) { return k < 4 ? (dir ? 35 - k : 32 + k) : (dir ? 31 - (k - 4) : k - 4); }

__device__ __forceinline__ void mlstm_unit(Frame& F, CArgs* ka, int u, bool need_ctx) {
    const int tid = tid_fresh(), lane = tid & 63, w = __builtin_amdgcn_readfirstlane(tid >> 6), c16 = lane & 15, q = lane >> 4;
    const int es = u & 3, dir = (u >> 2) & 1, h = (u >> 3) & 7, b = u >> 6;
    LAS unsigned char* L = F.lds;
    const bf16_t* P = WSB(WS_P); float* MH = WSF(WS_MH) + (size_t)dir * MROWS * DM;
    const f32x4* GSC = (const f32x4*)WSF(WS_GSC) + (((size_t)b * 2 + dir) * 8 + h) * 36 * 64;
    LAS float* TABg = (LAS float*)(L + TAB_OFF); LAS float* TABmm = TABg + 64; LAS float* TABbc = TABg + 128;
    __syncthreads();
    for (int i = tid; i < 80 * CT_PITCH / 16; i += 512) *(LAS v4u*)(L + CT_OFF + i * 16) = (v4u){0u, 0u, 0u, 0u};
    for (int i = tid; i < 16 * 64; i += 512) { const int e = 64 + (i >> 6), s = i & 63; *(LAS bf16_t*)(L + VT_OFF + e * VT_PITCH + s * 2) = (bf16_t)(e == 64 ? 0x3F80 : 0); }
    f32x4 C[2][5];
#pragma unroll
    for (int a = 0; a < 2; ++a)
#pragma unroll
        for (int e = 0; e < 5; ++e) C[a][e] = (f32x4){0.f, 0.f, 0.f, 0.f};
    float m = -1e30f;
    const int tn = w & 3, wh = w >> 2;
    v4u kraw[4], vraw; bf16x8 Qf[8]; float gsc0, gsc1, gsc2;
#define ML_ROW(base, j) ((size_t)(base) + (dir ? 63 - (j) : (j)))
#define ML_LOAD_KVG(k) do { const int _c = chunk_of((k), dir), _base = b * TPB + _c * 64; const bf16_t* _rp = P + ML_ROW(_base, lane) * NP; \
        _Pragma("unroll") for (int i = 0; i < 4; ++i) kraw[i] = *(const v4u*)(_rp + C_MK + h * 256 + (w * 4 + i) * 8); \
        vraw = *(const v4u*)(_rp + C_MV + h * 256 + es * 64 + w * 8); { const float* _gp = (const float*)(GSC + _c * 64 + lane); gsc0 = _gp[0]; gsc1 = _gp[1]; gsc2 = _gp[2]; } } while (0)
#define ML_LOAD_Q(k) do { const int _base = b * TPB + chunk_of((k), dir) * 64; const bf16_t* _qp = P + ML_ROW(_base, tn * 16 + c16) * NP + C_MQ + h * 256 + q * 8; \
        _Pragma("unroll") for (int ks = 0; ks < 8; ++ks) Qf[ks] = *(const bf16x8*)(_qp + ks * 32); } while (0)
    ML_LOAD_KVG(0); ML_LOAD_Q(0);
#pragma unroll 1
    for (int k = 0; k < 36; ++k) {
        const int base = b * TPB + chunk_of(k, dir) * 64; const bool do_out = need_ctx || k >= 4;
        const float bc = gsc0, g = gsc1, mm = fmaxf(gsc2, m), bL = lane_get(bc, 63), mm63 = lane_get(mm, 63), wk = __expf(g - mm63);
        if (w == 0) { TABg[lane] = g; TABmm[lane] = mm; TABbc[lane] = bc; }
#pragma unroll
        for (int i = 0; i < 4; ++i) { *(LAS v4u*)(L + KS_OFF + lane * KS_PITCH + (w * 4 + i) * 16) = kraw[i];
#pragma unroll
            for (int e = 0; e < 4; ++e) { const unsigned x = kraw[i][e]; const unsigned pk = pk2(blo(x) * wk, bhi(x) * wk);
                *(LAS bf16_t*)(L + KT_OFF + ((w * 4 + i) * 8 + 2 * e) * KT_PITCH + lane * 2) = (bf16_t)(pk & 0xffffu); *(LAS bf16_t*)(L + KT_OFF + ((w * 4 + i) * 8 + 2 * e + 1) * KT_PITCH + lane * 2) = (bf16_t)(pk >> 16); } }
#pragma unroll
        for (int e = 0; e < 4; ++e) { const unsigned x = vraw[e];
            *(LAS bf16_t*)(L + VT_OFF + (w * 8 + 2 * e) * VT_PITCH + lane * 2) = (bf16_t)(x & 0xffffu); *(LAS bf16_t*)(L + VT_OFF + (w * 8 + 2 * e + 1) * VT_PITCH + lane * 2) = (bf16_t)(x >> 16); }
        __syncthreads();
        const int t = tn * 16 + c16; const int kn = k + 1 < 36 ? k + 1 : 35;
        if (do_out) {
            const float mmt = TABmm[t];
#pragma unroll
            for (int si = 0; si < 2; ++si) { const int sm = wh * 2 + si; v2u o = {0u, 0u};
                if (sm <= tn) { f32x4 acc = {0.f, 0.f, 0.f, 0.f};
#pragma unroll
                    for (int ks = 0; ks < 8; ++ks) { const bf16x8 a = *(const LAS bf16x8*)(L + KS_OFF + (sm * 16 + c16) * KS_PITCH + (ks * 32 + q * 8) * 2); acc = ML_MFMA(a, Qf[ks], acc); }
                    float v[4];
#pragma unroll
                    for (int j = 0; j < 4; ++j) { const int s = sm * 16 + q * 4 + j; v[j] = s <= t ? acc[j] * __expf(TABg[s] - mmt) : 0.f; }
                    o.x = pk2(v[0], v[1]); o.y = pk2(v[2], v[3]); }
                *(LAS v2u*)(L + ST_OFF + t * ST_PITCH + (sm * 16 + q * 4) * 2) = o; }
        }
        ML_LOAD_KVG(kn);
        __syncthreads();
        f32x4 num0 = {0.f, 0.f, 0.f, 0.f}, num1 = {0.f, 0.f, 0.f, 0.f}; float den = 1.f;
        if (do_out) {
            const float wi = __expf(m - TABmm[t]);
            bf16x8 sb[2];
#pragma unroll
            for (int ks = 0; ks < 2; ++ks) sb[ks] = *(const LAS bf16x8*)(L + ST_OFF + t * ST_PITCH + (ks * 32 + q * 8) * 2);
#pragma unroll
            for (int ei = 0; ei < 3; ++ei) { const int em = ei < 2 ? wh * 2 + ei : 4;
                f32x4 a1 = {0.f, 0.f, 0.f, 0.f}, a2 = {0.f, 0.f, 0.f, 0.f};
#pragma unroll
                for (int ks = 0; ks < 2; ++ks) { const bf16x8 a = *(const LAS bf16x8*)(L + VT_OFF + (em * 16 + c16) * VT_PITCH + (ks * 32 + q * 8) * 2); a1 = ML_MFMA(a, sb[ks], a1); }
#pragma unroll
                for (int ks = 0; ks < 8; ++ks) { const bf16x8 a = *(const LAS bf16x8*)(L + CT_OFF + (em * 16 + c16) * CT_PITCH + (ks * 32 + q * 8) * 2); a2 = ML_MFMA(a, Qf[ks], a2); }
                const f32x4 nv = a1 + a2 * wi;
                if (ei == 0) num0 = nv; else if (ei == 1) num1 = nv;
                else den = fmaxf(fabsf(lane_get(nv[0], c16)), __expf(-(TABbc[t] + TABmm[t]))); }
        }
        ML_LOAD_Q(kn);
        if (do_out) { const float rd = 1.f / den; float* op = MH + ML_ROW(base, t) * DM + h * 256 + es * 64 + q * 4;
            *(f32x4*)(op + (wh * 2) * 16) = num0 * rd; *(f32x4*)(op + (wh * 2 + 1) * 16) = num1 * rd; }
        __syncthreads();
        { const float decay = __expf(m - mm63);
          bf16x8 vb[5][2];
#pragma unroll
          for (int en = 0; en < 5; ++en)
#pragma unroll
              for (int ks = 0; ks < 2; ++ks) vb[en][ks] = *(const LAS bf16x8*)(L + VT_OFF + (en * 16 + c16) * VT_PITCH + (ks * 32 + q * 8) * 2);
#pragma unroll
          for (int di = 0; di < 2; ++di) {
            bf16x8 a[2];
#pragma unroll
            for (int ks = 0; ks < 2; ++ks) a[ks] = *(const LAS bf16x8*)(L + KT_OFF + ((2 * w + di) * 16 + c16) * KT_PITCH + (ks * 32 + q * 8) * 2);
#pragma unroll
            for (int en = 0; en < 5; ++en) { f32x4 c = C[di][en] * decay;
#pragma unroll
                for (int ks = 0; ks < 2; ++ks) c = ML_MFMA(a[ks], vb[en][ks], c);
                C[di][en] = c; v2u o; o.x = pk2(c[0], c[1]); o.y = pk2(c[2], c[3]);
                *(LAS v2u*)(L + CT_OFF + (en * 16 + c16) * CT_PITCH + ((2 * w + di) * 16 + q * 4) * 2) = o; } }
          m = bL + mm63; }
        __syncthreads();
    }
#undef ML_ROW
#undef ML_LOAD_KVG
#undef ML_LOAD_Q
}
}

namespace lru {
typedef short bf16x8 __attribute__((ext_vector_type(8)));
constexpr int XB_OFF = 0, XB_PITCH = 272;
constexpr int XF_OFF = XB_OFF + 64 * XB_PITCH, XF_PITCH = 528;
constexpr int YO_OFF = XF_OFF + 64 * XF_PITCH, YO_PITCH = 528;
constexpr int HIN_OFF = YO_OFF + 64 * YO_PITCH;
constexpr int CW_OFF = HIN_OFF + 9 * 2 * 128 * 4;
constexpr int END_OFF = CW_OFF + 5 * 128 * 4;
static_assert(END_OFF <= MISC_OFF, "LRU LDS map");
#define LRU_COMPOSE(A, B, a2, b2) do { B = (a2) * B + (b2); A = (a2) * A; } while (0)

template <bool FINAL, class BcOf>
__device__ __forceinline__ void lru_run(Frame& F, CArgs* ka, int l, int blk, int NU, const BcOf& bc_of) {
    const int tid = tid_fresh(), lane = tid & 63, w = __builtin_amdgcn_readfirstlane(tid >> 6), c16 = lane & 15, q = lane >> 4;
    LAS unsigned char* L = F.lds; const bf16_t* P = WSB(WS_P);
    const int cg = tid & 15, rg = tid >> 4, chl = 16 * w + c16, ch = blk * 128 + chl;
    bf16x8 bw[4][4];
    { const bf16_t* Wt = WSB(WS_WLRU) + (size_t)l * 4 * 16 * 16384 + ((size_t)blk * 128 + chl) * 128 + q * 8;
#pragma unroll
      for (int g = 0; g < 4; ++g)
#pragma unroll
          for (int ks = 0; ks < 4; ++ks) bw[g][ks] = *(const bf16x8*)(Wt + (size_t)g * 16 * 16384 + ks * 32); }
    float cbr[2], cbi[2], csp[2];
#pragma unroll
    for (int dr = 0; dr < 2; ++dr) { cbr[dr] = KIN(12)[((size_t)l * 2 + dr) * DM + ch]; cbi[dr] = KIN(14)[((size_t)l * 2 + dr) * DM + ch]; csp[dr] = log1pf(__expf(-KIN(15)[((size_t)l * 2 + dr) * DM + ch])); }
    for (int i = tid; i < 5 * 128; i += 512) { const int kk = i >> 7, c = i & 127; ((LAS float*)(L + CW_OFF))[i] = kk < 4 ? KIN(9)[((size_t)l * 4 + kk) * DM + blk * 128 + c] : KIN(10)[(size_t)l * DM + blk * 128 + c]; }
    v4u raw[5];
#define LRU_LOAD(i) do { int _b, _c; bc_of((i), _b, _c); const int _t0 = _c * 64, _lo = _c < 32 ? 0 : SEQ, _hi = _c < 32 ? SEQ : TPB; const size_t _rb = (size_t)_b * TPB; \
        _Pragma("unroll") for (int x = 0; x < 5; ++x) { const int tt = _t0 + 2 * rg - 2 + x; raw[x] = (v4u){0u, 0u, 0u, 0u}; if (tt >= _lo && tt < _hi) raw[x] = *(const v4u*)(P + (_rb + tt) * NP + C_LX + blk * 128 + cg * 8); } \
        } while (0)
    LRU_LOAD(0);
#pragma unroll 1
    for (int ui = 0; ui < NU; ++ui) {
        int b, chunk; bc_of(ui, b, chunk); const size_t rb = (size_t)b * TPB; const int t0 = chunk * 64;
        __syncthreads();
        {
          float o0[8], o1[8]; const LAS float* cwl = (const LAS float*)(L + CW_OFF) + cg * 8;
#pragma unroll
          for (int e = 0; e < 8; ++e) { o0[e] = cwl[4 * 128 + e]; o1[e] = o0[e]; }
#pragma unroll
          for (int kk = 0; kk < 5; ++kk) { float xin[8];
#pragma unroll
              for (int e = 0; e < 4; ++e) { xin[2 * e] = blo(raw[kk][e]); xin[2 * e + 1] = bhi(raw[kk][e]); }
#pragma unroll
              for (int e = 0; e < 8; ++e) { if (kk < 4) o0[e] += cwl[kk * 128 + e] * xin[e]; if (kk > 0) o1[e] += cwl[(kk - 1) * 128 + e] * xin[e]; } }
          v4u p0, p1; p0.x = pk2(o0[0], o0[1]); p0.y = pk2(o0[2], o0[3]); p0.z = pk2(o0[4], o0[5]); p0.w = pk2(o0[6], o0[7]); p1.x = pk2(o1[0], o1[1]); p1.y = pk2(o1[2], o1[3]); p1.z = pk2(o1[4], o1[5]); p1.w = pk2(o1[6], o1[7]);
          *(LAS v4u*)(L + XB_OFF + (2 * rg) * XB_PITCH + cg * 16) = p0; *(LAS v4u*)(L + XB_OFF + (2 * rg + 1) * XB_PITCH + cg * 16) = p1;
          LAS float* f0 = (LAS float*)(L + XF_OFF + (2 * rg) * XF_PITCH + cg * 32); LAS float* f1 = (LAS float*)(L + XF_OFF + (2 * rg + 1) * XF_PITCH + cg * 32);
          *(LAS f32x4*)f0 = (f32x4){o0[0], o0[1], o0[2], o0[3]}; *(LAS f32x4*)(f0 + 4) = (f32x4){o0[4], o0[5], o0[6], o0[7]};
          *(LAS f32x4*)f1 = (f32x4){o1[0], o1[1], o1[2], o1[3]}; *(LAS f32x4*)(f1 + 4) = (f32x4){o1[4], o1[5], o1[6], o1[7]}; }
        __syncthreads();
        v4u zcur[2];
        if (FINAL) {
#pragma unroll
            for (int x = 0; x < 2; ++x) { const int cidx = tid + 512 * x; zcur[x] = *(const v4u*)(P + (rb + t0 + (cidx >> 4)) * NP + C_LZ + blk * 128 + (cidx & 15) * 8); } }
        if (ui + 1 < NU) LRU_LOAD(ui + 1);
#pragma unroll
        for (int dr = 0; dr < 2; ++dr) {
            f32x4 acc[2][4];
#pragma unroll
            for (int g = 0; g < 2; ++g)
#pragma unroll
                for (int tm = 0; tm < 4; ++tm) acc[g][tm] = (f32x4){0.f, 0.f, 0.f, 0.f};
#pragma unroll
            for (int ks = 0; ks < 4; ++ks) { bf16x8 a[4];
#pragma unroll
                for (int tm = 0; tm < 4; ++tm) a[tm] = *(const LAS bf16x8*)(L + XB_OFF + (tm * 16 + c16) * XB_PITCH + (ks * 32 + q * 8) * 2);
#pragma unroll
                for (int g = 0; g < 2; ++g)
#pragma unroll
                    for (int tm = 0; tm < 4; ++tm) acc[g][tm] = __builtin_amdgcn_mfma_f32_16x16x32_bf16(a[tm], bw[2 * dr + g][ks], acc[g][tm], 0, 0, 0); }
#pragma unroll
            for (int tm = 0; tm < 4; ++tm)
#pragma unroll
                for (int j = 0; j < 4; ++j) { const int t = tm * 16 + q * 4 + j; const float xv = *(const LAS float*)(L + XF_OFF + t * XF_PITCH + chl * 4);
                    const float rgt = pg8::sigmoid_f(acc[0][tm][j] + cbr[dr]), igt = pg8::sigmoid_f(acc[1][tm][j] + cbi[dr]), la = -8.f * rgt * csp[dr], av = __expf(la), x2 = 2.f * la;
                    const float om = x2 > -0.1f ? -x2 * (1.f + x2 * (0.5f + x2 * (0.16666667f + x2 * (0.041666668f + x2 * 0.0083333338f)))) : 1.f - av * av;
                    acc[0][tm][j] = av; acc[1][tm][j] = sqrtf(om) * igt * xv; }
#define LRU_TM(i) (dr ? 3 - (i) : (i))
            if constexpr (!FINAL) {
                float2* AGG = (float2*)WSF(WS_LA); float TA = 1.f, TB = 0.f;
#pragma unroll
                for (int ti = 0; ti < 4; ++ti) { const int tm = LRU_TM(ti); float sa = 1.f, sb = 0.f;
#pragma unroll
                    for (int ji = 0; ji < 4; ++ji) { const int j = LRU_TM(ji); LRU_COMPOSE(sa, sb, acc[0][tm][j], acc[1][tm][j]); }
#pragma unroll
                    for (int qi = 0; qi < 4; ++qi) { const int qq = LRU_TM(qi); const float xa = lane_get(sa, c16 + 16 * qq), xb = lane_get(sb, c16 + 16 * qq); LRU_COMPOSE(TA, TB, xa, xb); } }
                if (q == 0) AGG[(((size_t)b * 36 + chunk) * 2 + dr) * DM + ch] = make_float2(TA, TB);
            } else {
                float H = ((const LAS float*)(L + HIN_OFF))[ui * 256 + dr * 128 + chl];
#pragma unroll
                for (int ti = 0; ti < 4; ++ti) { const int tm = LRU_TM(ti); float sa = 1.f, sb = 0.f;
#pragma unroll
                    for (int ji = 0; ji < 4; ++ji) { const int j = LRU_TM(ji); LRU_COMPOSE(sa, sb, acc[0][tm][j], acc[1][tm][j]); }
                    float ea = 1.f, eb = 0.f, ta = 1.f, tb = 0.f;
#pragma unroll
                    for (int qi = 0; qi < 4; ++qi) { const int qq = LRU_TM(qi); const float xa = lane_get(sa, c16 + 16 * qq), xb = lane_get(sb, c16 + 16 * qq); if (qq == q) { ea = ta; eb = tb; } LRU_COMPOSE(ta, tb, xa, xb); }
                    float hs = ea * H + eb;
#pragma unroll
                    for (int ji = 0; ji < 4; ++ji) { const int j = LRU_TM(ji); hs = acc[0][tm][j] * hs + acc[1][tm][j]; LAS float* yp = (LAS float*)(L + YO_OFF + (tm * 16 + q * 4 + j) * YO_PITCH + chl * 4);
                        if (dr == 0) *yp = hs; else *yp += hs; }
                    H = ta * H + tb; }
            }
#undef LRU_TM
        }
        if constexpr (FINAL) {
            __syncthreads();
            bf16_t* YB0 = WSB(WS_YB);
#pragma unroll
            for (int i = 0; i < 2; ++i) { const int cidx = tid + 512 * i, row = cidx >> 4, cgo = cidx & 15; const size_t rgl = rb + t0 + row;
                const f32x4 y0 = *(const LAS f32x4*)(L + YO_OFF + row * YO_PITCH + cgo * 32), y1 = *(const LAS f32x4*)(L + YO_OFF + row * YO_PITCH + cgo * 32 + 16);
                const v4u z = zcur[i];
                v4u o; o.x = pk2(y0[0] * blo(z.x), y0[1] * bhi(z.x)); o.y = pk2(y0[2] * blo(z.y), y0[3] * bhi(z.y)); o.z = pk2(y1[0] * blo(z.z), y1[1] * bhi(z.z)); o.w = pk2(y1[2] * blo(z.w), y1[3] * bhi(z.w));
                *(v4u*)(YB0 + rgl * DM + blk * 128 + cgo * 8) = o; }
        }
    }
#undef LRU_LOAD
}
__device__ __forceinline__ void p_lru_agg(Frame& F, CArgs* ka, int l) {
    for (int v = F.wg; v < 256; v += F.G) { const int blk = v & 15, c0 = v >> 4;
        lru_run<false>(F, ka, l, blk, 9, [c0](int i, int& b, int& c) { const int x = c0 + 16 * i; b = x / 36; c = x - b * 36; }); }
}
__device__ __forceinline__ void p_lru_final(Frame& F, CArgs* ka, int l) {
    for (int v = F.wg; v < 256; v += F.G) { const int b = v >> 6, blk = (v >> 2) & 15, qt = v & 3;
        const int tid = tid_fresh();
        __syncthreads();
        if (tid < 256) { const int dirx = tid >> 7, chl = tid & 127; const float2* AGG = (const float2*)WSF(WS_LA) + ((size_t)b * 36 * 2 + dirx) * DM + blk * 128 + chl;
            LAS float* HIN = (LAS float*)(F.lds + HIN_OFF); float hcar = 0.f;
#pragma unroll 12
            for (int k = 0; k < 36; ++k) { const int cidx = ml::chunk_of(k, dirx); const float2 ab = AGG[(size_t)cidx * 2 * DM];
                const int sl = cidx - qt * 9; if (sl >= 0 && sl < 9) HIN[sl * 256 + dirx * 128 + chl] = hcar;
                hcar = ab.x * hcar + ab.y; } }
        lru_run<true>(F, ka, l, blk, 9, [b, qt](int i, int& bb, int& c) { bb = b; c = qt * 9 + i; });
    }
}
}

#ifndef GEMM_NHALF
#define GEMM_NHALF false
#endif
#ifndef CONVERT_AHEAD
#define CONVERT_AHEAD 1
#endif
#ifndef DUP_PRO
#define DUP_PRO 0
#endif
#ifndef DUP_THIN
#define DUP_THIN 0
#endif
#ifndef DUP_G1
#define DUP_G1 0
#endif
#ifndef DUP_HEAVY
#define DUP_HEAVY 0
#endif
#ifndef DUP_ATT
#define DUP_ATT 0
#endif
#ifndef DUP_ML
#define DUP_ML 0
#endif
#ifndef DUP_LRU1
#define DUP_LRU1 0
#endif
#ifndef DUP_G23
#define DUP_G23 0
#endif
__global__ void __launch_bounds__(NWAVES * 64, 2) fwd(Args args) {
    extern __shared__ __attribute__((aligned(16))) unsigned char lds[];
    Frame F;
    F.lds = (LAS unsigned char*)lds; F.ldsg = (char*)lds;
    F.tid = threadIdx.x; F.lane = F.tid & 63; F.wave = __builtin_amdgcn_readfirstlane(F.tid >> 6); F.G = gridDim.x; F.wg = blockIdx.x;
    CArgs* const ka0 = (CArgs*)__builtin_amdgcn_kernarg_segment_ptr();
    unsigned char* ws; { CArgs* ka = ka0; ws = ka->ws; }
    volatile LAS unsigned* MISC = (volatile LAS unsigned*)(F.lds + MISC_OFF);
    if (F.tid < 64) ((LAS unsigned*)(F.lds + MISC_OFF))[F.tid] = 0u;
    __syncthreads();
    const int lo = ka0->ph_lo, hi = ka0->ph_hi;
    XcdBarrier bar; bar.bar = (unsigned*)(ws + WS_CTL) + CW_BAR; bar.x = 0; bar.st = nullptr;
    if (hi - lo > 1) bar = xcd_barrier_post((unsigned*)(ws + WS_CTL) + CW_BAR, MISC + 8);
#define IN(k) (lo <= (k) && (k) < hi)
#define SEAM(k) do { if ((k) + 1 < hi) xcd_barrier(bar); } while (0)

    if (IN(0)) { for (int rep = 0; rep <= DUP_PRO; ++rep) { const int wv = F.wg * NWAVES + F.wave, nwv = F.G * NWAVES;
            for (int lc = 0; lc < (CONVERT_AHEAD ? 1 : DEPTH); ++lc) p_convert(F, KA(), lc, wv, nwv);
            p_prologue(F, KA()); }
        SEAM(0); }
#pragma unroll 1
    for (int l = 0; l < DEPTH; ++l) {
        const int base = 1 + l * PH_PER_LAYER; const bool need_ctx = l < DEPTH - 1;
        if (IN(base + 0)) { p_norm(F, KA(), l); SEAM(base + 0); }
        if (IN(base + 1)) {
            CArgs* ka = KA(); pg8::Gemm g{WSB(WS_H), WSB(WS_WIN) + (size_t)l * NP * DM, MROWS, NP, DM, 0, 0}; pg8::StaticOrder S; S.init(MROWS, NP, F.G, F.wg);
            pg8::EpiIn E{WSB(WS_P)};
            pg8::gemm_phase<pg8::EpiIn, pg8::StaticOrder, true, true>(F.lds, g, S, E);
            if (DUP_G1) pg8::gemm_phase<pg8::EpiIn, pg8::StaticOrder, true, true>(F.lds, g, S, E);
            SEAM(base + 1);
        }
        if (IN(base + 2)) { p_prep(F, KA(), l);
#if USE_NAIVE_LRU
            p_lru_gates_naive(F, KA(), l);
#endif
            SEAM(base + 2); }
        if (IN(base + 3)) { for (int rep = 0; rep <= DUP_HEAVY; ++rep) { for (int r2 = 0; r2 <= DUP_ATT; ++r2) p_attention(F, KA(), l, need_ctx);
#if USE_NAIVE_ML
            p_mlstm_naive(F, KA(), l);
#else
            for (int r2 = 0; r2 <= DUP_ML; ++r2) for (int u = F.wg; u < 256; u += F.G) ml::mlstm_unit(F, KA(), u, need_ctx);
#endif
#if USE_NAIVE_LRU
            p_lru_scan_naive(F, KA());
#else
            for (int r2 = 0; r2 <= DUP_LRU1; ++r2) lru::p_lru_agg(F, KA(), l);
#endif
            }
            SEAM(base + 3); }
        if (IN(base + 4)) { for (int rep = 0; rep <= DUP_THIN; ++rep) { p_mlout(F, KA(), l);
#if USE_NAIVE_LRU
            p_lru_combine_naive(F, KA());
#else
            lru::p_lru_final(F, KA(), l);
#endif
            }
            SEAM(base + 4); }
        if (IN(base + 5)) {
            CArgs* ka = KA(); pg8::Gemm g{WSB(WS_YB), WSB(WS_WBR) + (size_t)l * 3 * DM * DM, MROWS, DM, DM, (size_t)MROWS * DM * 2, (size_t)DM * DM * 2}; pg8::MergeOrder S; S.init(MROWS, DM, F.G, F.wg, GEMM_NHALF ? 128 : 256);
            pg8::EpiMerge<GEMM_NHALF> E{WSB(WS_P), WSF(WS_ACC), WSB(WS_G2)};
            pg8::gemm_phase<pg8::EpiMerge<GEMM_NHALF>, pg8::MergeOrder, true, true, GEMM_NHALF>(F.lds, g, S, E);
            if (DUP_G23) pg8::gemm_phase<pg8::EpiMerge<GEMM_NHALF>, pg8::MergeOrder, true, true, GEMM_NHALF>(F.lds, g, S, E);
            if (CONVERT_AHEAD && l + 1 < DEPTH) {
                const int ntile = (MROWS / 256) * (DM / (GEMM_NHALF ? 128 : 256)), busy2 = (ntile > F.G && ntile < 2 * F.G) ? ntile - F.G : 0;
                if (F.wg >= busy2) p_convert(F, KA(), l + 1, (F.wg - busy2) * NWAVES + F.wave, (F.G - busy2) * NWAVES); }
            SEAM(base + 5);
        }
        if (IN(base + 6)) {
            CArgs* ka = KA(); pg8::Gemm g{WSB(WS_G2), WSB(WS_WOUT) + (size_t)l * DM * DM, MROWS, DM, DM, 0, 0}; pg8::StaticOrder S; S.init(MROWS, DM, F.G, F.wg, GEMM_NHALF ? 128 : 256);
            pg8::EpiF32<GEMM_NHALF> E{WSF(WS_Y), DM};
            pg8::gemm_phase<pg8::EpiF32<GEMM_NHALF>, pg8::StaticOrder, true, true, GEMM_NHALF>(F.lds, g, S, E);
            if (DUP_G23) pg8::gemm_phase<pg8::EpiF32<GEMM_NHALF>, pg8::StaticOrder, true, true, GEMM_NHALF>(F.lds, g, S, E);
            SEAM(base + 6);
        }
    }
    if (IN(N_PHASES - 1)) p_norm(F, KA(), DEPTH);
#undef IN
#undef SEAM
}

extern "C" void kernel_launch(void* const* d_in, const int* in_sizes, int n_in, void* d_out, int out_size, void* d_ws, size_t ws_size, hipStream_t stream) {
    static int grid = 0;
    if (grid == 0) {
        if (n_in != 22 || in_sizes[0] != NBATCH * SEQ * DM || out_size != NBATCH * SEQ * DM || ws_size < WS_END) {
            fprintf(stderr, "kernel_launch: unexpected shapes: n_in %d in0 %d out %d ws %zu (need %zu)\n", n_in, n_in > 0 ? in_sizes[0] : -1, out_size, ws_size, (size_t)WS_END); grid = -1; return; }
        int dev = 0, cus = 0, per_cu = 0;
        if (hipGetDevice(&dev) != hipSuccess || hipDeviceGetAttribute(&cus, hipDeviceAttributeMultiprocessorCount, dev) != hipSuccess) { fprintf(stderr, "kernel_launch: device query failed\n"); grid = -1; return; }
        if (hipFuncSetAttribute((const void*)fwd, hipFuncAttributeMaxDynamicSharedMemorySize, LDS_BYTES) != hipSuccess) { fprintf(stderr, "kernel_launch: hipFuncSetAttribute failed\n"); grid = -1; return; }
        if (hipOccupancyMaxActiveBlocksPerMultiprocessor(&per_cu, (const void*)fwd, NWAVES * 64, LDS_BYTES) != hipSuccess || per_cu < 1)
            fprintf(stderr, "kernel_launch: note: occupancy query reports %d workgroups per CU\n", per_cu);
        (void)hipGetLastError();
        grid = cus;
    }
    if (grid < 0) return;
    if (hipMemsetAsync((char*)d_ws + WS_CTL, 0, CTL_ZERO_BYTES, stream) != hipSuccess) { fprintf(stderr, "kernel_launch: memset failed\n"); return; }
    Args a{};
    for (int i = 0; i < 22; ++i) a.in[i] = (const float*)d_in[i];
    a.out = (float*)d_out; a.ws = (unsigned char*)d_ws;
    if (MK_N_LAUNCHES == 1) { a.ph_lo = 0; a.ph_hi = N_PHASES; hipLaunchKernelGGL(fwd, dim3(grid), dim3(NWAVES * 64), LDS_BYTES, stream, a); }
    else for (int k = 0; k < N_PHASES; ++k) { a.ph_lo = k; a.ph_hi = k + 1; hipLaunchKernelGGL(fwd, dim3(grid), dim3(NWAVES * 64), LDS_BYTES, stream, a); }
    const hipError_t le = hipPeekAtLastError();
    if (le != hipSuccess) fprintf(stderr, "kernel_launch: launch failed: %s\n", hipGetErrorName(le));
}
```

```cpp
#include <hip/hip_runtime.h>
#include <hip/hip_bf16.h>
#include <cstdio>
#include <cstdint>

constexpr int DM = 2048, NBATCH = 4, SEQ = 2048, CTXL = 256, TPB = SEQ + CTXL  , MROWS = NBATCH * TPB  , DEPTH = 4;
constexpr int NIN = 25632, NP = 25600;
constexpr int C_LX = 0, C_LZ = 2048, C_MQ = 4096, C_MK = 6144, C_MV = 8192, C_MO = 10240, C_MZ = 12288, C_AQ = 14336, C_AK = 16384, C_AV = 16896, C_AZ = 17408, C_MG = 19456;
constexpr float EPS = 1e-6f;
namespace pg8 {
#define PG8_LAS __attribute__((address_space(3)))
typedef unsigned short bf16_t;
typedef short bf16x8 __attribute__((ext_vector_type(8)));
typedef float f32x4 __attribute__((ext_vector_type(4)));
typedef unsigned u32x4 __attribute__((ext_vector_type(4)));
constexpr int BM = 256, BK = 64, HALF = 128, HTB = HALF * BK * 2  , STAGE_BYTES = 8 * HTB, NXCD = 8, WGM = 8;

__host__ __device__ __forceinline__ int lds_byte(int r, int c) { const int st = (r >> 4) * 2 + (c >> 5), rr = r & 15, cc = c & 31, ob = rr * 64 + cc * 2; return st * 1024 + (ob ^ (((ob >> 9) & 1) << 5)); }
__host__ __device__ __forceinline__ void stage_rc(int b, int& R, int& C) { const int st = b / 1024, sb = b % 1024, swz = sb ^ (((sb >> 9) & 1) << 5); R = (st >> 1) * 16 + swz / 64; C = (st & 1) * 32 + (swz % 64) / 2; }
__host__ __device__ __forceinline__ int perm32(int rho) { const int n = rho >> 4, i = rho & 15; return 8 * (i >> 2) + 4 * n + (i & 3); }

struct Unit { int pm, pn, z; };
struct Gemm { const bf16_t* A; const bf16_t* Bt; int M, N, K; size_t zA, zB; };

struct StaticOrder {
    int nM, nN, nwg, G, c; bool lat;
    __host__ __device__ void init(int M, int N, int G_, int c_, int tileN = BM, bool lat_ = false) { lat = lat_; nM = lat ? (M / BM) * 8 / 9 : M / BM; nN = N / tileN; nwg = nM * nN; G = G_; c = c_; }
    __host__ __device__ bool map(long L, Unit& u) const {
        if (L >= nwg) return false;
        int wgid = (int)L; { const int q = nwg / NXCD, r = nwg % NXCD, xcd = wgid % NXCD, off = wgid / NXCD; wgid = (xcd < r ? xcd * (q + 1) : r * (q + 1) + (xcd - r) * q) + off; }
        const int nig = WGM * nN, gid = wgid / nig, fm = gid * WGM, gsz = (nM - fm) < WGM ? (nM - fm) : WGM;
        u.pm = fm + ((wgid % nig) % gsz); u.pn = (wgid % nig) / gsz; u.z = 0; if (lat) u.pm = (u.pm >> 3) * 9 + (u.pm & 7); return true;
    }
    __host__ __device__ bool next(int i, Unit& u) const { return map((long)i * G + c, u); }
    __device__ __forceinline__ void a_ready(const Unit&) const {}
    __device__ __forceinline__ void done(const Unit&) const {}
};
struct InOrder : StaticOrder {
    __host__ __device__ bool next(int i, Unit& u) const { const long L = (long)i * G + c; if (L < nwg) return map(L, u);
        if (!lat) return false; const int idx = (int)(L - nwg); if (idx >= 4 * 28) return false;
        const int bb = idx / 28, j = idx - bb * 28; u.pm = 9 * bb + 8; u.z = 0; u.pn = j < 8 ? j : j < 16 ? 16 + j : j < 24 ? 16 + j : j < 26 ? 40 + j : 40 + j; return true; }
};
struct MergeOrder : StaticOrder {
    __host__ __device__ bool next(int i, Unit& u) const { const int it = i / 3; if (!StaticOrder::next(it, u)) return false; u.z = i - 3 * it; return true; }
};

__device__ __forceinline__ unsigned cvt_pk_bf16(float lo, float hi) { unsigned r; asm volatile("v_cvt_pk_bf16_f32 %0, %1, %2" : "=v"(r) : "v"(lo), "v"(hi)); return r; }
__device__ __forceinline__ float bflo(unsigned w) { return __uint_as_float(w << 16); }
__device__ __forceinline__ float bfhi(unsigned w) { return __uint_as_float(w & 0xffff0000u); }
__device__ __forceinline__ float sigmoid_f(float x) { return __builtin_amdgcn_rcpf(1.f + __expf(-x)); }

template <bool NHALF> struct EpiF32 {
    static constexpr bool PERM = false, AFTER_DRAIN = false;
    float* C; int ldc;
    __device__ __forceinline__ void operator()(const f32x4 (&acc)[2][2][4][2], const Unit& u, int wr, int wc, int fr, int fq) const {
        const int row0 = u.pm * BM + wr * 64 + fr, col0 = u.pn * (NHALF ? HALF : BM) + wc * 32 + 4 * fq;
#pragma unroll
        for (int ai = 0; ai < 2; ++ai)
#pragma unroll
            for (int m = 0; m < 4; ++m) { float* rowp = C + (size_t)(row0 + ai * HALF + m * 16) * ldc + col0;
#pragma unroll
                for (int bj = 0; bj < (NHALF ? 1 : 2); ++bj)
#pragma unroll
                    for (int n = 0; n < 2; ++n) *(f32x4*)(rowp + bj * HALF + n * 16) = acc[ai][bj][m][n]; }
    }
};
struct EpiIn {
    static constexpr bool PERM = true, AFTER_DRAIN = false;
    bf16_t* O;
    __device__ __forceinline__ void operator()(const f32x4 (&acc)[2][2][4][2], const Unit& u, int wr, int wc, int fr, int fq) const {
        const int row0 = u.pm * BM + wr * 64 + fr, col0 = u.pn * BM + wc * 32 + 8 * fq, pn = u.pn;
        int act = 0;
        if ((pn >= 8 && pn < 16) || (pn >= 48 && pn < 56) || (pn >= 68 && pn < 76)) act = 1;
        else if ((pn >= 40 && pn < 48) || pn >= 76) act = 2;
        else if (pn >= 24 && pn < 32) act = 3;
#pragma unroll
        for (int ai = 0; ai < 2; ++ai)
#pragma unroll
            for (int m = 0; m < 4; ++m) { bf16_t* rowp = O + (size_t)(row0 + ai * HALF + m * 16) * NP + col0;
#pragma unroll
                for (int bj = 0; bj < 2; ++bj) { f32x4 v0 = acc[ai][bj][m][0], v1 = acc[ai][bj][m][1];
                    if (act == 1) {
#pragma unroll
                        for (int j = 0; j < 4; ++j) { v0[j] = v0[j] * sigmoid_f(v0[j]); v1[j] = v1[j] * sigmoid_f(v1[j]); } }
                    else if (act == 2) {
#pragma unroll
                        for (int j = 0; j < 4; ++j) { v0[j] = sigmoid_f(v0[j]); v1[j] = sigmoid_f(v1[j]); } }
                    else if (act == 3) { v0 = v0 * 0.0625f; v1 = v1 * 0.0625f; }
                    u32x4 w; w.x = cvt_pk_bf16(v0[0], v0[1]); w.y = cvt_pk_bf16(v0[2], v0[3]); w.z = cvt_pk_bf16(v1[0], v1[1]); w.w = cvt_pk_bf16(v1[2], v1[3]);
                    *(u32x4*)(rowp + bj * HALF) = w; } }
    }
};
template <bool NHALF> struct EpiMerge {
    static constexpr bool PERM = true, AFTER_DRAIN = false;
    const bf16_t* P; float* ACC; bf16_t* G2;
    __device__ __forceinline__ void operator()(const f32x4 (&acc)[2][2][4][2], const Unit& u, int wr, int wc, int fr, int fq) const {
        const int row0 = u.pm * BM + wr * 64 + fr, col0 = u.pn * (NHALF ? HALF : BM) + wc * 32 + 8 * fq, z = u.z;
#pragma unroll
        for (int ai = 0; ai < 2; ++ai)
#pragma unroll
            for (int m = 0; m < 4; ++m) { const size_t r = (size_t)(row0 + ai * HALF + m * 16);
#pragma unroll
                for (int bj = 0; bj < (NHALF ? 1 : 2); ++bj) { const int c = col0 + bj * HALF;
                    const u32x4 g = *(const u32x4*)(P + r * NP + C_MG + z * DM + c);
                    f32x4 v0 = acc[ai][bj][m][0], v1 = acc[ai][bj][m][1];
                    v0[0] *= bflo(g.x); v0[1] *= bfhi(g.x); v0[2] *= bflo(g.y); v0[3] *= bfhi(g.y);
                    v1[0] *= bflo(g.z); v1[1] *= bfhi(g.z); v1[2] *= bflo(g.w); v1[3] *= bfhi(g.w);
                    float* ap = ACC + r * DM + c;
                    if (z > 0) { v0 = v0 + *(const f32x4*)ap; v1 = v1 + *(const f32x4*)(ap + 4); }
                    if (z < 2) { *(f32x4*)ap = v0; *(f32x4*)(ap + 4) = v1; }
                    else { u32x4 w; w.x = cvt_pk_bf16(v0[0], v0[1]); w.y = cvt_pk_bf16(v0[2], v0[3]); w.z = cvt_pk_bf16(v1[0], v1[1]); w.w = cvt_pk_bf16(v1[2], v1[3]);
                        *(u32x4*)(G2 + r * DM + c) = w; } } }
    }
};
template <class Epi, class Sched, bool ALIGN_EPI = false, bool SP2 = false, bool NHALF = false>
__device__ __forceinline__ void gemm_phase(PG8_LAS unsigned char* lds, const Gemm g, const Sched& S, const Epi& E) {
    int tid = threadIdx.x; asm volatile("" : "+v"(tid));
    const int wid = __builtin_amdgcn_readfirstlane(tid >> 6), lane = tid & 63, wr = wid >> 2, wc = wid & 3, fr = lane & 15, fq = lane >> 4;
    const int K = g.K, nt = K / BK;
    unsigned voffA[2], voffB[2];
#pragma unroll
    for (int i = 0; i < 2; ++i) { int R, C; stage_rc(tid * 16 + i * 8192, R, C); const int Rb = Epi::PERM ? ((R & ~31) + perm32(R & 31)) : R;
        voffA[i] = (unsigned)(R * K + C) * 2u; voffB[i] = (unsigned)(Rb * K + C) * 2u; }
    const size_t kstep = (size_t)(BK * 2);
    const size_t hstep = (size_t)HALF * K * 2;
    const size_t tstep = 2 * hstep;
    const size_t hsB = NHALF ? 0 : hstep, tstepB = NHALF ? hstep : tstep; static_assert(!NHALF || SP2, "NHALF is implemented for the SP2 loop");
    const unsigned ldsw = (unsigned)wid * 1024u;
    const int aoff = lds_byte(wr * 64 + fr, fq * 8), boff = lds_byte(wc * 32 + fr, fq * 8);
#define PG8_SA(b, h) (((b) * 2 + (h)) * HTB)
#define PG8_SB(b, h) ((4 + (b) * 2 + (h)) * HTB)
#define PG8_STAGE(bufoff, gbase, voff) do { _Pragma("unroll") for (int _i = 0; _i < 2; ++_i) \
        __builtin_amdgcn_global_load_lds((const unsigned*)((const char*)(gbase) + (voff)[_i]), (PG8_LAS unsigned*)(lds + (bufoff) + ldsw + _i * 8192), 16, 0, 0); } while (0)
#define PG8_LDA(dst, b, h) do { _Pragma("unroll") for (int m = 0; m < 4; ++m) _Pragma("unroll") for (int k = 0; k < 2; ++k) dst[m][k] = *(const PG8_LAS bf16x8*)(lds + PG8_SA(b, h) + aoff + m * 2048 + k * 1024); } while (0)
#define PG8_LDB(dst, b, h) do { _Pragma("unroll") for (int n = 0; n < 2; ++n) _Pragma("unroll") for (int k = 0; k < 2; ++k) dst[n][k] = *(const PG8_LAS bf16x8*)(lds + PG8_SB(b, h) + boff + n * 2048 + k * 1024); } while (0)
#define PG8_MMA(ai, bj, At, Bt) do { __builtin_amdgcn_s_setprio(1); _Pragma("unroll") for (int m = 0; m < 4; ++m) _Pragma("unroll") for (int n = 0; n < 2; ++n) _Pragma("unroll") for (int k = 0; k < 2; ++k) \
        acc[ai][bj][m][n] = __builtin_amdgcn_mfma_f32_16x16x32_bf16(Bt[n][k], At[m][k], acc[ai][bj][m][n], 0, 0, 0); __builtin_amdgcn_s_setprio(0); } while (0)
#define PG8_WAIT_V(n) asm volatile("s_waitcnt vmcnt(" #n ")" ::: "memory")
#define PG8_WAIT_L(n) asm volatile("s_waitcnt lgkmcnt(" #n ")" ::: "memory")
#define PG8_BAR __builtin_amdgcn_s_barrier()
#define PG8_SCHED __builtin_amdgcn_sched_barrier(0)
    Unit cur, nxt; int ui = 0;
    if (!S.next(0, cur)) return;
    f32x4 acc[2][2][4][2];
#pragma unroll
    for (int a = 0; a < 2; ++a)
#pragma unroll
        for (int b = 0; b < 2; ++b)
#pragma unroll
            for (int m = 0; m < 4; ++m)
#pragma unroll
                for (int n = 0; n < 2; ++n) acc[a][b][m][n] = (f32x4){0.f, 0.f, 0.f, 0.f};
    bf16x8 At[4][2], B0[2][2], B1[2][2];
    const char* cA = (const char*)g.A + (size_t)cur.z * g.zA + (size_t)cur.pm * tstep; const char* cB = (const char*)g.Bt + (size_t)cur.z * g.zB + (size_t)cur.pn * tstepB;
    S.a_ready(cur);
    if constexpr (SP2) {
        PG8_STAGE(PG8_SB(0, 0), cB, voffB); PG8_STAGE(PG8_SB(0, 1), cB + hsB, voffB); PG8_STAGE(PG8_SA(0, 0), cA, voffA); PG8_STAGE(PG8_SA(0, 1), cA + hstep, voffA);
        if (wr == 1) PG8_BAR;
        PG8_WAIT_V(2); PG8_BAR;
        PG8_STAGE(PG8_SB(1, 0), cB + kstep, voffB); PG8_STAGE(PG8_SA(1, 0), cA + kstep, voffA); PG8_STAGE(PG8_SB(1, 1), cB + hsB + kstep, voffB);
        PG8_WAIT_V(6); PG8_BAR;
    } else {
        PG8_STAGE(PG8_SB(0, 0), cB, voffB); PG8_STAGE(PG8_SA(0, 0), cA, voffA); PG8_STAGE(PG8_SB(0, 1), cB + hstep, voffB); PG8_STAGE(PG8_SA(0, 1), cA + hstep, voffA);
        if (wr == 1) PG8_BAR;
        PG8_WAIT_V(4); PG8_BAR;
        PG8_STAGE(PG8_SB(1, 0), cB + kstep, voffB); PG8_STAGE(PG8_SA(1, 0), cA + kstep, voffA); PG8_STAGE(PG8_SB(1, 1), cB + hstep + kstep, voffB);
        PG8_WAIT_V(6); PG8_BAR;
    }
    for (;;) {
        const bool has_next = S.next(ui + 1, nxt);
        const char* nA = has_next ? (const char*)g.A + (size_t)nxt.z * g.zA + (size_t)nxt.pm * tstep : cA; const char* nB = has_next ? (const char*)g.Bt + (size_t)nxt.z * g.zB + (size_t)nxt.pn * tstepB : cB;
        for (int t = 0; t < nt; t += 2) {
            const bool last = (t == nt - 2);
            const char* a1 = cA + (size_t)(t + 1) * kstep;
            const char* a2 = last ? nA : cA + (size_t)(t + 2) * kstep; const char* b2 = last ? nB : cB + (size_t)(t + 2) * kstep;
            const char* a3 = a2 + kstep; const char* b3 = b2 + kstep;
            if (last && has_next) S.a_ready(nxt);
            if constexpr (SP2) {
            PG8_LDB(B0, 0, 0); if constexpr (!NHALF) PG8_LDB(B1, 0, 1); PG8_SCHED; PG8_LDA(At, 0, 0); PG8_STAGE(PG8_SA(1, 1), a1 + hstep, voffA);
            PG8_WAIT_V(8); PG8_WAIT_L(0); PG8_BAR; PG8_MMA(0, 0, At, B0); if constexpr (!NHALF) PG8_MMA(0, 1, At, B1); PG8_BAR; PG8_SCHED;
            PG8_LDA(At, 0, 1); PG8_STAGE(PG8_SB(0, 0), b2, voffB); PG8_STAGE(PG8_SB(0, 1), b2 + hsB, voffB); PG8_STAGE(PG8_SA(0, 0), a2, voffA);
            PG8_WAIT_V(8); PG8_WAIT_L(0); PG8_BAR; PG8_MMA(1, 0, At, B0); if constexpr (!NHALF) PG8_MMA(1, 1, At, B1); PG8_BAR; PG8_SCHED;
            PG8_LDB(B0, 1, 0); if constexpr (!NHALF) PG8_LDB(B1, 1, 1); PG8_SCHED; PG8_LDA(At, 1, 0); PG8_STAGE(PG8_SA(0, 1), a2 + hstep, voffA);
            PG8_WAIT_V(8); PG8_WAIT_L(0); PG8_BAR; PG8_MMA(0, 0, At, B0); if constexpr (!NHALF) PG8_MMA(0, 1, At, B1); PG8_BAR; PG8_SCHED;
            PG8_LDA(At, 1, 1); PG8_STAGE(PG8_SB(1, 0), b3, voffB); PG8_STAGE(PG8_SB(1, 1), b3 + hsB, voffB); PG8_STAGE(PG8_SA(1, 0), a3, voffA);
            PG8_WAIT_V(8); PG8_WAIT_L(0); PG8_BAR; PG8_MMA(1, 0, At, B0); if constexpr (!NHALF) PG8_MMA(1, 1, At, B1); PG8_BAR; PG8_SCHED;
            } else {
            PG8_LDB(B0, 0, 0); PG8_SCHED; PG8_LDA(At, 0, 0); PG8_STAGE(PG8_SA(1, 1), a1 + hstep, voffA);
            PG8_WAIT_L(8); PG8_BAR; PG8_WAIT_L(0); PG8_MMA(0, 0, At, B0); PG8_BAR; PG8_SCHED;
            PG8_LDB(B1, 0, 1); PG8_STAGE(PG8_SB(0, 0), b2, voffB);
            PG8_BAR; PG8_WAIT_L(0); PG8_MMA(0, 1, At, B1); PG8_BAR;
            PG8_LDA(At, 0, 1); PG8_STAGE(PG8_SA(0, 0), a2, voffA);
            PG8_BAR; PG8_WAIT_L(0); PG8_MMA(1, 0, At, B0); PG8_BAR; PG8_SCHED;
            PG8_STAGE(PG8_SB(0, 1), b2 + hstep, voffB);
            PG8_WAIT_V(6); PG8_BAR; PG8_MMA(1, 1, At, B1); PG8_BAR;
            PG8_LDB(B0, 1, 0); PG8_SCHED; PG8_LDA(At, 1, 0); PG8_STAGE(PG8_SA(0, 1), a2 + hstep, voffA);
            PG8_WAIT_L(8); PG8_BAR; PG8_WAIT_L(0); PG8_MMA(0, 0, At, B0); PG8_BAR; PG8_SCHED;
            PG8_LDB(B1, 1, 1); PG8_STAGE(PG8_SB(1, 0), b3, voffB);
            PG8_BAR; PG8_WAIT_L(0); PG8_MMA(0, 1, At, B1); PG8_BAR;
            PG8_LDA(At, 1, 1); PG8_STAGE(PG8_SA(1, 0), a3, voffA);
            PG8_BAR; PG8_WAIT_L(0); PG8_MMA(1, 0, At, B0); PG8_BAR; PG8_SCHED;
            PG8_STAGE(PG8_SB(1, 1), b3 + hstep, voffB);
            PG8_WAIT_V(6); PG8_BAR; PG8_MMA(1, 1, At, B1); PG8_BAR;
            }
        }
        if constexpr (ALIGN_EPI) { if (wr == 0) PG8_BAR; }
        if constexpr (!Epi::AFTER_DRAIN) { E(acc, cur, wr, wc, fr, fq); S.done(cur); }
        if (!has_next) break;
#pragma unroll
        for (int a = 0; a < 2; ++a)
#pragma unroll
            for (int b = 0; b < 2; ++b)
#pragma unroll
                for (int m = 0; m < 4; ++m)
#pragma unroll
                    for (int n = 0; n < 2; ++n) acc[a][b][m][n] = (f32x4){0.f, 0.f, 0.f, 0.f};
        cur = nxt; cA = nA; cB = nB; ++ui;
        if constexpr (ALIGN_EPI) { if (wr == 1) PG8_BAR; }
    }
    PG8_WAIT_V(0);
    if constexpr (!ALIGN_EPI) { if (wr == 0) PG8_BAR; }
    PG8_BAR;
    if constexpr (Epi::AFTER_DRAIN) { E.fused(acc, cur, wr, wc, fr, fq, lds, wid, lane); S.done(cur); }
#undef PG8_SA
#undef PG8_SB
#undef PG8_STAGE
#undef PG8_LDA
#undef PG8_LDB
#undef PG8_MMA
#undef PG8_WAIT_V
#undef PG8_WAIT_L
#undef PG8_BAR
#undef PG8_SCHED
}
}

namespace att {
using bf16 = __hip_bfloat16;
constexpr int   D = 128, NW = 8, QBLK = 32, KVBLK = 64;
constexpr float SCALE = 0.088388347648318440f;
constexpr float THR = 8.f;
#ifndef ATT_SDEPTH
#define ATT_SDEPTH 1
#endif
constexpr int SDEPTH = ATT_SDEPTH;
constexpr int LDQ = NP, LDK = NP, LDO = DM;
constexpr size_t SHM_V = KVBLK * D * 2, SHM_K = KVBLK * D * 2, SHM_ATTN = 2 * SHM_V + 2 * SHM_K + NW * 64 * 4;
constexpr int OST_OFF = 69632, OST_END = OST_OFF + NW * 32 * 272;
using bf16x8 = __attribute__((ext_vector_type(8))) short;
using s16x4  = __attribute__((ext_vector_type(4))) short;
using f32x16 = __attribute__((ext_vector_type(16))) float;
using f32x4  = __attribute__((ext_vector_type(4))) float;
using u32x4  = __attribute__((ext_vector_type(4))) unsigned;
#define KSWZ(row, colB) ((row) * 256 + ((colB) ^ (((row) & 7) << 4)))
#define SBAR() __builtin_amdgcn_sched_barrier(0)
__device__ __forceinline__ int crow(int r, int hi) { return (r & 3) + 8 * (r >> 2) + 4 * hi; }
__device__ __forceinline__ unsigned cvtpk(float lo, float hi) { unsigned r; asm volatile("v_cvt_pk_bf16_f32 %0, %1, %2" : "=v"(r) : "v"(lo), "v"(hi)); return r; }
__device__ __forceinline__ bf16x8 ld8(const bf16* p) { return *reinterpret_cast<const bf16x8*>(p); }

__device__ __forceinline__ void partialSM(f32x16& p0, f32x16& p1, float& m_reg, float& mn, float& alpha) {
  constexpr float C = SCALE * 1.4426950408889634f;
  float pmax = p0[0];
#pragma unroll
  for (int r = 1; r < 16; ++r) pmax = fmaxf(pmax, p0[r]);
#pragma unroll
  for (int r = 0; r < 16; ++r) pmax = fmaxf(pmax, p1[r]);
  { auto rr = __builtin_amdgcn_permlane32_swap(__float_as_uint(pmax), __float_as_uint(pmax), false, false);
    pmax = fmaxf(__uint_as_float(rr[0]), __uint_as_float(rr[1])); }
  if (__builtin_expect(__all(pmax - m_reg <= THR / SCALE), 1)) { mn = m_reg; alpha = 1.f; }
  else { mn = fmaxf(m_reg, pmax); alpha = __builtin_amdgcn_exp2f((m_reg - mn) * C); m_reg = mn; }
  float mnC = -mn * C;
#pragma unroll
  for (int r = 0; r < 16; ++r) p0[r] = fmaf(p0[r], C, mnC);
#pragma unroll
  for (int r = 0; r < 16; ++r) p1[r] = fmaf(p1[r], C, mnC);
#pragma unroll
  for (int r = 0; r < 16; ++r) p0[r] = __builtin_amdgcn_exp2f(p0[r]);
}
__device__ __forceinline__ void finishSM(f32x16& p0, f32x16& p1, float alpha, float& l_reg, bf16x8& pa0, bf16x8& pa1, bf16x8& pa2, bf16x8& pa3) {
#pragma unroll
  for (int r = 0; r < 16; ++r) p1[r] = __builtin_amdgcn_exp2f(p1[r]);
  float ps = 0;
#pragma unroll
  for (int r = 0; r < 16; ++r) ps += p0[r];
#pragma unroll
  for (int r = 0; r < 16; ++r) ps += p1[r];
  { auto rr = __builtin_amdgcn_permlane32_swap(__float_as_uint(ps), __float_as_uint(ps), false, false);
    ps = __uint_as_float(rr[0]) + __uint_as_float(rr[1]); }
  l_reg = l_reg * alpha + ps;
#define PK4(P, BASE, OUT) do { unsigned a0 = cvtpk(P[BASE + 0], P[BASE + 1]), a1 = cvtpk(P[BASE + 2], P[BASE + 3]);   \
    unsigned b0 = cvtpk(P[BASE + 4], P[BASE + 5]), b1 = cvtpk(P[BASE + 6], P[BASE + 7]);                              \
    auto r0 = __builtin_amdgcn_permlane32_swap(a0, b0, false, false); auto r1 = __builtin_amdgcn_permlane32_swap(a1, b1, false, false); \
    u32x4 w = {r0[0], r1[0], r0[1], r1[1]}; OUT = *reinterpret_cast<bf16x8*>(&w); } while (0)
  PK4(p0, 0, pa0); PK4(p0, 8, pa1); PK4(p1, 0, pa2); PK4(p1, 8, pa3);
#undef PK4
}
__device__ __forceinline__ void qkt(f32x16& p0, f32x16& p1, const bf16* Ks, const bf16x8* qr, int r32, int hi) {
  p0 = f32x16{}; p1 = f32x16{};
#pragma unroll
  for (int d0 = 0; d0 < 8; ++d0) { int cb = (d0 * 16 + hi * 8) * 2;
    bf16x8 b0 = *reinterpret_cast<const bf16x8*>((const char*)Ks + KSWZ(r32, cb));
    bf16x8 b1 = *reinterpret_cast<const bf16x8*>((const char*)Ks + KSWZ(32 + r32, cb));
    p0 = __builtin_amdgcn_mfma_f32_32x32x16_bf16(b0, qr[d0], p0, 0, 0, 0);
    p1 = __builtin_amdgcn_mfma_f32_32x32x16_bf16(b1, qr[d0], p1, 0, 0, 0); }
}
__device__ __forceinline__ int v_st(int k, int c) { const int kk = (k & ~0xC) | ((k & 4) << 1) | ((k & 8) >> 1); return ((kk >> 3) * 4 + (c >> 5)) * 512 + ((kk & 7) * 32 + (c & 31)) * 2; }
__device__ __forceinline__ int v_rd_base(int lane) { return ((lane & 3) << 3) | (((lane >> 2) & 3) << 6) | (((lane >> 4) & 1) << 5) | (((lane >> 5) & 1) << 8); }
constexpr int v_rd_off(int d0, int ks, int half) { return d0 * 512 + ks * 4096 + half * 2048; }
template <int OFF> __device__ __forceinline__ s16x4 tr_read(int vb) {
  s16x4 r; asm volatile("ds_read_b64_tr_b16 %0, %1 offset:%2" : "=&v"(r) : "v"(vb), "i"(OFF) : "memory"); return r;
}
template <int D0> __device__ __forceinline__ void pv_one(f32x16& od, int vb, bf16x8 pa0, bf16x8 pa1, bf16x8 pa2, bf16x8 pa3) {
  const s16x4 l0 = tr_read<v_rd_off(D0, 0, 0)>(vb), h0 = tr_read<v_rd_off(D0, 0, 1)>(vb), l1 = tr_read<v_rd_off(D0, 1, 0)>(vb), h1 = tr_read<v_rd_off(D0, 1, 1)>(vb);
  const s16x4 l2 = tr_read<v_rd_off(D0, 2, 0)>(vb), h2 = tr_read<v_rd_off(D0, 2, 1)>(vb), l3 = tr_read<v_rd_off(D0, 3, 0)>(vb), h3 = tr_read<v_rd_off(D0, 3, 1)>(vb);
  asm volatile("s_waitcnt lgkmcnt(0)" ::: "memory"); SBAR();
#define PK(L, H) (bf16x8){L[0], L[1], L[2], L[3], H[0], H[1], H[2], H[3]}
  od = __builtin_amdgcn_mfma_f32_32x32x16_bf16(pa0, PK(l0, h0), od, 0, 0, 0);
  od = __builtin_amdgcn_mfma_f32_32x32x16_bf16(pa1, PK(l1, h1), od, 0, 0, 0);
  od = __builtin_amdgcn_mfma_f32_32x32x16_bf16(pa2, PK(l2, h2), od, 0, 0, 0);
  od = __builtin_amdgcn_mfma_f32_32x32x16_bf16(pa3, PK(l3, h3), od, 0, 0, 0);
#undef PK
}
__device__ __forceinline__ void pv_d0(f32x16* o, int vb, bf16x8 pa0, bf16x8 pa1, bf16x8 pa2, bf16x8 pa3) {
  pv_one<0>(o[0], vb, pa0, pa1, pa2, pa3); pv_one<1>(o[1], vb, pa0, pa1, pa2, pa3); pv_one<2>(o[2], vb, pa0, pa1, pa2, pa3); pv_one<3>(o[3], vb, pa0, pa1, pa2, pa3);
}

__device__ __forceinline__ void attn_unit(const bf16* __restrict__ Qb, const bf16* __restrict__ Kh, const bf16* __restrict__ Vh, const bf16* __restrict__ Zb,
                                          bf16* __restrict__ Ob, int seq, char* lds, const float* __restrict__ qn, const float* __restrict__ cs, const float* __restrict__ sn) {
  int tid = threadIdx.x; asm volatile("" : "+v"(tid));
  int wid = tid >> 6, lane = tid & 63, r32 = lane & 31, hi = lane >> 5;
  bf16* V_lds = (bf16*)lds; bf16* K_lds = (bf16*)(lds + 2 * SHM_V);
  float* ws = (float*)(lds + 2 * SHM_V + 2 * SHM_K) + wid * 64; float* li_l = ws; float* al_l = ws + 32;
  float m_reg = -1e30f, l_reg = 0; f32x16 o[4] = {}; bf16x8 qr[8];
  {
    const bf16* Qw = Qb + (long)(wid * QBLK + r32) * LDQ + hi * 8;
    float ss = 0.f;
#pragma unroll
    for (int d0 = 0; d0 < 8; ++d0) { const u32x4 w = *reinterpret_cast<const u32x4*>(Qw + d0 * 16); qr[d0] = __builtin_bit_cast(bf16x8, w);
#pragma unroll
      for (int e = 0; e < 4; ++e) { const float lo = __uint_as_float(w[e] << 16), hh = __uint_as_float(w[e] & 0xffff0000u); ss += lo * lo + hh * hh; } }
    { auto rr = __builtin_amdgcn_permlane32_swap(__float_as_uint(ss), __float_as_uint(ss), false, false); ss = __uint_as_float(rr[0]) + __uint_as_float(rr[1]); }
    const float rs = rsqrtf(ss * (1.f / 128.f) + EPS);
    const float* cp = cs ? cs + (long)(wid * QBLK + r32) * 64 + hi * 8 : nullptr; const float* sp = cs ? sn + (long)(wid * QBLK + r32) * 64 + hi * 8 : nullptr;
#pragma unroll
    for (int d0 = 0; d0 < 4; ++d0) {
      const u32x4 wa = __builtin_bit_cast(u32x4, qr[d0]), wb = __builtin_bit_cast(u32x4, qr[d0 + 4]); float x1[8], x2[8];
#pragma unroll
      for (int e = 0; e < 4; ++e) { x1[2 * e] = __uint_as_float(wa[e] << 16); x1[2 * e + 1] = __uint_as_float(wa[e] & 0xffff0000u); x2[2 * e] = __uint_as_float(wb[e] << 16); x2[2 * e + 1] = __uint_as_float(wb[e] & 0xffff0000u); }
      const f32x4 ga0 = *reinterpret_cast<const f32x4*>(qn + d0 * 16 + hi * 8), ga1 = *reinterpret_cast<const f32x4*>(qn + d0 * 16 + hi * 8 + 4);
      const f32x4 gb0 = *reinterpret_cast<const f32x4*>(qn + 64 + d0 * 16 + hi * 8), gb1 = *reinterpret_cast<const f32x4*>(qn + 64 + d0 * 16 + hi * 8 + 4);
#pragma unroll
      for (int e = 0; e < 8; ++e) { x1[e] *= rs * (e < 4 ? ga0[e & 3] : ga1[e & 3]); x2[e] *= rs * (e < 4 ? gb0[e & 3] : gb1[e & 3]); }
      if (cs) {
        const f32x4 c0 = *reinterpret_cast<const f32x4*>(cp + d0 * 16), c1 = *reinterpret_cast<const f32x4*>(cp + d0 * 16 + 4);
        const f32x4 s0 = *reinterpret_cast<const f32x4*>(sp + d0 * 16), s1 = *reinterpret_cast<const f32x4*>(sp + d0 * 16 + 4);
#pragma unroll
        for (int e = 0; e < 8; ++e) { const float c = e < 4 ? c0[e & 3] : c1[e & 3], sv = e < 4 ? s0[e & 3] : s1[e & 3];
          const float a = x1[e], bq = x2[e]; x1[e] = a * c - bq * sv; x2[e] = bq * c + a * sv; }
      }
      const u32x4 oa = {cvtpk(x1[0], x1[1]), cvtpk(x1[2], x1[3]), cvtpk(x1[4], x1[5]), cvtpk(x1[6], x1[7])}, ob = {cvtpk(x2[0], x2[1]), cvtpk(x2[2], x2[3]), cvtpk(x2[4], x2[5]), cvtpk(x2[6], x2[7])};
      qr[d0] = __builtin_bit_cast(bf16x8, oa); qr[d0 + 4] = __builtin_bit_cast(bf16x8, ob);
      asm volatile("" ::: "memory");
    }
  }
  const int sr = tid >> 4, sc = (tid & 15) * 8, vst0 = v_st(sr, sc), vst1 = v_st(32 + sr, sc);
  const int vb0 = (int)(uintptr_t)V_lds + v_rd_base(lane);
  struct { bf16x8 vs0, vs1, ks0, ks1; } sr_[SDEPTH];
#define SLOAD(i, k0) do { sr_[i].vs0 = ld8(&Vh[(long)((k0) + sr) * LDK + sc]); sr_[i].vs1 = ld8(&Vh[(long)((k0) + 32 + sr) * LDK + sc]); \
    sr_[i].ks0 = ld8(&Kh[(long)((k0) + sr) * LDK + sc]); sr_[i].ks1 = ld8(&Kh[(long)((k0) + 32 + sr) * LDK + sc]); } while (0)
#define SWRITE(b, i) do { *(bf16x8*)((char*)V_lds + (b) * SHM_V + vst0) = sr_[i].vs0;          \
    *(bf16x8*)((char*)V_lds + (b) * SHM_V + vst1) = sr_[i].vs1; int kc = sc * 2;               \
    *(bf16x8*)((char*)K_lds + (b) * SHM_K + KSWZ(sr, kc)) = sr_[i].ks0;                       \
    *(bf16x8*)((char*)K_lds + (b) * SHM_K + KSWZ(32 + sr, kc)) = sr_[i].ks1; } while (0)
#define SWAIT() do { if constexpr (SDEPTH == 2) asm volatile("s_waitcnt vmcnt(4)" ::: "memory"); else asm volatile("s_waitcnt vmcnt(0)" ::: "memory"); } while (0)
#define RESC(a) do { if (__any((a) < 1.f)) { if (hi == 0) al_l[r32] = (a); asm volatile("s_waitcnt lgkmcnt(0)" ::: "memory"); \
    _Pragma("unroll") for (int d = 0; d < 4; ++d) _Pragma("unroll") for (int r = 0; r < 16; ++r) o[d][r] *= al_l[crow(r, hi)]; } } while (0)
  f32x16 pA0, pA1, pB0, pB1; float mnA, mnB, alA, alB; bf16x8 pa0, pa1, pa2, pa3; const int NT = seq / KVBLK;
  constexpr int SE = 0, SO = SDEPTH - 1;
  SLOAD(SE, 0); asm volatile("s_waitcnt vmcnt(0)" ::: "memory"); SWRITE(0, SE); __syncthreads();
  qkt(pA0, pA1, K_lds, qr, r32, hi); partialSM(pA0, pA1, m_reg, mnA, alA);
  SLOAD(SO, KVBLK); if constexpr (SDEPTH == 2) { if (2 < NT) SLOAD(SE, 2 * KVBLK); }
  SWAIT(); SWRITE(1, SO); __syncthreads();
  for (int j = 1; j + 1 < NT; j += 2) {
    SBAR(); qkt(pB0, pB1, (bf16*)((char*)K_lds + SHM_K), qr, r32, hi);
    finishSM(pA0, pA1, alA, l_reg, pa0, pa1, pa2, pa3); SBAR();
    SLOAD(SO, (j + SDEPTH) * KVBLK); SBAR();
    pv_d0(o, vb0, pa0, pa1, pa2, pa3); partialSM(pB0, pB1, m_reg, mnB, alB);
    __syncthreads(); SWAIT(); SWRITE(0, SE);
    RESC(alB); __syncthreads();
    SBAR(); qkt(pA0, pA1, K_lds, qr, r32, hi);
    finishSM(pB0, pB1, alB, l_reg, pa0, pa1, pa2, pa3); SBAR();
    if (SDEPTH == 1 || j + 3 < NT) SLOAD(SE, (j + 1 + SDEPTH) * KVBLK); SBAR();
    pv_d0(o, vb0 + (int)SHM_V, pa0, pa1, pa2, pa3); partialSM(pA0, pA1, m_reg, mnA, alA);
    __syncthreads(); SWAIT(); SWRITE(1, SO);
    RESC(alA); __syncthreads();
  }
  SBAR(); qkt(pB0, pB1, (bf16*)((char*)K_lds + SHM_K), qr, r32, hi);
  finishSM(pA0, pA1, alA, l_reg, pa0, pa1, pa2, pa3); SBAR();
  pv_d0(o, vb0, pa0, pa1, pa2, pa3); partialSM(pB0, pB1, m_reg, mnB, alB);
  __syncthreads(); RESC(alB);
  finishSM(pB0, pB1, alB, l_reg, pa0, pa1, pa2, pa3); SBAR();
  pv_d0(o, vb0 + (int)SHM_V, pa0, pa1, pa2, pa3);
  if (hi == 0) li_l[r32] = l_reg; asm volatile("s_waitcnt lgkmcnt(0)" ::: "memory");
  { int tz = threadIdx.x; asm volatile("" : "+v"(tz)); wid = tz >> 6; lane = tz & 63; r32 = lane & 31; hi = lane >> 5; }
  float rli[16];
#pragma unroll
  for (int r = 0; r < 16; ++r) rli[r] = __builtin_amdgcn_rcpf(li_l[crow(r, hi)]);
  char* ost = lds + OST_OFF + wid * (32 * 272);
#pragma unroll
  for (int r = 0; r < 16; ++r) { const int orow = crow(r, hi);
#pragma unroll
    for (int d0 = 0; d0 < 4; ++d0) *(bf16*)(ost + orow * 272 + (d0 * 32 + r32) * 2) = __float2bfloat16(o[d0][r] * rli[r]); }
  asm volatile("s_waitcnt lgkmcnt(0)" ::: "memory");
  bf16* Ow = Ob + (long)(wid * QBLK) * LDO; const bf16* Zw = Zb + (long)(wid * QBLK) * LDQ;
#pragma unroll
  for (int hb = 0; hb < 2; ++hb) {
    u32x4 ov[4], zv[4];
#pragma unroll
    for (int i = 0; i < 4; ++i) { const int c = (hb * 4 + i) * 64 + lane, row = c >> 4, col = (c & 15) * 8;
      ov[i] = *reinterpret_cast<const u32x4*>(ost + row * 272 + col * 2); zv[i] = *reinterpret_cast<const u32x4*>(Zw + (long)row * LDQ + col); }
#pragma unroll
    for (int i = 0; i < 4; ++i) { const int c = (hb * 4 + i) * 64 + lane, row = c >> 4, col = (c & 15) * 8; u32x4 w;
#pragma unroll
      for (int e = 0; e < 4; ++e) { const unsigned a = ov[i][e], z = zv[i][e];
        w[e] = cvtpk(__uint_as_float(a << 16) * __uint_as_float(z << 16), __uint_as_float(a & 0xffff0000u) * __uint_as_float(z & 0xffff0000u)); }
      *reinterpret_cast<u32x4*>(Ow + (long)row * LDO + col) = w; }
  }
  __syncthreads();
#undef SLOAD
#undef SWRITE
#undef SWAIT
#undef RESC
}
}

constexpr int NWAVES = 8;
#ifndef MK_N_LAUNCHES
#define MK_N_LAUNCHES 1
#endif
constexpr int PH_PER_LAYER = 7, N_PHASES = 2 + DEPTH * PH_PER_LAYER;
constexpr size_t MiB = 1u << 20;
constexpr size_t WS_CTL = 0, CTL_ZERO_BYTES = 1 * MiB;
constexpr size_t WS_MOD = 1 * MiB;
constexpr size_t WS_ROPE = WS_MOD + MiB / 2;
constexpr size_t WS_WG = 3 * MiB;
constexpr size_t WS_WLRU = 4 * MiB;
constexpr size_t WS_WOUT = 12 * MiB;
constexpr size_t WS_WBR = 44 * MiB;
constexpr size_t WS_WIN = 140 * MiB;
constexpr size_t WS_X = 540 * MiB;
constexpr size_t WS_Y = 612 * MiB;
constexpr size_t WS_H = 684 * MiB;
constexpr size_t WS_G2 = 720 * MiB;
constexpr size_t WS_YB = 756 * MiB;
constexpr size_t WS_ACC = 864 * MiB;
constexpr size_t WS_GT = 936 * MiB;
constexpr size_t WS_MH = 938 * MiB;
constexpr size_t WS_P = 1082 * MiB;
constexpr size_t WS_LA = 1532 * MiB;
constexpr size_t WS_LB = 1676 * MiB;
constexpr size_t WS_HL = 1820 * MiB;
constexpr size_t WS_GSC = 1964 * MiB;
constexpr size_t WS_END = 1968 * MiB;
constexpr int CW_BAR = 4096;
constexpr int RING_BYTES = 131072, LDS_BYTES = 147456, MISC_OFF = LDS_BYTES - 256;
static_assert(att::OST_END <= MISC_OFF, "LDS map");

#define GAS __attribute__((address_space(1)))
#define LAS __attribute__((address_space(3)))
typedef unsigned short bf16_t;
typedef unsigned v4u __attribute__((ext_vector_type(4)));
typedef unsigned v2u __attribute__((ext_vector_type(2)));
typedef float f32x4 __attribute__((ext_vector_type(4)));
#define LDS_WAIT() asm volatile("s_waitcnt lgkmcnt(0)" ::: "memory")
__device__ __forceinline__ unsigned f2bf(float f) { unsigned u = __builtin_bit_cast(unsigned, f); return (u + 0x7fffu + ((u >> 16) & 1u)) >> 16; }
__device__ __forceinline__ unsigned pk2(float lo, float hi) { return f2bf(lo) | (f2bf(hi) << 16); }
__device__ __forceinline__ float bf2f(bf16_t b) { return __uint_as_float((unsigned)b << 16); }
__device__ __forceinline__ float blo(unsigned w) { return __uint_as_float(w << 16); }
__device__ __forceinline__ float bhi(unsigned w) { return __uint_as_float(w & 0xffff0000u); }
__device__ __forceinline__ float lane_get(float v, int src) { return __builtin_bit_cast(float, __builtin_amdgcn_ds_bpermute(src << 2, __builtin_bit_cast(int, v))); }
__device__ __forceinline__ float lane_xor(float v, int mask, int lane) { return lane_get(v, lane ^ mask); }
__device__ __forceinline__ float lane_up(float v, int delta, int lane) { return lane_get(v, lane >= delta ? lane - delta : lane); }
__device__ __forceinline__ float wave_sum(float v, int lane) {
#pragma unroll
    for (int o = 1; o < 64; o <<= 1) v += lane_xor(v, o, lane);
    return v;
}
#define XB_TMO      128
#define XB_XCNT(j)  (256  + 64 * (j))
#define XB_XSUB(j)  (1280 + 64 * (j))
#define XB_XGEN(j)  (2304 + 64 * (j))
#define XB_TOP      3328
#define XB_TOPGEN   3392
#define XCD_BAR_WORDS 3456
#define XB_SPIN_CAP (1u << 18)

__device__ __forceinline__ unsigned xb_ld(unsigned* p)              { return __hip_atomic_load(p, __ATOMIC_RELAXED, __HIP_MEMORY_SCOPE_AGENT); }
__device__ __forceinline__ unsigned xb_add(unsigned* p, unsigned v) { return __hip_atomic_fetch_add(p, v, __ATOMIC_RELAXED, __HIP_MEMORY_SCOPE_AGENT); }
__device__ __forceinline__ unsigned xb_xcc_id() { return (unsigned)__builtin_amdgcn_s_getreg((3 << 11) | 20) & 0xFu; }
#define XB_SPIN(cond, bar) do { unsigned _sp = 0; while (cond) { __builtin_amdgcn_s_sleep(1); \
    if ((++_sp & 255u) == 0u) { if (xb_ld(&(bar)[XB_TMO])) break; if (_sp > XB_SPIN_CAP) { atomicAdd(&(bar)[XB_TMO], 1u); break; } } } } while (0)

struct XcdBarrier {
    unsigned* bar; unsigned x;
    volatile LAS unsigned* st;
};

__device__ __forceinline__ XcdBarrier xcd_barrier_post(unsigned* bar, volatile LAS unsigned* st) {
    XcdBarrier b; b.bar = bar; b.x = xb_xcc_id(); b.st = st;
    if (threadIdx.x == 0) (void)xb_add(&bar[XB_XCNT(b.x)], 1u);
    return b;
}
__device__ __forceinline__ void xcd_barrier_complete(unsigned* bar, unsigned x, unsigned& nloc, unsigned& nx) {
    const unsigned G = gridDim.x * gridDim.y * gridDim.z;
    unsigned sum, cnt, mine, sp = 0u;
    for (;;) {
        sum = 0u; cnt = 0u; mine = 0u;
#pragma unroll
        for (unsigned j = 0; j < 16; ++j) { const unsigned c = xb_ld(&bar[XB_XCNT(j)]); sum += c; cnt += (c > 0u) ? 1u : 0u; mine = (j == x) ? c : mine; }
        if (sum == G) break;
        __builtin_amdgcn_s_sleep(1);
        if ((++sp & 255u) == 0u) { if (xb_ld(&bar[XB_TMO])) break; if (sp > XB_SPIN_CAP) { atomicAdd(&bar[XB_TMO], 1u); break; } }
    }
    nloc = mine > 0u ? mine : 1u; nx = cnt > 0u ? cnt : 1u;
}

__device__ __forceinline__ void xcd_barrier(const XcdBarrier& b) {
    asm volatile("s_waitcnt vmcnt(0)" ::: "memory");
    __syncthreads();
    if (threadIdx.x == 0) {
        unsigned* bar = b.bar;
        __builtin_amdgcn_s_waitcnt(0);
        unsigned nloc = b.st[0], nx = b.st[1];
        if (nloc == 0u) { xcd_barrier_complete(bar, b.x, nloc, nx); b.st[0] = nloc; b.st[1] = nx; }
        const unsigned old = xb_add(&bar[XB_XSUB(b.x)], 1u);
        const unsigned gen = old / nloc;
        if (old + 1u == (gen + 1u) * nloc) {
            __builtin_amdgcn_fence(__ATOMIC_RELEASE, "agent");
            asm volatile("s_waitcnt vmcnt(0)" ::: "memory");
            const unsigned og = xb_add(&bar[XB_TOP], 1u);
            const unsigned tg = og / nx;
            if (og + 1u == (tg + 1u) * nx) xb_add(&bar[XB_TOPGEN], 1u);
            else XB_SPIN(xb_ld(&bar[XB_TOPGEN]) == tg, bar);
            __builtin_amdgcn_fence(__ATOMIC_ACQUIRE, "agent");
            xb_add(&bar[XB_XGEN(b.x)], 1u);
            asm volatile("s_waitcnt vmcnt(0)" ::: "memory");
        } else {
            XB_SPIN(xb_ld(&bar[XB_XGEN(b.x)]) == gen, bar);
            __builtin_amdgcn_fence(__ATOMIC_ACQUIRE, "agent");
            asm volatile("s_waitcnt vmcnt(0)" ::: "memory");
        }
    }
    __syncthreads();
}

struct Args { const float* in[22]; float* out; unsigned char* ws; int ph_lo, ph_hi; };
typedef const __attribute__((address_space(4))) Args CArgs;
#define KIN(k) ((const float*)ka->in[k])
#define WSF(off) ((float*)(ka->ws + (off)))
#define WSB(off) ((bf16_t*)(ka->ws + (off)))
#define KA() ({ CArgs* _k = ka0; asm volatile("" : "+s"(_k)); _k; })
__device__ __forceinline__ int tid_fresh() { int t = threadIdx.x; asm volatile("" : "+v"(t)); return t; }
struct Frame {
    LAS unsigned char* lds; char* ldsg;
    int tid, lane, wave, G, wg;
};

__device__ __forceinline__ void transpose_item(const float* W, int ldw, int col0, int k0, bf16_t* WT, int ldt, int drow0, LAS float* scr, int lane) {
#pragma unroll 8
    for (int i = 0; i < 32; ++i) { const int kk = 2 * i + (lane >> 5); scr[kk * 33 + (lane & 31)] = __builtin_nontemporal_load(W + (size_t)(k0 + kk) * ldw + col0 + (lane & 31)); }
    LDS_WAIT(); asm volatile("" ::: "memory");
    const int c = lane & 7;
#pragma unroll
    for (int j = 0; j < 4; ++j) { const int n = (lane >> 3) + 8 * j; const LAS float* s = scr + (8 * c) * 33 + n;
        v4u o; o.x = pk2(s[0 * 33], s[1 * 33]); o.y = pk2(s[2 * 33], s[3 * 33]); o.z = pk2(s[4 * 33], s[5 * 33]); o.w = pk2(s[6 * 33], s[7 * 33]);
        *(v4u*)(WT + (size_t)(drow0 + n) * ldt + k0 + 8 * c) = o; }
    LDS_WAIT(); asm volatile("" ::: "memory");
}
__device__ __forceinline__ void p_convert(Frame& F, CArgs* ka, int l, int wv, int nwv) {
    const int tid = tid_fresh(), lane = tid & 63, wave = __builtin_amdgcn_readfirstlane(tid >> 6);
    LAS float* scr = (LAS float*)(F.lds + wave * 8704);
    constexpr int I_IN = 32 * 800, I_G = 32, I_BR = 3 * 2048, I_OUT = 2048, I_LRU = 2 * 2 * 16 * 8, I_LAYER = I_IN + I_G + I_BR + I_OUT + I_LRU;
    for (int it = wv; it < I_LAYER; it += nwv) {
        int r = it;
        if (r < I_IN) { const int kb = r / 800, nb = r - kb * 800, n0 = nb * 32, sc = n0 < 14336 ? n0 : n0 + 32;
            transpose_item(KIN(8) + (size_t)l * DM * NIN, NIN, sc, kb * 64, WSB(WS_WIN) + (size_t)l * NP * DM, DM, n0, scr, lane); continue; }
        r -= I_IN;
        if (r < I_G) { transpose_item(KIN(8) + (size_t)l * DM * NIN, NIN, 14336, r * 64, WSB(WS_WG) + (size_t)l * 32 * DM, DM, 0, scr, lane); continue; }
        r -= I_G;
        if (r < I_BR) { const int z = r / 2048, q = r - z * 2048, kb = q / 64, nb = q - kb * 64;
            transpose_item(KIN(20) + ((size_t)l * 3 + z) * DM * DM, DM, nb * 32, kb * 64, WSB(WS_WBR) + ((size_t)l * 3 + z) * DM * DM, DM, nb * 32, scr, lane); continue; }
        r -= I_BR;
        if (r < I_OUT) { const int kb = r / 64, nb = r - kb * 64;
            transpose_item(KIN(21) + (size_t)l * DM * DM, DM, nb * 32, kb * 64, WSB(WS_WOUT) + (size_t)l * DM * DM, DM, nb * 32, scr, lane); continue; }
        r -= I_OUT;
        { const int q = r & 7, mt = r >> 3, blk = mt & 15, gate = (mt >> 4) & 1, dr = mt >> 5, kb = q >> 2, nb = q & 3;
          const float* src = (gate ? KIN(13) : KIN(11)) + (((size_t)l * 2 + dr) * 16 + blk) * 16384;
          transpose_item(src, 128, nb * 32, kb * 64, WSB(WS_WLRU) + ((((size_t)l * 2 + dr) * 2 + gate) * 16 + blk) * 16384, 128, nb * 32, scr, lane); }
    }
}
__device__ __forceinline__ void p_prologue(Frame& F, CArgs* ka) {
    const int tid = tid_fresh(), lane = tid & 63, wave = __builtin_amdgcn_readfirstlane(tid >> 6); (void)lane; (void)wave;
    for (int i = F.wg * 512 + tid; i < SEQ * 64; i += F.G * 512) { const int t = i >> 6, j = i & 63;
        const float inv = 1.0f / powf(10000.0f, (float)(j & 31) * (1.0f / 32.0f)); const float pos = (float)(j < 32 ? (t >> 6) : (t & 63)); const float ang = pos * inv;
        WSF(WS_ROPE)[i] = cosf(ang); WSF(WS_ROPE)[SEQ * 64 + i] = sinf(ang); }
    __syncthreads();
    LAS float* sc = (LAS float*)(F.lds + 73728);
    LAS float* red = (LAS float*)(F.lds + 73728 + 5 * 2048 * 4);
    for (int i = tid; i < 5 * DM; i += 512) { const int bi = i >> 11, k = i & 2047; const float v = bi < 4 ? KIN(1)[bi * DM + k] : KIN(3)[k]; sc[i] = v / (1.f + expf(-v)); }
    __syncthreads();
    for (int it = F.wg; it < DEPTH * 192; it += F.G) { const int l = it / 192, j0 = (it - l * 192) * 32, cj = tid & 31, ks = tid >> 5;
        float a0 = 0.f, a1 = 0.f, a2 = 0.f, a3 = 0.f, a4 = 0.f; const float* w = KIN(4) + (size_t)l * DM * 3 * DM + j0 + cj;
        for (int k = ks * 128; k < ks * 128 + 128; ++k) { const float wv = w[(size_t)k * (3 * DM)]; a0 += sc[k] * wv; a1 += sc[2048 + k] * wv; a2 += sc[4096 + k] * wv; a3 += sc[6144 + k] * wv; a4 += sc[8192 + k] * wv; }
        red[(ks * 5 + 0) * 32 + cj] = a0; red[(ks * 5 + 1) * 32 + cj] = a1; red[(ks * 5 + 2) * 32 + cj] = a2; red[(ks * 5 + 3) * 32 + cj] = a3; red[(ks * 5 + 4) * 32 + cj] = a4;
        __syncthreads();
        if (tid < 160) { const int bi = tid >> 5, c = tid & 31; float s = KIN(5)[(size_t)l * 3 * DM + j0 + c];
            for (int q = 0; q < 16; ++q) s += red[(q * 5 + bi) * 32 + c];
            WSF(WS_MOD)[((size_t)l * 5 + bi) * (3 * DM) + j0 + c] = s; }
        __syncthreads();
    }
}

__device__ __forceinline__ void p_norm(Frame& F, CArgs* ka, int l) {
    const int tid = tid_fresh(), lane = tid & 63, wave = __builtin_amdgcn_readfirstlane(tid >> 6); (void)lane; (void)wave;
    const int gw = F.wg * NWAVES + wave, NGW = F.G * NWAVES;
    for (int r = gw; r < MROWS; r += NGW) {
        const int b = r / TPB, t = r - b * TPB; const bool isctx = t >= SEQ; const int bi = isctx ? 4 : b;
        if (l == DEPTH && isctx) continue;
        f32x4 v[8];
        if (l == 0) { const float* src = isctx ? KIN(2) + ((size_t)b * CTXL + (t - SEQ)) * DM : KIN(0) + ((size_t)b * SEQ + t) * DM;
#pragma unroll
            for (int j = 0; j < 8; ++j) v[j] = *(const f32x4*)(src + j * 256 + lane * 4);
        } else {
            const float* yr = WSF(WS_Y) + (size_t)r * DM; const float* xr = WSF(WS_X) + (size_t)r * DM; f32x4 y[8]; float ss = 0.f;
#pragma unroll
            for (int j = 0; j < 8; ++j) { y[j] = *(const f32x4*)(yr + j * 256 + lane * 4); ss += y[j].x * y[j].x + y[j].y * y[j].y + y[j].z * y[j].z + y[j].w * y[j].w; }
            const float rs = rsqrtf(wave_sum(ss, lane) * (1.f / DM) + EPS);
            const float* gate = WSF(WS_MOD) + ((size_t)(l - 1) * 5 + bi) * (3 * DM) + 2 * DM; const float* npost = KIN(7) + (size_t)(l - 1) * DM;
#pragma unroll
            for (int j = 0; j < 8; ++j) { const int c = j * 256 + lane * 4; const f32x4 g = *(const f32x4*)(gate + c), w = *(const f32x4*)(npost + c), xv = *(const f32x4*)(xr + c);
                v[j] = xv + g * (y[j] * rs * w); }
        }
        if (l == DEPTH) { float* o = (ka->out) + ((size_t)b * SEQ + t) * DM;
#pragma unroll
            for (int j = 0; j < 8; ++j) *(f32x4*)(o + j * 256 + lane * 4) = v[j];
            continue; }
        float* xo = WSF(WS_X) + (size_t)r * DM; float ss = 0.f;
#pragma unroll
        for (int j = 0; j < 8; ++j) { *(f32x4*)(xo + j * 256 + lane * 4) = v[j]; ss += v[j].x * v[j].x + v[j].y * v[j].y + v[j].z * v[j].z + v[j].w * v[j].w; }
        const float rs = rsqrtf(wave_sum(ss, lane) * (1.f / DM) + EPS);
        const float* shift = WSF(WS_MOD) + ((size_t)l * 5 + bi) * (3 * DM); const float* scale = shift + DM; const float* npre = KIN(6) + (size_t)l * DM;
        bf16_t* ho = WSB(WS_H) + (size_t)r * DM;
#pragma unroll
        for (int j = 0; j < 8; ++j) { const int c = j * 256 + lane * 4; const f32x4 sh = *(const f32x4*)(shift + c), scv = *(const f32x4*)(scale + c), w = *(const f32x4*)(npre + c);
            const f32x4 h = v[j] * rs * w * (scv + 1.f) + sh; v2u o; o.x = pk2(h.x, h.y); o.y = pk2(h.z, h.w); *(v2u*)(ho + c) = o; }
    }
}

__device__ __forceinline__ void p_gates(Frame& F, CArgs* ka, int l, int wk0, int nwk) {
    const int tid = tid_fresh(), lane = tid & 63, wave = __builtin_amdgcn_readfirstlane(tid >> 6), c16 = lane & 15, q = lane >> 4;
    typedef short bf16x8 __attribute__((ext_vector_type(8)));
    LAS float* GL = (LAS float*)F.lds;
    const bf16_t* H = WSB(WS_H); const bf16_t* WG = WSB(WS_WG) + (size_t)l * 32 * DM; float* GT = WSF(WS_GT); f32x4* GSC = (f32x4*)WSF(WS_GSC);
    for (int task = wk0; task < NBATCH * 36; task += nwk) { const int b = task / 36, chunk = task - b * 36; const size_t row0 = (size_t)b * TPB + chunk * 64;
        __syncthreads();
        { const int rb = wave & 3, kh = wave >> 2; f32x4 a0 = {0.f, 0.f, 0.f, 0.f}, a1 = {0.f, 0.f, 0.f, 0.f};
          const bf16_t* hp = H + (row0 + rb * 16 + c16) * DM + kh * 1024 + q * 8; const bf16_t* w0 = WG + (size_t)c16 * DM + kh * 1024 + q * 8; const bf16_t* w1 = w0 + 16 * DM;
#pragma unroll 8
          for (int ks = 0; ks < 32; ++ks) { const bf16x8 av = *(const bf16x8*)(hp + ks * 32), b0 = *(const bf16x8*)(w0 + ks * 32), b1 = *(const bf16x8*)(w1 + ks * 32);
              a0 = __builtin_amdgcn_mfma_f32_16x16x32_bf16(av, b0, a0, 0, 0, 0); a1 = __builtin_amdgcn_mfma_f32_16x16x32_bf16(av, b1, a1, 0, 0, 0); }
#pragma unroll
          for (int j = 0; j < 4; ++j) { GL[(kh * 64 + rb * 16 + q * 4 + j) * 33 + c16] = a0[j]; GL[(kh * 64 + rb * 16 + q * 4 + j) * 33 + 16 + c16] = a1[j]; } }
        __syncthreads();
#pragma unroll
        for (int i = 0; i < 4; ++i) { const int idx = tid + 512 * i, r = idx >> 5, c = idx & 31; float s = GL[r * 33 + c] + GL[(64 + r) * 33 + c] + KIN(16)[l * 32 + c];
            if ((c >> 3) & 1) s = fminf(s, 0.f) - log1pf(expf(-fabsf(s)));
            GL[r * 33 + c] = s; GT[(row0 + r) * 32 + c] = s; }
        __syncthreads();
#pragma unroll
        for (int pi = 0; pi < 2; ++pi) { const int p = wave * 2 + pi, dir = p >> 3, h = p & 7, rl = dir ? 63 - lane : lane;
            const float gi = GL[rl * 33 + dir * 16 + h]; float bc = GL[rl * 33 + dir * 16 + 8 + h];
#pragma unroll
            for (int o = 1; o < 64; o <<= 1) { const float v = lane_up(bc, o, lane); if (lane >= o) bc += v; }
            const float g = gi - bc; float pm = g;
#pragma unroll
            for (int o = 1; o < 64; o <<= 1) { const float v = lane_up(pm, o, lane); if (lane >= o) pm = fmaxf(pm, v); }
            GSC[((((size_t)b * 2 + dir) * 8 + h) * 36 + chunk) * 64 + lane] = (f32x4){bc, g, pm, 0.f}; }
    }
    __syncthreads();
}
__device__ __forceinline__ void p_knorm(Frame& F, CArgs* ka, int l) {
    const int tid = tid_fresh(), lane = tid & 63, wave = __builtin_amdgcn_readfirstlane(tid >> 6);
    const int gw = F.wg * NWAVES + wave, NGW = F.G * NWAVES; const int sub = lane & 15;
    f32x4 kn0 = *(const f32x4*)(KIN(19) + l * 128 + sub * 8), kn1 = *(const f32x4*)(KIN(19) + l * 128 + sub * 8 + 4);
    for (int r = gw; r < MROWS; r += NGW) { const int b = r / TPB, t = r - b * TPB;
        bf16_t* kp = WSB(WS_P) + (size_t)r * NP + C_AK + lane * 8; const v4u raw = *(const v4u*)kp; float v[8];
#pragma unroll
        for (int e = 0; e < 4; ++e) { v[2 * e] = blo(raw[e]); v[2 * e + 1] = bhi(raw[e]); }
        float ss = 0.f;
#pragma unroll
        for (int e = 0; e < 8; ++e) ss += v[e] * v[e];
        ss += lane_xor(ss, 1, lane); ss += lane_xor(ss, 2, lane); ss += lane_xor(ss, 4, lane); ss += lane_xor(ss, 8, lane);
        const float rs = rsqrtf(ss * (1.f / 128.f) + EPS);
#pragma unroll
        for (int e = 0; e < 8; ++e) v[e] *= rs * (e < 4 ? kn0[e & 3] : kn1[e & 3]);
        if (t < SEQ) { const int i0 = (sub & 7) * 8; const float* cp = WSF(WS_ROPE) + (size_t)t * 64 + i0; const float* sp = cp + SEQ * 64;
            const f32x4 c0 = *(const f32x4*)cp, c1 = *(const f32x4*)(cp + 4), s0 = *(const f32x4*)sp, s1 = *(const f32x4*)(sp + 4); const bool upper = (sub & 8) != 0;
#pragma unroll
            for (int e = 0; e < 8; ++e) { const float o = lane_xor(v[e], 8, lane), c = e < 4 ? c0[e & 3] : c1[e & 3], sn = e < 4 ? s0[e & 3] : s1[e & 3];
                v[e] = upper ? v[e] * c + o * sn : v[e] * c - o * sn; } }
        v4u ov; ov.x = pk2(v[0], v[1]); ov.y = pk2(v[2], v[3]); ov.z = pk2(v[4], v[5]); ov.w = pk2(v[6], v[7]);
        *(v4u*)kp = ov; }
}

__device__ __forceinline__ void p_lru_gates_naive(Frame& F, CArgs* ka, int l) {
    const int tid = tid_fresh(); (void)tid;
    LAS float* xs = (LAS float*)F.lds;
    for (int it = F.wg; it < (MROWS / 16) * 16; it += F.G) { const int rt = it >> 4, blk = it & 15;
        __syncthreads();
#pragma unroll
        for (int j = 0; j < 4; ++j) { const int idx = tid + 512 * j, rr = idx >> 7, c = idx & 127, r = rt * 16 + rr, b = r / TPB, t = r - b * TPB, ch = blk * 128 + c;
            const int lo = t < SEQ ? 0 : SEQ, hi = t < SEQ ? SEQ : TPB; float a = KIN(10)[l * DM + ch];
#pragma unroll
            for (int k = 0; k < 4; ++k) { const int tt = t + k - 2; if (tt >= lo && tt < hi) a += KIN(9)[((size_t)l * 4 + k) * DM + ch] * bf2f(WSB(WS_P)[((size_t)b * TPB + tt) * NP + C_LX + ch]); }
            xs[rr * 128 + c] = a; }
        __syncthreads();
        const int co = tid & 127, r0 = tid >> 7, ch = blk * 128 + co;
#pragma unroll 1
        for (int dr = 0; dr < 2; ++dr) {
            const float* wr = KIN(11) + (((size_t)l * 2 + dr) * 16 + blk) * 16384 + co; const float* wi = KIN(13) + (((size_t)l * 2 + dr) * 16 + blk) * 16384 + co;
            float ar[4], ai[4];
#pragma unroll
            for (int j = 0; j < 4; ++j) { ar[j] = KIN(12)[((size_t)l * 2 + dr) * DM + ch]; ai[j] = KIN(14)[((size_t)l * 2 + dr) * DM + ch]; }
            for (int c = 0; c < 128; ++c) { const float w0 = wr[c * 128], w1 = wi[c * 128];
#pragma unroll
                for (int j = 0; j < 4; ++j) { const float xv = xs[(r0 + 4 * j) * 128 + c]; ar[j] += xv * w0; ai[j] += xv * w1; } }
            const float lam = KIN(15)[((size_t)l * 2 + dr) * DM + ch], sp = log1pf(expf(-lam));
#pragma unroll
            for (int j = 0; j < 4; ++j) { const int r = rt * 16 + r0 + 4 * j; const float rg = 1.f / (1.f + expf(-ar[j])), ig = 1.f / (1.f + expf(-ai[j]));
                const float log_a = -8.f * rg * sp, a = expf(log_a), mult = sqrtf(-expm1f(2.f * log_a));
                WSF(WS_LA)[((size_t)dr * MROWS + r) * DM + ch] = a; WSF(WS_LB)[((size_t)dr * MROWS + r) * DM + ch] = mult * ig * xs[(r0 + 4 * j) * 128 + co]; }
        }
    }
    __syncthreads();
}

__device__ __forceinline__ void p_attention(Frame& F, CArgs* ka, int l, bool need_ctx) {
    using att::bf16;
    const int n_lat = NBATCH * 16 * 8, n_all = n_lat + (need_ctx ? NBATCH * 16 : 0);
    for (int u = F.wg; u < n_all; u += F.G) {
        int b, h, q0, k0, seq; const float *cs = nullptr, *sn = nullptr;
        if (u < n_lat) { const int qb = u & 7; h = (u >> 3) & 15; b = u >> 7; q0 = qb * 256; k0 = 0; seq = TPB; cs = WSF(WS_ROPE) + (size_t)q0 * 64; sn = WSF(WS_ROPE) + (size_t)SEQ * 64 + (size_t)q0 * 64; }
        else { const int v = u - n_lat; h = v & 15; b = v >> 4; q0 = SEQ; k0 = SEQ; seq = CTXL; }
        const size_t rq = (size_t)b * TPB + q0, rk = (size_t)b * TPB + k0; const int kvh = h >> 2;
        att::attn_unit((const bf16*)(WSB(WS_P) + rq * NP + C_AQ + h * 128), (const bf16*)(WSB(WS_P) + rk * NP + C_AK + kvh * 128), (const bf16*)(WSB(WS_P) + rk * NP + C_AV + kvh * 128),
                       (const bf16*)(WSB(WS_P) + rq * NP + C_AZ + h * 128), (bf16*)(WSB(WS_YB) + ((size_t)2 * MROWS + rq) * DM + h * 128), seq, F.ldsg, KIN(18) + l * 128, cs, sn);
    }
}
__device__ __forceinline__ int seq_row(int s, int dir) { return s < CTXL ? SEQ + (dir ? CTXL - 1 - s : s) : (dir ? SEQ - 1 - (s - CTXL) : s - CTXL); }
__device__ __forceinline__ void p_mlstm_naive(Frame& F, CArgs* ka, int l) {
    const int tid = tid_fresh(), lane = tid & 63, wave = __builtin_amdgcn_readfirstlane(tid >> 6); (void)lane; (void)wave;
    LAS float* sq = (LAS float*)F.lds; LAS float* sk = sq + 256; LAS float* rn = sk + 256; LAS float* rd = rn + 512;
    const int e = tid & 63, dg = tid >> 6;
    for (int u = F.wg; u < 256; u += F.G) { const int es = u & 3, dir = (u >> 2) & 1, h = (u >> 3) & 7, b = u >> 6;
        float C[32], n[32];
#pragma unroll
        for (int i = 0; i < 32; ++i) { C[i] = 0.f; n[i] = 0.f; }
        float m = -1e30f;
        const int lcol = tid < 64 ? C_MQ + h * 256 + tid * 4 : C_MK + h * 256 + (tid - 64) * 4, vcol = C_MV + h * 256 + es * 64 + e;
        v2u pqk = {0u, 0u}; bf16_t pv; float gi, gf;
        { const size_t r = (size_t)b * TPB + seq_row(0, dir); if (tid < 128) pqk = *(const v2u*)(WSB(WS_P) + r * NP + lcol); pv = WSB(WS_P)[r * NP + vcol]; gi = WSF(WS_GT)[r * 32 + dir * 16 + h]; gf = WSF(WS_GT)[r * 32 + dir * 16 + 8 + h]; }
        __syncthreads();
        for (int s = 0; s < TPB; ++s) {
            const size_t r = (size_t)b * TPB + seq_row(s, dir);
            if (tid < 128) { LAS float* d = (tid < 64 ? sq : sk) + (tid & 63) * 4; d[0] = blo(pqk.x); d[1] = bhi(pqk.x); d[2] = blo(pqk.y); d[3] = bhi(pqk.y); }
            const float vv = bf2f(pv), iv = gi, lf = gf;
            __syncthreads();
            if (s + 1 < TPB) { const size_t r2 = (size_t)b * TPB + seq_row(s + 1, dir); if (tid < 128) pqk = *(const v2u*)(WSB(WS_P) + r2 * NP + lcol); pv = WSB(WS_P)[r2 * NP + vcol]; gi = WSF(WS_GT)[r2 * 32 + dir * 16 + h]; gf = WSF(WS_GT)[r2 * 32 + dir * 16 + 8 + h]; }
            const float mnew = fmaxf(lf + m, iv), fw = expf(lf + m - mnew), iw = expf(iv - mnew); m = mnew;
            float pn = 0.f, pd = 0.f;
#pragma unroll
            for (int dd = 0; dd < 32; ++dd) { const float kd = sk[dg * 32 + dd], qd = sq[dg * 32 + dd]; C[dd] = fw * C[dd] + iw * kd * vv; n[dd] = fw * n[dd] + iw * kd; pn += qd * C[dd]; pd += qd * n[dd]; }
            rn[dg * 64 + e] = pn; rd[dg * 64 + e] = pd;
            __syncthreads();
            if (dg == 0) { float num = 0.f, den = 0.f;
#pragma unroll
                for (int g = 0; g < 8; ++g) { num += rn[g * 64 + e]; den += rd[g * 64 + e]; }
                WSB(WS_MH)[((size_t)dir * MROWS + r) * DM + h * 256 + es * 64 + e] = (bf16_t)f2bf(num / fmaxf(fabsf(den), expf(-m))); }
        }
        __syncthreads();
    }
}
__device__ __forceinline__ void p_lru_scan_naive(Frame& F, CArgs* ka) {
    const int tid = tid_fresh(), lane = tid & 63, wave = __builtin_amdgcn_readfirstlane(tid >> 6); (void)lane; (void)wave;
    if (wave != 0) return;
    for (int cw = F.wg; cw < 256; cw += F.G) { const int combo = cw * 64 + lane, b = combo >> 12, dir = (combo >> 11) & 1, ch = combo & 2047;
        const float* A = WSF(WS_LA) + (size_t)dir * MROWS * DM + ch; const float* Bx = WSF(WS_LB) + (size_t)dir * MROWS * DM + ch; float* Ho = WSF(WS_HL) + (size_t)dir * MROWS * DM + ch; float h = 0.f;
#pragma unroll 8
        for (int s = 0; s < TPB; ++s) { const size_t r = (size_t)b * TPB + seq_row(s, dir); h = A[r * DM] * h + Bx[r * DM]; Ho[r * DM] = h; }
    }
}

__device__ __forceinline__ void p_mlout(Frame& F, CArgs* ka, int l, bool need_ctx) {
    const int tid = tid_fresh(), lane = tid & 63, wave = __builtin_amdgcn_readfirstlane(tid >> 6); (void)lane; (void)wave;
    const int gw = F.wg * NWAVES + wave, NGW = F.G * NWAVES, nrow = need_ctx ? MROWS : NBATCH * SEQ;
    for (int ri = gw; ri < nrow; ri += NGW) { const int r = need_ctx ? ri : (ri >> 11) * TPB + (ri & 2047);
        const bf16_t* pr = WSB(WS_P) + (size_t)r * NP;
#pragma unroll 2
        for (int h = 0; h < 8; ++h) { const int col = h * 256 + lane * 4;
            const v2u ma = *(const v2u*)(WSB(WS_MH) + (size_t)r * DM + col), mb = *(const v2u*)(WSB(WS_MH) + ((size_t)MROWS + r) * DM + col);
            const f32x4 a = {blo(ma.x), bhi(ma.x), blo(ma.y), bhi(ma.y)}, bb = {blo(mb.x), bhi(mb.x), blo(mb.y), bhi(mb.y)};
            const v2u ow = *(const v2u*)(pr + C_MO + col), zw = *(const v2u*)(pr + C_MZ + col); const f32x4 g = *(const f32x4*)(KIN(17) + (size_t)l * DM + col);
            f32x4 v = a + bb; v.x *= blo(ow.x); v.y *= bhi(ow.x); v.z *= blo(ow.y); v.w *= bhi(ow.y);
            const float rs = rsqrtf(wave_sum(v.x * v.x + v.y * v.y + v.z * v.z + v.w * v.w, lane) * (1.f / 256.f) + EPS);
            v2u o; o.x = pk2(v.x * rs * g.x * blo(zw.x), v.y * rs * g.y * bhi(zw.x)); o.y = pk2(v.z * rs * g.z * blo(zw.y), v.w * rs * g.w * bhi(zw.y));
            *(v2u*)(WSB(WS_YB) + ((size_t)MROWS + r) * DM + col) = o; }
    }
}

__device__ __forceinline__ void p_lru_combine_naive(Frame& F, CArgs* ka) {
    const int tid = tid_fresh(), lane = tid & 63, wave = __builtin_amdgcn_readfirstlane(tid >> 6);
    const int gw = F.wg * NWAVES + wave, NGW = F.G * NWAVES;
    for (int r = gw; r < MROWS; r += NGW) {
        const bf16_t* pr = WSB(WS_P) + (size_t)r * NP;
#pragma unroll 2
        for (int j = 0; j < 8; ++j) { const int col = j * 256 + lane * 4;
            const f32x4 a = *(const f32x4*)(WSF(WS_HL) + (size_t)r * DM + col), bb = *(const f32x4*)(WSF(WS_HL) + ((size_t)MROWS + r) * DM + col); const v2u zw = *(const v2u*)(pr + C_LZ + col);
            const f32x4 v = a + bb; v2u o; o.x = pk2(v.x * blo(zw.x), v.y * bhi(zw.x)); o.y = pk2(v.z * blo(zw.y), v.w * bhi(zw.y));
            *(v2u*)(WSB(WS_YB) + (size_t)r * DM + col) = o; }
    }
}
#ifndef USE_NAIVE_ML
#define USE_NAIVE_ML 0
#endif
#ifndef USE_NAIVE_LRU
#define USE_NAIVE_LRU 0
#endif

namespace ml {
typedef short bf16x8 __attribute__((ext_vector_type(8)));
constexpr int KS_OFF = 0, KS_PITCH = 528;
constexpr int KT_OFF = KS_OFF + 64 * KS_PITCH, KT_PITCH = 144;
constexpr int VT_OFF = KT_OFF + 256 * KT_PITCH, VT_PITCH = 144;
constexpr int ST_OFF = VT_OFF + 80 * VT_PITCH, ST_PITCH = 144;
constexpr int CT_OFF = ST_OFF + 64 * ST_PITCH, CT_PITCH = 528;
constexpr int TAB_OFF = CT_OFF + 80 * CT_PITCH;
constexpr int END_OFF = TAB_OFF + 1024;
static_assert(END_OFF <= MISC_OFF, "mLSTM LDS map");
#define ML_MFMA(a, b, c) __builtin_amdgcn_mfma_f32_16x16x32_bf16((a), (b), (c), 0, 0, 0)
__device__ __forceinline__ int chunk_of(int k, int dir) { return k < 4 ? (dir ? 35 - k : 32 + k) : (dir ? 31 - (k - 4) : k - 4); }

__device__ __forceinline__ void mlstm_unit(Frame& F, CArgs* ka, int u, bool need_ctx) {
    const int tid = tid_fresh(), lane = tid & 63, w = __builtin_amdgcn_readfirstlane(tid >> 6), c16 = lane & 15, q = lane >> 4;
    const int es = u & 3, dir = (u >> 2) & 1, h = (u >> 3) & 7, b = u >> 6;
    LAS unsigned char* L = F.lds;
    const bf16_t* P = WSB(WS_P); bf16_t* MH = WSB(WS_MH) + (size_t)dir * MROWS * DM;
    const f32x4* GSC = (const f32x4*)WSF(WS_GSC) + (((size_t)b * 2 + dir) * 8 + h) * 36 * 64;
    LAS float* TABg = (LAS float*)(L + TAB_OFF); LAS float* TABmm = TABg + 64; LAS float* TABbc = TABg + 128;
    __syncthreads();
    for (int i = tid; i < 80 * CT_PITCH / 16; i += 512) *(LAS v4u*)(L + CT_OFF + i * 16) = (v4u){0u, 0u, 0u, 0u};
    for (int i = tid; i < 16 * 64; i += 512) { const int e = 64 + (i >> 6), s = i & 63; *(LAS bf16_t*)(L + VT_OFF + e * VT_PITCH + s * 2) = (bf16_t)(e == 64 ? 0x3F80 : 0); }
    f32x4 C[2][5];
#pragma unroll
    for (int a = 0; a < 2; ++a)
#pragma unroll
        for (int e = 0; e < 5; ++e) C[a][e] = (f32x4){0.f, 0.f, 0.f, 0.f};
    float m = -1e30f;
    const int tn = w & 3, wh = w >> 2;
    v4u kraw[4], vraw; bf16x8 Qf[8]; float gsc0, gsc1, gsc2;
#define ML_ROW(base, j) ((size_t)(base) + (dir ? 63 - (j) : (j)))
#define ML_LOAD_KVG(k) do { const int _c = chunk_of((k), dir), _base = b * TPB + _c * 64; const bf16_t* _rp = P + ML_ROW(_base, lane) * NP; \
        _Pragma("unroll") for (int i = 0; i < 4; ++i) kraw[i] = *(const v4u*)(_rp + C_MK + h * 256 + (w * 4 + i) * 8); \
        vraw = *(const v4u*)(_rp + C_MV + h * 256 + es * 64 + w * 8); { const float* _gp = (const float*)(GSC + _c * 64 + lane); gsc0 = _gp[0]; gsc1 = _gp[1]; gsc2 = _gp[2]; } } while (0)
#define ML_LOAD_Q(k) do { const int _base = b * TPB + chunk_of((k), dir) * 64; const bf16_t* _qp = P + ML_ROW(_base, tn * 16 + c16) * NP + C_MQ + h * 256 + q * 8; \
        _Pragma("unroll") for (int ks = 0; ks < 8; ++ks) Qf[ks] = *(const bf16x8*)(_qp + ks * 32); } while (0)
    ML_LOAD_KVG(0); ML_LOAD_Q(0);
#pragma unroll 1
    for (int k = 0; k < 36; ++k) {
        const int base = b * TPB + chunk_of(k, dir) * 64; const bool do_out = need_ctx || k >= 4;
        const float bc = gsc0, g = gsc1, mm = fmaxf(gsc2, m), bL = lane_get(bc, 63), mm63 = lane_get(mm, 63), wk = __expf(g - mm63);
        if (w == 0) { TABg[lane] = g; TABmm[lane] = mm; TABbc[lane] = bc; }
#pragma unroll
        for (int i = 0; i < 4; ++i) { *(LAS v4u*)(L + KS_OFF + lane * KS_PITCH + (w * 4 + i) * 16) = kraw[i];
#pragma unroll
            for (int e = 0; e < 4; ++e) { const unsigned x = kraw[i][e]; const unsigned pk = pk2(blo(x) * wk, bhi(x) * wk);
                *(LAS bf16_t*)(L + KT_OFF + ((w * 4 + i) * 8 + 2 * e) * KT_PITCH + lane * 2) = (bf16_t)(pk & 0xffffu); *(LAS bf16_t*)(L + KT_OFF + ((w * 4 + i) * 8 + 2 * e + 1) * KT_PITCH + lane * 2) = (bf16_t)(pk >> 16); } }
#pragma unroll
        for (int e = 0; e < 4; ++e) { const unsigned x = vraw[e];
            *(LAS bf16_t*)(L + VT_OFF + (w * 8 + 2 * e) * VT_PITCH + lane * 2) = (bf16_t)(x & 0xffffu); *(LAS bf16_t*)(L + VT_OFF + (w * 8 + 2 * e + 1) * VT_PITCH + lane * 2) = (bf16_t)(x >> 16); }
        __syncthreads();
        const int t = tn * 16 + c16; const int kn = k + 1 < 36 ? k + 1 : 35;
        if (do_out) {
            const float mmt = TABmm[t];
#pragma unroll
            for (int si = 0; si < 2; ++si) { const int sm = wh * 2 + si; v2u o = {0u, 0u};
                if (sm <= tn) { f32x4 acc = {0.f, 0.f, 0.f, 0.f};
#pragma unroll
                    for (int ks = 0; ks < 8; ++ks) { const bf16x8 a = *(const LAS bf16x8*)(L + KS_OFF + (sm * 16 + c16) * KS_PITCH + (ks * 32 + q * 8) * 2); acc = ML_MFMA(a, Qf[ks], acc); }
                    float v[4];
#pragma unroll
                    for (int j = 0; j < 4; ++j) { const int s = sm * 16 + q * 4 + j; v[j] = s <= t ? acc[j] * __expf(TABg[s] - mmt) : 0.f; }
                    o.x = pk2(v[0], v[1]); o.y = pk2(v[2], v[3]); }
                *(LAS v2u*)(L + ST_OFF + t * ST_PITCH + (sm * 16 + q * 4) * 2) = o; }
        }
        ML_LOAD_KVG(kn);
        __syncthreads();
        f32x4 num0 = {0.f, 0.f, 0.f, 0.f}, num1 = {0.f, 0.f, 0.f, 0.f}; float den = 1.f;
        if (do_out) {
            const float wi = __expf(m - TABmm[t]);
            bf16x8 sb[2];
#pragma unroll
            for (int ks = 0; ks < 2; ++ks) sb[ks] = *(const LAS bf16x8*)(L + ST_OFF + t * ST_PITCH + (ks * 32 + q * 8) * 2);
#pragma unroll
            for (int ei = 0; ei < 3; ++ei) { const int em = ei < 2 ? wh * 2 + ei : 4;
                f32x4 a1 = {0.f, 0.f, 0.f, 0.f}, a2 = {0.f, 0.f, 0.f, 0.f};
#pragma unroll
                for (int ks = 0; ks < 2; ++ks) { const bf16x8 a = *(const LAS bf16x8*)(L + VT_OFF + (em * 16 + c16) * VT_PITCH + (ks * 32 + q * 8) * 2); a1 = ML_MFMA(a, sb[ks], a1); }
#pragma unroll
                for (int ks = 0; ks < 8; ++ks) { const bf16x8 a = *(const LAS bf16x8*)(L + CT_OFF + (em * 16 + c16) * CT_PITCH + (ks * 32 + q * 8) * 2); a2 = ML_MFMA(a, Qf[ks], a2); }
                const f32x4 nv = a1 + a2 * wi;
                if (ei == 0) num0 = nv; else if (ei == 1) num1 = nv;
                else den = fmaxf(fabsf(lane_get(nv[0], c16)), __expf(-(TABbc[t] + TABmm[t]))); }
        }
        ML_LOAD_Q(kn);
        if (do_out) { const float rd = 1.f / den; bf16_t* op = MH + ML_ROW(base, t) * DM + h * 256 + es * 64 + q * 4; const f32x4 o0 = num0 * rd, o1 = num1 * rd;
            v2u w0, w1; w0.x = pk2(o0[0], o0[1]); w0.y = pk2(o0[2], o0[3]); w1.x = pk2(o1[0], o1[1]); w1.y = pk2(o1[2], o1[3]);
            *(v2u*)(op + (wh * 2) * 16) = w0; *(v2u*)(op + (wh * 2 + 1) * 16) = w1; }
        __syncthreads();
        { const float decay = __expf(m - mm63);
          bf16x8 vb[5][2];
#pragma unroll
          for (int en = 0; en < 5; ++en)
#pragma unroll
              for (int ks = 0; ks < 2; ++ks) vb[en][ks] = *(const LAS bf16x8*)(L + VT_OFF + (en * 16 + c16) * VT_PITCH + (ks * 32 + q * 8) * 2);
#pragma unroll
          for (int di = 0; di < 2; ++di) {
            bf16x8 a[2];
#pragma unroll
            for (int ks = 0; ks < 2; ++ks) a[ks] = *(const LAS bf16x8*)(L + KT_OFF + ((2 * w + di) * 16 + c16) * KT_PITCH + (ks * 32 + q * 8) * 2);
#pragma unroll
            for (int en = 0; en < 5; ++en) { f32x4 c = C[di][en] * decay;
#pragma unroll
                for (int ks = 0; ks < 2; ++ks) c = ML_MFMA(a[ks], vb[en][ks], c);
                C[di][en] = c; v2u o; o.x = pk2(c[0], c[1]); o.y = pk2(c[2], c[3]);
                *(LAS v2u*)(L + CT_OFF + (en * 16 + c16) * CT_PITCH + ((2 * w + di) * 16 + q * 4) * 2) = o; } }
          m = bL + mm63; }
        __syncthreads();
    }
#undef ML_ROW
#undef ML_LOAD_KVG
#undef ML_LOAD_Q
}
}

namespace lru {
typedef short bf16x8 __attribute__((ext_vector_type(8)));
constexpr int XB_OFF = 0, XB_PITCH = 272;
constexpr int XF_OFF = XB_OFF + 64 * XB_PITCH, XF_PITCH = 528;
constexpr int YO_OFF = XF_OFF + 64 * XF_PITCH, YO_PITCH = 528;
constexpr int HIN_OFF = YO_OFF + 64 * YO_PITCH;
constexpr int CW_OFF = HIN_OFF + 9 * 2 * 128 * 4;
constexpr int END_OFF = CW_OFF + 5 * 128 * 4;
static_assert(END_OFF <= MISC_OFF, "LRU LDS map");
#define LRU_COMPOSE(A, B, a2, b2) do { B = (a2) * B + (b2); A = (a2) * A; } while (0)

template <bool FINAL, class BcOf>
__device__ __forceinline__ void lru_run(Frame& F, CArgs* ka, int l, int blk, int NU, const BcOf& bc_of) {
    const int tid = tid_fresh(), lane = tid & 63, w = __builtin_amdgcn_readfirstlane(tid >> 6), c16 = lane & 15, q = lane >> 4;
    LAS unsigned char* L = F.lds; const bf16_t* P = WSB(WS_P);
    const int cg = tid & 15, rg = tid >> 4, chl = 16 * w + c16, ch = blk * 128 + chl;
    bf16x8 bw[4][4];
    { const bf16_t* Wt = WSB(WS_WLRU) + (size_t)l * 4 * 16 * 16384 + ((size_t)blk * 128 + chl) * 128 + q * 8;
#pragma unroll
      for (int g = 0; g < 4; ++g)
#pragma unroll
          for (int ks = 0; ks < 4; ++ks) bw[g][ks] = *(const bf16x8*)(Wt + (size_t)g * 16 * 16384 + ks * 32); }
    float cbr[2], cbi[2], csp[2];
#pragma unroll
    for (int dr = 0; dr < 2; ++dr) { cbr[dr] = KIN(12)[((size_t)l * 2 + dr) * DM + ch]; cbi[dr] = KIN(14)[((size_t)l * 2 + dr) * DM + ch]; csp[dr] = log1pf(__expf(-KIN(15)[((size_t)l * 2 + dr) * DM + ch])); }
    for (int i = tid; i < 5 * 128; i += 512) { const int kk = i >> 7, c = i & 127; ((LAS float*)(L + CW_OFF))[i] = kk < 4 ? KIN(9)[((size_t)l * 4 + kk) * DM + blk * 128 + c] : KIN(10)[(size_t)l * DM + blk * 128 + c]; }
    v4u raw[5];
#define LRU_LOAD(i) do { int _b, _c; bc_of((i), _b, _c); const int _t0 = _c * 64, _lo = _c < 32 ? 0 : SEQ, _hi = _c < 32 ? SEQ : TPB; const size_t _rb = (size_t)_b * TPB; \
        _Pragma("unroll") for (int x = 0; x < 5; ++x) { const int tt = _t0 + 2 * rg - 2 + x; raw[x] = (v4u){0u, 0u, 0u, 0u}; if (tt >= _lo && tt < _hi) raw[x] = *(const v4u*)(P + (_rb + tt) * NP + C_LX + blk * 128 + cg * 8); } \
        } while (0)
    LRU_LOAD(0);
#pragma unroll 1
    for (int ui = 0; ui < NU; ++ui) {
        int b, chunk; bc_of(ui, b, chunk); const size_t rb = (size_t)b * TPB; const int t0 = chunk * 64;
        __syncthreads();
        {
          float o0[8], o1[8]; const LAS float* cwl = (const LAS float*)(L + CW_OFF) + cg * 8;
#pragma unroll
          for (int e = 0; e < 8; ++e) { o0[e] = cwl[4 * 128 + e]; o1[e] = o0[e]; }
#pragma unroll
          for (int kk = 0; kk < 5; ++kk) { float xin[8];
#pragma unroll
              for (int e = 0; e < 4; ++e) { xin[2 * e] = blo(raw[kk][e]); xin[2 * e + 1] = bhi(raw[kk][e]); }
#pragma unroll
              for (int e = 0; e < 8; ++e) { if (kk < 4) o0[e] += cwl[kk * 128 + e] * xin[e]; if (kk > 0) o1[e] += cwl[(kk - 1) * 128 + e] * xin[e]; } }
          v4u p0, p1; p0.x = pk2(o0[0], o0[1]); p0.y = pk2(o0[2], o0[3]); p0.z = pk2(o0[4], o0[5]); p0.w = pk2(o0[6], o0[7]); p1.x = pk2(o1[0], o1[1]); p1.y = pk2(o1[2], o1[3]); p1.z = pk2(o1[4], o1[5]); p1.w = pk2(o1[6], o1[7]);
          *(LAS v4u*)(L + XB_OFF + (2 * rg) * XB_PITCH + cg * 16) = p0; *(LAS v4u*)(L + XB_OFF + (2 * rg + 1) * XB_PITCH + cg * 16) = p1;
          LAS float* f0 = (LAS float*)(L + XF_OFF + (2 * rg) * XF_PITCH + cg * 32); LAS float* f1 = (LAS float*)(L + XF_OFF + (2 * rg + 1) * XF_PITCH + cg * 32);
          *(LAS f32x4*)f0 = (f32x4){o0[0], o0[1], o0[2], o0[3]}; *(LAS f32x4*)(f0 + 4) = (f32x4){o0[4], o0[5], o0[6], o0[7]};
          *(LAS f32x4*)f1 = (f32x4){o1[0], o1[1], o1[2], o1[3]}; *(LAS f32x4*)(f1 + 4) = (f32x4){o1[4], o1[5], o1[6], o1[7]}; }
        __syncthreads();
        v4u zcur[2];
        if (FINAL) {
#pragma unroll
            for (int x = 0; x < 2; ++x) { const int cidx = tid + 512 * x; zcur[x] = *(const v4u*)(P + (rb + t0 + (cidx >> 4)) * NP + C_LZ + blk * 128 + (cidx & 15) * 8); } }
        if (ui + 1 < NU) LRU_LOAD(ui + 1);
#pragma unroll
        for (int dr = 0; dr < 2; ++dr) {
            f32x4 acc[2][4];
#pragma unroll
            for (int g = 0; g < 2; ++g)
#pragma unroll
                for (int tm = 0; tm < 4; ++tm) acc[g][tm] = (f32x4){0.f, 0.f, 0.f, 0.f};
#pragma unroll
            for (int ks = 0; ks < 4; ++ks) { bf16x8 a[4];
#pragma unroll
                for (int tm = 0; tm < 4; ++tm) a[tm] = *(const LAS bf16x8*)(L + XB_OFF + (tm * 16 + c16) * XB_PITCH + (ks * 32 + q * 8) * 2);
#pragma unroll
                for (int g = 0; g < 2; ++g)
#pragma unroll
                    for (int tm = 0; tm < 4; ++tm) acc[g][tm] = __builtin_amdgcn_mfma_f32_16x16x32_bf16(a[tm], bw[2 * dr + g][ks], acc[g][tm], 0, 0, 0); }
#pragma unroll
            for (int tm = 0; tm < 4; ++tm)
#pragma unroll
                for (int j = 0; j < 4; ++j) { const int t = tm * 16 + q * 4 + j; const float xv = *(const LAS float*)(L + XF_OFF + t * XF_PITCH + chl * 4);
                    const float rgt = pg8::sigmoid_f(acc[0][tm][j] + cbr[dr]), igt = pg8::sigmoid_f(acc[1][tm][j] + cbi[dr]), la = -8.f * rgt * csp[dr], av = __expf(la), x2 = 2.f * la;
                    const float om = x2 > -0.1f ? -x2 * (1.f + x2 * (0.5f + x2 * (0.16666667f + x2 * (0.041666668f + x2 * 0.0083333338f)))) : 1.f - av * av;
                    acc[0][tm][j] = av; acc[1][tm][j] = sqrtf(om) * igt * xv; }
#define LRU_TM(i) (dr ? 3 - (i) : (i))
            if constexpr (!FINAL) {
                float2* AGG = (float2*)WSF(WS_LA); float TA = 1.f, TB = 0.f;
#pragma unroll
                for (int ti = 0; ti < 4; ++ti) { const int tm = LRU_TM(ti); float sa = 1.f, sb = 0.f;
#pragma unroll
                    for (int ji = 0; ji < 4; ++ji) { const int j = LRU_TM(ji); LRU_COMPOSE(sa, sb, acc[0][tm][j], acc[1][tm][j]); }
#pragma unroll
                    for (int qi = 0; qi < 4; ++qi) { const int qq = LRU_TM(qi); const float xa = lane_get(sa, c16 + 16 * qq), xb = lane_get(sb, c16 + 16 * qq); LRU_COMPOSE(TA, TB, xa, xb); } }
                if (q == 0) AGG[(((size_t)b * 36 + chunk) * 2 + dr) * DM + ch] = make_float2(TA, TB);
            } else {
                float H = ((const LAS float*)(L + HIN_OFF))[ui * 256 + dr * 128 + chl];
#pragma unroll
                for (int ti = 0; ti < 4; ++ti) { const int tm = LRU_TM(ti); float sa = 1.f, sb = 0.f;
#pragma unroll
                    for (int ji = 0; ji < 4; ++ji) { const int j = LRU_TM(ji); LRU_COMPOSE(sa, sb, acc[0][tm][j], acc[1][tm][j]); }
                    float ea = 1.f, eb = 0.f, ta = 1.f, tb = 0.f;
#pragma unroll
                    for (int qi = 0; qi < 4; ++qi) { const int qq = LRU_TM(qi); const float xa = lane_get(sa, c16 + 16 * qq), xb = lane_get(sb, c16 + 16 * qq); if (qq == q) { ea = ta; eb = tb; } LRU_COMPOSE(ta, tb, xa, xb); }
                    float hs = ea * H + eb;
#pragma unroll
                    for (int ji = 0; ji < 4; ++ji) { const int j = LRU_TM(ji); hs = acc[0][tm][j] * hs + acc[1][tm][j]; LAS float* yp = (LAS float*)(L + YO_OFF + (tm * 16 + q * 4 + j) * YO_PITCH + chl * 4);
                        if (dr == 0) *yp = hs; else *yp += hs; }
                    H = ta * H + tb; }
            }
#undef LRU_TM
        }
        if constexpr (FINAL) {
            __syncthreads();
            bf16_t* YB0 = WSB(WS_YB);
#pragma unroll
            for (int i = 0; i < 2; ++i) { const int cidx = tid + 512 * i, row = cidx >> 4, cgo = cidx & 15; const size_t rgl = rb + t0 + row;
                const f32x4 y0 = *(const LAS f32x4*)(L + YO_OFF + row * YO_PITCH + cgo * 32), y1 = *(const LAS f32x4*)(L + YO_OFF + row * YO_PITCH + cgo * 32 + 16);
                const v4u z = zcur[i];
                v4u o; o.x = pk2(y0[0] * blo(z.x), y0[1] * bhi(z.x)); o.y = pk2(y0[2] * blo(z.y), y0[3] * bhi(z.y)); o.z = pk2(y1[0] * blo(z.z), y1[1] * bhi(z.z)); o.w = pk2(y1[2] * blo(z.w), y1[3] * bhi(z.w));
                *(v4u*)(YB0 + rgl * DM + blk * 128 + cgo * 8) = o; }
        }
    }
#undef LRU_LOAD
}
__device__ __forceinline__ void p_lru_agg(Frame& F, CArgs* ka, int l) {
    for (int v = F.wg; v < 256; v += F.G) { const int blk = v & 15, c0 = v >> 4;
        lru_run<false>(F, ka, l, blk, 9, [c0](int i, int& b, int& c) { const int x = c0 + 16 * i; b = x / 36; c = x - b * 36; }); }
}
__device__ __forceinline__ void p_lru_final(Frame& F, CArgs* ka, int l, bool need_ctx) {
    for (int v = F.wg; v < 256; v += F.G) { const int b = v >> 6, blk = (v >> 2) & 15, qt = v & 3;
        const int tid = tid_fresh();
        __syncthreads();
        if (tid < 256) { const int dirx = tid >> 7, chl = tid & 127; const float2* AGG = (const float2*)WSF(WS_LA) + ((size_t)b * 36 * 2 + dirx) * DM + blk * 128 + chl;
            LAS float* HIN = (LAS float*)(F.lds + HIN_OFF); float hcar = 0.f;
#pragma unroll 12
            for (int k = 0; k < 36; ++k) { const int cidx = ml::chunk_of(k, dirx); const float2 ab = AGG[(size_t)cidx * 2 * DM];
                const int sl = cidx - qt * 9; if (sl >= 0 && sl < 9) HIN[sl * 256 + dirx * 128 + chl] = hcar;
                hcar = ab.x * hcar + ab.y; } }
        lru_run<true>(F, ka, l, blk, (need_ctx || qt < 3) ? 9 : 5, [b, qt](int i, int& bb, int& c) { bb = b; c = qt * 9 + i; });
    }
}
}

#ifndef GEMM_NHALF
#define GEMM_NHALF false
#endif
#ifndef CONVERT_AHEAD
#define CONVERT_AHEAD 1
#endif
#ifndef DUP_PRO
#define DUP_PRO 0
#endif
#ifndef DUP_THIN
#define DUP_THIN 0
#endif
#ifndef DUP_G1
#define DUP_G1 0
#endif
#ifndef DUP_HEAVY
#define DUP_HEAVY 0
#endif
#ifndef DUP_ATT
#define DUP_ATT 0
#endif
#ifndef DUP_ML
#define DUP_ML 0
#endif
#ifndef DUP_LRU1
#define DUP_LRU1 0
#endif
#ifndef DUP_G23
#define DUP_G23 0
#endif
__global__ void __launch_bounds__(NWAVES * 64, 2) fwd(Args args) {
    extern __shared__ __attribute__((aligned(16))) unsigned char lds[];
    Frame F;
    F.lds = (LAS unsigned char*)lds; F.ldsg = (char*)lds;
    F.tid = threadIdx.x; F.lane = F.tid & 63; F.wave = __builtin_amdgcn_readfirstlane(F.tid >> 6); F.G = gridDim.x; F.wg = blockIdx.x;
    CArgs* const ka0 = (CArgs*)__builtin_amdgcn_kernarg_segment_ptr();
    unsigned char* ws; { CArgs* ka = ka0; ws = ka->ws; }
    volatile LAS unsigned* MISC = (volatile LAS unsigned*)(F.lds + MISC_OFF);
    if (F.tid < 64) ((LAS unsigned*)(F.lds + MISC_OFF))[F.tid] = 0u;
    __syncthreads();
    const int lo = ka0->ph_lo, hi = ka0->ph_hi;
    XcdBarrier bar; bar.bar = (unsigned*)(ws + WS_CTL) + CW_BAR; bar.x = 0; bar.st = nullptr;
    if (hi - lo > 1) bar = xcd_barrier_post((unsigned*)(ws + WS_CTL) + CW_BAR, MISC + 8);
#define IN(k) (lo <= (k) && (k) < hi)
#define SEAM(k) do { if ((k) + 1 < hi) xcd_barrier(bar); } while (0)

    if (IN(0)) { for (int rep = 0; rep <= DUP_PRO; ++rep) { const int wv = F.wg * NWAVES + F.wave, nwv = F.G * NWAVES;
            for (int lc = 0; lc < (CONVERT_AHEAD ? 1 : DEPTH); ++lc) p_convert(F, KA(), lc, wv, nwv);
            p_prologue(F, KA()); }
        SEAM(0); }
#pragma unroll 1
    for (int l = 0; l < DEPTH; ++l) {
        const int base = 1 + l * PH_PER_LAYER; const bool need_ctx = l < DEPTH - 1;
        if (IN(base + 0)) { p_norm(F, KA(), l); SEAM(base + 0); }
        if (IN(base + 1)) {
            CArgs* ka = KA(); pg8::Gemm g{WSB(WS_H), WSB(WS_WIN) + (size_t)l * NP * DM, MROWS, NP, DM, 0, 0}; pg8::InOrder S; S.init(MROWS, NP, F.G, F.wg, 256, !need_ctx);
            pg8::EpiIn E{WSB(WS_P)};
            pg8::gemm_phase<pg8::EpiIn, pg8::InOrder, true, true>(F.lds, g, S, E);
            if (DUP_G1) pg8::gemm_phase<pg8::EpiIn, pg8::InOrder, true, true>(F.lds, g, S, E);
            if (need_ctx) {
                const int nu = (MROWS / 256) * (NP / 256), extra = nu % F.G;
                if (F.wg >= extra) p_gates(F, KA(), l, F.wg - extra, F.G - extra); }
            SEAM(base + 1);
        }
        if (IN(base + 2)) { if (!need_ctx) p_gates(F, KA(), l, F.wg, F.G); p_knorm(F, KA(), l);
#if USE_NAIVE_LRU
            p_lru_gates_naive(F, KA(), l);
#endif
            SEAM(base + 2); }
        if (IN(base + 3)) { for (int rep = 0; rep <= DUP_HEAVY; ++rep) { for (int r2 = 0; r2 <= DUP_ATT; ++r2) p_attention(F, KA(), l, need_ctx);
#if USE_NAIVE_ML
            p_mlstm_naive(F, KA(), l);
#else
            for (int r2 = 0; r2 <= DUP_ML; ++r2) for (int u = F.wg; u < 256; u += F.G) ml::mlstm_unit(F, KA(), u, need_ctx);
#endif
#if USE_NAIVE_LRU
            p_lru_scan_naive(F, KA());
#else
            for (int r2 = 0; r2 <= DUP_LRU1; ++r2) lru::p_lru_agg(F, KA(), l);
#endif
            }
            SEAM(base + 3); }
        if (IN(base + 4)) { for (int rep = 0; rep <= DUP_THIN; ++rep) { p_mlout(F, KA(), l, need_ctx);
#if USE_NAIVE_LRU
            p_lru_combine_naive(F, KA());
#else
            lru::p_lru_final(F, KA(), l, need_ctx);
#endif
            }
            SEAM(base + 4); }
        if (IN(base + 5)) {
            CArgs* ka = KA(); pg8::Gemm g{WSB(WS_YB), WSB(WS_WBR) + (size_t)l * 3 * DM * DM, MROWS, DM, DM, (size_t)MROWS * DM * 2, (size_t)DM * DM * 2}; pg8::MergeOrder S; S.init(MROWS, DM, F.G, F.wg, GEMM_NHALF ? 128 : 256, !need_ctx);
            pg8::EpiMerge<GEMM_NHALF> E{WSB(WS_P), WSF(WS_ACC), WSB(WS_G2)};
            pg8::gemm_phase<pg8::EpiMerge<GEMM_NHALF>, pg8::MergeOrder, true, true, GEMM_NHALF>(F.lds, g, S, E);
            if (DUP_G23) pg8::gemm_phase<pg8::EpiMerge<GEMM_NHALF>, pg8::MergeOrder, true, true, GEMM_NHALF>(F.lds, g, S, E);
            if (CONVERT_AHEAD && l + 1 < DEPTH) {
                const int ntile = (MROWS / 256) * (DM / (GEMM_NHALF ? 128 : 256)), busy2 = (ntile > F.G && ntile < 2 * F.G) ? ntile - F.G : 0;
                if (F.wg >= busy2) p_convert(F, KA(), l + 1, (F.wg - busy2) * NWAVES + F.wave, (F.G - busy2) * NWAVES); }
            SEAM(base + 5);
        }
        if (IN(base + 6)) {
            CArgs* ka = KA(); pg8::Gemm g{WSB(WS_G2), WSB(WS_WOUT) + (size_t)l * DM * DM, MROWS, DM, DM, 0, 0}; pg8::StaticOrder S; S.init(MROWS, DM, F.G, F.wg, GEMM_NHALF ? 128 : 256, !need_ctx);
            pg8::EpiF32<GEMM_NHALF> E{WSF(WS_Y), DM};
            pg8::gemm_phase<pg8::EpiF32<GEMM_NHALF>, pg8::StaticOrder, true, true, GEMM_NHALF>(F.lds, g, S, E);
            if (DUP_G23) pg8::gemm_phase<pg8::EpiF32<GEMM_NHALF>, pg8::StaticOrder, true, true, GEMM_NHALF>(F.lds, g, S, E);
            SEAM(base + 6);
        }
    }
    if (IN(N_PHASES - 1)) p_norm(F, KA(), DEPTH);
#undef IN
#undef SEAM
}

extern "C" void kernel_launch(void* const* d_in, const int* in_sizes, int n_in, void* d_out, int out_size, void* d_ws, size_t ws_size, hipStream_t stream) {
    static int grid = 0;
    if (grid == 0) {
        if (n_in != 22 || in_sizes[0] != NBATCH * SEQ * DM || out_size != NBATCH * SEQ * DM || ws_size < WS_END) {
            fprintf(stderr, "kernel_launch: unexpected shapes: n_in %d in0 %d out %d ws %zu (need %zu)\n", n_in, n_in > 0 ? in_sizes[0] : -1, out_size, ws_size, (size_t)WS_END); grid = -1; return; }
        int dev = 0, cus = 0, per_cu = 0;
        if (hipGetDevice(&dev) != hipSuccess || hipDeviceGetAttribute(&cus, hipDeviceAttributeMultiprocessorCount, dev) != hipSuccess) { fprintf(stderr, "kernel_launch: device query failed\n"); grid = -1; return; }
        if (hipFuncSetAttribute((const void*)fwd, hipFuncAttributeMaxDynamicSharedMemorySize, LDS_BYTES) != hipSuccess) { fprintf(stderr, "kernel_launch: hipFuncSetAttribute failed\n"); grid = -1; return; }
        if (hipOccupancyMaxActiveBlocksPerMultiprocessor(&per_cu, (const void*)fwd, NWAVES * 64, LDS_BYTES) != hipSuccess || per_cu < 1)
            fprintf(stderr, "kernel_launch: note: occupancy query reports %d workgroups per CU\n", per_cu);
        (void)hipGetLastError();
        grid = cus;
    }
    if (grid < 0) return;
    if (hipMemsetAsync((char*)d_ws + WS_CTL, 0, CTL_ZERO_BYTES, stream) != hipSuccess) { fprintf(stderr, "kernel_launch: memset failed\n"); return; }
    Args a{};
    for (int i = 0; i < 22; ++i) a.in[i] = (const float*)d_in[i];
    a.out = (float*)d_out; a.ws = (unsigned char*)d_ws;
    if (MK_N_LAUNCHES == 1) { a.ph_lo = 0; a.ph_hi = N_PHASES; hipLaunchKernelGGL(fwd, dim3(grid), dim3(NWAVES * 64), LDS_BYTES, stream, a); }
    else for (int k = 0; k < N_PHASES; ++k) { a.ph_lo = k; a.ph_hi = k + 1; hipLaunchKernelGGL(fwd, dim3(grid), dim3(NWAVES * 64), LDS_BYTES, stream, a); }
    const hipError_t le = hipPeekAtLastError();
    if (le != hipSuccess) fprintf(stderr, "kernel_launch: launch failed: %s\n", hipGetErrorName(le));
}
```

```cpp
#include <hip/hip_runtime.h>
#include <hip/hip_bf16.h>
#include <cstdio>
#include <cstdint>

constexpr int DM = 2048, NBATCH = 4, SEQ = 2048, CTXL = 256, TPB = SEQ + CTXL  , MROWS = NBATCH * TPB  , DEPTH = 4;
constexpr int NIN = 25632, NP = 25600;
constexpr int C_LX = 0, C_LZ = 2048, C_MQ = 4096, C_MK = 6144, C_MV = 8192, C_MO = 10240, C_MZ = 12288, C_AQ = 14336, C_AK = 16384, C_AV = 16896, C_AZ = 17408, C_MG = 19456;
constexpr float EPS = 1e-6f;
namespace pg8 {
#define PG8_LAS __attribute__((address_space(3)))
typedef unsigned short bf16_t;
typedef short bf16x8 __attribute__((ext_vector_type(8)));
typedef float f32x4 __attribute__((ext_vector_type(4)));
typedef unsigned u32x4 __attribute__((ext_vector_type(4)));
constexpr int BM = 256, BK = 64, HALF = 128, HTB = HALF * BK * 2  , STAGE_BYTES = 8 * HTB, NXCD = 8, WGM = 8;

__host__ __device__ __forceinline__ int lds_byte(int r, int c) { const int st = (r >> 4) * 2 + (c >> 5), rr = r & 15, cc = c & 31, ob = rr * 64 + cc * 2; return st * 1024 + (ob ^ (((ob >> 9) & 1) << 5)); }
__host__ __device__ __forceinline__ void stage_rc(int b, int& R, int& C) { const int st = b / 1024, sb = b % 1024, swz = sb ^ (((sb >> 9) & 1) << 5); R = (st >> 1) * 16 + swz / 64; C = (st & 1) * 32 + (swz % 64) / 2; }
__host__ __device__ __forceinline__ int perm32(int rho) { const int n = rho >> 4, i = rho & 15; return 8 * (i >> 2) + 4 * n + (i & 3); }

struct Unit { int pm, pn, z; };
struct Gemm { const bf16_t* A; const bf16_t* Bt; int M, N, K; size_t zA, zB; };

struct StaticOrder {
    int nM, nN, nwg, G, c; bool lat;
    __host__ __device__ void init(int M, int N, int G_, int c_, int tileN = BM, bool lat_ = false) { lat = lat_; nM = lat ? (M / BM) * 8 / 9 : M / BM; nN = N / tileN; nwg = nM * nN; G = G_; c = c_; }
    __host__ __device__ bool map(long L, Unit& u) const {
        if (L >= nwg) return false;
        int wgid = (int)L; { const int q = nwg / NXCD, r = nwg % NXCD, xcd = wgid % NXCD, off = wgid / NXCD; wgid = (xcd < r ? xcd * (q + 1) : r * (q + 1) + (xcd - r) * q) + off; }
        const int nig = WGM * nN, gid = wgid / nig, fm = gid * WGM, gsz = (nM - fm) < WGM ? (nM - fm) : WGM;
        u.pm = fm + ((wgid % nig) % gsz); u.pn = (wgid % nig) / gsz; u.z = 0; if (lat) u.pm = (u.pm >> 3) * 9 + (u.pm & 7); return true;
    }
    __host__ __device__ bool next(int i, Unit& u) const { return map((long)i * G + c, u); }
    __device__ __forceinline__ void a_ready(const Unit&) const {}
    __device__ __forceinline__ void done(const Unit&) const {}
};
struct InOrder : StaticOrder {
    __host__ __device__ bool next(int i, Unit& u) const { const long L = (long)i * G + c; if (L < nwg) return map(L, u);
        if (!lat) return false; const int idx = (int)(L - nwg); if (idx >= 4 * 28) return false;
        const int bb = idx / 28, j = idx - bb * 28; u.pm = 9 * bb + 8; u.z = 0; u.pn = j < 8 ? j : j < 16 ? 16 + j : j < 24 ? 16 + j : j < 26 ? 40 + j : 40 + j; return true; }
};
struct FixedOrder : StaticOrder {
    __host__ __device__ bool next(int i, Unit& u) const { if (!StaticOrder::next(i, u)) return false; u.pm = 0; u.pn = 0; return true; }
};
struct MergeOrder : StaticOrder {
    __host__ __device__ bool next(int i, Unit& u) const { const int it = i / 3; if (!StaticOrder::next(it, u)) return false; u.z = i - 3 * it; return true; }
};

__device__ __forceinline__ unsigned cvt_pk_bf16(float lo, float hi) { unsigned r; asm volatile("v_cvt_pk_bf16_f32 %0, %1, %2" : "=v"(r) : "v"(lo), "v"(hi)); return r; }
__device__ __forceinline__ float bflo(unsigned w) { return __uint_as_float(w << 16); }
__device__ __forceinline__ float bfhi(unsigned w) { return __uint_as_float(w & 0xffff0000u); }
__device__ __forceinline__ float sigmoid_f(float x) { return __builtin_amdgcn_rcpf(1.f + __expf(-x)); }

template <bool NHALF> struct EpiF32 {
    static constexpr bool PERM = false, AFTER_DRAIN = false;
    float* C; int ldc;
    __device__ __forceinline__ void operator()(const f32x4 (&acc)[2][2][4][2], const Unit& u, int wr, int wc, int fr, int fq) const {
        const int row0 = u.pm * BM + wr * 64 + fr, col0 = u.pn * (NHALF ? HALF : BM) + wc * 32 + 4 * fq;
#pragma unroll
        for (int ai = 0; ai < 2; ++ai)
#pragma unroll
            for (int m = 0; m < 4; ++m) { float* rowp = C + (size_t)(row0 + ai * HALF + m * 16) * ldc + col0;
#pragma unroll
                for (int bj = 0; bj < (NHALF ? 1 : 2); ++bj)
#pragma unroll
                    for (int n = 0; n < 2; ++n) *(f32x4*)(rowp + bj * HALF + n * 16) = acc[ai][bj][m][n]; }
    }
};
struct EpiNull {
    static constexpr bool PERM = true, AFTER_DRAIN = false; float* sink;
    __device__ __forceinline__ void operator()(const f32x4 (&acc)[2][2][4][2], const Unit& u, int wr, int wc, int fr, int fq) const {
        float s = 0.f;
#pragma unroll
        for (int ai = 0; ai < 2; ++ai)
#pragma unroll
            for (int bj = 0; bj < 2; ++bj)
#pragma unroll
                for (int m = 0; m < 4; ++m)
#pragma unroll
                    for (int n = 0; n < 2; ++n) s += acc[ai][bj][m][n][0] + acc[ai][bj][m][n][1] + acc[ai][bj][m][n][2] + acc[ai][bj][m][n][3];
        if (s == 123.456f) sink[0] = s; }
};
struct EpiIn {
    static constexpr bool PERM = true, AFTER_DRAIN = false;
    bf16_t* O;
    __device__ __forceinline__ void operator()(const f32x4 (&acc)[2][2][4][2], const Unit& u, int wr, int wc, int fr, int fq) const {
        const int row0 = u.pm * BM + wr * 64 + fr, col0 = u.pn * BM + wc * 32 + 8 * fq, pn = u.pn;
        int act = 0;
        if ((pn >= 8 && pn < 16) || (pn >= 48 && pn < 56) || (pn >= 68 && pn < 76)) act = 1;
        else if ((pn >= 40 && pn < 48) || pn >= 76) act = 2;
        else if (pn >= 24 && pn < 32) act = 3;
#pragma unroll
        for (int ai = 0; ai < 2; ++ai)
#pragma unroll
            for (int m = 0; m < 4; ++m) { bf16_t* rowp = O + (size_t)(row0 + ai * HALF + m * 16) * NP + col0;
#pragma unroll
                for (int bj = 0; bj < 2; ++bj) { f32x4 v0 = acc[ai][bj][m][0], v1 = acc[ai][bj][m][1];
                    if (act == 1) {
#pragma unroll
                        for (int j = 0; j < 4; ++j) { v0[j] = v0[j] * sigmoid_f(v0[j]); v1[j] = v1[j] * sigmoid_f(v1[j]); } }
                    else if (act == 2) {
#pragma unroll
                        for (int j = 0; j < 4; ++j) { v0[j] = sigmoid_f(v0[j]); v1[j] = sigmoid_f(v1[j]); } }
                    else if (act == 3) { v0 = v0 * 0.0625f; v1 = v1 * 0.0625f; }
                    u32x4 w; w.x = cvt_pk_bf16(v0[0], v0[1]); w.y = cvt_pk_bf16(v0[2], v0[3]); w.z = cvt_pk_bf16(v1[0], v1[1]); w.w = cvt_pk_bf16(v1[2], v1[3]);
                    *(u32x4*)(rowp + bj * HALF) = w; } }
    }
};
template <bool NHALF> struct EpiMerge {
    static constexpr bool PERM = true, AFTER_DRAIN = false;
    const bf16_t* P; float* ACC; bf16_t* G2;
    __device__ __forceinline__ void operator()(const f32x4 (&acc)[2][2][4][2], const Unit& u, int wr, int wc, int fr, int fq) const {
        const int row0 = u.pm * BM + wr * 64 + fr, col0 = u.pn * (NHALF ? HALF : BM) + wc * 32 + 8 * fq, z = u.z;
#pragma unroll
        for (int ai = 0; ai < 2; ++ai)
#pragma unroll
            for (int m = 0; m < 4; ++m) { const size_t r = (size_t)(row0 + ai * HALF + m * 16);
#pragma unroll
                for (int bj = 0; bj < (NHALF ? 1 : 2); ++bj) { const int c = col0 + bj * HALF;
                    const u32x4 g = *(const u32x4*)(P + r * NP + C_MG + z * DM + c);
                    f32x4 v0 = acc[ai][bj][m][0], v1 = acc[ai][bj][m][1];
                    v0[0] *= bflo(g.x); v0[1] *= bfhi(g.x); v0[2] *= bflo(g.y); v0[3] *= bfhi(g.y);
                    v1[0] *= bflo(g.z); v1[1] *= bfhi(g.z); v1[2] *= bflo(g.w); v1[3] *= bfhi(g.w);
                    float* ap = ACC + r * DM + c;
                    if (z > 0) { v0 = v0 + *(const f32x4*)ap; v1 = v1 + *(const f32x4*)(ap + 4); }
                    if (z < 2) { *(f32x4*)ap = v0; *(f32x4*)(ap + 4) = v1; }
                    else { u32x4 w; w.x = cvt_pk_bf16(v0[0], v0[1]); w.y = cvt_pk_bf16(v0[2], v0[3]); w.z = cvt_pk_bf16(v1[0], v1[1]); w.w = cvt_pk_bf16(v1[2], v1[3]);
                        *(u32x4*)(G2 + r * DM + c) = w; } } }
    }
};
template <class Epi, class Sched, bool ALIGN_EPI = false, bool SP2 = false, bool NHALF = false>
__device__ __forceinline__ void gemm_phase(PG8_LAS unsigned char* lds, const Gemm g, const Sched& S, const Epi& E) {
    int tid = threadIdx.x; asm volatile("" : "+v"(tid));
    const int wid = __builtin_amdgcn_readfirstlane(tid >> 6), lane = tid & 63, wr = wid >> 2, wc = wid & 3, fr = lane & 15, fq = lane >> 4;
    const int K = g.K, nt = K / BK;
    unsigned voffA[2], voffB[2];
#pragma unroll
    for (int i = 0; i < 2; ++i) { int R, C; stage_rc(tid * 16 + i * 8192, R, C); const int Rb = Epi::PERM ? ((R & ~31) + perm32(R & 31)) : R;
        voffA[i] = (unsigned)(R * K + C) * 2u; voffB[i] = (unsigned)(Rb * K + C) * 2u; }
    const size_t kstep = (size_t)(BK * 2);
    const size_t hstep = (size_t)HALF * K * 2;
    const size_t tstep = 2 * hstep;
    const size_t hsB = NHALF ? 0 : hstep, tstepB = NHALF ? hstep : tstep; static_assert(!NHALF || SP2, "NHALF is implemented for the SP2 loop");
    const unsigned ldsw = (unsigned)wid * 1024u;
    const int aoff = lds_byte(wr * 64 + fr, fq * 8), boff = lds_byte(wc * 32 + fr, fq * 8);
#define PG8_SA(b, h) (((b) * 2 + (h)) * HTB)
#define PG8_SB(b, h) ((4 + (b) * 2 + (h)) * HTB)
#define PG8_STAGE(bufoff, gbase, voff) do { _Pragma("unroll") for (int _i = 0; _i < 2; ++_i) \
        __builtin_amdgcn_global_load_lds((const unsigned*)((const char*)(gbase) + (voff)[_i]), (PG8_LAS unsigned*)(lds + (bufoff) + ldsw + _i * 8192), 16, 0, 0); } while (0)
#define PG8_LDA(dst, b, h) do { _Pragma("unroll") for (int m = 0; m < 4; ++m) _Pragma("unroll") for (int k = 0; k < 2; ++k) dst[m][k] = *(const PG8_LAS bf16x8*)(lds + PG8_SA(b, h) + aoff + m * 2048 + k * 1024); } while (0)
#define PG8_LDB(dst, b, h) do { _Pragma("unroll") for (int n = 0; n < 2; ++n) _Pragma("unroll") for (int k = 0; k < 2; ++k) dst[n][k] = *(const PG8_LAS bf16x8*)(lds + PG8_SB(b, h) + boff + n * 2048 + k * 1024); } while (0)
#define PG8_MMA(ai, bj, At, Bt) do { __builtin_amdgcn_s_setprio(1); _Pragma("unroll") for (int m = 0; m < 4; ++m) _Pragma("unroll") for (int n = 0; n < 2; ++n) _Pragma("unroll") for (int k = 0; k < 2; ++k) \
        acc[ai][bj][m][n] = __builtin_amdgcn_mfma_f32_16x16x32_bf16(Bt[n][k], At[m][k], acc[ai][bj][m][n], 0, 0, 0); __builtin_amdgcn_s_setprio(0); } while (0)
#define PG8_WAIT_V(n) asm volatile("s_waitcnt vmcnt(" #n ")" ::: "memory")
#define PG8_WAIT_L(n) asm volatile("s_waitcnt lgkmcnt(" #n ")" ::: "memory")
#define PG8_BAR __builtin_amdgcn_s_barrier()
#define PG8_SCHED __builtin_amdgcn_sched_barrier(0)
    Unit cur, nxt; int ui = 0;
    if (!S.next(0, cur)) return;
    f32x4 acc[2][2][4][2];
#pragma unroll
    for (int a = 0; a < 2; ++a)
#pragma unroll
        for (int b = 0; b < 2; ++b)
#pragma unroll
            for (int m = 0; m < 4; ++m)
#pragma unroll
                for (int n = 0; n < 2; ++n) acc[a][b][m][n] = (f32x4){0.f, 0.f, 0.f, 0.f};
    bf16x8 At[4][2], B0[2][2], B1[2][2];
    const char* cA = (const char*)g.A + (size_t)cur.z * g.zA + (size_t)cur.pm * tstep; const char* cB = (const char*)g.Bt + (size_t)cur.z * g.zB + (size_t)cur.pn * tstepB;
    S.a_ready(cur);
    if constexpr (SP2) {
        PG8_STAGE(PG8_SB(0, 0), cB, voffB); PG8_STAGE(PG8_SB(0, 1), cB + hsB, voffB); PG8_STAGE(PG8_SA(0, 0), cA, voffA); PG8_STAGE(PG8_SA(0, 1), cA + hstep, voffA);
        if (wr == 1) PG8_BAR;
        PG8_WAIT_V(2); PG8_BAR;
        PG8_STAGE(PG8_SB(1, 0), cB + kstep, voffB); PG8_STAGE(PG8_SA(1, 0), cA + kstep, voffA); PG8_STAGE(PG8_SB(1, 1), cB + hsB + kstep, voffB);
        PG8_WAIT_V(6); PG8_BAR;
    } else {
        PG8_STAGE(PG8_SB(0, 0), cB, voffB); PG8_STAGE(PG8_SA(0, 0), cA, voffA); PG8_STAGE(PG8_SB(0, 1), cB + hstep, voffB); PG8_STAGE(PG8_SA(0, 1), cA + hstep, voffA);
        if (wr == 1) PG8_BAR;
        PG8_WAIT_V(4); PG8_BAR;
        PG8_STAGE(PG8_SB(1, 0), cB + kstep, voffB); PG8_STAGE(PG8_SA(1, 0), cA + kstep, voffA); PG8_STAGE(PG8_SB(1, 1), cB + hstep + kstep, voffB);
        PG8_WAIT_V(6); PG8_BAR;
    }
    for (;;) {
        const bool has_next = S.next(ui + 1, nxt);
        const char* nA = has_next ? (const char*)g.A + (size_t)nxt.z * g.zA + (size_t)nxt.pm * tstep : cA; const char* nB = has_next ? (const char*)g.Bt + (size_t)nxt.z * g.zB + (size_t)nxt.pn * tstepB : cB;
        for (int t = 0; t < nt; t += 2) {
            const bool last = (t == nt - 2);
            const char* a1 = cA + (size_t)(t + 1) * kstep;
            const char* a2 = last ? nA : cA + (size_t)(t + 2) * kstep; const char* b2 = last ? nB : cB + (size_t)(t + 2) * kstep;
            const char* a3 = a2 + kstep; const char* b3 = b2 + kstep;
            if (last && has_next) S.a_ready(nxt);
            if constexpr (SP2) {
            PG8_LDB(B0, 0, 0); if constexpr (!NHALF) PG8_LDB(B1, 0, 1); PG8_SCHED; PG8_LDA(At, 0, 0); PG8_STAGE(PG8_SA(1, 1), a1 + hstep, voffA);
            PG8_WAIT_V(8); PG8_WAIT_L(0); PG8_BAR; PG8_MMA(0, 0, At, B0); if constexpr (!NHALF) PG8_MMA(0, 1, At, B1); PG8_BAR; PG8_SCHED;
            PG8_LDA(At, 0, 1); PG8_STAGE(PG8_SB(0, 0), b2, voffB); PG8_STAGE(PG8_SB(0, 1), b2 + hsB, voffB); PG8_STAGE(PG8_SA(0, 0), a2, voffA);
            PG8_WAIT_V(8); PG8_WAIT_L(0); PG8_BAR; PG8_MMA(1, 0, At, B0); if constexpr (!NHALF) PG8_MMA(1, 1, At, B1); PG8_BAR; PG8_SCHED;
            PG8_LDB(B0, 1, 0); if constexpr (!NHALF) PG8_LDB(B1, 1, 1); PG8_SCHED; PG8_LDA(At, 1, 0); PG8_STAGE(PG8_SA(0, 1), a2 + hstep, voffA);
            PG8_WAIT_V(8); PG8_WAIT_L(0); PG8_BAR; PG8_MMA(0, 0, At, B0); if constexpr (!NHALF) PG8_MMA(0, 1, At, B1); PG8_BAR; PG8_SCHED;
            PG8_LDA(At, 1, 1); PG8_STAGE(PG8_SB(1, 0), b3, voffB); PG8_STAGE(PG8_SB(1, 1), b3 + hsB, voffB); PG8_STAGE(PG8_SA(1, 0), a3, voffA);
            PG8_WAIT_V(8); PG8_WAIT_L(0); PG8_BAR; PG8_MMA(1, 0, At, B0); if constexpr (!NHALF) PG8_MMA(1, 1, At, B1); PG8_BAR; PG8_SCHED;
            } else {
            PG8_LDB(B0, 0, 0); PG8_SCHED; PG8_LDA(At, 0, 0); PG8_STAGE(PG8_SA(1, 1), a1 + hstep, voffA);
            PG8_WAIT_L(8); PG8_BAR; PG8_WAIT_L(0); PG8_MMA(0, 0, At, B0); PG8_BAR; PG8_SCHED;
            PG8_LDB(B1, 0, 1); PG8_STAGE(PG8_SB(0, 0), b2, voffB);
            PG8_BAR; PG8_WAIT_L(0); PG8_MMA(0, 1, At, B1); PG8_BAR;
            PG8_LDA(At, 0, 1); PG8_STAGE(PG8_SA(0, 0), a2, voffA);
            PG8_BAR; PG8_WAIT_L(0); PG8_MMA(1, 0, At, B0); PG8_BAR; PG8_SCHED;
            PG8_STAGE(PG8_SB(0, 1), b2 + hstep, voffB);
            PG8_WAIT_V(6); PG8_BAR; PG8_MMA(1, 1, At, B1); PG8_BAR;
            PG8_LDB(B0, 1, 0); PG8_SCHED; PG8_LDA(At, 1, 0); PG8_STAGE(PG8_SA(0, 1), a2 + hstep, voffA);
            PG8_WAIT_L(8); PG8_BAR; PG8_WAIT_L(0); PG8_MMA(0, 0, At, B0); PG8_BAR; PG8_SCHED;
            PG8_LDB(B1, 1, 1); PG8_STAGE(PG8_SB(1, 0), b3, voffB);
            PG8_BAR; PG8_WAIT_L(0); PG8_MMA(0, 1, At, B1); PG8_BAR;
            PG8_LDA(At, 1, 1); PG8_STAGE(PG8_SA(1, 0), a3, voffA);
            PG8_BAR; PG8_WAIT_L(0); PG8_MMA(1, 0, At, B0); PG8_BAR; PG8_SCHED;
            PG8_STAGE(PG8_SB(1, 1), b3 + hstep, voffB);
            PG8_WAIT_V(6); PG8_BAR; PG8_MMA(1, 1, At, B1); PG8_BAR;
            }
        }
        if constexpr (ALIGN_EPI) { if (wr == 0) PG8_BAR; }
        if constexpr (!Epi::AFTER_DRAIN) { E(acc, cur, wr, wc, fr, fq); S.done(cur); }
        if (!has_next) break;
#pragma unroll
        for (int a = 0; a < 2; ++a)
#pragma unroll
            for (int b = 0; b < 2; ++b)
#pragma unroll
                for (int m = 0; m < 4; ++m)
#pragma unroll
                    for (int n = 0; n < 2; ++n) acc[a][b][m][n] = (f32x4){0.f, 0.f, 0.f, 0.f};
        cur = nxt; cA = nA; cB = nB; ++ui;
        if constexpr (ALIGN_EPI) { if (wr == 1) PG8_BAR; }
    }
    PG8_WAIT_V(0);
    if constexpr (!ALIGN_EPI) { if (wr == 0) PG8_BAR; }
    PG8_BAR;
    if constexpr (Epi::AFTER_DRAIN) { E.fused(acc, cur, wr, wc, fr, fq, lds, wid, lane); S.done(cur); }
#undef PG8_SA
#undef PG8_SB
#undef PG8_STAGE
#undef PG8_LDA
#undef PG8_LDB
#undef PG8_MMA
#undef PG8_WAIT_V
#undef PG8_WAIT_L
#undef PG8_BAR
#undef PG8_SCHED
}
}

namespace att {
using bf16 = __hip_bfloat16;
constexpr int   D = 128, NW = 8, QBLK = 32, KVBLK = 64;
constexpr float SCALE = 0.088388347648318440f;
constexpr float THR = 8.f;
#ifndef ATT_SDEPTH
#define ATT_SDEPTH 1
#endif
constexpr int SDEPTH = ATT_SDEPTH;
constexpr int LDQ = NP, LDK = NP, LDO = DM;
constexpr size_t SHM_V = KVBLK * D * 2, SHM_K = KVBLK * D * 2, SHM_ATTN = 2 * SHM_V + 2 * SHM_K + NW * 64 * 4;
constexpr int OST_OFF = 69632, OST_END = OST_OFF + NW * 32 * 272;
using bf16x8 = __attribute__((ext_vector_type(8))) short;
using s16x4  = __attribute__((ext_vector_type(4))) short;
using f32x16 = __attribute__((ext_vector_type(16))) float;
using f32x4  = __attribute__((ext_vector_type(4))) float;
using u32x4  = __attribute__((ext_vector_type(4))) unsigned;
#define KSWZ(row, colB) ((row) * 256 + ((colB) ^ (((row) & 7) << 4)))
#define SBAR() __builtin_amdgcn_sched_barrier(0)
__device__ __forceinline__ int crow(int r, int hi) { return (r & 3) + 8 * (r >> 2) + 4 * hi; }
__device__ __forceinline__ unsigned cvtpk(float lo, float hi) { unsigned r; asm volatile("v_cvt_pk_bf16_f32 %0, %1, %2" : "=v"(r) : "v"(lo), "v"(hi)); return r; }
__device__ __forceinline__ bf16x8 ld8(const bf16* p) { return *reinterpret_cast<const bf16x8*>(p); }

__device__ __forceinline__ void partialSM(f32x16& p0, f32x16& p1, float& m_reg, float& mn, float& alpha) {
  constexpr float C = SCALE * 1.4426950408889634f;
  float pmax = p0[0];
#pragma unroll
  for (int r = 1; r < 16; ++r) pmax = fmaxf(pmax, p0[r]);
#pragma unroll
  for (int r = 0; r < 16; ++r) pmax = fmaxf(pmax, p1[r]);
  { auto rr = __builtin_amdgcn_permlane32_swap(__float_as_uint(pmax), __float_as_uint(pmax), false, false);
    pmax = fmaxf(__uint_as_float(rr[0]), __uint_as_float(rr[1])); }
  if (__builtin_expect(__all(pmax - m_reg <= THR / SCALE), 1)) { mn = m_reg; alpha = 1.f; }
  else { mn = fmaxf(m_reg, pmax); alpha = __builtin_amdgcn_exp2f((m_reg - mn) * C); m_reg = mn; }
  float mnC = -mn * C;
#pragma unroll
  for (int r = 0; r < 16; ++r) p0[r] = fmaf(p0[r], C, mnC);
#pragma unroll
  for (int r = 0; r < 16; ++r) p1[r] = fmaf(p1[r], C, mnC);
#pragma unroll
  for (int r = 0; r < 16; ++r) p0[r] = __builtin_amdgcn_exp2f(p0[r]);
}
__device__ __forceinline__ void finishSM(f32x16& p0, f32x16& p1, float alpha, float& l_reg, bf16x8& pa0, bf16x8& pa1, bf16x8& pa2, bf16x8& pa3) {
#pragma unroll
  for (int r = 0; r < 16; ++r) p1[r] = __builtin_amdgcn_exp2f(p1[r]);
  float ps = 0;
#pragma unroll
  for (int r = 0; r < 16; ++r) ps += p0[r];
#pragma unroll
  for (int r = 0; r < 16; ++r) ps += p1[r];
  { auto rr = __builtin_amdgcn_permlane32_swap(__float_as_uint(ps), __float_as_uint(ps), false, false);
    ps = __uint_as_float(rr[0]) + __uint_as_float(rr[1]); }
  l_reg = l_reg * alpha + ps;
#define PK4(P, BASE, OUT) do { unsigned a0 = cvtpk(P[BASE + 0], P[BASE + 1]), a1 = cvtpk(P[BASE + 2], P[BASE + 3]);   \
    unsigned b0 = cvtpk(P[BASE + 4], P[BASE + 5]), b1 = cvtpk(P[BASE + 6], P[BASE + 7]);                              \
    auto r0 = __builtin_amdgcn_permlane32_swap(a0, b0, false, false); auto r1 = __builtin_amdgcn_permlane32_swap(a1, b1, false, false); \
    u32x4 w = {r0[0], r1[0], r0[1], r1[1]}; OUT = *reinterpret_cast<bf16x8*>(&w); } while (0)
  PK4(p0, 0, pa0); PK4(p0, 8, pa1); PK4(p1, 0, pa2); PK4(p1, 8, pa3);
#undef PK4
}
__device__ __forceinline__ void qkt(f32x16& p0, f32x16& p1, const bf16* Ks, const bf16x8* qr, int r32, int hi) {
  p0 = f32x16{}; p1 = f32x16{};
#pragma unroll
  for (int d0 = 0; d0 < 8; ++d0) { int cb = (d0 * 16 + hi * 8) * 2;
    bf16x8 b0 = *reinterpret_cast<const bf16x8*>((const char*)Ks + KSWZ(r32, cb));
    bf16x8 b1 = *reinterpret_cast<const bf16x8*>((const char*)Ks + KSWZ(32 + r32, cb));
    p0 = __builtin_amdgcn_mfma_f32_32x32x16_bf16(b0, qr[d0], p0, 0, 0, 0);
    p1 = __builtin_amdgcn_mfma_f32_32x32x16_bf16(b1, qr[d0], p1, 0, 0, 0); }
}
__device__ __forceinline__ int v_st(int k, int c) { const int kk = (k & ~0xC) | ((k & 4) << 1) | ((k & 8) >> 1); return ((kk >> 3) * 4 + (c >> 5)) * 512 + ((kk & 7) * 32 + (c & 31)) * 2; }
__device__ __forceinline__ int v_rd_base(int lane) { return ((lane & 3) << 3) | (((lane >> 2) & 3) << 6) | (((lane >> 4) & 1) << 5) | (((lane >> 5) & 1) << 8); }
constexpr int v_rd_off(int d0, int ks, int half) { return d0 * 512 + ks * 4096 + half * 2048; }
template <int OFF> __device__ __forceinline__ s16x4 tr_read(int vb) {
  s16x4 r; asm volatile("ds_read_b64_tr_b16 %0, %1 offset:%2" : "=&v"(r) : "v"(vb), "i"(OFF) : "memory"); return r;
}
template <int D0> __device__ __forceinline__ void pv_one(f32x16& od, int vb, bf16x8 pa0, bf16x8 pa1, bf16x8 pa2, bf16x8 pa3) {
  const s16x4 l0 = tr_read<v_rd_off(D0, 0, 0)>(vb), h0 = tr_read<v_rd_off(D0, 0, 1)>(vb), l1 = tr_read<v_rd_off(D0, 1, 0)>(vb), h1 = tr_read<v_rd_off(D0, 1, 1)>(vb);
  const s16x4 l2 = tr_read<v_rd_off(D0, 2, 0)>(vb), h2 = tr_read<v_rd_off(D0, 2, 1)>(vb), l3 = tr_read<v_rd_off(D0, 3, 0)>(vb), h3 = tr_read<v_rd_off(D0, 3, 1)>(vb);
  asm volatile("s_waitcnt lgkmcnt(0)" ::: "memory"); SBAR();
#define PK(L, H) (bf16x8){L[0], L[1], L[2], L[3], H[0], H[1], H[2], H[3]}
  od = __builtin_amdgcn_mfma_f32_32x32x16_bf16(pa0, PK(l0, h0), od, 0, 0, 0);
  od = __builtin_amdgcn_mfma_f32_32x32x16_bf16(pa1, PK(l1, h1), od, 0, 0, 0);
  od = __builtin_amdgcn_mfma_f32_32x32x16_bf16(pa2, PK(l2, h2), od, 0, 0, 0);
  od = __builtin_amdgcn_mfma_f32_32x32x16_bf16(pa3, PK(l3, h3), od, 0, 0, 0);
#undef PK
}
__device__ __forceinline__ void pv_d0(f32x16* o, int vb, bf16x8 pa0, bf16x8 pa1, bf16x8 pa2, bf16x8 pa3) {
  pv_one<0>(o[0], vb, pa0, pa1, pa2, pa3); pv_one<1>(o[1], vb, pa0, pa1, pa2, pa3); pv_one<2>(o[2], vb, pa0, pa1, pa2, pa3); pv_one<3>(o[3], vb, pa0, pa1, pa2, pa3);
}

__device__ __forceinline__ void attn_unit(const bf16* __restrict__ Qb, const bf16* __restrict__ Kh, const bf16* __restrict__ Vh, const bf16* __restrict__ Zb,
                                          bf16* __restrict__ Ob, int seq, char* lds, const float* __restrict__ qn, const float* __restrict__ cs, const float* __restrict__ sn) {
  int tid = threadIdx.x; asm volatile("" : "+v"(tid));
  int wid = tid >> 6, lane = tid & 63, r32 = lane & 31, hi = lane >> 5;
  bf16* V_lds = (bf16*)lds; bf16* K_lds = (bf16*)(lds + 2 * SHM_V);
  float* ws = (float*)(lds + 2 * SHM_V + 2 * SHM_K) + wid * 64; float* li_l = ws; float* al_l = ws + 32;
  float m_reg = -1e30f, l_reg = 0; f32x16 o[4] = {}; bf16x8 qr[8];
  {
    const bf16* Qw = Qb + (long)(wid * QBLK + r32) * LDQ + hi * 8;
    float ss = 0.f;
#pragma unroll
    for (int d0 = 0; d0 < 8; ++d0) { const u32x4 w = *reinterpret_cast<const u32x4*>(Qw + d0 * 16); qr[d0] = __builtin_bit_cast(bf16x8, w);
#pragma unroll
      for (int e = 0; e < 4; ++e) { const float lo = __uint_as_float(w[e] << 16), hh = __uint_as_float(w[e] & 0xffff0000u); ss += lo * lo + hh * hh; } }
    { auto rr = __builtin_amdgcn_permlane32_swap(__float_as_uint(ss), __float_as_uint(ss), false, false); ss = __uint_as_float(rr[0]) + __uint_as_float(rr[1]); }
    const float rs = rsqrtf(ss * (1.f / 128.f) + EPS);
    const float* cp = cs ? cs + (long)(wid * QBLK + r32) * 64 + hi * 8 : nullptr; const float* sp = cs ? sn + (long)(wid * QBLK + r32) * 64 + hi * 8 : nullptr;
#pragma unroll
    for (int d0 = 0; d0 < 4; ++d0) {
      const u32x4 wa = __builtin_bit_cast(u32x4, qr[d0]), wb = __builtin_bit_cast(u32x4, qr[d0 + 4]); float x1[8], x2[8];
#pragma unroll
      for (int e = 0; e < 4; ++e) { x1[2 * e] = __uint_as_float(wa[e] << 16); x1[2 * e + 1] = __uint_as_float(wa[e] & 0xffff0000u); x2[2 * e] = __uint_as_float(wb[e] << 16); x2[2 * e + 1] = __uint_as_float(wb[e] & 0xffff0000u); }
      const f32x4 ga0 = *reinterpret_cast<const f32x4*>(qn + d0 * 16 + hi * 8), ga1 = *reinterpret_cast<const f32x4*>(qn + d0 * 16 + hi * 8 + 4);
      const f32x4 gb0 = *reinterpret_cast<const f32x4*>(qn + 64 + d0 * 16 + hi * 8), gb1 = *reinterpret_cast<const f32x4*>(qn + 64 + d0 * 16 + hi * 8 + 4);
#pragma unroll
      for (int e = 0; e < 8; ++e) { x1[e] *= rs * (e < 4 ? ga0[e & 3] : ga1[e & 3]); x2[e] *= rs * (e < 4 ? gb0[e & 3] : gb1[e & 3]); }
      if (cs) {
        const f32x4 c0 = *reinterpret_cast<const f32x4*>(cp + d0 * 16), c1 = *reinterpret_cast<const f32x4*>(cp + d0 * 16 + 4);
        const f32x4 s0 = *reinterpret_cast<const f32x4*>(sp + d0 * 16), s1 = *reinterpret_cast<const f32x4*>(sp + d0 * 16 + 4);
#pragma unroll
        for (int e = 0; e < 8; ++e) { const float c = e < 4 ? c0[e & 3] : c1[e & 3], sv = e < 4 ? s0[e & 3] : s1[e & 3];
          const float a = x1[e], bq = x2[e]; x1[e] = a * c - bq * sv; x2[e] = bq * c + a * sv; }
      }
      const u32x4 oa = {cvtpk(x1[0], x1[1]), cvtpk(x1[2], x1[3]), cvtpk(x1[4], x1[5]), cvtpk(x1[6], x1[7])}, ob = {cvtpk(x2[0], x2[1]), cvtpk(x2[2], x2[3]), cvtpk(x2[4], x2[5]), cvtpk(x2[6], x2[7])};
      qr[d0] = __builtin_bit_cast(bf16x8, oa); qr[d0 + 4] = __builtin_bit_cast(bf16x8, ob);
      asm volatile("" ::: "memory");
    }
  }
  const int sr = tid >> 4, sc = (tid & 15) * 8, vst0 = v_st(sr, sc), vst1 = v_st(32 + sr, sc);
  const int vb0 = (int)(uintptr_t)V_lds + v_rd_base(lane);
  struct { bf16x8 vs0, vs1, ks0, ks1; } sr_[SDEPTH];
#define SLOAD(i, k0) do { sr_[i].vs0 = ld8(&Vh[(long)((k0) + sr) * LDK + sc]); sr_[i].vs1 = ld8(&Vh[(long)((k0) + 32 + sr) * LDK + sc]); \
    sr_[i].ks0 = ld8(&Kh[(long)((k0) + sr) * LDK + sc]); sr_[i].ks1 = ld8(&Kh[(long)((k0) + 32 + sr) * LDK + sc]); } while (0)
#define SWRITE(b, i) do { *(bf16x8*)((char*)V_lds + (b) * SHM_V + vst0) = sr_[i].vs0;          \
    *(bf16x8*)((char*)V_lds + (b) * SHM_V + vst1) = sr_[i].vs1; int kc = sc * 2;               \
    *(bf16x8*)((char*)K_lds + (b) * SHM_K + KSWZ(sr, kc)) = sr_[i].ks0;                       \
    *(bf16x8*)((char*)K_lds + (b) * SHM_K + KSWZ(32 + sr, kc)) = sr_[i].ks1; } while (0)
#define SWAIT() do { if constexpr (SDEPTH == 2) asm volatile("s_waitcnt vmcnt(4)" ::: "memory"); else asm volatile("s_waitcnt vmcnt(0)" ::: "memory"); } while (0)
#define RESC(a) do { if (__any((a) < 1.f)) { if (hi == 0) al_l[r32] = (a); asm volatile("s_waitcnt lgkmcnt(0)" ::: "memory"); \
    _Pragma("unroll") for (int d = 0; d < 4; ++d) _Pragma("unroll") for (int r = 0; r < 16; ++r) o[d][r] *= al_l[crow(r, hi)]; } } while (0)
  f32x16 pA0, pA1, pB0, pB1; float mnA, mnB, alA, alB; bf16x8 pa0, pa1, pa2, pa3; const int NT = seq / KVBLK;
  constexpr int SE = 0, SO = SDEPTH - 1;
  SLOAD(SE, 0); asm volatile("s_waitcnt vmcnt(0)" ::: "memory"); SWRITE(0, SE); __syncthreads();
  qkt(pA0, pA1, K_lds, qr, r32, hi); partialSM(pA0, pA1, m_reg, mnA, alA);
  SLOAD(SO, KVBLK); if constexpr (SDEPTH == 2) { if (2 < NT) SLOAD(SE, 2 * KVBLK); }
  SWAIT(); SWRITE(1, SO); __syncthreads();
  for (int j = 1; j + 1 < NT; j += 2) {
    SBAR(); qkt(pB0, pB1, (bf16*)((char*)K_lds + SHM_K), qr, r32, hi);
    finishSM(pA0, pA1, alA, l_reg, pa0, pa1, pa2, pa3); SBAR();
    SLOAD(SO, (j + SDEPTH) * KVBLK); SBAR();
    pv_d0(o, vb0, pa0, pa1, pa2, pa3); partialSM(pB0, pB1, m_reg, mnB, alB);
    __syncthreads(); SWAIT(); SWRITE(0, SE);
    RESC(alB); __syncthreads();
    SBAR(); qkt(pA0, pA1, K_lds, qr, r32, hi);
    finishSM(pB0, pB1, alB, l_reg, pa0, pa1, pa2, pa3); SBAR();
    if (SDEPTH == 1 || j + 3 < NT) SLOAD(SE, (j + 1 + SDEPTH) * KVBLK); SBAR();
    pv_d0(o, vb0 + (int)SHM_V, pa0, pa1, pa2, pa3); partialSM(pA0, pA1, m_reg, mnA, alA);
    __syncthreads(); SWAIT(); SWRITE(1, SO);
    RESC(alA); __syncthreads();
  }
  SBAR(); qkt(pB0, pB1, (bf16*)((char*)K_lds + SHM_K), qr, r32, hi);
  finishSM(pA0, pA1, alA, l_reg, pa0, pa1, pa2, pa3); SBAR();
  pv_d0(o, vb0, pa0, pa1, pa2, pa3); partialSM(pB0, pB1, m_reg, mnB, alB);
  __syncthreads(); RESC(alB);
  finishSM(pB0, pB1, alB, l_reg, pa0, pa1, pa2, pa3); SBAR();
  pv_d0(o, vb0 + (int)SHM_V, pa0, pa1, pa2, pa3);
  if (hi == 0) li_l[r32] = l_reg; asm volatile("s_waitcnt lgkmcnt(0)" ::: "memory");
  { int tz = threadIdx.x; asm volatile("" : "+v"(tz)); wid = tz >> 6; lane = tz & 63; r32 = lane & 31; hi = lane >> 5; }
  float rli[16];
#pragma unroll
  for (int r = 0; r < 16; ++r) rli[r] = __builtin_amdgcn_rcpf(li_l[crow(r, hi)]);
  char* ost = lds + OST_OFF + wid * (32 * 272);
#pragma unroll
  for (int r = 0; r < 16; ++r) { const int orow = crow(r, hi);
#pragma unroll
    for (int d0 = 0; d0 < 4; ++d0) *(bf16*)(ost + orow * 272 + (d0 * 32 + r32) * 2) = __float2bfloat16(o[d0][r] * rli[r]); }
  asm volatile("s_waitcnt lgkmcnt(0)" ::: "memory");
  bf16* Ow = Ob + (long)(wid * QBLK) * LDO; const bf16* Zw = Zb + (long)(wid * QBLK) * LDQ;
#pragma unroll
  for (int hb = 0; hb < 2; ++hb) {
    u32x4 ov[4], zv[4];
#pragma unroll
    for (int i = 0; i < 4; ++i) { const int c = (hb * 4 + i) * 64 + lane, row = c >> 4, col = (c & 15) * 8;
      ov[i] = *reinterpret_cast<const u32x4*>(ost + row * 272 + col * 2); zv[i] = *reinterpret_cast<const u32x4*>(Zw + (long)row * LDQ + col); }
#pragma unroll
    for (int i = 0; i < 4; ++i) { const int c = (hb * 4 + i) * 64 + lane, row = c >> 4, col = (c & 15) * 8; u32x4 w;
#pragma unroll
      for (int e = 0; e < 4; ++e) { const unsigned a = ov[i][e], z = zv[i][e];
        w[e] = cvtpk(__uint_as_float(a << 16) * __uint_as_float(z << 16), __uint_as_float(a & 0xffff0000u) * __uint_as_float(z & 0xffff0000u)); }
      *reinterpret_cast<u32x4*>(Ow + (long)row * LDO + col) = w; }
  }
  __syncthreads();
#undef SLOAD
#undef SWRITE
#undef SWAIT
#undef RESC
}
}

constexpr int NWAVES = 8;
#ifndef MK_N_LAUNCHES
#define MK_N_LAUNCHES 1
#endif
constexpr int PH_PER_LAYER = 7, N_PHASES = 2 + DEPTH * PH_PER_LAYER;
constexpr size_t MiB = 1u << 20;
constexpr size_t WS_CTL = 0, CTL_ZERO_BYTES = 1 * MiB;
constexpr size_t WS_MOD = 1 * MiB;
constexpr size_t WS_ROPE = WS_MOD + MiB / 2;
constexpr size_t WS_WG = 3 * MiB;
constexpr size_t WS_WLRU = 4 * MiB;
constexpr size_t WS_WOUT = 12 * MiB;
constexpr size_t WS_WBR = 44 * MiB;
constexpr size_t WS_WIN = 140 * MiB;
constexpr size_t WS_X = 540 * MiB;
constexpr size_t WS_Y = 612 * MiB;
constexpr size_t WS_H = 684 * MiB;
constexpr size_t WS_G2 = 720 * MiB;
constexpr size_t WS_YB = 756 * MiB;
constexpr size_t WS_ACC = 864 * MiB;
constexpr size_t WS_GT = 936 * MiB;
constexpr size_t WS_MH = 938 * MiB;
constexpr size_t WS_P = 1082 * MiB;
constexpr size_t WS_LA = 1532 * MiB;
constexpr size_t WS_LB = 1676 * MiB;
constexpr size_t WS_HL = 1820 * MiB;
constexpr size_t WS_GSC = 1964 * MiB;
constexpr size_t WS_END = 1968 * MiB;
constexpr int CW_BAR = 4096;
constexpr int RING_BYTES = 131072, LDS_BYTES = 147456, MISC_OFF = LDS_BYTES - 256;
static_assert(att::OST_END <= MISC_OFF, "LDS map");

#define GAS __attribute__((address_space(1)))
#define LAS __attribute__((address_space(3)))
typedef unsigned short bf16_t;
typedef unsigned v4u __attribute__((ext_vector_type(4)));
typedef unsigned v2u __attribute__((ext_vector_type(2)));
typedef float f32x4 __attribute__((ext_vector_type(4)));
#define LDS_WAIT() asm volatile("s_waitcnt lgkmcnt(0)" ::: "memory")
__device__ __forceinline__ unsigned f2bf(float f) { unsigned u = __builtin_bit_cast(unsigned, f); return (u + 0x7fffu + ((u >> 16) & 1u)) >> 16; }
__device__ __forceinline__ unsigned pk2(float lo, float hi) { unsigned r; asm("v_cvt_pk_bf16_f32 %0, %1, %2" : "=v"(r) : "v"(lo), "v"(hi)); return r; }
__device__ __forceinline__ float bf2f(bf16_t b) { return __uint_as_float((unsigned)b << 16); }
__device__ __forceinline__ float blo(unsigned w) { return __uint_as_float(w << 16); }
__device__ __forceinline__ float bhi(unsigned w) { return __uint_as_float(w & 0xffff0000u); }
__device__ __forceinline__ float lane_get(float v, int src) { return __builtin_bit_cast(float, __builtin_amdgcn_ds_bpermute(src << 2, __builtin_bit_cast(int, v))); }
__device__ __forceinline__ float lane_xor(float v, int mask, int lane) { return lane_get(v, lane ^ mask); }
__device__ __forceinline__ float lane_up(float v, int delta, int lane) { return lane_get(v, lane >= delta ? lane - delta : lane); }
__device__ __forceinline__ float wave_sum(float v, int lane) {
#pragma unroll
    for (int o = 1; o < 64; o <<= 1) v += lane_xor(v, o, lane);
    return v;
}
#define XB_TMO      128
#define XB_XCNT(j)  (256  + 64 * (j))
#define XB_XSUB(j)  (1280 + 64 * (j))
#define XB_XGEN(j)  (2304 + 64 * (j))
#define XB_TOP      3328
#define XB_TOPGEN   3392
#define XCD_BAR_WORDS 3456
#define XB_SPIN_CAP (1u << 18)

__device__ __forceinline__ unsigned xb_ld(unsigned* p)              { return __hip_atomic_load(p, __ATOMIC_RELAXED, __HIP_MEMORY_SCOPE_AGENT); }
__device__ __forceinline__ unsigned xb_add(unsigned* p, unsigned v) { return __hip_atomic_fetch_add(p, v, __ATOMIC_RELAXED, __HIP_MEMORY_SCOPE_AGENT); }
__device__ __forceinline__ unsigned xb_xcc_id() { return (unsigned)__builtin_amdgcn_s_getreg((3 << 11) | 20) & 0xFu; }
#define XB_SPIN(cond, bar) do { unsigned _sp = 0; while (cond) { __builtin_amdgcn_s_sleep(1); \
    if ((++_sp & 255u) == 0u) { if (xb_ld(&(bar)[XB_TMO])) break; if (_sp > XB_SPIN_CAP) { atomicAdd(&(bar)[XB_TMO], 1u); break; } } } } while (0)

struct XcdBarrier {
    unsigned* bar; unsigned x;
    volatile LAS unsigned* st;
};

__device__ __forceinline__ XcdBarrier xcd_barrier_post(unsigned* bar, volatile LAS unsigned* st) {
    XcdBarrier b; b.bar = bar; b.x = xb_xcc_id(); b.st = st;
    if (threadIdx.x == 0) (void)xb_add(&bar[XB_XCNT(b.x)], 1u);
    return b;
}
__device__ __forceinline__ void xcd_barrier_complete(unsigned* bar, unsigned x, unsigned& nloc, unsigned& nx) {
    const unsigned G = gridDim.x * gridDim.y * gridDim.z;
    unsigned sum, cnt, mine, sp = 0u;
    for (;;) {
        sum = 0u; cnt = 0u; mine = 0u;
#pragma unroll
        for (unsigned j = 0; j < 16; ++j) { const unsigned c = xb_ld(&bar[XB_XCNT(j)]); sum += c; cnt += (c > 0u) ? 1u : 0u; mine = (j == x) ? c : mine; }
        if (sum == G) break;
        __builtin_amdgcn_s_sleep(1);
        if ((++sp & 255u) == 0u) { if (xb_ld(&bar[XB_TMO])) break; if (sp > XB_SPIN_CAP) { atomicAdd(&bar[XB_TMO], 1u); break; } }
    }
    nloc = mine > 0u ? mine : 1u; nx = cnt > 0u ? cnt : 1u;
}

__device__ __forceinline__ void xcd_barrier(const XcdBarrier& b) {
    asm volatile("s_waitcnt vmcnt(0)" ::: "memory");
    __syncthreads();
    if (threadIdx.x == 0) {
        unsigned* bar = b.bar;
        __builtin_amdgcn_s_waitcnt(0);
        unsigned nloc = b.st[0], nx = b.st[1];
        if (nloc == 0u) { xcd_barrier_complete(bar, b.x, nloc, nx); b.st[0] = nloc; b.st[1] = nx; }
        const unsigned old = xb_add(&bar[XB_XSUB(b.x)], 1u);
        const unsigned gen = old / nloc;
        if (old + 1u == (gen + 1u) * nloc) {
            __builtin_amdgcn_fence(__ATOMIC_RELEASE, "agent");
            asm volatile("s_waitcnt vmcnt(0)" ::: "memory");
            const unsigned og = xb_add(&bar[XB_TOP], 1u);
            const unsigned tg = og / nx;
            if (og + 1u == (tg + 1u) * nx) xb_add(&bar[XB_TOPGEN], 1u);
            else XB_SPIN(xb_ld(&bar[XB_TOPGEN]) == tg, bar);
            __builtin_amdgcn_fence(__ATOMIC_ACQUIRE, "agent");
            xb_add(&bar[XB_XGEN(b.x)], 1u);
            asm volatile("s_waitcnt vmcnt(0)" ::: "memory");
        } else {
            XB_SPIN(xb_ld(&bar[XB_XGEN(b.x)]) == gen, bar);
            __builtin_amdgcn_fence(__ATOMIC_ACQUIRE, "agent");
            asm volatile("s_waitcnt vmcnt(0)" ::: "memory");
        }
    }
    __syncthreads();
}

struct Args { const float* in[22]; float* out; unsigned char* ws; int ph_lo, ph_hi; };
typedef const __attribute__((address_space(4))) Args CArgs;
#define KIN(k) ((const float*)ka->in[k])
#define WSF(off) ((float*)(ka->ws + (off)))
#define WSB(off) ((bf16_t*)(ka->ws + (off)))
#define KA() ({ CArgs* _k = ka0; asm volatile("" : "+s"(_k)); _k; })
__device__ __forceinline__ int tid_fresh() { int t = threadIdx.x; asm volatile("" : "+v"(t)); return t; }
struct Frame {
    LAS unsigned char* lds; char* ldsg;
    int tid, lane, wave, G, wg;
};

__device__ __forceinline__ void transpose_item(const float* W, int ldw, int col0, int k0, bf16_t* WT, int ldt, int drow0, LAS float* scr, int lane) {
#pragma unroll 8
    for (int i = 0; i < 32; ++i) { const int kk = 2 * i + (lane >> 5); scr[kk * 33 + (lane & 31)] = __builtin_nontemporal_load(W + (size_t)(k0 + kk) * ldw + col0 + (lane & 31)); }
    LDS_WAIT(); asm volatile("" ::: "memory");
    const int c = lane & 7;
#pragma unroll
    for (int j = 0; j < 4; ++j) { const int n = (lane >> 3) + 8 * j; const LAS float* s = scr + (8 * c) * 33 + n;
        v4u o; o.x = pk2(s[0 * 33], s[1 * 33]); o.y = pk2(s[2 * 33], s[3 * 33]); o.z = pk2(s[4 * 33], s[5 * 33]); o.w = pk2(s[6 * 33], s[7 * 33]);
        __builtin_nontemporal_store(o, (v4u*)(WT + (size_t)(drow0 + n) * ldt + k0 + 8 * c)); }
    LDS_WAIT(); asm volatile("" ::: "memory");
}
__device__ __forceinline__ void p_convert(Frame& F, CArgs* ka, int l, int wv, int nwv, int it0 = 0, int it1 = 1 << 30) {
    const int tid = tid_fresh(), lane = tid & 63, wave = __builtin_amdgcn_readfirstlane(tid >> 6);
    LAS float* scr = (LAS float*)(F.lds + wave * 8704);
    constexpr int I_IN = 32 * 800, I_G = 32, I_BR = 3 * 2048, I_OUT = 2048, I_LRU = 2 * 2 * 16 * 8, I_LAYER = I_IN + I_G + I_BR + I_OUT + I_LRU;
    if (it1 > I_LAYER) it1 = I_LAYER;
    for (int it = it0 + wv; it < it1; it += nwv) {
        int r = it;
        if (r < I_IN) { const int kb = r / 800, nb = r - kb * 800, n0 = nb * 32, sc = n0 < 14336 ? n0 : n0 + 32;
            transpose_item(KIN(8) + (size_t)l * DM * NIN, NIN, sc, kb * 64, WSB(WS_WIN) + (size_t)l * NP * DM, DM, n0, scr, lane); continue; }
        r -= I_IN;
        if (r < I_G) { transpose_item(KIN(8) + (size_t)l * DM * NIN, NIN, 14336, r * 64, WSB(WS_WG) + (size_t)l * 32 * DM, DM, 0, scr, lane); continue; }
        r -= I_G;
        if (r < I_BR) { const int z = r / 2048, q = r - z * 2048, kb = q / 64, nb = q - kb * 64;
            transpose_item(KIN(20) + ((size_t)l * 3 + z) * DM * DM, DM, nb * 32, kb * 64, WSB(WS_WBR) + ((size_t)l * 3 + z) * DM * DM, DM, nb * 32, scr, lane); continue; }
        r -= I_BR;
        if (r < I_OUT) { const int kb = r / 64, nb = r - kb * 64;
            transpose_item(KIN(21) + (size_t)l * DM * DM, DM, nb * 32, kb * 64, WSB(WS_WOUT) + (size_t)l * DM * DM, DM, nb * 32, scr, lane); continue; }
        r -= I_OUT;
        { const int q = r & 7, mt = r >> 3, blk = mt & 15, gate = (mt >> 4) & 1, dr = mt >> 5, kb = q >> 2, nb = q & 3;
          const float* src = (gate ? KIN(13) : KIN(11)) + (((size_t)l * 2 + dr) * 16 + blk) * 16384;
          transpose_item(src, 128, nb * 32, kb * 64, WSB(WS_WLRU) + ((((size_t)l * 2 + dr) * 2 + gate) * 16 + blk) * 16384, 128, nb * 32, scr, lane); }
    }
}
__device__ __forceinline__ void p_prologue(Frame& F, CArgs* ka) {
    const int tid = tid_fresh(), lane = tid & 63, wave = __builtin_amdgcn_readfirstlane(tid >> 6); (void)lane; (void)wave;
    for (int i = F.wg * 512 + tid; i < SEQ * 64; i += F.G * 512) { const int t = i >> 6, j = i & 63;
        const float inv = 1.0f / powf(10000.0f, (float)(j & 31) * (1.0f / 32.0f)); const float pos = (float)(j < 32 ? (t >> 6) : (t & 63)); const float ang = pos * inv;
        WSF(WS_ROPE)[i] = cosf(ang); WSF(WS_ROPE)[SEQ * 64 + i] = sinf(ang); }
    __syncthreads();
    LAS float* sc = (LAS float*)(F.lds + 73728);
    LAS float* red = (LAS float*)(F.lds + 73728 + 5 * 2048 * 4);
    for (int i = tid; i < 5 * DM; i += 512) { const int bi = i >> 11, k = i & 2047; const float v = bi < 4 ? KIN(1)[bi * DM + k] : KIN(3)[k]; sc[i] = v / (1.f + expf(-v)); }
    __syncthreads();
    for (int it = F.wg; it < DEPTH * 192; it += F.G) { const int l = it / 192, j0 = (it - l * 192) * 32, cj = tid & 31, ks = tid >> 5;
        float a0 = 0.f, a1 = 0.f, a2 = 0.f, a3 = 0.f, a4 = 0.f; const float* w = KIN(4) + (size_t)l * DM * 3 * DM + j0 + cj;
        for (int k = ks * 128; k < ks * 128 + 128; ++k) { const float wv = w[(size_t)k * (3 * DM)]; a0 += sc[k] * wv; a1 += sc[2048 + k] * wv; a2 += sc[4096 + k] * wv; a3 += sc[6144 + k] * wv; a4 += sc[8192 + k] * wv; }
        red[(ks * 5 + 0) * 32 + cj] = a0; red[(ks * 5 + 1) * 32 + cj] = a1; red[(ks * 5 + 2) * 32 + cj] = a2; red[(ks * 5 + 3) * 32 + cj] = a3; red[(ks * 5 + 4) * 32 + cj] = a4;
        __syncthreads();
        if (tid < 160) { const int bi = tid >> 5, c = tid & 31; float s = KIN(5)[(size_t)l * 3 * DM + j0 + c];
            for (int q = 0; q < 16; ++q) s += red[(q * 5 + bi) * 32 + c];
            WSF(WS_MOD)[((size_t)l * 5 + bi) * (3 * DM) + j0 + c] = s; }
        __syncthreads();
    }
}

__device__ __forceinline__ void p_norm(Frame& F, CArgs* ka, int l, bool dry = false) {
    const int tid = tid_fresh(), lane = tid & 63, wave = __builtin_amdgcn_readfirstlane(tid >> 6); (void)lane; (void)wave;
    const int gw = F.wg * NWAVES + wave, NGW = F.G * NWAVES;
    for (int r = gw; r < MROWS; r += NGW) {
        const int b = r / TPB, t = r - b * TPB; const bool isctx = t >= SEQ; const int bi = isctx ? 4 : b;
        if (l == DEPTH && isctx) continue;
        f32x4 v[8];
        if (l == 0) { const float* src = isctx ? KIN(2) + ((size_t)b * CTXL + (t - SEQ)) * DM : KIN(0) + ((size_t)b * SEQ + t) * DM;
#pragma unroll
            for (int j = 0; j < 8; ++j) v[j] = *(const f32x4*)(src + j * 256 + lane * 4);
        } else {
            const float* yr = WSF(WS_Y) + (size_t)r * DM; const float* xr = WSF(WS_X) + (size_t)r * DM; f32x4 y[8]; float ss = 0.f;
#pragma unroll
            for (int j = 0; j < 8; ++j) { y[j] = *(const f32x4*)(yr + j * 256 + lane * 4); ss += y[j].x * y[j].x + y[j].y * y[j].y + y[j].z * y[j].z + y[j].w * y[j].w; }
            const float rs = rsqrtf(wave_sum(ss, lane) * (1.f / DM) + EPS);
            const float* gate = WSF(WS_MOD) + ((size_t)(l - 1) * 5 + bi) * (3 * DM) + 2 * DM; const float* npost = KIN(7) + (size_t)(l - 1) * DM;
#pragma unroll
            for (int j = 0; j < 8; ++j) { const int c = j * 256 + lane * 4; const f32x4 g = *(const f32x4*)(gate + c), w = *(const f32x4*)(npost + c), xv = *(const f32x4*)(xr + c);
                v[j] = xv + g * (y[j] * rs * w); }
        }
        if (l == DEPTH) { float* o = (ka->out) + ((size_t)b * SEQ + t) * DM;
#pragma unroll
            for (int j = 0; j < 8; ++j) *(f32x4*)(o + j * 256 + lane * 4) = v[j];
            continue; }
        float* xo = (dry ? WSF(WS_ACC) : WSF(WS_X)) + (size_t)r * DM; float ss = 0.f;
#pragma unroll
        for (int j = 0; j < 8; ++j) { *(f32x4*)(xo + j * 256 + lane * 4) = v[j]; ss += v[j].x * v[j].x + v[j].y * v[j].y + v[j].z * v[j].z + v[j].w * v[j].w; }
        const float rs = rsqrtf(wave_sum(ss, lane) * (1.f / DM) + EPS);
        const float* shift = WSF(WS_MOD) + ((size_t)l * 5 + bi) * (3 * DM); const float* scale = shift + DM; const float* npre = KIN(6) + (size_t)l * DM;
        bf16_t* ho = (dry ? WSB(WS_G2) : WSB(WS_H)) + (size_t)r * DM;
#pragma unroll
        for (int j = 0; j < 8; ++j) { const int c = j * 256 + lane * 4; const f32x4 sh = *(const f32x4*)(shift + c), scv = *(const f32x4*)(scale + c), w = *(const f32x4*)(npre + c);
            const f32x4 h = v[j] * rs * w * (scv + 1.f) + sh; v2u o; o.x = pk2(h.x, h.y); o.y = pk2(h.z, h.w); *(v2u*)(ho + c) = o; }
    }
}

__device__ __forceinline__ void p_gates(Frame& F, CArgs* ka, int l, int wk0, int nwk) {
    const int tid = tid_fresh(), lane = tid & 63, wave = __builtin_amdgcn_readfirstlane(tid >> 6), c16 = lane & 15, q = lane >> 4;
    typedef short bf16x8 __attribute__((ext_vector_type(8)));
    LAS float* GL = (LAS float*)F.lds;
    const bf16_t* H = WSB(WS_H); const bf16_t* WG = WSB(WS_WG) + (size_t)l * 32 * DM; float* GT = WSF(WS_GT); f32x4* GSC = (f32x4*)WSF(WS_GSC);
    for (int task = wk0; task < NBATCH * 36; task += nwk) { const int b = task / 36, chunk = task - b * 36; const size_t row0 = (size_t)b * TPB + chunk * 64;
        __syncthreads();
        { const int rb = wave & 3, kh = wave >> 2; f32x4 a0 = {0.f, 0.f, 0.f, 0.f}, a1 = {0.f, 0.f, 0.f, 0.f};
          const bf16_t* hp = H + (row0 + rb * 16 + c16) * DM + kh * 1024 + q * 8; const bf16_t* w0 = WG + (size_t)c16 * DM + kh * 1024 + q * 8; const bf16_t* w1 = w0 + 16 * DM;
#pragma unroll 8
          for (int ks = 0; ks < 32; ++ks) { const bf16x8 av = *(const bf16x8*)(hp + ks * 32), b0 = *(const bf16x8*)(w0 + ks * 32), b1 = *(const bf16x8*)(w1 + ks * 32);
              a0 = __builtin_amdgcn_mfma_f32_16x16x32_bf16(av, b0, a0, 0, 0, 0); a1 = __builtin_amdgcn_mfma_f32_16x16x32_bf16(av, b1, a1, 0, 0, 0); }
#pragma unroll
          for (int j = 0; j < 4; ++j) { GL[(kh * 64 + rb * 16 + q * 4 + j) * 33 + c16] = a0[j]; GL[(kh * 64 + rb * 16 + q * 4 + j) * 33 + 16 + c16] = a1[j]; } }
        __syncthreads();
#pragma unroll
        for (int i = 0; i < 4; ++i) { const int idx = tid + 512 * i, r = idx >> 5, c = idx & 31; float s = GL[r * 33 + c] + GL[(64 + r) * 33 + c] + KIN(16)[l * 32 + c];
            if ((c >> 3) & 1) s = fminf(s, 0.f) - log1pf(expf(-fabsf(s)));
            GL[r * 33 + c] = s; GT[(row0 + r) * 32 + c] = s; }
        __syncthreads();
#pragma unroll
        for (int pi = 0; pi < 2; ++pi) { const int p = wave * 2 + pi, dir = p >> 3, h = p & 7, rl = dir ? 63 - lane : lane;
            const float gi = GL[rl * 33 + dir * 16 + h]; float bc = GL[rl * 33 + dir * 16 + 8 + h];
#pragma unroll
            for (int o = 1; o < 64; o <<= 1) { const float v = lane_up(bc, o, lane); if (lane >= o) bc += v; }
            const float g = gi - bc; float pm = g;
#pragma unroll
            for (int o = 1; o < 64; o <<= 1) { const float v = lane_up(pm, o, lane); if (lane >= o) pm = fmaxf(pm, v); }
            GSC[((((size_t)b * 2 + dir) * 8 + h) * 36 + chunk) * 64 + lane] = (f32x4){bc, g, pm, 0.f}; }
    }
    __syncthreads();
}
__device__ __forceinline__ void p_knorm(Frame& F, CArgs* ka, int l, bool dry = false) {
    const int tid = tid_fresh(), lane = tid & 63, wave = __builtin_amdgcn_readfirstlane(tid >> 6);
    const int gw = F.wg * NWAVES + wave, NGW = F.G * NWAVES; const int sub = lane & 15;
    f32x4 kn0 = *(const f32x4*)(KIN(19) + l * 128 + sub * 8), kn1 = *(const f32x4*)(KIN(19) + l * 128 + sub * 8 + 4);
    for (int r = gw; r < MROWS; r += NGW) { const int b = r / TPB, t = r - b * TPB;
        bf16_t* kp = WSB(WS_P) + (size_t)r * NP + C_AK + lane * 8; const v4u raw = *(const v4u*)kp; float v[8];
#pragma unroll
        for (int e = 0; e < 4; ++e) { v[2 * e] = blo(raw[e]); v[2 * e + 1] = bhi(raw[e]); }
        float ss = 0.f;
#pragma unroll
        for (int e = 0; e < 8; ++e) ss += v[e] * v[e];
        ss += lane_xor(ss, 1, lane); ss += lane_xor(ss, 2, lane); ss += lane_xor(ss, 4, lane); ss += lane_xor(ss, 8, lane);
        const float rs = rsqrtf(ss * (1.f / 128.f) + EPS);
#pragma unroll
        for (int e = 0; e < 8; ++e) v[e] *= rs * (e < 4 ? kn0[e & 3] : kn1[e & 3]);
        if (t < SEQ) { const int i0 = (sub & 7) * 8; const float* cp = WSF(WS_ROPE) + (size_t)t * 64 + i0; const float* sp = cp + SEQ * 64;
            const f32x4 c0 = *(const f32x4*)cp, c1 = *(const f32x4*)(cp + 4), s0 = *(const f32x4*)sp, s1 = *(const f32x4*)(sp + 4); const bool upper = (sub & 8) != 0;
#pragma unroll
            for (int e = 0; e < 8; ++e) { const float o = lane_xor(v[e], 8, lane), c = e < 4 ? c0[e & 3] : c1[e & 3], sn = e < 4 ? s0[e & 3] : s1[e & 3];
                v[e] = upper ? v[e] * c + o * sn : v[e] * c - o * sn; } }
        v4u ov; ov.x = pk2(v[0], v[1]); ov.y = pk2(v[2], v[3]); ov.z = pk2(v[4], v[5]); ov.w = pk2(v[6], v[7]);
        if (dry) *(v4u*)(WSB(WS_ACC) + (size_t)r * 512 + lane * 8) = ov; else *(v4u*)kp = ov; }
}

__device__ __forceinline__ void p_lru_gates_naive(Frame& F, CArgs* ka, int l) {
    const int tid = tid_fresh(); (void)tid;
    LAS float* xs = (LAS float*)F.lds;
    for (int it = F.wg; it < (MROWS / 16) * 16; it += F.G) { const int rt = it >> 4, blk = it & 15;
        __syncthreads();
#pragma unroll
        for (int j = 0; j < 4; ++j) { const int idx = tid + 512 * j, rr = idx >> 7, c = idx & 127, r = rt * 16 + rr, b = r / TPB, t = r - b * TPB, ch = blk * 128 + c;
            const int lo = t < SEQ ? 0 : SEQ, hi = t < SEQ ? SEQ : TPB; float a = KIN(10)[l * DM + ch];
#pragma unroll
            for (int k = 0; k < 4; ++k) { const int tt = t + k - 2; if (tt >= lo && tt < hi) a += KIN(9)[((size_t)l * 4 + k) * DM + ch] * bf2f(WSB(WS_P)[((size_t)b * TPB + tt) * NP + C_LX + ch]); }
            xs[rr * 128 + c] = a; }
        __syncthreads();
        const int co = tid & 127, r0 = tid >> 7, ch = blk * 128 + co;
#pragma unroll 1
        for (int dr = 0; dr < 2; ++dr) {
            const float* wr = KIN(11) + (((size_t)l * 2 + dr) * 16 + blk) * 16384 + co; const float* wi = KIN(13) + (((size_t)l * 2 + dr) * 16 + blk) * 16384 + co;
            float ar[4], ai[4];
#pragma unroll
            for (int j = 0; j < 4; ++j) { ar[j] = KIN(12)[((size_t)l * 2 + dr) * DM + ch]; ai[j] = KIN(14)[((size_t)l * 2 + dr) * DM + ch]; }
            for (int c = 0; c < 128; ++c) { const float w0 = wr[c * 128], w1 = wi[c * 128];
#pragma unroll
                for (int j = 0; j < 4; ++j) { const float xv = xs[(r0 + 4 * j) * 128 + c]; ar[j] += xv * w0; ai[j] += xv * w1; } }
            const float lam = KIN(15)[((size_t)l * 2 + dr) * DM + ch], sp = log1pf(expf(-lam));
#pragma unroll
            for (int j = 0; j < 4; ++j) { const int r = rt * 16 + r0 + 4 * j; const float rg = 1.f / (1.f + expf(-ar[j])), ig = 1.f / (1.f + expf(-ai[j]));
                const float log_a = -8.f * rg * sp, a = expf(log_a), mult = sqrtf(-expm1f(2.f * log_a));
                WSF(WS_LA)[((size_t)dr * MROWS + r) * DM + ch] = a; WSF(WS_LB)[((size_t)dr * MROWS + r) * DM + ch] = mult * ig * xs[(r0 + 4 * j) * 128 + co]; }
        }
    }
    __syncthreads();
}

__device__ __forceinline__ void p_attention(Frame& F, CArgs* ka, int l, bool need_ctx) {
    using att::bf16;
    const int n_lat = NBATCH * 16 * 8, n_all = n_lat + (need_ctx ? NBATCH * 16 : 0);
    for (int u = F.wg; u < n_all; u += F.G) {
        int b, h, q0, k0, seq; const float *cs = nullptr, *sn = nullptr;
        if (u < n_lat) { const int qb = u & 7; h = (u >> 3) & 15; b = u >> 7; q0 = qb * 256; k0 = 0; seq = TPB; cs = WSF(WS_ROPE) + (size_t)q0 * 64; sn = WSF(WS_ROPE) + (size_t)SEQ * 64 + (size_t)q0 * 64; }
        else { const int v = u - n_lat; h = v & 15; b = v >> 4; q0 = SEQ; k0 = SEQ; seq = CTXL; }
        const size_t rq = (size_t)b * TPB + q0, rk = (size_t)b * TPB + k0; const int kvh = h >> 2;
        att::attn_unit((const bf16*)(WSB(WS_P) + rq * NP + C_AQ + h * 128), (const bf16*)(WSB(WS_P) + rk * NP + C_AK + kvh * 128), (const bf16*)(WSB(WS_P) + rk * NP + C_AV + kvh * 128),
                       (const bf16*)(WSB(WS_P) + rq * NP + C_AZ + h * 128), (bf16*)(WSB(WS_YB) + ((size_t)2 * MROWS + rq) * DM + h * 128), seq, F.ldsg, KIN(18) + l * 128, cs, sn);
    }
}
__device__ __forceinline__ int seq_row(int s, int dir) { return s < CTXL ? SEQ + (dir ? CTXL - 1 - s : s) : (dir ? SEQ - 1 - (s - CTXL) : s - CTXL); }
__device__ __forceinline__ void p_mlstm_naive(Frame& F, CArgs* ka, int l) {
    const int tid = tid_fresh(), lane = tid & 63, wave = __builtin_amdgcn_readfirstlane(tid >> 6); (void)lane; (void)wave;
    LAS float* sq = (LAS float*)F.lds; LAS float* sk = sq + 256; LAS float* rn = sk + 256; LAS float* rd = rn + 512;
    const int e = tid & 63, dg = tid >> 6;
    for (int u = F.wg; u < 256; u += F.G) { const int es = u & 3, dir = (u >> 2) & 1, h = (u >> 3) & 7, b = u >> 6;
        float C[32], n[32];
#pragma unroll
        for (int i = 0; i < 32; ++i) { C[i] = 0.f; n[i] = 0.f; }
        float m = -1e30f;
        const int lcol = tid < 64 ? C_MQ + h * 256 + tid * 4 : C_MK + h * 256 + (tid - 64) * 4, vcol = C_MV + h * 256 + es * 64 + e;
        v2u pqk = {0u, 0u}; bf16_t pv; float gi, gf;
        { const size_t r = (size_t)b * TPB + seq_row(0, dir); if (tid < 128) pqk = *(const v2u*)(WSB(WS_P) + r * NP + lcol); pv = WSB(WS_P)[r * NP + vcol]; gi = WSF(WS_GT)[r * 32 + dir * 16 + h]; gf = WSF(WS_GT)[r * 32 + dir * 16 + 8 + h]; }
        __syncthreads();
        for (int s = 0; s < TPB; ++s) {
            const size_t r = (size_t)b * TPB + seq_row(s, dir);
            if (tid < 128) { LAS float* d = (tid < 64 ? sq : sk) + (tid & 63) * 4; d[0] = blo(pqk.x); d[1] = bhi(pqk.x); d[2] = blo(pqk.y); d[3] = bhi(pqk.y); }
            const float vv = bf2f(pv), iv = gi, lf = gf;
            __syncthreads();
            if (s + 1 < TPB) { const size_t r2 = (size_t)b * TPB + seq_row(s + 1, dir); if (tid < 128) pqk = *(const v2u*)(WSB(WS_P) + r2 * NP + lcol); pv = WSB(WS_P)[r2 * NP + vcol]; gi = WSF(WS_GT)[r2 * 32 + dir * 16 + h]; gf = WSF(WS_GT)[r2 * 32 + dir * 16 + 8 + h]; }
            const float mnew = fmaxf(lf + m, iv), fw = expf(lf + m - mnew), iw = expf(iv - mnew); m = mnew;
            float pn = 0.f, pd = 0.f;
#pragma unroll
            for (int dd = 0; dd < 32; ++dd) { const float kd = sk[dg * 32 + dd], qd = sq[dg * 32 + dd]; C[dd] = fw * C[dd] + iw * kd * vv; n[dd] = fw * n[dd] + iw * kd; pn += qd * C[dd]; pd += qd * n[dd]; }
            rn[dg * 64 + e] = pn; rd[dg * 64 + e] = pd;
            __syncthreads();
            if (dg == 0) { float num = 0.f, den = 0.f;
#pragma unroll
                for (int g = 0; g < 8; ++g) { num += rn[g * 64 + e]; den += rd[g * 64 + e]; }
                WSB(WS_MH)[((size_t)dir * MROWS + r) * DM + h * 256 + es * 64 + e] = (bf16_t)f2bf(num / fmaxf(fabsf(den), expf(-m))); }
        }
        __syncthreads();
    }
}
__device__ __forceinline__ void p_lru_scan_naive(Frame& F, CArgs* ka) {
    const int tid = tid_fresh(), lane = tid & 63, wave = __builtin_amdgcn_readfirstlane(tid >> 6); (void)lane; (void)wave;
    if (wave != 0) return;
    for (int cw = F.wg; cw < 256; cw += F.G) { const int combo = cw * 64 + lane, b = combo >> 12, dir = (combo >> 11) & 1, ch = combo & 2047;
        const float* A = WSF(WS_LA) + (size_t)dir * MROWS * DM + ch; const float* Bx = WSF(WS_LB) + (size_t)dir * MROWS * DM + ch; float* Ho = WSF(WS_HL) + (size_t)dir * MROWS * DM + ch; float h = 0.f;
#pragma unroll 8
        for (int s = 0; s < TPB; ++s) { const size_t r = (size_t)b * TPB + seq_row(s, dir); h = A[r * DM] * h + Bx[r * DM]; Ho[r * DM] = h; }
    }
}

__device__ __forceinline__ void p_mlout(Frame& F, CArgs* ka, int l, bool need_ctx) {
    const int tid = tid_fresh(), lane = tid & 63, wave = __builtin_amdgcn_readfirstlane(tid >> 6); (void)lane; (void)wave;
    const int gw = F.wg * NWAVES + wave, NGW = F.G * NWAVES, nrow = need_ctx ? MROWS : NBATCH * SEQ;
    for (int ri = gw; ri < nrow; ri += NGW) { const int r = need_ctx ? ri : (ri >> 11) * TPB + (ri & 2047);
        const bf16_t* pr = WSB(WS_P) + (size_t)r * NP;
#pragma unroll 2
        for (int h = 0; h < 8; ++h) { const int col = h * 256 + lane * 4;
            const v2u ma = *(const v2u*)(WSB(WS_MH) + (size_t)r * DM + col), mb = *(const v2u*)(WSB(WS_MH) + ((size_t)MROWS + r) * DM + col);
            const f32x4 a = {blo(ma.x), bhi(ma.x), blo(ma.y), bhi(ma.y)}, bb = {blo(mb.x), bhi(mb.x), blo(mb.y), bhi(mb.y)};
            const v2u ow = *(const v2u*)(pr + C_MO + col), zw = *(const v2u*)(pr + C_MZ + col); const f32x4 g = *(const f32x4*)(KIN(17) + (size_t)l * DM + col);
            f32x4 v = a + bb; v.x *= blo(ow.x); v.y *= bhi(ow.x); v.z *= blo(ow.y); v.w *= bhi(ow.y);
            const float rs = rsqrtf(wave_sum(v.x * v.x + v.y * v.y + v.z * v.z + v.w * v.w, lane) * (1.f / 256.f) + EPS);
            v2u o; o.x = pk2(v.x * rs * g.x * blo(zw.x), v.y * rs * g.y * bhi(zw.x)); o.y = pk2(v.z * rs * g.z * blo(zw.y), v.w * rs * g.w * bhi(zw.y));
            *(v2u*)(WSB(WS_YB) + ((size_t)MROWS + r) * DM + col) = o; }
    }
}

__device__ __forceinline__ void p_lru_combine_naive(Frame& F, CArgs* ka) {
    const int tid = tid_fresh(), lane = tid & 63, wave = __builtin_amdgcn_readfirstlane(tid >> 6);
    const int gw = F.wg * NWAVES + wave, NGW = F.G * NWAVES;
    for (int r = gw; r < MROWS; r += NGW) {
        const bf16_t* pr = WSB(WS_P) + (size_t)r * NP;
#pragma unroll 2
        for (int j = 0; j < 8; ++j) { const int col = j * 256 + lane * 4;
            const f32x4 a = *(const f32x4*)(WSF(WS_HL) + (size_t)r * DM + col), bb = *(const f32x4*)(WSF(WS_HL) + ((size_t)MROWS + r) * DM + col); const v2u zw = *(const v2u*)(pr + C_LZ + col);
            const f32x4 v = a + bb; v2u o; o.x = pk2(v.x * blo(zw.x), v.y * bhi(zw.x)); o.y = pk2(v.z * blo(zw.y), v.w * bhi(zw.y));
            *(v2u*)(WSB(WS_YB) + (size_t)r * DM + col) = o; }
    }
}
#ifndef USE_NAIVE_ML
#define USE_NAIVE_ML 0
#endif
#ifndef USE_NAIVE_LRU
#define USE_NAIVE_LRU 0
#endif

namespace ml {
typedef short bf16x8 __attribute__((ext_vector_type(8)));
constexpr int KS_OFF = 0, KS_PITCH = 528;
constexpr int KT_OFF = KS_OFF + 64 * KS_PITCH, KT_PITCH = 144;
constexpr int VT_OFF = KT_OFF + 256 * KT_PITCH, VT_PITCH = 144;
constexpr int ST_OFF = VT_OFF + 80 * VT_PITCH, ST_PITCH = 144;
constexpr int CT_OFF = ST_OFF + 64 * ST_PITCH, CT_PITCH = 528;
constexpr int TAB_OFF = CT_OFF + 80 * CT_PITCH;
constexpr int END_OFF = TAB_OFF + 1024;
static_assert(END_OFF <= MISC_OFF, "mLSTM LDS map");
#define ML_MFMA(a, b, c) __builtin_amdgcn_mfma_f32_16x16x32_bf16((a), (b), (c), 0, 0, 0)
__device__ __forceinline__ int chunk_of(int k, int dir) { return k < 4 ? (dir ? 35 - k : 32 + k) : (dir ? 31 - (k - 4) : k - 4); }

__device__ __forceinline__ void mlstm_unit(Frame& F, CArgs* ka, int u, bool need_ctx) {
    const int tid = tid_fresh(), lane = tid & 63, w = __builtin_amdgcn_readfirstlane(tid >> 6), c16 = lane & 15, q = lane >> 4;
    const int es = u & 3, dir = (u >> 2) & 1, h = (u >> 3) & 7, b = u >> 6;
    LAS unsigned char* L = F.lds;
    const bf16_t* P = WSB(WS_P); bf16_t* MH = WSB(WS_MH) + (size_t)dir * MROWS * DM;
    const f32x4* GSC = (const f32x4*)WSF(WS_GSC) + (((size_t)b * 2 + dir) * 8 + h) * 36 * 64;
    LAS float* TABg = (LAS float*)(L + TAB_OFF); LAS float* TABmm = TABg + 64; LAS float* TABbc = TABg + 128;
    __syncthreads();
    { unsigned z0 = 0u; asm volatile("" : "+v"(z0)); const v4u zz = {z0, z0, z0, z0};
      for (int i = tid; i < 80 * CT_PITCH / 16; i += 512) *(LAS v4u*)(L + CT_OFF + i * 16) = zz; }
    for (int i = tid; i < 16 * 64; i += 512) { const int e = 64 + (i >> 6), s = i & 63; *(LAS bf16_t*)(L + VT_OFF + e * VT_PITCH + s * 2) = (bf16_t)(e == 64 ? 0x3F80 : 0); }
    f32x4 C[2][5];
#pragma unroll
    for (int a = 0; a < 2; ++a)
#pragma unroll
        for (int e = 0; e < 5; ++e) C[a][e] = (f32x4){0.f, 0.f, 0.f, 0.f};
    float m = -1e30f;
    const int tn = w & 3, wh = w >> 2;
    v4u kraw[4], vraw; bf16x8 Qf[8]; float gsc0, gsc1, gsc2;
#define ML_ROW(base, j) ((size_t)(base) + (dir ? 63 - (j) : (j)))
#define ML_LOAD_KVG(k) do { const int _c = chunk_of((k), dir), _base = b * TPB + _c * 64; const bf16_t* _rp = P + ML_ROW(_base, lane) * NP; \
        _Pragma("unroll") for (int i = 0; i < 4; ++i) kraw[i] = *(const v4u*)(_rp + C_MK + h * 256 + (w * 4 + i) * 8); \
        vraw = *(const v4u*)(_rp + C_MV + h * 256 + es * 64 + w * 8); { const float* _gp = (const float*)(GSC + _c * 64 + lane); gsc0 = _gp[0]; gsc1 = _gp[1]; gsc2 = _gp[2]; } } while (0)
#define ML_LOAD_Q(k) do { const int _base = b * TPB + chunk_of((k), dir) * 64; const bf16_t* _qp = P + ML_ROW(_base, tn * 16 + c16) * NP + C_MQ + h * 256 + q * 8; \
        _Pragma("unroll") for (int ks = 0; ks < 8; ++ks) Qf[ks] = *(const bf16x8*)(_qp + ks * 32); } while (0)
    ML_LOAD_KVG(0); ML_LOAD_Q(0);
    float bL = 0.f, mm63 = 0.f;
#pragma unroll 1
    for (int k = 0; k < 36; ++k) {
        const int base = b * TPB + chunk_of(k, dir) * 64; const bool do_out = need_ctx || k >= 4;
        if (k > 0) {
#pragma unroll
            for (int di = 0; di < 2; ++di)
#pragma unroll
                for (int en = 0; en < 5; ++en) { const f32x4 c = C[di][en]; v2u o; o.x = pk2(c[0], c[1]); o.y = pk2(c[2], c[3]);
                    *(LAS v2u*)(L + CT_OFF + (en * 16 + c16) * CT_PITCH + ((2 * w + di) * 16 + q * 4) * 2) = o; }
            m = bL + mm63; }
        const float bc = gsc0, g = gsc1, mm = fmaxf(gsc2, m), wk = __expf(g - lane_get(mm, 63));
        bL = lane_get(bc, 63); mm63 = lane_get(mm, 63);
        if (w == 0) { TABg[lane] = g; TABmm[lane] = mm; TABbc[lane] = bc; }
#pragma unroll
        for (int i = 0; i < 4; ++i) { *(LAS v4u*)(L + KS_OFF + lane * KS_PITCH + (w * 4 + i) * 16) = kraw[i];
#pragma unroll
            for (int e = 0; e < 4; ++e) { const unsigned x = kraw[i][e]; const unsigned pk = pk2(blo(x) * wk, bhi(x) * wk);
                *(LAS bf16_t*)(L + KT_OFF + ((w * 4 + i) * 8 + 2 * e) * KT_PITCH + lane * 2) = (bf16_t)(pk & 0xffffu); *(LAS bf16_t*)(L + KT_OFF + ((w * 4 + i) * 8 + 2 * e + 1) * KT_PITCH + lane * 2) = (bf16_t)(pk >> 16); } }
#pragma unroll
        for (int e = 0; e < 4; ++e) { const unsigned x = vraw[e];
            *(LAS bf16_t*)(L + VT_OFF + (w * 8 + 2 * e) * VT_PITCH + lane * 2) = (bf16_t)(x & 0xffffu); *(LAS bf16_t*)(L + VT_OFF + (w * 8 + 2 * e + 1) * VT_PITCH + lane * 2) = (bf16_t)(x >> 16); }
        __syncthreads();
        const int t = tn * 16 + c16; const int kn = k + 1 < 36 ? k + 1 : 35;
        if (do_out) {
            const float mmt = TABmm[t];
#pragma unroll
            for (int si = 0; si < 2; ++si) { const int sm = wh * 2 + si; v2u o = {0u, 0u};
                if (sm <= tn) { f32x4 acc = {0.f, 0.f, 0.f, 0.f};
#pragma unroll
                    for (int ks = 0; ks < 8; ++ks) { const bf16x8 a = *(const LAS bf16x8*)(L + KS_OFF + (sm * 16 + c16) * KS_PITCH + (ks * 32 + q * 8) * 2); acc = ML_MFMA(a, Qf[ks], acc); }
                    float v[4];
#pragma unroll
                    for (int j = 0; j < 4; ++j) { const int s = sm * 16 + q * 4 + j; v[j] = s <= t ? acc[j] * __expf(TABg[s] - mmt) : 0.f; }
                    o.x = pk2(v[0], v[1]); o.y = pk2(v[2], v[3]); }
                *(LAS v2u*)(L + ST_OFF + t * ST_PITCH + (sm * 16 + q * 4) * 2) = o; }
        }
        ML_LOAD_KVG(kn);
        __syncthreads();
        f32x4 num0 = {0.f, 0.f, 0.f, 0.f}, num1 = {0.f, 0.f, 0.f, 0.f}; float den = 1.f;
        if (do_out) {
            const float wi = __expf(m - TABmm[t]);
            bf16x8 sb[2];
#pragma unroll
            for (int ks = 0; ks < 2; ++ks) sb[ks] = *(const LAS bf16x8*)(L + ST_OFF + t * ST_PITCH + (ks * 32 + q * 8) * 2);
#pragma unroll
            for (int ei = 0; ei < 3; ++ei) { const int em = ei < 2 ? wh * 2 + ei : 4;
                f32x4 a1 = {0.f, 0.f, 0.f, 0.f}, a2 = {0.f, 0.f, 0.f, 0.f};
#pragma unroll
                for (int ks = 0; ks < 2; ++ks) { const bf16x8 a = *(const LAS bf16x8*)(L + VT_OFF + (em * 16 + c16) * VT_PITCH + (ks * 32 + q * 8) * 2); a1 = ML_MFMA(a, sb[ks], a1); }
#pragma unroll
                for (int ks = 0; ks < 8; ++ks) { const bf16x8 a = *(const LAS bf16x8*)(L + CT_OFF + (em * 16 + c16) * CT_PITCH + (ks * 32 + q * 8) * 2); a2 = ML_MFMA(a, Qf[ks], a2); }
                const f32x4 nv = a1 + a2 * wi;
                if (ei == 0) num0 = nv; else if (ei == 1) num1 = nv;
                else den = fmaxf(fabsf(lane_get(nv[0], c16)), __expf(-(TABbc[t] + TABmm[t]))); }
        }
        ML_LOAD_Q(kn);
        if (do_out) { const float rd = 1.f / den; bf16_t* op = MH + ML_ROW(base, t) * DM + h * 256 + es * 64 + q * 4; const f32x4 o0 = num0 * rd, o1 = num1 * rd;
            v2u w0, w1; w0.x = pk2(o0[0], o0[1]); w0.y = pk2(o0[2], o0[3]); w1.x = pk2(o1[0], o1[1]); w1.y = pk2(o1[2], o1[3]);
            *(v2u*)(op + (wh * 2) * 16) = w0; *(v2u*)(op + (wh * 2 + 1) * 16) = w1; }
        { const float decay = __expf(m - mm63);
          bf16x8 vb[5][2];
#pragma unroll
          for (int en = 0; en < 5; ++en)
#pragma unroll
              for (int ks = 0; ks < 2; ++ks) vb[en][ks] = *(const LAS bf16x8*)(L + VT_OFF + (en * 16 + c16) * VT_PITCH + (ks * 32 + q * 8) * 2);
#pragma unroll
          for (int di = 0; di < 2; ++di) {
            bf16x8 a[2];
#pragma unroll
            for (int ks = 0; ks < 2; ++ks) a[ks] = *(const LAS bf16x8*)(L + KT_OFF + ((2 * w + di) * 16 + c16) * KT_PITCH + (ks * 32 + q * 8) * 2);
#pragma unroll
            for (int en = 0; en < 5; ++en) { f32x4 c = C[di][en] * decay;
#pragma unroll
                for (int ks = 0; ks < 2; ++ks) c = ML_MFMA(a[ks], vb[en][ks], c);
                C[di][en] = c; } } }
        __syncthreads();
    }
#undef ML_ROW
#undef ML_LOAD_KVG
#undef ML_LOAD_Q
}
constexpr int ST2_OFF = TAB_OFF + 1024, TAB2_OFF = ST2_OFF + 64 * ST_PITCH, END2_OFF = TAB2_OFF + 1024;
static_assert(END2_OFF <= MISC_OFF, "mLSTM LDS map (pipelined)");
template <int VAR> __device__ __forceinline__ void mlstm_unit_pipe(Frame& F, CArgs* ka, int u, bool need_ctx) {
    const int tid = tid_fresh(), lane = tid & 63, w = __builtin_amdgcn_readfirstlane(tid >> 6), c16 = lane & 15, q = lane >> 4;
    const int es = u & 3, dir = (u >> 2) & 1, h = (u >> 3) & 7, b = u >> 6;
    LAS unsigned char* L = F.lds;
    const bf16_t* P = WSB(WS_P); bf16_t* MH = (VAR ? WSB(WS_ACC) : WSB(WS_MH)) + (size_t)dir * MROWS * DM;
    const f32x4* GSC = (const f32x4*)WSF(WS_GSC) + (((size_t)b * 2 + dir) * 8 + h) * 36 * 64;
    __syncthreads();
    { unsigned z0 = 0u; asm volatile("" : "+v"(z0)); const v4u zz = {z0, z0, z0, z0};
      for (int i = tid; i < 80 * CT_PITCH / 16; i += 512) *(LAS v4u*)(L + CT_OFF + i * 16) = zz; }
    for (int i = tid; i < 16 * 64; i += 512) { const int e = 64 + (i >> 6), s = i & 63; *(LAS bf16_t*)(L + VT_OFF + e * VT_PITCH + s * 2) = (bf16_t)(e == 64 ? 0x3F80 : 0); }
    f32x4 C[2][5];
#pragma unroll
    for (int a = 0; a < 2; ++a)
#pragma unroll
        for (int e = 0; e < 5; ++e) C[a][e] = (f32x4){0.f, 0.f, 0.f, 0.f};
    const int tn = w & 3, wh = w >> 2, t = tn * 16 + c16;
    v4u kc[4], kn[4], vc; bf16x8 Qc[8], Qn[8]; float gc0, gc1, gc2, gn0, gn1, gn2;
#define MLP_ROW(base, j) ((size_t)(base) + (dir ? 63 - (j) : (j)))
#define MLP_TAB(par) ((LAS float*)(L + ((par) ? TAB2_OFF : TAB_OFF)))
#define MLP_ST(par) ((par) ? ST2_OFF : ST_OFF)
#define MLP_LOADK(dst, k) do { const int _c = chunk_of((k), dir); const bf16_t* _rp = P + MLP_ROW(b * TPB + _c * 64, lane) * NP + C_MK + h * 256 + w * 32; \
        _Pragma("unroll") for (int i = 0; i < 4; ++i) dst[i] = *(const v4u*)(_rp + i * 8); } while (0)
#define MLP_LOADV(dst, k) do { const int _c = chunk_of((k), dir); dst = *(const v4u*)(P + MLP_ROW(b * TPB + _c * 64, lane) * NP + C_MV + h * 256 + es * 64 + w * 8); } while (0)
#define MLP_LOADG(d0, d1, d2, k) do { const float* _gp = (const float*)(GSC + chunk_of((k), dir) * 64 + lane); d0 = _gp[0]; d1 = _gp[1]; d2 = _gp[2]; } while (0)
#define MLP_LOADQ(dst, k) do { const bf16_t* _qp = P + MLP_ROW(b * TPB + chunk_of((k), dir) * 64, t) * NP + C_MQ + h * 256 + q * 8; \
        _Pragma("unroll") for (int ks = 0; ks < 8; ++ks) dst[ks] = *(const bf16x8*)(_qp + ks * 32); } while (0)
#define MLP_STILE(QQ, TB, SO) do { const float _mmt = (TB)[64 + t]; \
        _Pragma("unroll") for (int si = 0; si < 2; ++si) { const int sm = wh * 2 + si; v2u o = {0u, 0u}; \
            if (sm <= tn) { f32x4 acc = {0.f, 0.f, 0.f, 0.f}; \
                bf16x8 ka_[8]; \
                _Pragma("unroll") for (int ks = 0; ks < 8; ++ks) ka_[ks] = *(const LAS bf16x8*)(L + KS_OFF + (sm * 16 + c16) * KS_PITCH + (ks * 32 + q * 8) * 2); \
                __builtin_amdgcn_sched_barrier(0); \
                _Pragma("unroll") for (int ks = 0; ks < 8; ++ks) acc = ML_MFMA(ka_[ks], QQ[ks], acc); \
                float v[4]; \
                _Pragma("unroll") for (int j = 0; j < 4; ++j) { const int s = sm * 16 + q * 4 + j; v[j] = s <= t ? acc[j] * __expf((TB)[s] - _mmt) : 0.f; } \
                o.x = pk2(v[0], v[1]); o.y = pk2(v[2], v[3]); } \
            *(LAS v2u*)(L + (SO) + t * ST_PITCH + (sm * 16 + q * 4) * 2) = o; } } while (0)
    MLP_LOADK(kc, 0); MLP_LOADV(vc, 0); MLP_LOADG(gc0, gc1, gc2, 0); MLP_LOADQ(Qc, 0); MLP_LOADK(kn, 1); MLP_LOADG(gn0, gn1, gn2, 1); MLP_LOADQ(Qn, 1);
    float m = -1e30f;
    {
      const float mm = fmaxf(gc2, m); LAS float* TB = MLP_TAB(0);
      if (w == 0) { TB[lane] = gc1; TB[64 + lane] = mm; TB[128 + lane] = gc0; }
#pragma unroll
      for (int i = 0; i < 4; ++i) *(LAS v4u*)(L + KS_OFF + lane * KS_PITCH + (w * 4 + i) * 16) = kc[i];
      __syncthreads();
      if (need_ctx) MLP_STILE(Qc, TB, MLP_ST(0));
      __syncthreads(); }
#pragma unroll 1
    for (int k = 0; k < 36; ++k) {
        const int par = k & 1, k1 = k + 1 < 36 ? k + 1 : 35, k2 = k + 2 < 36 ? k + 2 : 35;
        const bool do_out = need_ctx || k >= 4, s_next = (k + 1 < 36) && (need_ctx || k + 1 >= 4);
        const size_t base = (size_t)b * TPB + chunk_of(k, dir) * 64;
        if (k > 0 && VAR != 2) {
#pragma unroll
            for (int di = 0; di < 2; ++di)
#pragma unroll
                for (int en = 0; en < 5; ++en) { const f32x4 c = C[di][en]; v2u o; o.x = pk2(c[0], c[1]); o.y = pk2(c[2], c[3]);
                    *(LAS v2u*)(L + CT_OFF + (en * 16 + c16) * CT_PITCH + ((2 * w + di) * 16 + q * 4) * 2) = o; } }
        const float mm = fmaxf(gc2, m), bL = lane_get(gc0, 63), mm63 = lane_get(mm, 63), wk = __expf(gc1 - mm63), m_next = bL + mm63;
#pragma unroll
        for (int i = 0; i < (VAR == 2 ? 1 : 4); ++i) {
#pragma unroll
            for (int e = 0; e < (VAR == 2 ? 1 : 4); ++e) { const unsigned x = kc[i][e]; const unsigned pk = pk2(blo(x) * wk, bhi(x) * wk);
                *(LAS bf16_t*)(L + KT_OFF + ((w * 4 + i) * 8 + 2 * e) * KT_PITCH + lane * 2) = (bf16_t)(pk & 0xffffu); *(LAS bf16_t*)(L + KT_OFF + ((w * 4 + i) * 8 + 2 * e + 1) * KT_PITCH + lane * 2) = (bf16_t)(pk >> 16); } }
#pragma unroll
        for (int e = 0; e < 4; ++e) { const unsigned x = vc[e];
            *(LAS bf16_t*)(L + VT_OFF + (w * 8 + 2 * e) * VT_PITCH + lane * 2) = (bf16_t)(x & 0xffffu); *(LAS bf16_t*)(L + VT_OFF + (w * 8 + 2 * e + 1) * VT_PITCH + lane * 2) = (bf16_t)(x >> 16); }
        { const float mmn = fmaxf(gn2, m_next); LAS float* TBn = MLP_TAB(par ^ 1);
          if (w == 0) { TBn[lane] = gn1; TBn[64 + lane] = mmn; TBn[128 + lane] = gn0; }
#pragma unroll
          for (int i = 0; i < (VAR == 2 ? 1 : 4); ++i) *(LAS v4u*)(L + KS_OFF + lane * KS_PITCH + (w * 4 + i) * 16) = kn[i]; }
        __syncthreads();
#pragma unroll
        for (int i = 0; i < 4; ++i) kc[i] = kn[i];
        gc0 = gn0; gc1 = gn1; gc2 = gn2;
        if (VAR != 3) { MLP_LOADK(kn, k2); MLP_LOADV(vc, k1); MLP_LOADG(gn0, gn1, gn2, k2); }
        const LAS float* TB = MLP_TAB(par);
        if (do_out && VAR != 1) {
            const float wi = __expf(m - TB[64 + t]); f32x4 num0 = {0.f, 0.f, 0.f, 0.f}, num1 = {0.f, 0.f, 0.f, 0.f}; float den = 1.f;
            bf16x8 sb[2];
#pragma unroll
            for (int ks = 0; ks < 2; ++ks) sb[ks] = *(const LAS bf16x8*)(L + MLP_ST(par) + t * ST_PITCH + (ks * 32 + q * 8) * 2);
#pragma unroll
            for (int ei = 0; ei < 3; ++ei) { const int em = ei < 2 ? wh * 2 + ei : 4;
                f32x4 a1 = {0.f, 0.f, 0.f, 0.f}, a2 = {0.f, 0.f, 0.f, 0.f}; bf16x8 va_[2], ca_[8];
#pragma unroll
                for (int ks = 0; ks < 2; ++ks) va_[ks] = *(const LAS bf16x8*)(L + VT_OFF + (em * 16 + c16) * VT_PITCH + (ks * 32 + q * 8) * 2);
#pragma unroll
                for (int ks = 0; ks < 8; ++ks) ca_[ks] = *(const LAS bf16x8*)(L + CT_OFF + (em * 16 + c16) * CT_PITCH + (ks * 32 + q * 8) * 2);
                __builtin_amdgcn_sched_barrier(0);
#pragma unroll
                for (int ks = 0; ks < 2; ++ks) a1 = ML_MFMA(va_[ks], sb[ks], a1);
#pragma unroll
                for (int ks = 0; ks < 8; ++ks) a2 = ML_MFMA(ca_[ks], Qc[ks], a2);
                __builtin_amdgcn_sched_barrier(0);
                const f32x4 nv = a1 + a2 * wi;
                if (ei == 0) num0 = nv; else if (ei == 1) num1 = nv;
                else den = fmaxf(fabsf(lane_get(nv[0], c16)), __expf(-(TB[128 + t] + TB[64 + t]))); }
            const float rd = 1.f / den; bf16_t* op = MH + MLP_ROW(base, t) * DM + h * 256 + es * 64 + q * 4; const f32x4 o0 = num0 * rd, o1 = num1 * rd;
            v2u w0, w1; w0.x = pk2(o0[0], o0[1]); w0.y = pk2(o0[2], o0[3]); w1.x = pk2(o1[0], o1[1]); w1.y = pk2(o1[2], o1[3]);
            *(v2u*)(op + (wh * 2) * 16) = w0; *(v2u*)(op + (wh * 2 + 1) * 16) = w1;
        }
        if (VAR != 1) { const float decay = __expf(m - mm63); bf16x8 vb_[5][2], ka2_[2][2];
#pragma unroll
          for (int en = 0; en < 5; ++en)
#pragma unroll
              for (int ks = 0; ks < 2; ++ks) vb_[en][ks] = *(const LAS bf16x8*)(L + VT_OFF + (en * 16 + c16) * VT_PITCH + (ks * 32 + q * 8) * 2);
#pragma unroll
          for (int di = 0; di < 2; ++di)
#pragma unroll
              for (int ks = 0; ks < 2; ++ks) ka2_[di][ks] = *(const LAS bf16x8*)(L + KT_OFF + ((2 * w + di) * 16 + c16) * KT_PITCH + (ks * 32 + q * 8) * 2);
#pragma unroll
          for (int di = 0; di < 2; ++di)
#pragma unroll
              for (int en = 0; en < 5; ++en) C[di][en] = C[di][en] * decay;
          __builtin_amdgcn_sched_barrier(0);
#pragma unroll
          for (int di = 0; di < 2; ++di)
#pragma unroll
              for (int en = 0; en < 5; ++en)
#pragma unroll
                  for (int ks = 0; ks < 2; ++ks) C[di][en] = ML_MFMA(ka2_[di][ks], vb_[en][ks], C[di][en]);
          __builtin_amdgcn_sched_barrier(0); }
        if (s_next && VAR != 1) MLP_STILE(Qn, MLP_TAB(par ^ 1), MLP_ST(par ^ 1));
#pragma unroll
        for (int ks = 0; ks < 8; ++ks) Qc[ks] = Qn[ks];
        if (VAR != 3) MLP_LOADQ(Qn, k2);
        m = m_next;
        __syncthreads();
    }
#undef MLP_ROW
#undef MLP_TAB
#undef MLP_ST
#undef MLP_LOADK
#undef MLP_LOADV
#undef MLP_LOADG
#undef MLP_LOADQ
#undef MLP_STILE
}
}

namespace lru {
typedef short bf16x8 __attribute__((ext_vector_type(8)));
constexpr int XB_OFF = 0, XB_PITCH = 272;
constexpr int XF_OFF = XB_OFF + 64 * XB_PITCH, XF_PITCH = 528;
constexpr int YO_OFF = XF_OFF + 64 * XF_PITCH, YO_PITCH = 528;
constexpr int HIN_OFF = YO_OFF + 64 * YO_PITCH;
constexpr int CW_OFF = HIN_OFF + 9 * 2 * 128 * 4;
constexpr int END_OFF = CW_OFF + 5 * 128 * 4;
static_assert(END_OFF <= MISC_OFF, "LRU LDS map");
#define LRU_COMPOSE(A, B, a2, b2) do { B = (a2) * B + (b2); A = (a2) * A; } while (0)

template <bool FINAL, int VAR, class BcOf>
__device__ __forceinline__ void lru_run(Frame& F, CArgs* ka, int l, int blk, int NU, const BcOf& bc_of) {
    const int tid = tid_fresh(), lane = tid & 63, w = __builtin_amdgcn_readfirstlane(tid >> 6), c16 = lane & 15, q = lane >> 4;
    LAS unsigned char* L = F.lds; const bf16_t* P = WSB(WS_P);
    const int cg = tid & 15, rg = tid >> 4, chl = 16 * w + c16, ch = blk * 128 + chl;
    bf16x8 bw[4][4];
    { const bf16_t* Wt = WSB(WS_WLRU) + (size_t)l * 4 * 16 * 16384 + ((size_t)blk * 128 + chl) * 128 + q * 8;
#pragma unroll
      for (int g = 0; g < 4; ++g)
#pragma unroll
          for (int ks = 0; ks < 4; ++ks) bw[g][ks] = *(const bf16x8*)(Wt + (size_t)g * 16 * 16384 + ks * 32); }
    float cbr[2], cbi[2], csp[2];
#pragma unroll
    for (int dr = 0; dr < 2; ++dr) { cbr[dr] = KIN(12)[((size_t)l * 2 + dr) * DM + ch]; cbi[dr] = KIN(14)[((size_t)l * 2 + dr) * DM + ch]; csp[dr] = log1pf(__expf(-KIN(15)[((size_t)l * 2 + dr) * DM + ch])); }
    for (int i = tid; i < 5 * 128; i += 512) { const int kk = i >> 7, c = i & 127; ((LAS float*)(L + CW_OFF))[i] = kk < 4 ? KIN(9)[((size_t)l * 4 + kk) * DM + blk * 128 + c] : KIN(10)[(size_t)l * DM + blk * 128 + c]; }
    v4u raw[5];
#define LRU_LOAD(i) do { int _b, _c; bc_of((i), _b, _c); const int _t0 = _c * 64, _lo = _c < 32 ? 0 : SEQ, _hi = _c < 32 ? SEQ : TPB; const size_t _rb = (size_t)_b * TPB; \
        _Pragma("unroll") for (int x = 0; x < 5; ++x) { const int tt = _t0 + 2 * rg - 2 + x; raw[x] = (v4u){0u, 0u, 0u, 0u}; if (tt >= _lo && tt < _hi) raw[x] = *(const v4u*)(P + (_rb + tt) * NP + C_LX + blk * 128 + cg * 8); } \
        } while (0)
    LRU_LOAD(0);
#pragma unroll 1
    for (int ui = 0; ui < NU; ++ui) {
        int b, chunk; bc_of(ui, b, chunk); const size_t rb = (size_t)b * TPB; const int t0 = chunk * 64;
        __syncthreads();
        {
          float o0[8], o1[8]; const LAS float* cwl = (const LAS float*)(L + CW_OFF) + cg * 8;
#pragma unroll
          for (int e = 0; e < 8; ++e) { o0[e] = cwl[4 * 128 + e]; o1[e] = o0[e]; }
#pragma unroll
          for (int kk = 0; kk < 5; ++kk) { float xin[8];
#pragma unroll
              for (int e = 0; e < 4; ++e) { xin[2 * e] = blo(raw[kk][e]); xin[2 * e + 1] = bhi(raw[kk][e]); }
#pragma unroll
              for (int e = 0; e < 8; ++e) { if (kk < 4) o0[e] += cwl[kk * 128 + e] * xin[e]; if (kk > 0) o1[e] += cwl[(kk - 1) * 128 + e] * xin[e]; } }
          v4u p0, p1; p0.x = pk2(o0[0], o0[1]); p0.y = pk2(o0[2], o0[3]); p0.z = pk2(o0[4], o0[5]); p0.w = pk2(o0[6], o0[7]); p1.x = pk2(o1[0], o1[1]); p1.y = pk2(o1[2], o1[3]); p1.z = pk2(o1[4], o1[5]); p1.w = pk2(o1[6], o1[7]);
          *(LAS v4u*)(L + XB_OFF + (2 * rg) * XB_PITCH + cg * 16) = p0; *(LAS v4u*)(L + XB_OFF + (2 * rg + 1) * XB_PITCH + cg * 16) = p1;
          LAS float* f0 = (LAS float*)(L + XF_OFF + (2 * rg) * XF_PITCH + cg * 32); LAS float* f1 = (LAS float*)(L + XF_OFF + (2 * rg + 1) * XF_PITCH + cg * 32);
          *(LAS f32x4*)f0 = (f32x4){o0[0], o0[1], o0[2], o0[3]}; *(LAS f32x4*)(f0 + 4) = (f32x4){o0[4], o0[5], o0[6], o0[7]};
          *(LAS f32x4*)f1 = (f32x4){o1[0], o1[1], o1[2], o1[3]}; *(LAS f32x4*)(f1 + 4) = (f32x4){o1[4], o1[5], o1[6], o1[7]}; }
        __syncthreads();
        v4u zcur[2];
        if (FINAL) {
#pragma unroll
            for (int x = 0; x < 2; ++x) { const int cidx = tid + 512 * x; zcur[x] = *(const v4u*)(P + (rb + t0 + (cidx >> 4)) * NP + C_LZ + blk * 128 + (cidx & 15) * 8); } }
        if (ui + 1 < NU) LRU_LOAD(ui + 1);
#pragma unroll
        for (int dr = 0; dr < 2; ++dr) {
            f32x4 acc[2][4];
#pragma unroll
            for (int g = 0; g < 2; ++g)
#pragma unroll
                for (int tm = 0; tm < 4; ++tm) acc[g][tm] = (f32x4){0.f, 0.f, 0.f, 0.f};
            if (VAR < 2) {
#pragma unroll
            for (int ks = 0; ks < 4; ++ks) { bf16x8 a[4];
#pragma unroll
                for (int tm = 0; tm < 4; ++tm) a[tm] = *(const LAS bf16x8*)(L + XB_OFF + (tm * 16 + c16) * XB_PITCH + (ks * 32 + q * 8) * 2);
#pragma unroll
                for (int g = 0; g < 2; ++g)
#pragma unroll
                    for (int tm = 0; tm < 4; ++tm) acc[g][tm] = __builtin_amdgcn_mfma_f32_16x16x32_bf16(a[tm], bw[2 * dr + g][ks], acc[g][tm], 0, 0, 0); } }
            if (VAR < 1)
#pragma unroll
            for (int tm = 0; tm < 4; ++tm)
#pragma unroll
                for (int j = 0; j < 4; ++j) { const int t = tm * 16 + q * 4 + j; const float xv = *(const LAS float*)(L + XF_OFF + t * XF_PITCH + chl * 4);
                    const float rgt = pg8::sigmoid_f(acc[0][tm][j] + cbr[dr]), igt = pg8::sigmoid_f(acc[1][tm][j] + cbi[dr]), la = -8.f * rgt * csp[dr], av = __expf(la), x2 = 2.f * la;
                    const float om = x2 > -0.1f ? -x2 * (1.f + x2 * (0.5f + x2 * (0.16666667f + x2 * (0.041666668f + x2 * 0.0083333338f)))) : 1.f - av * av;
                    acc[0][tm][j] = av; acc[1][tm][j] = sqrtf(om) * igt * xv; }
#define LRU_TM(i) (dr ? 3 - (i) : (i))
            if constexpr (!FINAL) { if (VAR < 3) {
                float2* AGG = (float2*)(VAR ? WSF(WS_ACC) : WSF(WS_LA)); float TA = 1.f, TB = 0.f;
#pragma unroll
                for (int ti = 0; ti < 4; ++ti) { const int tm = LRU_TM(ti); float sa = 1.f, sb = 0.f;
#pragma unroll
                    for (int ji = 0; ji < 4; ++ji) { const int j = LRU_TM(ji); LRU_COMPOSE(sa, sb, acc[0][tm][j], acc[1][tm][j]); }
#pragma unroll
                    for (int qi = 0; qi < 4; ++qi) { const int qq = LRU_TM(qi); const float xa = lane_get(sa, c16 + 16 * qq), xb = lane_get(sb, c16 + 16 * qq); LRU_COMPOSE(TA, TB, xa, xb); } }
                if (q == 0) AGG[(((size_t)b * 36 + chunk) * 2 + dr) * DM + ch] = make_float2(TA, TB); }
            } else {
                float H = ((const LAS float*)(L + HIN_OFF))[ui * 256 + dr * 128 + chl];
#pragma unroll
                for (int ti = 0; ti < 4; ++ti) { const int tm = LRU_TM(ti); float sa = 1.f, sb = 0.f;
#pragma unroll
                    for (int ji = 0; ji < 4; ++ji) { const int j = LRU_TM(ji); LRU_COMPOSE(sa, sb, acc[0][tm][j], acc[1][tm][j]); }
                    float ea = 1.f, eb = 0.f, ta = 1.f, tb = 0.f;
#pragma unroll
                    for (int qi = 0; qi < 4; ++qi) { const int qq = LRU_TM(qi); const float xa = lane_get(sa, c16 + 16 * qq), xb = lane_get(sb, c16 + 16 * qq); if (qq == q) { ea = ta; eb = tb; } LRU_COMPOSE(ta, tb, xa, xb); }
                    float hs = ea * H + eb;
#pragma unroll
                    for (int ji = 0; ji < 4; ++ji) { const int j = LRU_TM(ji); hs = acc[0][tm][j] * hs + acc[1][tm][j]; LAS float* yp = (LAS float*)(L + YO_OFF + (tm * 16 + q * 4 + j) * YO_PITCH + chl * 4);
                        if (dr == 0) *yp = hs; else *yp += hs; }
                    H = ta * H + tb; }
            }
#undef LRU_TM
        }
        if constexpr (FINAL) {
            __syncthreads();
            bf16_t* YB0 = WSB(WS_YB);
#pragma unroll
            for (int i = 0; i < 2; ++i) { const int cidx = tid + 512 * i, row = cidx >> 4, cgo = cidx & 15; const size_t rgl = rb + t0 + row;
                const f32x4 y0 = *(const LAS f32x4*)(L + YO_OFF + row * YO_PITCH + cgo * 32), y1 = *(const LAS f32x4*)(L + YO_OFF + row * YO_PITCH + cgo * 32 + 16);
                const v4u z = zcur[i];
                v4u o; o.x = pk2(y0[0] * blo(z.x), y0[1] * bhi(z.x)); o.y = pk2(y0[2] * blo(z.y), y0[3] * bhi(z.y)); o.z = pk2(y1[0] * blo(z.z), y1[1] * bhi(z.z)); o.w = pk2(y1[2] * blo(z.w), y1[3] * bhi(z.w));
                *(v4u*)(YB0 + rgl * DM + blk * 128 + cgo * 8) = o; }
        }
    }
#undef LRU_LOAD
}
constexpr int CW_LRUFLAG = 32768, LRU_FLAG_STRIDE = 16;
__device__ __forceinline__ void p_lru_lookback(Frame& F, CArgs* ka, int l) {
    const int tid = tid_fresh(), lane = tid & 63, w = __builtin_amdgcn_readfirstlane(tid >> 6), c16 = lane & 15, q = lane >> 4;
    const int npar = F.G / 36; if (F.wg >= npar * 36) return;
    const int slot = F.wg / 36, chunk = F.wg - slot * 36, cps = (64 + npar - 1) / npar;
    LAS unsigned char* L = F.lds; const bf16_t* P = WSB(WS_P);
    unsigned* ctl = (unsigned*)(ka->ws + WS_CTL); unsigned long long* AGG = (unsigned long long*)WSF(WS_LA) + (size_t)l * 64 * 36 * 2 * 128;
    const unsigned epoch = (unsigned)(l + 1);
    const int cg = tid & 15, rg = tid >> 4, chl = 16 * w + c16;
    const int t0 = chunk * 64, lo = chunk < 32 ? 0 : SEQ, hi = chunk < 32 ? SEQ : TPB;
    int cur_blk = -1;
    v4u raw[5];
#define LRU_LOADX(colx) do { const int _b = (colx) & 3, _blk = (colx) >> 2; const size_t _rb = (size_t)_b * TPB; \
        _Pragma("unroll") for (int x = 0; x < 5; ++x) { const int tt = t0 + 2 * rg - 2 + x; raw[x] = (v4u){0u, 0u, 0u, 0u}; if (tt >= lo && tt < hi) raw[x] = *(const v4u*)(P + (_rb + tt) * NP + C_LX + _blk * 128 + cg * 8); } } while (0)
    const int col0 = slot * cps, col1 = (col0 + cps) < 64 ? (col0 + cps) : 64;
    if (col0 < col1) LRU_LOADX(col0);
#pragma unroll 1
    for (int col = col0; col < col1; ++col) {
        const int b = col & 3, blk = col >> 2, ch = blk * 128 + chl; const size_t rb = (size_t)b * TPB;
        __syncthreads();
        bf16x8 bw[4][4]; float cbr[2], cbi[2], csp[2];
        { const bf16_t* Wt = WSB(WS_WLRU) + (size_t)l * 4 * 16 * 16384 + ((size_t)blk * 128 + chl) * 128 + q * 8;
#pragma unroll
          for (int g = 0; g < 4; ++g)
#pragma unroll
              for (int ks = 0; ks < 4; ++ks) bw[g][ks] = *(const bf16x8*)(Wt + (size_t)g * 16 * 16384 + ks * 32);
#pragma unroll
          for (int dr = 0; dr < 2; ++dr) { cbr[dr] = KIN(12)[((size_t)l * 2 + dr) * DM + ch]; cbi[dr] = KIN(14)[((size_t)l * 2 + dr) * DM + ch]; csp[dr] = log1pf(__expf(-KIN(15)[((size_t)l * 2 + dr) * DM + ch])); } }
        if (blk != cur_blk) { cur_blk = blk;
            for (int i = tid; i < 5 * 128; i += 512) { const int kk = i >> 7, c = i & 127; ((LAS float*)(L + CW_OFF))[i] = kk < 4 ? KIN(9)[((size_t)l * 4 + kk) * DM + blk * 128 + c] : KIN(10)[(size_t)l * DM + blk * 128 + c]; }
            __syncthreads(); }
        {
          float o0[8], o1[8]; const LAS float* cwl = (const LAS float*)(L + CW_OFF) + cg * 8;
#pragma unroll
          for (int e = 0; e < 8; ++e) { o0[e] = cwl[4 * 128 + e]; o1[e] = o0[e]; }
#pragma unroll
          for (int kk = 0; kk < 5; ++kk) { float xin[8];
#pragma unroll
              for (int e = 0; e < 4; ++e) { xin[2 * e] = blo(raw[kk][e]); xin[2 * e + 1] = bhi(raw[kk][e]); }
#pragma unroll
              for (int e = 0; e < 8; ++e) { if (kk < 4) o0[e] += cwl[kk * 128 + e] * xin[e]; if (kk > 0) o1[e] += cwl[(kk - 1) * 128 + e] * xin[e]; } }
          v4u p0, p1; p0.x = pk2(o0[0], o0[1]); p0.y = pk2(o0[2], o0[3]); p0.z = pk2(o0[4], o0[5]); p0.w = pk2(o0[6], o0[7]); p1.x = pk2(o1[0], o1[1]); p1.y = pk2(o1[2], o1[3]); p1.z = pk2(o1[4], o1[5]); p1.w = pk2(o1[6], o1[7]);
          *(LAS v4u*)(L + XB_OFF + (2 * rg) * XB_PITCH + cg * 16) = p0; *(LAS v4u*)(L + XB_OFF + (2 * rg + 1) * XB_PITCH + cg * 16) = p1;
          LAS float* f0 = (LAS float*)(L + XF_OFF + (2 * rg) * XF_PITCH + cg * 32); LAS float* f1 = (LAS float*)(L + XF_OFF + (2 * rg + 1) * XF_PITCH + cg * 32);
          *(LAS f32x4*)f0 = (f32x4){o0[0], o0[1], o0[2], o0[3]}; *(LAS f32x4*)(f0 + 4) = (f32x4){o0[4], o0[5], o0[6], o0[7]};
          *(LAS f32x4*)f1 = (f32x4){o1[0], o1[1], o1[2], o1[3]}; *(LAS f32x4*)(f1 + 4) = (f32x4){o1[4], o1[5], o1[6], o1[7]}; }
        __syncthreads();
        { const int coln = col + 1 < col1 ? col + 1 : col; LRU_LOADX(coln); }
        f32x4 av[2][4], bv[2][4];
#pragma unroll
        for (int dr = 0; dr < 2; ++dr) {
#pragma unroll
            for (int tm = 0; tm < 4; ++tm) { av[dr][tm] = (f32x4){0.f, 0.f, 0.f, 0.f}; bv[dr][tm] = (f32x4){0.f, 0.f, 0.f, 0.f}; }
#pragma unroll
            for (int ks = 0; ks < 4; ++ks) { bf16x8 a[4];
#pragma unroll
                for (int tm = 0; tm < 4; ++tm) a[tm] = *(const LAS bf16x8*)(L + XB_OFF + (tm * 16 + c16) * XB_PITCH + (ks * 32 + q * 8) * 2);
#pragma unroll
                for (int tm = 0; tm < 4; ++tm) { av[dr][tm] = __builtin_amdgcn_mfma_f32_16x16x32_bf16(a[tm], bw[2 * dr][ks], av[dr][tm], 0, 0, 0); bv[dr][tm] = __builtin_amdgcn_mfma_f32_16x16x32_bf16(a[tm], bw[2 * dr + 1][ks], bv[dr][tm], 0, 0, 0); } }
#pragma unroll
            for (int tm = 0; tm < 4; ++tm)
#pragma unroll
                for (int j = 0; j < 4; ++j) { const int t = tm * 16 + q * 4 + j; const float xv = *(const LAS float*)(L + XF_OFF + t * XF_PITCH + chl * 4);
                    const float rgt = pg8::sigmoid_f(av[dr][tm][j] + cbr[dr]), igt = pg8::sigmoid_f(bv[dr][tm][j] + cbi[dr]), la = -8.f * rgt * csp[dr], aa = __expf(la), x2 = 2.f * la;
                    const float om = x2 > -0.1f ? -x2 * (1.f + x2 * (0.5f + x2 * (0.16666667f + x2 * (0.041666668f + x2 * 0.0083333338f)))) : 1.f - aa * aa;
                    av[dr][tm][j] = aa; bv[dr][tm][j] = sqrtf(om) * igt * xv; }
#define LRU_TM(i) (dr ? 3 - (i) : (i))
            float TA = 1.f, TB = 0.f;
#pragma unroll
            for (int ti = 0; ti < 4; ++ti) { const int tm = LRU_TM(ti); float sa = 1.f, sb = 0.f;
#pragma unroll
                for (int ji = 0; ji < 4; ++ji) { const int j = LRU_TM(ji); LRU_COMPOSE(sa, sb, av[dr][tm][j], bv[dr][tm][j]); }
#pragma unroll
                for (int qi = 0; qi < 4; ++qi) { const int qq = LRU_TM(qi); const float xa = lane_get(sa, c16 + 16 * qq), xb = lane_get(sb, c16 + 16 * qq); LRU_COMPOSE(TA, TB, xa, xb); } }
            __builtin_amdgcn_sched_barrier(0);
            if (q == 0) __hip_atomic_store(AGG + (((size_t)col * 36 + chunk) * 2 + dr) * 128 + chl, ((unsigned long long)__float_as_uint(TB) << 32) | __float_as_uint(TA), __ATOMIC_RELAXED, __HIP_MEMORY_SCOPE_AGENT);
        }
        asm volatile("s_waitcnt vmcnt(0)" ::: "memory");
        __syncthreads();
        if (tid == 0) __hip_atomic_store(ctl + CW_LRUFLAG + (col * 36 + chunk) * LRU_FLAG_STRIDE, epoch, __ATOMIC_RELAXED, __HIP_MEMORY_SCOPE_AGENT);
        v4u zcur[2];
#pragma unroll
        for (int x = 0; x < 2; ++x) { const int cidx = tid + 512 * x; zcur[x] = *(const v4u*)(P + (rb + t0 + (cidx >> 4)) * NP + C_LZ + blk * 128 + (cidx & 15) * 8); }
        if (w == 0) {
            unsigned* fp = ctl + CW_LRUFLAG + (col * 36 + (lane < 36 ? lane : 0)) * LRU_FLAG_STRIDE; unsigned spins = 0;
            for (;;) { const bool ok = __hip_atomic_load(fp, __ATOMIC_RELAXED, __HIP_MEMORY_SCOPE_AGENT) >= epoch; if (__all(ok)) break;
                __builtin_amdgcn_s_sleep(1);
                if ((++spins & 255u) == 0u) { if (__hip_atomic_load(ctl, __ATOMIC_RELAXED, __HIP_MEMORY_SCOPE_AGENT) != 0u) break; if (spins > (1u << 20)) { if (lane == 0) __hip_atomic_store(ctl, 0x1200u + (unsigned)l, __ATOMIC_RELAXED, __HIP_MEMORY_SCOPE_AGENT); break; } } }
            __builtin_amdgcn_fence(__ATOMIC_ACQUIRE, "agent");
            asm volatile("s_waitcnt vmcnt(0)" ::: "memory"); }
        __syncthreads();
        if (tid < 256) {
            const int dirx = tid >> 7, cl = tid & 127; const unsigned long long* ap = AGG + ((size_t)col * 36 * 2 + dirx) * 128 + cl; float hcar = 0.f, hmine = 0.f;
#pragma unroll 12
            for (int k = 0; k < 36; ++k) { const int cidx = ml::chunk_of(k, dirx); const unsigned long long ab = ap[(size_t)cidx * 256];
                if (cidx == chunk) hmine = hcar;
                hcar = __uint_as_float((unsigned)ab) * hcar + __uint_as_float((unsigned)(ab >> 32)); }
            ((LAS float*)(L + HIN_OFF))[dirx * 128 + cl] = hmine; }
        __syncthreads();
#pragma unroll
        for (int dr = 0; dr < 2; ++dr) {
            float H = ((const LAS float*)(L + HIN_OFF))[dr * 128 + chl];
#pragma unroll
            for (int ti = 0; ti < 4; ++ti) { const int tm = LRU_TM(ti); float sa = 1.f, sb = 0.f;
#pragma unroll
                for (int ji = 0; ji < 4; ++ji) { const int j = LRU_TM(ji); LRU_COMPOSE(sa, sb, av[dr][tm][j], bv[dr][tm][j]); }
                float ea = 1.f, eb = 0.f, ta = 1.f, tb = 0.f;
#pragma unroll
                for (int qi = 0; qi < 4; ++qi) { const int qq = LRU_TM(qi); const float xa = lane_get(sa, c16 + 16 * qq), xb = lane_get(sb, c16 + 16 * qq); if (qq == q) { ea = ta; eb = tb; } LRU_COMPOSE(ta, tb, xa, xb); }
                float hs = ea * H + eb;
#pragma unroll
                for (int ji = 0; ji < 4; ++ji) { const int j = LRU_TM(ji); hs = av[dr][tm][j] * hs + bv[dr][tm][j]; LAS float* yp = (LAS float*)(L + YO_OFF + (tm * 16 + q * 4 + j) * YO_PITCH + chl * 4);
                    if (dr == 0) *yp = hs; else *yp += hs; }
                H = ta * H + tb; }
        }
#undef LRU_TM
        __syncthreads();
        bf16_t* YB0 = WSB(WS_YB);
#pragma unroll
        for (int i = 0; i < 2; ++i) { const int cidx = tid + 512 * i, row = cidx >> 4, cgo = cidx & 15; const size_t rgl = rb + t0 + row;
            const f32x4 y0 = *(const LAS f32x4*)(L + YO_OFF + row * YO_PITCH + cgo * 32), y1 = *(const LAS f32x4*)(L + YO_OFF + row * YO_PITCH + cgo * 32 + 16);
            const v4u z = zcur[i];
            v4u o; o.x = pk2(y0[0] * blo(z.x), y0[1] * bhi(z.x)); o.y = pk2(y0[2] * blo(z.y), y0[3] * bhi(z.y)); o.z = pk2(y1[0] * blo(z.z), y1[1] * bhi(z.z)); o.w = pk2(y1[2] * blo(z.w), y1[3] * bhi(z.w));
            *(v4u*)(YB0 + rgl * DM + blk * 128 + cgo * 8) = o; }
    }
#undef LRU_LOADX
}
template <int LV> __device__ __forceinline__ void p_lru_agg(Frame& F, CArgs* ka, int l) {
    for (int v = F.wg; v < 256; v += F.G) { const int blk = v & 15, c0 = v >> 4;
        lru_run<false, LV>(F, ka, l, blk, 9, [c0](int i, int& b, int& c) { const int x = c0 + 16 * i; b = x / 36; c = x - b * 36; }); }
}
__device__ __forceinline__ void p_lru_final(Frame& F, CArgs* ka, int l, bool need_ctx) {
    for (int v = F.wg; v < 256; v += F.G) { const int b = v >> 6, blk = (v >> 2) & 15, qt = v & 3;
        const int tid = tid_fresh();
        __syncthreads();
        if (tid < 256) { const int dirx = tid >> 7, chl = tid & 127; const float2* AGG = (const float2*)WSF(WS_LA) + ((size_t)b * 36 * 2 + dirx) * DM + blk * 128 + chl;
            LAS float* HIN = (LAS float*)(F.lds + HIN_OFF); float hcar = 0.f;
#pragma unroll 12
            for (int k = 0; k < 36; ++k) { const int cidx = ml::chunk_of(k, dirx); const float2 ab = AGG[(size_t)cidx * 2 * DM];
                const int sl = cidx - qt * 9; if (sl >= 0 && sl < 9) HIN[sl * 256 + dirx * 128 + chl] = hcar;
                hcar = ab.x * hcar + ab.y; } }
        lru_run<true, 0>(F, ka, l, blk, (need_ctx || qt < 3) ? 9 : 5, [b, qt](int i, int& bb, int& c) { bb = b; c = qt * 9 + i; });
    }
}
}

#ifndef GEMM_NHALF
#define GEMM_NHALF false
#endif
#ifndef CONVERT_AHEAD
#define CONVERT_AHEAD 1
#endif
#ifndef DUP_NORM
#define DUP_NORM 0
#endif
#ifndef DUP_KNORM
#define DUP_KNORM 0
#endif
#ifndef LRU_LOOKBACK
#define LRU_LOOKBACK 0
#endif
#ifndef DUP_G1NULL
#define DUP_G1NULL 0
#endif
#ifndef DUP_G1FIX
#define DUP_G1FIX 0
#endif
#ifndef DUP_BAR
#define DUP_BAR 0
#endif
#ifndef DUP_MLOUT
#define DUP_MLOUT 0
#endif
#ifndef DUP_LRU2
#define DUP_LRU2 0
#endif
#ifndef ML_PIPE
#define ML_PIPE 1
#endif
#ifndef ML_VAR
#define ML_VAR 0
#endif
#ifndef LRU_VAR
#define LRU_VAR -1
#endif
#ifndef CONV_SPLIT
#define CONV_SPLIT 0
#endif
#ifndef DUP_PRO
#define DUP_PRO 0
#endif
#ifndef DUP_THIN
#define DUP_THIN 0
#endif
#ifndef DUP_G1
#define DUP_G1 0
#endif
#ifndef DUP_HEAVY
#define DUP_HEAVY 0
#endif
#ifndef DUP_ATT
#define DUP_ATT 0
#endif
#ifndef DUP_ML
#define DUP_ML 0
#endif
#ifndef DUP_LRU1
#define DUP_LRU1 0
#endif
#ifndef DUP_G23
#define DUP_G23 0
#endif
__global__ void __launch_bounds__(NWAVES * 64, 2) fwd(Args args) {
    extern __shared__ __attribute__((aligned(16))) unsigned char lds[];
    Frame F;
    F.lds = (LAS unsigned char*)lds; F.ldsg = (char*)lds;
    F.tid = threadIdx.x; F.lane = F.tid & 63; F.wave = __builtin_amdgcn_readfirstlane(F.tid >> 6); F.G = gridDim.x; F.wg = blockIdx.x;
    CArgs* const ka0 = (CArgs*)__builtin_amdgcn_kernarg_segment_ptr();
    unsigned char* ws; { CArgs* ka = ka0; ws = ka->ws; }
    volatile LAS unsigned* MISC = (volatile LAS unsigned*)(F.lds + MISC_OFF);
    if (F.tid < 64) ((LAS unsigned*)(F.lds + MISC_OFF))[F.tid] = 0u;
    __syncthreads();
    const int lo = ka0->ph_lo, hi = ka0->ph_hi;
    XcdBarrier bar; bar.bar = (unsigned*)(ws + WS_CTL) + CW_BAR; bar.x = 0; bar.st = nullptr;
    if (hi - lo > 1) bar = xcd_barrier_post((unsigned*)(ws + WS_CTL) + CW_BAR, MISC + 8);
#define IN(k) (lo <= (k) && (k) < hi)
#define SEAM(k) do { if ((k) + 1 < hi) { xcd_barrier(bar); if (DUP_BAR) xcd_barrier(bar); } } while (0)

    if (IN(0)) { for (int rep = 0; rep <= DUP_PRO; ++rep) { const int wv = F.wg * NWAVES + F.wave, nwv = F.G * NWAVES;
            for (int lc = 0; lc < (CONVERT_AHEAD ? 1 : DEPTH); ++lc) p_convert(F, KA(), lc, wv, nwv);
            p_prologue(F, KA()); }
        SEAM(0); }
#pragma unroll 1
    for (int l = 0; l < DEPTH; ++l) {
        const int base = 1 + l * PH_PER_LAYER; const bool need_ctx = l < DEPTH - 1;
        if (IN(base + 0)) { p_norm(F, KA(), l); if (DUP_NORM) p_norm(F, KA(), l + 1 <= DEPTH - 1 && l > 0 ? l : l, true); SEAM(base + 0); }
        if (IN(base + 1)) {
            CArgs* ka = KA(); pg8::Gemm g{WSB(WS_H), WSB(WS_WIN) + (size_t)l * NP * DM, MROWS, NP, DM, 0, 0}; pg8::InOrder S; S.init(MROWS, NP, F.G, F.wg, 256, !need_ctx);
            pg8::EpiIn E{WSB(WS_P)};
            pg8::gemm_phase<pg8::EpiIn, pg8::InOrder, true, true>(F.lds, g, S, E);
            if (DUP_G1) pg8::gemm_phase<pg8::EpiIn, pg8::InOrder, true, true>(F.lds, g, S, E);
            if (DUP_G1NULL) { pg8::EpiNull EN{WSF(WS_ACC)}; pg8::gemm_phase<pg8::EpiNull, pg8::InOrder, true, true>(F.lds, g, S, EN); }
            if (DUP_G1FIX) { pg8::EpiNull EN{WSF(WS_ACC)}; pg8::FixedOrder SF; SF.init(MROWS, NP, F.G, F.wg); pg8::gemm_phase<pg8::EpiNull, pg8::FixedOrder, true, true>(F.lds, g, SF, EN); }
            if (need_ctx) {
                const int nu = (MROWS / 256) * (NP / 256), extra = nu % F.G;
                if (F.wg >= extra) { p_gates(F, KA(), l, F.wg - extra, F.G - extra);
                    if (CONVERT_AHEAD && l + 1 < DEPTH) p_convert(F, KA(), l + 1, (F.wg - extra) * NWAVES + F.wave, (F.G - extra) * NWAVES, 0, CONV_SPLIT); } }
            SEAM(base + 1);
        }
        if (IN(base + 2)) { if (!need_ctx) p_gates(F, KA(), l, F.wg, F.G); p_knorm(F, KA(), l); if (DUP_KNORM) p_knorm(F, KA(), l, true);
#if USE_NAIVE_LRU
            p_lru_gates_naive(F, KA(), l);
#endif
            SEAM(base + 2); }
        if (IN(base + 3)) { for (int rep = 0; rep <= DUP_HEAVY; ++rep) { for (int r2 = 0; r2 <= DUP_ATT; ++r2) p_attention(F, KA(), l, need_ctx);
#if USE_NAIVE_ML
            p_mlstm_naive(F, KA(), l);
#else
            for (int r2 = 0; r2 <= DUP_ML; ++r2) for (int v = F.wg; v < 256; v += F.G) {
                const int u = (F.G % 8 == 0) ? (((v & 7) * 8 + ((v >> 3) >> 2)) * 4 + ((v >> 3) & 3)) : v;
                if (ML_PIPE) ml::mlstm_unit_pipe<0>(F, KA(), u, need_ctx); else ml::mlstm_unit(F, KA(), u, need_ctx);
                if (ML_VAR) ml::mlstm_unit_pipe<ML_VAR>(F, KA(), u, need_ctx); }
#endif
#if USE_NAIVE_LRU
            p_lru_scan_naive(F, KA());
#else
#if LRU_LOOKBACK
            lru::p_lru_lookback(F, KA(), l);
#else
            lru::p_lru_agg<0>(F, KA(), l); if (LRU_VAR >= 0) lru::p_lru_agg<(LRU_VAR >= 0 ? LRU_VAR : 0)>(F, KA(), l);
#endif
#endif
            }
            SEAM(base + 3); }
        if (IN(base + 4)) { for (int rep = 0; rep <= DUP_THIN; ++rep) { for (int r2 = 0; r2 <= DUP_MLOUT; ++r2) p_mlout(F, KA(), l, need_ctx);
#if USE_NAIVE_LRU
            p_lru_combine_naive(F, KA());
#else
#if !LRU_LOOKBACK
            lru::p_lru_final(F, KA(), l, need_ctx); if (DUP_LRU2) lru::p_lru_final(F, KA(), l, need_ctx);
#endif
#endif
            }
            SEAM(base + 4); }
        if (IN(base + 5)) {
            CArgs* ka = KA(); pg8::Gemm g{WSB(WS_YB), WSB(WS_WBR) + (size_t)l * 3 * DM * DM, MROWS, DM, DM, (size_t)MROWS * DM * 2, (size_t)DM * DM * 2}; pg8::MergeOrder S; S.init(MROWS, DM, F.G, F.wg, GEMM_NHALF ? 128 : 256, !need_ctx);
            pg8::EpiMerge<GEMM_NHALF> E{WSB(WS_P), WSF(WS_ACC), WSB(WS_G2)};
            pg8::gemm_phase<pg8::EpiMerge<GEMM_NHALF>, pg8::MergeOrder, true, true, GEMM_NHALF>(F.lds, g, S, E);
            if (DUP_G23) pg8::gemm_phase<pg8::EpiMerge<GEMM_NHALF>, pg8::MergeOrder, true, true, GEMM_NHALF>(F.lds, g, S, E);
            if (CONVERT_AHEAD && l + 1 < DEPTH) {
                const int ntile = (MROWS / 256) * (DM / (GEMM_NHALF ? 128 : 256)), busy2 = (ntile > F.G && ntile < 2 * F.G) ? ntile - F.G : 0;
                if (F.wg >= busy2) p_convert(F, KA(), l + 1, (F.wg - busy2) * NWAVES + F.wave, (F.G - busy2) * NWAVES, CONV_SPLIT); }
            SEAM(base + 5);
        }
        if (IN(base + 6)) {
            CArgs* ka = KA(); pg8::Gemm g{WSB(WS_G2), WSB(WS_WOUT) + (size_t)l * DM * DM, MROWS, DM, DM, 0, 0}; pg8::StaticOrder S; S.init(MROWS, DM, F.G, F.wg, GEMM_NHALF ? 128 : 256, !need_ctx);
            pg8::EpiF32<GEMM_NHALF> E{WSF(WS_Y), DM};
            pg8::gemm_phase<pg8::EpiF32<GEMM_NHALF>, pg8::StaticOrder, true, true, GEMM_NHALF>(F.lds, g, S, E);
            if (DUP_G23) pg8::gemm_phase<pg8::EpiF32<GEMM_NHALF>, pg8::StaticOrder, true, true, GEMM_NHALF>(F.lds, g, S, E);
            SEAM(base + 6);
        }
    }
    if (IN(N_PHASES - 1)) p_norm(F, KA(), DEPTH);
#undef IN
#undef SEAM
}

extern "C" void kernel_launch(void* const* d_in, const int* in_sizes, int n_in, void* d_out, int out_size, void* d_ws, size_t ws_size, hipStream_t stream) {
    static int grid = 0;
    if (grid == 0) {
        if (n_in != 22 || in_sizes[0] != NBATCH * SEQ * DM || out_size != NBATCH * SEQ * DM || ws_size < WS_END) {
            fprintf(stderr, "kernel_launch: unexpected shapes: n_in %d in0 %d out %d ws %zu (need %zu)\n", n_in, n_in > 0 ? in_sizes[0] : -1, out_size, ws_size, (size_t)WS_END); grid = -1; return; }
        int dev = 0, cus = 0, per_cu = 0;
        if (hipGetDevice(&dev) != hipSuccess || hipDeviceGetAttribute(&cus, hipDeviceAttributeMultiprocessorCount, dev) != hipSuccess) { fprintf(stderr, "kernel_launch: device query failed\n"); grid = -1; return; }
        if (hipFuncSetAttribute((const void*)fwd, hipFuncAttributeMaxDynamicSharedMemorySize, LDS_BYTES) != hipSuccess) { fprintf(stderr, "kernel_launch: hipFuncSetAttribute failed\n"); grid = -1; return; }
        if (hipOccupancyMaxActiveBlocksPerMultiprocessor(&per_cu, (const void*)fwd, NWAVES * 64, LDS_BYTES) != hipSuccess || per_cu < 1)
            fprintf(stderr, "kernel_launch: note: occupancy query reports %d workgroups per CU\n", per_cu);
        (void)hipGetLastError();
        grid = cus;
    }
    if (grid < 0) return;
    if (hipMemsetAsync((char*)d_ws + WS_CTL, 0, CTL_ZERO_BYTES, stream) != hipSuccess) { fprintf(stderr, "kernel_launch: memset failed\n"); return; }
    Args a{};
    for (int i = 0; i < 22; ++i) a.in[i] = (const float*)d_in[i];
    a.out = (float*)d_out; a.ws = (unsigned char*)d_ws;
    if (MK_N_LAUNCHES == 1) { a.ph_lo = 0; a.ph_hi = N_PHASES; hipLaunchKernelGGL(fwd, dim3(grid), dim3(NWAVES * 64), LDS_BYTES, stream, a); }
    else for (int k = 0; k < N_PHASES; ++k) { a.ph_lo = k; a.ph_hi = k + 1; hipLaunchKernelGGL(fwd, dim3(grid), dim3(NWAVES * 64), LDS_BYTES, stream, a); }
    const hipError_t le = hipPeekAtLastError();
    if (le != hipSuccess) fprintf(stderr, "kernel_launch: launch failed: %s\n", hipGetErrorName(le));
}
```

```cpp
#include <hip/hip_runtime.h>
#include <hip/hip_bf16.h>
#include <cstdio>
#include <cstdint>

constexpr int DM = 2048, NBATCH = 4, SEQ = 2048, CTXL = 256, TPB = SEQ + CTXL  , MROWS = NBATCH * TPB  , DEPTH = 4;
constexpr int NIN = 25632, NP = 25600;
constexpr int C_LX = 0, C_LZ = 2048, C_MQ = 4096, C_MK = 6144, C_MV = 8192, C_MO = 10240, C_MZ = 12288, C_AQ = 14336, C_AK = 16384, C_AV = 16896, C_AZ = 17408, C_MG = 19456;
constexpr float EPS = 1e-6f;
#ifndef SPLIT_CTX
#define SPLIT_CTX 1
#endif
#ifndef Y_BF16
#define Y_BF16 1
#endif

namespace pg8 {
#define PG8_LAS __attribute__((address_space(3)))
typedef unsigned short bf16_t;
typedef short bf16x8 __attribute__((ext_vector_type(8)));
typedef float f32x4 __attribute__((ext_vector_type(4)));
typedef unsigned u32x4 __attribute__((ext_vector_type(4)));
constexpr int BM = 256, BK = 64, HALF = 128, HTB = HALF * BK * 2  , STAGE_BYTES = 8 * HTB, NXCD = 8, WGM = 8;

__host__ __device__ __forceinline__ int lds_byte(int r, int c) { const int st = (r >> 4) * 2 + (c >> 5), rr = r & 15, cc = c & 31, ob = rr * 64 + cc * 2; return st * 1024 + (ob ^ (((ob >> 9) & 1) << 5)); }
__host__ __device__ __forceinline__ void stage_rc(int b, int& R, int& C) { const int st = b / 1024, sb = b % 1024, swz = sb ^ (((sb >> 9) & 1) << 5); R = (st >> 1) * 16 + swz / 64; C = (st & 1) * 32 + (swz % 64) / 2; }
__host__ __device__ __forceinline__ int perm32(int rho) { const int n = rho >> 4, i = rho & 15; return 8 * (i >> 2) + 4 * n + (i & 3); }

struct Unit { int pm, pn, z, sp; };
struct Gemm { const bf16_t* A; const bf16_t* Bt; int M, N, K; size_t zA, zB; int ld; };

struct StaticOrder {
    int nM, nN, nwg, G, c; bool lat;
    __host__ __device__ void init(int M, int N, int G_, int c_, int tileN = BM, bool lat_ = false) { lat = lat_; nM = lat ? (M / BM) * 8 / 9 : M / BM; nN = N / tileN; nwg = nM * nN; G = G_; c = c_; }
    __host__ __device__ bool map_x(long L, Unit& u, int nM_, int nwg_, bool lat_) const {
        if (L >= nwg_) return false;
        int wgid = (int)L; { const int q = nwg_ / NXCD, r = nwg_ % NXCD, xcd = wgid % NXCD, off = wgid / NXCD; wgid = (xcd < r ? xcd * (q + 1) : r * (q + 1) + (xcd - r) * q) + off; }
        const int nig = WGM * nN, gid = wgid / nig, fm = gid * WGM, gsz = (nM_ - fm) < WGM ? (nM_ - fm) : WGM;
        u.pm = fm + ((wgid % nig) % gsz); u.pn = (wgid % nig) / gsz; u.z = 0; u.sp = 0; if (lat_) u.pm = (u.pm >> 3) * 9 + (u.pm & 7); return true;
    }
    __host__ __device__ bool map(long L, Unit& u) const { return map_x(L, u, nM, nwg, lat); }
    __host__ __device__ bool next(int i, Unit& u) const { return map((long)i * G + c, u); }
    __device__ __forceinline__ void a_ready(const Unit&) const {}
    __device__ __forceinline__ void done(const Unit&) const {}
};
struct InOrder : StaticOrder {
    int rounds;
    __host__ __device__ bool next(int i, Unit& u) const { if (rounds > 0 && i >= rounds) return false; const long L = (long)i * G + c; if (L < nwg) return map(L, u);
        if (!lat) return false; const int idx = (int)(L - nwg); if (idx >= 4 * 28) return false;
        const int bb = idx / 28, j = idx - bb * 28; u.pm = 9 * bb + 8; u.z = 0; u.sp = 0; u.pn = j < 8 ? j : j < 16 ? 16 + j : j < 24 ? 16 + j : j < 26 ? 40 + j : 40 + j; return true; }
};
struct TailOrder : StaticOrder {
    int full, extra, KS;
    __host__ __device__ bool next(int i, Unit& u) const { if (i > 0 || c >= extra * KS) return false; const int j = c / KS; if (!map((long)full * G + j, u)) return false; u.z = c - j * KS; u.sp = j; return true; }
};
struct FixedOrder : StaticOrder {
    __host__ __device__ bool next(int i, Unit& u) const { if (!StaticOrder::next(i, u)) return false; u.pm = 0; u.pn = 0; return true; }
};
struct MergeOrder : StaticOrder {
    __host__ __device__ bool split_ok() const { return SPLIT_CTX && !lat && nM == 36 && nN == 8 && G == 256; }
    __host__ __device__ bool next(int i, Unit& u) const {
        if (!split_ok()) { const int it = i / 3; if (!StaticOrder::next(it, u)) return false; u.z = i - 3 * it; return true; }
        if (i < 3) { if (!map_x((long)c, u, 32, 256, true)) return false; u.z = i; return true; }
        if (i > 3 || c >= 96) return false;
        const int s = c & 31; u.pm = 9 * (s >> 3) + 8; u.pn = s & 7; u.z = c >> 5; u.sp = 1; return true; }
};
struct SplitOutOrder : StaticOrder {
    __host__ __device__ bool split_ok() const { return SPLIT_CTX && !lat && nM == 36 && nN == 8 && G == 256; }
    __host__ __device__ bool next(int i, Unit& u) const {
        if (!split_ok()) return StaticOrder::next(i, u);
        if (i == 0) return map_x((long)c, u, 32, 256, true);
        if (i > 1 || c >= 96) return false;
        const int s = c & 31; u.pm = 9 * (s >> 3) + 8; u.pn = s & 7; u.z = 1 + (c >> 5); u.sp = 1; return true; }
};
__device__ __forceinline__ unsigned cvt_pk_bf16(float lo, float hi) { unsigned r; asm volatile("v_cvt_pk_bf16_f32 %0, %1, %2" : "=v"(r) : "v"(lo), "v"(hi)); return r; }
__device__ __forceinline__ float bflo(unsigned w) { return __uint_as_float(w << 16); }
__device__ __forceinline__ float bfhi(unsigned w) { return __uint_as_float(w & 0xffff0000u); }
__device__ __forceinline__ float sigmoid_f(float x) { return __builtin_amdgcn_rcpf(1.f + __expf(-x)); }

template <bool NHALF> struct EpiF32 {
    static constexpr bool PERM = false, AFTER_DRAIN = false;
    float* C; int ldc; size_t slab;
    __device__ __forceinline__ void operator()(const f32x4 (&acc)[2][2][4][2], const Unit& u, int wr, int wc, int fr, int fq) const {
        const int row0 = u.pm * BM + wr * 64 + fr, col0 = u.pn * (NHALF ? HALF : BM) + wc * 32 + 4 * fq;
        float* Cb = C + (u.sp ? (size_t)(u.z - 1) * slab : (size_t)0);
#pragma unroll
        for (int ai = 0; ai < 2; ++ai)
#pragma unroll
            for (int m = 0; m < 4; ++m) { float* rowp = Cb + (size_t)(row0 + ai * HALF + m * 16) * ldc + col0;
#pragma unroll
                for (int bj = 0; bj < (NHALF ? 1 : 2); ++bj)
#pragma unroll
                    for (int n = 0; n < 2; ++n) *(f32x4*)(rowp + bj * HALF + n * 16) = acc[ai][bj][m][n]; }
    }
};
struct EpiNull {
    static constexpr bool PERM = true, AFTER_DRAIN = false; float* sink;
    __device__ __forceinline__ void operator()(const f32x4 (&acc)[2][2][4][2], const Unit& u, int wr, int wc, int fr, int fq) const {
        float s = 0.f;
#pragma unroll
        for (int ai = 0; ai < 2; ++ai)
#pragma unroll
            for (int bj = 0; bj < 2; ++bj)
#pragma unroll
                for (int m = 0; m < 4; ++m)
#pragma unroll
                    for (int n = 0; n < 2; ++n) s += acc[ai][bj][m][n][0] + acc[ai][bj][m][n][1] + acc[ai][bj][m][n][2] + acc[ai][bj][m][n][3];
        if (s == 123.456f) sink[0] = s; }
};
template <long X8D> struct EpiIn {
    static constexpr bool PERM = true, AFTER_DRAIN = false;
    bf16_t* O;
    __device__ __forceinline__ void operator()(const f32x4 (&acc)[2][2][4][2], const Unit& u, int wr, int wc, int fr, int fq) const {
        const int pn = u.pn;
        int act = 0;
        if ((pn >= 8 && pn < 16) || (pn >= 48 && pn < 56) || (pn >= 68 && pn < 76)) act = 1;
        else if ((pn >= 40 && pn < 48) || pn >= 76) act = 2;
        else if (pn >= 24 && pn < 32) act = 3;
        const bool blocked = pn >= 16 && pn < 40;
        bf16_t* base = blocked ? O + X8D + (size_t)((pn - 16) >> 3) * MROWS * DM + ((size_t)((u.pm / 9) * 8 + ((pn - 16) & 7)) * 36 + (u.pm % 9) * 4) * (32 * 64 * 8)
                               : O + (size_t)u.pm * BM * NP + (size_t)pn * BM;
        const unsigned lane_off = blocked ? (unsigned)(wr * (32 * 64 * 8) + ((wc * 4 + fq) * 64 + fr) * 8) : (unsigned)((wr * 64 + fr) * NP + wc * 32 + 8 * fq);
        const unsigned sa = blocked ? 2u * 32 * 64 * 8 : (unsigned)HALF * NP, sm = blocked ? 16u * 8 : 16u * NP, sb = blocked ? 16u * 64 * 8 : (unsigned)HALF;
#pragma unroll
        for (int ai = 0; ai < 2; ++ai)
#pragma unroll
            for (int m = 0; m < 4; ++m) {
#pragma unroll
                for (int bj = 0; bj < 2; ++bj) { f32x4 v0 = acc[ai][bj][m][0], v1 = acc[ai][bj][m][1];
                    if (act == 1) {
#pragma unroll
                        for (int j = 0; j < 4; ++j) { v0[j] = v0[j] * sigmoid_f(v0[j]); v1[j] = v1[j] * sigmoid_f(v1[j]); } }
                    else if (act == 2) {
#pragma unroll
                        for (int j = 0; j < 4; ++j) { v0[j] = sigmoid_f(v0[j]); v1[j] = sigmoid_f(v1[j]); } }
                    else if (act == 3) { v0 = v0 * 0.0625f; v1 = v1 * 0.0625f; }
                    u32x4 w; w.x = cvt_pk_bf16(v0[0], v0[1]); w.y = cvt_pk_bf16(v0[2], v0[3]); w.z = cvt_pk_bf16(v1[0], v1[1]); w.w = cvt_pk_bf16(v1[2], v1[3]);
                    *(u32x4*)(base + (lane_off + ai * sa + m * sm + bj * sb)) = w; } }
    }
};
template <bool NHALF> struct EpiMerge {
    static constexpr bool PERM = true, AFTER_DRAIN = false;
    const bf16_t* P; float* ACC; bf16_t* G2;
    __device__ __forceinline__ void operator()(const f32x4 (&acc)[2][2][4][2], const Unit& u, int wr, int wc, int fr, int fq) const {
        const int row0 = u.pm * BM + wr * 64 + fr, col0 = u.pn * (NHALF ? HALF : BM) + wc * 32 + 8 * fq, z = u.z;
#pragma unroll
        for (int ai = 0; ai < 2; ++ai)
#pragma unroll
            for (int m = 0; m < 4; ++m) { const size_t r = (size_t)(row0 + ai * HALF + m * 16);
#pragma unroll
                for (int bj = 0; bj < (NHALF ? 1 : 2); ++bj) { const int c = col0 + bj * HALF;
                    const u32x4 g = *(const u32x4*)(P + r * NP + C_MG + z * DM + c);
                    f32x4 v0 = acc[ai][bj][m][0], v1 = acc[ai][bj][m][1];
                    v0[0] *= bflo(g.x); v0[1] *= bfhi(g.x); v0[2] *= bflo(g.y); v0[3] *= bfhi(g.y);
                    v1[0] *= bflo(g.z); v1[1] *= bfhi(g.z); v1[2] *= bflo(g.w); v1[3] *= bfhi(g.w);
                    if (u.sp) { u32x4 w; w.x = cvt_pk_bf16(v0[0], v0[1]); w.y = cvt_pk_bf16(v0[2], v0[3]); w.z = cvt_pk_bf16(v1[0], v1[1]); w.w = cvt_pk_bf16(v1[2], v1[3]);
                        *(u32x4*)(G2 + (size_t)(1 + z) * MROWS * DM + r * DM + c) = w;
                        continue; }
                    float* ap = ACC + r * DM + c;
                    if (z > 0) { v0 = v0 + *(const f32x4*)ap; v1 = v1 + *(const f32x4*)(ap + 4); }
                    if (z < 2) { *(f32x4*)ap = v0; *(f32x4*)(ap + 4) = v1; }
                    else { u32x4 w; w.x = cvt_pk_bf16(v0[0], v0[1]); w.y = cvt_pk_bf16(v0[2], v0[3]); w.z = cvt_pk_bf16(v1[0], v1[1]); w.w = cvt_pk_bf16(v1[2], v1[3]);
                        *(u32x4*)(G2 + r * DM + c) = w; } } }
    }
};
struct EpiMergeC {
    static constexpr bool PERM = true, AFTER_DRAIN = false, CHAIN = true;
    const bf16_t* P; bf16_t* G2;
    __device__ __forceinline__ static bool keep(const Unit& u) { return !u.sp && u.z < 2; }
    __device__ __forceinline__ void operator()(f32x4 (&acc)[2][2][4][2], const Unit& u, int wr, int wc, int fr, int fq) const {
        const int row0 = u.pm * BM + wr * 64 + fr, col0 = u.pn * BM + wc * 32 + 8 * fq, z = u.z;
        constexpr float FLOOR = 1e-12f;
#pragma unroll
        for (int ai = 0; ai < 2; ++ai)
#pragma unroll
            for (int m = 0; m < 4; ++m) { const size_t r = (size_t)(row0 + ai * HALF + m * 16);
#pragma unroll
                for (int bj = 0; bj < 2; ++bj) { const int c = col0 + bj * HALF;
                    const bf16_t* gp = P + r * NP + C_MG + z * DM + c;
                    const u32x4 g = *(const u32x4*)gp;
                    float s[8] = {bflo(g.x), bfhi(g.x), bflo(g.y), bfhi(g.y), bflo(g.z), bfhi(g.z), bflo(g.w), bfhi(g.w)};
                    if (u.sp) {
                        f32x4 v0 = acc[ai][bj][m][0], v1 = acc[ai][bj][m][1];
#pragma unroll
                        for (int j = 0; j < 4; ++j) { v0[j] *= s[j]; v1[j] *= s[4 + j]; }
                        u32x4 w; w.x = cvt_pk_bf16(v0[0], v0[1]); w.y = cvt_pk_bf16(v0[2], v0[3]); w.z = cvt_pk_bf16(v1[0], v1[1]); w.w = cvt_pk_bf16(v1[2], v1[3]);
                        *(u32x4*)(G2 + (size_t)(1 + z) * MROWS * DM + r * DM + c) = w;
                        continue; }
#pragma unroll
                    for (int j = 0; j < 8; ++j) s[j] = fmaxf(s[j], FLOOR);
                    if (z < 2) { const u32x4 h = *(const u32x4*)(gp + DM);
                        const float d[8] = {bflo(h.x), bfhi(h.x), bflo(h.y), bfhi(h.y), bflo(h.z), bfhi(h.z), bflo(h.w), bfhi(h.w)};
#pragma unroll
                        for (int j = 0; j < 8; ++j) s[j] *= __builtin_amdgcn_rcpf(fmaxf(d[j], FLOOR));
#pragma unroll
                        for (int j = 0; j < 4; ++j) { acc[ai][bj][m][0][j] *= s[j]; acc[ai][bj][m][1][j] *= s[4 + j]; } }
                    else { f32x4 v0 = acc[ai][bj][m][0], v1 = acc[ai][bj][m][1];
#pragma unroll
                        for (int j = 0; j < 4; ++j) { v0[j] *= s[j]; v1[j] *= s[4 + j]; }
                        u32x4 w; w.x = cvt_pk_bf16(v0[0], v0[1]); w.y = cvt_pk_bf16(v0[2], v0[3]); w.z = cvt_pk_bf16(v1[0], v1[1]); w.w = cvt_pk_bf16(v1[2], v1[3]);
                        *(u32x4*)(G2 + r * DM + c) = w; } } }
    }
};
struct EpiY16 {
    static constexpr bool PERM = true, AFTER_DRAIN = false;
    bf16_t* Y; size_t slab;
    __device__ __forceinline__ void operator()(const f32x4 (&acc)[2][2][4][2], const Unit& u, int wr, int wc, int fr, int fq) const {
        const int row0 = u.pm * BM + wr * 64 + fr, col0 = u.pn * BM + wc * 32 + 8 * fq;
        bf16_t* Yb = Y + (u.sp ? (size_t)(u.z - 1) * slab : (size_t)0);
#pragma unroll
        for (int ai = 0; ai < 2; ++ai)
#pragma unroll
            for (int m = 0; m < 4; ++m) { bf16_t* rowp = Yb + (size_t)(row0 + ai * HALF + m * 16) * DM + col0;
#pragma unroll
                for (int bj = 0; bj < 2; ++bj) { const f32x4 v0 = acc[ai][bj][m][0], v1 = acc[ai][bj][m][1];
                    u32x4 w; w.x = cvt_pk_bf16(v0[0], v0[1]); w.y = cvt_pk_bf16(v0[2], v0[3]); w.z = cvt_pk_bf16(v1[0], v1[1]); w.w = cvt_pk_bf16(v1[2], v1[3]);
                    *(u32x4*)(rowp + bj * HALF) = w; } }
    }
};

struct EpiPartial {
    static constexpr bool PERM = true, AFTER_DRAIN = false;
    float* S; int ntile;
    __device__ __forceinline__ void operator()(const f32x4 (&acc)[2][2][4][2], const Unit& u, int wr, int wc, int fr, int fq) const {
        float* T = S + ((size_t)u.z * ntile + u.sp) * (BM * BM) + (size_t)(wr * 64 + fr) * BM + wc * 32 + 8 * fq;
#pragma unroll
        for (int ai = 0; ai < 2; ++ai)
#pragma unroll
            for (int m = 0; m < 4; ++m)
#pragma unroll
                for (int bj = 0; bj < 2; ++bj) { float* q = T + (size_t)(ai * HALF + m * 16) * BM + bj * HALF; *(f32x4*)q = acc[ai][bj][m][0]; *(f32x4*)(q + 4) = acc[ai][bj][m][1]; }
    }
};
template <class T, class = void> struct epi_chain { static constexpr bool value = false; };
template <class T> struct epi_chain<T, decltype((void)T::CHAIN)> { static constexpr bool value = T::CHAIN; };
template <class Epi, class Sched, bool ALIGN_EPI = false, bool SP2 = false, bool NHALF = false>
__device__ __forceinline__ void gemm_phase(PG8_LAS unsigned char* lds, const Gemm g, const Sched& S, const Epi& E) {
    int tid = threadIdx.x; asm volatile("" : "+v"(tid));
    const int wid = __builtin_amdgcn_readfirstlane(tid >> 6), lane = tid & 63, wr = wid >> 2, wc = wid & 3, fr = lane & 15, fq = lane >> 4;
    const int K = g.K, LD = g.ld ? g.ld : g.K, nt = K / BK;
    unsigned voffA[2], voffB[2];
#pragma unroll
    for (int i = 0; i < 2; ++i) { int R, C; stage_rc(tid * 16 + i * 8192, R, C); const int Rb = Epi::PERM ? ((R & ~31) + perm32(R & 31)) : R;
        voffA[i] = (unsigned)(R * LD + C) * 2u; voffB[i] = (unsigned)(Rb * LD + C) * 2u; }
    const size_t kstep = (size_t)(BK * 2);
    const size_t hstep = (size_t)HALF * LD * 2;
    const size_t tstep = 2 * hstep;
    const size_t hsB = NHALF ? 0 : hstep, tstepB = NHALF ? hstep : tstep; static_assert(!NHALF || SP2, "NHALF is implemented for the SP2 loop");
    const unsigned ldsw = (unsigned)wid * 1024u;
    const int aoff = lds_byte(wr * 64 + fr, fq * 8), boff = lds_byte(wc * 32 + fr, fq * 8);
#define PG8_SA(b, h) (((b) * 2 + (h)) * HTB)
#define PG8_SB(b, h) ((4 + (b) * 2 + (h)) * HTB)
#define PG8_STAGE(bufoff, gbase, voff) do { _Pragma("unroll") for (int _i = 0; _i < 2; ++_i) \
        __builtin_amdgcn_global_load_lds((const unsigned*)((const char*)(gbase) + (voff)[_i]), (PG8_LAS unsigned*)(lds + (bufoff) + ldsw + _i * 8192), 16, 0, 0); } while (0)
#define PG8_LDA(dst, b, h) do { _Pragma("unroll") for (int m = 0; m < 4; ++m) _Pragma("unroll") for (int k = 0; k < 2; ++k) dst[m][k] = *(const PG8_LAS bf16x8*)(lds + PG8_SA(b, h) + aoff + m * 2048 + k * 1024); } while (0)
#define PG8_LDB(dst, b, h) do { _Pragma("unroll") for (int n = 0; n < 2; ++n) _Pragma("unroll") for (int k = 0; k < 2; ++k) dst[n][k] = *(const PG8_LAS bf16x8*)(lds + PG8_SB(b, h) + boff + n * 2048 + k * 1024); } while (0)
#define PG8_MMA(ai, bj, At, Bt) do { __builtin_amdgcn_s_setprio(1); _Pragma("unroll") for (int m = 0; m < 4; ++m) _Pragma("unroll") for (int n = 0; n < 2; ++n) _Pragma("unroll") for (int k = 0; k < 2; ++k) \
        acc[ai][bj][m][n] = __builtin_amdgcn_mfma_f32_16x16x32_bf16(Bt[n][k], At[m][k], acc[ai][bj][m][n], 0, 0, 0); __builtin_amdgcn_s_setprio(0); } while (0)
#define PG8_WAIT_V(n) asm volatile("s_waitcnt vmcnt(" #n ")" ::: "memory")
#define PG8_WAIT_L(n) asm volatile("s_waitcnt lgkmcnt(" #n ")" ::: "memory")
#define PG8_BAR __builtin_amdgcn_s_barrier()
#define PG8_SCHED __builtin_amdgcn_sched_barrier(0)
    Unit cur, nxt; int ui = 0;
    if (!S.next(0, cur)) return;
    f32x4 acc[2][2][4][2];
#pragma unroll
    for (int a = 0; a < 2; ++a)
#pragma unroll
        for (int b = 0; b < 2; ++b)
#pragma unroll
            for (int m = 0; m < 4; ++m)
#pragma unroll
                for (int n = 0; n < 2; ++n) acc[a][b][m][n] = (f32x4){0.f, 0.f, 0.f, 0.f};
    bf16x8 At[4][2], B0[2][2], B1[2][2];
    const char* cA = (const char*)g.A + (size_t)cur.z * g.zA + (size_t)cur.pm * tstep; const char* cB = (const char*)g.Bt + (size_t)cur.z * g.zB + (size_t)cur.pn * tstepB;
    S.a_ready(cur);
    if constexpr (SP2) {
        PG8_STAGE(PG8_SB(0, 0), cB, voffB); PG8_STAGE(PG8_SB(0, 1), cB + hsB, voffB); PG8_STAGE(PG8_SA(0, 0), cA, voffA); PG8_STAGE(PG8_SA(0, 1), cA + hstep, voffA);
        if (wr == 1) PG8_BAR;
        PG8_WAIT_V(2); PG8_BAR;
        PG8_STAGE(PG8_SB(1, 0), cB + kstep, voffB); PG8_STAGE(PG8_SA(1, 0), cA + kstep, voffA); PG8_STAGE(PG8_SB(1, 1), cB + hsB + kstep, voffB);
        PG8_WAIT_V(6); PG8_BAR;
    } else {
        PG8_STAGE(PG8_SB(0, 0), cB, voffB); PG8_STAGE(PG8_SA(0, 0), cA, voffA); PG8_STAGE(PG8_SB(0, 1), cB + hstep, voffB); PG8_STAGE(PG8_SA(0, 1), cA + hstep, voffA);
        if (wr == 1) PG8_BAR;
        PG8_WAIT_V(4); PG8_BAR;
        PG8_STAGE(PG8_SB(1, 0), cB + kstep, voffB); PG8_STAGE(PG8_SA(1, 0), cA + kstep, voffA); PG8_STAGE(PG8_SB(1, 1), cB + hstep + kstep, voffB);
        PG8_WAIT_V(6); PG8_BAR;
    }
    for (;;) {
        const bool has_next = S.next(ui + 1, nxt);
        const char* nA = has_next ? (const char*)g.A + (size_t)nxt.z * g.zA + (size_t)nxt.pm * tstep : cA; const char* nB = has_next ? (const char*)g.Bt + (size_t)nxt.z * g.zB + (size_t)nxt.pn * tstepB : cB;
        for (int t = 0; t < nt; t += 2) {
            const bool last = (t == nt - 2);
            const char* a1 = cA + (size_t)(t + 1) * kstep;
            const char* a2 = last ? nA : cA + (size_t)(t + 2) * kstep; const char* b2 = last ? nB : cB + (size_t)(t + 2) * kstep;
            const char* a3 = a2 + kstep; const char* b3 = b2 + kstep;
            if (last && has_next) S.a_ready(nxt);
            if constexpr (SP2) {
            PG8_LDB(B0, 0, 0); if constexpr (!NHALF) PG8_LDB(B1, 0, 1); PG8_SCHED; PG8_LDA(At, 0, 0); PG8_STAGE(PG8_SA(1, 1), a1 + hstep, voffA);
            PG8_WAIT_V(8); PG8_WAIT_L(0); PG8_BAR; PG8_MMA(0, 0, At, B0); if constexpr (!NHALF) PG8_MMA(0, 1, At, B1); PG8_BAR; PG8_SCHED;
            PG8_LDA(At, 0, 1); PG8_STAGE(PG8_SB(0, 0), b2, voffB); PG8_STAGE(PG8_SB(0, 1), b2 + hsB, voffB); PG8_STAGE(PG8_SA(0, 0), a2, voffA);
            PG8_WAIT_V(8); PG8_WAIT_L(0); PG8_BAR; PG8_MMA(1, 0, At, B0); if constexpr (!NHALF) PG8_MMA(1, 1, At, B1); PG8_BAR; PG8_SCHED;
            PG8_LDB(B0, 1, 0); if constexpr (!NHALF) PG8_LDB(B1, 1, 1); PG8_SCHED; PG8_LDA(At, 1, 0); PG8_STAGE(PG8_SA(0, 1), a2 + hstep, voffA);
            PG8_WAIT_V(8); PG8_WAIT_L(0); PG8_BAR; PG8_MMA(0, 0, At, B0); if constexpr (!NHALF) PG8_MMA(0, 1, At, B1); PG8_BAR; PG8_SCHED;
            PG8_LDA(At, 1, 1); PG8_STAGE(PG8_SB(1, 0), b3, voffB); PG8_STAGE(PG8_SB(1, 1), b3 + hsB, voffB); PG8_STAGE(PG8_SA(1, 0), a3, voffA);
            PG8_WAIT_V(8); PG8_WAIT_L(0); PG8_BAR; PG8_MMA(1, 0, At, B0); if constexpr (!NHALF) PG8_MMA(1, 1, At, B1); PG8_BAR; PG8_SCHED;
            } else {
            PG8_LDB(B0, 0, 0); PG8_SCHED; PG8_LDA(At, 0, 0); PG8_STAGE(PG8_SA(1, 1), a1 + hstep, voffA);
            PG8_WAIT_L(8); PG8_BAR; PG8_WAIT_L(0); PG8_MMA(0, 0, At, B0); PG8_BAR; PG8_SCHED;
            PG8_LDB(B1, 0, 1); PG8_STAGE(PG8_SB(0, 0), b2, voffB);
            PG8_BAR; PG8_WAIT_L(0); PG8_MMA(0, 1, At, B1); PG8_BAR;
            PG8_LDA(At, 0, 1); PG8_STAGE(PG8_SA(0, 0), a2, voffA);
            PG8_BAR; PG8_WAIT_L(0); PG8_MMA(1, 0, At, B0); PG8_BAR; PG8_SCHED;
            PG8_STAGE(PG8_SB(0, 1), b2 + hstep, voffB);
            PG8_WAIT_V(6); PG8_BAR; PG8_MMA(1, 1, At, B1); PG8_BAR;
            PG8_LDB(B0, 1, 0); PG8_SCHED; PG8_LDA(At, 1, 0); PG8_STAGE(PG8_SA(0, 1), a2 + hstep, voffA);
            PG8_WAIT_L(8); PG8_BAR; PG8_WAIT_L(0); PG8_MMA(0, 0, At, B0); PG8_BAR; PG8_SCHED;
            PG8_LDB(B1, 1, 1); PG8_STAGE(PG8_SB(1, 0), b3, voffB);
            PG8_BAR; PG8_WAIT_L(0); PG8_MMA(0, 1, At, B1); PG8_BAR;
            PG8_LDA(At, 1, 1); PG8_STAGE(PG8_SA(1, 0), a3, voffA);
            PG8_BAR; PG8_WAIT_L(0); PG8_MMA(1, 0, At, B0); PG8_BAR; PG8_SCHED;
            PG8_STAGE(PG8_SB(1, 1), b3 + hstep, voffB);
            PG8_WAIT_V(6); PG8_BAR; PG8_MMA(1, 1, At, B1); PG8_BAR;
            }
        }
        if constexpr (ALIGN_EPI) { if (wr == 0) PG8_BAR; }
        if constexpr (!Epi::AFTER_DRAIN) { E(acc, cur, wr, wc, fr, fq); S.done(cur); }
        if (!has_next) break;
        bool clear = true; if constexpr (epi_chain<Epi>::value) clear = !Epi::keep(cur);
        if (clear) {
#pragma unroll
        for (int a = 0; a < 2; ++a)
#pragma unroll
            for (int b = 0; b < 2; ++b)
#pragma unroll
                for (int m = 0; m < 4; ++m)
#pragma unroll
                    for (int n = 0; n < 2; ++n) acc[a][b][m][n] = (f32x4){0.f, 0.f, 0.f, 0.f};
        }
        cur = nxt; cA = nA; cB = nB; ++ui;
        if constexpr (ALIGN_EPI) { if (wr == 1) PG8_BAR; }
    }
    PG8_WAIT_V(0);
    if constexpr (!ALIGN_EPI) { if (wr == 0) PG8_BAR; }
    PG8_BAR;
    if constexpr (Epi::AFTER_DRAIN) { E.fused(acc, cur, wr, wc, fr, fq, lds, wid, lane); S.done(cur); }
#undef PG8_SA
#undef PG8_SB
#undef PG8_STAGE
#undef PG8_LDA
#undef PG8_LDB
#undef PG8_MMA
#undef PG8_WAIT_V
#undef PG8_WAIT_L
#undef PG8_BAR
#undef PG8_SCHED
}
}

namespace att {
using bf16 = __hip_bfloat16;
constexpr int   D = 128, NW = 8, QBLK = 32, KVBLK = 64;
constexpr float SCALE = 0.088388347648318440f;
constexpr float THR = 8.f;
#ifndef ATT_SDEPTH
#define ATT_SDEPTH 1
#endif
constexpr int SDEPTH = ATT_SDEPTH;
constexpr int LDQ = NP, LDK = NP, LDO = DM;
constexpr size_t SHM_V = KVBLK * D * 2, SHM_K = KVBLK * D * 2, SHM_ATTN = 2 * SHM_V + 2 * SHM_K + NW * 64 * 4;
constexpr int OST_OFF = 69632, OST_END = OST_OFF + NW * 32 * 272;
using bf16x8 = __attribute__((ext_vector_type(8))) short;
using s16x4  = __attribute__((ext_vector_type(4))) short;
using f32x16 = __attribute__((ext_vector_type(16))) float;
using f32x4  = __attribute__((ext_vector_type(4))) float;
using u32x4  = __attribute__((ext_vector_type(4))) unsigned;
#define KSWZ(row, colB) ((row) * 256 + ((colB) ^ (((row) & 7) << 4)))
#define SBAR() __builtin_amdgcn_sched_barrier(0)
__device__ __forceinline__ int crow(int r, int hi) { return (r & 3) + 8 * (r >> 2) + 4 * hi; }
__device__ __forceinline__ unsigned cvtpk(float lo, float hi) { unsigned r; asm volatile("v_cvt_pk_bf16_f32 %0, %1, %2" : "=v"(r) : "v"(lo), "v"(hi)); return r; }
__device__ __forceinline__ bf16x8 ld8(const bf16* p) { return *reinterpret_cast<const bf16x8*>(p); }

__device__ __forceinline__ void partialSM(f32x16& p0, f32x16& p1, float& m_reg, float& mn, float& alpha) {
  constexpr float C = SCALE * 1.4426950408889634f;
  float pmax = p0[0];
#pragma unroll
  for (int r = 1; r < 16; ++r) pmax = fmaxf(pmax, p0[r]);
#pragma unroll
  for (int r = 0; r < 16; ++r) pmax = fmaxf(pmax, p1[r]);
  { auto rr = __builtin_amdgcn_permlane32_swap(__float_as_uint(pmax), __float_as_uint(pmax), false, false);
    pmax = fmaxf(__uint_as_float(rr[0]), __uint_as_float(rr[1])); }
  if (__builtin_expect(__all(pmax - m_reg <= THR / SCALE), 1)) { mn = m_reg; alpha = 1.f; }
  else { mn = fmaxf(m_reg, pmax); alpha = __builtin_amdgcn_exp2f((m_reg - mn) * C); m_reg = mn; }
  float mnC = -mn * C;
#pragma unroll
  for (int r = 0; r < 16; ++r) p0[r] = fmaf(p0[r], C, mnC);
#pragma unroll
  for (int r = 0; r < 16; ++r) p1[r] = fmaf(p1[r], C, mnC);
#pragma unroll
  for (int r = 0; r < 16; ++r) p0[r] = __builtin_amdgcn_exp2f(p0[r]);
}
__device__ __forceinline__ void finishSM(f32x16& p0, f32x16& p1, float alpha, float& l_reg, bf16x8& pa0, bf16x8& pa1, bf16x8& pa2, bf16x8& pa3) {
#pragma unroll
  for (int r = 0; r < 16; ++r) p1[r] = __builtin_amdgcn_exp2f(p1[r]);
  float ps = 0;
#pragma unroll
  for (int r = 0; r < 16; ++r) ps += p0[r];
#pragma unroll
  for (int r = 0; r < 16; ++r) ps += p1[r];
  { auto rr = __builtin_amdgcn_permlane32_swap(__float_as_uint(ps), __float_as_uint(ps), false, false);
    ps = __uint_as_float(rr[0]) + __uint_as_float(rr[1]); }
  l_reg = l_reg * alpha + ps;
#define PK4(P, BASE, OUT) do { unsigned a0 = cvtpk(P[BASE + 0], P[BASE + 1]), a1 = cvtpk(P[BASE + 2], P[BASE + 3]);   \
    unsigned b0 = cvtpk(P[BASE + 4], P[BASE + 5]), b1 = cvtpk(P[BASE + 6], P[BASE + 7]);                              \
    auto r0 = __builtin_amdgcn_permlane32_swap(a0, b0, false, false); auto r1 = __builtin_amdgcn_permlane32_swap(a1, b1, false, false); \
    u32x4 w = {r0[0], r1[0], r0[1], r1[1]}; OUT = *reinterpret_cast<bf16x8*>(&w); } while (0)
  PK4(p0, 0, pa0); PK4(p0, 8, pa1); PK4(p1, 0, pa2); PK4(p1, 8, pa3);
#undef PK4
}
__device__ __forceinline__ void qkt(f32x16& p0, f32x16& p1, const bf16* Ks, const bf16x8* qr, int r32, int hi) {
  p0 = f32x16{}; p1 = f32x16{};
#pragma unroll
  for (int d0 = 0; d0 < 8; ++d0) { int cb = (d0 * 16 + hi * 8) * 2;
    bf16x8 b0 = *reinterpret_cast<const bf16x8*>((const char*)Ks + KSWZ(r32, cb));
    bf16x8 b1 = *reinterpret_cast<const bf16x8*>((const char*)Ks + KSWZ(32 + r32, cb));
    p0 = __builtin_amdgcn_mfma_f32_32x32x16_bf16(b0, qr[d0], p0, 0, 0, 0);
    p1 = __builtin_amdgcn_mfma_f32_32x32x16_bf16(b1, qr[d0], p1, 0, 0, 0); }
}
__device__ __forceinline__ int v_st(int k, int c) { const int kk = (k & ~0xC) | ((k & 4) << 1) | ((k & 8) >> 1); return ((kk >> 3) * 4 + (c >> 5)) * 512 + ((kk & 7) * 32 + (c & 31)) * 2; }
__device__ __forceinline__ int v_rd_base(int lane) { return ((lane & 3) << 3) | (((lane >> 2) & 3) << 6) | (((lane >> 4) & 1) << 5) | (((lane >> 5) & 1) << 8); }
constexpr int v_rd_off(int d0, int ks, int half) { return d0 * 512 + ks * 4096 + half * 2048; }
template <int OFF> __device__ __forceinline__ s16x4 tr_read(int vb) {
  s16x4 r; asm volatile("ds_read_b64_tr_b16 %0, %1 offset:%2" : "=&v"(r) : "v"(vb), "i"(OFF) : "memory"); return r;
}
template <int D0> __device__ __forceinline__ void pv_one(f32x16& od, int vb, bf16x8 pa0, bf16x8 pa1, bf16x8 pa2, bf16x8 pa3) {
  const s16x4 l0 = tr_read<v_rd_off(D0, 0, 0)>(vb), h0 = tr_read<v_rd_off(D0, 0, 1)>(vb), l1 = tr_read<v_rd_off(D0, 1, 0)>(vb), h1 = tr_read<v_rd_off(D0, 1, 1)>(vb);
  const s16x4 l2 = tr_read<v_rd_off(D0, 2, 0)>(vb), h2 = tr_read<v_rd_off(D0, 2, 1)>(vb), l3 = tr_read<v_rd_off(D0, 3, 0)>(vb), h3 = tr_read<v_rd_off(D0, 3, 1)>(vb);
  asm volatile("s_waitcnt lgkmcnt(0)" ::: "memory"); SBAR();
#define PK(L, H) (bf16x8){L[0], L[1], L[2], L[3], H[0], H[1], H[2], H[3]}
  od = __builtin_amdgcn_mfma_f32_32x32x16_bf16(pa0, PK(l0, h0), od, 0, 0, 0);
  od = __builtin_amdgcn_mfma_f32_32x32x16_bf16(pa1, PK(l1, h1), od, 0, 0, 0);
  od = __builtin_amdgcn_mfma_f32_32x32x16_bf16(pa2, PK(l2, h2), od, 0, 0, 0);
  od = __builtin_amdgcn_mfma_f32_32x32x16_bf16(pa3, PK(l3, h3), od, 0, 0, 0);
#undef PK
}
__device__ __forceinline__ void pv_d0(f32x16* o, int vb, bf16x8 pa0, bf16x8 pa1, bf16x8 pa2, bf16x8 pa3) {
  pv_one<0>(o[0], vb, pa0, pa1, pa2, pa3); pv_one<1>(o[1], vb, pa0, pa1, pa2, pa3); pv_one<2>(o[2], vb, pa0, pa1, pa2, pa3); pv_one<3>(o[3], vb, pa0, pa1, pa2, pa3);
}

__device__ __forceinline__ void attn_unit(const bf16* __restrict__ Qb, const bf16* __restrict__ Kh, const bf16* __restrict__ Vh, const bf16* __restrict__ Zb,
                                          bf16* __restrict__ Ob, int seq, char* lds, const float* __restrict__ qn, const float* __restrict__ cs, const float* __restrict__ sn) {
  int tid = threadIdx.x; asm volatile("" : "+v"(tid));
  int wid = tid >> 6, lane = tid & 63, r32 = lane & 31, hi = lane >> 5;
  bf16* V_lds = (bf16*)lds; bf16* K_lds = (bf16*)(lds + 2 * SHM_V);
  float* ws = (float*)(lds + 2 * SHM_V + 2 * SHM_K) + wid * 64; float* li_l = ws; float* al_l = ws + 32;
  float m_reg = -1e30f, l_reg = 0; f32x16 o[4] = {}; bf16x8 qr[8];
  {
    const bf16* Qw = Qb + (long)(wid * QBLK + r32) * LDQ + hi * 8;
    float ss = 0.f;
#pragma unroll
    for (int d0 = 0; d0 < 8; ++d0) { const u32x4 w = *reinterpret_cast<const u32x4*>(Qw + d0 * 16); qr[d0] = __builtin_bit_cast(bf16x8, w);
#pragma unroll
      for (int e = 0; e < 4; ++e) { const float lo = __uint_as_float(w[e] << 16), hh = __uint_as_float(w[e] & 0xffff0000u); ss += lo * lo + hh * hh; } }
    { auto rr = __builtin_amdgcn_permlane32_swap(__float_as_uint(ss), __float_as_uint(ss), false, false); ss = __uint_as_float(rr[0]) + __uint_as_float(rr[1]); }
    const float rs = rsqrtf(ss * (1.f / 128.f) + EPS);
    const float* cp = cs ? cs + (long)(wid * QBLK + r32) * 64 + hi * 8 : nullptr; const float* sp = cs ? sn + (long)(wid * QBLK + r32) * 64 + hi * 8 : nullptr;
#pragma unroll
    for (int d0 = 0; d0 < 4; ++d0) {
      const u32x4 wa = __builtin_bit_cast(u32x4, qr[d0]), wb = __builtin_bit_cast(u32x4, qr[d0 + 4]); float x1[8], x2[8];
#pragma unroll
      for (int e = 0; e < 4; ++e) { x1[2 * e] = __uint_as_float(wa[e] << 16); x1[2 * e + 1] = __uint_as_float(wa[e] & 0xffff0000u); x2[2 * e] = __uint_as_float(wb[e] << 16); x2[2 * e + 1] = __uint_as_float(wb[e] & 0xffff0000u); }
      const f32x4 ga0 = *reinterpret_cast<const f32x4*>(qn + d0 * 16 + hi * 8), ga1 = *reinterpret_cast<const f32x4*>(qn + d0 * 16 + hi * 8 + 4);
      const f32x4 gb0 = *reinterpret_cast<const f32x4*>(qn + 64 + d0 * 16 + hi * 8), gb1 = *reinterpret_cast<const f32x4*>(qn + 64 + d0 * 16 + hi * 8 + 4);
#pragma unroll
      for (int e = 0; e < 8; ++e) { x1[e] *= rs * (e < 4 ? ga0[e & 3] : ga1[e & 3]); x2[e] *= rs * (e < 4 ? gb0[e & 3] : gb1[e & 3]); }
      if (cs) {
        const f32x4 c0 = *reinterpret_cast<const f32x4*>(cp + d0 * 16), c1 = *reinterpret_cast<const f32x4*>(cp + d0 * 16 + 4);
        const f32x4 s0 = *reinterpret_cast<const f32x4*>(sp + d0 * 16), s1 = *reinterpret_cast<const f32x4*>(sp + d0 * 16 + 4);
#pragma unroll
        for (int e = 0; e < 8; ++e) { const float c = e < 4 ? c0[e & 3] : c1[e & 3], sv = e < 4 ? s0[e & 3] : s1[e & 3];
          const float a = x1[e], bq = x2[e]; x1[e] = a * c - bq * sv; x2[e] = bq * c + a * sv; }
      }
      const u32x4 oa = {cvtpk(x1[0], x1[1]), cvtpk(x1[2], x1[3]), cvtpk(x1[4], x1[5]), cvtpk(x1[6], x1[7])}, ob = {cvtpk(x2[0], x2[1]), cvtpk(x2[2], x2[3]), cvtpk(x2[4], x2[5]), cvtpk(x2[6], x2[7])};
      qr[d0] = __builtin_bit_cast(bf16x8, oa); qr[d0 + 4] = __builtin_bit_cast(bf16x8, ob);
      asm volatile("" ::: "memory");
    }
  }
  const int sr = tid >> 4, sc = (tid & 15) * 8, vst0 = v_st(sr, sc), vst1 = v_st(32 + sr, sc);
  const int vb0 = (int)(uintptr_t)V_lds + v_rd_base(lane);
  struct { bf16x8 vs0, vs1, ks0, ks1; } sr_[SDEPTH];
#define SLOAD(i, k0) do { sr_[i].vs0 = ld8(&Vh[(long)((k0) + sr) * LDK + sc]); sr_[i].vs1 = ld8(&Vh[(long)((k0) + 32 + sr) * LDK + sc]); \
    sr_[i].ks0 = ld8(&Kh[(long)((k0) + sr) * LDK + sc]); sr_[i].ks1 = ld8(&Kh[(long)((k0) + 32 + sr) * LDK + sc]); } while (0)
#define SWRITE(b, i) do { *(bf16x8*)((char*)V_lds + (b) * SHM_V + vst0) = sr_[i].vs0;          \
    *(bf16x8*)((char*)V_lds + (b) * SHM_V + vst1) = sr_[i].vs1; int kc = sc * 2;               \
    *(bf16x8*)((char*)K_lds + (b) * SHM_K + KSWZ(sr, kc)) = sr_[i].ks0;                       \
    *(bf16x8*)((char*)K_lds + (b) * SHM_K + KSWZ(32 + sr, kc)) = sr_[i].ks1; } while (0)
#define SWAIT() do { if constexpr (SDEPTH == 2) asm volatile("s_waitcnt vmcnt(4)" ::: "memory"); else asm volatile("s_waitcnt vmcnt(0)" ::: "memory"); } while (0)
#define RESC(a) do { if (__any((a) < 1.f)) { if (hi == 0) al_l[r32] = (a); asm volatile("s_waitcnt lgkmcnt(0)" ::: "memory"); \
    _Pragma("unroll") for (int d = 0; d < 4; ++d) _Pragma("unroll") for (int r = 0; r < 16; ++r) o[d][r] *= al_l[crow(r, hi)]; } } while (0)
  f32x16 pA0, pA1, pB0, pB1; float mnA, mnB, alA, alB; bf16x8 pa0, pa1, pa2, pa3; const int NT = seq / KVBLK;
  constexpr int SE = 0, SO = SDEPTH - 1;
  SLOAD(SE, 0); asm volatile("s_waitcnt vmcnt(0)" ::: "memory"); SWRITE(0, SE); __syncthreads();
  qkt(pA0, pA1, K_lds, qr, r32, hi); partialSM(pA0, pA1, m_reg, mnA, alA);
  SLOAD(SO, KVBLK); if constexpr (SDEPTH == 2) { if (2 < NT) SLOAD(SE, 2 * KVBLK); }
  SWAIT(); SWRITE(1, SO); __syncthreads();
  for (int j = 1; j + 1 < NT; j += 2) {
    SBAR(); qkt(pB0, pB1, (bf16*)((char*)K_lds + SHM_K), qr, r32, hi);
    finishSM(pA0, pA1, alA, l_reg, pa0, pa1, pa2, pa3); SBAR();
    SLOAD(SO, (j + SDEPTH) * KVBLK); SBAR();
    pv_d0(o, vb0, pa0, pa1, pa2, pa3); partialSM(pB0, pB1, m_reg, mnB, alB);
    __syncthreads(); SWAIT(); SWRITE(0, SE);
    RESC(alB); __syncthreads();
    SBAR(); qkt(pA0, pA1, K_lds, qr, r32, hi);
    finishSM(pB0, pB1, alB, l_reg, pa0, pa1, pa2, pa3); SBAR();
    if (SDEPTH == 1 || j + 3 < NT) SLOAD(SE, (j + 1 + SDEPTH) * KVBLK); SBAR();
    pv_d0(o, vb0 + (int)SHM_V, pa0, pa1, pa2, pa3); partialSM(pA0, pA1, m_reg, mnA, alA);
    __syncthreads(); SWAIT(); SWRITE(1, SO);
    RESC(alA); __syncthreads();
  }
  SBAR(); qkt(pB0, pB1, (bf16*)((char*)K_lds + SHM_K), qr, r32, hi);
  finishSM(pA0, pA1, alA, l_reg, pa0, pa1, pa2, pa3); SBAR();
  pv_d0(o, vb0, pa0, pa1, pa2, pa3); partialSM(pB0, pB1, m_reg, mnB, alB);
  __syncthreads(); RESC(alB);
  finishSM(pB0, pB1, alB, l_reg, pa0, pa1, pa2, pa3); SBAR();
  pv_d0(o, vb0 + (int)SHM_V, pa0, pa1, pa2, pa3);
  if (hi == 0) li_l[r32] = l_reg; asm volatile("s_waitcnt lgkmcnt(0)" ::: "memory");
  { int tz = threadIdx.x; asm volatile("" : "+v"(tz)); wid = tz >> 6; lane = tz & 63; r32 = lane & 31; hi = lane >> 5; }
  float rli[16];
#pragma unroll
  for (int r = 0; r < 16; ++r) rli[r] = __builtin_amdgcn_rcpf(li_l[crow(r, hi)]);
  char* ost = lds + OST_OFF + wid * (32 * 272);
#pragma unroll
  for (int r = 0; r < 16; ++r) { const int orow = crow(r, hi);
#pragma unroll
    for (int d0 = 0; d0 < 4; ++d0) *(bf16*)(ost + orow * 272 + (d0 * 32 + r32) * 2) = __float2bfloat16(o[d0][r] * rli[r]); }
  asm volatile("s_waitcnt lgkmcnt(0)" ::: "memory");
  bf16* Ow = Ob + (long)(wid * QBLK) * LDO; const bf16* Zw = Zb + (long)(wid * QBLK) * LDQ;
#pragma unroll
  for (int hb = 0; hb < 2; ++hb) {
    u32x4 ov[4], zv[4];
#pragma unroll
    for (int i = 0; i < 4; ++i) { const int c = (hb * 4 + i) * 64 + lane, row = c >> 4, col = (c & 15) * 8;
      ov[i] = *reinterpret_cast<const u32x4*>(ost + row * 272 + col * 2); zv[i] = *reinterpret_cast<const u32x4*>(Zw + (long)row * LDQ + col); }
#pragma unroll
    for (int i = 0; i < 4; ++i) { const int c = (hb * 4 + i) * 64 + lane, row = c >> 4, col = (c & 15) * 8; u32x4 w;
#pragma unroll
      for (int e = 0; e < 4; ++e) { const unsigned a = ov[i][e], z = zv[i][e];
        w[e] = cvtpk(__uint_as_float(a << 16) * __uint_as_float(z << 16), __uint_as_float(a & 0xffff0000u) * __uint_as_float(z & 0xffff0000u)); }
      *reinterpret_cast<u32x4*>(Ow + (long)row * LDO + col) = w; }
  }
  __syncthreads();
#undef SLOAD
#undef SWRITE
#undef SWAIT
#undef RESC
}
}

constexpr int NWAVES = 8;
#ifndef MK_N_LAUNCHES
#define MK_N_LAUNCHES 1
#endif
constexpr int PH_PER_LAYER = 7, N_PHASES = 2 + DEPTH * PH_PER_LAYER;
constexpr size_t MiB = 1u << 20;
constexpr size_t WS_CTL = 0, CTL_ZERO_BYTES = 1 * MiB;
constexpr size_t WS_MOD = 1 * MiB;
constexpr size_t WS_ROPE = WS_MOD + MiB / 2;
constexpr size_t WS_WG = 3 * MiB;
constexpr size_t WS_WLRU = 4 * MiB;
constexpr size_t WS_WOUT = 12 * MiB;
constexpr size_t WS_WBR = 44 * MiB;
constexpr size_t WS_WIN = 140 * MiB;
constexpr size_t WS_X = 540 * MiB;
constexpr size_t WS_Y = 2112 * MiB;
constexpr size_t WS_H = 684 * MiB;
constexpr size_t WS_G2 = 1968 * MiB;
constexpr size_t WS_YB = 756 * MiB;
constexpr size_t WS_ACC = 864 * MiB;
constexpr size_t WS_GT = 936 * MiB;
constexpr size_t WS_MH = 938 * MiB;
constexpr size_t WS_P = 1082 * MiB;
constexpr size_t WS_LA = 1532 * MiB;
constexpr size_t WS_LB = 1676 * MiB;
constexpr size_t WS_X8 = WS_LB;
constexpr size_t WS_HL = 1820 * MiB;
constexpr size_t WS_GSC = 1964 * MiB;
constexpr size_t WS_END = 2328 * MiB;
constexpr int CW_BAR = 4096;
constexpr int RING_BYTES = 131072, LDS_BYTES = 147456, MISC_OFF = LDS_BYTES - 256;
static_assert(att::OST_END <= MISC_OFF, "LDS map");

#define GAS __attribute__((address_space(1)))
#define LAS __attribute__((address_space(3)))
typedef unsigned short bf16_t;
typedef unsigned v4u __attribute__((ext_vector_type(4)));
typedef unsigned v2u __attribute__((ext_vector_type(2)));
typedef float f32x4 __attribute__((ext_vector_type(4)));
#define LDS_WAIT() asm volatile("s_waitcnt lgkmcnt(0)" ::: "memory")
__device__ __forceinline__ unsigned f2bf(float f) { unsigned u = __builtin_bit_cast(unsigned, f); return (u + 0x7fffu + ((u >> 16) & 1u)) >> 16; }
__device__ __forceinline__ unsigned pk2(float lo, float hi) { unsigned r; asm("v_cvt_pk_bf16_f32 %0, %1, %2" : "=v"(r) : "v"(lo), "v"(hi)); return r; }
__device__ __forceinline__ float bf2f(bf16_t b) { return __uint_as_float((unsigned)b << 16); }
__device__ __forceinline__ float blo(unsigned w) { return __uint_as_float(w << 16); }
__device__ __forceinline__ float bhi(unsigned w) { return __uint_as_float(w & 0xffff0000u); }
__device__ __forceinline__ float lane_get(float v, int src) { return __builtin_bit_cast(float, __builtin_amdgcn_ds_bpermute(src << 2, __builtin_bit_cast(int, v))); }
__device__ __forceinline__ float lane_xor(float v, int mask, int lane) { return lane_get(v, lane ^ mask); }
__device__ __forceinline__ float lane_up(float v, int delta, int lane) { return lane_get(v, lane >= delta ? lane - delta : lane); }
__device__ __forceinline__ float wave_sum(float v, int lane) {
#pragma unroll
    for (int o = 1; o < 64; o <<= 1) v += lane_xor(v, o, lane);
    return v;
}
#define XB_TMO      128
#define XB_XCNT(j)  (256  + 64 * (j))
#define XB_XSUB(j)  (1280 + 64 * (j))
#define XB_XGEN(j)  (2304 + 64 * (j))
#define XB_TOP      3328
#define XB_TOPGEN   3392
#define XCD_BAR_WORDS 3456
#define XB_SPIN_CAP (1u << 18)

__device__ __forceinline__ unsigned xb_ld(unsigned* p)              { return __hip_atomic_load(p, __ATOMIC_RELAXED, __HIP_MEMORY_SCOPE_AGENT); }
__device__ __forceinline__ unsigned xb_add(unsigned* p, unsigned v) { return __hip_atomic_fetch_add(p, v, __ATOMIC_RELAXED, __HIP_MEMORY_SCOPE_AGENT); }
__device__ __forceinline__ unsigned xb_xcc_id() { return (unsigned)__builtin_amdgcn_s_getreg((3 << 11) | 20) & 0xFu; }
#define XB_SPIN(cond, bar) do { unsigned _sp = 0; while (cond) { __builtin_amdgcn_s_sleep(1); \
    if ((++_sp & 255u) == 0u) { if (xb_ld(&(bar)[XB_TMO])) break; if (_sp > XB_SPIN_CAP) { atomicAdd(&(bar)[XB_TMO], 1u); break; } } } } while (0)

struct XcdBarrier {
    unsigned* bar; unsigned x;
    volatile LAS unsigned* st;
};

__device__ __forceinline__ XcdBarrier xcd_barrier_post(unsigned* bar, volatile LAS unsigned* st) {
    XcdBarrier b; b.bar = bar; b.x = xb_xcc_id(); b.st = st;
    if (threadIdx.x == 0) (void)xb_add(&bar[XB_XCNT(b.x)], 1u);
    return b;
}
__device__ __forceinline__ void xcd_barrier_complete(unsigned* bar, unsigned x, unsigned& nloc, unsigned& nx) {
    const unsigned G = gridDim.x * gridDim.y * gridDim.z;
    unsigned sum, cnt, mine, sp = 0u;
    for (;;) {
        sum = 0u; cnt = 0u; mine = 0u;
#pragma unroll
        for (unsigned j = 0; j < 16; ++j) { const unsigned c = xb_ld(&bar[XB_XCNT(j)]); sum += c; cnt += (c > 0u) ? 1u : 0u; mine = (j == x) ? c : mine; }
        if (sum == G) break;
        __builtin_amdgcn_s_sleep(1);
        if ((++sp & 255u) == 0u) { if (xb_ld(&bar[XB_TMO])) break; if (sp > XB_SPIN_CAP) { atomicAdd(&bar[XB_TMO], 1u); break; } }
    }
    nloc = mine > 0u ? mine : 1u; nx = cnt > 0u ? cnt : 1u;
}

__device__ __forceinline__ void xcd_barrier(const XcdBarrier& b) {
    asm volatile("s_waitcnt vmcnt(0)" ::: "memory");
    __syncthreads();
    if (threadIdx.x == 0) {
        unsigned* bar = b.bar;
        __builtin_amdgcn_s_waitcnt(0);
        unsigned nloc = b.st[0], nx = b.st[1];
        if (nloc == 0u) { xcd_barrier_complete(bar, b.x, nloc, nx); b.st[0] = nloc; b.st[1] = nx; }
        const unsigned old = xb_add(&bar[XB_XSUB(b.x)], 1u);
        const unsigned gen = old / nloc;
        if (old + 1u == (gen + 1u) * nloc) {
            __builtin_amdgcn_fence(__ATOMIC_RELEASE, "agent");
            asm volatile("s_waitcnt vmcnt(0)" ::: "memory");
            const unsigned og = xb_add(&bar[XB_TOP], 1u);
            const unsigned tg = og / nx;
            if (og + 1u == (tg + 1u) * nx) xb_add(&bar[XB_TOPGEN], 1u);
            else XB_SPIN(xb_ld(&bar[XB_TOPGEN]) == tg, bar);
            __builtin_amdgcn_fence(__ATOMIC_ACQUIRE, "agent");
            xb_add(&bar[XB_XGEN(b.x)], 1u);
            asm volatile("s_waitcnt vmcnt(0)" ::: "memory");
        } else {
            XB_SPIN(xb_ld(&bar[XB_XGEN(b.x)]) == gen, bar);
            __builtin_amdgcn_fence(__ATOMIC_ACQUIRE, "agent");
            asm volatile("s_waitcnt vmcnt(0)" ::: "memory");
        }
    }
    __syncthreads();
}

struct Args { const float* in[22]; float* out; unsigned char* ws; int ph_lo, ph_hi; };
typedef const __attribute__((address_space(4))) Args CArgs;
#define KIN(k) ((const float*)ka->in[k])
#define WSF(off) ((float*)(ka->ws + (off)))
#define WSB(off) ((bf16_t*)(ka->ws + (off)))
#define KA() ({ CArgs* _k = ka0; asm volatile("" : "+s"(_k)); _k; })
__device__ __forceinline__ int tid_fresh() { int t = threadIdx.x; asm volatile("" : "+v"(t)); return t; }
struct Frame {
    LAS unsigned char* lds; char* ldsg;
    int tid, lane, wave, G, wg;
};

__device__ __forceinline__ void transpose_item(const float* W, int ldw, int col0, int k0, bf16_t* WT, int ldt, int drow0, LAS float* scr, int lane) {
    f32x4 v[8];
#pragma unroll
    for (int i = 0; i < 8; ++i) v[i] = __builtin_nontemporal_load((const f32x4*)(W + (size_t)(k0 + 8 * i + (lane >> 3)) * ldw + col0 + 4 * (lane & 7)));
#pragma unroll
    for (int i = 0; i < 8; ++i) { LAS float* d = scr + (8 * i + (lane >> 3)) * 33 + 4 * (lane & 7); d[0] = v[i][0]; d[1] = v[i][1]; d[2] = v[i][2]; d[3] = v[i][3]; }
    LDS_WAIT(); asm volatile("" ::: "memory");
    const int c = lane & 7;
#pragma unroll
    for (int j = 0; j < 4; ++j) { const int n = (lane >> 3) + 8 * j; const LAS float* s = scr + (8 * c) * 33 + n;
        v4u o; o.x = pk2(s[0 * 33], s[1 * 33]); o.y = pk2(s[2 * 33], s[3 * 33]); o.z = pk2(s[4 * 33], s[5 * 33]); o.w = pk2(s[6 * 33], s[7 * 33]);
        __builtin_nontemporal_store(o, (v4u*)(WT + (size_t)(drow0 + n) * ldt + k0 + 8 * c)); }
    LDS_WAIT(); asm volatile("" ::: "memory");
}
__device__ __forceinline__ void p_convert(Frame& F, CArgs* ka, int l, int wv, int nwv, int it0 = 0, int it1 = 1 << 30) {
    const int tid = tid_fresh(), lane = tid & 63, wave = __builtin_amdgcn_readfirstlane(tid >> 6);
    LAS float* scr = (LAS float*)(F.lds + wave * 8704);
    constexpr int I_IN = 32 * 800, I_G = 32, I_BR = 3 * 2048, I_OUT = 2048, I_LRU = 2 * 2 * 16 * 8, I_LAYER = I_IN + I_G + I_BR + I_OUT + I_LRU;
    if (it1 > I_LAYER) it1 = I_LAYER;
    for (int it = it0 + wv; it < it1; it += nwv) {
        int r = it;
        if (r < I_IN) { const int kb = r / 800, nb = r - kb * 800, n0 = nb * 32, sc = n0 < 14336 ? n0 : n0 + 32;
            transpose_item(KIN(8) + (size_t)l * DM * NIN, NIN, sc, kb * 64, WSB(WS_WIN) + (size_t)l * NP * DM, DM, n0, scr, lane); continue; }
        r -= I_IN;
        if (r < I_G) { transpose_item(KIN(8) + (size_t)l * DM * NIN, NIN, 14336, r * 64, WSB(WS_WG) + (size_t)l * 32 * DM, DM, 0, scr, lane); continue; }
        r -= I_G;
        if (r < I_BR) { const int z = r / 2048, q = r - z * 2048, kb = q / 64, nb = q - kb * 64;
            transpose_item(KIN(20) + ((size_t)l * 3 + z) * DM * DM, DM, nb * 32, kb * 64, WSB(WS_WBR) + ((size_t)l * 3 + z) * DM * DM, DM, nb * 32, scr, lane); continue; }
        r -= I_BR;
        if (r < I_OUT) { const int kb = r / 64, nb = r - kb * 64;
            transpose_item(KIN(21) + (size_t)l * DM * DM, DM, nb * 32, kb * 64, WSB(WS_WOUT) + (size_t)l * DM * DM, DM, nb * 32, scr, lane); continue; }
        r -= I_OUT;
        { const int q = r & 7, mt = r >> 3, blk = mt & 15, gate = (mt >> 4) & 1, dr = mt >> 5, kb = q >> 2, nb = q & 3;
          const float* src = (gate ? KIN(13) : KIN(11)) + (((size_t)l * 2 + dr) * 16 + blk) * 16384;
          transpose_item(src, 128, nb * 32, kb * 64, WSB(WS_WLRU) + ((((size_t)l * 2 + dr) * 2 + gate) * 16 + blk) * 16384, 128, nb * 32, scr, lane); }
    }
}
__device__ __forceinline__ void p_prologue(Frame& F, CArgs* ka) {
    const int tid = tid_fresh(), lane = tid & 63, wave = __builtin_amdgcn_readfirstlane(tid >> 6); (void)lane; (void)wave;
    for (int i = F.wg * 512 + tid; i < SEQ * 64; i += F.G * 512) { const int t = i >> 6, j = i & 63;
        const float inv = 1.0f / powf(10000.0f, (float)(j & 31) * (1.0f / 32.0f)); const float pos = (float)(j < 32 ? (t >> 6) : (t & 63)); const float ang = pos * inv;
        { const float rev = ang * 0.15915494309189535f; WSF(WS_ROPE)[i] = __builtin_amdgcn_cosf(rev); WSF(WS_ROPE)[SEQ * 64 + i] = __builtin_amdgcn_sinf(rev); } }
    __syncthreads();
    LAS float* sc = (LAS float*)(F.lds + 73728);
    LAS float* red = (LAS float*)(F.lds + 73728 + 5 * 2048 * 4);
    for (int i = tid; i < 5 * DM; i += 512) { const int bi = i >> 11, k = i & 2047; const float v = bi < 4 ? KIN(1)[bi * DM + k] : KIN(3)[k]; sc[i] = v / (1.f + expf(-v)); }
    __syncthreads();
    for (int it = F.wg; it < DEPTH * 192; it += F.G) { const int l = it / 192, j0 = (it - l * 192) * 32, cj = tid & 31, ks = tid >> 5;
        float a0 = 0.f, a1 = 0.f, a2 = 0.f, a3 = 0.f, a4 = 0.f; const float* w = KIN(4) + (size_t)l * DM * 3 * DM + j0 + cj;
        for (int k = ks * 128; k < ks * 128 + 128; ++k) { const float wv = w[(size_t)k * (3 * DM)]; a0 += sc[k] * wv; a1 += sc[2048 + k] * wv; a2 += sc[4096 + k] * wv; a3 += sc[6144 + k] * wv; a4 += sc[8192 + k] * wv; }
        red[(ks * 5 + 0) * 32 + cj] = a0; red[(ks * 5 + 1) * 32 + cj] = a1; red[(ks * 5 + 2) * 32 + cj] = a2; red[(ks * 5 + 3) * 32 + cj] = a3; red[(ks * 5 + 4) * 32 + cj] = a4;
        __syncthreads();
        if (tid < 160) { const int bi = tid >> 5, c = tid & 31; float s = KIN(5)[(size_t)l * 3 * DM + j0 + c];
            for (int q = 0; q < 16; ++q) s += red[(q * 5 + bi) * 32 + c];
            WSF(WS_MOD)[((size_t)l * 5 + bi) * (3 * DM) + j0 + c] = s; }
        __syncthreads();
    }
}

__device__ __forceinline__ void p_norm(Frame& F, CArgs* ka, int l, bool dry = false) {
    const int tid = tid_fresh(), lane = tid & 63, wave = __builtin_amdgcn_readfirstlane(tid >> 6); (void)lane; (void)wave;
    const int gw = F.wg * NWAVES + wave, NGW = F.G * NWAVES;
    for (int r = gw; r < MROWS; r += NGW) {
        const int b = r / TPB, t = r - b * TPB; const bool isctx = t >= SEQ; const int bi = isctx ? 4 : b;
        if (l == DEPTH && isctx) continue;
        f32x4 v[8];
        if (l == 0) { const float* src = isctx ? KIN(2) + ((size_t)b * CTXL + (t - SEQ)) * DM : KIN(0) + ((size_t)b * SEQ + t) * DM;
#pragma unroll
            for (int j = 0; j < 8; ++j) v[j] = *(const f32x4*)(src + j * 256 + lane * 4);
        } else {
            const float* xr = WSF(WS_X) + (size_t)r * DM; f32x4 y[8]; float ss = 0.f;
#if Y_BF16
            const bf16_t* yr = WSB(WS_Y) + (size_t)r * DM;
#define LDY(p) ({ const v2u w_ = *(const v2u*)(p); (f32x4){blo(w_.x), bhi(w_.x), blo(w_.y), bhi(w_.y)}; })
#else
            const float* yr = WSF(WS_Y) + (size_t)r * DM;
#define LDY(p) (*(const f32x4*)(p))
#endif
#pragma unroll
            for (int j = 0; j < 8; ++j) { y[j] = LDY(yr + j * 256 + lane * 4);
                if (SPLIT_CTX && isctx && F.G == 256) y[j] = y[j] + LDY(yr + (size_t)MROWS * DM + j * 256 + lane * 4) + LDY(yr + 2 * (size_t)MROWS * DM + j * 256 + lane * 4);
                ss += y[j].x * y[j].x + y[j].y * y[j].y + y[j].z * y[j].z + y[j].w * y[j].w; }
            const float rs = rsqrtf(wave_sum(ss, lane) * (1.f / DM) + EPS);
            const float* gate = WSF(WS_MOD) + ((size_t)(l - 1) * 5 + bi) * (3 * DM) + 2 * DM; const float* npost = KIN(7) + (size_t)(l - 1) * DM;
#pragma unroll
            for (int j = 0; j < 8; ++j) { const int c = j * 256 + lane * 4; const f32x4 g = *(const f32x4*)(gate + c), w = *(const f32x4*)(npost + c), xv = *(const f32x4*)(xr + c);
                v[j] = xv + g * (y[j] * rs * w); }
        }
        if (l == DEPTH) { float* o = (ka->out) + ((size_t)b * SEQ + t) * DM;
#pragma unroll
            for (int j = 0; j < 8; ++j) *(f32x4*)(o + j * 256 + lane * 4) = v[j];
            continue; }
        float* xo = (dry ? WSF(WS_ACC) : WSF(WS_X)) + (size_t)r * DM; float ss = 0.f;
#pragma unroll
        for (int j = 0; j < 8; ++j) { *(f32x4*)(xo + j * 256 + lane * 4) = v[j]; ss += v[j].x * v[j].x + v[j].y * v[j].y + v[j].z * v[j].z + v[j].w * v[j].w; }
        const float rs = rsqrtf(wave_sum(ss, lane) * (1.f / DM) + EPS);
        const float* shift = WSF(WS_MOD) + ((size_t)l * 5 + bi) * (3 * DM); const float* scale = shift + DM; const float* npre = KIN(6) + (size_t)l * DM;
        bf16_t* ho = (dry ? WSB(WS_G2) : WSB(WS_H)) + (size_t)r * DM;
#pragma unroll
        for (int j = 0; j < 8; ++j) { const int c = j * 256 + lane * 4; const f32x4 sh = *(const f32x4*)(shift + c), scv = *(const f32x4*)(scale + c), w = *(const f32x4*)(npre + c);
            const f32x4 h = v[j] * rs * w * (scv + 1.f) + sh; v2u o; o.x = pk2(h.x, h.y); o.y = pk2(h.z, h.w); *(v2u*)(ho + c) = o; }
    }
}

__device__ __forceinline__ void p_gates(Frame& F, CArgs* ka, int l, int wk0, int nwk) {
    const int tid = tid_fresh(), lane = tid & 63, wave = __builtin_amdgcn_readfirstlane(tid >> 6), c16 = lane & 15, q = lane >> 4;
    typedef short bf16x8 __attribute__((ext_vector_type(8)));
    LAS float* GL = (LAS float*)F.lds;
    const bf16_t* H = WSB(WS_H); const bf16_t* WG = WSB(WS_WG) + (size_t)l * 32 * DM; float* GT = WSF(WS_GT); f32x4* GSC = (f32x4*)WSF(WS_GSC);
    for (int task = wk0; task < NBATCH * 36; task += nwk) { const int b = task / 36, chunk = task - b * 36; const size_t row0 = (size_t)b * TPB + chunk * 64;
        __syncthreads();
        { const int rb = wave & 3, kh = wave >> 2; f32x4 a0 = {0.f, 0.f, 0.f, 0.f}, a1 = {0.f, 0.f, 0.f, 0.f};
          const bf16_t* hp = H + (row0 + rb * 16 + c16) * DM + kh * 1024 + q * 8; const bf16_t* w0 = WG + (size_t)c16 * DM + kh * 1024 + q * 8; const bf16_t* w1 = w0 + 16 * DM;
#pragma unroll 8
          for (int ks = 0; ks < 32; ++ks) { const bf16x8 av = *(const bf16x8*)(hp + ks * 32), b0 = *(const bf16x8*)(w0 + ks * 32), b1 = *(const bf16x8*)(w1 + ks * 32);
              a0 = __builtin_amdgcn_mfma_f32_16x16x32_bf16(av, b0, a0, 0, 0, 0); a1 = __builtin_amdgcn_mfma_f32_16x16x32_bf16(av, b1, a1, 0, 0, 0); }
#pragma unroll
          for (int j = 0; j < 4; ++j) { GL[(kh * 64 + rb * 16 + q * 4 + j) * 33 + c16] = a0[j]; GL[(kh * 64 + rb * 16 + q * 4 + j) * 33 + 16 + c16] = a1[j]; } }
        __syncthreads();
#pragma unroll
        for (int i = 0; i < 4; ++i) { const int idx = tid + 512 * i, r = idx >> 5, c = idx & 31; float s = GL[r * 33 + c] + GL[(64 + r) * 33 + c] + KIN(16)[l * 32 + c];
            if ((c >> 3) & 1) s = fminf(s, 0.f) - __logf(1.f + __expf(-fabsf(s)));
            GL[r * 33 + c] = s; GT[(row0 + r) * 32 + c] = s; }
        __syncthreads();
#pragma unroll
        for (int pi = 0; pi < 2; ++pi) { const int p = wave * 2 + pi, dir = p >> 3, h = p & 7, rl = dir ? 63 - lane : lane;
            const float gi = GL[rl * 33 + dir * 16 + h]; float bc = GL[rl * 33 + dir * 16 + 8 + h];
#pragma unroll
            for (int o = 1; o < 64; o <<= 1) { const float v = lane_up(bc, o, lane); if (lane >= o) bc += v; }
            const float g = gi - bc; float pm = g;
#pragma unroll
            for (int o = 1; o < 64; o <<= 1) { const float v = lane_up(pm, o, lane); if (lane >= o) pm = fmaxf(pm, v); }
            GSC[((((size_t)b * 2 + dir) * 8 + h) * 36 + chunk) * 64 + lane] = (f32x4){bc, g, pm, 0.f}; }
    }
    __syncthreads();
}
__device__ __forceinline__ void p_knorm(Frame& F, CArgs* ka, int l, bool dry = false) {
    const int tid = tid_fresh(), lane = tid & 63, wave = __builtin_amdgcn_readfirstlane(tid >> 6);
    const int gw = F.wg * NWAVES + wave, NGW = F.G * NWAVES; const int sub = lane & 15;
    f32x4 kn0 = *(const f32x4*)(KIN(19) + l * 128 + sub * 8), kn1 = *(const f32x4*)(KIN(19) + l * 128 + sub * 8 + 4);
    for (int r = gw; r < MROWS; r += NGW) { const int b = r / TPB, t = r - b * TPB;
        bf16_t* kp = WSB(WS_P) + (size_t)r * NP + C_AK + lane * 8; const v4u raw = *(const v4u*)kp; float v[8];
#pragma unroll
        for (int e = 0; e < 4; ++e) { v[2 * e] = blo(raw[e]); v[2 * e + 1] = bhi(raw[e]); }
        float ss = 0.f;
#pragma unroll
        for (int e = 0; e < 8; ++e) ss += v[e] * v[e];
        ss += lane_xor(ss, 1, lane); ss += lane_xor(ss, 2, lane); ss += lane_xor(ss, 4, lane); ss += lane_xor(ss, 8, lane);
        const float rs = rsqrtf(ss * (1.f / 128.f) + EPS);
#pragma unroll
        for (int e = 0; e < 8; ++e) v[e] *= rs * (e < 4 ? kn0[e & 3] : kn1[e & 3]);
        if (t < SEQ) { const int i0 = (sub & 7) * 8; const float* cp = WSF(WS_ROPE) + (size_t)t * 64 + i0; const float* sp = cp + SEQ * 64;
            const f32x4 c0 = *(const f32x4*)cp, c1 = *(const f32x4*)(cp + 4), s0 = *(const f32x4*)sp, s1 = *(const f32x4*)(sp + 4); const bool upper = (sub & 8) != 0;
#pragma unroll
            for (int e = 0; e < 8; ++e) { const float o = lane_xor(v[e], 8, lane), c = e < 4 ? c0[e & 3] : c1[e & 3], sn = e < 4 ? s0[e & 3] : s1[e & 3];
                v[e] = upper ? v[e] * c + o * sn : v[e] * c - o * sn; } }
        v4u ov; ov.x = pk2(v[0], v[1]); ov.y = pk2(v[2], v[3]); ov.z = pk2(v[4], v[5]); ov.w = pk2(v[6], v[7]);
        if (dry) *(v4u*)(WSB(WS_ACC) + (size_t)r * 512 + lane * 8) = ov; else *(v4u*)kp = ov; }
}

__device__ __forceinline__ void p_lru_gates_naive(Frame& F, CArgs* ka, int l) {
    const int tid = tid_fresh(); (void)tid;
    LAS float* xs = (LAS float*)F.lds;
    for (int it = F.wg; it < (MROWS / 16) * 16; it += F.G) { const int rt = it >> 4, blk = it & 15;
        __syncthreads();
#pragma unroll
        for (int j = 0; j < 4; ++j) { const int idx = tid + 512 * j, rr = idx >> 7, c = idx & 127, r = rt * 16 + rr, b = r / TPB, t = r - b * TPB, ch = blk * 128 + c;
            const int lo = t < SEQ ? 0 : SEQ, hi = t < SEQ ? SEQ : TPB; float a = KIN(10)[l * DM + ch];
#pragma unroll
            for (int k = 0; k < 4; ++k) { const int tt = t + k - 2; if (tt >= lo && tt < hi) a += KIN(9)[((size_t)l * 4 + k) * DM + ch] * bf2f(WSB(WS_P)[((size_t)b * TPB + tt) * NP + C_LX + ch]); }
            xs[rr * 128 + c] = a; }
        __syncthreads();
        const int co = tid & 127, r0 = tid >> 7, ch = blk * 128 + co;
#pragma unroll 1
        for (int dr = 0; dr < 2; ++dr) {
            const float* wr = KIN(11) + (((size_t)l * 2 + dr) * 16 + blk) * 16384 + co; const float* wi = KIN(13) + (((size_t)l * 2 + dr) * 16 + blk) * 16384 + co;
            float ar[4], ai[4];
#pragma unroll
            for (int j = 0; j < 4; ++j) { ar[j] = KIN(12)[((size_t)l * 2 + dr) * DM + ch]; ai[j] = KIN(14)[((size_t)l * 2 + dr) * DM + ch]; }
            for (int c = 0; c < 128; ++c) { const float w0 = wr[c * 128], w1 = wi[c * 128];
#pragma unroll
                for (int j = 0; j < 4; ++j) { const float xv = xs[(r0 + 4 * j) * 128 + c]; ar[j] += xv * w0; ai[j] += xv * w1; } }
            const float lam = KIN(15)[((size_t)l * 2 + dr) * DM + ch], sp = log1pf(expf(-lam));
#pragma unroll
            for (int j = 0; j < 4; ++j) { const int r = rt * 16 + r0 + 4 * j; const float rg = 1.f / (1.f + expf(-ar[j])), ig = 1.f / (1.f + expf(-ai[j]));
                const float log_a = -8.f * rg * sp, a = expf(log_a), mult = sqrtf(-expm1f(2.f * log_a));
                WSF(WS_LA)[((size_t)dr * MROWS + r) * DM + ch] = a; WSF(WS_LB)[((size_t)dr * MROWS + r) * DM + ch] = mult * ig * xs[(r0 + 4 * j) * 128 + co]; }
        }
    }
    __syncthreads();
}

__device__ __forceinline__ void p_attention(Frame& F, CArgs* ka, int l, bool need_ctx) {
    using att::bf16;
    const int n_lat = NBATCH * 16 * 8, n_all = n_lat + (need_ctx ? NBATCH * 16 : 0);
    for (int u = F.wg; u < n_all; u += F.G) {
        int b, h, q0, k0, seq; const float *cs = nullptr, *sn = nullptr;
        if (u < n_lat) { const int qb = u & 7; h = (u >> 3) & 15; b = u >> 7; q0 = qb * 256; k0 = 0; seq = TPB; cs = WSF(WS_ROPE) + (size_t)q0 * 64; sn = WSF(WS_ROPE) + (size_t)SEQ * 64 + (size_t)q0 * 64; }
        else { const int v = u - n_lat; h = v & 15; b = v >> 4; q0 = SEQ; k0 = SEQ; seq = CTXL; }
        const size_t rq = (size_t)b * TPB + q0, rk = (size_t)b * TPB + k0; const int kvh = h >> 2;
        att::attn_unit((const bf16*)(WSB(WS_P) + rq * NP + C_AQ + h * 128), (const bf16*)(WSB(WS_P) + rk * NP + C_AK + kvh * 128), (const bf16*)(WSB(WS_P) + rk * NP + C_AV + kvh * 128),
                       (const bf16*)(WSB(WS_P) + rq * NP + C_AZ + h * 128), (bf16*)(WSB(WS_YB) + ((size_t)2 * MROWS + rq) * DM + h * 128), seq, F.ldsg, KIN(18) + l * 128, cs, sn);
    }
}
__device__ __forceinline__ int seq_row(int s, int dir) { return s < CTXL ? SEQ + (dir ? CTXL - 1 - s : s) : (dir ? SEQ - 1 - (s - CTXL) : s - CTXL); }
__device__ __forceinline__ void p_mlstm_naive(Frame& F, CArgs* ka, int l) {
    const int tid = tid_fresh(), lane = tid & 63, wave = __builtin_amdgcn_readfirstlane(tid >> 6); (void)lane; (void)wave;
    LAS float* sq = (LAS float*)F.lds; LAS float* sk = sq + 256; LAS float* rn = sk + 256; LAS float* rd = rn + 512;
    const int e = tid & 63, dg = tid >> 6;
    for (int u = F.wg; u < 256; u += F.G) { const int es = u & 3, dir = (u >> 2) & 1, h = (u >> 3) & 7, b = u >> 6;
        float C[32], n[32];
#pragma unroll
        for (int i = 0; i < 32; ++i) { C[i] = 0.f; n[i] = 0.f; }
        float m = -1e30f;
        const int lcol = tid < 64 ? C_MQ + h * 256 + tid * 4 : C_MK + h * 256 + (tid - 64) * 4, vcol = C_MV + h * 256 + es * 64 + e;
        v2u pqk = {0u, 0u}; bf16_t pv; float gi, gf;
        { const size_t r = (size_t)b * TPB + seq_row(0, dir); if (tid < 128) pqk = *(const v2u*)(WSB(WS_P) + r * NP + lcol); pv = WSB(WS_P)[r * NP + vcol]; gi = WSF(WS_GT)[r * 32 + dir * 16 + h]; gf = WSF(WS_GT)[r * 32 + dir * 16 + 8 + h]; }
        __syncthreads();
        for (int s = 0; s < TPB; ++s) {
            const size_t r = (size_t)b * TPB + seq_row(s, dir);
            if (tid < 128) { LAS float* d = (tid < 64 ? sq : sk) + (tid & 63) * 4; d[0] = blo(pqk.x); d[1] = bhi(pqk.x); d[2] = blo(pqk.y); d[3] = bhi(pqk.y); }
            const float vv = bf2f(pv), iv = gi, lf = gf;
            __syncthreads();
            if (s + 1 < TPB) { const size_t r2 = (size_t)b * TPB + seq_row(s + 1, dir); if (tid < 128) pqk = *(const v2u*)(WSB(WS_P) + r2 * NP + lcol); pv = WSB(WS_P)[r2 * NP + vcol]; gi = WSF(WS_GT)[r2 * 32 + dir * 16 + h]; gf = WSF(WS_GT)[r2 * 32 + dir * 16 + 8 + h]; }
            const float mnew = fmaxf(lf + m, iv), fw = expf(lf + m - mnew), iw = expf(iv - mnew); m = mnew;
            float pn = 0.f, pd = 0.f;
#pragma unroll
            for (int dd = 0; dd < 32; ++dd) { const float kd = sk[dg * 32 + dd], qd = sq[dg * 32 + dd]; C[dd] = fw * C[dd] + iw * kd * vv; n[dd] = fw * n[dd] + iw * kd; pn += qd * C[dd]; pd += qd * n[dd]; }
            rn[dg * 64 + e] = pn; rd[dg * 64 + e] = pd;
            __syncthreads();
            if (dg == 0) { float num = 0.f, den = 0.f;
#pragma unroll
                for (int g = 0; g < 8; ++g) { num += rn[g * 64 + e]; den += rd[g * 64 + e]; }
                WSB(WS_MH)[((size_t)dir * MROWS + r) * DM + h * 256 + es * 64 + e] = (bf16_t)f2bf(num / fmaxf(fabsf(den), expf(-m))); }
        }
        __syncthreads();
    }
}
__device__ __forceinline__ void p_lru_scan_naive(Frame& F, CArgs* ka) {
    const int tid = tid_fresh(), lane = tid & 63, wave = __builtin_amdgcn_readfirstlane(tid >> 6); (void)lane; (void)wave;
    if (wave != 0) return;
    for (int cw = F.wg; cw < 256; cw += F.G) { const int combo = cw * 64 + lane, b = combo >> 12, dir = (combo >> 11) & 1, ch = combo & 2047;
        const float* A = WSF(WS_LA) + (size_t)dir * MROWS * DM + ch; const float* Bx = WSF(WS_LB) + (size_t)dir * MROWS * DM + ch; float* Ho = WSF(WS_HL) + (size_t)dir * MROWS * DM + ch; float h = 0.f;
#pragma unroll 8
        for (int s = 0; s < TPB; ++s) { const size_t r = (size_t)b * TPB + seq_row(s, dir); h = A[r * DM] * h + Bx[r * DM]; Ho[r * DM] = h; }
    }
}

__device__ __forceinline__ void p_mlout(Frame& F, CArgs* ka, int l, bool need_ctx) {
    const int tid = tid_fresh(), lane = tid & 63, wave = __builtin_amdgcn_readfirstlane(tid >> 6); (void)lane; (void)wave;
    const int gw = F.wg * NWAVES + wave, NGW = F.G * NWAVES, nrow = need_ctx ? MROWS : NBATCH * SEQ;
    for (int ri = gw; ri < nrow; ri += NGW) { const int r = need_ctx ? ri : (ri >> 11) * TPB + (ri & 2047);
        const bf16_t* pr = WSB(WS_P) + (size_t)r * NP;
#pragma unroll 2
        for (int h = 0; h < 8; ++h) { const int col = h * 256 + lane * 4;
            const v2u ma = *(const v2u*)(WSB(WS_MH) + (size_t)r * DM + col), mb = *(const v2u*)(WSB(WS_MH) + ((size_t)MROWS + r) * DM + col);
            const f32x4 a = {blo(ma.x), bhi(ma.x), blo(ma.y), bhi(ma.y)}, bb = {blo(mb.x), bhi(mb.x), blo(mb.y), bhi(mb.y)};
            const v2u ow = *(const v2u*)(pr + C_MO + col), zw = *(const v2u*)(pr + C_MZ + col); const f32x4 g = *(const f32x4*)(KIN(17) + (size_t)l * DM + col);
            f32x4 v = a + bb; v.x *= blo(ow.x); v.y *= bhi(ow.x); v.z *= blo(ow.y); v.w *= bhi(ow.y);
            const float rs = rsqrtf(wave_sum(v.x * v.x + v.y * v.y + v.z * v.z + v.w * v.w, lane) * (1.f / 256.f) + EPS);
            v2u o; o.x = pk2(v.x * rs * g.x * blo(zw.x), v.y * rs * g.y * bhi(zw.x)); o.y = pk2(v.z * rs * g.z * blo(zw.y), v.w * rs * g.w * bhi(zw.y));
            *(v2u*)(WSB(WS_YB) + ((size_t)MROWS + r) * DM + col) = o; }
    }
}

__device__ __forceinline__ void p_lru_combine_naive(Frame& F, CArgs* ka) {
    const int tid = tid_fresh(), lane = tid & 63, wave = __builtin_amdgcn_readfirstlane(tid >> 6);
    const int gw = F.wg * NWAVES + wave, NGW = F.G * NWAVES;
    for (int r = gw; r < MROWS; r += NGW) {
        const bf16_t* pr = WSB(WS_P) + (size_t)r * NP;
#pragma unroll 2
        for (int j = 0; j < 8; ++j) { const int col = j * 256 + lane * 4;
            const f32x4 a = *(const f32x4*)(WSF(WS_HL) + (size_t)r * DM + col), bb = *(const f32x4*)(WSF(WS_HL) + ((size_t)MROWS + r) * DM + col); const v2u zw = *(const v2u*)(pr + C_LZ + col);
            const f32x4 v = a + bb; v2u o; o.x = pk2(v.x * blo(zw.x), v.y * bhi(zw.x)); o.y = pk2(v.z * blo(zw.y), v.w * bhi(zw.y));
            *(v2u*)(WSB(WS_YB) + (size_t)r * DM + col) = o; }
    }
}
#ifndef USE_NAIVE_ML
#define USE_NAIVE_ML 0
#endif
#ifndef USE_NAIVE_LRU
#define USE_NAIVE_LRU 0
#endif

namespace ml {
typedef short bf16x8 __attribute__((ext_vector_type(8)));
constexpr int KS_OFF = 0, KS_PITCH = 528;
constexpr int KT_OFF = KS_OFF + 64 * KS_PITCH, KT_PITCH = 144;
constexpr int VT_OFF = KT_OFF + 256 * KT_PITCH, VT_PITCH = 144;
constexpr int ST_OFF = VT_OFF + 80 * VT_PITCH, ST_PITCH = 144;
constexpr int CT_OFF = ST_OFF + 64 * ST_PITCH, CT_PITCH = 528;
constexpr int TAB_OFF = CT_OFF + 80 * CT_PITCH;
constexpr int END_OFF = TAB_OFF + 1024;
static_assert(END_OFF <= MISC_OFF, "mLSTM LDS map");
#define ML_MFMA(a, b, c) __builtin_amdgcn_mfma_f32_16x16x32_bf16((a), (b), (c), 0, 0, 0)
__device__ __forceinline__ int chunk_of(int k, int dir) { return k < 4 ? (dir ? 35 - k : 32 + k) : (dir ? 31 - (k - 4) : k - 4); }

__device__ __forceinline__ void mlstm_unit(Frame& F, CArgs* ka, int u, bool need_ctx) {
    const int tid = tid_fresh(), lane = tid & 63, w = __builtin_amdgcn_readfirstlane(tid >> 6), c16 = lane & 15, q = lane >> 4;
    const int es = u & 3, dir = (u >> 2) & 1, h = (u >> 3) & 7, b = u >> 6;
    LAS unsigned char* L = F.lds;
    const bf16_t* P = WSB(WS_P); bf16_t* MH = WSB(WS_MH) + (size_t)dir * MROWS * DM;
    const f32x4* GSC = (const f32x4*)WSF(WS_GSC) + (((size_t)b * 2 + dir) * 8 + h) * 36 * 64;
    LAS float* TABg = (LAS float*)(L + TAB_OFF); LAS float* TABmm = TABg + 64; LAS float* TABbc = TABg + 128;
    __syncthreads();
    { unsigned z0 = 0u; asm volatile("" : "+v"(z0)); const v4u zz = {z0, z0, z0, z0};
      for (int i = tid; i < 80 * CT_PITCH / 16; i += 512) *(LAS v4u*)(L + CT_OFF + i * 16) = zz; }
    for (int i = tid; i < 16 * 64; i += 512) { const int e = 64 + (i >> 6), s = i & 63; *(LAS bf16_t*)(L + VT_OFF + e * VT_PITCH + s * 2) = (bf16_t)(e == 64 ? 0x3F80 : 0); }
    f32x4 C[2][5];
#pragma unroll
    for (int a = 0; a < 2; ++a)
#pragma unroll
        for (int e = 0; e < 5; ++e) C[a][e] = (f32x4){0.f, 0.f, 0.f, 0.f};
    float m = -1e30f;
    const int tn = w & 3, wh = w >> 2;
    v4u kraw[4], vraw; bf16x8 Qf[8]; float gsc0, gsc1, gsc2;
#define ML_ROW(base, j) ((size_t)(base) + (dir ? 63 - (j) : (j)))
#define ML_LOAD_KVG(k) do { const int _c = chunk_of((k), dir), _base = b * TPB + _c * 64; const bf16_t* _rp = P + ML_ROW(_base, lane) * NP; \
        _Pragma("unroll") for (int i = 0; i < 4; ++i) kraw[i] = *(const v4u*)(_rp + C_MK + h * 256 + (w * 4 + i) * 8); \
        vraw = *(const v4u*)(_rp + C_MV + h * 256 + es * 64 + w * 8); { const float* _gp = (const float*)(GSC + _c * 64 + lane); gsc0 = _gp[0]; gsc1 = _gp[1]; gsc2 = _gp[2]; } } while (0)
#define ML_LOAD_Q(k) do { const int _base = b * TPB + chunk_of((k), dir) * 64; const bf16_t* _qp = P + ML_ROW(_base, tn * 16 + c16) * NP + C_MQ + h * 256 + q * 8; \
        _Pragma("unroll") for (int ks = 0; ks < 8; ++ks) Qf[ks] = *(const bf16x8*)(_qp + ks * 32); } while (0)
    ML_LOAD_KVG(0); ML_LOAD_Q(0);
    float bL = 0.f, mm63 = 0.f;
#pragma unroll 1
    for (int k = 0; k < 36; ++k) {
        const int base = b * TPB + chunk_of(k, dir) * 64; const bool do_out = need_ctx || k >= 4;
        if (k > 0) {
#pragma unroll
            for (int di = 0; di < 2; ++di)
#pragma unroll
                for (int en = 0; en < 5; ++en) { const f32x4 c = C[di][en]; v2u o; o.x = pk2(c[0], c[1]); o.y = pk2(c[2], c[3]);
                    *(LAS v2u*)(L + CT_OFF + (en * 16 + c16) * CT_PITCH + ((2 * w + di) * 16 + q * 4) * 2) = o; }
            m = bL + mm63; }
        const float bc = gsc0, g = gsc1, mm = fmaxf(gsc2, m), wk = __expf(g - lane_get(mm, 63));
        bL = lane_get(bc, 63); mm63 = lane_get(mm, 63);
        if (w == 0) { TABg[lane] = g; TABmm[lane] = mm; TABbc[lane] = bc; }
#pragma unroll
        for (int i = 0; i < 4; ++i) { *(LAS v4u*)(L + KS_OFF + lane * KS_PITCH + (w * 4 + i) * 16) = kraw[i];
#pragma unroll
            for (int e = 0; e < 4; ++e) { const unsigned x = kraw[i][e]; const unsigned pk = pk2(blo(x) * wk, bhi(x) * wk);
                *(LAS bf16_t*)(L + KT_OFF + ((w * 4 + i) * 8 + 2 * e) * KT_PITCH + lane * 2) = (bf16_t)(pk & 0xffffu); *(LAS bf16_t*)(L + KT_OFF + ((w * 4 + i) * 8 + 2 * e + 1) * KT_PITCH + lane * 2) = (bf16_t)(pk >> 16); } }
#pragma unroll
        for (int e = 0; e < 4; ++e) { const unsigned x = vraw[e];
            *(LAS bf16_t*)(L + VT_OFF + (w * 8 + 2 * e) * VT_PITCH + lane * 2) = (bf16_t)(x & 0xffffu); *(LAS bf16_t*)(L + VT_OFF + (w * 8 + 2 * e + 1) * VT_PITCH + lane * 2) = (bf16_t)(x >> 16); }
        __syncthreads();
        const int t = tn * 16 + c16; const int kn = k + 1 < 36 ? k + 1 : 35;
        if (do_out) {
            const float mmt = TABmm[t];
#pragma unroll
            for (int si = 0; si < 2; ++si) { const int sm = wh * 2 + si; v2u o = {0u, 0u};
                if (sm <= tn) { f32x4 acc = {0.f, 0.f, 0.f, 0.f};
#pragma unroll
                    for (int ks = 0; ks < 8; ++ks) { const bf16x8 a = *(const LAS bf16x8*)(L + KS_OFF + (sm * 16 + c16) * KS_PITCH + (ks * 32 + q * 8) * 2); acc = ML_MFMA(a, Qf[ks], acc); }
                    float v[4];
#pragma unroll
                    for (int j = 0; j < 4; ++j) { const int s = sm * 16 + q * 4 + j; v[j] = s <= t ? acc[j] * __expf(TABg[s] - mmt) : 0.f; }
                    o.x = pk2(v[0], v[1]); o.y = pk2(v[2], v[3]); }
                *(LAS v2u*)(L + ST_OFF + t * ST_PITCH + (sm * 16 + q * 4) * 2) = o; }
        }
        ML_LOAD_KVG(kn);
        __syncthreads();
        f32x4 num0 = {0.f, 0.f, 0.f, 0.f}, num1 = {0.f, 0.f, 0.f, 0.f}; float den = 1.f;
        if (do_out) {
            const float wi = __expf(m - TABmm[t]);
            bf16x8 sb[2];
#pragma unroll
            for (int ks = 0; ks < 2; ++ks) sb[ks] = *(const LAS bf16x8*)(L + ST_OFF + t * ST_PITCH + (ks * 32 + q * 8) * 2);
#pragma unroll
            for (int ei = 0; ei < 3; ++ei) { const int em = ei < 2 ? wh * 2 + ei : 4;
                f32x4 a1 = {0.f, 0.f, 0.f, 0.f}, a2 = {0.f, 0.f, 0.f, 0.f};
#pragma unroll
                for (int ks = 0; ks < 2; ++ks) { const bf16x8 a = *(const LAS bf16x8*)(L + VT_OFF + (em * 16 + c16) * VT_PITCH + (ks * 32 + q * 8) * 2); a1 = ML_MFMA(a, sb[ks], a1); }
#pragma unroll
                for (int ks = 0; ks < 8; ++ks) { const bf16x8 a = *(const LAS bf16x8*)(L + CT_OFF + (em * 16 + c16) * CT_PITCH + (ks * 32 + q * 8) * 2); a2 = ML_MFMA(a, Qf[ks], a2); }
                const f32x4 nv = a1 + a2 * wi;
                if (ei == 0) num0 = nv; else if (ei == 1) num1 = nv;
                else den = fmaxf(fabsf(lane_get(nv[0], c16)), __expf(-(TABbc[t] + TABmm[t]))); }
        }
        ML_LOAD_Q(kn);
        if (do_out) { const float rd = 1.f / den; bf16_t* op = MH + ML_ROW(base, t) * DM + h * 256 + es * 64 + q * 4; const f32x4 o0 = num0 * rd, o1 = num1 * rd;
            v2u w0, w1; w0.x = pk2(o0[0], o0[1]); w0.y = pk2(o0[2], o0[3]); w1.x = pk2(o1[0], o1[1]); w1.y = pk2(o1[2], o1[3]);
            *(v2u*)(op + (wh * 2) * 16) = w0; *(v2u*)(op + (wh * 2 + 1) * 16) = w1; }
        { const float decay = __expf(m - mm63);
          bf16x8 vb[5][2];
#pragma unroll
          for (int en = 0; en < 5; ++en)
#pragma unroll
              for (int ks = 0; ks < 2; ++ks) vb[en][ks] = *(const LAS bf16x8*)(L + VT_OFF + (en * 16 + c16) * VT_PITCH + (ks * 32 + q * 8) * 2);
#pragma unroll
          for (int di = 0; di < 2; ++di) {
            bf16x8 a[2];
#pragma unroll
            for (int ks = 0; ks < 2; ++ks) a[ks] = *(const LAS bf16x8*)(L + KT_OFF + ((2 * w + di) * 16 + c16) * KT_PITCH + (ks * 32 + q * 8) * 2);
#pragma unroll
            for (int en = 0; en < 5; ++en) { f32x4 c = C[di][en] * decay;
#pragma unroll
                for (int ks = 0; ks < 2; ++ks) c = ML_MFMA(a[ks], vb[en][ks], c);
                C[di][en] = c; } } }
        __syncthreads();
    }
#undef ML_ROW
#undef ML_LOAD_KVG
#undef ML_LOAD_Q
}
constexpr int ST2_OFF = TAB_OFF + 1024, TAB2_OFF = ST2_OFF + 64 * ST_PITCH, END2_OFF = TAB2_OFF + 1024;
static_assert(END2_OFF <= MISC_OFF, "mLSTM LDS map (pipelined)");
template <int VAR> __device__ __forceinline__ void mlstm_unit_pipe(Frame& F, CArgs* ka, int u, bool need_ctx) {
    const int tid = tid_fresh(), lane = tid & 63, w = __builtin_amdgcn_readfirstlane(tid >> 6), c16 = lane & 15, q = lane >> 4;
    const int es = u & 3, dir = (u >> 2) & 1, h = (u >> 3) & 7, b = u >> 6;
    LAS unsigned char* L = F.lds;
    const bf16_t* X8 = WSB(WS_X8); constexpr size_t X8_SEC = (size_t)MROWS * DM; bf16_t* MH = (VAR ? WSB(WS_ACC) : WSB(WS_MH)) + (size_t)dir * MROWS * DM;
    const f32x4* GSC = (const f32x4*)WSF(WS_GSC) + (((size_t)b * 2 + dir) * 8 + h) * 36 * 64;
    __syncthreads();
    { unsigned z0 = 0u; asm volatile("" : "+v"(z0)); const v4u zz = {z0, z0, z0, z0};
      for (int i = tid; i < 80 * CT_PITCH / 16; i += 512) *(LAS v4u*)(L + CT_OFF + i * 16) = zz; }
    for (int i = tid; i < 16 * 64; i += 512) { const int e = 64 + (i >> 6), s = i & 63; *(LAS bf16_t*)(L + VT_OFF + e * VT_PITCH + s * 2) = (bf16_t)(e == 64 ? 0x3F80 : 0); }
    f32x4 C[2][5];
#pragma unroll
    for (int a = 0; a < 2; ++a)
#pragma unroll
        for (int e = 0; e < 5; ++e) C[a][e] = (f32x4){0.f, 0.f, 0.f, 0.f};
    const int tn = w & 3, wh = w >> 2, t = tn * 16 + c16;
    const int kl = (dir ? 63 - lane : lane) * 8, ql = q * 512 + (dir ? 63 - t : t) * 8;
    v4u kc[4], kn[4], vc; bf16x8 Qc[8], Qn[8]; float gc0, gc1, gc2, gn0, gn1, gn2;
#define MLP_ROW(base, j) ((size_t)(base) + (dir ? 63 - (j) : (j)))
#define MLP_TAB(par) ((LAS float*)(L + ((par) ? TAB2_OFF : TAB_OFF)))
#define MLP_ST(par) ((par) ? ST2_OFF : ST_OFF)
#define MLP_XB(sec, c_) (X8 + (size_t)(sec) * X8_SEC + ((size_t)(b * 8 + h) * 36 + (c_)) * (32 * 64 * 8))
#define MLP_LOADK(dst, k) do { const bf16_t* _xb = MLP_XB(1, chunk_of((k), dir)) + w * 4 * 512; \
        _Pragma("unroll") for (int i = 0; i < 4; ++i) dst[i] = *(const v4u*)(_xb + i * 512 + kl); } while (0)
#define MLP_LOADV(dst, k) do { dst = *(const v4u*)(MLP_XB(2, chunk_of((k), dir)) + (es * 8 + w) * 512 + kl); } while (0)
#define MLP_LOADG(d0, d1, d2, k) do { const float* _gp = (const float*)(GSC + chunk_of((k), dir) * 64 + lane); d0 = _gp[0]; d1 = _gp[1]; d2 = _gp[2]; } while (0)
#define MLP_LOADQ(dst, k) do { const bf16_t* _xb = MLP_XB(0, chunk_of((k), dir)); \
        _Pragma("unroll") for (int ks = 0; ks < 8; ++ks) dst[ks] = *(const bf16x8*)(_xb + ks * 2048 + ql); } while (0)
#define MLP_STILE(QQ, TB, SO) do { const float _mmt = (TB)[64 + t]; \
        _Pragma("unroll") for (int si = 0; si < 2; ++si) { const int sm = wh * 2 + si; v2u o = {0u, 0u}; \
            if (sm <= tn) { f32x4 acc = {0.f, 0.f, 0.f, 0.f}; \
                bf16x8 ka_[8]; \
                _Pragma("unroll") for (int ks = 0; ks < 8; ++ks) ka_[ks] = *(const LAS bf16x8*)(L + KS_OFF + (sm * 16 + c16) * KS_PITCH + (ks * 32 + q * 8) * 2); \
                __builtin_amdgcn_sched_barrier(0); \
                _Pragma("unroll") for (int ks = 0; ks < 8; ++ks) acc = ML_MFMA(ka_[ks], QQ[ks], acc); \
                float v[4]; \
                _Pragma("unroll") for (int j = 0; j < 4; ++j) { const int s = sm * 16 + q * 4 + j; v[j] = s <= t ? acc[j] * __expf((TB)[s] - _mmt) : 0.f; } \
                o.x = pk2(v[0], v[1]); o.y = pk2(v[2], v[3]); } \
            *(LAS v2u*)(L + (SO) + t * ST_PITCH + (sm * 16 + q * 4) * 2) = o; } } while (0)
    MLP_LOADK(kc, 0); MLP_LOADV(vc, 0); MLP_LOADG(gc0, gc1, gc2, 0); MLP_LOADQ(Qc, 0); MLP_LOADK(kn, 1); MLP_LOADG(gn0, gn1, gn2, 1); MLP_LOADQ(Qn, 1);
    float m = -1e30f;
    {
      const float mm = fmaxf(gc2, m); LAS float* TB = MLP_TAB(0);
      if (w == 0) { TB[lane] = gc1; TB[64 + lane] = mm; TB[128 + lane] = gc0; }
#pragma unroll
      for (int i = 0; i < 4; ++i) *(LAS v4u*)(L + KS_OFF + lane * KS_PITCH + (w * 4 + i) * 16) = kc[i];
      __syncthreads();
      if (need_ctx) MLP_STILE(Qc, TB, MLP_ST(0));
      __syncthreads(); }
#pragma unroll 1
    for (int k = 0; k < 36; ++k) {
        const int par = k & 1, k1 = k + 1 < 36 ? k + 1 : 35, k2 = k + 2 < 36 ? k + 2 : 35;
        const bool do_out = need_ctx || k >= 4, s_next = (k + 1 < 36) && (need_ctx || k + 1 >= 4);
        const size_t base = (size_t)b * TPB + chunk_of(k, dir) * 64;
        if (k > 0 && VAR != 2) {
#pragma unroll
            for (int di = 0; di < 2; ++di)
#pragma unroll
                for (int en = 0; en < 5; ++en) { const f32x4 c = C[di][en]; v2u o; o.x = pk2(c[0], c[1]); o.y = pk2(c[2], c[3]);
                    *(LAS v2u*)(L + CT_OFF + (en * 16 + c16) * CT_PITCH + ((2 * w + di) * 16 + q * 4) * 2) = o; } }
        const float mm = fmaxf(gc2, m), bL = lane_get(gc0, 63), mm63 = lane_get(mm, 63), wk = __expf(gc1 - mm63), m_next = bL + mm63;
#pragma unroll
        for (int i = 0; i < (VAR == 2 ? 1 : 4); ++i) {
#pragma unroll
            for (int e = 0; e < (VAR == 2 ? 1 : 4); ++e) { const unsigned x = kc[i][e]; const unsigned pk = pk2(blo(x) * wk, bhi(x) * wk);
                *(LAS bf16_t*)(L + KT_OFF + ((w * 4 + i) * 8 + 2 * e) * KT_PITCH + lane * 2) = (bf16_t)(pk & 0xffffu); *(LAS bf16_t*)(L + KT_OFF + ((w * 4 + i) * 8 + 2 * e + 1) * KT_PITCH + lane * 2) = (bf16_t)(pk >> 16); } }
#pragma unroll
        for (int e = 0; e < 4; ++e) { const unsigned x = vc[e];
            *(LAS bf16_t*)(L + VT_OFF + (w * 8 + 2 * e) * VT_PITCH + lane * 2) = (bf16_t)(x & 0xffffu); *(LAS bf16_t*)(L + VT_OFF + (w * 8 + 2 * e + 1) * VT_PITCH + lane * 2) = (bf16_t)(x >> 16); }
        { const float mmn = fmaxf(gn2, m_next); LAS float* TBn = MLP_TAB(par ^ 1);
          if (w == 0) { TBn[lane] = gn1; TBn[64 + lane] = mmn; TBn[128 + lane] = gn0; }
#pragma unroll
          for (int i = 0; i < (VAR == 2 ? 1 : 4); ++i) *(LAS v4u*)(L + KS_OFF + lane * KS_PITCH + (w * 4 + i) * 16) = kn[i]; }
        __syncthreads();
#pragma unroll
        for (int i = 0; i < 4; ++i) kc[i] = kn[i];
        gc0 = gn0; gc1 = gn1; gc2 = gn2;
        if (VAR != 3) { MLP_LOADK(kn, k2); MLP_LOADV(vc, k1); MLP_LOADG(gn0, gn1, gn2, k2); }
        const LAS float* TB = MLP_TAB(par);
        if (do_out && VAR != 1) {
            const float wi = __expf(m - TB[64 + t]); f32x4 num0 = {0.f, 0.f, 0.f, 0.f}, num1 = {0.f, 0.f, 0.f, 0.f}; float den = 1.f;
            bf16x8 sb[2];
#pragma unroll
            for (int ks = 0; ks < 2; ++ks) sb[ks] = *(const LAS bf16x8*)(L + MLP_ST(par) + t * ST_PITCH + (ks * 32 + q * 8) * 2);
#pragma unroll
            for (int ei = 0; ei < 3; ++ei) { const int em = ei < 2 ? wh * 2 + ei : 4;
                f32x4 a1 = {0.f, 0.f, 0.f, 0.f}, a2 = {0.f, 0.f, 0.f, 0.f}; bf16x8 va_[2], ca_[8];
#pragma unroll
                for (int ks = 0; ks < 2; ++ks) va_[ks] = *(const LAS bf16x8*)(L + VT_OFF + (em * 16 + c16) * VT_PITCH + (ks * 32 + q * 8) * 2);
#pragma unroll
                for (int ks = 0; ks < 8; ++ks) ca_[ks] = *(const LAS bf16x8*)(L + CT_OFF + (em * 16 + c16) * CT_PITCH + (ks * 32 + q * 8) * 2);
                __builtin_amdgcn_sched_barrier(0);
#pragma unroll
                for (int ks = 0; ks < 2; ++ks) a1 = ML_MFMA(va_[ks], sb[ks], a1);
#pragma unroll
                for (int ks = 0; ks < 8; ++ks) a2 = ML_MFMA(ca_[ks], Qc[ks], a2);
                __builtin_amdgcn_sched_barrier(0);
                const f32x4 nv = a1 + a2 * wi;
                if (ei == 0) num0 = nv; else if (ei == 1) num1 = nv;
                else den = fmaxf(fabsf(lane_get(nv[0], c16)), __expf(-(TB[128 + t] + TB[64 + t]))); }
            const float rd = 1.f / den; bf16_t* op = MH + MLP_ROW(base, t) * DM + h * 256 + es * 64 + q * 4; const f32x4 o0 = num0 * rd, o1 = num1 * rd;
            v2u w0, w1; w0.x = pk2(o0[0], o0[1]); w0.y = pk2(o0[2], o0[3]); w1.x = pk2(o1[0], o1[1]); w1.y = pk2(o1[2], o1[3]);
            *(v2u*)(op + (wh * 2) * 16) = w0; *(v2u*)(op + (wh * 2 + 1) * 16) = w1;
        }
        if (VAR != 1) { const float decay = __expf(m - mm63); bf16x8 vb_[5][2], ka2_[2][2];
#pragma unroll
          for (int en = 0; en < 5; ++en)
#pragma unroll
              for (int ks = 0; ks < 2; ++ks) vb_[en][ks] = *(const LAS bf16x8*)(L + VT_OFF + (en * 16 + c16) * VT_PITCH + (ks * 32 + q * 8) * 2);
#pragma unroll
          for (int di = 0; di < 2; ++di)
#pragma unroll
              for (int ks = 0; ks < 2; ++ks) ka2_[di][ks] = *(const LAS bf16x8*)(L + KT_OFF + ((2 * w + di) * 16 + c16) * KT_PITCH + (ks * 32 + q * 8) * 2);
#pragma unroll
          for (int di = 0; di < 2; ++di)
#pragma unroll
              for (int en = 0; en < 5; ++en) C[di][en] = C[di][en] * decay;
          __builtin_amdgcn_sched_barrier(0);
#pragma unroll
          for (int di = 0; di < 2; ++di)
#pragma unroll
              for (int en = 0; en < 5; ++en)
#pragma unroll
                  for (int ks = 0; ks < 2; ++ks) C[di][en] = ML_MFMA(ka2_[di][ks], vb_[en][ks], C[di][en]);
          __builtin_amdgcn_sched_barrier(0); }
        if (s_next && VAR != 1) MLP_STILE(Qn, MLP_TAB(par ^ 1), MLP_ST(par ^ 1));
#pragma unroll
        for (int ks = 0; ks < 8; ++ks) Qc[ks] = Qn[ks];
        if (VAR != 3) MLP_LOADQ(Qn, k2);
        m = m_next;
        __syncthreads();
    }
#undef MLP_ROW
#undef MLP_TAB
#undef MLP_ST
#undef MLP_XB
#undef MLP_LOADK
#undef MLP_LOADV
#undef MLP_LOADG
#undef MLP_LOADQ
#undef MLP_STILE
}
constexpr int T_CT = 0, T_CT_ROWS = 65;
constexpr int T_KS0 = T_CT + T_CT_ROWS * CT_PITCH, T_KS1 = T_KS0 + 64 * KS_PITCH;
constexpr int T_VS = T_KS1 + 64 * KS_PITCH, T_VPITCH = 160, T_VSW = T_VS + 64 * T_VPITCH;
constexpr int T_ST0 = T_VSW + 64 * T_VPITCH, T_ST1 = T_ST0 + 64 * ST_PITCH, T_TAB0 = T_ST1 + 64 * ST_PITCH, T_TAB1 = T_TAB0 + 1024, T_END = T_TAB1 + 1024;
static_assert(T_END <= MISC_OFF && T_CT + 80 * CT_PITCH <= T_END && T_KS0 % 16 == 0, "mLSTM LDS map (transposed reads)");
typedef short s16x4 __attribute__((ext_vector_type(4)));
template <int OFF> __device__ __forceinline__ s16x4 tr4(unsigned addr) { s16x4 r; asm volatile("ds_read_b64_tr_b16 %0, %1 offset:%2" : "=&v"(r) : "v"(addr), "i"(OFF) : "memory"); return r; }
#define TR_FRAG(OUT, addr, OFF0, OFF1) do { const s16x4 _a = tr4<(OFF0)>(addr), _b = tr4<(OFF1)>(addr); OUT##_lo = _a; OUT##_hi = _b; } while (0)
#define TR_JOIN(lo, hi) ((bf16x8){lo[0], lo[1], lo[2], lo[3], hi[0], hi[1], hi[2], hi[3]})
__device__ __forceinline__ void mlstm_unit_tr(Frame& F, CArgs* ka, int u, bool need_ctx) {
    const int tid = tid_fresh(), lane = tid & 63, w = __builtin_amdgcn_readfirstlane(tid >> 6), c16 = lane & 15, q = lane >> 4;
    const int es = u & 3, dir = (u >> 2) & 1, h = (u >> 3) & 7, b = u >> 6;
    LAS unsigned char* L = F.lds;
    const bf16_t* X8 = WSB(WS_X8); constexpr size_t X8_SEC = (size_t)MROWS * DM; bf16_t* MH = WSB(WS_MH) + (size_t)dir * MROWS * DM;
    const f32x4* GSC = (const f32x4*)WSF(WS_GSC) + (((size_t)b * 2 + dir) * 8 + h) * 36 * 64;
    __syncthreads();
    { unsigned z0 = 0u; asm volatile("" : "+v"(z0)); const v4u zz = {z0, z0, z0, z0};
      for (int i = tid; i < T_CT_ROWS * CT_PITCH / 16; i += 512) *(LAS v4u*)(L + T_CT + i * 16) = zz;
      if (tid < 128) { const int s = tid & 63, hf = tid >> 6; v4u one = zz; if (hf == 0) one.x = 0x3F80u;
          *(LAS v4u*)(L + T_VS + s * T_VPITCH + 128 + hf * 16) = one; *(LAS v4u*)(L + T_VSW + s * T_VPITCH + 128 + hf * 16) = zz; } }
    f32x4 C[2][5];
#pragma unroll
    for (int a = 0; a < 2; ++a)
#pragma unroll
        for (int e = 0; e < 5; ++e) C[a][e] = (f32x4){0.f, 0.f, 0.f, 0.f};
    const int tn = w & 3, wh = w >> 2, t = tn * 16 + c16;
    const int kl = (dir ? 63 - lane : lane) * 8, ql = q * 512 + (dir ? 63 - t : t) * 8;
    const unsigned LB = (unsigned)(size_t)L;
    const unsigned trK = (unsigned)((8 * q + (c16 >> 2)) * KS_PITCH + 8 * (lane & 3) + 64 * w), trV = (unsigned)((8 * q + (c16 >> 2)) * T_VPITCH + 8 * (lane & 3));
    v4u kn[4], vc; bf16x8 Qc[8], Qn[8]; float gc0, gc1, gc2, gn0, gn1, gn2;
#define MLP_ROW(base, j) ((size_t)(base) + (dir ? 63 - (j) : (j)))
#define MLP_TAB(par) ((LAS float*)(L + ((par) ? T_TAB1 : T_TAB0)))
#define MLP_ST(par) ((par) ? T_ST1 : T_ST0)
#define MLP_KS(par) ((par) ? T_KS1 : T_KS0)
#define MLP_XB(sec, c_) (X8 + (size_t)(sec) * X8_SEC + ((size_t)(b * 8 + h) * 36 + (c_)) * (32 * 64 * 8))
#define MLP_LOADK(dst, k) do { const bf16_t* _xb = MLP_XB(1, chunk_of((k), dir)) + w * 4 * 512; \
        _Pragma("unroll") for (int i = 0; i < 4; ++i) dst[i] = *(const v4u*)(_xb + i * 512 + kl); } while (0)
#define MLP_LOADV(dst, k) do { dst = *(const v4u*)(MLP_XB(2, chunk_of((k), dir)) + (es * 8 + w) * 512 + kl); } while (0)
#define MLP_LOADG(d0, d1, d2, k) do { const float* _gp = (const float*)(GSC + chunk_of((k), dir) * 64 + lane); d0 = _gp[0]; d1 = _gp[1]; d2 = _gp[2]; } while (0)
#define MLP_LOADQ(dst, k) do { const bf16_t* _xb = MLP_XB(0, chunk_of((k), dir)); \
        _Pragma("unroll") for (int ks = 0; ks < 8; ++ks) dst[ks] = *(const bf16x8*)(_xb + ks * 2048 + ql); } while (0)
#define MLP_STILE(QQ, TB, SO, KSO) do { const float _mmt = (TB)[64 + t]; \
        _Pragma("unroll") for (int si = 0; si < 2; ++si) { const int sm = wh * 2 + si; v2u o = {0u, 0u}; \
            if (sm <= tn) { f32x4 acc = {0.f, 0.f, 0.f, 0.f}; \
                bf16x8 ka_[8]; \
                _Pragma("unroll") for (int ks = 0; ks < 8; ++ks) ka_[ks] = *(const LAS bf16x8*)(L + (KSO) + (sm * 16 + c16) * KS_PITCH + (ks * 32 + q * 8) * 2); \
                __builtin_amdgcn_sched_barrier(0); \
                _Pragma("unroll") for (int ks = 0; ks < 8; ++ks) acc = ML_MFMA(ka_[ks], QQ[ks], acc); \
                float v[4]; \
                _Pragma("unroll") for (int j = 0; j < 4; ++j) { const int s = sm * 16 + q * 4 + j; v[j] = s <= t ? acc[j] * __expf((TB)[s] - _mmt) : 0.f; } \
                o.x = pk2(v[0], v[1]); o.y = pk2(v[2], v[3]); } \
            *(LAS v2u*)(L + (SO) + t * ST_PITCH + (sm * 16 + q * 4) * 2) = o; } } while (0)
    MLP_LOADK(kn, 0); MLP_LOADV(vc, 0); MLP_LOADG(gc0, gc1, gc2, 0); MLP_LOADQ(Qc, 0); MLP_LOADG(gn0, gn1, gn2, 1); MLP_LOADQ(Qn, 1);
    float m = -1e30f;
    { const float mm = fmaxf(gc2, m); LAS float* TB = MLP_TAB(0);
      if (w == 0) { TB[lane] = gc1; TB[64 + lane] = mm; TB[128 + lane] = gc0; }
#pragma unroll
      for (int i = 0; i < 4; ++i) *(LAS v4u*)(L + T_KS0 + lane * KS_PITCH + (w * 4 + i) * 16) = kn[i];
      MLP_LOADK(kn, 1);
      __syncthreads();
      if (need_ctx) MLP_STILE(Qc, TB, MLP_ST(0), T_KS0);
      __syncthreads(); }
#pragma unroll 1
    for (int k = 0; k < 36; ++k) {
        const int par = k & 1, k1 = k + 1 < 36 ? k + 1 : 35, k2 = k + 2 < 36 ? k + 2 : 35;
        const bool do_out = need_ctx || k >= 4, s_next = (k + 1 < 36) && (need_ctx || k + 1 >= 4);
        const size_t base = (size_t)b * TPB + chunk_of(k, dir) * 64;
        if (k > 0) {
#pragma unroll
            for (int di = 0; di < 2; ++di)
#pragma unroll
                for (int en = 0; en < 5; ++en) { const f32x4 c = C[di][en]; v2u o; o.x = pk2(c[0], c[1]); o.y = pk2(c[2], c[3]);
                    if (en < 4 || c16 == 0) *(LAS v2u*)(L + T_CT + (en * 16 + c16) * CT_PITCH + ((2 * w + di) * 16 + q * 4) * 2) = o; } }
        const float mm = fmaxf(gc2, m), bL = lane_get(gc0, 63), mm63 = lane_get(mm, 63), wk = __expf(gc1 - mm63), m_next = bL + mm63;
        { *(LAS v4u*)(L + T_VS + lane * T_VPITCH + w * 16) = vc;
          v4u sv;
#pragma unroll
          for (int e = 0; e < 4; ++e) sv[e] = pk2(blo(vc[e]) * wk, bhi(vc[e]) * wk);
          *(LAS v4u*)(L + T_VSW + lane * T_VPITCH + w * 16) = sv;
          if (w == 0) *(LAS bf16_t*)(L + T_VSW + lane * T_VPITCH + 128) = (bf16_t)(pk2(wk, 0.f) & 0xffffu); }
        { const float mmn = fmaxf(gn2, m_next); LAS float* TBn = MLP_TAB(par ^ 1);
          if (w == 0) { TBn[lane] = gn1; TBn[64 + lane] = mmn; TBn[128 + lane] = gn0; }
#pragma unroll
          for (int i = 0; i < 4; ++i) *(LAS v4u*)(L + MLP_KS(par ^ 1) + lane * KS_PITCH + (w * 4 + i) * 16) = kn[i]; }
        __syncthreads();
        gc0 = gn0; gc1 = gn1; gc2 = gn2;
        MLP_LOADK(kn, k2); MLP_LOADV(vc, k1); MLP_LOADG(gn0, gn1, gn2, k2);
        const LAS float* TB = MLP_TAB(par);
        if (do_out) {
            const float wi = __expf(m - TB[64 + t]); f32x4 num0 = {0.f, 0.f, 0.f, 0.f}, num1 = {0.f, 0.f, 0.f, 0.f}; float den = 1.f;
            bf16x8 sb[2];
#pragma unroll
            for (int ks = 0; ks < 2; ++ks) sb[ks] = *(const LAS bf16x8*)(L + MLP_ST(par) + t * ST_PITCH + (ks * 32 + q * 8) * 2);
#pragma unroll
            for (int ei = 0; ei < 3; ++ei) { const int em = ei < 2 ? wh * 2 + ei : 4;
                f32x4 a1 = {0.f, 0.f, 0.f, 0.f}, a2 = {0.f, 0.f, 0.f, 0.f}; bf16x8 ca_[8];
                const unsigned va = LB + T_VS + trV + 32 * em;
                const s16x4 v00 = tr4<0>(va), v01 = tr4<4 * T_VPITCH>(va), v10 = tr4<32 * T_VPITCH>(va), v11 = tr4<36 * T_VPITCH>(va);
#pragma unroll
                for (int ks = 0; ks < 8; ++ks) ca_[ks] = *(const LAS bf16x8*)(L + T_CT + (em * 16 + c16) * CT_PITCH + (ks * 32 + q * 8) * 2);
                asm volatile("s_waitcnt lgkmcnt(0)" ::: "memory"); __builtin_amdgcn_sched_barrier(0);
                a1 = ML_MFMA(TR_JOIN(v00, v01), sb[0], a1); a1 = ML_MFMA(TR_JOIN(v10, v11), sb[1], a1);
#pragma unroll
                for (int ks = 0; ks < 8; ++ks) a2 = ML_MFMA(ca_[ks], Qc[ks], a2);
                __builtin_amdgcn_sched_barrier(0);
                const f32x4 nv = a1 + a2 * wi;
                if (ei == 0) num0 = nv; else if (ei == 1) num1 = nv;
                else den = fmaxf(fabsf(lane_get(nv[0], c16)), __expf(-(TB[128 + t] + TB[64 + t]))); }
            const float rd = 1.f / den; bf16_t* op = MH + MLP_ROW(base, t) * DM + h * 256 + es * 64 + q * 4; const f32x4 o0 = num0 * rd, o1 = num1 * rd;
            v2u w0, w1; w0.x = pk2(o0[0], o0[1]); w0.y = pk2(o0[2], o0[3]); w1.x = pk2(o1[0], o1[1]); w1.y = pk2(o1[2], o1[3]);
            *(v2u*)(op + (wh * 2) * 16) = w0; *(v2u*)(op + (wh * 2 + 1) * 16) = w1;
        }
        {
          const float decay = __expf(m - mm63);
          const unsigned ka_ = LB + MLP_KS(par) + trK, vb_ = LB + T_VSW + trV;
          const s16x4 k000 = tr4<0>(ka_), k001 = tr4<4 * KS_PITCH>(ka_), k010 = tr4<32 * KS_PITCH>(ka_), k011 = tr4<36 * KS_PITCH>(ka_);
          const s16x4 k100 = tr4<32>(ka_), k101 = tr4<4 * KS_PITCH + 32>(ka_), k110 = tr4<32 * KS_PITCH + 32>(ka_), k111 = tr4<36 * KS_PITCH + 32>(ka_);
          s16x4 vq[5][4];
#define TRV(en) do { vq[en][0] = tr4<32 * (en)>(vb_); vq[en][1] = tr4<4 * T_VPITCH + 32 * (en)>(vb_); vq[en][2] = tr4<32 * T_VPITCH + 32 * (en)>(vb_); vq[en][3] = tr4<36 * T_VPITCH + 32 * (en)>(vb_); } while (0)
          TRV(0); TRV(1); TRV(2); TRV(3); TRV(4);
#undef TRV
#pragma unroll
          for (int di = 0; di < 2; ++di)
#pragma unroll
              for (int en = 0; en < 5; ++en) C[di][en] = C[di][en] * decay;
          asm volatile("s_waitcnt lgkmcnt(0)" ::: "memory"); __builtin_amdgcn_sched_barrier(0);
#pragma unroll
          for (int en = 0; en < 5; ++en) { const bf16x8 b0 = TR_JOIN(vq[en][0], vq[en][1]), b1 = TR_JOIN(vq[en][2], vq[en][3]);
              C[0][en] = ML_MFMA(TR_JOIN(k000, k001), b0, C[0][en]); C[0][en] = ML_MFMA(TR_JOIN(k010, k011), b1, C[0][en]);
              C[1][en] = ML_MFMA(TR_JOIN(k100, k101), b0, C[1][en]); C[1][en] = ML_MFMA(TR_JOIN(k110, k111), b1, C[1][en]); }
          __builtin_amdgcn_sched_barrier(0); }
        if (s_next) MLP_STILE(Qn, MLP_TAB(par ^ 1), MLP_ST(par ^ 1), MLP_KS(par ^ 1));
#pragma unroll
        for (int ks = 0; ks < 8; ++ks) Qc[ks] = Qn[ks];
        MLP_LOADQ(Qn, k2);
        m = m_next;
        __syncthreads();
    }
#undef MLP_ROW
#undef MLP_TAB
#undef MLP_ST
#undef MLP_KS
#undef MLP_XB
#undef MLP_LOADK
#undef MLP_LOADV
#undef MLP_LOADG
#undef MLP_LOADQ
#undef MLP_STILE
}
}

namespace lru {
typedef short bf16x8 __attribute__((ext_vector_type(8)));
constexpr int XB_OFF = 0, XB_PITCH = 272;
constexpr int XF_OFF = XB_OFF + 64 * XB_PITCH, XF_PITCH = 528;
constexpr int YO_OFF = XF_OFF + 64 * XF_PITCH, YO_PITCH = 528;
constexpr int HIN_OFF = YO_OFF + 64 * YO_PITCH;
constexpr int CW_OFF = HIN_OFF + 9 * 2 * 128 * 4;
constexpr int END_OFF = CW_OFF + 5 * 128 * 4;
static_assert(END_OFF <= MISC_OFF, "LRU LDS map");
#define LRU_COMPOSE(A, B, a2, b2) do { B = (a2) * B + (b2); A = (a2) * A; } while (0)

template <bool FINAL, int VAR, class BcOf>
__device__ __forceinline__ void lru_run(Frame& F, CArgs* ka, int l, int blk, int NU, const BcOf& bc_of) {
    const int tid = tid_fresh(), lane = tid & 63, w = __builtin_amdgcn_readfirstlane(tid >> 6), c16 = lane & 15, q = lane >> 4;
    LAS unsigned char* L = F.lds; const bf16_t* P = WSB(WS_P);
    const int cg = tid & 15, rg = tid >> 4, chl = 16 * w + c16, ch = blk * 128 + chl;
    bf16x8 bw[4][4];
    { const bf16_t* Wt = WSB(WS_WLRU) + (size_t)l * 4 * 16 * 16384 + ((size_t)blk * 128 + chl) * 128 + q * 8;
#pragma unroll
      for (int g = 0; g < 4; ++g)
#pragma unroll
          for (int ks = 0; ks < 4; ++ks) bw[g][ks] = *(const bf16x8*)(Wt + (size_t)g * 16 * 16384 + ks * 32); }
    float cbr[2], cbi[2], csp[2];
#pragma unroll
    for (int dr = 0; dr < 2; ++dr) { cbr[dr] = KIN(12)[((size_t)l * 2 + dr) * DM + ch]; cbi[dr] = KIN(14)[((size_t)l * 2 + dr) * DM + ch]; csp[dr] = log1pf(__expf(-KIN(15)[((size_t)l * 2 + dr) * DM + ch])); }
    for (int i = tid; i < 5 * 128; i += 512) { const int kk = i >> 7, c = i & 127; ((LAS float*)(L + CW_OFF))[i] = kk < 4 ? KIN(9)[((size_t)l * 4 + kk) * DM + blk * 128 + c] : KIN(10)[(size_t)l * DM + blk * 128 + c]; }
    v4u raw[5];
#define LRU_LOAD(i) do { int _b, _c; bc_of((i), _b, _c); const int _t0 = _c * 64, _lo = _c < 32 ? 0 : SEQ, _hi = _c < 32 ? SEQ : TPB; const size_t _rb = (size_t)_b * TPB; \
        _Pragma("unroll") for (int x = 0; x < 5; ++x) { const int tt = _t0 + 2 * rg - 2 + x; raw[x] = (v4u){0u, 0u, 0u, 0u}; if (tt >= _lo && tt < _hi) raw[x] = *(const v4u*)(P + (_rb + tt) * NP + C_LX + blk * 128 + cg * 8); } \
        } while (0)
    LRU_LOAD(0);
#pragma unroll 1
    for (int ui = 0; ui < NU; ++ui) {
        int b, chunk; bc_of(ui, b, chunk); const size_t rb = (size_t)b * TPB; const int t0 = chunk * 64;
        __syncthreads();
        {
          float o0[8], o1[8]; const LAS float* cwl = (const LAS float*)(L + CW_OFF) + cg * 8;
#pragma unroll
          for (int e = 0; e < 8; ++e) { o0[e] = cwl[4 * 128 + e]; o1[e] = o0[e]; }
#pragma unroll
          for (int kk = 0; kk < 5; ++kk) { float xin[8];
#pragma unroll
              for (int e = 0; e < 4; ++e) { xin[2 * e] = blo(raw[kk][e]); xin[2 * e + 1] = bhi(raw[kk][e]); }
#pragma unroll
              for (int e = 0; e < 8; ++e) { if (kk < 4) o0[e] += cwl[kk * 128 + e] * xin[e]; if (kk > 0) o1[e] += cwl[(kk - 1) * 128 + e] * xin[e]; } }
          v4u p0, p1; p0.x = pk2(o0[0], o0[1]); p0.y = pk2(o0[2], o0[3]); p0.z = pk2(o0[4], o0[5]); p0.w = pk2(o0[6], o0[7]); p1.x = pk2(o1[0], o1[1]); p1.y = pk2(o1[2], o1[3]); p1.z = pk2(o1[4], o1[5]); p1.w = pk2(o1[6], o1[7]);
          *(LAS v4u*)(L + XB_OFF + (2 * rg) * XB_PITCH + cg * 16) = p0; *(LAS v4u*)(L + XB_OFF + (2 * rg + 1) * XB_PITCH + cg * 16) = p1;
          LAS float* f0 = (LAS float*)(L + XF_OFF + (2 * rg) * XF_PITCH + cg * 32); LAS float* f1 = (LAS float*)(L + XF_OFF + (2 * rg + 1) * XF_PITCH + cg * 32);
          *(LAS f32x4*)f0 = (f32x4){o0[0], o0[1], o0[2], o0[3]}; *(LAS f32x4*)(f0 + 4) = (f32x4){o0[4], o0[5], o0[6], o0[7]};
          *(LAS f32x4*)f1 = (f32x4){o1[0], o1[1], o1[2], o1[3]}; *(LAS f32x4*)(f1 + 4) = (f32x4){o1[4], o1[5], o1[6], o1[7]}; }
        __syncthreads();
        v4u zcur[2];
        if (FINAL) {
#pragma unroll
            for (int x = 0; x < 2; ++x) { const int cidx = tid + 512 * x; zcur[x] = *(const v4u*)(P + (rb + t0 + (cidx >> 4)) * NP + C_LZ + blk * 128 + (cidx & 15) * 8); } }
        if (ui + 1 < NU) LRU_LOAD(ui + 1);
#pragma unroll
        for (int dr = 0; dr < 2; ++dr) {
            f32x4 acc[2][4];
#pragma unroll
            for (int g = 0; g < 2; ++g)
#pragma unroll
                for (int tm = 0; tm < 4; ++tm) acc[g][tm] = (f32x4){0.f, 0.f, 0.f, 0.f};
            if (VAR < 2) {
#pragma unroll
            for (int ks = 0; ks < 4; ++ks) { bf16x8 a[4];
#pragma unroll
                for (int tm = 0; tm < 4; ++tm) a[tm] = *(const LAS bf16x8*)(L + XB_OFF + (tm * 16 + c16) * XB_PITCH + (ks * 32 + q * 8) * 2);
#pragma unroll
                for (int g = 0; g < 2; ++g)
#pragma unroll
                    for (int tm = 0; tm < 4; ++tm) acc[g][tm] = __builtin_amdgcn_mfma_f32_16x16x32_bf16(a[tm], bw[2 * dr + g][ks], acc[g][tm], 0, 0, 0); } }
            if (VAR < 1) {
                typedef float f32x2 __attribute__((ext_vector_type(2)));
                const float NL2E = -1.4426950408889634f; const float kr = cbr[dr] * NL2E, ki = cbi[dr] * NL2E, c16l = -16.f * csp[dr], c8l2 = -8.f * csp[dr] * 1.4426950408889634f;
#pragma unroll
                for (int tm = 0; tm < 4; ++tm)
#pragma unroll
                    for (int jp = 0; jp < 2; ++jp) { const int t = tm * 16 + q * 4 + 2 * jp;
                        const f32x2 xv = {*(const LAS float*)(L + XF_OFF + t * XF_PITCH + chl * 4), *(const LAS float*)(L + XF_OFF + (t + 1) * XF_PITCH + chl * 4)};
                        const f32x2 ar = {acc[0][tm][2 * jp], acc[0][tm][2 * jp + 1]}, ai = {acc[1][tm][2 * jp], acc[1][tm][2 * jp + 1]};
                        f32x2 tr = ar * NL2E + kr, ti = ai * NL2E + ki; tr.x = fminf(tr.x, 60.f); tr.y = fminf(tr.y, 60.f); ti.x = fminf(ti.x, 60.f); ti.y = fminf(ti.y, 60.f);
                        f32x2 er, ei; er.x = __builtin_amdgcn_exp2f(tr.x); er.y = __builtin_amdgcn_exp2f(tr.y); ei.x = __builtin_amdgcn_exp2f(ti.x); ei.y = __builtin_amdgcn_exp2f(ti.y);
                        const f32x2 pr = er + 1.f, pi = ei + 1.f, dn = pr * pi; f32x2 R; R.x = __builtin_amdgcn_rcpf(dn.x); R.y = __builtin_amdgcn_rcpf(dn.y);
                        const f32x2 rgt = R * pi, igt = R * pr, x2 = rgt * c16l, l2 = rgt * c8l2;
                        f32x2 av; av.x = __builtin_amdgcn_exp2f(l2.x); av.y = __builtin_amdgcn_exp2f(l2.y);
                        const f32x2 ser = -x2 * (x2 * (x2 * (x2 * (x2 * 0.0083333338f + 0.041666668f) + 0.16666667f) + 0.5f) + 1.f), dir_ = 1.f - av * av;
                        f32x2 om; om.x = x2.x > -0.1f ? ser.x : dir_.x; om.y = x2.y > -0.1f ? ser.y : dir_.y;
                        f32x2 sq; sq.x = __builtin_amdgcn_sqrtf(om.x); sq.y = __builtin_amdgcn_sqrtf(om.y);
                        const f32x2 bxv = sq * igt * xv;
                        acc[0][tm][2 * jp] = av.x; acc[0][tm][2 * jp + 1] = av.y; acc[1][tm][2 * jp] = bxv.x; acc[1][tm][2 * jp + 1] = bxv.y; } }
#define LRU_TM(i) (dr ? 3 - (i) : (i))
            if constexpr (!FINAL) { if (VAR < 3) {
                float2* AGG = (float2*)(VAR ? WSF(WS_ACC) : WSF(WS_LA)); float TA = 1.f, TB = 0.f;
#pragma unroll
                for (int ti = 0; ti < 4; ++ti) { const int tm = LRU_TM(ti); float sa = 1.f, sb = 0.f;
#pragma unroll
                    for (int ji = 0; ji < 4; ++ji) { const int j = LRU_TM(ji); LRU_COMPOSE(sa, sb, acc[0][tm][j], acc[1][tm][j]); }
#pragma unroll
                    for (int qi = 0; qi < 4; ++qi) { const int qq = LRU_TM(qi); const float xa = lane_get(sa, c16 + 16 * qq), xb = lane_get(sb, c16 + 16 * qq); LRU_COMPOSE(TA, TB, xa, xb); } }
                if (q == 0) AGG[(((size_t)b * 36 + chunk) * 2 + dr) * DM + ch] = make_float2(TA, TB); }
            } else {
                float H = ((const LAS float*)(L + HIN_OFF))[ui * 256 + dr * 128 + chl];
#pragma unroll
                for (int ti = 0; ti < 4; ++ti) { const int tm = LRU_TM(ti); float sa = 1.f, sb = 0.f;
#pragma unroll
                    for (int ji = 0; ji < 4; ++ji) { const int j = LRU_TM(ji); LRU_COMPOSE(sa, sb, acc[0][tm][j], acc[1][tm][j]); }
                    float ea = 1.f, eb = 0.f, ta = 1.f, tb = 0.f;
#pragma unroll
                    for (int qi = 0; qi < 4; ++qi) { const int qq = LRU_TM(qi); const float xa = lane_get(sa, c16 + 16 * qq), xb = lane_get(sb, c16 + 16 * qq); if (qq == q) { ea = ta; eb = tb; } LRU_COMPOSE(ta, tb, xa, xb); }
                    float hs = ea * H + eb;
#pragma unroll
                    for (int ji = 0; ji < 4; ++ji) { const int j = LRU_TM(ji); hs = acc[0][tm][j] * hs + acc[1][tm][j]; LAS float* yp = (LAS float*)(L + YO_OFF + (tm * 16 + q * 4 + j) * YO_PITCH + chl * 4);
                        if (dr == 0) *yp = hs; else *yp += hs; }
                    H = ta * H + tb; }
            }
#undef LRU_TM
        }
        if constexpr (FINAL) {
            __syncthreads();
            bf16_t* YB0 = WSB(WS_YB);
#pragma unroll
            for (int i = 0; i < 2; ++i) { const int cidx = tid + 512 * i, row = cidx >> 4, cgo = cidx & 15; const size_t rgl = rb + t0 + row;
                const f32x4 y0 = *(const LAS f32x4*)(L + YO_OFF + row * YO_PITCH + cgo * 32), y1 = *(const LAS f32x4*)(L + YO_OFF + row * YO_PITCH + cgo * 32 + 16);
                const v4u z = zcur[i];
                v4u o; o.x = pk2(y0[0] * blo(z.x), y0[1] * bhi(z.x)); o.y = pk2(y0[2] * blo(z.y), y0[3] * bhi(z.y)); o.z = pk2(y1[0] * blo(z.z), y1[1] * bhi(z.z)); o.w = pk2(y1[2] * blo(z.w), y1[3] * bhi(z.w));
                *(v4u*)(YB0 + rgl * DM + blk * 128 + cgo * 8) = o; }
        }
    }
#undef LRU_LOAD
}
constexpr int CW_LRUFLAG = 32768, LRU_FLAG_STRIDE = 16;
__device__ __forceinline__ void p_lru_lookback(Frame& F, CArgs* ka, int l) {
    const int tid = tid_fresh(), lane = tid & 63, w = __builtin_amdgcn_readfirstlane(tid >> 6), c16 = lane & 15, q = lane >> 4;
    const int npar = F.G / 36; if (F.wg >= npar * 36) return;
    const int slot = F.wg / 36, chunk = F.wg - slot * 36, cps = (64 + npar - 1) / npar;
    LAS unsigned char* L = F.lds; const bf16_t* P = WSB(WS_P);
    unsigned* ctl = (unsigned*)(ka->ws + WS_CTL); unsigned long long* AGG = (unsigned long long*)WSF(WS_LA) + (size_t)l * 64 * 36 * 2 * 128;
    const unsigned epoch = (unsigned)(l + 1);
    const int cg = tid & 15, rg = tid >> 4, chl = 16 * w + c16;
    const int t0 = chunk * 64, lo = chunk < 32 ? 0 : SEQ, hi = chunk < 32 ? SEQ : TPB;
    int cur_blk = -1;
    v4u raw[5];
#define LRU_LOADX(colx) do { const int _b = (colx) & 3, _blk = (colx) >> 2; const size_t _rb = (size_t)_b * TPB; \
        _Pragma("unroll") for (int x = 0; x < 5; ++x) { const int tt = t0 + 2 * rg - 2 + x; raw[x] = (v4u){0u, 0u, 0u, 0u}; if (tt >= lo && tt < hi) raw[x] = *(const v4u*)(P + (_rb + tt) * NP + C_LX + _blk * 128 + cg * 8); } } while (0)
    const int col0 = slot * cps, col1 = (col0 + cps) < 64 ? (col0 + cps) : 64;
    if (col0 < col1) LRU_LOADX(col0);
#pragma unroll 1
    for (int col = col0; col < col1; ++col) {
        const int b = col & 3, blk = col >> 2, ch = blk * 128 + chl; const size_t rb = (size_t)b * TPB;
        __syncthreads();
        bf16x8 bw[4][4]; float cbr[2], cbi[2], csp[2];
        { const bf16_t* Wt = WSB(WS_WLRU) + (size_t)l * 4 * 16 * 16384 + ((size_t)blk * 128 + chl) * 128 + q * 8;
#pragma unroll
          for (int g = 0; g < 4; ++g)
#pragma unroll
              for (int ks = 0; ks < 4; ++ks) bw[g][ks] = *(const bf16x8*)(Wt + (size_t)g * 16 * 16384 + ks * 32);
#pragma unroll
          for (int dr = 0; dr < 2; ++dr) { cbr[dr] = KIN(12)[((size_t)l * 2 + dr) * DM + ch]; cbi[dr] = KIN(14)[((size_t)l * 2 + dr) * DM + ch]; csp[dr] = log1pf(__expf(-KIN(15)[((size_t)l * 2 + dr) * DM + ch])); } }
        if (blk != cur_blk) { cur_blk = blk;
            for (int i = tid; i < 5 * 128; i += 512) { const int kk = i >> 7, c = i & 127; ((LAS float*)(L + CW_OFF))[i] = kk < 4 ? KIN(9)[((size_t)l * 4 + kk) * DM + blk * 128 + c] : KIN(10)[(size_t)l * DM + blk * 128 + c]; }
            __syncthreads(); }
        {
          float o0[8], o1[8]; const LAS float* cwl = (const LAS float*)(L + CW_OFF) + cg * 8;
#pragma unroll
          for (int e = 0; e < 8; ++e) { o0[e] = cwl[4 * 128 + e]; o1[e] = o0[e]; }
#pragma unroll
          for (int kk = 0; kk < 5; ++kk) { float xin[8];
#pragma unroll
              for (int e = 0; e < 4; ++e) { xin[2 * e] = blo(raw[kk][e]); xin[2 * e + 1] = bhi(raw[kk][e]); }
#pragma unroll
              for (int e = 0; e < 8; ++e) { if (kk < 4) o0[e] += cwl[kk * 128 + e] * xin[e]; if (kk > 0) o1[e] += cwl[(kk - 1) * 128 + e] * xin[e]; } }
          v4u p0, p1; p0.x = pk2(o0[0], o0[1]); p0.y = pk2(o0[2], o0[3]); p0.z = pk2(o0[4], o0[5]); p0.w = pk2(o0[6], o0[7]); p1.x = pk2(o1[0], o1[1]); p1.y = pk2(o1[2], o1[3]); p1.z = pk2(o1[4], o1[5]); p1.w = pk2(o1[6], o1[7]);
          *(LAS v4u*)(L + XB_OFF + (2 * rg) * XB_PITCH + cg * 16) = p0; *(LAS v4u*)(L + XB_OFF + (2 * rg + 1) * XB_PITCH + cg * 16) = p1;
          LAS float* f0 = (LAS float*)(L + XF_OFF + (2 * rg) * XF_PITCH + cg * 32); LAS float* f1 = (LAS float*)(L + XF_OFF + (2 * rg + 1) * XF_PITCH + cg * 32);
          *(LAS f32x4*)f0 = (f32x4){o0[0], o0[1], o0[2], o0[3]}; *(LAS f32x4*)(f0 + 4) = (f32x4){o0[4], o0[5], o0[6], o0[7]};
          *(LAS f32x4*)f1 = (f32x4){o1[0], o1[1], o1[2], o1[3]}; *(LAS f32x4*)(f1 + 4) = (f32x4){o1[4], o1[5], o1[6], o1[7]}; }
        __syncthreads();
        { const int coln = col + 1 < col1 ? col + 1 : col; LRU_LOADX(coln); }
        f32x4 av[2][4], bv[2][4];
#pragma unroll
        for (int dr = 0; dr < 2; ++dr) {
#pragma unroll
            for (int tm = 0; tm < 4; ++tm) { av[dr][tm] = (f32x4){0.f, 0.f, 0.f, 0.f}; bv[dr][tm] = (f32x4){0.f, 0.f, 0.f, 0.f}; }
#pragma unroll
            for (int ks = 0; ks < 4; ++ks) { bf16x8 a[4];
#pragma unroll
                for (int tm = 0; tm < 4; ++tm) a[tm] = *(const LAS bf16x8*)(L + XB_OFF + (tm * 16 + c16) * XB_PITCH + (ks * 32 + q * 8) * 2);
#pragma unroll
                for (int tm = 0; tm < 4; ++tm) { av[dr][tm] = __builtin_amdgcn_mfma_f32_16x16x32_bf16(a[tm], bw[2 * dr][ks], av[dr][tm], 0, 0, 0); bv[dr][tm] = __builtin_amdgcn_mfma_f32_16x16x32_bf16(a[tm], bw[2 * dr + 1][ks], bv[dr][tm], 0, 0, 0); } }
#pragma unroll
            for (int tm = 0; tm < 4; ++tm)
#pragma unroll
                for (int j = 0; j < 4; ++j) { const int t = tm * 16 + q * 4 + j; const float xv = *(const LAS float*)(L + XF_OFF + t * XF_PITCH + chl * 4);
                    const float rgt = pg8::sigmoid_f(av[dr][tm][j] + cbr[dr]), igt = pg8::sigmoid_f(bv[dr][tm][j] + cbi[dr]), la = -8.f * rgt * csp[dr], aa = __expf(la), x2 = 2.f * la;
                    const float om = x2 > -0.1f ? -x2 * (1.f + x2 * (0.5f + x2 * (0.16666667f + x2 * (0.041666668f + x2 * 0.0083333338f)))) : 1.f - aa * aa;
                    av[dr][tm][j] = aa; bv[dr][tm][j] = sqrtf(om) * igt * xv; }
#define LRU_TM(i) (dr ? 3 - (i) : (i))
            float TA = 1.f, TB = 0.f;
#pragma unroll
            for (int ti = 0; ti < 4; ++ti) { const int tm = LRU_TM(ti); float sa = 1.f, sb = 0.f;
#pragma unroll
                for (int ji = 0; ji < 4; ++ji) { const int j = LRU_TM(ji); LRU_COMPOSE(sa, sb, av[dr][tm][j], bv[dr][tm][j]); }
#pragma unroll
                for (int qi = 0; qi < 4; ++qi) { const int qq = LRU_TM(qi); const float xa = lane_get(sa, c16 + 16 * qq), xb = lane_get(sb, c16 + 16 * qq); LRU_COMPOSE(TA, TB, xa, xb); } }
            __builtin_amdgcn_sched_barrier(0);
            if (q == 0) __hip_atomic_store(AGG + (((size_t)col * 36 + chunk) * 2 + dr) * 128 + chl, ((unsigned long long)__float_as_uint(TB) << 32) | __float_as_uint(TA), __ATOMIC_RELAXED, __HIP_MEMORY_SCOPE_AGENT);
        }
        asm volatile("s_waitcnt vmcnt(0)" ::: "memory");
        __syncthreads();
        if (tid == 0) __hip_atomic_store(ctl + CW_LRUFLAG + (col * 36 + chunk) * LRU_FLAG_STRIDE, epoch, __ATOMIC_RELAXED, __HIP_MEMORY_SCOPE_AGENT);
        v4u zcur[2];
#pragma unroll
        for (int x = 0; x < 2; ++x) { const int cidx = tid + 512 * x; zcur[x] = *(const v4u*)(P + (rb + t0 + (cidx >> 4)) * NP + C_LZ + blk * 128 + (cidx & 15) * 8); }
        if (w == 0) {
            unsigned* fp = ctl + CW_LRUFLAG + (col * 36 + (lane < 36 ? lane : 0)) * LRU_FLAG_STRIDE; unsigned spins = 0;
            for (;;) { const bool ok = __hip_atomic_load(fp, __ATOMIC_RELAXED, __HIP_MEMORY_SCOPE_AGENT) >= epoch; if (__all(ok)) break;
                __builtin_amdgcn_s_sleep(1);
                if ((++spins & 255u) == 0u) { if (__hip_atomic_load(ctl, __ATOMIC_RELAXED, __HIP_MEMORY_SCOPE_AGENT) != 0u) break; if (spins > (1u << 20)) { if (lane == 0) __hip_atomic_store(ctl, 0x1200u + (unsigned)l, __ATOMIC_RELAXED, __HIP_MEMORY_SCOPE_AGENT); break; } } }
            __builtin_amdgcn_fence(__ATOMIC_ACQUIRE, "agent");
            asm volatile("s_waitcnt vmcnt(0)" ::: "memory"); }
        __syncthreads();
        if (tid < 256) {
            const int dirx = tid >> 7, cl = tid & 127; const unsigned long long* ap = AGG + ((size_t)col * 36 * 2 + dirx) * 128 + cl; float hcar = 0.f, hmine = 0.f;
#pragma unroll 12
            for (int k = 0; k < 36; ++k) { const int cidx = ml::chunk_of(k, dirx); const unsigned long long ab = ap[(size_t)cidx * 256];
                if (cidx == chunk) hmine = hcar;
                hcar = __uint_as_float((unsigned)ab) * hcar + __uint_as_float((unsigned)(ab >> 32)); }
            ((LAS float*)(L + HIN_OFF))[dirx * 128 + cl] = hmine; }
        __syncthreads();
#pragma unroll
        for (int dr = 0; dr < 2; ++dr) {
            float H = ((const LAS float*)(L + HIN_OFF))[dr * 128 + chl];
#pragma unroll
            for (int ti = 0; ti < 4; ++ti) { const int tm = LRU_TM(ti); float sa = 1.f, sb = 0.f;
#pragma unroll
                for (int ji = 0; ji < 4; ++ji) { const int j = LRU_TM(ji); LRU_COMPOSE(sa, sb, av[dr][tm][j], bv[dr][tm][j]); }
                float ea = 1.f, eb = 0.f, ta = 1.f, tb = 0.f;
#pragma unroll
                for (int qi = 0; qi < 4; ++qi) { const int qq = LRU_TM(qi); const float xa = lane_get(sa, c16 + 16 * qq), xb = lane_get(sb, c16 + 16 * qq); if (qq == q) { ea = ta; eb = tb; } LRU_COMPOSE(ta, tb, xa, xb); }
                float hs = ea * H + eb;
#pragma unroll
                for (int ji = 0; ji < 4; ++ji) { const int j = LRU_TM(ji); hs = av[dr][tm][j] * hs + bv[dr][tm][j]; LAS float* yp = (LAS float*)(L + YO_OFF + (tm * 16 + q * 4 + j) * YO_PITCH + chl * 4);
                    if (dr == 0) *yp = hs; else *yp += hs; }
                H = ta * H + tb; }
        }
#undef LRU_TM
        __syncthreads();
        bf16_t* YB0 = WSB(WS_YB);
#pragma unroll
        for (int i = 0; i < 2; ++i) { const int cidx = tid + 512 * i, row = cidx >> 4, cgo = cidx & 15; const size_t rgl = rb + t0 + row;
            const f32x4 y0 = *(const LAS f32x4*)(L + YO_OFF + row * YO_PITCH + cgo * 32), y1 = *(const LAS f32x4*)(L + YO_OFF + row * YO_PITCH + cgo * 32 + 16);
            const v4u z = zcur[i];
            v4u o; o.x = pk2(y0[0] * blo(z.x), y0[1] * bhi(z.x)); o.y = pk2(y0[2] * blo(z.y), y0[3] * bhi(z.y)); o.z = pk2(y1[0] * blo(z.z), y1[1] * bhi(z.z)); o.w = pk2(y1[2] * blo(z.w), y1[3] * bhi(z.w));
            *(v4u*)(YB0 + rgl * DM + blk * 128 + cgo * 8) = o; }
    }
#undef LRU_LOADX
}
template <int LV> __device__ __forceinline__ void p_lru_agg(Frame& F, CArgs* ka, int l) {
    for (int v = F.wg; v < 256; v += F.G) { const int blk = v & 15, c0 = v >> 4;
        lru_run<false, LV>(F, ka, l, blk, 9, [c0](int i, int& b, int& c) { const int x = c0 + 16 * i; b = x / 36; c = x - b * 36; }); }
}
__device__ __forceinline__ void p_lru_final(Frame& F, CArgs* ka, int l, bool need_ctx) {
    for (int v = F.wg; v < 256; v += F.G) { const int b = v >> 6, blk = (v >> 2) & 15, qt = v & 3;
        const int tid = tid_fresh();
        __syncthreads();
        if (tid < 256) { const int dirx = tid >> 7, chl = tid & 127; const float2* AGG = (const float2*)WSF(WS_LA) + ((size_t)b * 36 * 2 + dirx) * DM + blk * 128 + chl;
            LAS float* HIN = (LAS float*)(F.lds + HIN_OFF); float hcar = 0.f;
#pragma unroll 12
            for (int k = 0; k < 36; ++k) { const int cidx = ml::chunk_of(k, dirx); const float2 ab = AGG[(size_t)cidx * 2 * DM];
                const int sl = cidx - qt * 9; if (sl >= 0 && sl < 9) HIN[sl * 256 + dirx * 128 + chl] = hcar;
                hcar = ab.x * hcar + ab.y; } }
        lru_run<true, 0>(F, ka, l, blk, (need_ctx || qt < 3) ? 9 : 5, [b, qt](int i, int& bb, int& c) { bb = b; c = qt * 9 + i; });
    }
}
}

#ifndef GEMM_NHALF
#define GEMM_NHALF false
#endif
#ifndef CONVERT_AHEAD
#define CONVERT_AHEAD 1
#endif
#ifndef DUP_NORM
#define DUP_NORM 0
#endif
#ifndef DUP_KNORM
#define DUP_KNORM 0
#endif
#ifndef LRU_LOOKBACK
#define LRU_LOOKBACK 0
#endif
#ifndef DUP_G1NULL
#define DUP_G1NULL 0
#endif
#ifndef DUP_G1FIX
#define DUP_G1FIX 0
#endif
#ifndef DUP_BAR
#define DUP_BAR 0
#endif
#ifndef DUP_MLOUT
#define DUP_MLOUT 0
#endif
#ifndef DUP_LRU2
#define DUP_LRU2 0
#endif
#ifndef ML_PIPE
#define ML_PIPE 1
#endif
#ifndef ML_VAR
#define ML_VAR 0
#endif
#ifndef LRU_VAR
#define LRU_VAR -1
#endif
#ifndef CONV_SPLIT
#define CONV_SPLIT 0
#endif
#ifndef GEMM_STAGGER
#define GEMM_STAGGER 0
#endif
#ifndef HEAVY_MIX
#define HEAVY_MIX 0
#endif
#ifndef THIN_MIX
#define THIN_MIX 0
#endif
#ifndef CONV_HEAVY
#define CONV_HEAVY 1
#endif
#ifndef HEAVY_ROT
#define HEAVY_ROT 0
#endif
#ifndef PRETOUCH
#define PRETOUCH 1
#endif
#ifndef PT_STRIDE
#define PT_STRIDE 65536
#endif
#ifndef TAIL_KS
#define TAIL_KS 4
#endif
__device__ __forceinline__ bool tail_split_ok(int G, bool need_ctx) {
    if (!TAIL_KS || !need_ctx) return false;
    const int nu = (MROWS / 256) * (NP / 256), extra = nu % G, full = nu / G; if (extra == 0 || extra > 16 || extra * TAIL_KS > G) return false;
    pg8::StaticOrder S; S.init(MROWS, NP, G, 0, 256, false);
    for (int j = 0; j < extra; ++j) { pg8::Unit u; S.map((long)full * G + j, u); if (u.pn == 64 || u.pn == 65) return false; }
    return true;
}
__device__ __forceinline__ void p_tail_combine(Frame& F, CArgs* ka) {
    const int tid = tid_fresh(); const int nu = (MROWS / 256) * (NP / 256), extra = nu % F.G, full = nu / F.G;
    pg8::StaticOrder S; S.init(MROWS, NP, F.G, 0, 256, false);
    for (int it = F.wg * 512 + tid; it < extra * 8192; it += F.G * 512) { const int j = it >> 13, r = (it >> 5) & 255, c = (it & 31) * 8;
        pg8::Unit u; S.map((long)full * F.G + j, u); const int pn = u.pn, pm = u.pm;
        f32x4 v0 = {0.f, 0.f, 0.f, 0.f}, v1 = v0;
#pragma unroll
        for (int z = 0; z < TAIL_KS; ++z) { const float* sp = WSF(WS_ACC) + ((size_t)z * extra + j) * 65536 + (size_t)r * 256 + c; v0 = v0 + *(const f32x4*)sp; v1 = v1 + *(const f32x4*)(sp + 4); }
        int act = 0;
        if ((pn >= 8 && pn < 16) || (pn >= 48 && pn < 56) || (pn >= 68 && pn < 76)) act = 1; else if ((pn >= 40 && pn < 48) || pn >= 76) act = 2; else if (pn >= 24 && pn < 32) act = 3;
#pragma unroll
        for (int e = 0; e < 4; ++e) {
            if (act == 1) { v0[e] = v0[e] * pg8::sigmoid_f(v0[e]); v1[e] = v1[e] * pg8::sigmoid_f(v1[e]); }
            else if (act == 2) { v0[e] = pg8::sigmoid_f(v0[e]); v1[e] = pg8::sigmoid_f(v1[e]); }
            else if (act == 3) { v0[e] *= 0.0625f; v1[e] *= 0.0625f; } }
        v4u w; w.x = pk2(v0[0], v0[1]); w.y = pk2(v0[2], v0[3]); w.z = pk2(v1[0], v1[1]); w.w = pk2(v1[2], v1[3]);
        bf16_t* dst;
        if (pn >= 16 && pn < 40) dst = WSB(WS_X8) + (size_t)((pn - 16) >> 3) * MROWS * DM + ((size_t)((pm / 9) * 8 + ((pn - 16) & 7)) * 36 + (pm % 9) * 4 + (r >> 6)) * (32 * 64 * 8) + ((c >> 3) * 64 + (r & 63)) * 8;
        else dst = WSB(WS_P) + ((size_t)pm * 256 + r) * NP + (size_t)pn * 256 + c;
        *(v4u*)dst = w; }
}
#ifndef MERGE_CHAIN
#define MERGE_CHAIN 1
#endif
#ifndef CONV_WIN_M
#define CONV_WIN_M 4000
#endif
#ifndef CONV_AHEAD_ITEMS
#define CONV_AHEAD_ITEMS 8000
#endif
#ifndef CONV_HALF
#define CONV_HALF 17168
#endif
static_assert(!(SPLIT_CTX && GEMM_NHALF), "the split context tiles assume 256-column units");
#ifndef ML_TR
#define ML_TR 1
#endif
#ifndef DUP_PRO
#define DUP_PRO 0
#endif
#ifndef DUP_THIN
#define DUP_THIN 0
#endif
#ifndef DUP_G1
#define DUP_G1 0
#endif
#ifndef DUP_HEAVY
#define DUP_HEAVY 0
#endif
#ifndef DUP_ATT
#define DUP_ATT 0
#endif
#ifndef DUP_ML
#define DUP_ML 0
#endif
#ifndef DUP_LRU1
#define DUP_LRU1 0
#endif
#ifndef DUP_G23
#define DUP_G23 0
#endif
__global__ void __launch_bounds__(NWAVES * 64, 2) fwd(Args args) {
    extern __shared__ __attribute__((aligned(16))) unsigned char lds[];
    Frame F;
    F.lds = (LAS unsigned char*)lds; F.ldsg = (char*)lds;
    F.tid = threadIdx.x; F.lane = F.tid & 63; F.wave = __builtin_amdgcn_readfirstlane(F.tid >> 6); F.G = gridDim.x; F.wg = blockIdx.x;
    CArgs* const ka0 = (CArgs*)__builtin_amdgcn_kernarg_segment_ptr();
    unsigned char* ws; { CArgs* ka = ka0; ws = ka->ws; }
    volatile LAS unsigned* MISC = (volatile LAS unsigned*)(F.lds + MISC_OFF);
    if (F.tid < 64) ((LAS unsigned*)(F.lds + MISC_OFF))[F.tid] = 0u;
    __syncthreads();
    const int lo = ka0->ph_lo, hi = ka0->ph_hi;
    XcdBarrier bar; bar.bar = (unsigned*)(ws + WS_CTL) + CW_BAR; bar.x = 0; bar.st = nullptr;
    if (hi - lo > 1) bar = xcd_barrier_post((unsigned*)(ws + WS_CTL) + CW_BAR, MISC + 8);
#define IN(k) (lo <= (k) && (k) < hi)
#define SEAM(k) do { if ((k) + 1 < hi) { xcd_barrier(bar); if (DUP_BAR) xcd_barrier(bar); } } while (0)

    if (IN(0) && PRETOUCH) {
        CArgs* ka = KA(); const size_t gt = (size_t)F.wg * 512 + F.tid, GT = (size_t)F.G * 512; unsigned acc_ = 0u;
#define PT_RANGE(ptr, bytes) for (size_t p = gt; p < (size_t)(bytes) / PT_STRIDE; p += GT) acc_ += __builtin_nontemporal_load((const unsigned*)((const char*)(ptr) + p * PT_STRIDE))
        PT_RANGE(ka->ws, WS_END); PT_RANGE(KIN(8), (size_t)DEPTH * DM * NIN * 4); PT_RANGE(KIN(20), (size_t)DEPTH * 3 * DM * DM * 4); PT_RANGE(KIN(21), (size_t)DEPTH * DM * DM * 4);
        PT_RANGE(KIN(4), (size_t)DEPTH * DM * 3 * DM * 4); PT_RANGE(KIN(0), (size_t)NBATCH * SEQ * DM * 4); PT_RANGE(KIN(2), (size_t)NBATCH * CTXL * DM * 4); PT_RANGE(ka->out, (size_t)NBATCH * SEQ * DM * 4);
#undef PT_RANGE
        asm volatile("" :: "v"(acc_)); }
    if (IN(0)) { for (int rep = 0; rep <= DUP_PRO; ++rep) { const int wv = F.wg * NWAVES + F.wave, nwv = F.G * NWAVES;
            for (int lc = 0; lc < (CONV_HEAVY ? 1 : DEPTH); ++lc) p_convert(F, KA(), lc, wv, nwv, (CONVERT_AHEAD && lc > 0) ? CONV_AHEAD_ITEMS : 0);
            p_prologue(F, KA()); }
        SEAM(0); }
#pragma unroll 1
    for (int l = 0; l < DEPTH; ++l) {
        const int base = 1 + l * PH_PER_LAYER; const bool need_ctx = l < DEPTH - 1;
        if (IN(base + 0)) { p_norm(F, KA(), l); if (DUP_NORM) p_norm(F, KA(), l + 1 <= DEPTH - 1 && l > 0 ? l : l, true); SEAM(base + 0); }
        if (IN(base + 1)) {
            CArgs* ka = KA(); pg8::Gemm g{WSB(WS_H), WSB(WS_WIN) + (size_t)l * NP * DM, MROWS, NP, DM, 0, 0}; pg8::InOrder S; S.init(MROWS, NP, F.G, F.wg, 256, !need_ctx); S.rounds = 0;
            typedef pg8::EpiIn<(long)((WS_X8 - WS_P) / 2)> EpiInT; EpiInT E{WSB(WS_P)};
            const int nu = (MROWS / 256) * (NP / 256), extra = nu % F.G, full = nu / F.G;
            const bool tsplit = tail_split_ok(F.G, need_ctx);
            if (tsplit) S.rounds = full;
            pg8::gemm_phase<EpiInT, pg8::InOrder, true, true>(F.lds, g, S, E);
            if (DUP_G1) pg8::gemm_phase<EpiInT, pg8::InOrder, true, true>(F.lds, g, S, E);
            if (tsplit) { pg8::Gemm gt{WSB(WS_H), WSB(WS_WIN) + (size_t)l * NP * DM, MROWS, NP, DM / TAIL_KS, (size_t)(DM / TAIL_KS) * 2, (size_t)(DM / TAIL_KS) * 2, DM};
                pg8::TailOrder ST; ST.init(MROWS, NP, F.G, F.wg, 256, false); ST.full = full; ST.extra = extra; ST.KS = TAIL_KS;
                pg8::EpiPartial EP{WSF(WS_ACC), extra};
                pg8::gemm_phase<pg8::EpiPartial, pg8::TailOrder, true, true>(F.lds, gt, ST, EP); }
            if (need_ctx) {
                const int busy = tsplit ? extra * TAIL_KS : extra;
                if (F.wg >= busy) { p_gates(F, KA(), l, F.wg - busy, F.G - busy);
                    if (CONVERT_AHEAD && l + 1 < DEPTH) p_convert(F, KA(), l + 1, (F.wg - busy) * NWAVES + F.wave, (F.G - busy) * NWAVES, 0, CONV_SPLIT); } }
            SEAM(base + 1);
        }
        if (IN(base + 2)) { if (!need_ctx) p_gates(F, KA(), l, F.wg, F.G); if (tail_split_ok(F.G, need_ctx)) p_tail_combine(F, KA()); p_knorm(F, KA(), l); if (DUP_KNORM) p_knorm(F, KA(), l, true);
#if USE_NAIVE_LRU
            p_lru_gates_naive(F, KA(), l);
#endif
            SEAM(base + 2); }
        if (IN(base + 3)) {
#define ML_UNITS() do { for (int v = F.wg; v < 256; v += F.G) {    \
                const int u = (F.G % 8 == 0) ? (((v & 7) * 8 + ((v >> 3) >> 2)) * 4 + ((v >> 3) & 3)) : v; \
                if (ML_TR) ml::mlstm_unit_tr(F, KA(), u, need_ctx); else ml::mlstm_unit_pipe<0>(F, KA(), u, need_ctx); if (ML_VAR) ml::mlstm_unit_pipe<ML_VAR>(F, KA(), u, need_ctx); } } while (0)
            if (HEAVY_MIX && (F.wg & 1)) ML_UNITS();
#define CONV_H() do { if (CONV_HEAVY && l + 1 < DEPTH) { __syncthreads(); p_convert(F, KA(), l + 1, F.wg * NWAVES + F.wave, F.G * NWAVES, CONV_AHEAD_ITEMS, 1 << 30); __syncthreads(); } } while (0)
            if (!((F.wg >> 3) & 1)) CONV_H();
#if HEAVY_ROT
            { const int rot = (F.wg >> 3) % 3;
#pragma unroll 1
              for (int sl = 0; sl < 3; ++sl) { const int k = (sl + rot) % 3;
                  __syncthreads();
                  if (k == 0) p_attention(F, KA(), l, need_ctx);
                  else if (k == 1) ML_UNITS();
                  else lru::p_lru_agg<0>(F, KA(), l); }
              __syncthreads(); }
#else
            for (int r2 = 0; r2 <= DUP_ATT; ++r2) p_attention(F, KA(), l, need_ctx);
            if (!(HEAVY_MIX && (F.wg & 1))) ML_UNITS();
            lru::p_lru_agg<0>(F, KA(), l); if (LRU_VAR >= 0) lru::p_lru_agg<(LRU_VAR >= 0 ? LRU_VAR : 0)>(F, KA(), l);
#endif
#undef ML_UNITS
            if ((F.wg >> 3) & 1) CONV_H();
#undef CONV_H
            SEAM(base + 3); }
        if (IN(base + 4)) { for (int rep = 0; rep <= DUP_THIN; ++rep) {
            const bool lru_first = THIN_MIX && ((F.wg >> 3) & 1);
            if (!lru_first) { for (int r2 = 0; r2 <= DUP_MLOUT; ++r2) p_mlout(F, KA(), l, need_ctx); }
#if USE_NAIVE_LRU
            p_lru_combine_naive(F, KA());
#else
#if !LRU_LOOKBACK
            lru::p_lru_final(F, KA(), l, need_ctx); if (DUP_LRU2) lru::p_lru_final(F, KA(), l, need_ctx);
#endif
#endif
            if (lru_first) p_mlout(F, KA(), l, need_ctx);
            }
            SEAM(base + 4); }
        if (IN(base + 5)) {
            CArgs* ka = KA(); pg8::Gemm g{WSB(WS_YB), WSB(WS_WBR) + (size_t)l * 3 * DM * DM, MROWS, DM, DM, (size_t)MROWS * DM * 2, (size_t)DM * DM * 2}; pg8::MergeOrder S; S.init(MROWS, DM, F.G, F.wg, GEMM_NHALF ? 128 : 256, !need_ctx);
#if MERGE_CHAIN
            pg8::EpiMergeC E{WSB(WS_P), WSB(WS_G2)};
            pg8::gemm_phase<pg8::EpiMergeC, pg8::MergeOrder, true, true, false>(F.lds, g, S, E);
#else
            pg8::EpiMerge<GEMM_NHALF> E{WSB(WS_P), WSF(WS_ACC), WSB(WS_G2)};
            pg8::gemm_phase<pg8::EpiMerge<GEMM_NHALF>, pg8::MergeOrder, true, true, GEMM_NHALF>(F.lds, g, S, E);
#endif
            if (DUP_G23) pg8::gemm_phase<decltype(E), pg8::MergeOrder, true, true, false>(F.lds, g, S, E);
            if (CONVERT_AHEAD && l + 1 < DEPTH) {
                const int ntile_m = (MROWS / 256) * (DM / (GEMM_NHALF ? 128 : 256));
                if (SPLIT_CTX && F.G == 256) { const int busy2 = 96; if (F.wg >= busy2) p_convert(F, KA(), l + 1, (F.wg - busy2) * NWAVES + F.wave, (F.G - busy2) * NWAVES, 0, CONV_WIN_M); }
                else { const int ntile = ntile_m, busy2 = (ntile > F.G && ntile < 2 * F.G) ? ntile - F.G : 0;
                    if (F.wg >= busy2) p_convert(F, KA(), l + 1, (F.wg - busy2) * NWAVES + F.wave, (F.G - busy2) * NWAVES, 0, CONV_AHEAD_ITEMS); } }
            SEAM(base + 5);
        }
        if (IN(base + 6)) {
            CArgs* ka = KA(); pg8::Gemm g{WSB(WS_G2), WSB(WS_WOUT) + (size_t)l * DM * DM, MROWS, DM, DM, (size_t)MROWS * DM * 2, 0}; pg8::SplitOutOrder S; S.init(MROWS, DM, F.G, F.wg, GEMM_NHALF ? 128 : 256, !need_ctx);
#if Y_BF16
            pg8::EpiY16 E{WSB(WS_Y), (size_t)MROWS * DM};
#else
            pg8::EpiF32<GEMM_NHALF> E{WSF(WS_Y), DM, (size_t)MROWS * DM};
#endif
            pg8::gemm_phase<decltype(E), pg8::SplitOutOrder, true, true, false>(F.lds, g, S, E);
            if (DUP_G23) pg8::gemm_phase<decltype(E), pg8::SplitOutOrder, true, true, false>(F.lds, g, S, E);
            const int ntile_o = (MROWS / 256) * (DM / (GEMM_NHALF ? 128 : 256));
            if (CONVERT_AHEAD && l + 1 < DEPTH && SPLIT_CTX && F.G == 256) { const int busy2 = 96; (void)ntile_o;
                if (F.wg >= busy2) p_convert(F, KA(), l + 1, (F.wg - busy2) * NWAVES + F.wave, (F.G - busy2) * NWAVES, CONV_WIN_M, CONV_AHEAD_ITEMS); }
            SEAM(base + 6);
        }
    }
    if (IN(N_PHASES - 1)) p_norm(F, KA(), DEPTH);
#undef IN
#undef SEAM
}

extern "C" void kernel_launch(void* const* d_in, const int* in_sizes, int n_in, void* d_out, int out_size, void* d_ws, size_t ws_size, hipStream_t stream) {
    static int grid = 0;
    if (grid == 0) {
        if (n_in != 22 || in_sizes[0] != NBATCH * SEQ * DM || out_size != NBATCH * SEQ * DM || ws_size < WS_END) {
            fprintf(stderr, "kernel_launch: unexpected shapes: n_in %d in0 %d out %d ws %zu (need %zu)\n", n_in, n_in > 0 ? in_sizes[0] : -1, out_size, ws_size, (size_t)WS_END); grid = -1; return; }
        int dev = 0, cus = 0, per_cu = 0;
        if (hipGetDevice(&dev) != hipSuccess || hipDeviceGetAttribute(&cus, hipDeviceAttributeMultiprocessorCount, dev) != hipSuccess) { fprintf(stderr, "kernel_launch: device query failed\n"); grid = -1; return; }
        if (hipFuncSetAttribute((const void*)fwd, hipFuncAttributeMaxDynamicSharedMemorySize, LDS_BYTES) != hipSuccess) { fprintf(stderr, "kernel_launch: hipFuncSetAttribute failed\n"); grid = -1; return; }
        if (hipOccupancyMaxActiveBlocksPerMultiprocessor(&per_cu, (const void*)fwd, NWAVES * 64, LDS_BYTES) != hipSuccess || per_cu < 1)
            fprintf(stderr, "kernel_launch: note: occupancy query reports %d workgroups per CU\n", per_cu);
        (void)hipGetLastError();
        grid = cus;
    }
    if (grid < 0) return;
    if (hipMemsetAsync((char*)d_ws + WS_CTL, 0, CTL_ZERO_BYTES, stream) != hipSuccess) { fprintf(stderr, "kernel_launch: memset failed\n"); return; }
    Args a{};
    for (int i = 0; i < 22; ++i) a.in[i] = (const float*)d_in[i];
    a.out = (float*)d_out; a.ws = (unsigned char*)d_ws;
    if (MK_N_LAUNCHES == 1) { a.ph_lo = 0; a.ph_hi = N_PHASES; hipLaunchKernelGGL(fwd, dim3(grid), dim3(NWAVES * 64), LDS_BYTES, stream, a); }
    else for (int k = 0; k < N_PHASES; ++k) { a.ph_lo = k; a.ph_hi = k + 1; hipLaunchKernelGGL(fwd, dim3(grid), dim3(NWAVES * 64), LDS_BYTES, stream, a); }
    const hipError_t le = hipPeekAtLastError();
    if (le != hipSuccess) fprintf(stderr, "kernel_launch: launch failed: %s\n", hipGetErrorName(le));
}
```

```cpp
#include <hip/hip_runtime.h>
#include <hip/hip_bf16.h>
#include <cstdio>
#include <cstdint>

constexpr int DM = 2048, NBATCH = 4, SEQ = 2048, CTXL = 256, TPB = SEQ + CTXL  , MROWS = NBATCH * TPB  , DEPTH = 4;
constexpr int NIN = 25632, NP = 25600;
constexpr int C_LX = 0, C_LZ = 2048, C_MQ = 4096, C_MK = 6144, C_MV = 8192, C_MO = 10240, C_MZ = 12288, C_AQ = 14336, C_AK = 16384, C_AV = 16896, C_AZ = 17408, C_MG = 19456;
constexpr float EPS = 1e-6f;
#ifndef SPLIT_CTX
#define SPLIT_CTX 1
#endif
#ifndef Y_BF16
#define Y_BF16 1
#endif

namespace pg8 {
#define PG8_LAS __attribute__((address_space(3)))
typedef unsigned short bf16_t;
typedef short bf16x8 __attribute__((ext_vector_type(8)));
typedef float f32x4 __attribute__((ext_vector_type(4)));
typedef unsigned u32x4 __attribute__((ext_vector_type(4)));
constexpr int BM = 256, BK = 64, HALF = 128, HTB = HALF * BK * 2  , STAGE_BYTES = 8 * HTB, NXCD = 8, WGM = 8;

__host__ __device__ __forceinline__ int lds_byte(int r, int c) { const int st = (r >> 4) * 2 + (c >> 5), rr = r & 15, cc = c & 31, ob = rr * 64 + cc * 2; return st * 1024 + (ob ^ (((ob >> 9) & 1) << 5)); }
__host__ __device__ __forceinline__ void stage_rc(int b, int& R, int& C) { const int st = b / 1024, sb = b % 1024, swz = sb ^ (((sb >> 9) & 1) << 5); R = (st >> 1) * 16 + swz / 64; C = (st & 1) * 32 + (swz % 64) / 2; }
__host__ __device__ __forceinline__ int perm32(int rho) { const int n = rho >> 4, i = rho & 15; return 8 * (i >> 2) + 4 * n + (i & 3); }

struct Unit { int pm, pn, z, sp; };
struct Gemm { const bf16_t* A; const bf16_t* Bt; int M, N, K; size_t zA, zB; };

struct StaticOrder {
    int nM, nN, nwg, G, c; bool lat;
    __host__ __device__ void init(int M, int N, int G_, int c_, int tileN = BM, bool lat_ = false) { lat = lat_; nM = lat ? (M / BM) * 8 / 9 : M / BM; nN = N / tileN; nwg = nM * nN; G = G_; c = c_; }
    __host__ __device__ bool map_x(long L, Unit& u, int nM_, int nwg_, bool lat_) const {
        if (L >= nwg_) return false;
        int wgid = (int)L; { const int q = nwg_ / NXCD, r = nwg_ % NXCD, xcd = wgid % NXCD, off = wgid / NXCD; wgid = (xcd < r ? xcd * (q + 1) : r * (q + 1) + (xcd - r) * q) + off; }
        const int nig = WGM * nN, gid = wgid / nig, fm = gid * WGM, gsz = (nM_ - fm) < WGM ? (nM_ - fm) : WGM;
        u.pm = fm + ((wgid % nig) % gsz); u.pn = (wgid % nig) / gsz; u.z = 0; u.sp = 0; if (lat_) u.pm = (u.pm >> 3) * 9 + (u.pm & 7); return true;
    }
    __host__ __device__ bool map(long L, Unit& u) const { return map_x(L, u, nM, nwg, lat); }
    __host__ __device__ bool next(int i, Unit& u) const { return map((long)i * G + c, u); }
    __device__ __forceinline__ void a_ready(const Unit&) const {}
    __device__ __forceinline__ void done(const Unit&) const {}
};
struct InOrder : StaticOrder {
    __host__ __device__ bool next(int i, Unit& u) const { const long L = (long)i * G + c; if (L < nwg) return map(L, u);
        if (!lat) return false; const int idx = (int)(L - nwg); if (idx >= 4 * 28) return false;
        const int bb = idx / 28, j = idx - bb * 28; u.pm = 9 * bb + 8; u.z = 0; u.sp = 0; u.pn = j < 8 ? j : j < 16 ? 16 + j : j < 24 ? 16 + j : j < 26 ? 40 + j : 40 + j; return true; }
};
struct FixedOrder : StaticOrder {
    __host__ __device__ bool next(int i, Unit& u) const { if (!StaticOrder::next(i, u)) return false; u.pm = 0; u.pn = 0; return true; }
};
struct MergeOrder : StaticOrder {
    __host__ __device__ bool split_ok() const { return SPLIT_CTX && !lat && nM == 36 && nN == 8 && G == 256; }
    __host__ __device__ bool next(int i, Unit& u) const {
        if (!split_ok()) { const int it = i / 3; if (!StaticOrder::next(it, u)) return false; u.z = i - 3 * it; return true; }
        if (i < 3) { if (!map_x((long)c, u, 32, 256, true)) return false; u.z = i; return true; }
        if (i > 3 || c >= 96) return false;
        const int s = c & 31; u.pm = 9 * (s >> 3) + 8; u.pn = s & 7; u.z = c >> 5; u.sp = 1; return true; }
};
struct SplitOutOrder : StaticOrder {
    __host__ __device__ bool split_ok() const { return SPLIT_CTX && !lat && nM == 36 && nN == 8 && G == 256; }
    __host__ __device__ bool next(int i, Unit& u) const {
        if (!split_ok()) return StaticOrder::next(i, u);
        if (i == 0) return map_x((long)c, u, 32, 256, true);
        if (i > 1 || c >= 96) return false;
        const int s = c & 31; u.pm = 9 * (s >> 3) + 8; u.pn = s & 7; u.z = 1 + (c >> 5); u.sp = 1; return true; }
};
__device__ __forceinline__ unsigned cvt_pk_bf16(float lo, float hi) { unsigned r; asm volatile("v_cvt_pk_bf16_f32 %0, %1, %2" : "=v"(r) : "v"(lo), "v"(hi)); return r; }
__device__ __forceinline__ float bflo(unsigned w) { return __uint_as_float(w << 16); }
__device__ __forceinline__ float bfhi(unsigned w) { return __uint_as_float(w & 0xffff0000u); }
__device__ __forceinline__ float sigmoid_f(float x) { return __builtin_amdgcn_rcpf(1.f + __expf(-x)); }

template <bool NHALF> struct EpiF32 {
    static constexpr bool PERM = false, AFTER_DRAIN = false;
    float* C; int ldc; size_t slab;
    __device__ __forceinline__ void operator()(const f32x4 (&acc)[2][2][4][2], const Unit& u, int wr, int wc, int fr, int fq) const {
        const int row0 = u.pm * BM + wr * 64 + fr, col0 = u.pn * (NHALF ? HALF : BM) + wc * 32 + 4 * fq;
        float* Cb = C + (u.sp ? (size_t)(u.z - 1) * slab : (size_t)0);
#pragma unroll
        for (int ai = 0; ai < 2; ++ai)
#pragma unroll
            for (int m = 0; m < 4; ++m) { float* rowp = Cb + (size_t)(row0 + ai * HALF + m * 16) * ldc + col0;
#pragma unroll
                for (int bj = 0; bj < (NHALF ? 1 : 2); ++bj)
#pragma unroll
                    for (int n = 0; n < 2; ++n) *(f32x4*)(rowp + bj * HALF + n * 16) = acc[ai][bj][m][n]; }
    }
};
struct EpiNull {
    static constexpr bool PERM = true, AFTER_DRAIN = false; float* sink;
    __device__ __forceinline__ void operator()(const f32x4 (&acc)[2][2][4][2], const Unit& u, int wr, int wc, int fr, int fq) const {
        float s = 0.f;
#pragma unroll
        for (int ai = 0; ai < 2; ++ai)
#pragma unroll
            for (int bj = 0; bj < 2; ++bj)
#pragma unroll
                for (int m = 0; m < 4; ++m)
#pragma unroll
                    for (int n = 0; n < 2; ++n) s += acc[ai][bj][m][n][0] + acc[ai][bj][m][n][1] + acc[ai][bj][m][n][2] + acc[ai][bj][m][n][3];
        if (s == 123.456f) sink[0] = s; }
};
template <long X8D> struct EpiIn {
    static constexpr bool PERM = true, AFTER_DRAIN = false;
    bf16_t* O;
    __device__ __forceinline__ void operator()(const f32x4 (&acc)[2][2][4][2], const Unit& u, int wr, int wc, int fr, int fq) const {
        const int pn = u.pn;
        int act = 0;
        if ((pn >= 8 && pn < 16) || (pn >= 48 && pn < 56) || (pn >= 68 && pn < 76)) act = 1;
        else if ((pn >= 40 && pn < 48) || pn >= 76) act = 2;
        else if (pn >= 24 && pn < 32) act = 3;
        const bool blocked = pn >= 16 && pn < 40;
        bf16_t* base = blocked ? O + X8D + (size_t)((pn - 16) >> 3) * MROWS * DM + ((size_t)((u.pm / 9) * 8 + ((pn - 16) & 7)) * 36 + (u.pm % 9) * 4) * (32 * 64 * 8)
                               : O + (size_t)u.pm * BM * NP + (size_t)pn * BM;
        const unsigned lane_off = blocked ? (unsigned)(wr * (32 * 64 * 8) + ((wc * 4 + fq) * 64 + fr) * 8) : (unsigned)((wr * 64 + fr) * NP + wc * 32 + 8 * fq);
        const unsigned sa = blocked ? 2u * 32 * 64 * 8 : (unsigned)HALF * NP, sm = blocked ? 16u * 8 : 16u * NP, sb = blocked ? 16u * 64 * 8 : (unsigned)HALF;
#pragma unroll
        for (int ai = 0; ai < 2; ++ai)
#pragma unroll
            for (int m = 0; m < 4; ++m) {
#pragma unroll
                for (int bj = 0; bj < 2; ++bj) { f32x4 v0 = acc[ai][bj][m][0], v1 = acc[ai][bj][m][1];
                    if (act == 1) {
#pragma unroll
                        for (int j = 0; j < 4; ++j) { v0[j] = v0[j] * sigmoid_f(v0[j]); v1[j] = v1[j] * sigmoid_f(v1[j]); } }
                    else if (act == 2) {
#pragma unroll
                        for (int j = 0; j < 4; ++j) { v0[j] = sigmoid_f(v0[j]); v1[j] = sigmoid_f(v1[j]); } }
                    else if (act == 3) { v0 = v0 * 0.0625f; v1 = v1 * 0.0625f; }
                    u32x4 w; w.x = cvt_pk_bf16(v0[0], v0[1]); w.y = cvt_pk_bf16(v0[2], v0[3]); w.z = cvt_pk_bf16(v1[0], v1[1]); w.w = cvt_pk_bf16(v1[2], v1[3]);
                    *(u32x4*)(base + (lane_off + ai * sa + m * sm + bj * sb)) = w; } }
    }
};
template <bool NHALF> struct EpiMerge {
    static constexpr bool PERM = true, AFTER_DRAIN = false;
    const bf16_t* P; float* ACC; bf16_t* G2;
    __device__ __forceinline__ void operator()(const f32x4 (&acc)[2][2][4][2], const Unit& u, int wr, int wc, int fr, int fq) const {
        const int row0 = u.pm * BM + wr * 64 + fr, col0 = u.pn * (NHALF ? HALF : BM) + wc * 32 + 8 * fq, z = u.z;
#pragma unroll
        for (int ai = 0; ai < 2; ++ai)
#pragma unroll
            for (int m = 0; m < 4; ++m) { const size_t r = (size_t)(row0 + ai * HALF + m * 16);
#pragma unroll
                for (int bj = 0; bj < (NHALF ? 1 : 2); ++bj) { const int c = col0 + bj * HALF;
                    const u32x4 g = *(const u32x4*)(P + r * NP + C_MG + z * DM + c);
                    f32x4 v0 = acc[ai][bj][m][0], v1 = acc[ai][bj][m][1];
                    v0[0] *= bflo(g.x); v0[1] *= bfhi(g.x); v0[2] *= bflo(g.y); v0[3] *= bfhi(g.y);
                    v1[0] *= bflo(g.z); v1[1] *= bfhi(g.z); v1[2] *= bflo(g.w); v1[3] *= bfhi(g.w);
                    if (u.sp) { u32x4 w; w.x = cvt_pk_bf16(v0[0], v0[1]); w.y = cvt_pk_bf16(v0[2], v0[3]); w.z = cvt_pk_bf16(v1[0], v1[1]); w.w = cvt_pk_bf16(v1[2], v1[3]);
                        *(u32x4*)(G2 + (size_t)(1 + z) * MROWS * DM + r * DM + c) = w;
                        continue; }
                    float* ap = ACC + r * DM + c;
                    if (z > 0) { v0 = v0 + *(const f32x4*)ap; v1 = v1 + *(const f32x4*)(ap + 4); }
                    if (z < 2) { *(f32x4*)ap = v0; *(f32x4*)(ap + 4) = v1; }
                    else { u32x4 w; w.x = cvt_pk_bf16(v0[0], v0[1]); w.y = cvt_pk_bf16(v0[2], v0[3]); w.z = cvt_pk_bf16(v1[0], v1[1]); w.w = cvt_pk_bf16(v1[2], v1[3]);
                        *(u32x4*)(G2 + r * DM + c) = w; } } }
    }
};
struct EpiMergeC {
    static constexpr bool PERM = true, AFTER_DRAIN = false, CHAIN = true;
    static constexpr int DEPTH_PF = 4;
    const bf16_t* P; bf16_t* G2;
    __device__ __forceinline__ static bool keep(const Unit& u) { return !u.sp && u.z < 2; }
    __device__ __forceinline__ static void unpack8(const u32x4 g, float (&s)[8]) { s[0] = bflo(g.x); s[1] = bfhi(g.x); s[2] = bflo(g.y); s[3] = bfhi(g.y); s[4] = bflo(g.z); s[5] = bfhi(g.z); s[6] = bflo(g.w); s[7] = bfhi(g.w); }
    __device__ __forceinline__ void operator()(f32x4 (&acc)[2][2][4][2], const Unit& u, int wr, int wc, int fr, int fq) const {
        const int row0 = u.pm * BM + wr * 64 + fr, col0 = u.pn * BM + wc * 32 + 8 * fq, z = u.z;
        constexpr float FLOOR = 1e-12f;
        const bf16_t* gp0 = P + (size_t)row0 * NP + C_MG + z * DM + col0;
        const bool chain = !u.sp && z < 2;
        bf16_t* O = G2 + (u.sp ? (size_t)(1 + z) * MROWS * DM : (size_t)0) + (size_t)row0 * DM + col0;
        u32x4 gq[DEPTH_PF], hq[DEPTH_PF];
#define EMC_OFF(t) ((size_t)((((t) >> 3) & 1) * HALF + (((t) >> 1) & 3) * 16) * NP + ((t) & 1) * HALF)
#define EMC_LOAD(t) do { gq[(t) % DEPTH_PF] = *(const u32x4*)(gp0 + EMC_OFF(t)); if (chain) hq[(t) % DEPTH_PF] = *(const u32x4*)(gp0 + EMC_OFF(t) + DM); } while (0)
#pragma unroll
        for (int t = 0; t < DEPTH_PF - 1; ++t) EMC_LOAD(t);
#pragma unroll
        for (int t = 0; t < 16; ++t) { const int ai = (t >> 3) & 1, m = (t >> 1) & 3, bj = t & 1;
            if (t + DEPTH_PF - 1 < 16) EMC_LOAD(t + DEPTH_PF - 1);
            float s[8]; unpack8(gq[t % DEPTH_PF], s);
            if (chain) { float d[8]; unpack8(hq[t % DEPTH_PF], d);
#pragma unroll
                for (int j = 0; j < 8; ++j) s[j] = fmaxf(s[j], FLOOR) * __builtin_amdgcn_rcpf(fmaxf(d[j], FLOOR));
#pragma unroll
                for (int j = 0; j < 4; ++j) { acc[ai][bj][m][0][j] *= s[j]; acc[ai][bj][m][1][j] *= s[4 + j]; } }
            else { if (!u.sp) {
#pragma unroll
                    for (int j = 0; j < 8; ++j) s[j] = fmaxf(s[j], FLOOR); }
                f32x4 v0 = acc[ai][bj][m][0], v1 = acc[ai][bj][m][1];
#pragma unroll
                for (int j = 0; j < 4; ++j) { v0[j] *= s[j]; v1[j] *= s[4 + j]; }
                u32x4 w; w.x = cvt_pk_bf16(v0[0], v0[1]); w.y = cvt_pk_bf16(v0[2], v0[3]); w.z = cvt_pk_bf16(v1[0], v1[1]); w.w = cvt_pk_bf16(v1[2], v1[3]);
                *(u32x4*)(O + (size_t)(ai * HALF + m * 16) * DM + bj * HALF) = w; } }
#undef EMC_OFF
#undef EMC_LOAD
    }
};
struct EpiY16 {
    static constexpr bool PERM = true, AFTER_DRAIN = false;
    bf16_t* Y; size_t slab;
    __device__ __forceinline__ void operator()(const f32x4 (&acc)[2][2][4][2], const Unit& u, int wr, int wc, int fr, int fq) const {
        const int row0 = u.pm * BM + wr * 64 + fr, col0 = u.pn * BM + wc * 32 + 8 * fq;
        bf16_t* Yb = Y + (u.sp ? (size_t)(u.z - 1) * slab : (size_t)0);
#pragma unroll
        for (int ai = 0; ai < 2; ++ai)
#pragma unroll
            for (int m = 0; m < 4; ++m) { bf16_t* rowp = Yb + (size_t)(row0 + ai * HALF + m * 16) * DM + col0;
#pragma unroll
                for (int bj = 0; bj < 2; ++bj) { const f32x4 v0 = acc[ai][bj][m][0], v1 = acc[ai][bj][m][1];
                    u32x4 w; w.x = cvt_pk_bf16(v0[0], v0[1]); w.y = cvt_pk_bf16(v0[2], v0[3]); w.z = cvt_pk_bf16(v1[0], v1[1]); w.w = cvt_pk_bf16(v1[2], v1[3]);
                    *(u32x4*)(rowp + bj * HALF) = w; } }
    }
};
template <class T, class = void> struct epi_chain { static constexpr bool value = false; };
template <class T> struct epi_chain<T, decltype((void)T::CHAIN)> { static constexpr bool value = T::CHAIN; };
template <class Epi, class Sched, bool ALIGN_EPI = false, bool SP2 = false, bool NHALF = false>
__device__ __forceinline__ void gemm_phase(PG8_LAS unsigned char* lds, const Gemm g, const Sched& S, const Epi& E) {
    int tid = threadIdx.x; asm volatile("" : "+v"(tid));
    const int wid = __builtin_amdgcn_readfirstlane(tid >> 6), lane = tid & 63, wr = wid >> 2, wc = wid & 3, fr = lane & 15, fq = lane >> 4;
    const int K = g.K, nt = K / BK;
    unsigned voffA[2], voffB[2];
#pragma unroll
    for (int i = 0; i < 2; ++i) { int R, C; stage_rc(tid * 16 + i * 8192, R, C); const int Rb = Epi::PERM ? ((R & ~31) + perm32(R & 31)) : R;
        voffA[i] = (unsigned)(R * K + C) * 2u; voffB[i] = (unsigned)(Rb * K + C) * 2u; }
    const size_t kstep = (size_t)(BK * 2);
    const size_t hstep = (size_t)HALF * K * 2;
    const size_t tstep = 2 * hstep;
    const size_t hsB = NHALF ? 0 : hstep, tstepB = NHALF ? hstep : tstep; static_assert(!NHALF || SP2, "NHALF is implemented for the SP2 loop");
    const unsigned ldsw = (unsigned)wid * 1024u;
    const int aoff = lds_byte(wr * 64 + fr, fq * 8), boff = lds_byte(wc * 32 + fr, fq * 8);
#define PG8_SA(b, h) (((b) * 2 + (h)) * HTB)
#define PG8_SB(b, h) ((4 + (b) * 2 + (h)) * HTB)
#define PG8_STAGE(bufoff, gbase, voff) do { _Pragma("unroll") for (int _i = 0; _i < 2; ++_i) \
        __builtin_amdgcn_global_load_lds((const unsigned*)((const char*)(gbase) + (voff)[_i]), (PG8_LAS unsigned*)(lds + (bufoff) + ldsw + _i * 8192), 16, 0, 0); } while (0)
#define PG8_LDA(dst, b, h) do { _Pragma("unroll") for (int m = 0; m < 4; ++m) _Pragma("unroll") for (int k = 0; k < 2; ++k) dst[m][k] = *(const PG8_LAS bf16x8*)(lds + PG8_SA(b, h) + aoff + m * 2048 + k * 1024); } while (0)
#define PG8_LDB(dst, b, h) do { _Pragma("unroll") for (int n = 0; n < 2; ++n) _Pragma("unroll") for (int k = 0; k < 2; ++k) dst[n][k] = *(const PG8_LAS bf16x8*)(lds + PG8_SB(b, h) + boff + n * 2048 + k * 1024); } while (0)
#define PG8_MMA(ai, bj, At, Bt) do { __builtin_amdgcn_s_setprio(1); _Pragma("unroll") for (int m = 0; m < 4; ++m) _Pragma("unroll") for (int n = 0; n < 2; ++n) _Pragma("unroll") for (int k = 0; k < 2; ++k) \
        acc[ai][bj][m][n] = __builtin_amdgcn_mfma_f32_16x16x32_bf16(Bt[n][k], At[m][k], acc[ai][bj][m][n], 0, 0, 0); __builtin_amdgcn_s_setprio(0); } while (0)
#define PG8_WAIT_V(n) asm volatile("s_waitcnt vmcnt(" #n ")" ::: "memory")
#define PG8_WAIT_L(n) asm volatile("s_waitcnt lgkmcnt(" #n ")" ::: "memory")
#define PG8_BAR __builtin_amdgcn_s_barrier()
#define PG8_SCHED __builtin_amdgcn_sched_barrier(0)
    Unit cur, nxt; int ui = 0;
    if (!S.next(0, cur)) return;
    f32x4 acc[2][2][4][2];
#pragma unroll
    for (int a = 0; a < 2; ++a)
#pragma unroll
        for (int b = 0; b < 2; ++b)
#pragma unroll
            for (int m = 0; m < 4; ++m)
#pragma unroll
                for (int n = 0; n < 2; ++n) acc[a][b][m][n] = (f32x4){0.f, 0.f, 0.f, 0.f};
    bf16x8 At[4][2], B0[2][2], B1[2][2];
    const char* cA = (const char*)g.A + (size_t)cur.z * g.zA + (size_t)cur.pm * tstep; const char* cB = (const char*)g.Bt + (size_t)cur.z * g.zB + (size_t)cur.pn * tstepB;
    S.a_ready(cur);
    if constexpr (SP2) {
        PG8_STAGE(PG8_SB(0, 0), cB, voffB); PG8_STAGE(PG8_SB(0, 1), cB + hsB, voffB); PG8_STAGE(PG8_SA(0, 0), cA, voffA); PG8_STAGE(PG8_SA(0, 1), cA + hstep, voffA);
        if (wr == 1) PG8_BAR;
        PG8_WAIT_V(2); PG8_BAR;
        PG8_STAGE(PG8_SB(1, 0), cB + kstep, voffB); PG8_STAGE(PG8_SA(1, 0), cA + kstep, voffA); PG8_STAGE(PG8_SB(1, 1), cB + hsB + kstep, voffB);
        PG8_WAIT_V(6); PG8_BAR;
    } else {
        PG8_STAGE(PG8_SB(0, 0), cB, voffB); PG8_STAGE(PG8_SA(0, 0), cA, voffA); PG8_STAGE(PG8_SB(0, 1), cB + hstep, voffB); PG8_STAGE(PG8_SA(0, 1), cA + hstep, voffA);
        if (wr == 1) PG8_BAR;
        PG8_WAIT_V(4); PG8_BAR;
        PG8_STAGE(PG8_SB(1, 0), cB + kstep, voffB); PG8_STAGE(PG8_SA(1, 0), cA + kstep, voffA); PG8_STAGE(PG8_SB(1, 1), cB + hstep + kstep, voffB);
        PG8_WAIT_V(6); PG8_BAR;
    }
    for (;;) {
        const bool has_next = S.next(ui + 1, nxt);
        const char* nA = has_next ? (const char*)g.A + (size_t)nxt.z * g.zA + (size_t)nxt.pm * tstep : cA; const char* nB = has_next ? (const char*)g.Bt + (size_t)nxt.z * g.zB + (size_t)nxt.pn * tstepB : cB;
        for (int t = 0; t < nt; t += 2) {
            const bool last = (t == nt - 2);
            const char* a1 = cA + (size_t)(t + 1) * kstep;
            const char* a2 = last ? nA : cA + (size_t)(t + 2) * kstep; const char* b2 = last ? nB : cB + (size_t)(t + 2) * kstep;
            const char* a3 = a2 + kstep; const char* b3 = b2 + kstep;
            if (last && has_next) S.a_ready(nxt);
            if constexpr (SP2) {
            PG8_LDB(B0, 0, 0); if constexpr (!NHALF) PG8_LDB(B1, 0, 1); PG8_SCHED; PG8_LDA(At, 0, 0); PG8_STAGE(PG8_SA(1, 1), a1 + hstep, voffA);
            PG8_WAIT_V(8); PG8_WAIT_L(0); PG8_BAR; PG8_MMA(0, 0, At, B0); if constexpr (!NHALF) PG8_MMA(0, 1, At, B1); PG8_BAR; PG8_SCHED;
            PG8_LDA(At, 0, 1); PG8_STAGE(PG8_SB(0, 0), b2, voffB); PG8_STAGE(PG8_SB(0, 1), b2 + hsB, voffB); PG8_STAGE(PG8_SA(0, 0), a2, voffA);
            PG8_WAIT_V(8); PG8_WAIT_L(0); PG8_BAR; PG8_MMA(1, 0, At, B0); if constexpr (!NHALF) PG8_MMA(1, 1, At, B1); PG8_BAR; PG8_SCHED;
            PG8_LDB(B0, 1, 0); if constexpr (!NHALF) PG8_LDB(B1, 1, 1); PG8_SCHED; PG8_LDA(At, 1, 0); PG8_STAGE(PG8_SA(0, 1), a2 + hstep, voffA);
            PG8_WAIT_V(8); PG8_WAIT_L(0); PG8_BAR; PG8_MMA(0, 0, At, B0); if constexpr (!NHALF) PG8_MMA(0, 1, At, B1); PG8_BAR; PG8_SCHED;
            PG8_LDA(At, 1, 1); PG8_STAGE(PG8_SB(1, 0), b3, voffB); PG8_STAGE(PG8_SB(1, 1), b3 + hsB, voffB); PG8_STAGE(PG8_SA(1, 0), a3, voffA);
            PG8_WAIT_V(8); PG8_WAIT_L(0); PG8_BAR; PG8_MMA(1, 0, At, B0); if constexpr (!NHALF) PG8_MMA(1, 1, At, B1); PG8_BAR; PG8_SCHED;
            } else {
            PG8_LDB(B0, 0, 0); PG8_SCHED; PG8_LDA(At, 0, 0); PG8_STAGE(PG8_SA(1, 1), a1 + hstep, voffA);
            PG8_WAIT_L(8); PG8_BAR; PG8_WAIT_L(0); PG8_MMA(0, 0, At, B0); PG8_BAR; PG8_SCHED;
            PG8_LDB(B1, 0, 1); PG8_STAGE(PG8_SB(0, 0), b2, voffB);
            PG8_BAR; PG8_WAIT_L(0); PG8_MMA(0, 1, At, B1); PG8_BAR;
            PG8_LDA(At, 0, 1); PG8_STAGE(PG8_SA(0, 0), a2, voffA);
            PG8_BAR; PG8_WAIT_L(0); PG8_MMA(1, 0, At, B0); PG8_BAR; PG8_SCHED;
            PG8_STAGE(PG8_SB(0, 1), b2 + hstep, voffB);
            PG8_WAIT_V(6); PG8_BAR; PG8_MMA(1, 1, At, B1); PG8_BAR;
            PG8_LDB(B0, 1, 0); PG8_SCHED; PG8_LDA(At, 1, 0); PG8_STAGE(PG8_SA(0, 1), a2 + hstep, voffA);
            PG8_WAIT_L(8); PG8_BAR; PG8_WAIT_L(0); PG8_MMA(0, 0, At, B0); PG8_BAR; PG8_SCHED;
            PG8_LDB(B1, 1, 1); PG8_STAGE(PG8_SB(1, 0), b3, voffB);
            PG8_BAR; PG8_WAIT_L(0); PG8_MMA(0, 1, At, B1); PG8_BAR;
            PG8_LDA(At, 1, 1); PG8_STAGE(PG8_SA(1, 0), a3, voffA);
            PG8_BAR; PG8_WAIT_L(0); PG8_MMA(1, 0, At, B0); PG8_BAR; PG8_SCHED;
            PG8_STAGE(PG8_SB(1, 1), b3 + hstep, voffB);
            PG8_WAIT_V(6); PG8_BAR; PG8_MMA(1, 1, At, B1); PG8_BAR;
            }
        }
        if constexpr (ALIGN_EPI) { if (wr == 0) PG8_BAR; }
        if constexpr (!Epi::AFTER_DRAIN) { E(acc, cur, wr, wc, fr, fq); S.done(cur); }
        if (!has_next) break;
        bool clear = true; if constexpr (epi_chain<Epi>::value) clear = !Epi::keep(cur);
        if (clear) {
#pragma unroll
        for (int a = 0; a < 2; ++a)
#pragma unroll
            for (int b = 0; b < 2; ++b)
#pragma unroll
                for (int m = 0; m < 4; ++m)
#pragma unroll
                    for (int n = 0; n < 2; ++n) acc[a][b][m][n] = (f32x4){0.f, 0.f, 0.f, 0.f};
        }
        cur = nxt; cA = nA; cB = nB; ++ui;
        if constexpr (ALIGN_EPI) { if (wr == 1) PG8_BAR; }
    }
    PG8_WAIT_V(0);
    if constexpr (!ALIGN_EPI) { if (wr == 0) PG8_BAR; }
    PG8_BAR;
    if constexpr (Epi::AFTER_DRAIN) { E.fused(acc, cur, wr, wc, fr, fq, lds, wid, lane); S.done(cur); }
#undef PG8_SA
#undef PG8_SB
#undef PG8_STAGE
#undef PG8_LDA
#undef PG8_LDB
#undef PG8_MMA
#undef PG8_WAIT_V
#undef PG8_WAIT_L
#undef PG8_BAR
#undef PG8_SCHED
}
}

namespace att {
using bf16 = __hip_bfloat16;
constexpr int   D = 128, NW = 8, QBLK = 32, KVBLK = 64;
constexpr float SCALE = 0.088388347648318440f;
constexpr float THR = 8.f;
#ifndef ATT_SDEPTH
#define ATT_SDEPTH 1
#endif
constexpr int SDEPTH = ATT_SDEPTH;
constexpr int LDQ = NP, LDK = NP, LDO = DM;
constexpr size_t SHM_V = KVBLK * D * 2, SHM_K = KVBLK * D * 2, SHM_ATTN = 2 * SHM_V + 2 * SHM_K + NW * 64 * 4;
constexpr int OST_OFF = 69632, OST_END = OST_OFF + NW * 32 * 272;
using bf16x8 = __attribute__((ext_vector_type(8))) short;
using s16x4  = __attribute__((ext_vector_type(4))) short;
using f32x16 = __attribute__((ext_vector_type(16))) float;
using f32x4  = __attribute__((ext_vector_type(4))) float;
using u32x4  = __attribute__((ext_vector_type(4))) unsigned;
#define KSWZ(row, colB) ((row) * 256 + ((colB) ^ (((row) & 7) << 4)))
#define SBAR() __builtin_amdgcn_sched_barrier(0)
__device__ __forceinline__ int crow(int r, int hi) { return (r & 3) + 8 * (r >> 2) + 4 * hi; }
__device__ __forceinline__ unsigned cvtpk(float lo, float hi) { unsigned r; asm volatile("v_cvt_pk_bf16_f32 %0, %1, %2" : "=v"(r) : "v"(lo), "v"(hi)); return r; }
__device__ __forceinline__ bf16x8 ld8(const bf16* p) { return *reinterpret_cast<const bf16x8*>(p); }

__device__ __forceinline__ void partialSM(f32x16& p0, f32x16& p1, float& m_reg, float& mn, float& alpha) {
  constexpr float C = SCALE * 1.4426950408889634f;
  float pmax = p0[0];
#pragma unroll
  for (int r = 1; r < 16; ++r) pmax = fmaxf(pmax, p0[r]);
#pragma unroll
  for (int r = 0; r < 16; ++r) pmax = fmaxf(pmax, p1[r]);
  { auto rr = __builtin_amdgcn_permlane32_swap(__float_as_uint(pmax), __float_as_uint(pmax), false, false);
    pmax = fmaxf(__uint_as_float(rr[0]), __uint_as_float(rr[1])); }
  if (__builtin_expect(__all(pmax - m_reg <= THR / SCALE), 1)) { mn = m_reg; alpha = 1.f; }
  else { mn = fmaxf(m_reg, pmax); alpha = __builtin_amdgcn_exp2f((m_reg - mn) * C); m_reg = mn; }
  float mnC = -mn * C;
#pragma unroll
  for (int r = 0; r < 16; ++r) p0[r] = fmaf(p0[r], C, mnC);
#pragma unroll
  for (int r = 0; r < 16; ++r) p1[r] = fmaf(p1[r], C, mnC);
#pragma unroll
  for (int r = 0; r < 16; ++r) p0[r] = __builtin_amdgcn_exp2f(p0[r]);
}
__device__ __forceinline__ void finishSM(f32x16& p0, f32x16& p1, float alpha, float& l_reg, bf16x8& pa0, bf16x8& pa1, bf16x8& pa2, bf16x8& pa3) {
#pragma unroll
  for (int r = 0; r < 16; ++r) p1[r] = __builtin_amdgcn_exp2f(p1[r]);
  float ps = 0;
#pragma unroll
  for (int r = 0; r < 16; ++r) ps += p0[r];
#pragma unroll
  for (int r = 0; r < 16; ++r) ps += p1[r];
  { auto rr = __builtin_amdgcn_permlane32_swap(__float_as_uint(ps), __float_as_uint(ps), false, false);
    ps = __uint_as_float(rr[0]) + __uint_as_float(rr[1]); }
  l_reg = l_reg * alpha + ps;
#define PK4(P, BASE, OUT) do { unsigned a0 = cvtpk(P[BASE + 0], P[BASE + 1]), a1 = cvtpk(P[BASE + 2], P[BASE + 3]);   \
    unsigned b0 = cvtpk(P[BASE + 4], P[BASE + 5]), b1 = cvtpk(P[BASE + 6], P[BASE + 7]);                              \
    auto r0 = __builtin_amdgcn_permlane32_swap(a0, b0, false, false); auto r1 = __builtin_amdgcn_permlane32_swap(a1, b1, false, false); \
    u32x4 w = {r0[0], r1[0], r0[1], r1[1]}; OUT = *reinterpret_cast<bf16x8*>(&w); } while (0)
  PK4(p0, 0, pa0); PK4(p0, 8, pa1); PK4(p1, 0, pa2); PK4(p1, 8, pa3);
#undef PK4
}
__device__ __forceinline__ void qkt(f32x16& p0, f32x16& p1, const bf16* Ks, const bf16x8* qr, int r32, int hi) {
  p0 = f32x16{}; p1 = f32x16{};
#pragma unroll
  for (int d0 = 0; d0 < 8; ++d0) { int cb = (d0 * 16 + hi * 8) * 2;
    bf16x8 b0 = *reinterpret_cast<const bf16x8*>((const char*)Ks + KSWZ(r32, cb));
    bf16x8 b1 = *reinterpret_cast<const bf16x8*>((const char*)Ks + KSWZ(32 + r32, cb));
    p0 = __builtin_amdgcn_mfma_f32_32x32x16_bf16(b0, qr[d0], p0, 0, 0, 0);
    p1 = __builtin_amdgcn_mfma_f32_32x32x16_bf16(b1, qr[d0], p1, 0, 0, 0); }
}
__device__ __forceinline__ int v_st(int k, int c) { const int kk = (k & ~0xC) | ((k & 4) << 1) | ((k & 8) >> 1); return ((kk >> 3) * 4 + (c >> 5)) * 512 + ((kk & 7) * 32 + (c & 31)) * 2; }
__device__ __forceinline__ int v_rd_base(int lane) { return ((lane & 3) << 3) | (((lane >> 2) & 3) << 6) | (((lane >> 4) & 1) << 5) | (((lane >> 5) & 1) << 8); }
constexpr int v_rd_off(int d0, int ks, int half) { return d0 * 512 + ks * 4096 + half * 2048; }
template <int OFF> __device__ __forceinline__ s16x4 tr_read(int vb) {
  s16x4 r; asm volatile("ds_read_b64_tr_b16 %0, %1 offset:%2" : "=&v"(r) : "v"(vb), "i"(OFF) : "memory"); return r;
}
template <int D0> __device__ __forceinline__ void pv_one(f32x16& od, int vb, bf16x8 pa0, bf16x8 pa1, bf16x8 pa2, bf16x8 pa3) {
  const s16x4 l0 = tr_read<v_rd_off(D0, 0, 0)>(vb), h0 = tr_read<v_rd_off(D0, 0, 1)>(vb), l1 = tr_read<v_rd_off(D0, 1, 0)>(vb), h1 = tr_read<v_rd_off(D0, 1, 1)>(vb);
  const s16x4 l2 = tr_read<v_rd_off(D0, 2, 0)>(vb), h2 = tr_read<v_rd_off(D0, 2, 1)>(vb), l3 = tr_read<v_rd_off(D0, 3, 0)>(vb), h3 = tr_read<v_rd_off(D0, 3, 1)>(vb);
  asm volatile("s_waitcnt lgkmcnt(0)" ::: "memory"); SBAR();
#define PK(L, H) (bf16x8){L[0], L[1], L[2], L[3], H[0], H[1], H[2], H[3]}
  od = __builtin_amdgcn_mfma_f32_32x32x16_bf16(pa0, PK(l0, h0), od, 0, 0, 0);
  od = __builtin_amdgcn_mfma_f32_32x32x16_bf16(pa1, PK(l1, h1), od, 0, 0, 0);
  od = __builtin_amdgcn_mfma_f32_32x32x16_bf16(pa2, PK(l2, h2), od, 0, 0, 0);
  od = __builtin_amdgcn_mfma_f32_32x32x16_bf16(pa3, PK(l3, h3), od, 0, 0, 0);
#undef PK
}
__device__ __forceinline__ void pv_d0(f32x16* o, int vb, bf16x8 pa0, bf16x8 pa1, bf16x8 pa2, bf16x8 pa3) {
  pv_one<0>(o[0], vb, pa0, pa1, pa2, pa3); pv_one<1>(o[1], vb, pa0, pa1, pa2, pa3); pv_one<2>(o[2], vb, pa0, pa1, pa2, pa3); pv_one<3>(o[3], vb, pa0, pa1, pa2, pa3);
}

__device__ __forceinline__ void attn_unit(const bf16* __restrict__ Qb, const bf16* __restrict__ Kh, const bf16* __restrict__ Vh, const bf16* __restrict__ Zb,
                                          bf16* __restrict__ Ob, int seq, char* lds, const float* __restrict__ qn, const float* __restrict__ cs, const float* __restrict__ sn) {
  int tid = threadIdx.x; asm volatile("" : "+v"(tid));
  int wid = tid >> 6, lane = tid & 63, r32 = lane & 31, hi = lane >> 5;
  bf16* V_lds = (bf16*)lds; bf16* K_lds = (bf16*)(lds + 2 * SHM_V);
  float* ws = (float*)(lds + 2 * SHM_V + 2 * SHM_K) + wid * 64; float* li_l = ws; float* al_l = ws + 32;
  float m_reg = -1e30f, l_reg = 0; f32x16 o[4] = {}; bf16x8 qr[8];
  {
    const bf16* Qw = Qb + (long)(wid * QBLK + r32) * LDQ + hi * 8;
    float ss = 0.f;
#pragma unroll
    for (int d0 = 0; d0 < 8; ++d0) { const u32x4 w = *reinterpret_cast<const u32x4*>(Qw + d0 * 16); qr[d0] = __builtin_bit_cast(bf16x8, w);
#pragma unroll
      for (int e = 0; e < 4; ++e) { const float lo = __uint_as_float(w[e] << 16), hh = __uint_as_float(w[e] & 0xffff0000u); ss += lo * lo + hh * hh; } }
    { auto rr = __builtin_amdgcn_permlane32_swap(__float_as_uint(ss), __float_as_uint(ss), false, false); ss = __uint_as_float(rr[0]) + __uint_as_float(rr[1]); }
    const float rs = rsqrtf(ss * (1.f / 128.f) + EPS);
    const float* cp = cs ? cs + (long)(wid * QBLK + r32) * 64 + hi * 8 : nullptr; const float* sp = cs ? sn + (long)(wid * QBLK + r32) * 64 + hi * 8 : nullptr;
#pragma unroll
    for (int d0 = 0; d0 < 4; ++d0) {
      const u32x4 wa = __builtin_bit_cast(u32x4, qr[d0]), wb = __builtin_bit_cast(u32x4, qr[d0 + 4]); float x1[8], x2[8];
#pragma unroll
      for (int e = 0; e < 4; ++e) { x1[2 * e] = __uint_as_float(wa[e] << 16); x1[2 * e + 1] = __uint_as_float(wa[e] & 0xffff0000u); x2[2 * e] = __uint_as_float(wb[e] << 16); x2[2 * e + 1] = __uint_as_float(wb[e] & 0xffff0000u); }
      const f32x4 ga0 = *reinterpret_cast<const f32x4*>(qn + d0 * 16 + hi * 8), ga1 = *reinterpret_cast<const f32x4*>(qn + d0 * 16 + hi * 8 + 4);
      const f32x4 gb0 = *reinterpret_cast<const f32x4*>(qn + 64 + d0 * 16 + hi * 8), gb1 = *reinterpret_cast<const f32x4*>(qn + 64 + d0 * 16 + hi * 8 + 4);
#pragma unroll
      for (int e = 0; e < 8; ++e) { x1[e] *= rs * (e < 4 ? ga0[e & 3] : ga1[e & 3]); x2[e] *= rs * (e < 4 ? gb0[e & 3] : gb1[e & 3]); }
      if (cs) {
        const f32x4 c0 = *reinterpret_cast<const f32x4*>(cp + d0 * 16), c1 = *reinterpret_cast<const f32x4*>(cp + d0 * 16 + 4);
        const f32x4 s0 = *reinterpret_cast<const f32x4*>(sp + d0 * 16), s1 = *reinterpret_cast<const f32x4*>(sp + d0 * 16 + 4);
#pragma unroll
        for (int e = 0; e < 8; ++e) { const float c = e < 4 ? c0[e & 3] : c1[e & 3], sv = e < 4 ? s0[e & 3] : s1[e & 3];
          const float a = x1[e], bq = x2[e]; x1[e] = a * c - bq * sv; x2[e] = bq * c + a * sv; }
      }
      const u32x4 oa = {cvtpk(x1[0], x1[1]), cvtpk(x1[2], x1[3]), cvtpk(x1[4], x1[5]), cvtpk(x1[6], x1[7])}, ob = {cvtpk(x2[0], x2[1]), cvtpk(x2[2], x2[3]), cvtpk(x2[4], x2[5]), cvtpk(x2[6], x2[7])};
      qr[d0] = __builtin_bit_cast(bf16x8, oa); qr[d0 + 4] = __builtin_bit_cast(bf16x8, ob);
      asm volatile("" ::: "memory");
    }
  }
  const int sr = tid >> 4, sc = (tid & 15) * 8, vst0 = v_st(sr, sc), vst1 = v_st(32 + sr, sc);
  const int vb0 = (int)(uintptr_t)V_lds + v_rd_base(lane);
  struct { bf16x8 vs0, vs1, ks0, ks1; } sr_[SDEPTH];
#define SLOAD(i, k0) do { sr_[i].vs0 = ld8(&Vh[(long)((k0) + sr) * LDK + sc]); sr_[i].vs1 = ld8(&Vh[(long)((k0) + 32 + sr) * LDK + sc]); \
    sr_[i].ks0 = ld8(&Kh[(long)((k0) + sr) * LDK + sc]); sr_[i].ks1 = ld8(&Kh[(long)((k0) + 32 + sr) * LDK + sc]); } while (0)
#define SWRITE(b, i) do { *(bf16x8*)((char*)V_lds + (b) * SHM_V + vst0) = sr_[i].vs0;          \
    *(bf16x8*)((char*)V_lds + (b) * SHM_V + vst1) = sr_[i].vs1; int kc = sc * 2;               \
    *(bf16x8*)((char*)K_lds + (b) * SHM_K + KSWZ(sr, kc)) = sr_[i].ks0;                       \
    *(bf16x8*)((char*)K_lds + (b) * SHM_K + KSWZ(32 + sr, kc)) = sr_[i].ks1; } while (0)
#define SWAIT() do { if constexpr (SDEPTH == 2) asm volatile("s_waitcnt vmcnt(4)" ::: "memory"); else asm volatile("s_waitcnt vmcnt(0)" ::: "memory"); } while (0)
#define RESC(a) do { if (__any((a) < 1.f)) { if (hi == 0) al_l[r32] = (a); asm volatile("s_waitcnt lgkmcnt(0)" ::: "memory"); \
    _Pragma("unroll") for (int d = 0; d < 4; ++d) _Pragma("unroll") for (int r = 0; r < 16; ++r) o[d][r] *= al_l[crow(r, hi)]; } } while (0)
  f32x16 pA0, pA1, pB0, pB1; float mnA, mnB, alA, alB; bf16x8 pa0, pa1, pa2, pa3; const int NT = seq / KVBLK;
  constexpr int SE = 0, SO = SDEPTH - 1;
  SLOAD(SE, 0); asm volatile("s_waitcnt vmcnt(0)" ::: "memory"); SWRITE(0, SE); __syncthreads();
  qkt(pA0, pA1, K_lds, qr, r32, hi); partialSM(pA0, pA1, m_reg, mnA, alA);
  SLOAD(SO, KVBLK); if constexpr (SDEPTH == 2) { if (2 < NT) SLOAD(SE, 2 * KVBLK); }
  SWAIT(); SWRITE(1, SO); __syncthreads();
  for (int j = 1; j + 1 < NT; j += 2) {
    SBAR(); qkt(pB0, pB1, (bf16*)((char*)K_lds + SHM_K), qr, r32, hi);
    finishSM(pA0, pA1, alA, l_reg, pa0, pa1, pa2, pa3); SBAR();
    SLOAD(SO, (j + SDEPTH) * KVBLK); SBAR();
    pv_d0(o, vb0, pa0, pa1, pa2, pa3); partialSM(pB0, pB1, m_reg, mnB, alB);
    __syncthreads(); SWAIT(); SWRITE(0, SE);
    RESC(alB); __syncthreads();
    SBAR(); qkt(pA0, pA1, K_lds, qr, r32, hi);
    finishSM(pB0, pB1, alB, l_reg, pa0, pa1, pa2, pa3); SBAR();
    if (SDEPTH == 1 || j + 3 < NT) SLOAD(SE, (j + 1 + SDEPTH) * KVBLK); SBAR();
    pv_d0(o, vb0 + (int)SHM_V, pa0, pa1, pa2, pa3); partialSM(pA0, pA1, m_reg, mnA, alA);
    __syncthreads(); SWAIT(); SWRITE(1, SO);
    RESC(alA); __syncthreads();
  }
  SBAR(); qkt(pB0, pB1, (bf16*)((char*)K_lds + SHM_K), qr, r32, hi);
  finishSM(pA0, pA1, alA, l_reg, pa0, pa1, pa2, pa3); SBAR();
  pv_d0(o, vb0, pa0, pa1, pa2, pa3); partialSM(pB0, pB1, m_reg, mnB, alB);
  __syncthreads(); RESC(alB);
  finishSM(pB0, pB1, alB, l_reg, pa0, pa1, pa2, pa3); SBAR();
  pv_d0(o, vb0 + (int)SHM_V, pa0, pa1, pa2, pa3);
  if (hi == 0) li_l[r32] = l_reg; asm volatile("s_waitcnt lgkmcnt(0)" ::: "memory");
  { int tz = threadIdx.x; asm volatile("" : "+v"(tz)); wid = tz >> 6; lane = tz & 63; r32 = lane & 31; hi = lane >> 5; }
  float rli[16];
#pragma unroll
  for (int r = 0; r < 16; ++r) rli[r] = __builtin_amdgcn_rcpf(li_l[crow(r, hi)]);
  char* ost = lds + OST_OFF + wid * (32 * 272);
#pragma unroll
  for (int r = 0; r < 16; ++r) { const int orow = crow(r, hi);
#pragma unroll
    for (int d0 = 0; d0 < 4; ++d0) *(bf16*)(ost + orow * 272 + (d0 * 32 + r32) * 2) = __float2bfloat16(o[d0][r] * rli[r]); }
  asm volatile("s_waitcnt lgkmcnt(0)" ::: "memory");
  bf16* Ow = Ob + (long)(wid * QBLK) * LDO; const bf16* Zw = Zb + (long)(wid * QBLK) * LDQ;
#pragma unroll
  for (int hb = 0; hb < 2; ++hb) {
    u32x4 ov[4], zv[4];
#pragma unroll
    for (int i = 0; i < 4; ++i) { const int c = (hb * 4 + i) * 64 + lane, row = c >> 4, col = (c & 15) * 8;
      ov[i] = *reinterpret_cast<const u32x4*>(ost + row * 272 + col * 2); zv[i] = *reinterpret_cast<const u32x4*>(Zw + (long)row * LDQ + col); }
#pragma unroll
    for (int i = 0; i < 4; ++i) { const int c = (hb * 4 + i) * 64 + lane, row = c >> 4, col = (c & 15) * 8; u32x4 w;
#pragma unroll
      for (int e = 0; e < 4; ++e) { const unsigned a = ov[i][e], z = zv[i][e];
        w[e] = cvtpk(__uint_as_float(a << 16) * __uint_as_float(z << 16), __uint_as_float(a & 0xffff0000u) * __uint_as_float(z & 0xffff0000u)); }
      *reinterpret_cast<u32x4*>(Ow + (long)row * LDO + col) = w; }
  }
  __syncthreads();
#undef SLOAD
#undef SWRITE
#undef SWAIT
#undef RESC
}
}

constexpr int NWAVES = 8;
#ifndef MK_N_LAUNCHES
#define MK_N_LAUNCHES 1
#endif
constexpr int PH_PER_LAYER = 7, N_PHASES = 2 + DEPTH * PH_PER_LAYER;
constexpr size_t MiB = 1u << 20;
constexpr size_t WS_CTL = 0, CTL_ZERO_BYTES = 1 * MiB;
constexpr size_t WS_MOD = 1 * MiB;
constexpr size_t WS_ROPE = WS_MOD + MiB / 2;
constexpr size_t WS_WG = 3 * MiB;
constexpr size_t WS_WLRU = 4 * MiB;
constexpr size_t WS_WOUT = 12 * MiB;
constexpr size_t WS_WBR = 44 * MiB;
constexpr size_t WS_WIN = 140 * MiB;
constexpr size_t WS_X = 540 * MiB;
constexpr size_t WS_Y = 2112 * MiB;
constexpr size_t WS_H = 684 * MiB;
constexpr size_t WS_G2 = 1968 * MiB;
constexpr size_t WS_YB = 756 * MiB;
constexpr size_t WS_ACC = 864 * MiB;
constexpr size_t WS_GT = 936 * MiB;
constexpr size_t WS_MH = 938 * MiB;
constexpr size_t WS_P = 1082 * MiB;
constexpr size_t WS_LA = 1532 * MiB;
constexpr size_t WS_LB = 1676 * MiB;
constexpr size_t WS_X8 = WS_LB;
constexpr size_t WS_HL = 1820 * MiB;
constexpr size_t WS_GSC = 1964 * MiB;
constexpr size_t WS_END = 2328 * MiB;
constexpr int CW_BAR = 4096;
constexpr int RING_BYTES = 131072, LDS_BYTES = 147456, MISC_OFF = LDS_BYTES - 256;
static_assert(att::OST_END <= MISC_OFF, "LDS map");

#define GAS __attribute__((address_space(1)))
#define LAS __attribute__((address_space(3)))
typedef unsigned short bf16_t;
typedef unsigned v4u __attribute__((ext_vector_type(4)));
typedef unsigned v2u __attribute__((ext_vector_type(2)));
typedef float f32x4 __attribute__((ext_vector_type(4)));
#define LDS_WAIT() asm volatile("s_waitcnt lgkmcnt(0)" ::: "memory")
__device__ __forceinline__ unsigned f2bf(float f) { unsigned u = __builtin_bit_cast(unsigned, f); return (u + 0x7fffu + ((u >> 16) & 1u)) >> 16; }
__device__ __forceinline__ unsigned pk2(float lo, float hi) { unsigned r; asm("v_cvt_pk_bf16_f32 %0, %1, %2" : "=v"(r) : "v"(lo), "v"(hi)); return r; }
__device__ __forceinline__ float bf2f(bf16_t b) { return __uint_as_float((unsigned)b << 16); }
__device__ __forceinline__ float blo(unsigned w) { return __uint_as_float(w << 16); }
__device__ __forceinline__ float bhi(unsigned w) { return __uint_as_float(w & 0xffff0000u); }
__device__ __forceinline__ float lane_get(float v, int src) { return __builtin_bit_cast(float, __builtin_amdgcn_ds_bpermute(src << 2, __builtin_bit_cast(int, v))); }
__device__ __forceinline__ float lane_xor(float v, int mask, int lane) { return lane_get(v, lane ^ mask); }
__device__ __forceinline__ float lane_up(float v, int delta, int lane) { return lane_get(v, lane >= delta ? lane - delta : lane); }
__device__ __forceinline__ float wave_sum(float v, int lane) {
#pragma unroll
    for (int o = 1; o < 64; o <<= 1) v += lane_xor(v, o, lane);
    return v;
}
#define XB_TMO      128
#define XB_XCNT(j)  (256  + 64 * (j))
#define XB_XSUB(j)  (1280 + 64 * (j))
#define XB_XGEN(j)  (2304 + 64 * (j))
#define XB_TOP      3328
#define XB_TOPGEN   3392
#define XCD_BAR_WORDS 3456
#define XB_SPIN_CAP (1u << 18)

__device__ __forceinline__ unsigned xb_ld(unsigned* p)              { return __hip_atomic_load(p, __ATOMIC_RELAXED, __HIP_MEMORY_SCOPE_AGENT); }
__device__ __forceinline__ unsigned xb_add(unsigned* p, unsigned v) { return __hip_atomic_fetch_add(p, v, __ATOMIC_RELAXED, __HIP_MEMORY_SCOPE_AGENT); }
__device__ __forceinline__ unsigned xb_xcc_id() { return (unsigned)__builtin_amdgcn_s_getreg((3 << 11) | 20) & 0xFu; }
#define XB_SPIN(cond, bar) do { unsigned _sp = 0; while (cond) { __builtin_amdgcn_s_sleep(1); \
    if ((++_sp & 255u) == 0u) { if (xb_ld(&(bar)[XB_TMO])) break; if (_sp > XB_SPIN_CAP) { atomicAdd(&(bar)[XB_TMO], 1u); break; } } } } while (0)

struct XcdBarrier {
    unsigned* bar; unsigned x;
    volatile LAS unsigned* st;
};

__device__ __forceinline__ XcdBarrier xcd_barrier_post(unsigned* bar, volatile LAS unsigned* st) {
    XcdBarrier b; b.bar = bar; b.x = xb_xcc_id(); b.st = st;
    if (threadIdx.x == 0) (void)xb_add(&bar[XB_XCNT(b.x)], 1u);
    return b;
}
__device__ __forceinline__ void xcd_barrier_complete(unsigned* bar, unsigned x, unsigned& nloc, unsigned& nx) {
    const unsigned G = gridDim.x * gridDim.y * gridDim.z;
    unsigned sum, cnt, mine, sp = 0u;
    for (;;) {
        sum = 0u; cnt = 0u; mine = 0u;
#pragma unroll
        for (unsigned j = 0; j < 16; ++j) { const unsigned c = xb_ld(&bar[XB_XCNT(j)]); sum += c; cnt += (c > 0u) ? 1u : 0u; mine = (j == x) ? c : mine; }
        if (sum == G) break;
        __builtin_amdgcn_s_sleep(1);
        if ((++sp & 255u) == 0u) { if (xb_ld(&bar[XB_TMO])) break; if (sp > XB_SPIN_CAP) { atomicAdd(&bar[XB_TMO], 1u); break; } }
    }
    nloc = mine > 0u ? mine : 1u; nx = cnt > 0u ? cnt : 1u;
}

__device__ __forceinline__ void xcd_barrier(const XcdBarrier& b) {
    asm volatile("s_waitcnt vmcnt(0)" ::: "memory");
    __syncthreads();
    if (threadIdx.x == 0) {
        unsigned* bar = b.bar;
        __builtin_amdgcn_s_waitcnt(0);
        unsigned nloc = b.st[0], nx = b.st[1];
        if (nloc == 0u) { xcd_barrier_complete(bar, b.x, nloc, nx); b.st[0] = nloc; b.st[1] = nx; }
        const unsigned old = xb_add(&bar[XB_XSUB(b.x)], 1u);
        const unsigned gen = old / nloc;
        if (old + 1u == (gen + 1u) * nloc) {
            __builtin_amdgcn_fence(__ATOMIC_RELEASE, "agent");
            asm volatile("s_waitcnt vmcnt(0)" ::: "memory");
            const unsigned og = xb_add(&bar[XB_TOP], 1u);
            const unsigned tg = og / nx;
            if (og + 1u == (tg + 1u) * nx) xb_add(&bar[XB_TOPGEN], 1u);
            else XB_SPIN(xb_ld(&bar[XB_TOPGEN]) == tg, bar);
            __builtin_amdgcn_fence(__ATOMIC_ACQUIRE, "agent");
            xb_add(&bar[XB_XGEN(b.x)], 1u);
            asm volatile("s_waitcnt vmcnt(0)" ::: "memory");
        } else {
            XB_SPIN(xb_ld(&bar[XB_XGEN(b.x)]) == gen, bar);
            __builtin_amdgcn_fence(__ATOMIC_ACQUIRE, "agent");
            asm volatile("s_waitcnt vmcnt(0)" ::: "memory");
        }
    }
    __syncthreads();
}

struct Args { const float* in[22]; float* out; unsigned char* ws; int ph_lo, ph_hi; };
typedef const __attribute__((address_space(4))) Args CArgs;
#define KIN(k) ((const float*)ka->in[k])
#define WSF(off) ((float*)(ka->ws + (off)))
#define WSB(off) ((bf16_t*)(ka->ws + (off)))
#define KA() ({ CArgs* _k = ka0; asm volatile("" : "+s"(_k)); _k; })
__device__ __forceinline__ int tid_fresh() { int t = threadIdx.x; asm volatile("" : "+v"(t)); return t; }
struct Frame {
    LAS unsigned char* lds; char* ldsg;
    int tid, lane, wave, G, wg;
};

__device__ __forceinline__ void transpose_item(const float* W, int ldw, int col0, int k0, bf16_t* WT, int ldt, int drow0, LAS float* scr, int lane) {
    f32x4 v[8];
#pragma unroll
    for (int i = 0; i < 8; ++i) v[i] = __builtin_nontemporal_load((const f32x4*)(W + (size_t)(k0 + 8 * i + (lane >> 3)) * ldw + col0 + 4 * (lane & 7)));
#pragma unroll
    for (int i = 0; i < 8; ++i) { LAS float* d = scr + (8 * i + (lane >> 3)) * 33 + 4 * (lane & 7); d[0] = v[i][0]; d[1] = v[i][1]; d[2] = v[i][2]; d[3] = v[i][3]; }
    LDS_WAIT(); asm volatile("" ::: "memory");
    const int c = lane & 7;
#pragma unroll
    for (int j = 0; j < 4; ++j) { const int n = (lane >> 3) + 8 * j; const LAS float* s = scr + (8 * c) * 33 + n;
        v4u o; o.x = pk2(s[0 * 33], s[1 * 33]); o.y = pk2(s[2 * 33], s[3 * 33]); o.z = pk2(s[4 * 33], s[5 * 33]); o.w = pk2(s[6 * 33], s[7 * 33]);
        __builtin_nontemporal_store(o, (v4u*)(WT + (size_t)(drow0 + n) * ldt + k0 + 8 * c)); }
    LDS_WAIT(); asm volatile("" ::: "memory");
}
__device__ __forceinline__ void p_convert(Frame& F, CArgs* ka, int l, int wv, int nwv, int it0 = 0, int it1 = 1 << 30) {
    const int tid = tid_fresh(), lane = tid & 63, wave = __builtin_amdgcn_readfirstlane(tid >> 6);
    LAS float* scr = (LAS float*)(F.lds + wave * 8704);
    constexpr int I_IN = 32 * 800, I_G = 32, I_BR = 3 * 2048, I_OUT = 2048, I_LRU = 2 * 2 * 16 * 8, I_LAYER = I_IN + I_G + I_BR + I_OUT + I_LRU;
    if (it1 > I_LAYER) it1 = I_LAYER;
    for (int it = it0 + wv; it < it1; it += nwv) {
        int r = it;
        if (r < I_IN) { const int kb = r / 800, nb = r - kb * 800, n0 = nb * 32, sc = n0 < 14336 ? n0 : n0 + 32;
            transpose_item(KIN(8) + (size_t)l * DM * NIN, NIN, sc, kb * 64, WSB(WS_WIN) + (size_t)l * NP * DM, DM, n0, scr, lane); continue; }
        r -= I_IN;
        if (r < I_G) { transpose_item(KIN(8) + (size_t)l * DM * NIN, NIN, 14336, r * 64, WSB(WS_WG) + (size_t)l * 32 * DM, DM, 0, scr, lane); continue; }
        r -= I_G;
        if (r < I_BR) { const int z = r / 2048, q = r - z * 2048, kb = q / 64, nb = q - kb * 64;
            transpose_item(KIN(20) + ((size_t)l * 3 + z) * DM * DM, DM, nb * 32, kb * 64, WSB(WS_WBR) + ((size_t)l * 3 + z) * DM * DM, DM, nb * 32, scr, lane); continue; }
        r -= I_BR;
        if (r < I_OUT) { const int kb = r / 64, nb = r - kb * 64;
            transpose_item(KIN(21) + (size_t)l * DM * DM, DM, nb * 32, kb * 64, WSB(WS_WOUT) + (size_t)l * DM * DM, DM, nb * 32, scr, lane); continue; }
        r -= I_OUT;
        { const int q = r & 7, mt = r >> 3, blk = mt & 15, gate = (mt >> 4) & 1, dr = mt >> 5, kb = q >> 2, nb = q & 3;
          const float* src = (gate ? KIN(13) : KIN(11)) + (((size_t)l * 2 + dr) * 16 + blk) * 16384;
          transpose_item(src, 128, nb * 32, kb * 64, WSB(WS_WLRU) + ((((size_t)l * 2 + dr) * 2 + gate) * 16 + blk) * 16384, 128, nb * 32, scr, lane); }
    }
}
__device__ __forceinline__ void p_prologue(Frame& F, CArgs* ka) {
    const int tid = tid_fresh(), lane = tid & 63, wave = __builtin_amdgcn_readfirstlane(tid >> 6); (void)lane; (void)wave;
    for (int i = F.wg * 512 + tid; i < SEQ * 64; i += F.G * 512) { const int t = i >> 6, j = i & 63;
        const float inv = 1.0f / powf(10000.0f, (float)(j & 31) * (1.0f / 32.0f)); const float pos = (float)(j < 32 ? (t >> 6) : (t & 63)); const float ang = pos * inv;
        { const float rev = ang * 0.15915494309189535f; WSF(WS_ROPE)[i] = __builtin_amdgcn_cosf(rev); WSF(WS_ROPE)[SEQ * 64 + i] = __builtin_amdgcn_sinf(rev); } }
    __syncthreads();
    LAS float* sc = (LAS float*)(F.lds + 73728);
    LAS float* red = (LAS float*)(F.lds + 73728 + 5 * 2048 * 4);
    for (int i = tid; i < 5 * DM; i += 512) { const int bi = i >> 11, k = i & 2047; const float v = bi < 4 ? KIN(1)[bi * DM + k] : KIN(3)[k]; sc[i] = v / (1.f + expf(-v)); }
    __syncthreads();
    for (int it = F.wg; it < DEPTH * 192; it += F.G) { const int l = it / 192, j0 = (it - l * 192) * 32, cj = tid & 31, ks = tid >> 5;
        float a0 = 0.f, a1 = 0.f, a2 = 0.f, a3 = 0.f, a4 = 0.f; const float* w = KIN(4) + (size_t)l * DM * 3 * DM + j0 + cj;
        for (int k = ks * 128; k < ks * 128 + 128; ++k) { const float wv = w[(size_t)k * (3 * DM)]; a0 += sc[k] * wv; a1 += sc[2048 + k] * wv; a2 += sc[4096 + k] * wv; a3 += sc[6144 + k] * wv; a4 += sc[8192 + k] * wv; }
        red[(ks * 5 + 0) * 32 + cj] = a0; red[(ks * 5 + 1) * 32 + cj] = a1; red[(ks * 5 + 2) * 32 + cj] = a2; red[(ks * 5 + 3) * 32 + cj] = a3; red[(ks * 5 + 4) * 32 + cj] = a4;
        __syncthreads();
        if (tid < 160) { const int bi = tid >> 5, c = tid & 31; float s = KIN(5)[(size_t)l * 3 * DM + j0 + c];
            for (int q = 0; q < 16; ++q) s += red[(q * 5 + bi) * 32 + c];
            WSF(WS_MOD)[((size_t)l * 5 + bi) * (3 * DM) + j0 + c] = s; }
        __syncthreads();
    }
}

__device__ __forceinline__ void p_norm(Frame& F, CArgs* ka, int l, bool dry = false) {
    const int tid = tid_fresh(), lane = tid & 63, wave = __builtin_amdgcn_readfirstlane(tid >> 6); (void)lane; (void)wave;
    const int gw = F.wg * NWAVES + wave, NGW = F.G * NWAVES;
    for (int r = gw; r < MROWS; r += NGW) {
        const int b = r / TPB, t = r - b * TPB; const bool isctx = t >= SEQ; const int bi = isctx ? 4 : b;
        if (l == DEPTH && isctx) continue;
        f32x4 v[8];
        if (l == 0) { const float* src = isctx ? KIN(2) + ((size_t)b * CTXL + (t - SEQ)) * DM : KIN(0) + ((size_t)b * SEQ + t) * DM;
#pragma unroll
            for (int j = 0; j < 8; ++j) v[j] = *(const f32x4*)(src + j * 256 + lane * 4);
        } else {
            const float* xr = WSF(WS_X) + (size_t)r * DM; f32x4 y[8]; float ss = 0.f;
#if Y_BF16
            const bf16_t* yr = WSB(WS_Y) + (size_t)r * DM;
#define LDY(p) ({ const v2u w_ = *(const v2u*)(p); (f32x4){blo(w_.x), bhi(w_.x), blo(w_.y), bhi(w_.y)}; })
#else
            const float* yr = WSF(WS_Y) + (size_t)r * DM;
#define LDY(p) (*(const f32x4*)(p))
#endif
#pragma unroll
            for (int j = 0; j < 8; ++j) { y[j] = LDY(yr + j * 256 + lane * 4);
                if (SPLIT_CTX && isctx && F.G == 256) y[j] = y[j] + LDY(yr + (size_t)MROWS * DM + j * 256 + lane * 4) + LDY(yr + 2 * (size_t)MROWS * DM + j * 256 + lane * 4);
                ss += y[j].x * y[j].x + y[j].y * y[j].y + y[j].z * y[j].z + y[j].w * y[j].w; }
            const float rs = rsqrtf(wave_sum(ss, lane) * (1.f / DM) + EPS);
            const float* gate = WSF(WS_MOD) + ((size_t)(l - 1) * 5 + bi) * (3 * DM) + 2 * DM; const float* npost = KIN(7) + (size_t)(l - 1) * DM;
#pragma unroll
            for (int j = 0; j < 8; ++j) { const int c = j * 256 + lane * 4; const f32x4 g = *(const f32x4*)(gate + c), w = *(const f32x4*)(npost + c), xv = *(const f32x4*)(xr + c);
                v[j] = xv + g * (y[j] * rs * w); }
        }
        if (l == DEPTH) { float* o = (ka->out) + ((size_t)b * SEQ + t) * DM;
#pragma unroll
            for (int j = 0; j < 8; ++j) *(f32x4*)(o + j * 256 + lane * 4) = v[j];
            continue; }
        float* xo = (dry ? WSF(WS_ACC) : WSF(WS_X)) + (size_t)r * DM; float ss = 0.f;
#pragma unroll
        for (int j = 0; j < 8; ++j) { *(f32x4*)(xo + j * 256 + lane * 4) = v[j]; ss += v[j].x * v[j].x + v[j].y * v[j].y + v[j].z * v[j].z + v[j].w * v[j].w; }
        const float rs = rsqrtf(wave_sum(ss, lane) * (1.f / DM) + EPS);
        const float* shift = WSF(WS_MOD) + ((size_t)l * 5 + bi) * (3 * DM); const float* scale = shift + DM; const float* npre = KIN(6) + (size_t)l * DM;
        bf16_t* ho = (dry ? WSB(WS_G2) : WSB(WS_H)) + (size_t)r * DM;
#pragma unroll
        for (int j = 0; j < 8; ++j) { const int c = j * 256 + lane * 4; const f32x4 sh = *(const f32x4*)(shift + c), scv = *(const f32x4*)(scale + c), w = *(const f32x4*)(npre + c);
            const f32x4 h = v[j] * rs * w * (scv + 1.f) + sh; v2u o; o.x = pk2(h.x, h.y); o.y = pk2(h.z, h.w); *(v2u*)(ho + c) = o; }
    }
}

__device__ __forceinline__ void p_gates(Frame& F, CArgs* ka, int l, int wk0, int nwk) {
    const int tid = tid_fresh(), lane = tid & 63, wave = __builtin_amdgcn_readfirstlane(tid >> 6), c16 = lane & 15, q = lane >> 4;
    typedef short bf16x8 __attribute__((ext_vector_type(8)));
    LAS float* GL = (LAS float*)F.lds;
    const bf16_t* H = WSB(WS_H); const bf16_t* WG = WSB(WS_WG) + (size_t)l * 32 * DM; float* GT = WSF(WS_GT); f32x4* GSC = (f32x4*)WSF(WS_GSC);
    for (int task = wk0; task < NBATCH * 36; task += nwk) { const int b = task / 36, chunk = task - b * 36; const size_t row0 = (size_t)b * TPB + chunk * 64;
        __syncthreads();
        { const int rb = wave & 3, kh = wave >> 2; f32x4 a0 = {0.f, 0.f, 0.f, 0.f}, a1 = {0.f, 0.f, 0.f, 0.f};
          const bf16_t* hp = H + (row0 + rb * 16 + c16) * DM + kh * 1024 + q * 8; const bf16_t* w0 = WG + (size_t)c16 * DM + kh * 1024 + q * 8; const bf16_t* w1 = w0 + 16 * DM;
#pragma unroll 8
          for (int ks = 0; ks < 32; ++ks) { const bf16x8 av = *(const bf16x8*)(hp + ks * 32), b0 = *(const bf16x8*)(w0 + ks * 32), b1 = *(const bf16x8*)(w1 + ks * 32);
              a0 = __builtin_amdgcn_mfma_f32_16x16x32_bf16(av, b0, a0, 0, 0, 0); a1 = __builtin_amdgcn_mfma_f32_16x16x32_bf16(av, b1, a1, 0, 0, 0); }
#pragma unroll
          for (int j = 0; j < 4; ++j) { GL[(kh * 64 + rb * 16 + q * 4 + j) * 33 + c16] = a0[j]; GL[(kh * 64 + rb * 16 + q * 4 + j) * 33 + 16 + c16] = a1[j]; } }
        __syncthreads();
#pragma unroll
        for (int i = 0; i < 4; ++i) { const int idx = tid + 512 * i, r = idx >> 5, c = idx & 31; float s = GL[r * 33 + c] + GL[(64 + r) * 33 + c] + KIN(16)[l * 32 + c];
            if ((c >> 3) & 1) s = fminf(s, 0.f) - __logf(1.f + __expf(-fabsf(s)));
            GL[r * 33 + c] = s; GT[(row0 + r) * 32 + c] = s; }
        __syncthreads();
#pragma unroll
        for (int pi = 0; pi < 2; ++pi) { const int p = wave * 2 + pi, dir = p >> 3, h = p & 7, rl = dir ? 63 - lane : lane;
            const float gi = GL[rl * 33 + dir * 16 + h]; float bc = GL[rl * 33 + dir * 16 + 8 + h];
#pragma unroll
            for (int o = 1; o < 64; o <<= 1) { const float v = lane_up(bc, o, lane); if (lane >= o) bc += v; }
            const float g = gi - bc; float pm = g;
#pragma unroll
            for (int o = 1; o < 64; o <<= 1) { const float v = lane_up(pm, o, lane); if (lane >= o) pm = fmaxf(pm, v); }
            GSC[((((size_t)b * 2 + dir) * 8 + h) * 36 + chunk) * 64 + lane] = (f32x4){bc, g, pm, 0.f}; }
    }
    __syncthreads();
}
__device__ __forceinline__ void p_knorm(Frame& F, CArgs* ka, int l, bool dry = false) {
    const int tid = tid_fresh(), lane = tid & 63, wave = __builtin_amdgcn_readfirstlane(tid >> 6);
    const int gw = F.wg * NWAVES + wave, NGW = F.G * NWAVES; const int sub = lane & 15;
    f32x4 kn0 = *(const f32x4*)(KIN(19) + l * 128 + sub * 8), kn1 = *(const f32x4*)(KIN(19) + l * 128 + sub * 8 + 4);
    for (int r = gw; r < MROWS; r += NGW) { const int b = r / TPB, t = r - b * TPB;
        bf16_t* kp = WSB(WS_P) + (size_t)r * NP + C_AK + lane * 8; const v4u raw = *(const v4u*)kp; float v[8];
#pragma unroll
        for (int e = 0; e < 4; ++e) { v[2 * e] = blo(raw[e]); v[2 * e + 1] = bhi(raw[e]); }
        float ss = 0.f;
#pragma unroll
        for (int e = 0; e < 8; ++e) ss += v[e] * v[e];
        ss += lane_xor(ss, 1, lane); ss += lane_xor(ss, 2, lane); ss += lane_xor(ss, 4, lane); ss += lane_xor(ss, 8, lane);
        const float rs = rsqrtf(ss * (1.f / 128.f) + EPS);
#pragma unroll
        for (int e = 0; e < 8; ++e) v[e] *= rs * (e < 4 ? kn0[e & 3] : kn1[e & 3]);
        if (t < SEQ) { const int i0 = (sub & 7) * 8; const float* cp = WSF(WS_ROPE) + (size_t)t * 64 + i0; const float* sp = cp + SEQ * 64;
            const f32x4 c0 = *(const f32x4*)cp, c1 = *(const f32x4*)(cp + 4), s0 = *(const f32x4*)sp, s1 = *(const f32x4*)(sp + 4); const bool upper = (sub & 8) != 0;
#pragma unroll
            for (int e = 0; e < 8; ++e) { const float o = lane_xor(v[e], 8, lane), c = e < 4 ? c0[e & 3] : c1[e & 3], sn = e < 4 ? s0[e & 3] : s1[e & 3];
                v[e] = upper ? v[e] * c + o * sn : v[e] * c - o * sn; } }
        v4u ov; ov.x = pk2(v[0], v[1]); ov.y = pk2(v[2], v[3]); ov.z = pk2(v[4], v[5]); ov.w = pk2(v[6], v[7]);
        if (dry) *(v4u*)(WSB(WS_ACC) + (size_t)r * 512 + lane * 8) = ov; else *(v4u*)kp = ov; }
}

__device__ __forceinline__ void p_lru_gates_naive(Frame& F, CArgs* ka, int l) {
    const int tid = tid_fresh(); (void)tid;
    LAS float* xs = (LAS float*)F.lds;
    for (int it = F.wg; it < (MROWS / 16) * 16; it += F.G) { const int rt = it >> 4, blk = it & 15;
        __syncthreads();
#pragma unroll
        for (int j = 0; j < 4; ++j) { const int idx = tid + 512 * j, rr = idx >> 7, c = idx & 127, r = rt * 16 + rr, b = r / TPB, t = r - b * TPB, ch = blk * 128 + c;
            const int lo = t < SEQ ? 0 : SEQ, hi = t < SEQ ? SEQ : TPB; float a = KIN(10)[l * DM + ch];
#pragma unroll
            for (int k = 0; k < 4; ++k) { const int tt = t + k - 2; if (tt >= lo && tt < hi) a += KIN(9)[((size_t)l * 4 + k) * DM + ch] * bf2f(WSB(WS_P)[((size_t)b * TPB + tt) * NP + C_LX + ch]); }
            xs[rr * 128 + c] = a; }
        __syncthreads();
        const int co = tid & 127, r0 = tid >> 7, ch = blk * 128 + co;
#pragma unroll 1
        for (int dr = 0; dr < 2; ++dr) {
            const float* wr = KIN(11) + (((size_t)l * 2 + dr) * 16 + blk) * 16384 + co; const float* wi = KIN(13) + (((size_t)l * 2 + dr) * 16 + blk) * 16384 + co;
            float ar[4], ai[4];
#pragma unroll
            for (int j = 0; j < 4; ++j) { ar[j] = KIN(12)[((size_t)l * 2 + dr) * DM + ch]; ai[j] = KIN(14)[((size_t)l * 2 + dr) * DM + ch]; }
            for (int c = 0; c < 128; ++c) { const float w0 = wr[c * 128], w1 = wi[c * 128];
#pragma unroll
                for (int j = 0; j < 4; ++j) { const float xv = xs[(r0 + 4 * j) * 128 + c]; ar[j] += xv * w0; ai[j] += xv * w1; } }
            const float lam = KIN(15)[((size_t)l * 2 + dr) * DM + ch], sp = log1pf(expf(-lam));
#pragma unroll
            for (int j = 0; j < 4; ++j) { const int r = rt * 16 + r0 + 4 * j; const float rg = 1.f / (1.f + expf(-ar[j])), ig = 1.f / (1.f + expf(-ai[j]));
                const float log_a = -8.f * rg * sp, a = expf(log_a), mult = sqrtf(-expm1f(2.f * log_a));
                WSF(WS_LA)[((size_t)dr * MROWS + r) * DM + ch] = a; WSF(WS_LB)[((size_t)dr * MROWS + r) * DM + ch] = mult * ig * xs[(r0 + 4 * j) * 128 + co]; }
        }
    }
    __syncthreads();
}

__device__ __forceinline__ void p_attention(Frame& F, CArgs* ka, int l, bool need_ctx) {
    using att::bf16;
    const int n_lat = NBATCH * 16 * 8, n_all = n_lat + (need_ctx ? NBATCH * 16 : 0);
    for (int u = F.wg; u < n_all; u += F.G) {
        int b, h, q0, k0, seq; const float *cs = nullptr, *sn = nullptr;
        if (u < n_lat) { const int qb = u & 7; h = (u >> 3) & 15; b = u >> 7; q0 = qb * 256; k0 = 0; seq = TPB; cs = WSF(WS_ROPE) + (size_t)q0 * 64; sn = WSF(WS_ROPE) + (size_t)SEQ * 64 + (size_t)q0 * 64; }
        else { const int v = u - n_lat; h = v & 15; b = v >> 4; q0 = SEQ; k0 = SEQ; seq = CTXL; }
        const size_t rq = (size_t)b * TPB + q0, rk = (size_t)b * TPB + k0; const int kvh = h >> 2;
        att::attn_unit((const bf16*)(WSB(WS_P) + rq * NP + C_AQ + h * 128), (const bf16*)(WSB(WS_P) + rk * NP + C_AK + kvh * 128), (const bf16*)(WSB(WS_P) + rk * NP + C_AV + kvh * 128),
                       (const bf16*)(WSB(WS_P) + rq * NP + C_AZ + h * 128), (bf16*)(WSB(WS_YB) + ((size_t)2 * MROWS + rq) * DM + h * 128), seq, F.ldsg, KIN(18) + l * 128, cs, sn);
    }
}
__device__ __forceinline__ int seq_row(int s, int dir) { return s < CTXL ? SEQ + (dir ? CTXL - 1 - s : s) : (dir ? SEQ - 1 - (s - CTXL) : s - CTXL); }
__device__ __forceinline__ void p_mlstm_naive(Frame& F, CArgs* ka, int l) {
    const int tid = tid_fresh(), lane = tid & 63, wave = __builtin_amdgcn_readfirstlane(tid >> 6); (void)lane; (void)wave;
    LAS float* sq = (LAS float*)F.lds; LAS float* sk = sq + 256; LAS float* rn = sk + 256; LAS float* rd = rn + 512;
    const int e = tid & 63, dg = tid >> 6;
    for (int u = F.wg; u < 256; u += F.G) { const int es = u & 3, dir = (u >> 2) & 1, h = (u >> 3) & 7, b = u >> 6;
        float C[32], n[32];
#pragma unroll
        for (int i = 0; i < 32; ++i) { C[i] = 0.f; n[i] = 0.f; }
        float m = -1e30f;
        const int lcol = tid < 64 ? C_MQ + h * 256 + tid * 4 : C_MK + h * 256 + (tid - 64) * 4, vcol = C_MV + h * 256 + es * 64 + e;
        v2u pqk = {0u, 0u}; bf16_t pv; float gi, gf;
        { const size_t r = (size_t)b * TPB + seq_row(0, dir); if (tid < 128) pqk = *(const v2u*)(WSB(WS_P) + r * NP + lcol); pv = WSB(WS_P)[r * NP + vcol]; gi = WSF(WS_GT)[r * 32 + dir * 16 + h]; gf = WSF(WS_GT)[r * 32 + dir * 16 + 8 + h]; }
        __syncthreads();
        for (int s = 0; s < TPB; ++s) {
            const size_t r = (size_t)b * TPB + seq_row(s, dir);
            if (tid < 128) { LAS float* d = (tid < 64 ? sq : sk) + (tid & 63) * 4; d[0] = blo(pqk.x); d[1] = bhi(pqk.x); d[2] = blo(pqk.y); d[3] = bhi(pqk.y); }
            const float vv = bf2f(pv), iv = gi, lf = gf;
            __syncthreads();
            if (s + 1 < TPB) { const size_t r2 = (size_t)b * TPB + seq_row(s + 1, dir); if (tid < 128) pqk = *(const v2u*)(WSB(WS_P) + r2 * NP + lcol); pv = WSB(WS_P)[r2 * NP + vcol]; gi = WSF(WS_GT)[r2 * 32 + dir * 16 + h]; gf = WSF(WS_GT)[r2 * 32 + dir * 16 + 8 + h]; }
            const float mnew = fmaxf(lf + m, iv), fw = expf(lf + m - mnew), iw = expf(iv - mnew); m = mnew;
            float pn = 0.f, pd = 0.f;
#pragma unroll
            for (int dd = 0; dd < 32; ++dd) { const float kd = sk[dg * 32 + dd], qd = sq[dg * 32 + dd]; C[dd] = fw * C[dd] + iw * kd * vv; n[dd] = fw * n[dd] + iw * kd; pn += qd * C[dd]; pd += qd * n[dd]; }
            rn[dg * 64 + e] = pn; rd[dg * 64 + e] = pd;
            __syncthreads();
            if (dg == 0) { float num = 0.f, den = 0.f;
#pragma unroll
                for (int g = 0; g < 8; ++g) { num += rn[g * 64 + e]; den += rd[g * 64 + e]; }
                WSB(WS_MH)[((size_t)dir * MROWS + r) * DM + h * 256 + es * 64 + e] = (bf16_t)f2bf(num / fmaxf(fabsf(den), expf(-m))); }
        }
        __syncthreads();
    }
}
__device__ __forceinline__ void p_lru_scan_naive(Frame& F, CArgs* ka) {
    const int tid = tid_fresh(), lane = tid & 63, wave = __builtin_amdgcn_readfirstlane(tid >> 6); (void)lane; (void)wave;
    if (wave != 0) return;
    for (int cw = F.wg; cw < 256; cw += F.G) { const int combo = cw * 64 + lane, b = combo >> 12, dir = (combo >> 11) & 1, ch = combo & 2047;
        const float* A = WSF(WS_LA) + (size_t)dir * MROWS * DM + ch; const float* Bx = WSF(WS_LB) + (size_t)dir * MROWS * DM + ch; float* Ho = WSF(WS_HL) + (size_t)dir * MROWS * DM + ch; float h = 0.f;
#pragma unroll 8
        for (int s = 0; s < TPB; ++s) { const size_t r = (size_t)b * TPB + seq_row(s, dir); h = A[r * DM] * h + Bx[r * DM]; Ho[r * DM] = h; }
    }
}

__device__ __forceinline__ void p_mlout(Frame& F, CArgs* ka, int l, bool need_ctx) {
    const int tid = tid_fresh(), lane = tid & 63, wave = __builtin_amdgcn_readfirstlane(tid >> 6); (void)lane; (void)wave;
    const int gw = F.wg * NWAVES + wave, NGW = F.G * NWAVES, nrow = need_ctx ? MROWS : NBATCH * SEQ;
    for (int ri = gw; ri < nrow; ri += NGW) { const int r = need_ctx ? ri : (ri >> 11) * TPB + (ri & 2047);
        const bf16_t* pr = WSB(WS_P) + (size_t)r * NP;
#pragma unroll 2
        for (int h = 0; h < 8; ++h) { const int col = h * 256 + lane * 4;
            const v2u ma = *(const v2u*)(WSB(WS_MH) + (size_t)r * DM + col), mb = *(const v2u*)(WSB(WS_MH) + ((size_t)MROWS + r) * DM + col);
            const f32x4 a = {blo(ma.x), bhi(ma.x), blo(ma.y), bhi(ma.y)}, bb = {blo(mb.x), bhi(mb.x), blo(mb.y), bhi(mb.y)};
            const v2u ow = *(const v2u*)(pr + C_MO + col), zw = *(const v2u*)(pr + C_MZ + col); const f32x4 g = *(const f32x4*)(KIN(17) + (size_t)l * DM + col);
            f32x4 v = a + bb; v.x *= blo(ow.x); v.y *= bhi(ow.x); v.z *= blo(ow.y); v.w *= bhi(ow.y);
            const float rs = rsqrtf(wave_sum(v.x * v.x + v.y * v.y + v.z * v.z + v.w * v.w, lane) * (1.f / 256.f) + EPS);
            v2u o; o.x = pk2(v.x * rs * g.x * blo(zw.x), v.y * rs * g.y * bhi(zw.x)); o.y = pk2(v.z * rs * g.z * blo(zw.y), v.w * rs * g.w * bhi(zw.y));
            *(v2u*)(WSB(WS_YB) + ((size_t)MROWS + r) * DM + col) = o; }
    }
}

__device__ __forceinline__ void p_lru_combine_naive(Frame& F, CArgs* ka) {
    const int tid = tid_fresh(), lane = tid & 63, wave = __builtin_amdgcn_readfirstlane(tid >> 6);
    const int gw = F.wg * NWAVES + wave, NGW = F.G * NWAVES;
    for (int r = gw; r < MROWS; r += NGW) {
        const bf16_t* pr = WSB(WS_P) + (size_t)r * NP;
#pragma unroll 2
        for (int j = 0; j < 8; ++j) { const int col = j * 256 + lane * 4;
            const f32x4 a = *(const f32x4*)(WSF(WS_HL) + (size_t)r * DM + col), bb = *(const f32x4*)(WSF(WS_HL) + ((size_t)MROWS + r) * DM + col); const v2u zw = *(const v2u*)(pr + C_LZ + col);
            const f32x4 v = a + bb; v2u o; o.x = pk2(v.x * blo(zw.x), v.y * bhi(zw.x)); o.y = pk2(v.z * blo(zw.y), v.w * bhi(zw.y));
            *(v2u*)(WSB(WS_YB) + (size_t)r * DM + col) = o; }
    }
}
#ifndef USE_NAIVE_ML
#define USE_NAIVE_ML 0
#endif
#ifndef USE_NAIVE_LRU
#define USE_NAIVE_LRU 0
#endif

namespace ml {
typedef short bf16x8 __attribute__((ext_vector_type(8)));
constexpr int KS_OFF = 0, KS_PITCH = 528;
constexpr int KT_OFF = KS_OFF + 64 * KS_PITCH, KT_PITCH = 144;
constexpr int VT_OFF = KT_OFF + 256 * KT_PITCH, VT_PITCH = 144;
constexpr int ST_OFF = VT_OFF + 80 * VT_PITCH, ST_PITCH = 144;
constexpr int CT_OFF = ST_OFF + 64 * ST_PITCH, CT_PITCH = 528;
constexpr int TAB_OFF = CT_OFF + 80 * CT_PITCH;
constexpr int END_OFF = TAB_OFF + 1024;
static_assert(END_OFF <= MISC_OFF, "mLSTM LDS map");
#define ML_MFMA(a, b, c) __builtin_amdgcn_mfma_f32_16x16x32_bf16((a), (b), (c), 0, 0, 0)
__device__ __forceinline__ int chunk_of(int k, int dir) { return k < 4 ? (dir ? 35 - k : 32 + k) : (dir ? 31 - (k - 4) : k - 4); }

__device__ __forceinline__ void mlstm_unit(Frame& F, CArgs* ka, int u, bool need_ctx) {
    const int tid = tid_fresh(), lane = tid & 63, w = __builtin_amdgcn_readfirstlane(tid >> 6), c16 = lane & 15, q = lane >> 4;
    const int es = u & 3, dir = (u >> 2) & 1, h = (u >> 3) & 7, b = u >> 6;
    LAS unsigned char* L = F.lds;
    const bf16_t* P = WSB(WS_P); bf16_t* MH = WSB(WS_MH) + (size_t)dir * MROWS * DM;
    const f32x4* GSC = (const f32x4*)WSF(WS_GSC) + (((size_t)b * 2 + dir) * 8 + h) * 36 * 64;
    LAS float* TABg = (LAS float*)(L + TAB_OFF); LAS float* TABmm = TABg + 64; LAS float* TABbc = TABg + 128;
    __syncthreads();
    { unsigned z0 = 0u; asm volatile("" : "+v"(z0)); const v4u zz = {z0, z0, z0, z0};
      for (int i = tid; i < 80 * CT_PITCH / 16; i += 512) *(LAS v4u*)(L + CT_OFF + i * 16) = zz; }
    for (int i = tid; i < 16 * 64; i += 512) { const int e = 64 + (i >> 6), s = i & 63; *(LAS bf16_t*)(L + VT_OFF + e * VT_PITCH + s * 2) = (bf16_t)(e == 64 ? 0x3F80 : 0); }
    f32x4 C[2][5];
#pragma unroll
    for (int a = 0; a < 2; ++a)
#pragma unroll
        for (int e = 0; e < 5; ++e) C[a][e] = (f32x4){0.f, 0.f, 0.f, 0.f};
    float m = -1e30f;
    const int tn = w & 3, wh = w >> 2;
    v4u kraw[4], vraw; bf16x8 Qf[8]; float gsc0, gsc1, gsc2;
#define ML_ROW(base, j) ((size_t)(base) + (dir ? 63 - (j) : (j)))
#define ML_LOAD_KVG(k) do { const int _c = chunk_of((k), dir), _base = b * TPB + _c * 64; const bf16_t* _rp = P + ML_ROW(_base, lane) * NP; \
        _Pragma("unroll") for (int i = 0; i < 4; ++i) kraw[i] = *(const v4u*)(_rp + C_MK + h * 256 + (w * 4 + i) * 8); \
        vraw = *(const v4u*)(_rp + C_MV + h * 256 + es * 64 + w * 8); { const float* _gp = (const float*)(GSC + _c * 64 + lane); gsc0 = _gp[0]; gsc1 = _gp[1]; gsc2 = _gp[2]; } } while (0)
#define ML_LOAD_Q(k) do { const int _base = b * TPB + chunk_of((k), dir) * 64; const bf16_t* _qp = P + ML_ROW(_base, tn * 16 + c16) * NP + C_MQ + h * 256 + q * 8; \
        _Pragma("unroll") for (int ks = 0; ks < 8; ++ks) Qf[ks] = *(const bf16x8*)(_qp + ks * 32); } while (0)
    ML_LOAD_KVG(0); ML_LOAD_Q(0);
    float bL = 0.f, mm63 = 0.f;
#pragma unroll 1
    for (int k = 0; k < 36; ++k) {
        const int base = b * TPB + chunk_of(k, dir) * 64; const bool do_out = need_ctx || k >= 4;
        if (k > 0) {
#pragma unroll
            for (int di = 0; di < 2; ++di)
#pragma unroll
                for (int en = 0; en < 5; ++en) { const f32x4 c = C[di][en]; v2u o; o.x = pk2(c[0], c[1]); o.y = pk2(c[2], c[3]);
                    *(LAS v2u*)(L + CT_OFF + (en * 16 + c16) * CT_PITCH + ((2 * w + di) * 16 + q * 4) * 2) = o; }
            m = bL + mm63; }
        const float bc = gsc0, g = gsc1, mm = fmaxf(gsc2, m), wk = __expf(g - lane_get(mm, 63));
        bL = lane_get(bc, 63); mm63 = lane_get(mm, 63);
        if (w == 0) { TABg[lane] = g; TABmm[lane] = mm; TABbc[lane] = bc; }
#pragma unroll
        for (int i = 0; i < 4; ++i) { *(LAS v4u*)(L + KS_OFF + lane * KS_PITCH + (w * 4 + i) * 16) = kraw[i];
#pragma unroll
            for (int e = 0; e < 4; ++e) { const unsigned x = kraw[i][e]; const unsigned pk = pk2(blo(x) * wk, bhi(x) * wk);
                *(LAS bf16_t*)(L + KT_OFF + ((w * 4 + i) * 8 + 2 * e) * KT_PITCH + lane * 2) = (bf16_t)(pk & 0xffffu); *(LAS bf16_t*)(L + KT_OFF + ((w * 4 + i) * 8 + 2 * e + 1) * KT_PITCH + lane * 2) = (bf16_t)(pk >> 16); } }
#pragma unroll
        for (int e = 0; e < 4; ++e) { const unsigned x = vraw[e];
            *(LAS bf16_t*)(L + VT_OFF + (w * 8 + 2 * e) * VT_PITCH + lane * 2) = (bf16_t)(x & 0xffffu); *(LAS bf16_t*)(L + VT_OFF + (w * 8 + 2 * e + 1) * VT_PITCH + lane * 2) = (bf16_t)(x >> 16); }
        __syncthreads();
        const int t = tn * 16 + c16; const int kn = k + 1 < 36 ? k + 1 : 35;
        if (do_out) {
            const float mmt = TABmm[t];
#pragma unroll
            for (int si = 0; si < 2; ++si) { const int sm = wh * 2 + si; v2u o = {0u, 0u};
                if (sm <= tn) { f32x4 acc = {0.f, 0.f, 0.f, 0.f};
#pragma unroll
                    for (int ks = 0; ks < 8; ++ks) { const bf16x8 a = *(const LAS bf16x8*)(L + KS_OFF + (sm * 16 + c16) * KS_PITCH + (ks * 32 + q * 8) * 2); acc = ML_MFMA(a, Qf[ks], acc); }
                    float v[4];
#pragma unroll
                    for (int j = 0; j < 4; ++j) { const int s = sm * 16 + q * 4 + j; v[j] = s <= t ? acc[j] * __expf(TABg[s] - mmt) : 0.f; }
                    o.x = pk2(v[0], v[1]); o.y = pk2(v[2], v[3]); }
                *(LAS v2u*)(L + ST_OFF + t * ST_PITCH + (sm * 16 + q * 4) * 2) = o; }
        }
        ML_LOAD_KVG(kn);
        __syncthreads();
        f32x4 num0 = {0.f, 0.f, 0.f, 0.f}, num1 = {0.f, 0.f, 0.f, 0.f}; float den = 1.f;
        if (do_out) {
            const float wi = __expf(m - TABmm[t]);
            bf16x8 sb[2];
#pragma unroll
            for (int ks = 0; ks < 2; ++ks) sb[ks] = *(const LAS bf16x8*)(L + ST_OFF + t * ST_PITCH + (ks * 32 + q * 8) * 2);
#pragma unroll
            for (int ei = 0; ei < 3; ++ei) { const int em = ei < 2 ? wh * 2 + ei : 4;
                f32x4 a1 = {0.f, 0.f, 0.f, 0.f}, a2 = {0.f, 0.f, 0.f, 0.f};
#pragma unroll
                for (int ks = 0; ks < 2; ++ks) { const bf16x8 a = *(const LAS bf16x8*)(L + VT_OFF + (em * 16 + c16) * VT_PITCH + (ks * 32 + q * 8) * 2); a1 = ML_MFMA(a, sb[ks], a1); }
#pragma unroll
                for (int ks = 0; ks < 8; ++ks) { const bf16x8 a = *(const LAS bf16x8*)(L + CT_OFF + (em * 16 + c16) * CT_PITCH + (ks * 32 + q * 8) * 2); a2 = ML_MFMA(a, Qf[ks], a2); }
                const f32x4 nv = a1 + a2 * wi;
                if (ei == 0) num0 = nv; else if (ei == 1) num1 = nv;
                else den = fmaxf(fabsf(lane_get(nv[0], c16)), __expf(-(TABbc[t] + TABmm[t]))); }
        }
        ML_LOAD_Q(kn);
        if (do_out) { const float rd = 1.f / den; bf16_t* op = MH + ML_ROW(base, t) * DM + h * 256 + es * 64 + q * 4; const f32x4 o0 = num0 * rd, o1 = num1 * rd;
            v2u w0, w1; w0.x = pk2(o0[0], o0[1]); w0.y = pk2(o0[2], o0[3]); w1.x = pk2(o1[0], o1[1]); w1.y = pk2(o1[2], o1[3]);
            *(v2u*)(op + (wh * 2) * 16) = w0; *(v2u*)(op + (wh * 2 + 1) * 16) = w1; }
        { const float decay = __expf(m - mm63);
          bf16x8 vb[5][2];
#pragma unroll
          for (int en = 0; en < 5; ++en)
#pragma unroll
              for (int ks = 0; ks < 2; ++ks) vb[en][ks] = *(const LAS bf16x8*)(L + VT_OFF + (en * 16 + c16) * VT_PITCH + (ks * 32 + q * 8) * 2);
#pragma unroll
          for (int di = 0; di < 2; ++di) {
            bf16x8 a[2];
#pragma unroll
            for (int ks = 0; ks < 2; ++ks) a[ks] = *(const LAS bf16x8*)(L + KT_OFF + ((2 * w + di) * 16 + c16) * KT_PITCH + (ks * 32 + q * 8) * 2);
#pragma unroll
            for (int en = 0; en < 5; ++en) { f32x4 c = C[di][en] * decay;
#pragma unroll
                for (int ks = 0; ks < 2; ++ks) c = ML_MFMA(a[ks], vb[en][ks], c);
                C[di][en] = c; } } }
        __syncthreads();
    }
#undef ML_ROW
#undef ML_LOAD_KVG
#undef ML_LOAD_Q
}
constexpr int ST2_OFF = TAB_OFF + 1024, TAB2_OFF = ST2_OFF + 64 * ST_PITCH, END2_OFF = TAB2_OFF + 1024;
static_assert(END2_OFF <= MISC_OFF, "mLSTM LDS map (pipelined)");
template <int VAR> __device__ __forceinline__ void mlstm_unit_pipe(Frame& F, CArgs* ka, int u, bool need_ctx) {
    const int tid = tid_fresh(), lane = tid & 63, w = __builtin_amdgcn_readfirstlane(tid >> 6), c16 = lane & 15, q = lane >> 4;
    const int es = u & 3, dir = (u >> 2) & 1, h = (u >> 3) & 7, b = u >> 6;
    LAS unsigned char* L = F.lds;
    const bf16_t* X8 = WSB(WS_X8); constexpr size_t X8_SEC = (size_t)MROWS * DM; bf16_t* MH = (VAR ? WSB(WS_ACC) : WSB(WS_MH)) + (size_t)dir * MROWS * DM;
    const f32x4* GSC = (const f32x4*)WSF(WS_GSC) + (((size_t)b * 2 + dir) * 8 + h) * 36 * 64;
    __syncthreads();
    { unsigned z0 = 0u; asm volatile("" : "+v"(z0)); const v4u zz = {z0, z0, z0, z0};
      for (int i = tid; i < 80 * CT_PITCH / 16; i += 512) *(LAS v4u*)(L + CT_OFF + i * 16) = zz; }
    for (int i = tid; i < 16 * 64; i += 512) { const int e = 64 + (i >> 6), s = i & 63; *(LAS bf16_t*)(L + VT_OFF + e * VT_PITCH + s * 2) = (bf16_t)(e == 64 ? 0x3F80 : 0); }
    f32x4 C[2][5];
#pragma unroll
    for (int a = 0; a < 2; ++a)
#pragma unroll
        for (int e = 0; e < 5; ++e) C[a][e] = (f32x4){0.f, 0.f, 0.f, 0.f};
    const int tn = w & 3, wh = w >> 2, t = tn * 16 + c16;
    const int kl = (dir ? 63 - lane : lane) * 8, ql = q * 512 + (dir ? 63 - t : t) * 8;
    v4u kc[4], kn[4], vc; bf16x8 Qc[8], Qn[8]; float gc0, gc1, gc2, gn0, gn1, gn2;
#define MLP_ROW(base, j) ((size_t)(base) + (dir ? 63 - (j) : (j)))
#define MLP_TAB(par) ((LAS float*)(L + ((par) ? TAB2_OFF : TAB_OFF)))
#define MLP_ST(par) ((par) ? ST2_OFF : ST_OFF)
#define MLP_XB(sec, c_) (X8 + (size_t)(sec) * X8_SEC + ((size_t)(b * 8 + h) * 36 + (c_)) * (32 * 64 * 8))
#define MLP_LOADK(dst, k) do { const bf16_t* _xb = MLP_XB(1, chunk_of((k), dir)) + w * 4 * 512; \
        _Pragma("unroll") for (int i = 0; i < 4; ++i) dst[i] = *(const v4u*)(_xb + i * 512 + kl); } while (0)
#define MLP_LOADV(dst, k) do { dst = *(const v4u*)(MLP_XB(2, chunk_of((k), dir)) + (es * 8 + w) * 512 + kl); } while (0)
#define MLP_LOADG(d0, d1, d2, k) do { const float* _gp = (const float*)(GSC + chunk_of((k), dir) * 64 + lane); d0 = _gp[0]; d1 = _gp[1]; d2 = _gp[2]; } while (0)
#define MLP_LOADQ(dst, k) do { const bf16_t* _xb = MLP_XB(0, chunk_of((k), dir)); \
        _Pragma("unroll") for (int ks = 0; ks < 8; ++ks) dst[ks] = *(const bf16x8*)(_xb + ks * 2048 + ql); } while (0)
#define MLP_STILE(QQ, TB, SO) do { const float _mmt = (TB)[64 + t]; \
        _Pragma("unroll") for (int si = 0; si < 2; ++si) { const int sm = wh * 2 + si; v2u o = {0u, 0u}; \
            if (sm <= tn) { f32x4 acc = {0.f, 0.f, 0.f, 0.f}; \
                bf16x8 ka_[8]; \
                _Pragma("unroll") for (int ks = 0; ks < 8; ++ks) ka_[ks] = *(const LAS bf16x8*)(L + KS_OFF + (sm * 16 + c16) * KS_PITCH + (ks * 32 + q * 8) * 2); \
                __builtin_amdgcn_sched_barrier(0); \
                _Pragma("unroll") for (int ks = 0; ks < 8; ++ks) acc = ML_MFMA(ka_[ks], QQ[ks], acc); \
                float v[4]; \
                _Pragma("unroll") for (int j = 0; j < 4; ++j) { const int s = sm * 16 + q * 4 + j; v[j] = s <= t ? acc[j] * __expf((TB)[s] - _mmt) : 0.f; } \
                o.x = pk2(v[0], v[1]); o.y = pk2(v[2], v[3]); } \
            *(LAS v2u*)(L + (SO) + t * ST_PITCH + (sm * 16 + q * 4) * 2) = o; } } while (0)
    MLP_LOADK(kc, 0); MLP_LOADV(vc, 0); MLP_LOADG(gc0, gc1, gc2, 0); MLP_LOADQ(Qc, 0); MLP_LOADK(kn, 1); MLP_LOADG(gn0, gn1, gn2, 1); MLP_LOADQ(Qn, 1);
    float m = -1e30f;
    {
      const float mm = fmaxf(gc2, m); LAS float* TB = MLP_TAB(0);
      if (w == 0) { TB[lane] = gc1; TB[64 + lane] = mm; TB[128 + lane] = gc0; }
#pragma unroll
      for (int i = 0; i < 4; ++i) *(LAS v4u*)(L + KS_OFF + lane * KS_PITCH + (w * 4 + i) * 16) = kc[i];
      __syncthreads();
      if (need_ctx) MLP_STILE(Qc, TB, MLP_ST(0));
      __syncthreads(); }
#pragma unroll 1
    for (int k = 0; k < 36; ++k) {
        const int par = k & 1, k1 = k + 1 < 36 ? k + 1 : 35, k2 = k + 2 < 36 ? k + 2 : 35;
        const bool do_out = need_ctx || k >= 4, s_next = (k + 1 < 36) && (need_ctx || k + 1 >= 4);
        const size_t base = (size_t)b * TPB + chunk_of(k, dir) * 64;
        if (k > 0 && VAR != 2) {
#pragma unroll
            for (int di = 0; di < 2; ++di)
#pragma unroll
                for (int en = 0; en < 5; ++en) { const f32x4 c = C[di][en]; v2u o; o.x = pk2(c[0], c[1]); o.y = pk2(c[2], c[3]);
                    *(LAS v2u*)(L + CT_OFF + (en * 16 + c16) * CT_PITCH + ((2 * w + di) * 16 + q * 4) * 2) = o; } }
        const float mm = fmaxf(gc2, m), bL = lane_get(gc0, 63), mm63 = lane_get(mm, 63), wk = __expf(gc1 - mm63), m_next = bL + mm63;
#pragma unroll
        for (int i = 0; i < (VAR == 2 ? 1 : 4); ++i) {
#pragma unroll
            for (int e = 0; e < (VAR == 2 ? 1 : 4); ++e) { const unsigned x = kc[i][e]; const unsigned pk = pk2(blo(x) * wk, bhi(x) * wk);
                *(LAS bf16_t*)(L + KT_OFF + ((w * 4 + i) * 8 + 2 * e) * KT_PITCH + lane * 2) = (bf16_t)(pk & 0xffffu); *(LAS bf16_t*)(L + KT_OFF + ((w * 4 + i) * 8 + 2 * e + 1) * KT_PITCH + lane * 2) = (bf16_t)(pk >> 16); } }
#pragma unroll
        for (int e = 0; e < 4; ++e) { const unsigned x = vc[e];
            *(LAS bf16_t*)(L + VT_OFF + (w * 8 + 2 * e) * VT_PITCH + lane * 2) = (bf16_t)(x & 0xffffu); *(LAS bf16_t*)(L + VT_OFF + (w * 8 + 2 * e + 1) * VT_PITCH + lane * 2) = (bf16_t)(x >> 16); }
        { const float mmn = fmaxf(gn2, m_next); LAS float* TBn = MLP_TAB(par ^ 1);
          if (w == 0) { TBn[lane] = gn1; TBn[64 + lane] = mmn; TBn[128 + lane] = gn0; }
#pragma unroll
          for (int i = 0; i < (VAR == 2 ? 1 : 4); ++i) *(LAS v4u*)(L + KS_OFF + lane * KS_PITCH + (w * 4 + i) * 16) = kn[i]; }
        __syncthreads();
#pragma unroll
        for (int i = 0; i < 4; ++i) kc[i] = kn[i];
        gc0 = gn0; gc1 = gn1; gc2 = gn2;
        if (VAR != 3) { MLP_LOADK(kn, k2); MLP_LOADV(vc, k1); MLP_LOADG(gn0, gn1, gn2, k2); }
        const LAS float* TB = MLP_TAB(par);
        if (do_out && VAR != 1) {
            const float wi = __expf(m - TB[64 + t]); f32x4 num0 = {0.f, 0.f, 0.f, 0.f}, num1 = {0.f, 0.f, 0.f, 0.f}; float den = 1.f;
            bf16x8 sb[2];
#pragma unroll
            for (int ks = 0; ks < 2; ++ks) sb[ks] = *(const LAS bf16x8*)(L + MLP_ST(par) + t * ST_PITCH + (ks * 32 + q * 8) * 2);
#pragma unroll
            for (int ei = 0; ei < 3; ++ei) { const int em = ei < 2 ? wh * 2 + ei : 4;
                f32x4 a1 = {0.f, 0.f, 0.f, 0.f}, a2 = {0.f, 0.f, 0.f, 0.f}; bf16x8 va_[2], ca_[8];
#pragma unroll
                for (int ks = 0; ks < 2; ++ks) va_[ks] = *(const LAS bf16x8*)(L + VT_OFF + (em * 16 + c16) * VT_PITCH + (ks * 32 + q * 8) * 2);
#pragma unroll
                for (int ks = 0; ks < 8; ++ks) ca_[ks] = *(const LAS bf16x8*)(L + CT_OFF + (em * 16 + c16) * CT_PITCH + (ks * 32 + q * 8) * 2);
                __builtin_amdgcn_sched_barrier(0);
#pragma unroll
                for (int ks = 0; ks < 2; ++ks) a1 = ML_MFMA(va_[ks], sb[ks], a1);
#pragma unroll
                for (int ks = 0; ks < 8; ++ks) a2 = ML_MFMA(ca_[ks], Qc[ks], a2);
                __builtin_amdgcn_sched_barrier(0);
                const f32x4 nv = a1 + a2 * wi;
                if (ei == 0) num0 = nv; else if (ei == 1) num1 = nv;
                else den = fmaxf(fabsf(lane_get(nv[0], c16)), __expf(-(TB[128 + t] + TB[64 + t]))); }
            const float rd = 1.f / den; bf16_t* op = MH + MLP_ROW(base, t) * DM + h * 256 + es * 64 + q * 4; const f32x4 o0 = num0 * rd, o1 = num1 * rd;
            v2u w0, w1; w0.x = pk2(o0[0], o0[1]); w0.y = pk2(o0[2], o0[3]); w1.x = pk2(o1[0], o1[1]); w1.y = pk2(o1[2], o1[3]);
            *(v2u*)(op + (wh * 2) * 16) = w0; *(v2u*)(op + (wh * 2 + 1) * 16) = w1;
        }
        if (VAR != 1) { const float decay = __expf(m - mm63); bf16x8 vb_[5][2], ka2_[2][2];
#pragma unroll
          for (int en = 0; en < 5; ++en)
#pragma unroll
              for (int ks = 0; ks < 2; ++ks) vb_[en][ks] = *(const LAS bf16x8*)(L + VT_OFF + (en * 16 + c16) * VT_PITCH + (ks * 32 + q * 8) * 2);
#pragma unroll
          for (int di = 0; di < 2; ++di)
#pragma unroll
              for (int ks = 0; ks < 2; ++ks) ka2_[di][ks] = *(const LAS bf16x8*)(L + KT_OFF + ((2 * w + di) * 16 + c16) * KT_PITCH + (ks * 32 + q * 8) * 2);
#pragma unroll
          for (int di = 0; di < 2; ++di)
#pragma unroll
              for (int en = 0; en < 5; ++en) C[di][en] = C[di][en] * decay;
          __builtin_amdgcn_sched_barrier(0);
#pragma unroll
          for (int di = 0; di < 2; ++di)
#pragma unroll
              for (int en = 0; en < 5; ++en)
#pragma unroll
                  for (int ks = 0; ks < 2; ++ks) C[di][en] = ML_MFMA(ka2_[di][ks], vb_[en][ks], C[di][en]);
          __builtin_amdgcn_sched_barrier(0); }
        if (s_next && VAR != 1) MLP_STILE(Qn, MLP_TAB(par ^ 1), MLP_ST(par ^ 1));
#pragma unroll
        for (int ks = 0; ks < 8; ++ks) Qc[ks] = Qn[ks];
        if (VAR != 3) MLP_LOADQ(Qn, k2);
        m = m_next;
        __syncthreads();
    }
#undef MLP_ROW
#undef MLP_TAB
#undef MLP_ST
#undef MLP_XB
#undef MLP_LOADK
#undef MLP_LOADV
#undef MLP_LOADG
#undef MLP_LOADQ
#undef MLP_STILE
}
constexpr int T_CT = 0, T_CT_ROWS = 65;
constexpr int T_KS0 = T_CT + T_CT_ROWS * CT_PITCH, T_KS1 = T_KS0 + 64 * KS_PITCH;
constexpr int T_VS = T_KS1 + 64 * KS_PITCH, T_VPITCH = 160, T_VSW = T_VS + 64 * T_VPITCH;
constexpr int T_ST0 = T_VSW + 64 * T_VPITCH, T_ST1 = T_ST0 + 64 * ST_PITCH, T_TAB0 = T_ST1 + 64 * ST_PITCH, T_TAB1 = T_TAB0 + 1024, T_END = T_TAB1 + 1024;
static_assert(T_END <= MISC_OFF && T_CT + 80 * CT_PITCH <= T_END && T_KS0 % 16 == 0, "mLSTM LDS map (transposed reads)");
typedef short s16x4 __attribute__((ext_vector_type(4)));
template <int OFF> __device__ __forceinline__ s16x4 tr4(unsigned addr) { s16x4 r; asm volatile("ds_read_b64_tr_b16 %0, %1 offset:%2" : "=&v"(r) : "v"(addr), "i"(OFF) : "memory"); return r; }
#define TR_FRAG(OUT, addr, OFF0, OFF1) do { const s16x4 _a = tr4<(OFF0)>(addr), _b = tr4<(OFF1)>(addr); OUT##_lo = _a; OUT##_hi = _b; } while (0)
#define TR_JOIN(lo, hi) ((bf16x8){lo[0], lo[1], lo[2], lo[3], hi[0], hi[1], hi[2], hi[3]})
__device__ __forceinline__ void mlstm_unit_tr(Frame& F, CArgs* ka, int u, bool need_ctx) {
    const int tid = tid_fresh(), lane = tid & 63, w = __builtin_amdgcn_readfirstlane(tid >> 6), c16 = lane & 15, q = lane >> 4;
    const int es = u & 3, dir = (u >> 2) & 1, h = (u >> 3) & 7, b = u >> 6;
    LAS unsigned char* L = F.lds;
    const bf16_t* X8 = WSB(WS_X8); constexpr size_t X8_SEC = (size_t)MROWS * DM; bf16_t* MH = WSB(WS_MH) + (size_t)dir * MROWS * DM;
    const f32x4* GSC = (const f32x4*)WSF(WS_GSC) + (((size_t)b * 2 + dir) * 8 + h) * 36 * 64;
    __syncthreads();
    { unsigned z0 = 0u; asm volatile("" : "+v"(z0)); const v4u zz = {z0, z0, z0, z0};
      for (int i = tid; i < T_CT_ROWS * CT_PITCH / 16; i += 512) *(LAS v4u*)(L + T_CT + i * 16) = zz;
      if (tid < 128) { const int s = tid & 63, hf = tid >> 6; v4u one = zz; if (hf == 0) one.x = 0x3F80u;
          *(LAS v4u*)(L + T_VS + s * T_VPITCH + 128 + hf * 16) = one; *(LAS v4u*)(L + T_VSW + s * T_VPITCH + 128 + hf * 16) = zz; } }
    f32x4 C[2][5];
#pragma unroll
    for (int a = 0; a < 2; ++a)
#pragma unroll
        for (int e = 0; e < 5; ++e) C[a][e] = (f32x4){0.f, 0.f, 0.f, 0.f};
    const int tn = w & 3, wh = w >> 2, t = tn * 16 + c16;
    const int kl = (dir ? 63 - lane : lane) * 8, ql = q * 512 + (dir ? 63 - t : t) * 8;
    const unsigned LB = (unsigned)(size_t)L;
    const unsigned trK = (unsigned)((8 * q + (c16 >> 2)) * KS_PITCH + 8 * (lane & 3) + 64 * w), trV = (unsigned)((8 * q + (c16 >> 2)) * T_VPITCH + 8 * (lane & 3));
    v4u kn[4], vc; bf16x8 Qc[8], Qn[8]; float gc0, gc1, gc2, gn0, gn1, gn2;
#define MLP_ROW(base, j) ((size_t)(base) + (dir ? 63 - (j) : (j)))
#define MLP_TAB(par) ((LAS float*)(L + ((par) ? T_TAB1 : T_TAB0)))
#define MLP_ST(par) ((par) ? T_ST1 : T_ST0)
#define MLP_KS(par) ((par) ? T_KS1 : T_KS0)
#define MLP_XB(sec, c_) (X8 + (size_t)(sec) * X8_SEC + ((size_t)(b * 8 + h) * 36 + (c_)) * (32 * 64 * 8))
#define MLP_LOADK(dst, k) do { const bf16_t* _xb = MLP_XB(1, chunk_of((k), dir)) + w * 4 * 512; \
        _Pragma("unroll") for (int i = 0; i < 4; ++i) dst[i] = *(const v4u*)(_xb + i * 512 + kl); } while (0)
#define MLP_LOADV(dst, k) do { dst = *(const v4u*)(MLP_XB(2, chunk_of((k), dir)) + (es * 8 + w) * 512 + kl); } while (0)
#define MLP_LOADG(d0, d1, d2, k) do { const float* _gp = (const float*)(GSC + chunk_of((k), dir) * 64 + lane); d0 = _gp[0]; d1 = _gp[1]; d2 = _gp[2]; } while (0)
#define MLP_LOADQ(dst, k) do { const bf16_t* _xb = MLP_XB(0, chunk_of((k), dir)); \
        _Pragma("unroll") for (int ks = 0; ks < 8; ++ks) dst[ks] = *(const bf16x8*)(_xb + ks * 2048 + ql); } while (0)
#define MLP_STILE(QQ, TB, SO, KSO) do { const float _mmt = (TB)[64 + t]; \
        _Pragma("unroll") for (int si = 0; si < 2; ++si) { const int sm = wh * 2 + si; v2u o = {0u, 0u}; \
            if (sm <= tn) { f32x4 acc = {0.f, 0.f, 0.f, 0.f}; \
                bf16x8 ka_[8]; \
                _Pragma("unroll") for (int ks = 0; ks < 8; ++ks) ka_[ks] = *(const LAS bf16x8*)(L + (KSO) + (sm * 16 + c16) * KS_PITCH + (ks * 32 + q * 8) * 2); \
                __builtin_amdgcn_sched_barrier(0); \
                _Pragma("unroll") for (int ks = 0; ks < 8; ++ks) acc = ML_MFMA(ka_[ks], QQ[ks], acc); \
                float v[4]; \
                _Pragma("unroll") for (int j = 0; j < 4; ++j) { const int s = sm * 16 + q * 4 + j; v[j] = s <= t ? acc[j] * __expf((TB)[s] - _mmt) : 0.f; } \
                o.x = pk2(v[0], v[1]); o.y = pk2(v[2], v[3]); } \
            *(LAS v2u*)(L + (SO) + t * ST_PITCH + (sm * 16 + q * 4) * 2) = o; } } while (0)
    MLP_LOADK(kn, 0); MLP_LOADV(vc, 0); MLP_LOADG(gc0, gc1, gc2, 0); MLP_LOADQ(Qc, 0); MLP_LOADG(gn0, gn1, gn2, 1); MLP_LOADQ(Qn, 1);
    float m = -1e30f;
    { const float mm = fmaxf(gc2, m); LAS float* TB = MLP_TAB(0);
      if (w == 0) { TB[lane] = gc1; TB[64 + lane] = mm; TB[128 + lane] = gc0; }
#pragma unroll
      for (int i = 0; i < 4; ++i) *(LAS v4u*)(L + T_KS0 + lane * KS_PITCH + (w * 4 + i) * 16) = kn[i];
      MLP_LOADK(kn, 1);
      __syncthreads();
      if (need_ctx) MLP_STILE(Qc, TB, MLP_ST(0), T_KS0);
      __syncthreads(); }
#pragma unroll 1
    for (int k = 0; k < 36; ++k) {
        const int par = k & 1, k1 = k + 1 < 36 ? k + 1 : 35, k2 = k + 2 < 36 ? k + 2 : 35;
        const bool do_out = need_ctx || k >= 4, s_next = (k + 1 < 36) && (need_ctx || k + 1 >= 4);
        const size_t base = (size_t)b * TPB + chunk_of(k, dir) * 64;
        if (k > 0) {
#pragma unroll
            for (int di = 0; di < 2; ++di)
#pragma unroll
                for (int en = 0; en < 5; ++en) { const f32x4 c = C[di][en]; v2u o; o.x = pk2(c[0], c[1]); o.y = pk2(c[2], c[3]);
                    if (en < 4 || c16 == 0) *(LAS v2u*)(L + T_CT + (en * 16 + c16) * CT_PITCH + ((2 * w + di) * 16 + q * 4) * 2) = o; } }
        const float mm = fmaxf(gc2, m), bL = lane_get(gc0, 63), mm63 = lane_get(mm, 63), wk = __expf(gc1 - mm63), m_next = bL + mm63;
        { *(LAS v4u*)(L + T_VS + lane * T_VPITCH + w * 16) = vc;
          v4u sv;
#pragma unroll
          for (int e = 0; e < 4; ++e) sv[e] = pk2(blo(vc[e]) * wk, bhi(vc[e]) * wk);
          *(LAS v4u*)(L + T_VSW + lane * T_VPITCH + w * 16) = sv;
          if (w == 0) *(LAS bf16_t*)(L + T_VSW + lane * T_VPITCH + 128) = (bf16_t)(pk2(wk, 0.f) & 0xffffu); }
        { const float mmn = fmaxf(gn2, m_next); LAS float* TBn = MLP_TAB(par ^ 1);
          if (w == 0) { TBn[lane] = gn1; TBn[64 + lane] = mmn; TBn[128 + lane] = gn0; }
#pragma unroll
          for (int i = 0; i < 4; ++i) *(LAS v4u*)(L + MLP_KS(par ^ 1) + lane * KS_PITCH + (w * 4 + i) * 16) = kn[i]; }
        __syncthreads();
        gc0 = gn0; gc1 = gn1; gc2 = gn2;
        MLP_LOADK(kn, k2); MLP_LOADV(vc, k1); MLP_LOADG(gn0, gn1, gn2, k2);
        const LAS float* TB = MLP_TAB(par);
        if (do_out) {
            const float wi = __expf(m - TB[64 + t]); f32x4 num0 = {0.f, 0.f, 0.f, 0.f}, num1 = {0.f, 0.f, 0.f, 0.f}; float den = 1.f;
            bf16x8 sb[2];
#pragma unroll
            for (int ks = 0; ks < 2; ++ks) sb[ks] = *(const LAS bf16x8*)(L + MLP_ST(par) + t * ST_PITCH + (ks * 32 + q * 8) * 2);
#pragma unroll
            for (int ei = 0; ei < 3; ++ei) { const int em = ei < 2 ? wh * 2 + ei : 4;
                f32x4 a1 = {0.f, 0.f, 0.f, 0.f}, a2 = {0.f, 0.f, 0.f, 0.f}; bf16x8 ca_[8];
                const unsigned va = LB + T_VS + trV + 32 * em;
                const s16x4 v00 = tr4<0>(va), v01 = tr4<4 * T_VPITCH>(va), v10 = tr4<32 * T_VPITCH>(va), v11 = tr4<36 * T_VPITCH>(va);
#pragma unroll
                for (int ks = 0; ks < 8; ++ks) ca_[ks] = *(const LAS bf16x8*)(L + T_CT + (em * 16 + c16) * CT_PITCH + (ks * 32 + q * 8) * 2);
                asm volatile("s_waitcnt lgkmcnt(0)" ::: "memory"); __builtin_amdgcn_sched_barrier(0);
                a1 = ML_MFMA(TR_JOIN(v00, v01), sb[0], a1); a1 = ML_MFMA(TR_JOIN(v10, v11), sb[1], a1);
#pragma unroll
                for (int ks = 0; ks < 8; ++ks) a2 = ML_MFMA(ca_[ks], Qc[ks], a2);
                __builtin_amdgcn_sched_barrier(0);
                const f32x4 nv = a1 + a2 * wi;
                if (ei == 0) num0 = nv; else if (ei == 1) num1 = nv;
                else den = fmaxf(fabsf(lane_get(nv[0], c16)), __expf(-(TB[128 + t] + TB[64 + t]))); }
            const float rd = 1.f / den; bf16_t* op = MH + MLP_ROW(base, t) * DM + h * 256 + es * 64 + q * 4; const f32x4 o0 = num0 * rd, o1 = num1 * rd;
            v2u w0, w1; w0.x = pk2(o0[0], o0[1]); w0.y = pk2(o0[2], o0[3]); w1.x = pk2(o1[0], o1[1]); w1.y = pk2(o1[2], o1[3]);
            *(v2u*)(op + (wh * 2) * 16) = w0; *(v2u*)(op + (wh * 2 + 1) * 16) = w1;
        }
        {
          const float decay = __expf(m - mm63);
          const unsigned ka_ = LB + MLP_KS(par) + trK, vb_ = LB + T_VSW + trV;
          const s16x4 k000 = tr4<0>(ka_), k001 = tr4<4 * KS_PITCH>(ka_), k010 = tr4<32 * KS_PITCH>(ka_), k011 = tr4<36 * KS_PITCH>(ka_);
          const s16x4 k100 = tr4<32>(ka_), k101 = tr4<4 * KS_PITCH + 32>(ka_), k110 = tr4<32 * KS_PITCH + 32>(ka_), k111 = tr4<36 * KS_PITCH + 32>(ka_);
          s16x4 vq[5][4];
#define TRV(en) do { vq[en][0] = tr4<32 * (en)>(vb_); vq[en][1] = tr4<4 * T_VPITCH + 32 * (en)>(vb_); vq[en][2] = tr4<32 * T_VPITCH + 32 * (en)>(vb_); vq[en][3] = tr4<36 * T_VPITCH + 32 * (en)>(vb_); } while (0)
          TRV(0); TRV(1); TRV(2); TRV(3); TRV(4);
#undef TRV
#pragma unroll
          for (int di = 0; di < 2; ++di)
#pragma unroll
              for (int en = 0; en < 5; ++en) C[di][en] = C[di][en] * decay;
          asm volatile("s_waitcnt lgkmcnt(0)" ::: "memory"); __builtin_amdgcn_sched_barrier(0);
#pragma unroll
          for (int en = 0; en < 5; ++en) { const bf16x8 b0 = TR_JOIN(vq[en][0], vq[en][1]), b1 = TR_JOIN(vq[en][2], vq[en][3]);
              C[0][en] = ML_MFMA(TR_JOIN(k000, k001), b0, C[0][en]); C[0][en] = ML_MFMA(TR_JOIN(k010, k011), b1, C[0][en]);
              C[1][en] = ML_MFMA(TR_JOIN(k100, k101), b0, C[1][en]); C[1][en] = ML_MFMA(TR_JOIN(k110, k111), b1, C[1][en]); }
          __builtin_amdgcn_sched_barrier(0); }
        if (s_next) MLP_STILE(Qn, MLP_TAB(par ^ 1), MLP_ST(par ^ 1), MLP_KS(par ^ 1));
#pragma unroll
        for (int ks = 0; ks < 8; ++ks) Qc[ks] = Qn[ks];
        MLP_LOADQ(Qn, k2);
        m = m_next;
        __syncthreads();
    }
#undef MLP_ROW
#undef MLP_TAB
#undef MLP_ST
#undef MLP_KS
#undef MLP_XB
#undef MLP_LOADK
#undef MLP_LOADV
#undef MLP_LOADG
#undef MLP_LOADQ
#undef MLP_STILE
}
}

namespace lru {
typedef short bf16x8 __attribute__((ext_vector_type(8)));
constexpr int XB_OFF = 0, XB_PITCH = 272;
constexpr int XF_OFF = XB_OFF + 64 * XB_PITCH, XF_PITCH = 528;
constexpr int YO_OFF = XF_OFF + 64 * XF_PITCH, YO_PITCH = 528;
constexpr int HIN_OFF = YO_OFF + 64 * YO_PITCH;
constexpr int CW_OFF = HIN_OFF + 9 * 2 * 128 * 4;
constexpr int END_OFF = CW_OFF + 5 * 128 * 4;
static_assert(END_OFF <= MISC_OFF, "LRU LDS map");
#define LRU_COMPOSE(A, B, a2, b2) do { B = (a2) * B + (b2); A = (a2) * A; } while (0)

template <bool FINAL, int VAR, class BcOf>
__device__ __forceinline__ void lru_run(Frame& F, CArgs* ka, int l, int blk, int NU, const BcOf& bc_of) {
    const int tid = tid_fresh(), lane = tid & 63, w = __builtin_amdgcn_readfirstlane(tid >> 6), c16 = lane & 15, q = lane >> 4;
    LAS unsigned char* L = F.lds; const bf16_t* P = WSB(WS_P);
    const int cg = tid & 15, rg = tid >> 4, chl = 16 * w + c16, ch = blk * 128 + chl;
    bf16x8 bw[4][4];
    { const bf16_t* Wt = WSB(WS_WLRU) + (size_t)l * 4 * 16 * 16384 + ((size_t)blk * 128 + chl) * 128 + q * 8;
#pragma unroll
      for (int g = 0; g < 4; ++g)
#pragma unroll
          for (int ks = 0; ks < 4; ++ks) bw[g][ks] = *(const bf16x8*)(Wt + (size_t)g * 16 * 16384 + ks * 32); }
    float cbr[2], cbi[2], csp[2];
#pragma unroll
    for (int dr = 0; dr < 2; ++dr) { cbr[dr] = KIN(12)[((size_t)l * 2 + dr) * DM + ch]; cbi[dr] = KIN(14)[((size_t)l * 2 + dr) * DM + ch]; csp[dr] = log1pf(__expf(-KIN(15)[((size_t)l * 2 + dr) * DM + ch])); }
    for (int i = tid; i < 5 * 128; i += 512) { const int kk = i >> 7, c = i & 127; ((LAS float*)(L + CW_OFF))[i] = kk < 4 ? KIN(9)[((size_t)l * 4 + kk) * DM + blk * 128 + c] : KIN(10)[(size_t)l * DM + blk * 128 + c]; }
    v4u raw[5];
#define LRU_LOAD(i) do { int _b, _c; bc_of((i), _b, _c); const int _t0 = _c * 64, _lo = _c < 32 ? 0 : SEQ, _hi = _c < 32 ? SEQ : TPB; const size_t _rb = (size_t)_b * TPB; \
        _Pragma("unroll") for (int x = 0; x < 5; ++x) { const int tt = _t0 + 2 * rg - 2 + x; raw[x] = (v4u){0u, 0u, 0u, 0u}; if (tt >= _lo && tt < _hi) raw[x] = *(const v4u*)(P + (_rb + tt) * NP + C_LX + blk * 128 + cg * 8); } \
        } while (0)
    LRU_LOAD(0);
#pragma unroll 1
    for (int ui = 0; ui < NU; ++ui) {
        int b, chunk; bc_of(ui, b, chunk); const size_t rb = (size_t)b * TPB; const int t0 = chunk * 64;
        __syncthreads();
        {
          float o0[8], o1[8]; const LAS float* cwl = (const LAS float*)(L + CW_OFF) + cg * 8;
#pragma unroll
          for (int e = 0; e < 8; ++e) { o0[e] = cwl[4 * 128 + e]; o1[e] = o0[e]; }
#pragma unroll
          for (int kk = 0; kk < 5; ++kk) { float xin[8];
#pragma unroll
              for (int e = 0; e < 4; ++e) { xin[2 * e] = blo(raw[kk][e]); xin[2 * e + 1] = bhi(raw[kk][e]); }
#pragma unroll
              for (int e = 0; e < 8; ++e) { if (kk < 4) o0[e] += cwl[kk * 128 + e] * xin[e]; if (kk > 0) o1[e] += cwl[(kk - 1) * 128 + e] * xin[e]; } }
          v4u p0, p1; p0.x = pk2(o0[0], o0[1]); p0.y = pk2(o0[2], o0[3]); p0.z = pk2(o0[4], o0[5]); p0.w = pk2(o0[6], o0[7]); p1.x = pk2(o1[0], o1[1]); p1.y = pk2(o1[2], o1[3]); p1.z = pk2(o1[4], o1[5]); p1.w = pk2(o1[6], o1[7]);
          *(LAS v4u*)(L + XB_OFF + (2 * rg) * XB_PITCH + cg * 16) = p0; *(LAS v4u*)(L + XB_OFF + (2 * rg + 1) * XB_PITCH + cg * 16) = p1;
          LAS float* f0 = (LAS float*)(L + XF_OFF + (2 * rg) * XF_PITCH + cg * 32); LAS float* f1 = (LAS float*)(L + XF_OFF + (2 * rg + 1) * XF_PITCH + cg * 32);
          *(LAS f32x4*)f0 = (f32x4){o0[0], o0[1], o0[2], o0[3]}; *(LAS f32x4*)(f0 + 4) = (f32x4){o0[4], o0[5], o0[6], o0[7]};
          *(LAS f32x4*)f1 = (f32x4){o1[0], o1[1], o1[2], o1[3]}; *(LAS f32x4*)(f1 + 4) = (f32x4){o1[4], o1[5], o1[6], o1[7]}; }
        __syncthreads();
        v4u zcur[2];
        if (FINAL) {
#pragma unroll
            for (int x = 0; x < 2; ++x) { const int cidx = tid + 512 * x; zcur[x] = *(const v4u*)(P + (rb + t0 + (cidx >> 4)) * NP + C_LZ + blk * 128 + (cidx & 15) * 8); } }
        if (ui + 1 < NU) LRU_LOAD(ui + 1);
#pragma unroll
        for (int dr = 0; dr < 2; ++dr) {
            f32x4 acc[2][4];
#pragma unroll
            for (int g = 0; g < 2; ++g)
#pragma unroll
                for (int tm = 0; tm < 4; ++tm) acc[g][tm] = (f32x4){0.f, 0.f, 0.f, 0.f};
            if (VAR < 2) {
#pragma unroll
            for (int ks = 0; ks < 4; ++ks) { bf16x8 a[4];
#pragma unroll
                for (int tm = 0; tm < 4; ++tm) a[tm] = *(const LAS bf16x8*)(L + XB_OFF + (tm * 16 + c16) * XB_PITCH + (ks * 32 + q * 8) * 2);
#pragma unroll
                for (int g = 0; g < 2; ++g)
#pragma unroll
                    for (int tm = 0; tm < 4; ++tm) acc[g][tm] = __builtin_amdgcn_mfma_f32_16x16x32_bf16(a[tm], bw[2 * dr + g][ks], acc[g][tm], 0, 0, 0); } }
            if (VAR < 1) {
                typedef float f32x2 __attribute__((ext_vector_type(2)));
                const float NL2E = -1.4426950408889634f; const float kr = cbr[dr] * NL2E, ki = cbi[dr] * NL2E, c16l = -16.f * csp[dr], c8l2 = -8.f * csp[dr] * 1.4426950408889634f;
#pragma unroll
                for (int tm = 0; tm < 4; ++tm)
#pragma unroll
                    for (int jp = 0; jp < 2; ++jp) { const int t = tm * 16 + q * 4 + 2 * jp;
                        const f32x2 xv = {*(const LAS float*)(L + XF_OFF + t * XF_PITCH + chl * 4), *(const LAS float*)(L + XF_OFF + (t + 1) * XF_PITCH + chl * 4)};
                        const f32x2 ar = {acc[0][tm][2 * jp], acc[0][tm][2 * jp + 1]}, ai = {acc[1][tm][2 * jp], acc[1][tm][2 * jp + 1]};
                        f32x2 tr = ar * NL2E + kr, ti = ai * NL2E + ki; tr.x = fminf(tr.x, 60.f); tr.y = fminf(tr.y, 60.f); ti.x = fminf(ti.x, 60.f); ti.y = fminf(ti.y, 60.f);
                        f32x2 er, ei; er.x = __builtin_amdgcn_exp2f(tr.x); er.y = __builtin_amdgcn_exp2f(tr.y); ei.x = __builtin_amdgcn_exp2f(ti.x); ei.y = __builtin_amdgcn_exp2f(ti.y);
                        const f32x2 pr = er + 1.f, pi = ei + 1.f, dn = pr * pi; f32x2 R; R.x = __builtin_amdgcn_rcpf(dn.x); R.y = __builtin_amdgcn_rcpf(dn.y);
                        const f32x2 rgt = R * pi, igt = R * pr, x2 = rgt * c16l, l2 = rgt * c8l2;
                        f32x2 av; av.x = __builtin_amdgcn_exp2f(l2.x); av.y = __builtin_amdgcn_exp2f(l2.y);
                        const f32x2 ser = -x2 * (x2 * (x2 * (x2 * (x2 * 0.0083333338f + 0.041666668f) + 0.16666667f) + 0.5f) + 1.f), dir_ = 1.f - av * av;
                        f32x2 om; om.x = x2.x > -0.1f ? ser.x : dir_.x; om.y = x2.y > -0.1f ? ser.y : dir_.y;
                        f32x2 sq; sq.x = __builtin_amdgcn_sqrtf(om.x); sq.y = __builtin_amdgcn_sqrtf(om.y);
                        const f32x2 bxv = sq * igt * xv;
                        acc[0][tm][2 * jp] = av.x; acc[0][tm][2 * jp + 1] = av.y; acc[1][tm][2 * jp] = bxv.x; acc[1][tm][2 * jp + 1] = bxv.y; } }
#define LRU_TM(i) (dr ? 3 - (i) : (i))
            if constexpr (!FINAL) { if (VAR < 3) {
                float2* AGG = (float2*)(VAR ? WSF(WS_ACC) : WSF(WS_LA)); float TA = 1.f, TB = 0.f;
#pragma unroll
                for (int ti = 0; ti < 4; ++ti) { const int tm = LRU_TM(ti); float sa = 1.f, sb = 0.f;
#pragma unroll
                    for (int ji = 0; ji < 4; ++ji) { const int j = LRU_TM(ji); LRU_COMPOSE(sa, sb, acc[0][tm][j], acc[1][tm][j]); }
#pragma unroll
                    for (int qi = 0; qi < 4; ++qi) { const int qq = LRU_TM(qi); const float xa = lane_get(sa, c16 + 16 * qq), xb = lane_get(sb, c16 + 16 * qq); LRU_COMPOSE(TA, TB, xa, xb); } }
                if (q == 0) AGG[(((size_t)b * 36 + chunk) * 2 + dr) * DM + ch] = make_float2(TA, TB); }
            } else {
                float H = ((const LAS float*)(L + HIN_OFF))[ui * 256 + dr * 128 + chl];
#pragma unroll
                for (int ti = 0; ti < 4; ++ti) { const int tm = LRU_TM(ti); float sa = 1.f, sb = 0.f;
#pragma unroll
                    for (int ji = 0; ji < 4; ++ji) { const int j = LRU_TM(ji); LRU_COMPOSE(sa, sb, acc[0][tm][j], acc[1][tm][j]); }
                    float ea = 1.f, eb = 0.f, ta = 1.f, tb = 0.f;
#pragma unroll
                    for (int qi = 0; qi < 4; ++qi) { const int qq = LRU_TM(qi); const float xa = lane_get(sa, c16 + 16 * qq), xb = lane_get(sb, c16 + 16 * qq); if (qq == q) { ea = ta; eb = tb; } LRU_COMPOSE(ta, tb, xa, xb); }
                    float hs = ea * H + eb;
#pragma unroll
                    for (int ji = 0; ji < 4; ++ji) { const int j = LRU_TM(ji); hs = acc[0][tm][j] * hs + acc[1][tm][j]; LAS float* yp = (LAS float*)(L + YO_OFF + (tm * 16 + q * 4 + j) * YO_PITCH + chl * 4);
                        if (dr == 0) *yp = hs; else *yp += hs; }
                    H = ta * H + tb; }
            }
#undef LRU_TM
        }
        if constexpr (FINAL) {
            __syncthreads();
            bf16_t* YB0 = WSB(WS_YB);
#pragma unroll
            for (int i = 0; i < 2; ++i) { const int cidx = tid + 512 * i, row = cidx >> 4, cgo = cidx & 15; const size_t rgl = rb + t0 + row;
                const f32x4 y0 = *(const LAS f32x4*)(L + YO_OFF + row * YO_PITCH + cgo * 32), y1 = *(const LAS f32x4*)(L + YO_OFF + row * YO_PITCH + cgo * 32 + 16);
                const v4u z = zcur[i];
                v4u o; o.x = pk2(y0[0] * blo(z.x), y0[1] * bhi(z.x)); o.y = pk2(y0[2] * blo(z.y), y0[3] * bhi(z.y)); o.z = pk2(y1[0] * blo(z.z), y1[1] * bhi(z.z)); o.w = pk2(y1[2] * blo(z.w), y1[3] * bhi(z.w));
                *(v4u*)(YB0 + rgl * DM + blk * 128 + cgo * 8) = o; }
        }
    }
#undef LRU_LOAD
}
constexpr int CW_LRUFLAG = 32768, LRU_FLAG_STRIDE = 16;
__device__ __forceinline__ void p_lru_lookback(Frame& F, CArgs* ka, int l) {
    const int tid = tid_fresh(), lane = tid & 63, w = __builtin_amdgcn_readfirstlane(tid >> 6), c16 = lane & 15, q = lane >> 4;
    const int npar = F.G / 36; if (F.wg >= npar * 36) return;
    const int slot = F.wg / 36, chunk = F.wg - slot * 36, cps = (64 + npar - 1) / npar;
    LAS unsigned char* L = F.lds; const bf16_t* P = WSB(WS_P);
    unsigned* ctl = (unsigned*)(ka->ws + WS_CTL); unsigned long long* AGG = (unsigned long long*)WSF(WS_LA) + (size_t)l * 64 * 36 * 2 * 128;
    const unsigned epoch = (unsigned)(l + 1);
    const int cg = tid & 15, rg = tid >> 4, chl = 16 * w + c16;
    const int t0 = chunk * 64, lo = chunk < 32 ? 0 : SEQ, hi = chunk < 32 ? SEQ : TPB;
    int cur_blk = -1;
    v4u raw[5];
#define LRU_LOADX(colx) do { const int _b = (colx) & 3, _blk = (colx) >> 2; const size_t _rb = (size_t)_b * TPB; \
        _Pragma("unroll") for (int x = 0; x < 5; ++x) { const int tt = t0 + 2 * rg - 2 + x; raw[x] = (v4u){0u, 0u, 0u, 0u}; if (tt >= lo && tt < hi) raw[x] = *(const v4u*)(P + (_rb + tt) * NP + C_LX + _blk * 128 + cg * 8); } } while (0)
    const int col0 = slot * cps, col1 = (col0 + cps) < 64 ? (col0 + cps) : 64;
    if (col0 < col1) LRU_LOADX(col0);
#pragma unroll 1
    for (int col = col0; col < col1; ++col) {
        const int b = col & 3, blk = col >> 2, ch = blk * 128 + chl; const size_t rb = (size_t)b * TPB;
        __syncthreads();
        bf16x8 bw[4][4]; float cbr[2], cbi[2], csp[2];
        { const bf16_t* Wt = WSB(WS_WLRU) + (size_t)l * 4 * 16 * 16384 + ((size_t)blk * 128 + chl) * 128 + q * 8;
#pragma unroll
          for (int g = 0; g < 4; ++g)
#pragma unroll
              for (int ks = 0; ks < 4; ++ks) bw[g][ks] = *(const bf16x8*)(Wt + (size_t)g * 16 * 16384 + ks * 32);
#pragma unroll
          for (int dr = 0; dr < 2; ++dr) { cbr[dr] = KIN(12)[((size_t)l * 2 + dr) * DM + ch]; cbi[dr] = KIN(14)[((size_t)l * 2 + dr) * DM + ch]; csp[dr] = log1pf(__expf(-KIN(15)[((size_t)l * 2 + dr) * DM + ch])); } }
        if (blk != cur_blk) { cur_blk = blk;
            for (int i = tid; i < 5 * 128; i += 512) { const int kk = i >> 7, c = i & 127; ((LAS float*)(L + CW_OFF))[i] = kk < 4 ? KIN(9)[((size_t)l * 4 + kk) * DM + blk * 128 + c] : KIN(10)[(size_t)l * DM + blk * 128 + c]; }
            __syncthreads(); }
        {
          float o0[8], o1[8]; const LAS float* cwl = (const LAS float*)(L + CW_OFF) + cg * 8;
#pragma unroll
          for (int e = 0; e < 8; ++e) { o0[e] = cwl[4 * 128 + e]; o1[e] = o0[e]; }
#pragma unroll
          for (int kk = 0; kk < 5; ++kk) { float xin[8];
#pragma unroll
              for (int e = 0; e < 4; ++e) { xin[2 * e] = blo(raw[kk][e]); xin[2 * e + 1] = bhi(raw[kk][e]); }
#pragma unroll
              for (int e = 0; e < 8; ++e) { if (kk < 4) o0[e] += cwl[kk * 128 + e] * xin[e]; if (kk > 0) o1[e] += cwl[(kk - 1) * 128 + e] * xin[e]; } }
          v4u p0, p1; p0.x = pk2(o0[0], o0[1]); p0.y = pk2(o0[2], o0[3]); p0.z = pk2(o0[4], o0[5]); p0.w = pk2(o0[6], o0[7]); p1.x = pk2(o1[0], o1[1]); p1.y = pk2(o1[2], o1[3]); p1.z = pk2(o1[4], o1[5]); p1.w = pk2(o1[6], o1[7]);
          *(LAS v4u*)(L + XB_OFF + (2 * rg) * XB_PITCH + cg * 16) = p0; *(LAS v4u*)(L + XB_OFF + (2 * rg + 1) * XB_PITCH + cg * 16) = p1;
          LAS float* f0 = (LAS float*)(L + XF_OFF + (2 * rg) * XF_PITCH + cg * 32); LAS float* f1 = (LAS float*)(L + XF_OFF + (2 * rg + 1) * XF_PITCH + cg * 32);
          *(LAS f32x4*)f0 = (f32x4){o0[0], o0[1], o0[2], o0[3]}; *(LAS f32x4*)(f0 + 4) = (f32x4){o0[4], o0[5], o0[6], o0[7]};
          *(LAS f32x4*)f1 = (f32x4){o1[0], o1[1], o1[2], o1[3]}; *(LAS f32x4*)(f1 + 4) = (f32x4){o1[4], o1[5], o1[6], o1[7]}; }
        __syncthreads();
        { const int coln = col + 1 < col1 ? col + 1 : col; LRU_LOADX(coln); }
        f32x4 av[2][4], bv[2][4];
#pragma unroll
        for (int dr = 0; dr < 2; ++dr) {
#pragma unroll
            for (int tm = 0; tm < 4; ++tm) { av[dr][tm] = (f32x4){0.f, 0.f, 0.f, 0.f}; bv[dr][tm] = (f32x4){0.f, 0.f, 0.f, 0.f}; }
#pragma unroll
            for (int ks = 0; ks < 4; ++ks) { bf16x8 a[4];
#pragma unroll
                for (int tm = 0; tm < 4; ++tm) a[tm] = *(const LAS bf16x8*)(L + XB_OFF + (tm * 16 + c16) * XB_PITCH + (ks * 32 + q * 8) * 2);
#pragma unroll
                for (int tm = 0; tm < 4; ++tm) { av[dr][tm] = __builtin_amdgcn_mfma_f32_16x16x32_bf16(a[tm], bw[2 * dr][ks], av[dr][tm], 0, 0, 0); bv[dr][tm] = __builtin_amdgcn_mfma_f32_16x16x32_bf16(a[tm], bw[2 * dr + 1][ks], bv[dr][tm], 0, 0, 0); } }
#pragma unroll
            for (int tm = 0; tm < 4; ++tm)
#pragma unroll
                for (int j = 0; j < 4; ++j) { const int t = tm * 16 + q * 4 + j; const float xv = *(const LAS float*)(L + XF_OFF + t * XF_PITCH + chl * 4);
                    const float rgt = pg8::sigmoid_f(av[dr][tm][j] + cbr[dr]), igt = pg8::sigmoid_f(bv[dr][tm][j] + cbi[dr]), la = -8.f * rgt * csp[dr], aa = __expf(la), x2 = 2.f * la;
                    const float om = x2 > -0.1f ? -x2 * (1.f + x2 * (0.5f + x2 * (0.16666667f + x2 * (0.041666668f + x2 * 0.0083333338f)))) : 1.f - aa * aa;
                    av[dr][tm][j] = aa; bv[dr][tm][j] = sqrtf(om) * igt * xv; }
#define LRU_TM(i) (dr ? 3 - (i) : (i))
            float TA = 1.f, TB = 0.f;
#pragma unroll
            for (int ti = 0; ti < 4; ++ti) { const int tm = LRU_TM(ti); float sa = 1.f, sb = 0.f;
#pragma unroll
                for (int ji = 0; ji < 4; ++ji) { const int j = LRU_TM(ji); LRU_COMPOSE(sa, sb, av[dr][tm][j], bv[dr][tm][j]); }
#pragma unroll
                for (int qi = 0; qi < 4; ++qi) { const int qq = LRU_TM(qi); const float xa = lane_get(sa, c16 + 16 * qq), xb = lane_get(sb, c16 + 16 * qq); LRU_COMPOSE(TA, TB, xa, xb); } }
            __builtin_amdgcn_sched_barrier(0);
            if (q == 0) __hip_atomic_store(AGG + (((size_t)col * 36 + chunk) * 2 + dr) * 128 + chl, ((unsigned long long)__float_as_uint(TB) << 32) | __float_as_uint(TA), __ATOMIC_RELAXED, __HIP_MEMORY_SCOPE_AGENT);
        }
        asm volatile("s_waitcnt vmcnt(0)" ::: "memory");
        __syncthreads();
        if (tid == 0) __hip_atomic_store(ctl + CW_LRUFLAG + (col * 36 + chunk) * LRU_FLAG_STRIDE, epoch, __ATOMIC_RELAXED, __HIP_MEMORY_SCOPE_AGENT);
        v4u zcur[2];
#pragma unroll
        for (int x = 0; x < 2; ++x) { const int cidx = tid + 512 * x; zcur[x] = *(const v4u*)(P + (rb + t0 + (cidx >> 4)) * NP + C_LZ + blk * 128 + (cidx & 15) * 8); }
        if (w == 0) {
            unsigned* fp = ctl + CW_LRUFLAG + (col * 36 + (lane < 36 ? lane : 0)) * LRU_FLAG_STRIDE; unsigned spins = 0;
            for (;;) { const bool ok = __hip_atomic_load(fp, __ATOMIC_RELAXED, __HIP_MEMORY_SCOPE_AGENT) >= epoch; if (__all(ok)) break;
                __builtin_amdgcn_s_sleep(1);
                if ((++spins & 255u) == 0u) { if (__hip_atomic_load(ctl, __ATOMIC_RELAXED, __HIP_MEMORY_SCOPE_AGENT) != 0u) break; if (spins > (1u << 20)) { if (lane == 0) __hip_atomic_store(ctl, 0x1200u + (unsigned)l, __ATOMIC_RELAXED, __HIP_MEMORY_SCOPE_AGENT); break; } } }
            __builtin_amdgcn_fence(__ATOMIC_ACQUIRE, "agent");
            asm volatile("s_waitcnt vmcnt(0)" ::: "memory"); }
        __syncthreads();
        if (tid < 256) {
            const int dirx = tid >> 7, cl = tid & 127; const unsigned long long* ap = AGG + ((size_t)col * 36 * 2 + dirx) * 128 + cl; float hcar = 0.f, hmine = 0.f;
#pragma unroll 12
            for (int k = 0; k < 36; ++k) { const int cidx = ml::chunk_of(k, dirx); const unsigned long long ab = ap[(size_t)cidx * 256];
                if (cidx == chunk) hmine = hcar;
                hcar = __uint_as_float((unsigned)ab) * hcar + __uint_as_float((unsigned)(ab >> 32)); }
            ((LAS float*)(L + HIN_OFF))[dirx * 128 + cl] = hmine; }
        __syncthreads();
#pragma unroll
        for (int dr = 0; dr < 2; ++dr) {
            float H = ((const LAS float*)(L + HIN_OFF))[dr * 128 + chl];
#pragma unroll
            for (int ti = 0; ti < 4; ++ti) { const int tm = LRU_TM(ti); float sa = 1.f, sb = 0.f;
#pragma unroll
                for (int ji = 0; ji < 4; ++ji) { const int j = LRU_TM(ji); LRU_COMPOSE(sa, sb, av[dr][tm][j], bv[dr][tm][j]); }
                float ea = 1.f, eb = 0.f, ta = 1.f, tb = 0.f;
#pragma unroll
                for (int qi = 0; qi < 4; ++qi) { const int qq = LRU_TM(qi); const float xa = lane_get(sa, c16 + 16 * qq), xb = lane_get(sb, c16 + 16 * qq); if (qq == q) { ea = ta; eb = tb; } LRU_COMPOSE(ta, tb, xa, xb); }
                float hs = ea * H + eb;
#pragma unroll
                for (int ji = 0; ji < 4; ++ji) { const int j = LRU_TM(ji); hs = av[dr][tm][j] * hs + bv[dr][tm][j]; LAS float* yp = (LAS float*)(L + YO_OFF + (tm * 16 + q * 4 + j) * YO_PITCH + chl * 4);
                    if (dr == 0) *yp = hs; else *yp += hs; }
                H = ta * H + tb; }
        }
#undef LRU_TM
        __syncthreads();
        bf16_t* YB0 = WSB(WS_YB);
#pragma unroll
        for (int i = 0; i < 2; ++i) { const int cidx = tid + 512 * i, row = cidx >> 4, cgo = cidx & 15; const size_t rgl = rb + t0 + row;
            const f32x4 y0 = *(const LAS f32x4*)(L + YO_OFF + row * YO_PITCH + cgo * 32), y1 = *(const LAS f32x4*)(L + YO_OFF + row * YO_PITCH + cgo * 32 + 16);
            const v4u z = zcur[i];
            v4u o; o.x = pk2(y0[0] * blo(z.x), y0[1] * bhi(z.x)); o.y = pk2(y0[2] * blo(z.y), y0[3] * bhi(z.y)); o.z = pk2(y1[0] * blo(z.z), y1[1] * bhi(z.z)); o.w = pk2(y1[2] * blo(z.w), y1[3] * bhi(z.w));
            *(v4u*)(YB0 + rgl * DM + blk * 128 + cgo * 8) = o; }
    }
#undef LRU_LOADX
}
template <int LV> __device__ __forceinline__ void p_lru_agg(Frame& F, CArgs* ka, int l) {
    for (int v = F.wg; v < 256; v += F.G) { const int blk = v & 15, c0 = v >> 4;
        lru_run<false, LV>(F, ka, l, blk, 9, [c0](int i, int& b, int& c) { const int x = c0 + 16 * i; b = x / 36; c = x - b * 36; }); }
}
__device__ __forceinline__ void p_lru_final(Frame& F, CArgs* ka, int l, bool need_ctx) {
    for (int v = F.wg; v < 256; v += F.G) { const int b = v >> 6, blk = (v >> 2) & 15, qt = v & 3;
        const int tid = tid_fresh();
        __syncthreads();
        if (tid < 256) { const int dirx = tid >> 7, chl = tid & 127; const float2* AGG = (const float2*)WSF(WS_LA) + ((size_t)b * 36 * 2 + dirx) * DM + blk * 128 + chl;
            LAS float* HIN = (LAS float*)(F.lds + HIN_OFF); float hcar = 0.f;
#pragma unroll 12
            for (int k = 0; k < 36; ++k) { const int cidx = ml::chunk_of(k, dirx); const float2 ab = AGG[(size_t)cidx * 2 * DM];
                const int sl = cidx - qt * 9; if (sl >= 0 && sl < 9) HIN[sl * 256 + dirx * 128 + chl] = hcar;
                hcar = ab.x * hcar + ab.y; } }
        lru_run<true, 0>(F, ka, l, blk, (need_ctx || qt < 3) ? 9 : 5, [b, qt](int i, int& bb, int& c) { bb = b; c = qt * 9 + i; });
    }
}
}

#ifndef GEMM_NHALF
#define GEMM_NHALF false
#endif
#ifndef CONVERT_AHEAD
#define CONVERT_AHEAD 1
#endif
#ifndef DUP_NORM
#define DUP_NORM 0
#endif
#ifndef DUP_KNORM
#define DUP_KNORM 0
#endif
#ifndef LRU_LOOKBACK
#define LRU_LOOKBACK 0
#endif
#ifndef DUP_G1NULL
#define DUP_G1NULL 0
#endif
#ifndef DUP_G1FIX
#define DUP_G1FIX 0
#endif
#ifndef DUP_BAR
#define DUP_BAR 0
#endif
#ifndef DUP_MLOUT
#define DUP_MLOUT 0
#endif
#ifndef DUP_LRU2
#define DUP_LRU2 0
#endif
#ifndef ML_PIPE
#define ML_PIPE 1
#endif
#ifndef ML_VAR
#define ML_VAR 0
#endif
#ifndef LRU_VAR
#define LRU_VAR -1
#endif
#ifndef CONV_SPLIT
#define CONV_SPLIT 0
#endif
#ifndef GEMM_STAGGER
#define GEMM_STAGGER 0
#endif
#ifndef HEAVY_MIX
#define HEAVY_MIX 0
#endif
#ifndef THIN_MIX
#define THIN_MIX 0
#endif
#ifndef CONV_HEAVY
#define CONV_HEAVY 1
#endif
#ifndef HEAVY_ROT
#define HEAVY_ROT 0
#endif
#ifndef PRETOUCH
#define PRETOUCH 1
#endif
#ifndef PT_STRIDE
#define PT_STRIDE 65536
#endif
#ifndef MERGE_CHAIN
#define MERGE_CHAIN 1
#endif
#ifndef CONV_WIN_M
#define CONV_WIN_M 4000
#endif
#ifndef CONV_AHEAD_ITEMS
#define CONV_AHEAD_ITEMS 8000
#endif
#ifndef CONV_HALF
#define CONV_HALF 17168
#endif
static_assert(!(SPLIT_CTX && GEMM_NHALF), "the split context tiles assume 256-column units");
#ifndef ML_TR
#define ML_TR 1
#endif
#ifndef DUP_PRO
#define DUP_PRO 0
#endif
#ifndef DUP_THIN
#define DUP_THIN 0
#endif
#ifndef DUP_G1
#define DUP_G1 0
#endif
#ifndef DUP_HEAVY
#define DUP_HEAVY 0
#endif
#ifndef DUP_ATT
#define DUP_ATT 0
#endif
#ifndef DUP_ML
#define DUP_ML 0
#endif
#ifndef DUP_LRU1
#define DUP_LRU1 0
#endif
#ifndef DUP_G23
#define DUP_G23 0
#endif
__global__ void __launch_bounds__(NWAVES * 64, 2) fwd(Args args) {
    extern __shared__ __attribute__((aligned(16))) unsigned char lds[];
    Frame F;
    F.lds = (LAS unsigned char*)lds; F.ldsg = (char*)lds;
    F.tid = threadIdx.x; F.lane = F.tid & 63; F.wave = __builtin_amdgcn_readfirstlane(F.tid >> 6); F.G = gridDim.x; F.wg = blockIdx.x;
    CArgs* const ka0 = (CArgs*)__builtin_amdgcn_kernarg_segment_ptr();
    unsigned char* ws; { CArgs* ka = ka0; ws = ka->ws; }
    volatile LAS unsigned* MISC = (volatile LAS unsigned*)(F.lds + MISC_OFF);
    if (F.tid < 64) ((LAS unsigned*)(F.lds + MISC_OFF))[F.tid] = 0u;
    __syncthreads();
    const int lo = ka0->ph_lo, hi = ka0->ph_hi;
    XcdBarrier bar; bar.bar = (unsigned*)(ws + WS_CTL) + CW_BAR; bar.x = 0; bar.st = nullptr;
    if (hi - lo > 1) bar = xcd_barrier_post((unsigned*)(ws + WS_CTL) + CW_BAR, MISC + 8);
#define IN(k) (lo <= (k) && (k) < hi)
#define SEAM(k) do { if ((k) + 1 < hi) { xcd_barrier(bar); if (DUP_BAR) xcd_barrier(bar); } } while (0)

    if (IN(0) && PRETOUCH) {
        CArgs* ka = KA(); const size_t gt = (size_t)F.wg * 512 + F.tid, GT = (size_t)F.G * 512; unsigned acc_ = 0u;
#define PT_RANGE(ptr, bytes) for (size_t p = gt; p < (size_t)(bytes) / PT_STRIDE; p += GT) acc_ += __builtin_nontemporal_load((const unsigned*)((const char*)(ptr) + p * PT_STRIDE))
        PT_RANGE(ka->ws, WS_END); PT_RANGE(KIN(8), (size_t)DEPTH * DM * NIN * 4); PT_RANGE(KIN(20), (size_t)DEPTH * 3 * DM * DM * 4); PT_RANGE(KIN(21), (size_t)DEPTH * DM * DM * 4);
        PT_RANGE(KIN(4), (size_t)DEPTH * DM * 3 * DM * 4); PT_RANGE(KIN(0), (size_t)NBATCH * SEQ * DM * 4); PT_RANGE(KIN(2), (size_t)NBATCH * CTXL * DM * 4); PT_RANGE(ka->out, (size_t)NBATCH * SEQ * DM * 4);
#undef PT_RANGE
        asm volatile("" :: "v"(acc_)); }
    if (IN(0)) { for (int rep = 0; rep <= DUP_PRO; ++rep) { const int wv = F.wg * NWAVES + F.wave, nwv = F.G * NWAVES;
            for (int lc = 0; lc < (CONV_HEAVY ? 1 : DEPTH); ++lc) p_convert(F, KA(), lc, wv, nwv, (CONVERT_AHEAD && lc > 0) ? CONV_AHEAD_ITEMS : 0);
            p_prologue(F, KA()); }
        SEAM(0); }
#pragma unroll 1
    for (int l = 0; l < DEPTH; ++l) {
        const int base = 1 + l * PH_PER_LAYER; const bool need_ctx = l < DEPTH - 1;
        if (IN(base + 0)) { p_norm(F, KA(), l); if (DUP_NORM) p_norm(F, KA(), l + 1 <= DEPTH - 1 && l > 0 ? l : l, true); SEAM(base + 0); }
        if (IN(base + 1)) {
            CArgs* ka = KA(); pg8::Gemm g{WSB(WS_H), WSB(WS_WIN) + (size_t)l * NP * DM, MROWS, NP, DM, 0, 0}; pg8::InOrder S; S.init(MROWS, NP, F.G, F.wg, 256, !need_ctx);
            typedef pg8::EpiIn<(long)((WS_X8 - WS_P) / 2)> EpiInT; EpiInT E{WSB(WS_P)};
            if (GEMM_STAGGER && need_ctx) {
                const int nu = (MROWS / 256) * (NP / 256), extra = nu % F.G;
                if (F.wg >= extra) { const unsigned long long t0 = __builtin_amdgcn_s_memrealtime(), dt = (unsigned long long)(((F.wg - extra) >> 3) & 15) * GEMM_STAGGER;
                    while (__builtin_amdgcn_s_memrealtime() - t0 < dt) __builtin_amdgcn_s_sleep(8); } }
            pg8::gemm_phase<EpiInT, pg8::InOrder, true, true>(F.lds, g, S, E);
            if (DUP_G1) pg8::gemm_phase<EpiInT, pg8::InOrder, true, true>(F.lds, g, S, E);
            if (DUP_G1NULL) { pg8::EpiNull EN{WSF(WS_ACC)}; pg8::gemm_phase<pg8::EpiNull, pg8::InOrder, true, true>(F.lds, g, S, EN); }
            if (DUP_G1FIX) { pg8::EpiNull EN{WSF(WS_ACC)}; pg8::FixedOrder SF; SF.init(MROWS, NP, F.G, F.wg); pg8::gemm_phase<pg8::EpiNull, pg8::FixedOrder, true, true>(F.lds, g, SF, EN); }
            if (need_ctx) {
                const int nu = (MROWS / 256) * (NP / 256), extra = nu % F.G;
                if (F.wg >= extra) { p_gates(F, KA(), l, F.wg - extra, F.G - extra);
                    if (CONVERT_AHEAD && l + 1 < DEPTH) p_convert(F, KA(), l + 1, (F.wg - extra) * NWAVES + F.wave, (F.G - extra) * NWAVES, 0, CONV_SPLIT); } }
            SEAM(base + 1);
        }
        if (IN(base + 2)) { if (!need_ctx) p_gates(F, KA(), l, F.wg, F.G); p_knorm(F, KA(), l); if (DUP_KNORM) p_knorm(F, KA(), l, true);
#if USE_NAIVE_LRU
            p_lru_gates_naive(F, KA(), l);
#endif
            SEAM(base + 2); }
        if (IN(base + 3)) {
#define ML_UNITS() do { for (int v = F.wg; v < 256; v += F.G) {    \
                const int u = (F.G % 8 == 0) ? (((v & 7) * 8 + ((v >> 3) >> 2)) * 4 + ((v >> 3) & 3)) : v; \
                if (ML_TR) ml::mlstm_unit_tr(F, KA(), u, need_ctx); else ml::mlstm_unit_pipe<0>(F, KA(), u, need_ctx); if (ML_VAR) ml::mlstm_unit_pipe<ML_VAR>(F, KA(), u, need_ctx); } } while (0)
            if (HEAVY_MIX && (F.wg & 1)) ML_UNITS();
#define CONV_H() do { if (CONV_HEAVY && l + 1 < DEPTH) { __syncthreads(); p_convert(F, KA(), l + 1, F.wg * NWAVES + F.wave, F.G * NWAVES, CONV_AHEAD_ITEMS, 1 << 30); __syncthreads(); } } while (0)
            if (!((F.wg >> 3) & 1)) CONV_H();
#if HEAVY_ROT
            { const int rot = (F.wg >> 3) % 3;
#pragma unroll 1
              for (int sl = 0; sl < 3; ++sl) { const int k = (sl + rot) % 3;
                  __syncthreads();
                  if (k == 0) p_attention(F, KA(), l, need_ctx);
                  else if (k == 1) ML_UNITS();
                  else lru::p_lru_agg<0>(F, KA(), l); }
              __syncthreads(); }
#else
            for (int r2 = 0; r2 <= DUP_ATT; ++r2) p_attention(F, KA(), l, need_ctx);
            if (!(HEAVY_MIX && (F.wg & 1))) ML_UNITS();
            lru::p_lru_agg<0>(F, KA(), l); if (LRU_VAR >= 0) lru::p_lru_agg<(LRU_VAR >= 0 ? LRU_VAR : 0)>(F, KA(), l);
#endif
#undef ML_UNITS
            if ((F.wg >> 3) & 1) CONV_H();
#undef CONV_H
            SEAM(base + 3); }
        if (IN(base + 4)) { for (int rep = 0; rep <= DUP_THIN; ++rep) {
            const bool lru_first = THIN_MIX && ((F.wg >> 3) & 1);
            if (!lru_first) { for (int r2 = 0; r2 <= DUP_MLOUT; ++r2) p_mlout(F, KA(), l, need_ctx); }
#if USE_NAIVE_LRU
            p_lru_combine_naive(F, KA());
#else
#if !LRU_LOOKBACK
            lru::p_lru_final(F, KA(), l, need_ctx); if (DUP_LRU2) lru::p_lru_final(F, KA(), l, need_ctx);
#endif
#endif
            if (lru_first) p_mlout(F, KA(), l, need_ctx);
            }
            SEAM(base + 4); }
        if (IN(base + 5)) {
            CArgs* ka = KA(); pg8::Gemm g{WSB(WS_YB), WSB(WS_WBR) + (size_t)l * 3 * DM * DM, MROWS, DM, DM, (size_t)MROWS * DM * 2, (size_t)DM * DM * 2}; pg8::MergeOrder S; S.init(MROWS, DM, F.G, F.wg, GEMM_NHALF ? 128 : 256, !need_ctx);
#if MERGE_CHAIN
            pg8::EpiMergeC E{WSB(WS_P), WSB(WS_G2)};
            pg8::gemm_phase<pg8::EpiMergeC, pg8::MergeOrder, true, true, false>(F.lds, g, S, E);
#else
            pg8::EpiMerge<GEMM_NHALF> E{WSB(WS_P), WSF(WS_ACC), WSB(WS_G2)};
            pg8::gemm_phase<pg8::EpiMerge<GEMM_NHALF>, pg8::MergeOrder, true, true, GEMM_NHALF>(F.lds, g, S, E);
#endif
            if (DUP_G23) pg8::gemm_phase<decltype(E), pg8::MergeOrder, true, true, false>(F.lds, g, S, E);
            if (CONVERT_AHEAD && l + 1 < DEPTH) {
                const int ntile_m = (MROWS / 256) * (DM / (GEMM_NHALF ? 128 : 256));
                if (SPLIT_CTX && F.G == 256) { const int busy2 = 96; if (F.wg >= busy2) p_convert(F, KA(), l + 1, (F.wg - busy2) * NWAVES + F.wave, (F.G - busy2) * NWAVES, 0, CONV_WIN_M); }
                else { const int ntile = ntile_m, busy2 = (ntile > F.G && ntile < 2 * F.G) ? ntile - F.G : 0;
                    if (F.wg >= busy2) p_convert(F, KA(), l + 1, (F.wg - busy2) * NWAVES + F.wave, (F.G - busy2) * NWAVES, 0, CONV_AHEAD_ITEMS); } }
            SEAM(base + 5);
        }
        if (IN(base + 6)) {
            CArgs* ka = KA(); pg8::Gemm g{WSB(WS_G2), WSB(WS_WOUT) + (size_t)l * DM * DM, MROWS, DM, DM, (size_t)MROWS * DM * 2, 0}; pg8::SplitOutOrder S; S.init(MROWS, DM, F.G, F.wg, GEMM_NHALF ? 128 : 256, !need_ctx);
#if Y_BF16
            pg8::EpiY16 E{WSB(WS_Y), (size_t)MROWS * DM};
#else
            pg8::EpiF32<GEMM_NHALF> E{WSF(WS_Y), DM, (size_t)MROWS * DM};
#endif
            pg8::gemm_phase<decltype(E), pg8::SplitOutOrder, true, true, false>(F.lds, g, S, E);
            if (DUP_G23) pg8::gemm_phase<decltype(E), pg8::SplitOutOrder, true, true, false>(F.lds, g, S, E);
            const int ntile_o = (MROWS / 256) * (DM / (GEMM_NHALF ? 128 : 256));
            if (CONVERT_AHEAD && l + 1 < DEPTH && SPLIT_CTX && F.G == 256) { const int busy2 = 96; (void)ntile_o;
                if (F.wg >= busy2) p_convert(F, KA(), l + 1, (F.wg - busy2) * NWAVES + F.wave, (F.G - busy2) * NWAVES, CONV_WIN_M, CONV_AHEAD_ITEMS); }
            SEAM(base + 6);
        }
    }
    if (IN(N_PHASES - 1)) p_norm(F, KA(), DEPTH);
#undef IN
#undef SEAM
}

extern "C" void kernel_launch(void* const* d_in, const int* in_sizes, int n_in, void* d_out, int out_size, void* d_ws, size_t ws_size, hipStream_t stream) {
    static int grid = 0;
    if (grid == 0) {
        if (n_in != 22 || in_sizes[0] != NBATCH * SEQ * DM || out_size != NBATCH * SEQ * DM || ws_size < WS_END) {
            fprintf(stderr, "kernel_launch: unexpected shapes: n_in %d in0 %d out %d ws %zu (need %zu)\n", n_in, n_in > 0 ? in_sizes[0] : -1, out_size, ws_size, (size_t)WS_END); grid = -1; return; }
        int dev = 0, cus = 0, per_cu = 0;
        if (hipGetDevice(&dev) != hipSuccess || hipDeviceGetAttribute(&cus, hipDeviceAttributeMultiprocessorCount, dev) != hipSuccess) { fprintf(stderr, "kernel_launch: device query failed\n"); grid = -1; return; }
        if (hipFuncSetAttribute((const void*)fwd, hipFuncAttributeMaxDynamicSharedMemorySize, LDS_BYTES) != hipSuccess) { fprintf(stderr, "kernel_launch: hipFuncSetAttribute failed\n"); grid = -1; return; }
        if (hipOccupancyMaxActiveBlocksPerMultiprocessor(&per_cu, (const void*)fwd, NWAVES * 64, LDS_BYTES) != hipSuccess || per_cu < 1)
            fprintf(stderr, "kernel_launch: note: occupancy query reports %d workgroups per CU\n", per_cu);
        (void)hipGetLastError();
        grid = cus;
    }
    if (grid < 0) return;
    if (hipMemsetAsync((char*)d_ws + WS_CTL, 0, CTL_ZERO_BYTES, stream) != hipSuccess) { fprintf(stderr, "kernel_launch: memset failed\n"); return; }
    Args a{};
    for (int i = 0; i < 22; ++i) a.in[i] = (const float*)d_in[i];
    a.out = (float*)d_out; a.ws = (unsigned char*)d_ws;
    if (MK_N_LAUNCHES == 1) { a.ph_lo = 0; a.ph_hi = N_PHASES; hipLaunchKernelGGL(fwd, dim3(grid), dim3(NWAVES * 64), LDS_BYTES, stream, a); }
    else for (int k = 0; k < N_PHASES; ++k) { a.ph_lo = k; a.ph_hi = k + 1; hipLaunchKernelGGL(fwd, dim3(grid), dim3(NWAVES * 64), LDS_BYTES, stream, a); }
    const hipError_t le = hipPeekAtLastError();
    if (le != hipSuccess) fprintf(stderr, "kernel_launch: launch failed: %s\n", hipGetErrorName(le));
}
```

```cpp
#include <hip/hip_runtime.h>
#include <hip/hip_bf16.h>
#include <cstdio>
#include <cstdint>

constexpr int DM = 2048, NBATCH = 4, SEQ = 2048, CTXL = 256, TPB = SEQ + CTXL  , MROWS = NBATCH * TPB  , DEPTH = 4;
constexpr int NIN = 25632, NP = 25600;
constexpr int C_LX = 0, C_LZ = 2048, C_MQ = 4096, C_MK = 6144, C_MV = 8192, C_MO = 10240, C_MZ = 12288, C_AQ = 14336, C_AK = 16384, C_AV = 16896, C_AZ = 17408, C_MG = 19456;
constexpr float EPS = 1e-6f;
#ifndef SPLIT_CTX
#define SPLIT_CTX 1
#endif
#ifndef Y_BF16
#define Y_BF16 1
#endif

namespace pg8 {
#define PG8_LAS __attribute__((address_space(3)))
typedef unsigned short bf16_t;
typedef short bf16x8 __attribute__((ext_vector_type(8)));
typedef float f32x4 __attribute__((ext_vector_type(4)));
typedef unsigned u32x4 __attribute__((ext_vector_type(4)));
constexpr int BM = 256, BK = 64, HALF = 128, HTB = HALF * BK * 2  , STAGE_BYTES = 8 * HTB, NXCD = 8, WGM = 8;

__host__ __device__ __forceinline__ int lds_byte(int r, int c) { const int st = (r >> 4) * 2 + (c >> 5), rr = r & 15, cc = c & 31, ob = rr * 64 + cc * 2; return st * 1024 + (ob ^ (((ob >> 9) & 1) << 5)); }
__host__ __device__ __forceinline__ void stage_rc(int b, int& R, int& C) { const int st = b / 1024, sb = b % 1024, swz = sb ^ (((sb >> 9) & 1) << 5); R = (st >> 1) * 16 + swz / 64; C = (st & 1) * 32 + (swz % 64) / 2; }
__host__ __device__ __forceinline__ int perm32(int rho) { const int n = rho >> 4, i = rho & 15; return 8 * (i >> 2) + 4 * n + (i & 3); }

struct Unit { int pm, pn, z, sp; };
struct Gemm { const bf16_t* A; const bf16_t* Bt; int M, N, K; size_t zA, zB; };

struct StaticOrder {
    int nM, nN, nwg, G, c; bool lat;
    __host__ __device__ void init(int M, int N, int G_, int c_, int tileN = BM, bool lat_ = false) { lat = lat_; nM = lat ? (M / BM) * 8 / 9 : M / BM; nN = N / tileN; nwg = nM * nN; G = G_; c = c_; }
    __host__ __device__ bool map_x(long L, Unit& u, int nM_, int nwg_, bool lat_) const {
        if (L >= nwg_) return false;
        int wgid = (int)L; { const int q = nwg_ / NXCD, r = nwg_ % NXCD, xcd = wgid % NXCD, off = wgid / NXCD; wgid = (xcd < r ? xcd * (q + 1) : r * (q + 1) + (xcd - r) * q) + off; }
        const int nig = WGM * nN, gid = wgid / nig, fm = gid * WGM, gsz = (nM_ - fm) < WGM ? (nM_ - fm) : WGM;
        u.pm = fm + ((wgid % nig) % gsz); u.pn = (wgid % nig) / gsz; u.z = 0; u.sp = 0; if (lat_) u.pm = (u.pm >> 3) * 9 + (u.pm & 7); return true;
    }
    __host__ __device__ bool map(long L, Unit& u) const { return map_x(L, u, nM, nwg, lat); }
    __host__ __device__ bool next(int i, Unit& u) const { return map((long)i * G + c, u); }
    __device__ __forceinline__ void a_ready(const Unit&) const {}
    __device__ __forceinline__ void done(const Unit&) const {}
};
struct InOrder : StaticOrder {
    __host__ __device__ bool next(int i, Unit& u) const { const long L = (long)i * G + c; if (L < nwg) return map(L, u);
        if (!lat) return false; const int idx = (int)(L - nwg); if (idx >= 4 * 28) return false;
        const int bb = idx / 28, j = idx - bb * 28; u.pm = 9 * bb + 8; u.z = 0; u.sp = 0; u.pn = j < 8 ? j : j < 16 ? 16 + j : j < 24 ? 16 + j : j < 26 ? 40 + j : 40 + j; return true; }
};
struct FixedOrder : StaticOrder {
    __host__ __device__ bool next(int i, Unit& u) const { if (!StaticOrder::next(i, u)) return false; u.pm = 0; u.pn = 0; return true; }
};
struct MergeOrder : StaticOrder {
    __host__ __device__ bool split_ok() const { return SPLIT_CTX && !lat && nM == 36 && nN == 8 && G == 256; }
    __host__ __device__ bool next(int i, Unit& u) const {
        if (!split_ok()) { const int it = i / 3; if (!StaticOrder::next(it, u)) return false; u.z = i - 3 * it; return true; }
        if (i < 3) { if (!map_x((long)c, u, 32, 256, true)) return false; u.z = i; return true; }
        if (i > 3 || c >= 96) return false;
        const int s = c & 31; u.pm = 9 * (s >> 3) + 8; u.pn = s & 7; u.z = c >> 5; u.sp = 1; return true; }
};
struct SplitOutOrder : StaticOrder {
    __host__ __device__ bool split_ok() const { return SPLIT_CTX && !lat && nM == 36 && nN == 8 && G == 256; }
    __host__ __device__ bool next(int i, Unit& u) const {
        if (!split_ok()) return StaticOrder::next(i, u);
        if (i == 0) return map_x((long)c, u, 32, 256, true);
        if (i > 1 || c >= 96) return false;
        const int s = c & 31; u.pm = 9 * (s >> 3) + 8; u.pn = s & 7; u.z = 1 + (c >> 5); u.sp = 1; return true; }
};
__device__ __forceinline__ unsigned cvt_pk_bf16(float lo, float hi) { unsigned r; asm volatile("v_cvt_pk_bf16_f32 %0, %1, %2" : "=v"(r) : "v"(lo), "v"(hi)); return r; }
__device__ __forceinline__ float bflo(unsigned w) { return __uint_as_float(w << 16); }
__device__ __forceinline__ float bfhi(unsigned w) { return __uint_as_float(w & 0xffff0000u); }
__device__ __forceinline__ float sigmoid_f(float x) { return __builtin_amdgcn_rcpf(1.f + __expf(-x)); }

template <bool NHALF> struct EpiF32 {
    static constexpr bool PERM = false, AFTER_DRAIN = false;
    float* C; int ldc; size_t slab;
    __device__ __forceinline__ void operator()(const f32x4 (&acc)[2][2][4][2], const Unit& u, int wr, int wc, int fr, int fq) const {
        const int row0 = u.pm * BM + wr * 64 + fr, col0 = u.pn * (NHALF ? HALF : BM) + wc * 32 + 4 * fq;
        float* Cb = C + (u.sp ? (size_t)(u.z - 1) * slab : (size_t)0);
#pragma unroll
        for (int ai = 0; ai < 2; ++ai)
#pragma unroll
            for (int m = 0; m < 4; ++m) { float* rowp = Cb + (size_t)(row0 + ai * HALF + m * 16) * ldc + col0;
#pragma unroll
                for (int bj = 0; bj < (NHALF ? 1 : 2); ++bj)
#pragma unroll
                    for (int n = 0; n < 2; ++n) *(f32x4*)(rowp + bj * HALF + n * 16) = acc[ai][bj][m][n]; }
    }
};
struct EpiNull {
    static constexpr bool PERM = true, AFTER_DRAIN = false; float* sink;
    __device__ __forceinline__ void operator()(const f32x4 (&acc)[2][2][4][2], const Unit& u, int wr, int wc, int fr, int fq) const {
        float s = 0.f;
#pragma unroll
        for (int ai = 0; ai < 2; ++ai)
#pragma unroll
            for (int bj = 0; bj < 2; ++bj)
#pragma unroll
                for (int m = 0; m < 4; ++m)
#pragma unroll
                    for (int n = 0; n < 2; ++n) s += acc[ai][bj][m][n][0] + acc[ai][bj][m][n][1] + acc[ai][bj][m][n][2] + acc[ai][bj][m][n][3];
        if (s == 123.456f) sink[0] = s; }
};
template <long X8D> struct EpiIn {
    static constexpr bool PERM = true, AFTER_DRAIN = false;
    bf16_t* O;
    __device__ __forceinline__ void operator()(const f32x4 (&acc)[2][2][4][2], const Unit& u, int wr, int wc, int fr, int fq) const {
        const int pn = u.pn;
        int act = 0;
        if ((pn >= 8 && pn < 16) || (pn >= 48 && pn < 56) || (pn >= 68 && pn < 76)) act = 1;
        else if ((pn >= 40 && pn < 48) || pn >= 76) act = 2;
        else if (pn >= 24 && pn < 32) act = 3;
        const bool blocked = pn >= 16 && pn < 40;
        bf16_t* base = blocked ? O + X8D + (size_t)((pn - 16) >> 3) * MROWS * DM + ((size_t)((u.pm / 9) * 8 + ((pn - 16) & 7)) * 36 + (u.pm % 9) * 4) * (32 * 64 * 8)
                               : O + (size_t)u.pm * BM * NP + (size_t)pn * BM;
        const unsigned lane_off = blocked ? (unsigned)(wr * (32 * 64 * 8) + ((wc * 4 + fq) * 64 + fr) * 8) : (unsigned)((wr * 64 + fr) * NP + wc * 32 + 8 * fq);
        const unsigned sa = blocked ? 2u * 32 * 64 * 8 : (unsigned)HALF * NP, sm = blocked ? 16u * 8 : 16u * NP, sb = blocked ? 16u * 64 * 8 : (unsigned)HALF;
#pragma unroll
        for (int ai = 0; ai < 2; ++ai)
#pragma unroll
            for (int m = 0; m < 4; ++m) {
#pragma unroll
                for (int bj = 0; bj < 2; ++bj) { f32x4 v0 = acc[ai][bj][m][0], v1 = acc[ai][bj][m][1];
                    if (act == 1) {
#pragma unroll
                        for (int j = 0; j < 4; ++j) { v0[j] = v0[j] * sigmoid_f(v0[j]); v1[j] = v1[j] * sigmoid_f(v1[j]); } }
                    else if (act == 2) {
#pragma unroll
                        for (int j = 0; j < 4; ++j) { v0[j] = sigmoid_f(v0[j]); v1[j] = sigmoid_f(v1[j]); } }
                    else if (act == 3) { v0 = v0 * 0.0625f; v1 = v1 * 0.0625f; }
                    u32x4 w; w.x = cvt_pk_bf16(v0[0], v0[1]); w.y = cvt_pk_bf16(v0[2], v0[3]); w.z = cvt_pk_bf16(v1[0], v1[1]); w.w = cvt_pk_bf16(v1[2], v1[3]);
                    *(u32x4*)(base + (lane_off + ai * sa + m * sm + bj * sb)) = w; } }
    }
};
template <bool NHALF> struct EpiMerge {
    static constexpr bool PERM = true, AFTER_DRAIN = false;
    const bf16_t* P; float* ACC; bf16_t* G2;
    __device__ __forceinline__ void operator()(const f32x4 (&acc)[2][2][4][2], const Unit& u, int wr, int wc, int fr, int fq) const {
        const int row0 = u.pm * BM + wr * 64 + fr, col0 = u.pn * (NHALF ? HALF : BM) + wc * 32 + 8 * fq, z = u.z;
#pragma unroll
        for (int ai = 0; ai < 2; ++ai)
#pragma unroll
            for (int m = 0; m < 4; ++m) { const size_t r = (size_t)(row0 + ai * HALF + m * 16);
#pragma unroll
                for (int bj = 0; bj < (NHALF ? 1 : 2); ++bj) { const int c = col0 + bj * HALF;
                    const u32x4 g = *(const u32x4*)(P + r * NP + C_MG + z * DM + c);
                    f32x4 v0 = acc[ai][bj][m][0], v1 = acc[ai][bj][m][1];
                    v0[0] *= bflo(g.x); v0[1] *= bfhi(g.x); v0[2] *= bflo(g.y); v0[3] *= bfhi(g.y);
                    v1[0] *= bflo(g.z); v1[1] *= bfhi(g.z); v1[2] *= bflo(g.w); v1[3] *= bfhi(g.w);
                    if (u.sp) { u32x4 w; w.x = cvt_pk_bf16(v0[0], v0[1]); w.y = cvt_pk_bf16(v0[2], v0[3]); w.z = cvt_pk_bf16(v1[0], v1[1]); w.w = cvt_pk_bf16(v1[2], v1[3]);
                        *(u32x4*)(G2 + (size_t)(1 + z) * MROWS * DM + r * DM + c) = w;
                        continue; }
                    float* ap = ACC + r * DM + c;
                    if (z > 0) { v0 = v0 + *(const f32x4*)ap; v1 = v1 + *(const f32x4*)(ap + 4); }
                    if (z < 2) { *(f32x4*)ap = v0; *(f32x4*)(ap + 4) = v1; }
                    else { u32x4 w; w.x = cvt_pk_bf16(v0[0], v0[1]); w.y = cvt_pk_bf16(v0[2], v0[3]); w.z = cvt_pk_bf16(v1[0], v1[1]); w.w = cvt_pk_bf16(v1[2], v1[3]);
                        *(u32x4*)(G2 + r * DM + c) = w; } } }
    }
};
struct EpiMergeC {
    static constexpr bool PERM = true, AFTER_DRAIN = false, CHAIN = true;
    static constexpr int DEPTH_PF = 4;
    const bf16_t* P; bf16_t* G2;
    __device__ __forceinline__ static bool keep(const Unit& u) { return !u.sp && u.z < 2; }
    __device__ __forceinline__ static void unpack8(const u32x4 g, float (&s)[8]) { s[0] = bflo(g.x); s[1] = bfhi(g.x); s[2] = bflo(g.y); s[3] = bfhi(g.y); s[4] = bflo(g.z); s[5] = bfhi(g.z); s[6] = bflo(g.w); s[7] = bfhi(g.w); }
    __device__ __forceinline__ void operator()(f32x4 (&acc)[2][2][4][2], const Unit& u, int wr, int wc, int fr, int fq) const {
        const int row0 = u.pm * BM + wr * 64 + fr, col0 = u.pn * BM + wc * 32 + 8 * fq, z = u.z;
        constexpr float FLOOR = 1e-12f;
        const bf16_t* gp0 = P + (size_t)row0 * NP + C_MG + z * DM + col0;
        const bool chain = !u.sp && z < 2;
        bf16_t* O = G2 + (u.sp ? (size_t)(1 + z) * MROWS * DM : (size_t)0) + (size_t)row0 * DM + col0;
        u32x4 gq[DEPTH_PF], hq[DEPTH_PF];
#define EMC_OFF(t) ((size_t)((((t) >> 3) & 1) * HALF + (((t) >> 1) & 3) * 16) * NP + ((t) & 1) * HALF)
#define EMC_LOAD(t) do { gq[(t) % DEPTH_PF] = *(const u32x4*)(gp0 + EMC_OFF(t)); if (chain) hq[(t) % DEPTH_PF] = *(const u32x4*)(gp0 + EMC_OFF(t) + DM); } while (0)
#pragma unroll
        for (int t = 0; t < DEPTH_PF - 1; ++t) EMC_LOAD(t);
#pragma unroll
        for (int t = 0; t < 16; ++t) { const int ai = (t >> 3) & 1, m = (t >> 1) & 3, bj = t & 1;
            if (t + DEPTH_PF - 1 < 16) EMC_LOAD(t + DEPTH_PF - 1);
            float s[8]; unpack8(gq[t % DEPTH_PF], s);
            if (chain) { float d[8]; unpack8(hq[t % DEPTH_PF], d);
#pragma unroll
                for (int j = 0; j < 8; ++j) s[j] = fmaxf(s[j], FLOOR) * __builtin_amdgcn_rcpf(fmaxf(d[j], FLOOR));
#pragma unroll
                for (int j = 0; j < 4; ++j) { acc[ai][bj][m][0][j] *= s[j]; acc[ai][bj][m][1][j] *= s[4 + j]; } }
            else { if (!u.sp) {
#pragma unroll
                    for (int j = 0; j < 8; ++j) s[j] = fmaxf(s[j], FLOOR); }
                f32x4 v0 = acc[ai][bj][m][0], v1 = acc[ai][bj][m][1];
#pragma unroll
                for (int j = 0; j < 4; ++j) { v0[j] *= s[j]; v1[j] *= s[4 + j]; }
                u32x4 w; w.x = cvt_pk_bf16(v0[0], v0[1]); w.y = cvt_pk_bf16(v0[2], v0[3]); w.z = cvt_pk_bf16(v1[0], v1[1]); w.w = cvt_pk_bf16(v1[2], v1[3]);
                *(u32x4*)(O + (size_t)(ai * HALF + m * 16) * DM + bj * HALF) = w; } }
#undef EMC_OFF
#undef EMC_LOAD
    }
};
struct EpiY16 {
    static constexpr bool PERM = true, AFTER_DRAIN = false;
    bf16_t* Y; size_t slab;
    __device__ __forceinline__ void operator()(const f32x4 (&acc)[2][2][4][2], const Unit& u, int wr, int wc, int fr, int fq) const {
        const int row0 = u.pm * BM + wr * 64 + fr, col0 = u.pn * BM + wc * 32 + 8 * fq;
        bf16_t* Yb = Y + (u.sp ? (size_t)(u.z - 1) * slab : (size_t)0);
#pragma unroll
        for (int ai = 0; ai < 2; ++ai)
#pragma unroll
            for (int m = 0; m < 4; ++m) { bf16_t* rowp = Yb + (size_t)(row0 + ai * HALF + m * 16) * DM + col0;
#pragma unroll
                for (int bj = 0; bj < 2; ++bj) { const f32x4 v0 = acc[ai][bj][m][0], v1 = acc[ai][bj][m][1];
                    u32x4 w; w.x = cvt_pk_bf16(v0[0], v0[1]); w.y = cvt_pk_bf16(v0[2], v0[3]); w.z = cvt_pk_bf16(v1[0], v1[1]); w.w = cvt_pk_bf16(v1[2], v1[3]);
                    *(u32x4*)(rowp + bj * HALF) = w; } }
    }
};
template <class T, class = void> struct epi_chain { static constexpr bool value = false; };
template <class T> struct epi_chain<T, decltype((void)T::CHAIN)> { static constexpr bool value = T::CHAIN; };
template <class Epi, class Sched, bool ALIGN_EPI = false, bool SP2 = false, bool NHALF = false>
__device__ __forceinline__ void gemm_phase(PG8_LAS unsigned char* lds, const Gemm g, const Sched& S, const Epi& E) {
    int tid = threadIdx.x; asm volatile("" : "+v"(tid));
    const int wid = __builtin_amdgcn_readfirstlane(tid >> 6), lane = tid & 63, wr = wid >> 2, wc = wid & 3, fr = lane & 15, fq = lane >> 4;
    const int K = g.K, nt = K / BK;
    unsigned voffA[2], voffB[2];
#pragma unroll
    for (int i = 0; i < 2; ++i) { int R, C; stage_rc(tid * 16 + i * 8192, R, C); const int Rb = Epi::PERM ? ((R & ~31) + perm32(R & 31)) : R;
        voffA[i] = (unsigned)(R * K + C) * 2u; voffB[i] = (unsigned)(Rb * K + C) * 2u; }
    const size_t kstep = (size_t)(BK * 2);
    const size_t hstep = (size_t)HALF * K * 2;
    const size_t tstep = 2 * hstep;
    const size_t hsB = NHALF ? 0 : hstep, tstepB = NHALF ? hstep : tstep; static_assert(!NHALF || SP2, "NHALF is implemented for the SP2 loop");
    const unsigned ldsw = (unsigned)wid * 1024u;
    const int aoff = lds_byte(wr * 64 + fr, fq * 8), boff = lds_byte(wc * 32 + fr, fq * 8);
#define PG8_SA(b, h) (((b) * 2 + (h)) * HTB)
#define PG8_SB(b, h) ((4 + (b) * 2 + (h)) * HTB)
#define PG8_STAGE(bufoff, gbase, voff) do { _Pragma("unroll") for (int _i = 0; _i < 2; ++_i) \
        __builtin_amdgcn_global_load_lds((const unsigned*)((const char*)(gbase) + (voff)[_i]), (PG8_LAS unsigned*)(lds + (bufoff) + ldsw + _i * 8192), 16, 0, 0); } while (0)
#define PG8_LDA(dst, b, h) do { _Pragma("unroll") for (int m = 0; m < 4; ++m) _Pragma("unroll") for (int k = 0; k < 2; ++k) dst[m][k] = *(const PG8_LAS bf16x8*)(lds + PG8_SA(b, h) + aoff + m * 2048 + k * 1024); } while (0)
#define PG8_LDB(dst, b, h) do { _Pragma("unroll") for (int n = 0; n < 2; ++n) _Pragma("unroll") for (int k = 0; k < 2; ++k) dst[n][k] = *(const PG8_LAS bf16x8*)(lds + PG8_SB(b, h) + boff + n * 2048 + k * 1024); } while (0)
#define PG8_MMA(ai, bj, At, Bt) do { __builtin_amdgcn_s_setprio(1); _Pragma("unroll") for (int m = 0; m < 4; ++m) _Pragma("unroll") for (int n = 0; n < 2; ++n) _Pragma("unroll") for (int k = 0; k < 2; ++k) \
        acc[ai][bj][m][n] = __builtin_amdgcn_mfma_f32_16x16x32_bf16(Bt[n][k], At[m][k], acc[ai][bj][m][n], 0, 0, 0); __builtin_amdgcn_s_setprio(0); } while (0)
#define PG8_WAIT_V(n) asm volatile("s_waitcnt vmcnt(" #n ")" ::: "memory")
#define PG8_WAIT_L(n) asm volatile("s_waitcnt lgkmcnt(" #n ")" ::: "memory")
#define PG8_BAR __builtin_amdgcn_s_barrier()
#define PG8_SCHED __builtin_amdgcn_sched_barrier(0)
    Unit cur, nxt; int ui = 0;
    if (!S.next(0, cur)) return;
    f32x4 acc[2][2][4][2];
#pragma unroll
    for (int a = 0; a < 2; ++a)
#pragma unroll
        for (int b = 0; b < 2; ++b)
#pragma unroll
            for (int m = 0; m < 4; ++m)
#pragma unroll
                for (int n = 0; n < 2; ++n) acc[a][b][m][n] = (f32x4){0.f, 0.f, 0.f, 0.f};
    bf16x8 At[4][2], B0[2][2], B1[2][2];
    const char* cA = (const char*)g.A + (size_t)cur.z * g.zA + (size_t)cur.pm * tstep; const char* cB = (const char*)g.Bt + (size_t)cur.z * g.zB + (size_t)cur.pn * tstepB;
    S.a_ready(cur);
    if constexpr (SP2) {
        PG8_STAGE(PG8_SB(0, 0), cB, voffB); PG8_STAGE(PG8_SB(0, 1), cB + hsB, voffB); PG8_STAGE(PG8_SA(0, 0), cA, voffA); PG8_STAGE(PG8_SA(0, 1), cA + hstep, voffA);
        if (wr == 1) PG8_BAR;
        PG8_WAIT_V(2); PG8_BAR;
        PG8_STAGE(PG8_SB(1, 0), cB + kstep, voffB); PG8_STAGE(PG8_SA(1, 0), cA + kstep, voffA); PG8_STAGE(PG8_SB(1, 1), cB + hsB + kstep, voffB);
        PG8_WAIT_V(6); PG8_BAR;
    } else {
        PG8_STAGE(PG8_SB(0, 0), cB, voffB); PG8_STAGE(PG8_SA(0, 0), cA, voffA); PG8_STAGE(PG8_SB(0, 1), cB + hstep, voffB); PG8_STAGE(PG8_SA(0, 1), cA + hstep, voffA);
        if (wr == 1) PG8_BAR;
        PG8_WAIT_V(4); PG8_BAR;
        PG8_STAGE(PG8_SB(1, 0), cB + kstep, voffB); PG8_STAGE(PG8_SA(1, 0), cA + kstep, voffA); PG8_STAGE(PG8_SB(1, 1), cB + hstep + kstep, voffB);
        PG8_WAIT_V(6); PG8_BAR;
    }
    for (;;) {
        const bool has_next = S.next(ui + 1, nxt);
        const char* nA = has_next ? (const char*)g.A + (size_t)nxt.z * g.zA + (size_t)nxt.pm * tstep : cA; const char* nB = has_next ? (const char*)g.Bt + (size_t)nxt.z * g.zB + (size_t)nxt.pn * tstepB : cB;
        for (int t = 0; t < nt; t += 2) {
            const bool last = (t == nt - 2);
            const char* a1 = cA + (size_t)(t + 1) * kstep;
            const char* a2 = last ? nA : cA + (size_t)(t + 2) * kstep; const char* b2 = last ? nB : cB + (size_t)(t + 2) * kstep;
            const char* a3 = a2 + kstep; const char* b3 = b2 + kstep;
            if (last && has_next) S.a_ready(nxt);
            if constexpr (SP2) {
            PG8_LDB(B0, 0, 0); if constexpr (!NHALF) PG8_LDB(B1, 0, 1); PG8_SCHED; PG8_LDA(At, 0, 0); PG8_STAGE(PG8_SA(1, 1), a1 + hstep, voffA);
            PG8_WAIT_V(8); PG8_WAIT_L(0); PG8_BAR; PG8_MMA(0, 0, At, B0); if constexpr (!NHALF) PG8_MMA(0, 1, At, B1); PG8_BAR; PG8_SCHED;
            PG8_LDA(At, 0, 1); PG8_STAGE(PG8_SB(0, 0), b2, voffB); PG8_STAGE(PG8_SB(0, 1), b2 + hsB, voffB); PG8_STAGE(PG8_SA(0, 0), a2, voffA);
            PG8_WAIT_V(8); PG8_WAIT_L(0); PG8_BAR; PG8_MMA(1, 0, At, B0); if constexpr (!NHALF) PG8_MMA(1, 1, At, B1); PG8_BAR; PG8_SCHED;
            PG8_LDB(B0, 1, 0); if constexpr (!NHALF) PG8_LDB(B1, 1, 1); PG8_SCHED; PG8_LDA(At, 1, 0); PG8_STAGE(PG8_SA(0, 1), a2 + hstep, voffA);
            PG8_WAIT_V(8); PG8_WAIT_L(0); PG8_BAR; PG8_MMA(0, 0, At, B0); if constexpr (!NHALF) PG8_MMA(0, 1, At, B1); PG8_BAR; PG8_SCHED;
            PG8_LDA(At, 1, 1); PG8_STAGE(PG8_SB(1, 0), b3, voffB); PG8_STAGE(PG8_SB(1, 1), b3 + hsB, voffB); PG8_STAGE(PG8_SA(1, 0), a3, voffA);
            PG8_WAIT_V(8); PG8_WAIT_L(0); PG8_BAR; PG8_MMA(1, 0, At, B0); if constexpr (!NHALF) PG8_MMA(1, 1, At, B1); PG8_BAR; PG8_SCHED;
            } else {
            PG8_LDB(B0, 0, 0); PG8_SCHED; PG8_LDA(At, 0, 0); PG8_STAGE(PG8_SA(1, 1), a1 + hstep, voffA);
            PG8_WAIT_L(8); PG8_BAR; PG8_WAIT_L(0); PG8_MMA(0, 0, At, B0); PG8_BAR; PG8_SCHED;
            PG8_LDB(B1, 0, 1); PG8_STAGE(PG8_SB(0, 0), b2, voffB);
            PG8_BAR; PG8_WAIT_L(0); PG8_MMA(0, 1, At, B1); PG8_BAR;
            PG8_LDA(At, 0, 1); PG8_STAGE(PG8_SA(0, 0), a2, voffA);
            PG8_BAR; PG8_WAIT_L(0); PG8_MMA(1, 0, At, B0); PG8_BAR; PG8_SCHED;
            PG8_STAGE(PG8_SB(0, 1), b2 + hstep, voffB);
            PG8_WAIT_V(6); PG8_BAR; PG8_MMA(1, 1, At, B1); PG8_BAR;
            PG8_LDB(B0, 1, 0); PG8_SCHED; PG8_LDA(At, 1, 0); PG8_STAGE(PG8_SA(0, 1), a2 + hstep, voffA);
            PG8_WAIT_L(8); PG8_BAR; PG8_WAIT_L(0); PG8_MMA(0, 0, At, B0); PG8_BAR; PG8_SCHED;
            PG8_LDB(B1, 1, 1); PG8_STAGE(PG8_SB(1, 0), b3, voffB);
            PG8_BAR; PG8_WAIT_L(0); PG8_MMA(0, 1, At, B1); PG8_BAR;
            PG8_LDA(At, 1, 1); PG8_STAGE(PG8_SA(1, 0), a3, voffA);
            PG8_BAR; PG8_WAIT_L(0); PG8_MMA(1, 0, At, B0); PG8_BAR; PG8_SCHED;
            PG8_STAGE(PG8_SB(1, 1), b3 + hstep, voffB);
            PG8_WAIT_V(6); PG8_BAR; PG8_MMA(1, 1, At, B1); PG8_BAR;
            }
        }
        if constexpr (ALIGN_EPI) { if (wr == 0) PG8_BAR; }
        if constexpr (!Epi::AFTER_DRAIN) { E(acc, cur, wr, wc, fr, fq); S.done(cur); }
        if (!has_next) break;
        bool clear = true; if constexpr (epi_chain<Epi>::value) clear = !Epi::keep(cur);
        if (clear) {
#pragma unroll
        for (int a = 0; a < 2; ++a)
#pragma unroll
            for (int b = 0; b < 2; ++b)
#pragma unroll
                for (int m = 0; m < 4; ++m)
#pragma unroll
                    for (int n = 0; n < 2; ++n) acc[a][b][m][n] = (f32x4){0.f, 0.f, 0.f, 0.f};
        }
        cur = nxt; cA = nA; cB = nB; ++ui;
        if constexpr (ALIGN_EPI) { if (wr == 1) PG8_BAR; }
    }
    PG8_WAIT_V(0);
    if constexpr (!ALIGN_EPI) { if (wr == 0) PG8_BAR; }
    PG8_BAR;
    if constexpr (Epi::AFTER_DRAIN) { E.fused(acc, cur, wr, wc, fr, fq, lds, wid, lane); S.done(cur); }
#undef PG8_SA
#undef PG8_SB
#undef PG8_STAGE
#undef PG8_LDA
#undef PG8_LDB
#undef PG8_MMA
#undef PG8_WAIT_V
#undef PG8_WAIT_L
#undef PG8_BAR
#undef PG8_SCHED
}
}

namespace att {
using bf16 = __hip_bfloat16;
constexpr int   D = 128, NW = 8, QBLK = 32, KVBLK = 64;
constexpr float SCALE = 0.088388347648318440f;
constexpr float THR = 8.f;
#ifndef ATT_SDEPTH
#define ATT_SDEPTH 1
#endif
constexpr int SDEPTH = ATT_SDEPTH;
constexpr int LDQ = NP, LDK = NP, LDO = DM;
constexpr size_t SHM_V = KVBLK * D * 2, SHM_K = KVBLK * D * 2, SHM_ATTN = 2 * SHM_V + 2 * SHM_K + NW * 64 * 4;
constexpr int OST_OFF = 69632, OST_END = OST_OFF + NW * 32 * 272;
using bf16x8 = __attribute__((ext_vector_type(8))) short;
using s16x4  = __attribute__((ext_vector_type(4))) short;
using f32x16 = __attribute__((ext_vector_type(16))) float;
using f32x4  = __attribute__((ext_vector_type(4))) float;
using u32x4  = __attribute__((ext_vector_type(4))) unsigned;
#define KSWZ(row, colB) ((row) * 256 + ((colB) ^ (((row) & 7) << 4)))
#define SBAR() __builtin_amdgcn_sched_barrier(0)
__device__ __forceinline__ int crow(int r, int hi) { return (r & 3) + 8 * (r >> 2) + 4 * hi; }
__device__ __forceinline__ unsigned cvtpk(float lo, float hi) { unsigned r; asm volatile("v_cvt_pk_bf16_f32 %0, %1, %2" : "=v"(r) : "v"(lo), "v"(hi)); return r; }
__device__ __forceinline__ bf16x8 ld8(const bf16* p) { return *reinterpret_cast<const bf16x8*>(p); }

__device__ __forceinline__ void partialSM(f32x16& p0, f32x16& p1, float& m_reg, float& mn, float& alpha) {
  constexpr float C = SCALE * 1.4426950408889634f;
  float pmax = p0[0];
#pragma unroll
  for (int r = 1; r < 16; ++r) pmax = fmaxf(pmax, p0[r]);
#pragma unroll
  for (int r = 0; r < 16; ++r) pmax = fmaxf(pmax, p1[r]);
  { auto rr = __builtin_amdgcn_permlane32_swap(__float_as_uint(pmax), __float_as_uint(pmax), false, false);
    pmax = fmaxf(__uint_as_float(rr[0]), __uint_as_float(rr[1])); }
  if (__builtin_expect(__all(pmax - m_reg <= THR / SCALE), 1)) { mn = m_reg; alpha = 1.f; }
  else { mn = fmaxf(m_reg, pmax); alpha = __builtin_amdgcn_exp2f((m_reg - mn) * C); m_reg = mn; }
  float mnC = -mn * C;
#pragma unroll
  for (int r = 0; r < 16; ++r) p0[r] = fmaf(p0[r], C, mnC);
#pragma unroll
  for (int r = 0; r < 16; ++r) p1[r] = fmaf(p1[r], C, mnC);
#pragma unroll
  for (int r = 0; r < 16; ++r) p0[r] = __builtin_amdgcn_exp2f(p0[r]);
}
__device__ __forceinline__ void finishSM(f32x16& p0, f32x16& p1, float alpha, float& l_reg, bf16x8& pa0, bf16x8& pa1, bf16x8& pa2, bf16x8& pa3) {
#pragma unroll
  for (int r = 0; r < 16; ++r) p1[r] = __builtin_amdgcn_exp2f(p1[r]);
  float ps = 0;
#pragma unroll
  for (int r = 0; r < 16; ++r) ps += p0[r];
#pragma unroll
  for (int r = 0; r < 16; ++r) ps += p1[r];
  { auto rr = __builtin_amdgcn_permlane32_swap(__float_as_uint(ps), __float_as_uint(ps), false, false);
    ps = __uint_as_float(rr[0]) + __uint_as_float(rr[1]); }
  l_reg = l_reg * alpha + ps;
#define PK4(P, BASE, OUT) do { unsigned a0 = cvtpk(P[BASE + 0], P[BASE + 1]), a1 = cvtpk(P[BASE + 2], P[BASE + 3]);   \
    unsigned b0 = cvtpk(P[BASE + 4], P[BASE + 5]), b1 = cvtpk(P[BASE + 6], P[BASE + 7]);                              \
    auto r0 = __builtin_amdgcn_permlane32_swap(a0, b0, false, false); auto r1 = __builtin_amdgcn_permlane32_swap(a1, b1, false, false); \
    u32x4 w = {r0[0], r1[0], r0[1], r1[1]}; OUT = *reinterpret_cast<bf16x8*>(&w); } while (0)
  PK4(p0, 0, pa0); PK4(p0, 8, pa1); PK4(p1, 0, pa2); PK4(p1, 8, pa3);
#undef PK4
}
__device__ __forceinline__ void qkt(f32x16& p0, f32x16& p1, const bf16* Ks, const bf16x8* qr, int r32, int hi) {
  p0 = f32x16{}; p1 = f32x16{};
#pragma unroll
  for (int d0 = 0; d0 < 8; ++d0) { int cb = (d0 * 16 + hi * 8) * 2;
    bf16x8 b0 = *reinterpret_cast<const bf16x8*>((const char*)Ks + KSWZ(r32, cb));
    bf16x8 b1 = *reinterpret_cast<const bf16x8*>((const char*)Ks + KSWZ(32 + r32, cb));
    p0 = __builtin_amdgcn_mfma_f32_32x32x16_bf16(b0, qr[d0], p0, 0, 0, 0);
    p1 = __builtin_amdgcn_mfma_f32_32x32x16_bf16(b1, qr[d0], p1, 0, 0, 0); }
}
__device__ __forceinline__ int v_st(int k, int c) { const int kk = (k & ~0xC) | ((k & 4) << 1) | ((k & 8) >> 1); return ((kk >> 3) * 4 + (c >> 5)) * 512 + ((kk & 7) * 32 + (c & 31)) * 2; }
__device__ __forceinline__ int v_rd_base(int lane) { return ((lane & 3) << 3) | (((lane >> 2) & 3) << 6) | (((lane >> 4) & 1) << 5) | (((lane >> 5) & 1) << 8); }
constexpr int v_rd_off(int d0, int ks, int half) { return d0 * 512 + ks * 4096 + half * 2048; }
template <int OFF> __device__ __forceinline__ s16x4 tr_read(int vb) {
  s16x4 r; asm volatile("ds_read_b64_tr_b16 %0, %1 offset:%2" : "=&v"(r) : "v"(vb), "i"(OFF) : "memory"); return r;
}
template <int D0> __device__ __forceinline__ void pv_one(f32x16& od, int vb, bf16x8 pa0, bf16x8 pa1, bf16x8 pa2, bf16x8 pa3) {
  const s16x4 l0 = tr_read<v_rd_off(D0, 0, 0)>(vb), h0 = tr_read<v_rd_off(D0, 0, 1)>(vb), l1 = tr_read<v_rd_off(D0, 1, 0)>(vb), h1 = tr_read<v_rd_off(D0, 1, 1)>(vb);
  const s16x4 l2 = tr_read<v_rd_off(D0, 2, 0)>(vb), h2 = tr_read<v_rd_off(D0, 2, 1)>(vb), l3 = tr_read<v_rd_off(D0, 3, 0)>(vb), h3 = tr_read<v_rd_off(D0, 3, 1)>(vb);
  asm volatile("s_waitcnt lgkmcnt(0)" ::: "memory"); SBAR();
#define PK(L, H) (bf16x8){L[0], L[1], L[2], L[3], H[0], H[1], H[2], H[3]}
  od = __builtin_amdgcn_mfma_f32_32x32x16_bf16(pa0, PK(l0, h0), od, 0, 0, 0);
  od = __builtin_amdgcn_mfma_f32_32x32x16_bf16(pa1, PK(l1, h1), od, 0, 0, 0);
  od = __builtin_amdgcn_mfma_f32_32x32x16_bf16(pa2, PK(l2, h2), od, 0, 0, 0);
  od = __builtin_amdgcn_mfma_f32_32x32x16_bf16(pa3, PK(l3, h3), od, 0, 0, 0);
#undef PK
}
__device__ __forceinline__ void pv_d0(f32x16* o, int vb, bf16x8 pa0, bf16x8 pa1, bf16x8 pa2, bf16x8 pa3) {
  pv_one<0>(o[0], vb, pa0, pa1, pa2, pa3); pv_one<1>(o[1], vb, pa0, pa1, pa2, pa3); pv_one<2>(o[2], vb, pa0, pa1, pa2, pa3); pv_one<3>(o[3], vb, pa0, pa1, pa2, pa3);
}

__device__ __forceinline__ void attn_unit(const bf16* __restrict__ Qb, const bf16* __restrict__ Kh, const bf16* __restrict__ Vh, const bf16* __restrict__ Zb,
                                          bf16* __restrict__ Ob, int seq, char* lds, const float* __restrict__ qn, const float* __restrict__ cs, const float* __restrict__ sn) {
  int tid = threadIdx.x; asm volatile("" : "+v"(tid));
  int wid = tid >> 6, lane = tid & 63, r32 = lane & 31, hi = lane >> 5;
  bf16* V_lds = (bf16*)lds; bf16* K_lds = (bf16*)(lds + 2 * SHM_V);
  float* ws = (float*)(lds + 2 * SHM_V + 2 * SHM_K) + wid * 64; float* li_l = ws; float* al_l = ws + 32;
  float m_reg = -1e30f, l_reg = 0; f32x16 o[4] = {}; bf16x8 qr[8];
  {
    const bf16* Qw = Qb + (long)(wid * QBLK + r32) * LDQ + hi * 8;
    float ss = 0.f;
#pragma unroll
    for (int d0 = 0; d0 < 8; ++d0) { const u32x4 w = *reinterpret_cast<const u32x4*>(Qw + d0 * 16); qr[d0] = __builtin_bit_cast(bf16x8, w);
#pragma unroll
      for (int e = 0; e < 4; ++e) { const float lo = __uint_as_float(w[e] << 16), hh = __uint_as_float(w[e] & 0xffff0000u); ss += lo * lo + hh * hh; } }
    { auto rr = __builtin_amdgcn_permlane32_swap(__float_as_uint(ss), __float_as_uint(ss), false, false); ss = __uint_as_float(rr[0]) + __uint_as_float(rr[1]); }
    const float rs = rsqrtf(ss * (1.f / 128.f) + EPS);
    const float* cp = cs ? cs + (long)(wid * QBLK + r32) * 64 + hi * 8 : nullptr; const float* sp = cs ? sn + (long)(wid * QBLK + r32) * 64 + hi * 8 : nullptr;
#pragma unroll
    for (int d0 = 0; d0 < 4; ++d0) {
      const u32x4 wa = __builtin_bit_cast(u32x4, qr[d0]), wb = __builtin_bit_cast(u32x4, qr[d0 + 4]); float x1[8], x2[8];
#pragma unroll
      for (int e = 0; e < 4; ++e) { x1[2 * e] = __uint_as_float(wa[e] << 16); x1[2 * e + 1] = __uint_as_float(wa[e] & 0xffff0000u); x2[2 * e] = __uint_as_float(wb[e] << 16); x2[2 * e + 1] = __uint_as_float(wb[e] & 0xffff0000u); }
      const f32x4 ga0 = *reinterpret_cast<const f32x4*>(qn + d0 * 16 + hi * 8), ga1 = *reinterpret_cast<const f32x4*>(qn + d0 * 16 + hi * 8 + 4);
      const f32x4 gb0 = *reinterpret_cast<const f32x4*>(qn + 64 + d0 * 16 + hi * 8), gb1 = *reinterpret_cast<const f32x4*>(qn + 64 + d0 * 16 + hi * 8 + 4);
#pragma unroll
      for (int e = 0; e < 8; ++e) { x1[e] *= rs * (e < 4 ? ga0[e & 3] : ga1[e & 3]); x2[e] *= rs * (e < 4 ? gb0[e & 3] : gb1[e & 3]); }
      if (cs) {
        const f32x4 c0 = *reinterpret_cast<const f32x4*>(cp + d0 * 16), c1 = *reinterpret_cast<const f32x4*>(cp + d0 * 16 + 4);
        const f32x4 s0 = *reinterpret_cast<const f32x4*>(sp + d0 * 16), s1 = *reinterpret_cast<const f32x4*>(sp + d0 * 16 + 4);
#pragma unroll
        for (int e = 0; e < 8; ++e) { const float c = e < 4 ? c0[e & 3] : c1[e & 3], sv = e < 4 ? s0[e & 3] : s1[e & 3];
          const float a = x1[e], bq = x2[e]; x1[e] = a * c - bq * sv; x2[e] = bq * c + a * sv; }
      }
      const u32x4 oa = {cvtpk(x1[0], x1[1]), cvtpk(x1[2], x1[3]), cvtpk(x1[4], x1[5]), cvtpk(x1[6], x1[7])}, ob = {cvtpk(x2[0], x2[1]), cvtpk(x2[2], x2[3]), cvtpk(x2[4], x2[5]), cvtpk(x2[6], x2[7])};
      qr[d0] = __builtin_bit_cast(bf16x8, oa); qr[d0 + 4] = __builtin_bit_cast(bf16x8, ob);
      asm volatile("" ::: "memory");
    }
  }
  const int sr = tid >> 4, sc = (tid & 15) * 8, vst0 = v_st(sr, sc), vst1 = v_st(32 + sr, sc);
  const int vb0 = (int)(uintptr_t)V_lds + v_rd_base(lane);
  struct { bf16x8 vs0, vs1, ks0, ks1; } sr_[SDEPTH];
#define SLOAD(i, k0) do { sr_[i].vs0 = ld8(&Vh[(long)((k0) + sr) * LDK + sc]); sr_[i].vs1 = ld8(&Vh[(long)((k0) + 32 + sr) * LDK + sc]); \
    sr_[i].ks0 = ld8(&Kh[(long)((k0) + sr) * LDK + sc]); sr_[i].ks1 = ld8(&Kh[(long)((k0) + 32 + sr) * LDK + sc]); } while (0)
#define SWRITE(b, i) do { *(bf16x8*)((char*)V_lds + (b) * SHM_V + vst0) = sr_[i].vs0;          \
    *(bf16x8*)((char*)V_lds + (b) * SHM_V + vst1) = sr_[i].vs1; int kc = sc * 2;               \
    *(bf16x8*)((char*)K_lds + (b) * SHM_K + KSWZ(sr, kc)) = sr_[i].ks0;                       \
    *(bf16x8*)((char*)K_lds + (b) * SHM_K + KSWZ(32 + sr, kc)) = sr_[i].ks1; } while (0)
#define SWAIT() do { if constexpr (SDEPTH == 2) asm volatile("s_waitcnt vmcnt(4)" ::: "memory"); else asm volatile("s_waitcnt vmcnt(0)" ::: "memory"); } while (0)
#define RESC(a) do { if (__any((a) < 1.f)) { if (hi == 0) al_l[r32] = (a); asm volatile("s_waitcnt lgkmcnt(0)" ::: "memory"); \
    _Pragma("unroll") for (int d = 0; d < 4; ++d) _Pragma("unroll") for (int r = 0; r < 16; ++r) o[d][r] *= al_l[crow(r, hi)]; } } while (0)
  f32x16 pA0, pA1, pB0, pB1; float mnA, mnB, alA, alB; bf16x8 pa0, pa1, pa2, pa3; const int NT = seq / KVBLK;
  constexpr int SE = 0, SO = SDEPTH - 1;
  SLOAD(SE, 0); asm volatile("s_waitcnt vmcnt(0)" ::: "memory"); SWRITE(0, SE); __syncthreads();
  qkt(pA0, pA1, K_lds, qr, r32, hi); partialSM(pA0, pA1, m_reg, mnA, alA);
  SLOAD(SO, KVBLK); if constexpr (SDEPTH == 2) { if (2 < NT) SLOAD(SE, 2 * KVBLK); }
  SWAIT(); SWRITE(1, SO); __syncthreads();
  for (int j = 1; j + 1 < NT; j += 2) {
    SBAR(); qkt(pB0, pB1, (bf16*)((char*)K_lds + SHM_K), qr, r32, hi);
    finishSM(pA0, pA1, alA, l_reg, pa0, pa1, pa2, pa3); SBAR();
    SLOAD(SO, (j + SDEPTH) * KVBLK); SBAR();
    pv_d0(o, vb0, pa0, pa1, pa2, pa3); partialSM(pB0, pB1, m_reg, mnB, alB);
    __syncthreads(); SWAIT(); SWRITE(0, SE);
    RESC(alB); __syncthreads();
    SBAR(); qkt(pA0, pA1, K_lds, qr, r32, hi);
    finishSM(pB0, pB1, alB, l_reg, pa0, pa1, pa2, pa3); SBAR();
    if (SDEPTH == 1 || j + 3 < NT) SLOAD(SE, (j + 1 + SDEPTH) * KVBLK); SBAR();
    pv_d0(o, vb0 + (int)SHM_V, pa0, pa1, pa2, pa3); partialSM(pA0, pA1, m_reg, mnA, alA);
    __syncthreads(); SWAIT(); SWRITE(1, SO);
    RESC(alA); __syncthreads();
  }
  SBAR(); qkt(pB0, pB1, (bf16*)((char*)K_lds + SHM_K), qr, r32, hi);
  finishSM(pA0, pA1, alA, l_reg, pa0, pa1, pa2, pa3); SBAR();
  pv_d0(o, vb0, pa0, pa1, pa2, pa3); partialSM(pB0, pB1, m_reg, mnB, alB);
  __syncthreads(); RESC(alB);
  finishSM(pB0, pB1, alB, l_reg, pa0, pa1, pa2, pa3); SBAR();
  pv_d0(o, vb0 + (int)SHM_V, pa0, pa1, pa2, pa3);
  if (hi == 0) li_l[r32] = l_reg; asm volatile("s_waitcnt lgkmcnt(0)" ::: "memory");
  { int tz = threadIdx.x; asm volatile("" : "+v"(tz)); wid = tz >> 6; lane = tz & 63; r32 = lane & 31; hi = lane >> 5; }
  float rli[16];
#pragma unroll
  for (int r = 0; r < 16; ++r) rli[r] = __builtin_amdgcn_rcpf(li_l[crow(r, hi)]);
  char* ost = lds + OST_OFF + wid * (32 * 272);
#pragma unroll
  for (int r = 0; r < 16; ++r) { const int orow = crow(r, hi);
#pragma unroll
    for (int d0 = 0; d0 < 4; ++d0) *(bf16*)(ost + orow * 272 + (d0 * 32 + r32) * 2) = __float2bfloat16(o[d0][r] * rli[r]); }
  asm volatile("s_waitcnt lgkmcnt(0)" ::: "memory");
  bf16* Ow = Ob + (long)(wid * QBLK) * LDO; const bf16* Zw = Zb + (long)(wid * QBLK) * LDQ;
#pragma unroll
  for (int hb = 0; hb < 2; ++hb) {
    u32x4 ov[4], zv[4];
#pragma unroll
    for (int i = 0; i < 4; ++i) { const int c = (hb * 4 + i) * 64 + lane, row = c >> 4, col = (c & 15) * 8;
      ov[i] = *reinterpret_cast<const u32x4*>(ost + row * 272 + col * 2); zv[i] = *reinterpret_cast<const u32x4*>(Zw + (long)row * LDQ + col); }
#pragma unroll
    for (int i = 0; i < 4; ++i) { const int c = (hb * 4 + i) * 64 + lane, row = c >> 4, col = (c & 15) * 8; u32x4 w;
#pragma unroll
      for (int e = 0; e < 4; ++e) { const unsigned a = ov[i][e], z = zv[i][e];
        w[e] = cvtpk(__uint_as_float(a << 16) * __uint_as_float(z << 16), __uint_as_float(a & 0xffff0000u) * __uint_as_float(z & 0xffff0000u)); }
      *reinterpret_cast<u32x4*>(Ow + (long)row * LDO + col) = w; }
  }
  __syncthreads();
#undef SLOAD
#undef SWRITE
#undef SWAIT
#undef RESC
}
}

constexpr int NWAVES = 8;
#ifndef MK_N_LAUNCHES
#define MK_N_LAUNCHES 1
#endif
constexpr int PH_PER_LAYER = 7, N_PHASES = 2 + DEPTH * PH_PER_LAYER;
constexpr size_t MiB = 1u << 20;
constexpr size_t WS_CTL = 0, CTL_ZERO_BYTES = 1 * MiB;
constexpr size_t WS_MOD = 1 * MiB;
constexpr size_t WS_ROPE = WS_MOD + MiB / 2;
constexpr size_t WS_WG = 3 * MiB;
constexpr size_t WS_WLRU = 4 * MiB;
constexpr size_t WS_WOUT = 12 * MiB;
constexpr size_t WS_WBR = 44 * MiB;
constexpr size_t WS_WIN = 140 * MiB;
constexpr size_t WS_X = 540 * MiB;
constexpr size_t WS_Y = 2112 * MiB;
constexpr size_t WS_H = 684 * MiB;
constexpr size_t WS_G2 = 1968 * MiB;
constexpr size_t WS_YB = 756 * MiB;
constexpr size_t WS_ACC = 864 * MiB;
constexpr size_t WS_GT = 936 * MiB;
constexpr size_t WS_MH = 938 * MiB;
constexpr size_t WS_P = 1082 * MiB;
constexpr size_t WS_LA = 1532 * MiB;
constexpr size_t WS_LB = 1676 * MiB;
constexpr size_t WS_X8 = WS_LB;
constexpr size_t WS_HL = 1820 * MiB;
constexpr size_t WS_GSC = 1964 * MiB;
constexpr size_t WS_END = 2328 * MiB;
constexpr int CW_BAR = 4096;
constexpr int RING_BYTES = 131072, LDS_BYTES = 147456, MISC_OFF = LDS_BYTES - 256;
static_assert(att::OST_END <= MISC_OFF, "LDS map");

#define GAS __attribute__((address_space(1)))
#define LAS __attribute__((address_space(3)))
typedef unsigned short bf16_t;
typedef unsigned v4u __attribute__((ext_vector_type(4)));
typedef unsigned v2u __attribute__((ext_vector_type(2)));
typedef float f32x4 __attribute__((ext_vector_type(4)));
#define LDS_WAIT() asm volatile("s_waitcnt lgkmcnt(0)" ::: "memory")
__device__ __forceinline__ unsigned f2bf(float f) { unsigned u = __builtin_bit_cast(unsigned, f); return (u + 0x7fffu + ((u >> 16) & 1u)) >> 16; }
__device__ __forceinline__ unsigned pk2(float lo, float hi) { unsigned r; asm("v_cvt_pk_bf16_f32 %0, %1, %2" : "=v"(r) : "v"(lo), "v"(hi)); return r; }
__device__ __forceinline__ float bf2f(bf16_t b) { return __uint_as_float((unsigned)b << 16); }
__device__ __forceinline__ float blo(unsigned w) { return __uint_as_float(w << 16); }
__device__ __forceinline__ float bhi(unsigned w) { return __uint_as_float(w & 0xffff0000u); }
__device__ __forceinline__ float lane_get(float v, int src) { return __builtin_bit_cast(float, __builtin_amdgcn_ds_bpermute(src << 2, __builtin_bit_cast(int, v))); }
__device__ __forceinline__ float lane_xor(float v, int mask, int lane) { return lane_get(v, lane ^ mask); }
__device__ __forceinline__ float lane_up(float v, int delta, int lane) { return lane_get(v, lane >= delta ? lane - delta : lane); }
__device__ __forceinline__ float wave_sum(float v, int lane) {
#pragma unroll
    for (int o = 1; o < 64; o <<= 1) v += lane_xor(v, o, lane);
    return v;
}
#define XB_TMO      128
#define XB_XCNT(j)  (256  + 64 * (j))
#define XB_XSUB(j)  (1280 + 64 * (j))
#define XB_XGEN(j)  (2304 + 64 * (j))
#define XB_TOP      3328
#define XB_TOPGEN   3392
#define XCD_BAR_WORDS 3456
#define XB_SPIN_CAP (1u << 18)

__device__ __forceinline__ unsigned xb_ld(unsigned* p)              { return __hip_atomic_load(p, __ATOMIC_RELAXED, __HIP_MEMORY_SCOPE_AGENT); }
__device__ __forceinline__ unsigned xb_add(unsigned* p, unsigned v) { return __hip_atomic_fetch_add(p, v, __ATOMIC_RELAXED, __HIP_MEMORY_SCOPE_AGENT); }
__device__ __forceinline__ unsigned xb_xcc_id() { return (unsigned)__builtin_amdgcn_s_getreg((3 << 11) | 20) & 0xFu; }
#define XB_SPIN(cond, bar) do { unsigned _sp = 0; while (cond) { __builtin_amdgcn_s_sleep(1); \
    if ((++_sp & 255u) == 0u) { if (xb_ld(&(bar)[XB_TMO])) break; if (_sp > XB_SPIN_CAP) { atomicAdd(&(bar)[XB_TMO], 1u); break; } } } } while (0)

struct XcdBarrier {
    unsigned* bar; unsigned x;
    volatile LAS unsigned* st;
};

__device__ __forceinline__ XcdBarrier xcd_barrier_post(unsigned* bar, volatile LAS unsigned* st) {
    XcdBarrier b; b.bar = bar; b.x = xb_xcc_id(); b.st = st;
    if (threadIdx.x == 0) (void)xb_add(&bar[XB_XCNT(b.x)], 1u);
    return b;
}
__device__ __forceinline__ void xcd_barrier_complete(unsigned* bar, unsigned x, unsigned& nloc, unsigned& nx) {
    const unsigned G = gridDim.x * gridDim.y * gridDim.z;
    unsigned sum, cnt, mine, sp = 0u;
    for (;;) {
        sum = 0u; cnt = 0u; mine = 0u;
#pragma unroll
        for (unsigned j = 0; j < 16; ++j) { const unsigned c = xb_ld(&bar[XB_XCNT(j)]); sum += c; cnt += (c > 0u) ? 1u : 0u; mine = (j == x) ? c : mine; }
        if (sum == G) break;
        __builtin_amdgcn_s_sleep(1);
        if ((++sp & 255u) == 0u) { if (xb_ld(&bar[XB_TMO])) break; if (sp > XB_SPIN_CAP) { atomicAdd(&bar[XB_TMO], 1u); break; } }
    }
    nloc = mine > 0u ? mine : 1u; nx = cnt > 0u ? cnt : 1u;
}

__device__ __forceinline__ void xcd_barrier(const XcdBarrier& b) {
    asm volatile("s_waitcnt vmcnt(0)" ::: "memory");
    __syncthreads();
    if (threadIdx.x == 0) {
        unsigned* bar = b.bar;
        __builtin_amdgcn_s_waitcnt(0);
        unsigned nloc = b.st[0], nx = b.st[1];
        if (nloc == 0u) { xcd_barrier_complete(bar, b.x, nloc, nx); b.st[0] = nloc; b.st[1] = nx; }
        const unsigned old = xb_add(&bar[XB_XSUB(b.x)], 1u);
        const unsigned gen = old / nloc;
        if (old + 1u == (gen + 1u) * nloc) {
            __builtin_amdgcn_fence(__ATOMIC_RELEASE, "agent");
            asm volatile("s_waitcnt vmcnt(0)" ::: "memory");
            const unsigned og = xb_add(&bar[XB_TOP], 1u);
            const unsigned tg = og / nx;
            if (og + 1u == (tg + 1u) * nx) xb_add(&bar[XB_TOPGEN], 1u);
            else XB_SPIN(xb_ld(&bar[XB_TOPGEN]) == tg, bar);
            __builtin_amdgcn_fence(__ATOMIC_ACQUIRE, "agent");
            xb_add(&bar[XB_XGEN(b.x)], 1u);
            asm volatile("s_waitcnt vmcnt(0)" ::: "memory");
        } else {
            XB_SPIN(xb_ld(&bar[XB_XGEN(b.x)]) == gen, bar);
            __builtin_amdgcn_fence(__ATOMIC_ACQUIRE, "agent");
            asm volatile("s_waitcnt vmcnt(0)" ::: "memory");
        }
    }
    __syncthreads();
}

struct Args { const float* in[22]; float* out; unsigned char* ws; int ph_lo, ph_hi; };
typedef const __attribute__((address_space(4))) Args CArgs;
#define KIN(k) ((const float*)ka->in[k])
#define WSF(off) ((float*)(ka->ws + (off)))
#define WSB(off) ((bf16_t*)(ka->ws + (off)))
#define KA() ({ CArgs* _k = ka0; asm volatile("" : "+s"(_k)); _k; })
__device__ __forceinline__ int tid_fresh() { int t = threadIdx.x; asm volatile("" : "+v"(t)); return t; }
struct Frame {
    LAS unsigned char* lds; char* ldsg;
    int tid, lane, wave, G, wg;
};

__device__ __forceinline__ void transpose_item(const float* W, int ldw, int col0, int k0, bf16_t* WT, int ldt, int drow0, LAS float* scr, int lane) {
    f32x4 v[8];
#pragma unroll
    for (int i = 0; i < 8; ++i) v[i] = __builtin_nontemporal_load((const f32x4*)(W + (size_t)(k0 + 8 * i + (lane >> 3)) * ldw + col0 + 4 * (lane & 7)));
#pragma unroll
    for (int i = 0; i < 8; ++i) { LAS float* d = scr + (8 * i + (lane >> 3)) * 33 + 4 * (lane & 7); d[0] = v[i][0]; d[1] = v[i][1]; d[2] = v[i][2]; d[3] = v[i][3]; }
    LDS_WAIT(); asm volatile("" ::: "memory");
    const int c = lane & 7;
#pragma unroll
    for (int j = 0; j < 4; ++j) { const int n = (lane >> 3) + 8 * j; const LAS float* s = scr + (8 * c) * 33 + n;
        v4u o; o.x = pk2(s[0 * 33], s[1 * 33]); o.y = pk2(s[2 * 33], s[3 * 33]); o.z = pk2(s[4 * 33], s[5 * 33]); o.w = pk2(s[6 * 33], s[7 * 33]);
        __builtin_nontemporal_store(o, (v4u*)(WT + (size_t)(drow0 + n) * ldt + k0 + 8 * c)); }
    LDS_WAIT(); asm volatile("" ::: "memory");
}
__device__ __forceinline__ void p_convert(Frame& F, CArgs* ka, int l, int wv, int nwv, int it0 = 0, int it1 = 1 << 30) {
    const int tid = tid_fresh(), lane = tid & 63, wave = __builtin_amdgcn_readfirstlane(tid >> 6);
    LAS float* scr = (LAS float*)(F.lds + wave * 8704);
    constexpr int I_IN = 32 * 800, I_G = 32, I_BR = 3 * 2048, I_OUT = 2048, I_LRU = 2 * 2 * 16 * 8, I_LAYER = I_IN + I_G + I_BR + I_OUT + I_LRU;
    if (it1 > I_LAYER) it1 = I_LAYER;
    for (int it = it0 + wv; it < it1; it += nwv) {
        int r = it;
        if (r < I_IN) { const int kb = r / 800, nb = r - kb * 800, n0 = nb * 32, sc = n0 < 14336 ? n0 : n0 + 32;
            transpose_item(KIN(8) + (size_t)l * DM * NIN, NIN, sc, kb * 64, WSB(WS_WIN) + (size_t)l * NP * DM, DM, n0, scr, lane); continue; }
        r -= I_IN;
        if (r < I_G) { transpose_item(KIN(8) + (size_t)l * DM * NIN, NIN, 14336, r * 64, WSB(WS_WG) + (size_t)l * 32 * DM, DM, 0, scr, lane); continue; }
        r -= I_G;
        if (r < I_BR) { const int z = r / 2048, q = r - z * 2048, kb = q / 64, nb = q - kb * 64;
            transpose_item(KIN(20) + ((size_t)l * 3 + z) * DM * DM, DM, nb * 32, kb * 64, WSB(WS_WBR) + ((size_t)l * 3 + z) * DM * DM, DM, nb * 32, scr, lane); continue; }
        r -= I_BR;
        if (r < I_OUT) { const int kb = r / 64, nb = r - kb * 64;
            transpose_item(KIN(21) + (size_t)l * DM * DM, DM, nb * 32, kb * 64, WSB(WS_WOUT) + (size_t)l * DM * DM, DM, nb * 32, scr, lane); continue; }
        r -= I_OUT;
        { const int q = r & 7, mt = r >> 3, blk = mt & 15, gate = (mt >> 4) & 1, dr = mt >> 5, kb = q >> 2, nb = q & 3;
          const float* src = (gate ? KIN(13) : KIN(11)) + (((size_t)l * 2 + dr) * 16 + blk) * 16384;
          transpose_item(src, 128, nb * 32, kb * 64, WSB(WS_WLRU) + ((((size_t)l * 2 + dr) * 2 + gate) * 16 + blk) * 16384, 128, nb * 32, scr, lane); }
    }
}
__device__ __forceinline__ void p_prologue(Frame& F, CArgs* ka) {
    const int tid = tid_fresh(), lane = tid & 63, wave = __builtin_amdgcn_readfirstlane(tid >> 6); (void)lane; (void)wave;
    for (int i = F.wg * 512 + tid; i < SEQ * 64; i += F.G * 512) { const int t = i >> 6, j = i & 63;
        const float inv = 1.0f / powf(10000.0f, (float)(j & 31) * (1.0f / 32.0f)); const float pos = (float)(j < 32 ? (t >> 6) : (t & 63)); const float ang = pos * inv;
        { const float rev = ang * 0.15915494309189535f; WSF(WS_ROPE)[i] = __builtin_amdgcn_cosf(rev); WSF(WS_ROPE)[SEQ * 64 + i] = __builtin_amdgcn_sinf(rev); } }
    __syncthreads();
    LAS float* sc = (LAS float*)(F.lds + 73728);
    LAS float* red = (LAS float*)(F.lds + 73728 + 5 * 2048 * 4);
    for (int i = tid; i < 5 * DM; i += 512) { const int bi = i >> 11, k = i & 2047; const float v = bi < 4 ? KIN(1)[bi * DM + k] : KIN(3)[k]; sc[i] = v / (1.f + expf(-v)); }
    __syncthreads();
    for (int it = F.wg; it < DEPTH * 192; it += F.G) { const int l = it / 192, j0 = (it - l * 192) * 32, cj = tid & 31, ks = tid >> 5;
        float a0 = 0.f, a1 = 0.f, a2 = 0.f, a3 = 0.f, a4 = 0.f; const float* w = KIN(4) + (size_t)l * DM * 3 * DM + j0 + cj;
        for (int k = ks * 128; k < ks * 128 + 128; ++k) { const float wv = w[(size_t)k * (3 * DM)]; a0 += sc[k] * wv; a1 += sc[2048 + k] * wv; a2 += sc[4096 + k] * wv; a3 += sc[6144 + k] * wv; a4 += sc[8192 + k] * wv; }
        red[(ks * 5 + 0) * 32 + cj] = a0; red[(ks * 5 + 1) * 32 + cj] = a1; red[(ks * 5 + 2) * 32 + cj] = a2; red[(ks * 5 + 3) * 32 + cj] = a3; red[(ks * 5 + 4) * 32 + cj] = a4;
        __syncthreads();
        if (tid < 160) { const int bi = tid >> 5, c = tid & 31; float s = KIN(5)[(size_t)l * 3 * DM + j0 + c];
            for (int q = 0; q < 16; ++q) s += red[(q * 5 + bi) * 32 + c];
            WSF(WS_MOD)[((size_t)l * 5 + bi) * (3 * DM) + j0 + c] = s; }
        __syncthreads();
    }
}

__device__ __forceinline__ void p_norm(Frame& F, CArgs* ka, int l, bool dry = false) {
    const int tid = tid_fresh(), lane = tid & 63, wave = __builtin_amdgcn_readfirstlane(tid >> 6); (void)lane; (void)wave;
    const int gw = F.wg * NWAVES + wave, NGW = F.G * NWAVES;
    for (int r = gw; r < MROWS; r += NGW) {
        const int b = r / TPB, t = r - b * TPB; const bool isctx = t >= SEQ; const int bi = isctx ? 4 : b;
        if (l == DEPTH && isctx) continue;
        f32x4 v[8];
        if (l == 0) { const float* src = isctx ? KIN(2) + ((size_t)b * CTXL + (t - SEQ)) * DM : KIN(0) + ((size_t)b * SEQ + t) * DM;
#pragma unroll
            for (int j = 0; j < 8; ++j) v[j] = *(const f32x4*)(src + j * 256 + lane * 4);
        } else {
            const float* xr = WSF(WS_X) + (size_t)r * DM; f32x4 y[8]; float ss = 0.f;
#if Y_BF16
            const bf16_t* yr = WSB(WS_Y) + (size_t)r * DM;
#define LDY(p) ({ const v2u w_ = *(const v2u*)(p); (f32x4){blo(w_.x), bhi(w_.x), blo(w_.y), bhi(w_.y)}; })
#else
            const float* yr = WSF(WS_Y) + (size_t)r * DM;
#define LDY(p) (*(const f32x4*)(p))
#endif
#pragma unroll
            for (int j = 0; j < 8; ++j) { y[j] = LDY(yr + j * 256 + lane * 4);
                if (SPLIT_CTX && isctx && F.G == 256) y[j] = y[j] + LDY(yr + (size_t)MROWS * DM + j * 256 + lane * 4) + LDY(yr + 2 * (size_t)MROWS * DM + j * 256 + lane * 4);
                ss += y[j].x * y[j].x + y[j].y * y[j].y + y[j].z * y[j].z + y[j].w * y[j].w; }
            const float rs = rsqrtf(wave_sum(ss, lane) * (1.f / DM) + EPS);
            const float* gate = WSF(WS_MOD) + ((size_t)(l - 1) * 5 + bi) * (3 * DM) + 2 * DM; const float* npost = KIN(7) + (size_t)(l - 1) * DM;
#pragma unroll
            for (int j = 0; j < 8; ++j) { const int c = j * 256 + lane * 4; const f32x4 g = *(const f32x4*)(gate + c), w = *(const f32x4*)(npost + c), xv = *(const f32x4*)(xr + c);
                v[j] = xv + g * (y[j] * rs * w); }
        }
        if (l == DEPTH) { float* o = (ka->out) + ((size_t)b * SEQ + t) * DM;
#pragma unroll
            for (int j = 0; j < 8; ++j) *(f32x4*)(o + j * 256 + lane * 4) = v[j];
            continue; }
        float* xo = (dry ? WSF(WS_ACC) : WSF(WS_X)) + (size_t)r * DM; float ss = 0.f;
#pragma unroll
        for (int j = 0; j < 8; ++j) { *(f32x4*)(xo + j * 256 + lane * 4) = v[j]; ss += v[j].x * v[j].x + v[j].y * v[j].y + v[j].z * v[j].z + v[j].w * v[j].w; }
        const float rs = rsqrtf(wave_sum(ss, lane) * (1.f / DM) + EPS);
        const float* shift = WSF(WS_MOD) + ((size_t)l * 5 + bi) * (3 * DM); const float* scale = shift + DM; const float* npre = KIN(6) + (size_t)l * DM;
        bf16_t* ho = (dry ? WSB(WS_G2) : WSB(WS_H)) + (size_t)r * DM;
#pragma unroll
        for (int j = 0; j < 8; ++j) { const int c = j * 256 + lane * 4; const f32x4 sh = *(const f32x4*)(shift + c), scv = *(const f32x4*)(scale + c), w = *(const f32x4*)(npre + c);
            const f32x4 h = v[j] * rs * w * (scv + 1.f) + sh; v2u o; o.x = pk2(h.x, h.y); o.y = pk2(h.z, h.w); *(v2u*)(ho + c) = o; }
    }
}

__device__ __forceinline__ void p_gates(Frame& F, CArgs* ka, int l, int wk0, int nwk) {
    const int tid = tid_fresh(), lane = tid & 63, wave = __builtin_amdgcn_readfirstlane(tid >> 6), c16 = lane & 15, q = lane >> 4;
    typedef short bf16x8 __attribute__((ext_vector_type(8)));
    LAS float* GL = (LAS float*)F.lds;
    const bf16_t* H = WSB(WS_H); const bf16_t* WG = WSB(WS_WG) + (size_t)l * 32 * DM; float* GT = WSF(WS_GT); f32x4* GSC = (f32x4*)WSF(WS_GSC);
    for (int task = wk0; task < NBATCH * 36; task += nwk) { const int b = task / 36, chunk = task - b * 36; const size_t row0 = (size_t)b * TPB + chunk * 64;
        __syncthreads();
        { const int rb = wave & 3, kh = wave >> 2; f32x4 a0 = {0.f, 0.f, 0.f, 0.f}, a1 = {0.f, 0.f, 0.f, 0.f};
          const bf16_t* hp = H + (row0 + rb * 16 + c16) * DM + kh * 1024 + q * 8; const bf16_t* w0 = WG + (size_t)c16 * DM + kh * 1024 + q * 8; const bf16_t* w1 = w0 + 16 * DM;
#pragma unroll 8
          for (int ks = 0; ks < 32; ++ks) { const bf16x8 av = *(const bf16x8*)(hp + ks * 32), b0 = *(const bf16x8*)(w0 + ks * 32), b1 = *(const bf16x8*)(w1 + ks * 32);
              a0 = __builtin_amdgcn_mfma_f32_16x16x32_bf16(av, b0, a0, 0, 0, 0); a1 = __builtin_amdgcn_mfma_f32_16x16x32_bf16(av, b1, a1, 0, 0, 0); }
#pragma unroll
          for (int j = 0; j < 4; ++j) { GL[(kh * 64 + rb * 16 + q * 4 + j) * 33 + c16] = a0[j]; GL[(kh * 64 + rb * 16 + q * 4 + j) * 33 + 16 + c16] = a1[j]; } }
        __syncthreads();
#pragma unroll
        for (int i = 0; i < 4; ++i) { const int idx = tid + 512 * i, r = idx >> 5, c = idx & 31; float s = GL[r * 33 + c] + GL[(64 + r) * 33 + c] + KIN(16)[l * 32 + c];
            if ((c >> 3) & 1) s = fminf(s, 0.f) - __logf(1.f + __expf(-fabsf(s)));
            GL[r * 33 + c] = s; GT[(row0 + r) * 32 + c] = s; }
        __syncthreads();
#pragma unroll
        for (int pi = 0; pi < 2; ++pi) { const int p = wave * 2 + pi, dir = p >> 3, h = p & 7, rl = dir ? 63 - lane : lane;
            const float gi = GL[rl * 33 + dir * 16 + h]; float bc = GL[rl * 33 + dir * 16 + 8 + h];
#pragma unroll
            for (int o = 1; o < 64; o <<= 1) { const float v = lane_up(bc, o, lane); if (lane >= o) bc += v; }
            const float g = gi - bc; float pm = g;
#pragma unroll
            for (int o = 1; o < 64; o <<= 1) { const float v = lane_up(pm, o, lane); if (lane >= o) pm = fmaxf(pm, v); }
            GSC[((((size_t)b * 2 + dir) * 8 + h) * 36 + chunk) * 64 + lane] = (f32x4){bc, g, pm, 0.f}; }
    }
    __syncthreads();
}
__device__ __forceinline__ void p_knorm(Frame& F, CArgs* ka, int l, bool dry = false) {
    const int tid = tid_fresh(), lane = tid & 63, wave = __builtin_amdgcn_readfirstlane(tid >> 6);
    const int gw = F.wg * NWAVES + wave, NGW = F.G * NWAVES; const int sub = lane & 15;
    f32x4 kn0 = *(const f32x4*)(KIN(19) + l * 128 + sub * 8), kn1 = *(const f32x4*)(KIN(19) + l * 128 + sub * 8 + 4);
    for (int r = gw; r < MROWS; r += NGW) { const int b = r / TPB, t = r - b * TPB;
        bf16_t* kp = WSB(WS_P) + (size_t)r * NP + C_AK + lane * 8; const v4u raw = *(const v4u*)kp; float v[8];
#pragma unroll
        for (int e = 0; e < 4; ++e) { v[2 * e] = blo(raw[e]); v[2 * e + 1] = bhi(raw[e]); }
        float ss = 0.f;
#pragma unroll
        for (int e = 0; e < 8; ++e) ss += v[e] * v[e];
        ss += lane_xor(ss, 1, lane); ss += lane_xor(ss, 2, lane); ss += lane_xor(ss, 4, lane); ss += lane_xor(ss, 8, lane);
        const float rs = rsqrtf(ss * (1.f / 128.f) + EPS);
#pragma unroll
        for (int e = 0; e < 8; ++e) v[e] *= rs * (e < 4 ? kn0[e & 3] : kn1[e & 3]);
        if (t < SEQ) { const int i0 = (sub & 7) * 8; const float* cp = WSF(WS_ROPE) + (size_t)t * 64 + i0; const float* sp = cp + SEQ * 64;
            const f32x4 c0 = *(const f32x4*)cp, c1 = *(const f32x4*)(cp + 4), s0 = *(const f32x4*)sp, s1 = *(const f32x4*)(sp + 4); const bool upper = (sub & 8) != 0;
#pragma unroll
            for (int e = 0; e < 8; ++e) { const float o = lane_xor(v[e], 8, lane), c = e < 4 ? c0[e & 3] : c1[e & 3], sn = e < 4 ? s0[e & 3] : s1[e & 3];
                v[e] = upper ? v[e] * c + o * sn : v[e] * c - o * sn; } }
        v4u ov; ov.x = pk2(v[0], v[1]); ov.y = pk2(v[2], v[3]); ov.z = pk2(v[4], v[5]); ov.w = pk2(v[6], v[7]);
        if (dry) *(v4u*)(WSB(WS_ACC) + (size_t)r * 512 + lane * 8) = ov; else *(v4u*)kp = ov; }
}

__device__ __forceinline__ void p_lru_gates_naive(Frame& F, CArgs* ka, int l) {
    const int tid = tid_fresh(); (void)tid;
    LAS float* xs = (LAS float*)F.lds;
    for (int it = F.wg; it < (MROWS / 16) * 16; it += F.G) { const int rt = it >> 4, blk = it & 15;
        __syncthreads();
#pragma unroll
        for (int j = 0; j < 4; ++j) { const int idx = tid + 512 * j, rr = idx >> 7, c = idx & 127, r = rt * 16 + rr, b = r / TPB, t = r - b * TPB, ch = blk * 128 + c;
            const int lo = t < SEQ ? 0 : SEQ, hi = t < SEQ ? SEQ : TPB; float a = KIN(10)[l * DM + ch];
#pragma unroll
            for (int k = 0; k < 4; ++k) { const int tt = t + k - 2; if (tt >= lo && tt < hi) a += KIN(9)[((size_t)l * 4 + k) * DM + ch] * bf2f(WSB(WS_P)[((size_t)b * TPB + tt) * NP + C_LX + ch]); }
            xs[rr * 128 + c] = a; }
        __syncthreads();
        const int co = tid & 127, r0 = tid >> 7, ch = blk * 128 + co;
#pragma unroll 1
        for (int dr = 0; dr < 2; ++dr) {
            const float* wr = KIN(11) + (((size_t)l * 2 + dr) * 16 + blk) * 16384 + co; const float* wi = KIN(13) + (((size_t)l * 2 + dr) * 16 + blk) * 16384 + co;
            float ar[4], ai[4];
#pragma unroll
            for (int j = 0; j < 4; ++j) { ar[j] = KIN(12)[((size_t)l * 2 + dr) * DM + ch]; ai[j] = KIN(14)[((size_t)l * 2 + dr) * DM + ch]; }
            for (int c = 0; c < 128; ++c) { const float w0 = wr[c * 128], w1 = wi[c * 128];
#pragma unroll
                for (int j = 0; j < 4; ++j) { const float xv = xs[(r0 + 4 * j) * 128 + c]; ar[j] += xv * w0; ai[j] += xv * w1; } }
            const float lam = KIN(15)[((size_t)l * 2 + dr) * DM + ch], sp = log1pf(expf(-lam));
#pragma unroll
            for (int j = 0; j < 4; ++j) { const int r = rt * 16 + r0 + 4 * j; const float rg = 1.f / (1.f + expf(-ar[j])), ig = 1.f / (1.f + expf(-ai[j]));
                const float log_a = -8.f * rg * sp, a = expf(log_a), mult = sqrtf(-expm1f(2.f * log_a));
                WSF(WS_LA)[((size_t)dr * MROWS + r) * DM + ch] = a; WSF(WS_LB)[((size_t)dr * MROWS + r) * DM + ch] = mult * ig * xs[(r0 + 4 * j) * 128 + co]; }
        }
    }
    __syncthreads();
}

__device__ __forceinline__ void p_attention(Frame& F, CArgs* ka, int l, bool need_ctx) {
    using att::bf16;
    const int n_lat = NBATCH * 16 * 8, n_all = n_lat + (need_ctx ? NBATCH * 16 : 0);
    for (int u = F.wg; u < n_all; u += F.G) {
        int b, h, q0, k0, seq; const float *cs = nullptr, *sn = nullptr;
        if (u < n_lat) { const int qb = u & 7; h = (u >> 3) & 15; b = u >> 7; q0 = qb * 256; k0 = 0; seq = TPB; cs = WSF(WS_ROPE) + (size_t)q0 * 64; sn = WSF(WS_ROPE) + (size_t)SEQ * 64 + (size_t)q0 * 64; }
        else { const int v = u - n_lat; h = v & 15; b = v >> 4; q0 = SEQ; k0 = SEQ; seq = CTXL; }
        const size_t rq = (size_t)b * TPB + q0, rk = (size_t)b * TPB + k0; const int kvh = h >> 2;
        att::attn_unit((const bf16*)(WSB(WS_P) + rq * NP + C_AQ + h * 128), (const bf16*)(WSB(WS_P) + rk * NP + C_AK + kvh * 128), (const bf16*)(WSB(WS_P) + rk * NP + C_AV + kvh * 128),
                       (const bf16*)(WSB(WS_P) + rq * NP + C_AZ + h * 128), (bf16*)(WSB(WS_YB) + ((size_t)2 * MROWS + rq) * DM + h * 128), seq, F.ldsg, KIN(18) + l * 128, cs, sn);
    }
}
__device__ __forceinline__ int seq_row(int s, int dir) { return s < CTXL ? SEQ + (dir ? CTXL - 1 - s : s) : (dir ? SEQ - 1 - (s - CTXL) : s - CTXL); }
__device__ __forceinline__ void p_mlstm_naive(Frame& F, CArgs* ka, int l) {
    const int tid = tid_fresh(), lane = tid & 63, wave = __builtin_amdgcn_readfirstlane(tid >> 6); (void)lane; (void)wave;
    LAS float* sq = (LAS float*)F.lds; LAS float* sk = sq + 256; LAS float* rn = sk + 256; LAS float* rd = rn + 512;
    const int e = tid & 63, dg = tid >> 6;
    for (int u = F.wg; u < 256; u += F.G) { const int es = u & 3, dir = (u >> 2) & 1, h = (u >> 3) & 7, b = u >> 6;
        float C[32], n[32];
#pragma unroll
        for (int i = 0; i < 32; ++i) { C[i] = 0.f; n[i] = 0.f; }
        float m = -1e30f;
        const int lcol = tid < 64 ? C_MQ + h * 256 + tid * 4 : C_MK + h * 256 + (tid - 64) * 4, vcol = C_MV + h * 256 + es * 64 + e;
        v2u pqk = {0u, 0u}; bf16_t pv; float gi, gf;
        { const size_t r = (size_t)b * TPB + seq_row(0, dir); if (tid < 128) pqk = *(const v2u*)(WSB(WS_P) + r * NP + lcol); pv = WSB(WS_P)[r * NP + vcol]; gi = WSF(WS_GT)[r * 32 + dir * 16 + h]; gf = WSF(WS_GT)[r * 32 + dir * 16 + 8 + h]; }
        __syncthreads();
        for (int s = 0; s < TPB; ++s) {
            const size_t r = (size_t)b * TPB + seq_row(s, dir);
            if (tid < 128) { LAS float* d = (tid < 64 ? sq : sk) + (tid & 63) * 4; d[0] = blo(pqk.x); d[1] = bhi(pqk.x); d[2] = blo(pqk.y); d[3] = bhi(pqk.y); }
            const float vv = bf2f(pv), iv = gi, lf = gf;
            __syncthreads();
            if (s + 1 < TPB) { const size_t r2 = (size_t)b * TPB + seq_row(s + 1, dir); if (tid < 128) pqk = *(const v2u*)(WSB(WS_P) + r2 * NP + lcol); pv = WSB(WS_P)[r2 * NP + vcol]; gi = WSF(WS_GT)[r2 * 32 + dir * 16 + h]; gf = WSF(WS_GT)[r2 * 32 + dir * 16 + 8 + h]; }
            const float mnew = fmaxf(lf + m, iv), fw = expf(lf + m - mnew), iw = expf(iv - mnew); m = mnew;
            float pn = 0.f, pd = 0.f;
#pragma unroll
            for (int dd = 0; dd < 32; ++dd) { const float kd = sk[dg * 32 + dd], qd = sq[dg * 32 + dd]; C[dd] = fw * C[dd] + iw * kd * vv; n[dd] = fw * n[dd] + iw * kd; pn += qd * C[dd]; pd += qd * n[dd]; }
            rn[dg * 64 + e] = pn; rd[dg * 64 + e] = pd;
            __syncthreads();
            if (dg == 0) { float num = 0.f, den = 0.f;
#pragma unroll
                for (int g = 0; g < 8; ++g) { num += rn[g * 64 + e]; den += rd[g * 64 + e]; }
                WSB(WS_MH)[((size_t)dir * MROWS + r) * DM + h * 256 + es * 64 + e] = (bf16_t)f2bf(num / fmaxf(fabsf(den), expf(-m))); }
        }
        __syncthreads();
    }
}
__device__ __forceinline__ void p_lru_scan_naive(Frame& F, CArgs* ka) {
    const int tid = tid_fresh(), lane = tid & 63, wave = __builtin_amdgcn_readfirstlane(tid >> 6); (void)lane; (void)wave;
    if (wave != 0) return;
    for (int cw = F.wg; cw < 256; cw += F.G) { const int combo = cw * 64 + lane, b = combo >> 12, dir = (combo >> 11) & 1, ch = combo & 2047;
        const float* A = WSF(WS_LA) + (size_t)dir * MROWS * DM + ch; const float* Bx = WSF(WS_LB) + (size_t)dir * MROWS * DM + ch; float* Ho = WSF(WS_HL) + (size_t)dir * MROWS * DM + ch; float h = 0.f;
#pragma unroll 8
        for (int s = 0; s < TPB; ++s) { const size_t r = (size_t)b * TPB + seq_row(s, dir); h = A[r * DM] * h + Bx[r * DM]; Ho[r * DM] = h; }
    }
}

__device__ __forceinline__ void p_mlout(Frame& F, CArgs* ka, int l, bool need_ctx) {
    const int tid = tid_fresh(), lane = tid & 63, wave = __builtin_amdgcn_readfirstlane(tid >> 6); (void)lane; (void)wave;
    const int gw = F.wg * NWAVES + wave, NGW = F.G * NWAVES, nrow = need_ctx ? MROWS : NBATCH * SEQ;
    for (int ri = gw; ri < nrow; ri += NGW) { const int r = need_ctx ? ri : (ri >> 11) * TPB + (ri & 2047);
        const bf16_t* pr = WSB(WS_P) + (size_t)r * NP;
        v2u ma[8], mb[8], ow[8], zw[8]; f32x4 g[8];
#pragma unroll
        for (int h = 0; h < 8; ++h) { const int col = h * 256 + lane * 4;
            ma[h] = *(const v2u*)(WSB(WS_MH) + (size_t)r * DM + col); mb[h] = *(const v2u*)(WSB(WS_MH) + ((size_t)MROWS + r) * DM + col);
            ow[h] = *(const v2u*)(pr + C_MO + col); zw[h] = *(const v2u*)(pr + C_MZ + col); g[h] = *(const f32x4*)(KIN(17) + (size_t)l * DM + col); }
#pragma unroll
        for (int h = 0; h < 8; ++h) { const int col = h * 256 + lane * 4;
            const f32x4 a = {blo(ma[h].x), bhi(ma[h].x), blo(ma[h].y), bhi(ma[h].y)}, bb = {blo(mb[h].x), bhi(mb[h].x), blo(mb[h].y), bhi(mb[h].y)};
            f32x4 v = a + bb; v.x *= blo(ow[h].x); v.y *= bhi(ow[h].x); v.z *= blo(ow[h].y); v.w *= bhi(ow[h].y);
            const float rs = rsqrtf(wave_sum(v.x * v.x + v.y * v.y + v.z * v.z + v.w * v.w, lane) * (1.f / 256.f) + EPS);
            v2u o; o.x = pk2(v.x * rs * g[h].x * blo(zw[h].x), v.y * rs * g[h].y * bhi(zw[h].x)); o.y = pk2(v.z * rs * g[h].z * blo(zw[h].y), v.w * rs * g[h].w * bhi(zw[h].y));
            *(v2u*)(WSB(WS_YB) + ((size_t)MROWS + r) * DM + col) = o; }
    }
}

__device__ __forceinline__ void p_lru_combine_naive(Frame& F, CArgs* ka) {
    const int tid = tid_fresh(), lane = tid & 63, wave = __builtin_amdgcn_readfirstlane(tid >> 6);
    const int gw = F.wg * NWAVES + wave, NGW = F.G * NWAVES;
    for (int r = gw; r < MROWS; r += NGW) {
        const bf16_t* pr = WSB(WS_P) + (size_t)r * NP;
#pragma unroll 2
        for (int j = 0; j < 8; ++j) { const int col = j * 256 + lane * 4;
            const f32x4 a = *(const f32x4*)(WSF(WS_HL) + (size_t)r * DM + col), bb = *(const f32x4*)(WSF(WS_HL) + ((size_t)MROWS + r) * DM + col); const v2u zw = *(const v2u*)(pr + C_LZ + col);
            const f32x4 v = a + bb; v2u o; o.x = pk2(v.x * blo(zw.x), v.y * bhi(zw.x)); o.y = pk2(v.z * blo(zw.y), v.w * bhi(zw.y));
            *(v2u*)(WSB(WS_YB) + (size_t)r * DM + col) = o; }
    }
}
#ifndef USE_NAIVE_ML
#define USE_NAIVE_ML 0
#endif
#ifndef USE_NAIVE_LRU
#define USE_NAIVE_LRU 0
#endif

namespace ml {
typedef short bf16x8 __attribute__((ext_vector_type(8)));
constexpr int KS_OFF = 0, KS_PITCH = 528;
constexpr int KT_OFF = KS_OFF + 64 * KS_PITCH, KT_PITCH = 144;
constexpr int VT_OFF = KT_OFF + 256 * KT_PITCH, VT_PITCH = 144;
constexpr int ST_OFF = VT_OFF + 80 * VT_PITCH, ST_PITCH = 144;
constexpr int CT_OFF = ST_OFF + 64 * ST_PITCH, CT_PITCH = 528;
constexpr int TAB_OFF = CT_OFF + 80 * CT_PITCH;
constexpr int END_OFF = TAB_OFF + 1024;
static_assert(END_OFF <= MISC_OFF, "mLSTM LDS map");
#define ML_MFMA(a, b, c) __builtin_amdgcn_mfma_f32_16x16x32_bf16((a), (b), (c), 0, 0, 0)
__device__ __forceinline__ int chunk_of(int k, int dir) { return k < 4 ? (dir ? 35 - k : 32 + k) : (dir ? 31 - (k - 4) : k - 4); }

__device__ __forceinline__ void mlstm_unit(Frame& F, CArgs* ka, int u, bool need_ctx) {
    const int tid = tid_fresh(), lane = tid & 63, w = __builtin_amdgcn_readfirstlane(tid >> 6), c16 = lane & 15, q = lane >> 4;
    const int es = u & 3, dir = (u >> 2) & 1, h = (u >> 3) & 7, b = u >> 6;
    LAS unsigned char* L = F.lds;
    const bf16_t* P = WSB(WS_P); bf16_t* MH = WSB(WS_MH) + (size_t)dir * MROWS * DM;
    const f32x4* GSC = (const f32x4*)WSF(WS_GSC) + (((size_t)b * 2 + dir) * 8 + h) * 36 * 64;
    LAS float* TABg = (LAS float*)(L + TAB_OFF); LAS float* TABmm = TABg + 64; LAS float* TABbc = TABg + 128;
    __syncthreads();
    { unsigned z0 = 0u; asm volatile("" : "+v"(z0)); const v4u zz = {z0, z0, z0, z0};
      for (int i = tid; i < 80 * CT_PITCH / 16; i += 512) *(LAS v4u*)(L + CT_OFF + i * 16) = zz; }
    for (int i = tid; i < 16 * 64; i += 512) { const int e = 64 + (i >> 6), s = i & 63; *(LAS bf16_t*)(L + VT_OFF + e * VT_PITCH + s * 2) = (bf16_t)(e == 64 ? 0x3F80 : 0); }
    f32x4 C[2][5];
#pragma unroll
    for (int a = 0; a < 2; ++a)
#pragma unroll
        for (int e = 0; e < 5; ++e) C[a][e] = (f32x4){0.f, 0.f, 0.f, 0.f};
    float m = -1e30f;
    const int tn = w & 3, wh = w >> 2;
    v4u kraw[4], vraw; bf16x8 Qf[8]; float gsc0, gsc1, gsc2;
#define ML_ROW(base, j) ((size_t)(base) + (dir ? 63 - (j) : (j)))
#define ML_LOAD_KVG(k) do { const int _c = chunk_of((k), dir), _base = b * TPB + _c * 64; const bf16_t* _rp = P + ML_ROW(_base, lane) * NP; \
        _Pragma("unroll") for (int i = 0; i < 4; ++i) kraw[i] = *(const v4u*)(_rp + C_MK + h * 256 + (w * 4 + i) * 8); \
        vraw = *(const v4u*)(_rp + C_MV + h * 256 + es * 64 + w * 8); { const float* _gp = (const float*)(GSC + _c * 64 + lane); gsc0 = _gp[0]; gsc1 = _gp[1]; gsc2 = _gp[2]; } } while (0)
#define ML_LOAD_Q(k) do { const int _base = b * TPB + chunk_of((k), dir) * 64; const bf16_t* _qp = P + ML_ROW(_base, tn * 16 + c16) * NP + C_MQ + h * 256 + q * 8; \
        _Pragma("unroll") for (int ks = 0; ks < 8; ++ks) Qf[ks] = *(const bf16x8*)(_qp + ks * 32); } while (0)
    ML_LOAD_KVG(0); ML_LOAD_Q(0);
    float bL = 0.f, mm63 = 0.f;
#pragma unroll 1
    for (int k = 0; k < 36; ++k) {
        const int base = b * TPB + chunk_of(k, dir) * 64; const bool do_out = need_ctx || k >= 4;
        if (k > 0) {
#pragma unroll
            for (int di = 0; di < 2; ++di)
#pragma unroll
                for (int en = 0; en < 5; ++en) { const f32x4 c = C[di][en]; v2u o; o.x = pk2(c[0], c[1]); o.y = pk2(c[2], c[3]);
                    *(LAS v2u*)(L + CT_OFF + (en * 16 + c16) * CT_PITCH + ((2 * w + di) * 16 + q * 4) * 2) = o; }
            m = bL + mm63; }
        const float bc = gsc0, g = gsc1, mm = fmaxf(gsc2, m), wk = __expf(g - lane_get(mm, 63));
        bL = lane_get(bc, 63); mm63 = lane_get(mm, 63);
        if (w == 0) { TABg[lane] = g; TABmm[lane] = mm; TABbc[lane] = bc; }
#pragma unroll
        for (int i = 0; i < 4; ++i) { *(LAS v4u*)(L + KS_OFF + lane * KS_PITCH + (w * 4 + i) * 16) = kraw[i];
#pragma unroll
            for (int e = 0; e < 4; ++e) { const unsigned x = kraw[i][e]; const unsigned pk = pk2(blo(x) * wk, bhi(x) * wk);
                *(LAS bf16_t*)(L + KT_OFF + ((w * 4 + i) * 8 + 2 * e) * KT_PITCH + lane * 2) = (bf16_t)(pk & 0xffffu); *(LAS bf16_t*)(L + KT_OFF + ((w * 4 + i) * 8 + 2 * e + 1) * KT_PITCH + lane * 2) = (bf16_t)(pk >> 16); } }
#pragma unroll
        for (int e = 0; e < 4; ++e) { const unsigned x = vraw[e];
            *(LAS bf16_t*)(L + VT_OFF + (w * 8 + 2 * e) * VT_PITCH + lane * 2) = (bf16_t)(x & 0xffffu); *(LAS bf16_t*)(L + VT_OFF + (w * 8 + 2 * e + 1) * VT_PITCH + lane * 2) = (bf16_t)(x >> 16); }
        __syncthreads();
        const int t = tn * 16 + c16; const int kn = k + 1 < 36 ? k + 1 : 35;
        if (do_out) {
            const float mmt = TABmm[t];
#pragma unroll
            for (int si = 0; si < 2; ++si) { const int sm = wh * 2 + si; v2u o = {0u, 0u};
                if (sm <= tn) { f32x4 acc = {0.f, 0.f, 0.f, 0.f};
#pragma unroll
                    for (int ks = 0; ks < 8; ++ks) { const bf16x8 a = *(const LAS bf16x8*)(L + KS_OFF + (sm * 16 + c16) * KS_PITCH + (ks * 32 + q * 8) * 2); acc = ML_MFMA(a, Qf[ks], acc); }
                    float v[4];
#pragma unroll
                    for (int j = 0; j < 4; ++j) { const int s = sm * 16 + q * 4 + j; v[j] = s <= t ? acc[j] * __expf(TABg[s] - mmt) : 0.f; }
                    o.x = pk2(v[0], v[1]); o.y = pk2(v[2], v[3]); }
                *(LAS v2u*)(L + ST_OFF + t * ST_PITCH + (sm * 16 + q * 4) * 2) = o; }
        }
        ML_LOAD_KVG(kn);
        __syncthreads();
        f32x4 num0 = {0.f, 0.f, 0.f, 0.f}, num1 = {0.f, 0.f, 0.f, 0.f}; float den = 1.f;
        if (do_out) {
            const float wi = __expf(m - TABmm[t]);
            bf16x8 sb[2];
#pragma unroll
            for (int ks = 0; ks < 2; ++ks) sb[ks] = *(const LAS bf16x8*)(L + ST_OFF + t * ST_PITCH + (ks * 32 + q * 8) * 2);
#pragma unroll
            for (int ei = 0; ei < 3; ++ei) { const int em = ei < 2 ? wh * 2 + ei : 4;
                f32x4 a1 = {0.f, 0.f, 0.f, 0.f}, a2 = {0.f, 0.f, 0.f, 0.f};
#pragma unroll
                for (int ks = 0; ks < 2; ++ks) { const bf16x8 a = *(const LAS bf16x8*)(L + VT_OFF + (em * 16 + c16) * VT_PITCH + (ks * 32 + q * 8) * 2); a1 = ML_MFMA(a, sb[ks], a1); }
#pragma unroll
                for (int ks = 0; ks < 8; ++ks) { const bf16x8 a = *(const LAS bf16x8*)(L + CT_OFF + (em * 16 + c16) * CT_PITCH + (ks * 32 + q * 8) * 2); a2 = ML_MFMA(a, Qf[ks], a2); }
                const f32x4 nv = a1 + a2 * wi;
                if (ei == 0) num0 = nv; else if (ei == 1) num1 = nv;
                else den = fmaxf(fabsf(lane_get(nv[0], c16)), __expf(-(TABbc[t] + TABmm[t]))); }
        }
        ML_LOAD_Q(kn);
        if (do_out) { const float rd = 1.f / den; bf16_t* op = MH + ML_ROW(base, t) * DM + h * 256 + es * 64 + q * 4; const f32x4 o0 = num0 * rd, o1 = num1 * rd;
            v2u w0, w1; w0.x = pk2(o0[0], o0[1]); w0.y = pk2(o0[2], o0[3]); w1.x = pk2(o1[0], o1[1]); w1.y = pk2(o1[2], o1[3]);
            *(v2u*)(op + (wh * 2) * 16) = w0; *(v2u*)(op + (wh * 2 + 1) * 16) = w1; }
        { const float decay = __expf(m - mm63);
          bf16x8 vb[5][2];
#pragma unroll
          for (int en = 0; en < 5; ++en)
#pragma unroll
              for (int ks = 0; ks < 2; ++ks) vb[en][ks] = *(const LAS bf16x8*)(L + VT_OFF + (en * 16 + c16) * VT_PITCH + (ks * 32 + q * 8) * 2);
#pragma unroll
          for (int di = 0; di < 2; ++di) {
            bf16x8 a[2];
#pragma unroll
            for (int ks = 0; ks < 2; ++ks) a[ks] = *(const LAS bf16x8*)(L + KT_OFF + ((2 * w + di) * 16 + c16) * KT_PITCH + (ks * 32 + q * 8) * 2);
#pragma unroll
            for (int en = 0; en < 5; ++en) { f32x4 c = C[di][en] * decay;
#pragma unroll
                for (int ks = 0; ks < 2; ++ks) c = ML_MFMA(a[ks], vb[en][ks], c);
                C[di][en] = c; } } }
        __syncthreads();
    }
#undef ML_ROW
#undef ML_LOAD_KVG
#undef ML_LOAD_Q
}
constexpr int ST2_OFF = TAB_OFF + 1024, TAB2_OFF = ST2_OFF + 64 * ST_PITCH, END2_OFF = TAB2_OFF + 1024;
static_assert(END2_OFF <= MISC_OFF, "mLSTM LDS map (pipelined)");
template <int VAR> __device__ __forceinline__ void mlstm_unit_pipe(Frame& F, CArgs* ka, int u, bool need_ctx) {
    const int tid = tid_fresh(), lane = tid & 63, w = __builtin_amdgcn_readfirstlane(tid >> 6), c16 = lane & 15, q = lane >> 4;
    const int es = u & 3, dir = (u >> 2) & 1, h = (u >> 3) & 7, b = u >> 6;
    LAS unsigned char* L = F.lds;
    const bf16_t* X8 = WSB(WS_X8); constexpr size_t X8_SEC = (size_t)MROWS * DM; bf16_t* MH = (VAR ? WSB(WS_ACC) : WSB(WS_MH)) + (size_t)dir * MROWS * DM;
    const f32x4* GSC = (const f32x4*)WSF(WS_GSC) + (((size_t)b * 2 + dir) * 8 + h) * 36 * 64;
    __syncthreads();
    { unsigned z0 = 0u; asm volatile("" : "+v"(z0)); const v4u zz = {z0, z0, z0, z0};
      for (int i = tid; i < 80 * CT_PITCH / 16; i += 512) *(LAS v4u*)(L + CT_OFF + i * 16) = zz; }
    for (int i = tid; i < 16 * 64; i += 512) { const int e = 64 + (i >> 6), s = i & 63; *(LAS bf16_t*)(L + VT_OFF + e * VT_PITCH + s * 2) = (bf16_t)(e == 64 ? 0x3F80 : 0); }
    f32x4 C[2][5];
#pragma unroll
    for (int a = 0; a < 2; ++a)
#pragma unroll
        for (int e = 0; e < 5; ++e) C[a][e] = (f32x4){0.f, 0.f, 0.f, 0.f};
    const int tn = w & 3, wh = w >> 2, t = tn * 16 + c16;
    const int kl = (dir ? 63 - lane : lane) * 8, ql = q * 512 + (dir ? 63 - t : t) * 8;
    v4u kc[4], kn[4], vc; bf16x8 Qc[8], Qn[8]; float gc0, gc1, gc2, gn0, gn1, gn2;
#define MLP_ROW(base, j) ((size_t)(base) + (dir ? 63 - (j) : (j)))
#define MLP_TAB(par) ((LAS float*)(L + ((par) ? TAB2_OFF : TAB_OFF)))
#define MLP_ST(par) ((par) ? ST2_OFF : ST_OFF)
#define MLP_XB(sec, c_) (X8 + (size_t)(sec) * X8_SEC + ((size_t)(b * 8 + h) * 36 + (c_)) * (32 * 64 * 8))
#define MLP_LOADK(dst, k) do { const bf16_t* _xb = MLP_XB(1, chunk_of((k), dir)) + w * 4 * 512; \
        _Pragma("unroll") for (int i = 0; i < 4; ++i) dst[i] = *(const v4u*)(_xb + i * 512 + kl); } while (0)
#define MLP_LOADV(dst, k) do { dst = *(const v4u*)(MLP_XB(2, chunk_of((k), dir)) + (es * 8 + w) * 512 + kl); } while (0)
#define MLP_LOADG(d0, d1, d2, k) do { const float* _gp = (const float*)(GSC + chunk_of((k), dir) * 64 + lane); d0 = _gp[0]; d1 = _gp[1]; d2 = _gp[2]; } while (0)
#define MLP_LOADQ(dst, k) do { const bf16_t* _xb = MLP_XB(0, chunk_of((k), dir)); \
        _Pragma("unroll") for (int ks = 0; ks < 8; ++ks) dst[ks] = *(const bf16x8*)(_xb + ks * 2048 + ql); } while (0)
#define MLP_STILE(QQ, TB, SO) do { const float _mmt = (TB)[64 + t]; \
        _Pragma("unroll") for (int si = 0; si < 2; ++si) { const int sm = wh * 2 + si; v2u o = {0u, 0u}; \
            if (sm <= tn) { f32x4 acc = {0.f, 0.f, 0.f, 0.f}; \
                bf16x8 ka_[8]; \
                _Pragma("unroll") for (int ks = 0; ks < 8; ++ks) ka_[ks] = *(const LAS bf16x8*)(L + KS_OFF + (sm * 16 + c16) * KS_PITCH + (ks * 32 + q * 8) * 2); \
                __builtin_amdgcn_sched_barrier(0); \
                _Pragma("unroll") for (int ks = 0; ks < 8; ++ks) acc = ML_MFMA(ka_[ks], QQ[ks], acc); \
                float v[4]; \
                _Pragma("unroll") for (int j = 0; j < 4; ++j) { const int s = sm * 16 + q * 4 + j; v[j] = s <= t ? acc[j] * __expf((TB)[s] - _mmt) : 0.f; } \
                o.x = pk2(v[0], v[1]); o.y = pk2(v[2], v[3]); } \
            *(LAS v2u*)(L + (SO) + t * ST_PITCH + (sm * 16 + q * 4) * 2) = o; } } while (0)
    MLP_LOADK(kc, 0); MLP_LOADV(vc, 0); MLP_LOADG(gc0, gc1, gc2, 0); MLP_LOADQ(Qc, 0); MLP_LOADK(kn, 1); MLP_LOADG(gn0, gn1, gn2, 1); MLP_LOADQ(Qn, 1);
    float m = -1e30f;
    {
      const float mm = fmaxf(gc2, m); LAS float* TB = MLP_TAB(0);
      if (w == 0) { TB[lane] = gc1; TB[64 + lane] = mm; TB[128 + lane] = gc0; }
#pragma unroll
      for (int i = 0; i < 4; ++i) *(LAS v4u*)(L + KS_OFF + lane * KS_PITCH + (w * 4 + i) * 16) = kc[i];
      __syncthreads();
      if (need_ctx) MLP_STILE(Qc, TB, MLP_ST(0));
      __syncthreads(); }
#pragma unroll 1
    for (int k = 0; k < 36; ++k) {
        const int par = k & 1, k1 = k + 1 < 36 ? k + 1 : 35, k2 = k + 2 < 36 ? k + 2 : 35;
        const bool do_out = need_ctx || k >= 4, s_next = (k + 1 < 36) && (need_ctx || k + 1 >= 4);
        const size_t base = (size_t)b * TPB + chunk_of(k, dir) * 64;
        if (k > 0 && VAR != 2) {
#pragma unroll
            for (int di = 0; di < 2; ++di)
#pragma unroll
                for (int en = 0; en < 5; ++en) { const f32x4 c = C[di][en]; v2u o; o.x = pk2(c[0], c[1]); o.y = pk2(c[2], c[3]);
                    *(LAS v2u*)(L + CT_OFF + (en * 16 + c16) * CT_PITCH + ((2 * w + di) * 16 + q * 4) * 2) = o; } }
        const float mm = fmaxf(gc2, m), bL = lane_get(gc0, 63), mm63 = lane_get(mm, 63), wk = __expf(gc1 - mm63), m_next = bL + mm63;
#pragma unroll
        for (int i = 0; i < (VAR == 2 ? 1 : 4); ++i) {
#pragma unroll
            for (int e = 0; e < (VAR == 2 ? 1 : 4); ++e) { const unsigned x = kc[i][e]; const unsigned pk = pk2(blo(x) * wk, bhi(x) * wk);
                *(LAS bf16_t*)(L + KT_OFF + ((w * 4 + i) * 8 + 2 * e) * KT_PITCH + lane * 2) = (bf16_t)(pk & 0xffffu); *(LAS bf16_t*)(L + KT_OFF + ((w * 4 + i) * 8 + 2 * e + 1) * KT_PITCH + lane * 2) = (bf16_t)(pk >> 16); } }
#pragma unroll
        for (int e = 0; e < 4; ++e) { const unsigned x = vc[e];
            *(LAS bf16_t*)(L + VT_OFF + (w * 8 + 2 * e) * VT_PITCH + lane * 2) = (bf16_t)(x & 0xffffu); *(LAS bf16_t*)(L + VT_OFF + (w * 8 + 2 * e + 1) * VT_PITCH + lane * 2) = (bf16_t)(x >> 16); }
        { const float mmn = fmaxf(gn2, m_next); LAS float* TBn = MLP_TAB(par ^ 1);
          if (w == 0) { TBn[lane] = gn1; TBn[64 + lane] = mmn; TBn[128 + lane] = gn0; }
#pragma unroll
          for (int i = 0; i < (VAR == 2 ? 1 : 4); ++i) *(LAS v4u*)(L + KS_OFF + lane * KS_PITCH + (w * 4 + i) * 16) = kn[i]; }
        __syncthreads();
#pragma unroll
        for (int i = 0; i < 4; ++i) kc[i] = kn[i];
        gc0 = gn0; gc1 = gn1; gc2 = gn2;
        if (VAR != 3) { MLP_LOADK(kn, k2); MLP_LOADV(vc, k1); MLP_LOADG(gn0, gn1, gn2, k2); }
        const LAS float* TB = MLP_TAB(par);
        if (do_out && VAR != 1) {
            const float wi = __expf(m - TB[64 + t]); f32x4 num0 = {0.f, 0.f, 0.f, 0.f}, num1 = {0.f, 0.f, 0.f, 0.f}; float den = 1.f;
            bf16x8 sb[2];
#pragma unroll
            for (int ks = 0; ks < 2; ++ks) sb[ks] = *(const LAS bf16x8*)(L + MLP_ST(par) + t * ST_PITCH + (ks * 32 + q * 8) * 2);
#pragma unroll
            for (int ei = 0; ei < 3; ++ei) { const int em = ei < 2 ? wh * 2 + ei : 4;
                f32x4 a1 = {0.f, 0.f, 0.f, 0.f}, a2 = {0.f, 0.f, 0.f, 0.f}; bf16x8 va_[2], ca_[8];
#pragma unroll
                for (int ks = 0; ks < 2; ++ks) va_[ks] = *(const LAS bf16x8*)(L + VT_OFF + (em * 16 + c16) * VT_PITCH + (ks * 32 + q * 8) * 2);
#pragma unroll
                for (int ks = 0; ks < 8; ++ks) ca_[ks] = *(const LAS bf16x8*)(L + CT_OFF + (em * 16 + c16) * CT_PITCH + (ks * 32 + q * 8) * 2);
                __builtin_amdgcn_sched_barrier(0);
#pragma unroll
                for (int ks = 0; ks < 2; ++ks) a1 = ML_MFMA(va_[ks], sb[ks], a1);
#pragma unroll
                for (int ks = 0; ks < 8; ++ks) a2 = ML_MFMA(ca_[ks], Qc[ks], a2);
                __builtin_amdgcn_sched_barrier(0);
                const f32x4 nv = a1 + a2 * wi;
                if (ei == 0) num0 = nv; else if (ei == 1) num1 = nv;
                else den = fmaxf(fabsf(lane_get(nv[0], c16)), __expf(-(TB[128 + t] + TB[64 + t]))); }
            const float rd = 1.f / den; bf16_t* op = MH + MLP_ROW(base, t) * DM + h * 256 + es * 64 + q * 4; const f32x4 o0 = num0 * rd, o1 = num1 * rd;
            v2u w0, w1; w0.x = pk2(o0[0], o0[1]); w0.y = pk2(o0[2], o0[3]); w1.x = pk2(o1[0], o1[1]); w1.y = pk2(o1[2], o1[3]);
            *(v2u*)(op + (wh * 2) * 16) = w0; *(v2u*)(op + (wh * 2 + 1) * 16) = w1;
        }
        if (VAR != 1) { const float decay = __expf(m - mm63); bf16x8 vb_[5][2], ka2_[2][2];
#pragma unroll
          for (int en = 0; en < 5; ++en)
#pragma unroll
              for (int ks = 0; ks < 2; ++ks) vb_[en][ks] = *(const LAS bf16x8*)(L + VT_OFF + (en * 16 + c16) * VT_PITCH + (ks * 32 + q * 8) * 2);
#pragma unroll
          for (int di = 0; di < 2; ++di)
#pragma unroll
              for (int ks = 0; ks < 2; ++ks) ka2_[di][ks] = *(const LAS bf16x8*)(L + KT_OFF + ((2 * w + di) * 16 + c16) * KT_PITCH + (ks * 32 + q * 8) * 2);
#pragma unroll
          for (int di = 0; di < 2; ++di)
#pragma unroll
              for (int en = 0; en < 5; ++en) C[di][en] = C[di][en] * decay;
          __builtin_amdgcn_sched_barrier(0);
#pragma unroll
          for (int di = 0; di < 2; ++di)
#pragma unroll
              for (int en = 0; en < 5; ++en)
#pragma unroll
                  for (int ks = 0; ks < 2; ++ks) C[di][en] = ML_MFMA(ka2_[di][ks], vb_[en][ks], C[di][en]);
          __builtin_amdgcn_sched_barrier(0); }
        if (s_next && VAR != 1) MLP_STILE(Qn, MLP_TAB(par ^ 1), MLP_ST(par ^ 1));
#pragma unroll
        for (int ks = 0; ks < 8; ++ks) Qc[ks] = Qn[ks];
        if (VAR != 3) MLP_LOADQ(Qn, k2);
        m = m_next;
        __syncthreads();
    }
#undef MLP_ROW
#undef MLP_TAB
#undef MLP_ST
#undef MLP_XB
#undef MLP_LOADK
#undef MLP_LOADV
#undef MLP_LOADG
#undef MLP_LOADQ
#undef MLP_STILE
}
constexpr int T_CT = 0, T_CT_ROWS = 65;
constexpr int T_KS0 = T_CT + T_CT_ROWS * CT_PITCH, T_KS1 = T_KS0 + 64 * KS_PITCH;
constexpr int T_VS = T_KS1 + 64 * KS_PITCH, T_VPITCH = 160, T_VSW = T_VS + 64 * T_VPITCH;
constexpr int T_ST0 = T_VSW + 64 * T_VPITCH, T_ST1 = T_ST0 + 64 * ST_PITCH, T_TAB0 = T_ST1 + 64 * ST_PITCH, T_TAB1 = T_TAB0 + 1024, T_END = T_TAB1 + 1024;
static_assert(T_END <= MISC_OFF && T_CT + 80 * CT_PITCH <= T_END && T_KS0 % 16 == 0, "mLSTM LDS map (transposed reads)");
typedef short s16x4 __attribute__((ext_vector_type(4)));
template <int OFF> __device__ __forceinline__ s16x4 tr4(unsigned addr) { s16x4 r; asm volatile("ds_read_b64_tr_b16 %0, %1 offset:%2" : "=&v"(r) : "v"(addr), "i"(OFF) : "memory"); return r; }
#define TR_FRAG(OUT, addr, OFF0, OFF1) do { const s16x4 _a = tr4<(OFF0)>(addr), _b = tr4<(OFF1)>(addr); OUT##_lo = _a; OUT##_hi = _b; } while (0)
#define TR_JOIN(lo, hi) ((bf16x8){lo[0], lo[1], lo[2], lo[3], hi[0], hi[1], hi[2], hi[3]})
__device__ __forceinline__ void mlstm_unit_tr(Frame& F, CArgs* ka, int u, bool need_ctx) {
    const int tid = tid_fresh(), lane = tid & 63, w = __builtin_amdgcn_readfirstlane(tid >> 6), c16 = lane & 15, q = lane >> 4;
    const int es = u & 3, dir = (u >> 2) & 1, h = (u >> 3) & 7, b = u >> 6;
    LAS unsigned char* L = F.lds;
    const bf16_t* X8 = WSB(WS_X8); constexpr size_t X8_SEC = (size_t)MROWS * DM; bf16_t* MH = WSB(WS_MH) + (size_t)dir * MROWS * DM;
    const f32x4* GSC = (const f32x4*)WSF(WS_GSC) + (((size_t)b * 2 + dir) * 8 + h) * 36 * 64;
    __syncthreads();
    { unsigned z0 = 0u; asm volatile("" : "+v"(z0)); const v4u zz = {z0, z0, z0, z0};
      for (int i = tid; i < T_CT_ROWS * CT_PITCH / 16; i += 512) *(LAS v4u*)(L + T_CT + i * 16) = zz;
      if (tid < 128) { const int s = tid & 63, hf = tid >> 6; v4u one = zz; if (hf == 0) one.x = 0x3F80u;
          *(LAS v4u*)(L + T_VS + s * T_VPITCH + 128 + hf * 16) = one; *(LAS v4u*)(L + T_VSW + s * T_VPITCH + 128 + hf * 16) = zz; } }
    f32x4 C[2][5];
#pragma unroll
    for (int a = 0; a < 2; ++a)
#pragma unroll
        for (int e = 0; e < 5; ++e) C[a][e] = (f32x4){0.f, 0.f, 0.f, 0.f};
    const int tn = w & 3, wh = w >> 2, t = tn * 16 + c16;
    const int kl = (dir ? 63 - lane : lane) * 8, ql = q * 512 + (dir ? 63 - t : t) * 8;
    const unsigned LB = (unsigned)(size_t)L;
    const unsigned trK = (unsigned)((8 * q + (c16 >> 2)) * KS_PITCH + 8 * (lane & 3) + 64 * w), trV = (unsigned)((8 * q + (c16 >> 2)) * T_VPITCH + 8 * (lane & 3));
    v4u kn[4], vc; bf16x8 Qc[8], Qn[8]; float gc0, gc1, gc2, gn0, gn1, gn2;
#define MLP_ROW(base, j) ((size_t)(base) + (dir ? 63 - (j) : (j)))
#define MLP_TAB(par) ((LAS float*)(L + ((par) ? T_TAB1 : T_TAB0)))
#define MLP_ST(par) ((par) ? T_ST1 : T_ST0)
#define MLP_KS(par) ((par) ? T_KS1 : T_KS0)
#define MLP_XB(sec, c_) (X8 + (size_t)(sec) * X8_SEC + ((size_t)(b * 8 + h) * 36 + (c_)) * (32 * 64 * 8))
#define MLP_LOADK(dst, k) do { const bf16_t* _xb = MLP_XB(1, chunk_of((k), dir)) + w * 4 * 512; \
        _Pragma("unroll") for (int i = 0; i < 4; ++i) dst[i] = *(const v4u*)(_xb + i * 512 + kl); } while (0)
#define MLP_LOADV(dst, k) do { dst = *(const v4u*)(MLP_XB(2, chunk_of((k), dir)) + (es * 8 + w) * 512 + kl); } while (0)
#define MLP_LOADG(d0, d1, d2, k) do { const float* _gp = (const float*)(GSC + chunk_of((k), dir) * 64 + lane); d0 = _gp[0]; d1 = _gp[1]; d2 = _gp[2]; } while (0)
#define MLP_LOADQ(dst, k) do { const bf16_t* _xb = MLP_XB(0, chunk_of((k), dir)); \
        _Pragma("unroll") for (int ks = 0; ks < 8; ++ks) dst[ks] = *(const bf16x8*)(_xb + ks * 2048 + ql); } while (0)
#define MLP_STILE(QQ, TB, SO, KSO) do { const float _mmt = (TB)[64 + t]; \
        _Pragma("unroll") for (int si = 0; si < 2; ++si) { const int sm = wh * 2 + si; v2u o = {0u, 0u}; \
            if (sm <= tn) { f32x4 acc = {0.f, 0.f, 0.f, 0.f}; \
                bf16x8 ka_[8]; \
                _Pragma("unroll") for (int ks = 0; ks < 8; ++ks) ka_[ks] = *(const LAS bf16x8*)(L + (KSO) + (sm * 16 + c16) * KS_PITCH + (ks * 32 + q * 8) * 2); \
                __builtin_amdgcn_sched_barrier(0); \
                _Pragma("unroll") for (int ks = 0; ks < 8; ++ks) acc = ML_MFMA(ka_[ks], QQ[ks], acc); \
                float v[4]; \
                _Pragma("unroll") for (int j = 0; j < 4; ++j) { const int s = sm * 16 + q * 4 + j; v[j] = s <= t ? acc[j] * __expf((TB)[s] - _mmt) : 0.f; } \
                o.x = pk2(v[0], v[1]); o.y = pk2(v[2], v[3]); } \
            *(LAS v2u*)(L + (SO) + t * ST_PITCH + (sm * 16 + q * 4) * 2) = o; } } while (0)
    MLP_LOADK(kn, 0); MLP_LOADV(vc, 0); MLP_LOADG(gc0, gc1, gc2, 0); MLP_LOADQ(Qc, 0); MLP_LOADG(gn0, gn1, gn2, 1); MLP_LOADQ(Qn, 1);
    float m = -1e30f;
    { const float mm = fmaxf(gc2, m); LAS float* TB = MLP_TAB(0);
      if (w == 0) { TB[lane] = gc1; TB[64 + lane] = mm; TB[128 + lane] = gc0; }
#pragma unroll
      for (int i = 0; i < 4; ++i) *(LAS v4u*)(L + T_KS0 + lane * KS_PITCH + (w * 4 + i) * 16) = kn[i];
      MLP_LOADK(kn, 1);
      __syncthreads();
      if (need_ctx) MLP_STILE(Qc, TB, MLP_ST(0), T_KS0);
      __syncthreads(); }
#pragma unroll 1
    for (int k = 0; k < 36; ++k) {
        const int par = k & 1, k1 = k + 1 < 36 ? k + 1 : 35, k2 = k + 2 < 36 ? k + 2 : 35;
        const bool do_out = need_ctx || k >= 4, s_next = (k + 1 < 36) && (need_ctx || k + 1 >= 4);
        const size_t base = (size_t)b * TPB + chunk_of(k, dir) * 64;
        if (k > 0) {
#pragma unroll
            for (int di = 0; di < 2; ++di)
#pragma unroll
                for (int en = 0; en < 5; ++en) { const f32x4 c = C[di][en]; v2u o; o.x = pk2(c[0], c[1]); o.y = pk2(c[2], c[3]);
                    if (en < 4 || c16 == 0) *(LAS v2u*)(L + T_CT + (en * 16 + c16) * CT_PITCH + ((2 * w + di) * 16 + q * 4) * 2) = o; } }
        const float mm = fmaxf(gc2, m), bL = lane_get(gc0, 63), mm63 = lane_get(mm, 63), wk = __expf(gc1 - mm63), m_next = bL + mm63;
        { *(LAS v4u*)(L + T_VS + lane * T_VPITCH + w * 16) = vc;
          v4u sv;
#pragma unroll
          for (int e = 0; e < 4; ++e) sv[e] = pk2(blo(vc[e]) * wk, bhi(vc[e]) * wk);
          *(LAS v4u*)(L + T_VSW + lane * T_VPITCH + w * 16) = sv;
          if (w == 0) *(LAS bf16_t*)(L + T_VSW + lane * T_VPITCH + 128) = (bf16_t)(pk2(wk, 0.f) & 0xffffu); }
        { const float mmn = fmaxf(gn2, m_next); LAS float* TBn = MLP_TAB(par ^ 1);
          if (w == 0) { TBn[lane] = gn1; TBn[64 + lane] = mmn; TBn[128 + lane] = gn0; }
#pragma unroll
          for (int i = 0; i < 4; ++i) *(LAS v4u*)(L + MLP_KS(par ^ 1) + lane * KS_PITCH + (w * 4 + i) * 16) = kn[i]; }
        __syncthreads();
        gc0 = gn0; gc1 = gn1; gc2 = gn2;
        MLP_LOADK(kn, k2); MLP_LOADV(vc, k1); MLP_LOADG(gn0, gn1, gn2, k2);
        const LAS float* TB = MLP_TAB(par);
        if (do_out) {
            const float wi = __expf(m - TB[64 + t]); f32x4 num0 = {0.f, 0.f, 0.f, 0.f}, num1 = {0.f, 0.f, 0.f, 0.f}; float den = 1.f;
            bf16x8 sb[2];
#pragma unroll
            for (int ks = 0; ks < 2; ++ks) sb[ks] = *(const LAS bf16x8*)(L + MLP_ST(par) + t * ST_PITCH + (ks * 32 + q * 8) * 2);
#pragma unroll
            for (int ei = 0; ei < 3; ++ei) { const int em = ei < 2 ? wh * 2 + ei : 4;
                f32x4 a1 = {0.f, 0.f, 0.f, 0.f}, a2 = {0.f, 0.f, 0.f, 0.f}; bf16x8 ca_[8];
                const unsigned va = LB + T_VS + trV + 32 * em;
                const s16x4 v00 = tr4<0>(va), v01 = tr4<4 * T_VPITCH>(va), v10 = tr4<32 * T_VPITCH>(va), v11 = tr4<36 * T_VPITCH>(va);
#pragma unroll
                for (int ks = 0; ks < 8; ++ks) ca_[ks] = *(const LAS bf16x8*)(L + T_CT + (em * 16 + c16) * CT_PITCH + (ks * 32 + q * 8) * 2);
                asm volatile("s_waitcnt lgkmcnt(0)" ::: "memory"); __builtin_amdgcn_sched_barrier(0);
                a1 = ML_MFMA(TR_JOIN(v00, v01), sb[0], a1); a1 = ML_MFMA(TR_JOIN(v10, v11), sb[1], a1);
#pragma unroll
                for (int ks = 0; ks < 8; ++ks) a2 = ML_MFMA(ca_[ks], Qc[ks], a2);
                __builtin_amdgcn_sched_barrier(0);
                const f32x4 nv = a1 + a2 * wi;
                if (ei == 0) num0 = nv; else if (ei == 1) num1 = nv;
                else den = fmaxf(fabsf(lane_get(nv[0], c16)), __expf(-(TB[128 + t] + TB[64 + t]))); }
            const float rd = 1.f / den; bf16_t* op = MH + MLP_ROW(base, t) * DM + h * 256 + es * 64 + q * 4; const f32x4 o0 = num0 * rd, o1 = num1 * rd;
            v2u w0, w1; w0.x = pk2(o0[0], o0[1]); w0.y = pk2(o0[2], o0[3]); w1.x = pk2(o1[0], o1[1]); w1.y = pk2(o1[2], o1[3]);
            *(v2u*)(op + (wh * 2) * 16) = w0; *(v2u*)(op + (wh * 2 + 1) * 16) = w1;
        }
        {
          const float decay = __expf(m - mm63);
          const unsigned ka_ = LB + MLP_KS(par) + trK, vb_ = LB + T_VSW + trV;
          const s16x4 k000 = tr4<0>(ka_), k001 = tr4<4 * KS_PITCH>(ka_), k010 = tr4<32 * KS_PITCH>(ka_), k011 = tr4<36 * KS_PITCH>(ka_);
          const s16x4 k100 = tr4<32>(ka_), k101 = tr4<4 * KS_PITCH + 32>(ka_), k110 = tr4<32 * KS_PITCH + 32>(ka_), k111 = tr4<36 * KS_PITCH + 32>(ka_);
          s16x4 vq[5][4];
#define TRV(en) do { vq[en][0] = tr4<32 * (en)>(vb_); vq[en][1] = tr4<4 * T_VPITCH + 32 * (en)>(vb_); vq[en][2] = tr4<32 * T_VPITCH + 32 * (en)>(vb_); vq[en][3] = tr4<36 * T_VPITCH + 32 * (en)>(vb_); } while (0)
          TRV(0); TRV(1); TRV(2); TRV(3); TRV(4);
#undef TRV
#pragma unroll
          for (int di = 0; di < 2; ++di)
#pragma unroll
              for (int en = 0; en < 5; ++en) C[di][en] = C[di][en] * decay;
          asm volatile("s_waitcnt lgkmcnt(0)" ::: "memory"); __builtin_amdgcn_sched_barrier(0);
#pragma unroll
          for (int en = 0; en < 5; ++en) { const bf16x8 b0 = TR_JOIN(vq[en][0], vq[en][1]), b1 = TR_JOIN(vq[en][2], vq[en][3]);
              C[0][en] = ML_MFMA(TR_JOIN(k000, k001), b0, C[0][en]); C[0][en] = ML_MFMA(TR_JOIN(k010, k011), b1, C[0][en]);
              C[1][en] = ML_MFMA(TR_JOIN(k100, k101), b0, C[1][en]); C[1][en] = ML_MFMA(TR_JOIN(k110, k111), b1, C[1][en]); }
          __builtin_amdgcn_sched_barrier(0); }
        if (s_next) MLP_STILE(Qn, MLP_TAB(par ^ 1), MLP_ST(par ^ 1), MLP_KS(par ^ 1));
#pragma unroll
        for (int ks = 0; ks < 8; ++ks) Qc[ks] = Qn[ks];
        MLP_LOADQ(Qn, k2);
        m = m_next;
        __syncthreads();
    }
#undef MLP_ROW
#undef MLP_TAB
#undef MLP_ST
#undef MLP_KS
#undef MLP_XB
#undef MLP_LOADK
#undef MLP_LOADV
#undef MLP_LOADG
#undef MLP_LOADQ
#undef MLP_STILE
}
}

namespace lru {
typedef short bf16x8 __attribute__((ext_vector_type(8)));
constexpr int XB_OFF = 0, XB_PITCH = 272;
constexpr int XF_OFF = XB_OFF + 64 * XB_PITCH, XF_PITCH = 528;
constexpr int YO_OFF = XF_OFF + 64 * XF_PITCH, YO_PITCH = 528;
constexpr int HIN_OFF = YO_OFF + 64 * YO_PITCH;
constexpr int CW_OFF = HIN_OFF + 9 * 2 * 128 * 4;
constexpr int END_OFF = CW_OFF + 5 * 128 * 4;
static_assert(END_OFF <= MISC_OFF, "LRU LDS map");
#define LRU_COMPOSE(A, B, a2, b2) do { B = (a2) * B + (b2); A = (a2) * A; } while (0)

template <bool FINAL, int VAR, class BcOf>
__device__ __forceinline__ void lru_run(Frame& F, CArgs* ka, int l, int blk, int NU, const BcOf& bc_of) {
    const int tid = tid_fresh(), lane = tid & 63, w = __builtin_amdgcn_readfirstlane(tid >> 6), c16 = lane & 15, q = lane >> 4;
    LAS unsigned char* L = F.lds; const bf16_t* P = WSB(WS_P);
    const int cg = tid & 15, rg = tid >> 4, chl = 16 * w + c16, ch = blk * 128 + chl;
    bf16x8 bw[4][4];
    { const bf16_t* Wt = WSB(WS_WLRU) + (size_t)l * 4 * 16 * 16384 + ((size_t)blk * 128 + chl) * 128 + q * 8;
#pragma unroll
      for (int g = 0; g < 4; ++g)
#pragma unroll
          for (int ks = 0; ks < 4; ++ks) bw[g][ks] = *(const bf16x8*)(Wt + (size_t)g * 16 * 16384 + ks * 32); }
    float cbr[2], cbi[2], csp[2];
#pragma unroll
    for (int dr = 0; dr < 2; ++dr) { cbr[dr] = KIN(12)[((size_t)l * 2 + dr) * DM + ch]; cbi[dr] = KIN(14)[((size_t)l * 2 + dr) * DM + ch]; csp[dr] = log1pf(__expf(-KIN(15)[((size_t)l * 2 + dr) * DM + ch])); }
    for (int i = tid; i < 5 * 128; i += 512) { const int kk = i >> 7, c = i & 127; ((LAS float*)(L + CW_OFF))[i] = kk < 4 ? KIN(9)[((size_t)l * 4 + kk) * DM + blk * 128 + c] : KIN(10)[(size_t)l * DM + blk * 128 + c]; }
    v4u raw[5];
#define LRU_LOAD(i) do { int _b, _c; bc_of((i), _b, _c); const int _t0 = _c * 64, _lo = _c < 32 ? 0 : SEQ, _hi = _c < 32 ? SEQ : TPB; const size_t _rb = (size_t)_b * TPB; \
        _Pragma("unroll") for (int x = 0; x < 5; ++x) { const int tt = _t0 + 2 * rg - 2 + x; raw[x] = (v4u){0u, 0u, 0u, 0u}; if (tt >= _lo && tt < _hi) raw[x] = *(const v4u*)(P + (_rb + tt) * NP + C_LX + blk * 128 + cg * 8); } \
        } while (0)
    LRU_LOAD(0);
#pragma unroll 1
    for (int ui = 0; ui < NU; ++ui) {
        int b, chunk; bc_of(ui, b, chunk); const size_t rb = (size_t)b * TPB; const int t0 = chunk * 64;
        __syncthreads();
        {
          float o0[8], o1[8]; const LAS float* cwl = (const LAS float*)(L + CW_OFF) + cg * 8;
#pragma unroll
          for (int e = 0; e < 8; ++e) { o0[e] = cwl[4 * 128 + e]; o1[e] = o0[e]; }
#pragma unroll
          for (int kk = 0; kk < 5; ++kk) { float xin[8];
#pragma unroll
              for (int e = 0; e < 4; ++e) { xin[2 * e] = blo(raw[kk][e]); xin[2 * e + 1] = bhi(raw[kk][e]); }
#pragma unroll
              for (int e = 0; e < 8; ++e) { if (kk < 4) o0[e] += cwl[kk * 128 + e] * xin[e]; if (kk > 0) o1[e] += cwl[(kk - 1) * 128 + e] * xin[e]; } }
          v4u p0, p1; p0.x = pk2(o0[0], o0[1]); p0.y = pk2(o0[2], o0[3]); p0.z = pk2(o0[4], o0[5]); p0.w = pk2(o0[6], o0[7]); p1.x = pk2(o1[0], o1[1]); p1.y = pk2(o1[2], o1[3]); p1.z = pk2(o1[4], o1[5]); p1.w = pk2(o1[6], o1[7]);
          *(LAS v4u*)(L + XB_OFF + (2 * rg) * XB_PITCH + cg * 16) = p0; *(LAS v4u*)(L + XB_OFF + (2 * rg + 1) * XB_PITCH + cg * 16) = p1;
          LAS float* f0 = (LAS float*)(L + XF_OFF + (2 * rg) * XF_PITCH + cg * 32); LAS float* f1 = (LAS float*)(L + XF_OFF + (2 * rg + 1) * XF_PITCH + cg * 32);
          *(LAS f32x4*)f0 = (f32x4){o0[0], o0[1], o0[2], o0[3]}; *(LAS f32x4*)(f0 + 4) = (f32x4){o0[4], o0[5], o0[6], o0[7]};
          *(LAS f32x4*)f1 = (f32x4){o1[0], o1[1], o1[2], o1[3]}; *(LAS f32x4*)(f1 + 4) = (f32x4){o1[4], o1[5], o1[6], o1[7]}; }
        __syncthreads();
        v4u zcur[2];
        if (FINAL) {
#pragma unroll
            for (int x = 0; x < 2; ++x) { const int cidx = tid + 512 * x; zcur[x] = *(const v4u*)(P + (rb + t0 + (cidx >> 4)) * NP + C_LZ + blk * 128 + (cidx & 15) * 8); } }
        if (ui + 1 < NU) LRU_LOAD(ui + 1);
#pragma unroll
        for (int dr = 0; dr < 2; ++dr) {
            f32x4 acc[2][4];
#pragma unroll
            for (int g = 0; g < 2; ++g)
#pragma unroll
                for (int tm = 0; tm < 4; ++tm) acc[g][tm] = (f32x4){0.f, 0.f, 0.f, 0.f};
            if (VAR < 2) {
#pragma unroll
            for (int ks = 0; ks < 4; ++ks) { bf16x8 a[4];
#pragma unroll
                for (int tm = 0; tm < 4; ++tm) a[tm] = *(const LAS bf16x8*)(L + XB_OFF + (tm * 16 + c16) * XB_PITCH + (ks * 32 + q * 8) * 2);
#pragma unroll
                for (int g = 0; g < 2; ++g)
#pragma unroll
                    for (int tm = 0; tm < 4; ++tm) acc[g][tm] = __builtin_amdgcn_mfma_f32_16x16x32_bf16(a[tm], bw[2 * dr + g][ks], acc[g][tm], 0, 0, 0); } }
            if (VAR < 1) {
                typedef float f32x2 __attribute__((ext_vector_type(2)));
                const float NL2E = -1.4426950408889634f; const float kr = cbr[dr] * NL2E, ki = cbi[dr] * NL2E, c16l = -16.f * csp[dr], c8l2 = -8.f * csp[dr] * 1.4426950408889634f;
#pragma unroll
                for (int tm = 0; tm < 4; ++tm)
#pragma unroll
                    for (int jp = 0; jp < 2; ++jp) { const int t = tm * 16 + q * 4 + 2 * jp;
                        const f32x2 xv = {*(const LAS float*)(L + XF_OFF + t * XF_PITCH + chl * 4), *(const LAS float*)(L + XF_OFF + (t + 1) * XF_PITCH + chl * 4)};
                        const f32x2 ar = {acc[0][tm][2 * jp], acc[0][tm][2 * jp + 1]}, ai = {acc[1][tm][2 * jp], acc[1][tm][2 * jp + 1]};
                        f32x2 tr = ar * NL2E + kr, ti = ai * NL2E + ki; tr.x = fminf(tr.x, 60.f); tr.y = fminf(tr.y, 60.f); ti.x = fminf(ti.x, 60.f); ti.y = fminf(ti.y, 60.f);
                        f32x2 er, ei; er.x = __builtin_amdgcn_exp2f(tr.x); er.y = __builtin_amdgcn_exp2f(tr.y); ei.x = __builtin_amdgcn_exp2f(ti.x); ei.y = __builtin_amdgcn_exp2f(ti.y);
                        const f32x2 pr = er + 1.f, pi = ei + 1.f, dn = pr * pi; f32x2 R; R.x = __builtin_amdgcn_rcpf(dn.x); R.y = __builtin_amdgcn_rcpf(dn.y);
                        const f32x2 rgt = R * pi, igt = R * pr, x2 = rgt * c16l, l2 = rgt * c8l2;
                        f32x2 av; av.x = __builtin_amdgcn_exp2f(l2.x); av.y = __builtin_amdgcn_exp2f(l2.y);
                        const f32x2 ser = -x2 * (x2 * (x2 * (x2 * (x2 * 0.0083333338f + 0.041666668f) + 0.16666667f) + 0.5f) + 1.f), dir_ = 1.f - av * av;
                        f32x2 om; om.x = x2.x > -0.1f ? ser.x : dir_.x; om.y = x2.y > -0.1f ? ser.y : dir_.y;
                        f32x2 sq; sq.x = __builtin_amdgcn_sqrtf(om.x); sq.y = __builtin_amdgcn_sqrtf(om.y);
                        const f32x2 bxv = sq * igt * xv;
                        acc[0][tm][2 * jp] = av.x; acc[0][tm][2 * jp + 1] = av.y; acc[1][tm][2 * jp] = bxv.x; acc[1][tm][2 * jp + 1] = bxv.y; } }
#define LRU_TM(i) (dr ? 3 - (i) : (i))
            if constexpr (!FINAL) { if (VAR < 3) {
                float2* AGG = (float2*)(VAR ? WSF(WS_ACC) : WSF(WS_LA)); float TA = 1.f, TB = 0.f;
#pragma unroll
                for (int ti = 0; ti < 4; ++ti) { const int tm = LRU_TM(ti); float sa = 1.f, sb = 0.f;
#pragma unroll
                    for (int ji = 0; ji < 4; ++ji) { const int j = LRU_TM(ji); LRU_COMPOSE(sa, sb, acc[0][tm][j], acc[1][tm][j]); }
#pragma unroll
                    for (int qi = 0; qi < 4; ++qi) { const int qq = LRU_TM(qi); const float xa = lane_get(sa, c16 + 16 * qq), xb = lane_get(sb, c16 + 16 * qq); LRU_COMPOSE(TA, TB, xa, xb); } }
                if (q == 0) AGG[(((size_t)b * 36 + chunk) * 2 + dr) * DM + ch] = make_float2(TA, TB); }
            } else {
                float H = ((const LAS float*)(L + HIN_OFF))[ui * 256 + dr * 128 + chl];
#pragma unroll
                for (int ti = 0; ti < 4; ++ti) { const int tm = LRU_TM(ti); float sa = 1.f, sb = 0.f;
#pragma unroll
                    for (int ji = 0; ji < 4; ++ji) { const int j = LRU_TM(ji); LRU_COMPOSE(sa, sb, acc[0][tm][j], acc[1][tm][j]); }
                    float ea = 1.f, eb = 0.f, ta = 1.f, tb = 0.f;
#pragma unroll
                    for (int qi = 0; qi < 4; ++qi) { const int qq = LRU_TM(qi); const float xa = lane_get(sa, c16 + 16 * qq), xb = lane_get(sb, c16 + 16 * qq); if (qq == q) { ea = ta; eb = tb; } LRU_COMPOSE(ta, tb, xa, xb); }
                    float hs = ea * H + eb;
#pragma unroll
                    for (int ji = 0; ji < 4; ++ji) { const int j = LRU_TM(ji); hs = acc[0][tm][j] * hs + acc[1][tm][j]; LAS float* yp = (LAS float*)(L + YO_OFF + (tm * 16 + q * 4 + j) * YO_PITCH + chl * 4);
                        if (dr == 0) *yp = hs; else *yp += hs; }
                    H = ta * H + tb; }
            }
#undef LRU_TM
        }
        if constexpr (FINAL) {
            __syncthreads();
            bf16_t* YB0 = WSB(WS_YB);
#pragma unroll
            for (int i = 0; i < 2; ++i) { const int cidx = tid + 512 * i, row = cidx >> 4, cgo = cidx & 15; const size_t rgl = rb + t0 + row;
                const f32x4 y0 = *(const LAS f32x4*)(L + YO_OFF + row * YO_PITCH + cgo * 32), y1 = *(const LAS f32x4*)(L + YO_OFF + row * YO_PITCH + cgo * 32 + 16);
                const v4u z = zcur[i];
                v4u o; o.x = pk2(y0[0] * blo(z.x), y0[1] * bhi(z.x)); o.y = pk2(y0[2] * blo(z.y), y0[3] * bhi(z.y)); o.z = pk2(y1[0] * blo(z.z), y1[1] * bhi(z.z)); o.w = pk2(y1[2] * blo(z.w), y1[3] * bhi(z.w));
                *(v4u*)(YB0 + rgl * DM + blk * 128 + cgo * 8) = o; }
        }
    }
#undef LRU_LOAD
}
constexpr int CW_LRUFLAG = 32768, LRU_FLAG_STRIDE = 16;
__device__ __forceinline__ void p_lru_lookback(Frame& F, CArgs* ka, int l) {
    const int tid = tid_fresh(), lane = tid & 63, w = __builtin_amdgcn_readfirstlane(tid >> 6), c16 = lane & 15, q = lane >> 4;
    const int npar = F.G / 36; if (F.wg >= npar * 36) return;
    const int slot = F.wg / 36, chunk = F.wg - slot * 36, cps = (64 + npar - 1) / npar;
    LAS unsigned char* L = F.lds; const bf16_t* P = WSB(WS_P);
    unsigned* ctl = (unsigned*)(ka->ws + WS_CTL); unsigned long long* AGG = (unsigned long long*)WSF(WS_LA) + (size_t)l * 64 * 36 * 2 * 128;
    const unsigned epoch = (unsigned)(l + 1);
    const int cg = tid & 15, rg = tid >> 4, chl = 16 * w + c16;
    const int t0 = chunk * 64, lo = chunk < 32 ? 0 : SEQ, hi = chunk < 32 ? SEQ : TPB;
    int cur_blk = -1;
    v4u raw[5];
#define LRU_LOADX(colx) do { const int _b = (colx) & 3, _blk = (colx) >> 2; const size_t _rb = (size_t)_b * TPB; \
        _Pragma("unroll") for (int x = 0; x < 5; ++x) { const int tt = t0 + 2 * rg - 2 + x; raw[x] = (v4u){0u, 0u, 0u, 0u}; if (tt >= lo && tt < hi) raw[x] = *(const v4u*)(P + (_rb + tt) * NP + C_LX + _blk * 128 + cg * 8); } } while (0)
    const int col0 = slot * cps, col1 = (col0 + cps) < 64 ? (col0 + cps) : 64;
    if (col0 < col1) LRU_LOADX(col0);
#pragma unroll 1
    for (int col = col0; col < col1; ++col) {
        const int b = col & 3, blk = col >> 2, ch = blk * 128 + chl; const size_t rb = (size_t)b * TPB;
        __syncthreads();
        bf16x8 bw[4][4]; float cbr[2], cbi[2], csp[2];
        { const bf16_t* Wt = WSB(WS_WLRU) + (size_t)l * 4 * 16 * 16384 + ((size_t)blk * 128 + chl) * 128 + q * 8;
#pragma unroll
          for (int g = 0; g < 4; ++g)
#pragma unroll
              for (int ks = 0; ks < 4; ++ks) bw[g][ks] = *(const bf16x8*)(Wt + (size_t)g * 16 * 16384 + ks * 32);
#pragma unroll
          for (int dr = 0; dr < 2; ++dr) { cbr[dr] = KIN(12)[((size_t)l * 2 + dr) * DM + ch]; cbi[dr] = KIN(14)[((size_t)l * 2 + dr) * DM + ch]; csp[dr] = log1pf(__expf(-KIN(15)[((size_t)l * 2 + dr) * DM + ch])); } }
        if (blk != cur_blk) { cur_blk = blk;
            for (int i = tid; i < 5 * 128; i += 512) { const int kk = i >> 7, c = i & 127; ((LAS float*)(L + CW_OFF))[i] = kk < 4 ? KIN(9)[((size_t)l * 4 + kk) * DM + blk * 128 + c] : KIN(10)[(size_t)l * DM + blk * 128 + c]; }
            __syncthreads(); }
        {
          float o0[8], o1[8]; const LAS float* cwl = (const LAS float*)(L + CW_OFF) + cg * 8;
#pragma unroll
          for (int e = 0; e < 8; ++e) { o0[e] = cwl[4 * 128 + e]; o1[e] = o0[e]; }
#pragma unroll
          for (int kk = 0; kk < 5; ++kk) { float xin[8];
#pragma unroll
              for (int e = 0; e < 4; ++e) { xin[2 * e] = blo(raw[kk][e]); xin[2 * e + 1] = bhi(raw[kk][e]); }
#pragma unroll
              for (int e = 0; e < 8; ++e) { if (kk < 4) o0[e] += cwl[kk * 128 + e] * xin[e]; if (kk > 0) o1[e] += cwl[(kk - 1) * 128 + e] * xin[e]; } }
          v4u p0, p1; p0.x = pk2(o0[0], o0[1]); p0.y = pk2(o0[2], o0[3]); p0.z = pk2(o0[4], o0[5]); p0.w = pk2(o0[6], o0[7]); p1.x = pk2(o1[0], o1[1]); p1.y = pk2(o1[2], o1[3]); p1.z = pk2(o1[4], o1[5]); p1.w = pk2(o1[6], o1[7]);
          *(LAS v4u*)(L + XB_OFF + (2 * rg) * XB_PITCH + cg * 16) = p0; *(LAS v4u*)(L + XB_OFF + (2 * rg + 1) * XB_PITCH + cg * 16) = p1;
          LAS float* f0 = (LAS float*)(L + XF_OFF + (2 * rg) * XF_PITCH + cg * 32); LAS float* f1 = (LAS float*)(L + XF_OFF + (2 * rg + 1) * XF_PITCH + cg * 32);
          *(LAS f32x4*)f0 = (f32x4){o0[0], o0[1], o0[2], o0[3]}; *(LAS f32x4*)(f0 + 4) = (f32x4){o0[4], o0[5], o0[6], o0[7]};
          *(LAS f32x4*)f1 = (f32x4){o1[0], o1[1], o1[2], o1[3]}; *(LAS f32x4*)(f1 + 4) = (f32x4){o1[4], o1[5], o1[6], o1[7]}; }
        __syncthreads();
        { const int coln = col + 1 < col1 ? col + 1 : col; LRU_LOADX(coln); }
        f32x4 av[2][4], bv[2][4];
#pragma unroll
        for (int dr = 0; dr < 2; ++dr) {
#pragma unroll
            for (int tm = 0; tm < 4; ++tm) { av[dr][tm] = (f32x4){0.f, 0.f, 0.f, 0.f}; bv[dr][tm] = (f32x4){0.f, 0.f, 0.f, 0.f}; }
#pragma unroll
            for (int ks = 0; ks < 4; ++ks) { bf16x8 a[4];
#pragma unroll
                for (int tm = 0; tm < 4; ++tm) a[tm] = *(const LAS bf16x8*)(L + XB_OFF + (tm * 16 + c16) * XB_PITCH + (ks * 32 + q * 8) * 2);
#pragma unroll
                for (int tm = 0; tm < 4; ++tm) { av[dr][tm] = __builtin_amdgcn_mfma_f32_16x16x32_bf16(a[tm], bw[2 * dr][ks], av[dr][tm], 0, 0, 0); bv[dr][tm] = __builtin_amdgcn_mfma_f32_16x16x32_bf16(a[tm], bw[2 * dr + 1][ks], bv[dr][tm], 0, 0, 0); } }
#pragma unroll
            for (int tm = 0; tm < 4; ++tm)
#pragma unroll
                for (int j = 0; j < 4; ++j) { const int t = tm * 16 + q * 4 + j; const float xv = *(const LAS float*)(L + XF_OFF + t * XF_PITCH + chl * 4);
                    const float rgt = pg8::sigmoid_f(av[dr][tm][j] + cbr[dr]), igt = pg8::sigmoid_f(bv[dr][tm][j] + cbi[dr]), la = -8.f * rgt * csp[dr], aa = __expf(la), x2 = 2.f * la;
                    const float om = x2 > -0.1f ? -x2 * (1.f + x2 * (0.5f + x2 * (0.16666667f + x2 * (0.041666668f + x2 * 0.0083333338f)))) : 1.f - aa * aa;
                    av[dr][tm][j] = aa; bv[dr][tm][j] = sqrtf(om) * igt * xv; }
#define LRU_TM(i) (dr ? 3 - (i) : (i))
            float TA = 1.f, TB = 0.f;
#pragma unroll
            for (int ti = 0; ti < 4; ++ti) { const int tm = LRU_TM(ti); float sa = 1.f, sb = 0.f;
#pragma unroll
                for (int ji = 0; ji < 4; ++ji) { const int j = LRU_TM(ji); LRU_COMPOSE(sa, sb, av[dr][tm][j], bv[dr][tm][j]); }
#pragma unroll
                for (int qi = 0; qi < 4; ++qi) { const int qq = LRU_TM(qi); const float xa = lane_get(sa, c16 + 16 * qq), xb = lane_get(sb, c16 + 16 * qq); LRU_COMPOSE(TA, TB, xa, xb); } }
            __builtin_amdgcn_sched_barrier(0);
            if (q == 0) __hip_atomic_store(AGG + (((size_t)col * 36 + chunk) * 2 + dr) * 128 + chl, ((unsigned long long)__float_as_uint(TB) << 32) | __float_as_uint(TA), __ATOMIC_RELAXED, __HIP_MEMORY_SCOPE_AGENT);
        }
        asm volatile("s_waitcnt vmcnt(0)" ::: "memory");
        __syncthreads();
        if (tid == 0) __hip_atomic_store(ctl + CW_LRUFLAG + (col * 36 + chunk) * LRU_FLAG_STRIDE, epoch, __ATOMIC_RELAXED, __HIP_MEMORY_SCOPE_AGENT);
        v4u zcur[2];
#pragma unroll
        for (int x = 0; x < 2; ++x) { const int cidx = tid + 512 * x; zcur[x] = *(const v4u*)(P + (rb + t0 + (cidx >> 4)) * NP + C_LZ + blk * 128 + (cidx & 15) * 8); }
        if (w == 0) {
            unsigned* fp = ctl + CW_LRUFLAG + (col * 36 + (lane < 36 ? lane : 0)) * LRU_FLAG_STRIDE; unsigned spins = 0;
            for (;;) { const bool ok = __hip_atomic_load(fp, __ATOMIC_RELAXED, __HIP_MEMORY_SCOPE_AGENT) >= epoch; if (__all(ok)) break;
                __builtin_amdgcn_s_sleep(1);
                if ((++spins & 255u) == 0u) { if (__hip_atomic_load(ctl, __ATOMIC_RELAXED, __HIP_MEMORY_SCOPE_AGENT) != 0u) break; if (spins > (1u << 20)) { if (lane == 0) __hip_atomic_store(ctl, 0x1200u + (unsigned)l, __ATOMIC_RELAXED, __HIP_MEMORY_SCOPE_AGENT); break; } } }
            __builtin_amdgcn_fence(__ATOMIC_ACQUIRE, "agent");
            asm volatile("s_waitcnt vmcnt(0)" ::: "memory"); }
        __syncthreads();
        if (tid < 256) {
            const int dirx = tid >> 7, cl = tid & 127; const unsigned long long* ap = AGG + ((size_t)col * 36 * 2 + dirx) * 128 + cl; float hcar = 0.f, hmine = 0.f;
#pragma unroll 12
            for (int k = 0; k < 36; ++k) { const int cidx = ml::chunk_of(k, dirx); const unsigned long long ab = ap[(size_t)cidx * 256];
                if (cidx == chunk) hmine = hcar;
                hcar = __uint_as_float((unsigned)ab) * hcar + __uint_as_float((unsigned)(ab >> 32)); }
            ((LAS float*)(L + HIN_OFF))[dirx * 128 + cl] = hmine; }
        __syncthreads();
#pragma unroll
        for (int dr = 0; dr < 2; ++dr) {
            float H = ((const LAS float*)(L + HIN_OFF))[dr * 128 + chl];
#pragma unroll
            for (int ti = 0; ti < 4; ++ti) { const int tm = LRU_TM(ti); float sa = 1.f, sb = 0.f;
#pragma unroll
                for (int ji = 0; ji < 4; ++ji) { const int j = LRU_TM(ji); LRU_COMPOSE(sa, sb, av[dr][tm][j], bv[dr][tm][j]); }
                float ea = 1.f, eb = 0.f, ta = 1.f, tb = 0.f;
#pragma unroll
                for (int qi = 0; qi < 4; ++qi) { const int qq = LRU_TM(qi); const float xa = lane_get(sa, c16 + 16 * qq), xb = lane_get(sb, c16 + 16 * qq); if (qq == q) { ea = ta; eb = tb; } LRU_COMPOSE(ta, tb, xa, xb); }
                float hs = ea * H + eb;
#pragma unroll
                for (int ji = 0; ji < 4; ++ji) { const int j = LRU_TM(ji); hs = av[dr][tm][j] * hs + bv[dr][tm][j]; LAS float* yp = (LAS float*)(L + YO_OFF + (tm * 16 + q * 4 + j) * YO_PITCH + chl * 4);
                    if (dr == 0) *yp = hs; else *yp += hs; }
                H = ta * H + tb; }
        }
#undef LRU_TM
        __syncthreads();
        bf16_t* YB0 = WSB(WS_YB);
#pragma unroll
        for (int i = 0; i < 2; ++i) { const int cidx = tid + 512 * i, row = cidx >> 4, cgo = cidx & 15; const size_t rgl = rb + t0 + row;
            const f32x4 y0 = *(const LAS f32x4*)(L + YO_OFF + row * YO_PITCH + cgo * 32), y1 = *(const LAS f32x4*)(L + YO_OFF + row * YO_PITCH + cgo * 32 + 16);
            const v4u z = zcur[i];
            v4u o; o.x = pk2(y0[0] * blo(z.x), y0[1] * bhi(z.x)); o.y = pk2(y0[2] * blo(z.y), y0[3] * bhi(z.y)); o.z = pk2(y1[0] * blo(z.z), y1[1] * bhi(z.z)); o.w = pk2(y1[2] * blo(z.w), y1[3] * bhi(z.w));
            *(v4u*)(YB0 + rgl * DM + blk * 128 + cgo * 8) = o; }
    }
#undef LRU_LOADX
}
template <int LV> __device__ __forceinline__ void p_lru_agg(Frame& F, CArgs* ka, int l) {
    for (int v = F.wg; v < 256; v += F.G) { const int blk = v & 15, c0 = v >> 4;
        lru_run<false, LV>(F, ka, l, blk, 9, [c0](int i, int& b, int& c) { const int x = c0 + 16 * i; b = x / 36; c = x - b * 36; }); }
}
__device__ __forceinline__ void p_lru_final(Frame& F, CArgs* ka, int l, bool need_ctx) {
    for (int v = F.wg; v < 256; v += F.G) { const int b = v >> 6, blk = (v >> 2) & 15, qt = v & 3;
        const int tid = tid_fresh();
        __syncthreads();
        if (tid < 256) { const int dirx = tid >> 7, chl = tid & 127; const float2* AGG = (const float2*)WSF(WS_LA) + ((size_t)b * 36 * 2 + dirx) * DM + blk * 128 + chl;
            LAS float* HIN = (LAS float*)(F.lds + HIN_OFF); float hcar = 0.f;
#pragma unroll 12
            for (int k = 0; k < 36; ++k) { const int cidx = ml::chunk_of(k, dirx); const float2 ab = AGG[(size_t)cidx * 2 * DM];
                const int sl = cidx - qt * 9; if (sl >= 0 && sl < 9) HIN[sl * 256 + dirx * 128 + chl] = hcar;
                hcar = ab.x * hcar + ab.y; } }
        lru_run<true, 0>(F, ka, l, blk, (need_ctx || qt < 3) ? 9 : 5, [b, qt](int i, int& bb, int& c) { bb = b; c = qt * 9 + i; });
    }
}
}

#ifndef GEMM_NHALF
#define GEMM_NHALF false
#endif
#ifndef CONVERT_AHEAD
#define CONVERT_AHEAD 1
#endif
#ifndef DUP_NORM
#define DUP_NORM 0
#endif
#ifndef DUP_KNORM
#define DUP_KNORM 0
#endif
#ifndef LRU_LOOKBACK
#define LRU_LOOKBACK 0
#endif
#ifndef DUP_G1NULL
#define DUP_G1NULL 0
#endif
#ifndef DUP_G1FIX
#define DUP_G1FIX 0
#endif
#ifndef DUP_BAR
#define DUP_BAR 0
#endif
#ifndef DUP_MLOUT
#define DUP_MLOUT 0
#endif
#ifndef DUP_LRU2
#define DUP_LRU2 0
#endif
#ifndef ML_PIPE
#define ML_PIPE 1
#endif
#ifndef ML_VAR
#define ML_VAR 0
#endif
#ifndef LRU_VAR
#define LRU_VAR -1
#endif
#ifndef CONV_SPLIT
#define CONV_SPLIT 0
#endif
#ifndef GEMM_STAGGER
#define GEMM_STAGGER 0
#endif
#ifndef HEAVY_MIX
#define HEAVY_MIX 0
#endif
#ifndef THIN_MIX
#define THIN_MIX 0
#endif
#ifndef CONV_HEAVY
#define CONV_HEAVY 1
#endif
#ifndef HEAVY_ROT
#define HEAVY_ROT 0
#endif
#ifndef PRETOUCH
#define PRETOUCH 1
#endif
#ifndef PT_STRIDE
#define PT_STRIDE 65536
#endif
#ifndef MERGE_CHAIN
#define MERGE_CHAIN 1
#endif
#ifndef CONV_WIN_M
#define CONV_WIN_M 4000
#endif
#ifndef CONV_AHEAD_ITEMS
#define CONV_AHEAD_ITEMS 8000
#endif
#ifndef CONV_HALF
#define CONV_HALF 17168
#endif
static_assert(!(SPLIT_CTX && GEMM_NHALF), "the split context tiles assume 256-column units");
#ifndef ML_TR
#define ML_TR 1
#endif
#ifndef DUP_PRO
#define DUP_PRO 0
#endif
#ifndef DUP_THIN
#define DUP_THIN 0
#endif
#ifndef DUP_G1
#define DUP_G1 0
#endif
#ifndef DUP_HEAVY
#define DUP_HEAVY 0
#endif
#ifndef DUP_ATT
#define DUP_ATT 0
#endif
#ifndef DUP_ML
#define DUP_ML 0
#endif
#ifndef DUP_LRU1
#define DUP_LRU1 0
#endif
#ifndef DUP_G23
#define DUP_G23 0
#endif
__global__ void __launch_bounds__(NWAVES * 64, 2) fwd(Args args) {
    extern __shared__ __attribute__((aligned(16))) unsigned char lds[];
    Frame F;
    F.lds = (LAS unsigned char*)lds; F.ldsg = (char*)lds;
    F.tid = threadIdx.x; F.lane = F.tid & 63; F.wave = __builtin_amdgcn_readfirstlane(F.tid >> 6); F.G = gridDim.x; F.wg = blockIdx.x;
    CArgs* const ka0 = (CArgs*)__builtin_amdgcn_kernarg_segment_ptr();
    unsigned char* ws; { CArgs* ka = ka0; ws = ka->ws; }
    volatile LAS unsigned* MISC = (volatile LAS unsigned*)(F.lds + MISC_OFF);
    if (F.tid < 64) ((LAS unsigned*)(F.lds + MISC_OFF))[F.tid] = 0u;
    __syncthreads();
    const int lo = ka0->ph_lo, hi = ka0->ph_hi;
    XcdBarrier bar; bar.bar = (unsigned*)(ws + WS_CTL) + CW_BAR; bar.x = 0; bar.st = nullptr;
    if (hi - lo > 1) bar = xcd_barrier_post((unsigned*)(ws + WS_CTL) + CW_BAR, MISC + 8);
#define IN(k) (lo <= (k) && (k) < hi)
#define SEAM(k) do { if ((k) + 1 < hi) { xcd_barrier(bar); if (DUP_BAR) xcd_barrier(bar); } } while (0)

    if (IN(0) && PRETOUCH) {
        CArgs* ka = KA(); const size_t gt = (size_t)F.wg * 512 + F.tid, GT = (size_t)F.G * 512; unsigned acc_ = 0u;
#define PT_RANGE(ptr, bytes) for (size_t p = gt; p < (size_t)(bytes) / PT_STRIDE; p += GT) acc_ += __builtin_nontemporal_load((const unsigned*)((const char*)(ptr) + p * PT_STRIDE))
        PT_RANGE(ka->ws, WS_END); PT_RANGE(KIN(8), (size_t)DEPTH * DM * NIN * 4); PT_RANGE(KIN(20), (size_t)DEPTH * 3 * DM * DM * 4); PT_RANGE(KIN(21), (size_t)DEPTH * DM * DM * 4);
        PT_RANGE(KIN(4), (size_t)DEPTH * DM * 3 * DM * 4); PT_RANGE(KIN(0), (size_t)NBATCH * SEQ * DM * 4); PT_RANGE(KIN(2), (size_t)NBATCH * CTXL * DM * 4); PT_RANGE(ka->out, (size_t)NBATCH * SEQ * DM * 4);
#undef PT_RANGE
        asm volatile("" :: "v"(acc_)); }
    if (IN(0)) { for (int rep = 0; rep <= DUP_PRO; ++rep) { const int wv = F.wg * NWAVES + F.wave, nwv = F.G * NWAVES;
            for (int lc = 0; lc < (CONV_HEAVY ? 1 : DEPTH); ++lc) p_convert(F, KA(), lc, wv, nwv, (CONVERT_AHEAD && lc > 0) ? CONV_AHEAD_ITEMS : 0);
            p_prologue(F, KA()); }
        SEAM(0); }
#pragma unroll 1
    for (int l = 0; l < DEPTH; ++l) {
        const int base = 1 + l * PH_PER_LAYER; const bool need_ctx = l < DEPTH - 1;
        if (IN(base + 0)) { p_norm(F, KA(), l); if (DUP_NORM) p_norm(F, KA(), l + 1 <= DEPTH - 1 && l > 0 ? l : l, true); SEAM(base + 0); }
        if (IN(base + 1)) {
            CArgs* ka = KA(); pg8::Gemm g{WSB(WS_H), WSB(WS_WIN) + (size_t)l * NP * DM, MROWS, NP, DM, 0, 0}; pg8::InOrder S; S.init(MROWS, NP, F.G, F.wg, 256, !need_ctx);
            typedef pg8::EpiIn<(long)((WS_X8 - WS_P) / 2)> EpiInT; EpiInT E{WSB(WS_P)};
            if (GEMM_STAGGER && need_ctx) {
                const int nu = (MROWS / 256) * (NP / 256), extra = nu % F.G;
                if (F.wg >= extra) { const unsigned long long t0 = __builtin_amdgcn_s_memrealtime(), dt = (unsigned long long)(((F.wg - extra) >> 3) & 15) * GEMM_STAGGER;
                    while (__builtin_amdgcn_s_memrealtime() - t0 < dt) __builtin_amdgcn_s_sleep(8); } }
            pg8::gemm_phase<EpiInT, pg8::InOrder, true, true>(F.lds, g, S, E);
            if (DUP_G1) pg8::gemm_phase<EpiInT, pg8::InOrder, true, true>(F.lds, g, S, E);
            if (DUP_G1NULL) { pg8::EpiNull EN{WSF(WS_ACC)}; pg8::gemm_phase<pg8::EpiNull, pg8::InOrder, true, true>(F.lds, g, S, EN); }
            if (DUP_G1FIX) { pg8::EpiNull EN{WSF(WS_ACC)}; pg8::FixedOrder SF; SF.init(MROWS, NP, F.G, F.wg); pg8::gemm_phase<pg8::EpiNull, pg8::FixedOrder, true, true>(F.lds, g, SF, EN); }
            if (need_ctx) {
                const int nu = (MROWS / 256) * (NP / 256), extra = nu % F.G;
                if (F.wg >= extra) { p_gates(F, KA(), l, F.wg - extra, F.G - extra);
                    if (CONVERT_AHEAD && l + 1 < DEPTH) p_convert(F, KA(), l + 1, (F.wg - extra) * NWAVES + F.wave, (F.G - extra) * NWAVES, 0, CONV_SPLIT); } }
            SEAM(base + 1);
        }
        if (IN(base + 2)) { if (!need_ctx) p_gates(F, KA(), l, F.wg, F.G); p_knorm(F, KA(), l); if (DUP_KNORM) p_knorm(F, KA(), l, true);
#if USE_NAIVE_LRU
            p_lru_gates_naive(F, KA(), l);
#endif
            SEAM(base + 2); }
        if (IN(base + 3)) {
#define ML_UNITS() do { for (int v = F.wg; v < 256; v += F.G) {    \
                const int u = (F.G % 8 == 0) ? (((v & 7) * 8 + ((v >> 3) >> 2)) * 4 + ((v >> 3) & 3)) : v; \
                if (ML_TR) ml::mlstm_unit_tr(F, KA(), u, need_ctx); else ml::mlstm_unit_pipe<0>(F, KA(), u, need_ctx); if (ML_VAR) ml::mlstm_unit_pipe<ML_VAR>(F, KA(), u, need_ctx); } } while (0)
            if (HEAVY_MIX && (F.wg & 1)) ML_UNITS();
#define CONV_H() do { if (CONV_HEAVY && l + 1 < DEPTH) { __syncthreads(); p_convert(F, KA(), l + 1, F.wg * NWAVES + F.wave, F.G * NWAVES, CONV_AHEAD_ITEMS, 1 << 30); __syncthreads(); } } while (0)
            if (!((F.wg >> 3) & 1)) CONV_H();
#if HEAVY_ROT
            { const int rot = (F.wg >> 3) % 3;
#pragma unroll 1
              for (int sl = 0; sl < 3; ++sl) { const int k = (sl + rot) % 3;
                  __syncthreads();
                  if (k == 0) p_attention(F, KA(), l, need_ctx);
                  else if (k == 1) ML_UNITS();
                  else lru::p_lru_agg<0>(F, KA(), l); }
              __syncthreads(); }
#else
            for (int r2 = 0; r2 <= DUP_ATT; ++r2) p_attention(F, KA(), l, need_ctx);
            if (!(HEAVY_MIX && (F.wg & 1))) ML_UNITS();
            lru::p_lru_agg<0>(F, KA(), l); if (LRU_VAR >= 0) lru::p_lru_agg<(LRU_VAR >= 0 ? LRU_VAR : 0)>(F, KA(), l);
#endif
#undef ML_UNITS
            if ((F.wg >> 3) & 1) CONV_H();
#undef CONV_H
            SEAM(base + 3); }
        if (IN(base + 4)) { for (int rep = 0; rep <= DUP_THIN; ++rep) {
            const bool lru_first = THIN_MIX && ((F.wg >> 3) & 1);
            if (!lru_first) { for (int r2 = 0; r2 <= DUP_MLOUT; ++r2) p_mlout(F, KA(), l, need_ctx); }
#if USE_NAIVE_LRU
            p_lru_combine_naive(F, KA());
#else
#if !LRU_LOOKBACK
            lru::p_lru_final(F, KA(), l, need_ctx); if (DUP_LRU2) lru::p_lru_final(F, KA(), l, need_ctx);
#endif
#endif
            if (lru_first) p_mlout(F, KA(), l, need_ctx);
            }
            SEAM(base + 4); }
        if (IN(base + 5)) {
            CArgs* ka = KA(); pg8::Gemm g{WSB(WS_YB), WSB(WS_WBR) + (size_t)l * 3 * DM * DM, MROWS, DM, DM, (size_t)MROWS * DM * 2, (size_t)DM * DM * 2}; pg8::MergeOrder S; S.init(MROWS, DM, F.G, F.wg, GEMM_NHALF ? 128 : 256, !need_ctx);
#if MERGE_CHAIN
            pg8::EpiMergeC E{WSB(WS_P), WSB(WS_G2)};
            pg8::gemm_phase<pg8::EpiMergeC, pg8::MergeOrder, true, true, false>(F.lds, g, S, E);
#else
            pg8::EpiMerge<GEMM_NHALF> E{WSB(WS_P), WSF(WS_ACC), WSB(WS_G2)};
            pg8::gemm_phase<pg8::EpiMerge<GEMM_NHALF>, pg8::MergeOrder, true, true, GEMM_NHALF>(F.lds, g, S, E);
#endif
            if (DUP_G23) pg8::gemm_phase<decltype(E), pg8::MergeOrder, true, true, false>(F.lds, g, S, E);
            if (CONVERT_AHEAD && l + 1 < DEPTH) {
                const int ntile_m = (MROWS / 256) * (DM / (GEMM_NHALF ? 128 : 256));
                if (SPLIT_CTX && F.G == 256) { const int busy2 = 96; if (F.wg >= busy2) p_convert(F, KA(), l + 1, (F.wg - busy2) * NWAVES + F.wave, (F.G - busy2) * NWAVES, 0, CONV_WIN_M); }
                else { const int ntile = ntile_m, busy2 = (ntile > F.G && ntile < 2 * F.G) ? ntile - F.G : 0;
                    if (F.wg >= busy2) p_convert(F, KA(), l + 1, (F.wg - busy2) * NWAVES + F.wave, (F.G - busy2) * NWAVES, 0, CONV_AHEAD_ITEMS); } }
            SEAM(base + 5);
        }
        if (IN(base + 6)) {
            CArgs* ka = KA(); pg8::Gemm g{WSB(WS_G2), WSB(WS_WOUT) + (size_t)l * DM * DM, MROWS, DM, DM, (size_t)MROWS * DM * 2, 0}; pg8::SplitOutOrder S; S.init(MROWS, DM, F.G, F.wg, GEMM_NHALF ? 128 : 256, !need_ctx);
#if Y_BF16
            pg8::EpiY16 E{WSB(WS_Y), (size_t)MROWS * DM};
#else
            pg8::EpiF32<GEMM_NHALF> E{WSF(WS_Y), DM, (size_t)MROWS * DM};
#endif
            pg8::gemm_phase<decltype(E), pg8::SplitOutOrder, true, true, false>(F.lds, g, S, E);
            if (DUP_G23) pg8::gemm_phase<decltype(E), pg8::SplitOutOrder, true, true, false>(F.lds, g, S, E);
            const int ntile_o = (MROWS / 256) * (DM / (GEMM_NHALF ? 128 : 256));
            if (CONVERT_AHEAD && l + 1 < DEPTH && SPLIT_CTX && F.G == 256) { const int busy2 = 96; (void)ntile_o;
                if (F.wg >= busy2) p_convert(F, KA(), l + 1, (F.wg - busy2) * NWAVES + F.wave, (F.G - busy2) * NWAVES, CONV_WIN_M, CONV_AHEAD_ITEMS); }
            SEAM(base + 6);
        }
    }
    if (IN(N_PHASES - 1)) p_norm(F, KA(), DEPTH);
#undef IN
#undef SEAM
}

extern "C" void kernel_launch(void* const* d_in, const int* in_sizes, int n_in, void* d_out, int out_size, void* d_ws, size_t ws_size, hipStream_t stream) {
    static int grid = 0;
    if (grid == 0) {
        if (n_in != 22 || in_sizes[0] != NBATCH * SEQ * DM || out_size != NBATCH * SEQ * DM || ws_size < WS_END) {
            fprintf(stderr, "kernel_launch: unexpected shapes: n_in %d in0 %d out %d ws %zu (need %zu)\n", n_in, n_in > 0 ? in_sizes[0] : -1, out_size, ws_size, (size_t)WS_END); grid = -1; return; }
        int dev = 0, cus = 0, per_cu = 0;
        if (hipGetDevice(&dev) != hipSuccess || hipDeviceGetAttribute(&cus, hipDeviceAttributeMultiprocessorCount, dev) != hipSuccess) { fprintf(stderr, "kernel_launch: device query failed\n"); grid = -1; return; }
        if (hipFuncSetAttribute((const void*)fwd, hipFuncAttributeMaxDynamicSharedMemorySize, LDS_BYTES) != hipSuccess) { fprintf(stderr, "kernel_launch: hipFuncSetAttribute failed\n"); grid = -1; return; }
        if (hipOccupancyMaxActiveBlocksPerMultiprocessor(&per_cu, (const void*)fwd, NWAVES * 64, LDS_BYTES) != hipSuccess || per_cu < 1)
            fprintf(stderr, "kernel_launch: note: occupancy query reports %d workgroups per CU\n", per_cu);
        (void)hipGetLastError();
        grid = cus;
    }
    if (grid < 0) return;
    if (hipMemsetAsync((char*)d_ws + WS_CTL, 0, CTL_ZERO_BYTES, stream) != hipSuccess) { fprintf(stderr, "kernel_launch: memset failed\n"); return; }
    Args a{};
    for (int i = 0; i < 22; ++i) a.in[i] = (const float*)d_in[i];
    a.out = (float*)d_out; a.ws = (unsigned char*)d_ws;
    if (MK_N_LAUNCHES == 1) { a.ph_lo = 0; a.ph_hi = N_PHASES; hipLaunchKernelGGL(fwd, dim3(grid), dim3(NWAVES * 64), LDS_BYTES, stream, a); }
    else for (int k = 0; k < N_PHASES; ++k) { a.ph_lo = k; a.ph_hi = k + 1; hipLaunchKernelGGL(fwd, dim3(grid), dim3(NWAVES * 64), LDS_BYTES, stream, a); }
    const hipError_t le = hipPeekAtLastError();
    if (le != hipSuccess) fprintf(stderr, "kernel_launch: launch failed: %s\n", hipGetErrorName(le));
}
```

```cpp
#include <hip/hip_runtime.h>
#include <hip/hip_bf16.h>
#include <cstdio>
#include <cstdint>

constexpr int DM = 2048, NBATCH = 4, SEQ = 2048, CTXL = 256, TPB = SEQ + CTXL  , MROWS = NBATCH * TPB  , DEPTH = 4;
constexpr int NIN = 25632, NP = 25600;
constexpr int C_LX = 0, C_LZ = 2048, C_MQ = 4096, C_MK = 6144, C_MV = 8192, C_MO = 10240, C_MZ = 12288, C_AQ = 14336, C_AK = 16384, C_AV = 16896, C_AZ = 17408, C_MG = 19456;
constexpr float EPS = 1e-6f;
#ifndef SPLIT_CTX
#define SPLIT_CTX 1
#endif
#ifndef Y_BF16
#define Y_BF16 1
#endif

namespace pg8 {
#define PG8_LAS __attribute__((address_space(3)))
typedef unsigned short bf16_t;
typedef short bf16x8 __attribute__((ext_vector_type(8)));
typedef float f32x4 __attribute__((ext_vector_type(4)));
typedef unsigned u32x4 __attribute__((ext_vector_type(4)));
constexpr int BM = 256, BK = 64, HALF = 128, HTB = HALF * BK * 2  , STAGE_BYTES = 8 * HTB, NXCD = 8, WGM = 8;

__host__ __device__ __forceinline__ int lds_byte(int r, int c) { const int st = (r >> 4) * 2 + (c >> 5), rr = r & 15, cc = c & 31, ob = rr * 64 + cc * 2; return st * 1024 + (ob ^ (((ob >> 9) & 1) << 5)); }
__host__ __device__ __forceinline__ void stage_rc(int b, int& R, int& C) { const int st = b / 1024, sb = b % 1024, swz = sb ^ (((sb >> 9) & 1) << 5); R = (st >> 1) * 16 + swz / 64; C = (st & 1) * 32 + (swz % 64) / 2; }
__host__ __device__ __forceinline__ int perm32(int rho) { const int n = rho >> 4, i = rho & 15; return 8 * (i >> 2) + 4 * n + (i & 3); }

struct Unit { int pm, pn, z, sp; };
struct Gemm { const bf16_t* A; const bf16_t* Bt; int M, N, K; size_t zA, zB; };

struct StaticOrder {
    int nM, nN, nwg, G, c; bool lat;
    __host__ __device__ void init(int M, int N, int G_, int c_, int tileN = BM, bool lat_ = false) { lat = lat_; nM = lat ? (M / BM) * 8 / 9 : M / BM; nN = N / tileN; nwg = nM * nN; G = G_; c = c_; }
    __host__ __device__ bool map_x(long L, Unit& u, int nM_, int nwg_, bool lat_) const {
        if (L >= nwg_) return false;
        int wgid = (int)L; { const int q = nwg_ / NXCD, r = nwg_ % NXCD, xcd = wgid % NXCD, off = wgid / NXCD; wgid = (xcd < r ? xcd * (q + 1) : r * (q + 1) + (xcd - r) * q) + off; }
        const int nig = WGM * nN, gid = wgid / nig, fm = gid * WGM, gsz = (nM_ - fm) < WGM ? (nM_ - fm) : WGM;
        u.pm = fm + ((wgid % nig) % gsz); u.pn = (wgid % nig) / gsz; u.z = 0; u.sp = 0; if (lat_) u.pm = (u.pm >> 3) * 9 + (u.pm & 7); return true;
    }
    __host__ __device__ bool map(long L, Unit& u) const { return map_x(L, u, nM, nwg, lat); }
    __host__ __device__ bool next(int i, Unit& u) const { return map((long)i * G + c, u); }
    __device__ __forceinline__ void a_ready(const Unit&) const {}
    __device__ __forceinline__ void done(const Unit&) const {}
};
struct InOrder : StaticOrder {
    __host__ __device__ bool next(int i, Unit& u) const { const long L = (long)i * G + c; if (L < nwg) return map(L, u);
        if (!lat) return false; const int idx = (int)(L - nwg); if (idx >= 4 * 28) return false;
        const int bb = idx / 28, j = idx - bb * 28; u.pm = 9 * bb + 8; u.z = 0; u.sp = 0; u.pn = j < 8 ? j : j < 16 ? 16 + j : j < 24 ? 16 + j : j < 26 ? 40 + j : 40 + j; return true; }
};
struct FixedOrder : StaticOrder {
    __host__ __device__ bool next(int i, Unit& u) const { if (!StaticOrder::next(i, u)) return false; u.pm = 0; u.pn = 0; return true; }
};
struct MergeOrder : StaticOrder {
    __host__ __device__ bool split_ok() const { return SPLIT_CTX && !lat && nM == 36 && nN == 8 && G == 256; }
    __host__ __device__ bool next(int i, Unit& u) const {
        if (!split_ok()) { const int it = i / 3; if (!StaticOrder::next(it, u)) return false; u.z = i - 3 * it; return true; }
        if (i < 3) { if (!map_x((long)c, u, 32, 256, true)) return false; u.z = i; return true; }
        if (i > 3 || c >= 96) return false;
        const int s = c & 31; u.pm = 9 * (s >> 3) + 8; u.pn = s & 7; u.z = c >> 5; u.sp = 1; return true; }
};
struct SplitOutOrder : StaticOrder {
    __host__ __device__ bool split_ok() const { return SPLIT_CTX && !lat && nM == 36 && nN == 8 && G == 256; }
    __host__ __device__ bool next(int i, Unit& u) const {
        if (!split_ok()) return StaticOrder::next(i, u);
        if (i == 0) return map_x((long)c, u, 32, 256, true);
        if (i > 1 || c >= 96) return false;
        const int s = c & 31; u.pm = 9 * (s >> 3) + 8; u.pn = s & 7; u.z = 1 + (c >> 5); u.sp = 1; return true; }
};
__device__ __forceinline__ unsigned cvt_pk_bf16(float lo, float hi) { unsigned r; asm volatile("v_cvt_pk_bf16_f32 %0, %1, %2" : "=v"(r) : "v"(lo), "v"(hi)); return r; }
__device__ __forceinline__ float bflo(unsigned w) { return __uint_as_float(w << 16); }
__device__ __forceinline__ float bfhi(unsigned w) { return __uint_as_float(w & 0xffff0000u); }
__device__ __forceinline__ float sigmoid_f(float x) { return __builtin_amdgcn_rcpf(1.f + __expf(-x)); }

template <bool NHALF> struct EpiF32 {
    static constexpr bool PERM = false, AFTER_DRAIN = false;
    float* C; int ldc; size_t slab;
    __device__ __forceinline__ void operator()(const f32x4 (&acc)[2][2][4][2], const Unit& u, int wr, int wc, int fr, int fq) const {
        const int row0 = u.pm * BM + wr * 64 + fr, col0 = u.pn * (NHALF ? HALF : BM) + wc * 32 + 4 * fq;
        float* Cb = C + (u.sp ? (size_t)(u.z - 1) * slab : (size_t)0);
#pragma unroll
        for (int ai = 0; ai < 2; ++ai)
#pragma unroll
            for (int m = 0; m < 4; ++m) { float* rowp = Cb + (size_t)(row0 + ai * HALF + m * 16) * ldc + col0;
#pragma unroll
                for (int bj = 0; bj < (NHALF ? 1 : 2); ++bj)
#pragma unroll
                    for (int n = 0; n < 2; ++n) *(f32x4*)(rowp + bj * HALF + n * 16) = acc[ai][bj][m][n]; }
    }
};
struct EpiNull {
    static constexpr bool PERM = true, AFTER_DRAIN = false; float* sink;
    __device__ __forceinline__ void operator()(const f32x4 (&acc)[2][2][4][2], const Unit& u, int wr, int wc, int fr, int fq) const {
        float s = 0.f;
#pragma unroll
        for (int ai = 0; ai < 2; ++ai)
#pragma unroll
            for (int bj = 0; bj < 2; ++bj)
#pragma unroll
                for (int m = 0; m < 4; ++m)
#pragma unroll
                    for (int n = 0; n < 2; ++n) s += acc[ai][bj][m][n][0] + acc[ai][bj][m][n][1] + acc[ai][bj][m][n][2] + acc[ai][bj][m][n][3];
        if (s == 123.456f) sink[0] = s; }
};
template <long X8D> struct EpiIn {
    static constexpr bool PERM = true, AFTER_DRAIN = false;
    bf16_t* O;
    __device__ __forceinline__ void operator()(const f32x4 (&acc)[2][2][4][2], const Unit& u, int wr, int wc, int fr, int fq) const {
        const int pn = u.pn;
        int act = 0;
        if ((pn >= 8 && pn < 16) || (pn >= 48 && pn < 56) || (pn >= 68 && pn < 76)) act = 1;
        else if ((pn >= 40 && pn < 48) || pn >= 76) act = 2;
        else if (pn >= 24 && pn < 32) act = 3;
        const bool blocked = pn >= 16 && pn < 40;
        bf16_t* base = blocked ? O + X8D + (size_t)((pn - 16) >> 3) * MROWS * DM + ((size_t)((u.pm / 9) * 8 + ((pn - 16) & 7)) * 36 + (u.pm % 9) * 4) * (32 * 64 * 8)
                               : O + (size_t)u.pm * BM * NP + (size_t)pn * BM;
        const unsigned lane_off = blocked ? (unsigned)(wr * (32 * 64 * 8) + ((wc * 4 + fq) * 64 + fr) * 8) : (unsigned)((wr * 64 + fr) * NP + wc * 32 + 8 * fq);
        const unsigned sa = blocked ? 2u * 32 * 64 * 8 : (unsigned)HALF * NP, sm = blocked ? 16u * 8 : 16u * NP, sb = blocked ? 16u * 64 * 8 : (unsigned)HALF;
#pragma unroll
        for (int ai = 0; ai < 2; ++ai)
#pragma unroll
            for (int m = 0; m < 4; ++m) {
#pragma unroll
                for (int bj = 0; bj < 2; ++bj) { f32x4 v0 = acc[ai][bj][m][0], v1 = acc[ai][bj][m][1];
                    if (act == 1) {
#pragma unroll
                        for (int j = 0; j < 4; ++j) { v0[j] = v0[j] * sigmoid_f(v0[j]); v1[j] = v1[j] * sigmoid_f(v1[j]); } }
                    else if (act == 2) {
#pragma unroll
                        for (int j = 0; j < 4; ++j) { v0[j] = sigmoid_f(v0[j]); v1[j] = sigmoid_f(v1[j]); } }
                    else if (act == 3) { v0 = v0 * 0.0625f; v1 = v1 * 0.0625f; }
                    u32x4 w; w.x = cvt_pk_bf16(v0[0], v0[1]); w.y = cvt_pk_bf16(v0[2], v0[3]); w.z = cvt_pk_bf16(v1[0], v1[1]); w.w = cvt_pk_bf16(v1[2], v1[3]);
                    *(u32x4*)(base + (lane_off + ai * sa + m * sm + bj * sb)) = w; } }
    }
};
template <bool NHALF> struct EpiMerge {
    static constexpr bool PERM = true, AFTER_DRAIN = false;
    const bf16_t* P; float* ACC; bf16_t* G2;
    __device__ __forceinline__ void operator()(const f32x4 (&acc)[2][2][4][2], const Unit& u, int wr, int wc, int fr, int fq) const {
        const int row0 = u.pm * BM + wr * 64 + fr, col0 = u.pn * (NHALF ? HALF : BM) + wc * 32 + 8 * fq, z = u.z;
#pragma unroll
        for (int ai = 0; ai < 2; ++ai)
#pragma unroll
            for (int m = 0; m < 4; ++m) { const size_t r = (size_t)(row0 + ai * HALF + m * 16);
#pragma unroll
                for (int bj = 0; bj < (NHALF ? 1 : 2); ++bj) { const int c = col0 + bj * HALF;
                    const u32x4 g = *(const u32x4*)(P + r * NP + C_MG + z * DM + c);
                    f32x4 v0 = acc[ai][bj][m][0], v1 = acc[ai][bj][m][1];
                    v0[0] *= bflo(g.x); v0[1] *= bfhi(g.x); v0[2] *= bflo(g.y); v0[3] *= bfhi(g.y);
                    v1[0] *= bflo(g.z); v1[1] *= bfhi(g.z); v1[2] *= bflo(g.w); v1[3] *= bfhi(g.w);
                    if (u.sp) { u32x4 w; w.x = cvt_pk_bf16(v0[0], v0[1]); w.y = cvt_pk_bf16(v0[2], v0[3]); w.z = cvt_pk_bf16(v1[0], v1[1]); w.w = cvt_pk_bf16(v1[2], v1[3]);
                        *(u32x4*)(G2 + (size_t)(1 + z) * MROWS * DM + r * DM + c) = w;
                        continue; }
                    float* ap = ACC + r * DM + c;
                    if (z > 0) { v0 = v0 + *(const f32x4*)ap; v1 = v1 + *(const f32x4*)(ap + 4); }
                    if (z < 2) { *(f32x4*)ap = v0; *(f32x4*)(ap + 4) = v1; }
                    else { u32x4 w; w.x = cvt_pk_bf16(v0[0], v0[1]); w.y = cvt_pk_bf16(v0[2], v0[3]); w.z = cvt_pk_bf16(v1[0], v1[1]); w.w = cvt_pk_bf16(v1[2], v1[3]);
                        *(u32x4*)(G2 + r * DM + c) = w; } } }
    }
};
struct EpiMergeC {
    static constexpr bool PERM = true, AFTER_DRAIN = false, CHAIN = true;
    static constexpr int DEPTH_PF = 4;
    const bf16_t* P; bf16_t* G2;
    __device__ __forceinline__ static bool keep(const Unit& u) { return !u.sp && u.z < 2; }
    __device__ __forceinline__ static void unpack8(const u32x4 g, float (&s)[8]) { s[0] = bflo(g.x); s[1] = bfhi(g.x); s[2] = bflo(g.y); s[3] = bfhi(g.y); s[4] = bflo(g.z); s[5] = bfhi(g.z); s[6] = bflo(g.w); s[7] = bfhi(g.w); }
    __device__ __forceinline__ void operator()(f32x4 (&acc)[2][2][4][2], const Unit& u, int wr, int wc, int fr, int fq) const {
        const int row0 = u.pm * BM + wr * 64 + fr, col0 = u.pn * BM + wc * 32 + 8 * fq, z = u.z;
        constexpr float FLOOR = 1e-12f;
        const bf16_t* gp0 = P + (size_t)row0 * NP + C_MG + z * DM + col0;
        const bool chain = !u.sp && z < 2;
        bf16_t* O = G2 + (u.sp ? (size_t)(1 + z) * MROWS * DM : (size_t)0) + (size_t)row0 * DM + col0;
        u32x4 gq[DEPTH_PF], hq[DEPTH_PF];
#define EMC_OFF(t) ((size_t)((((t) >> 3) & 1) * HALF + (((t) >> 1) & 3) * 16) * NP + ((t) & 1) * HALF)
#define EMC_LOAD(t) do { gq[(t) % DEPTH_PF] = *(const u32x4*)(gp0 + EMC_OFF(t)); if (chain) hq[(t) % DEPTH_PF] = *(const u32x4*)(gp0 + EMC_OFF(t) + DM); } while (0)
#pragma unroll
        for (int t = 0; t < DEPTH_PF - 1; ++t) EMC_LOAD(t);
#pragma unroll
        for (int t = 0; t < 16; ++t) { const int ai = (t >> 3) & 1, m = (t >> 1) & 3, bj = t & 1;
            if (t + DEPTH_PF - 1 < 16) EMC_LOAD(t + DEPTH_PF - 1);
            float s[8]; unpack8(gq[t % DEPTH_PF], s);
            if (chain) { float d[8]; unpack8(hq[t % DEPTH_PF], d);
#pragma unroll
                for (int j = 0; j < 8; ++j) s[j] = fmaxf(s[j], FLOOR) * __builtin_amdgcn_rcpf(fmaxf(d[j], FLOOR));
#pragma unroll
                for (int j = 0; j < 4; ++j) { acc[ai][bj][m][0][j] *= s[j]; acc[ai][bj][m][1][j] *= s[4 + j]; } }
            else { if (!u.sp) {
#pragma unroll
                    for (int j = 0; j < 8; ++j) s[j] = fmaxf(s[j], FLOOR); }
                f32x4 v0 = acc[ai][bj][m][0], v1 = acc[ai][bj][m][1];
#pragma unroll
                for (int j = 0; j < 4; ++j) { v0[j] *= s[j]; v1[j] *= s[4 + j]; }
                u32x4 w; w.x = cvt_pk_bf16(v0[0], v0[1]); w.y = cvt_pk_bf16(v0[2], v0[3]); w.z = cvt_pk_bf16(v1[0], v1[1]); w.w = cvt_pk_bf16(v1[2], v1[3]);
                *(u32x4*)(O + (size_t)(ai * HALF + m * 16) * DM + bj * HALF) = w; } }
#undef EMC_OFF
#undef EMC_LOAD
    }
};
struct EpiY16 {
    static constexpr bool PERM = true, AFTER_DRAIN = false;
    bf16_t* Y; size_t slab;
    __device__ __forceinline__ void operator()(const f32x4 (&acc)[2][2][4][2], const Unit& u, int wr, int wc, int fr, int fq) const {
        const int row0 = u.pm * BM + wr * 64 + fr, col0 = u.pn * BM + wc * 32 + 8 * fq;
        bf16_t* Yb = Y + (u.sp ? (size_t)(u.z - 1) * slab : (size_t)0);
#pragma unroll
        for (int ai = 0; ai < 2; ++ai)
#pragma unroll
            for (int m = 0; m < 4; ++m) { bf16_t* rowp = Yb + (size_t)(row0 + ai * HALF + m * 16) * DM + col0;
#pragma unroll
                for (int bj = 0; bj < 2; ++bj) { const f32x4 v0 = acc[ai][bj][m][0], v1 = acc[ai][bj][m][1];
                    u32x4 w; w.x = cvt_pk_bf16(v0[0], v0[1]); w.y = cvt_pk_bf16(v0[2], v0[3]); w.z = cvt_pk_bf16(v1[0], v1[1]); w.w = cvt_pk_bf16(v1[2], v1[3]);
                    *(u32x4*)(rowp + bj * HALF) = w; } }
    }
};
template <class T, class = void> struct epi_chain { static constexpr bool value = false; };
template <class T> struct epi_chain<T, decltype((void)T::CHAIN)> { static constexpr bool value = T::CHAIN; };
template <class Epi, class Sched, bool ALIGN_EPI = false, bool SP2 = false, bool NHALF = false>
__device__ __forceinline__ void gemm_phase(PG8_LAS unsigned char* lds, const Gemm g, const Sched& S, const Epi& E) {
    int tid = threadIdx.x; asm volatile("" : "+v"(tid));
    const int wid = __builtin_amdgcn_readfirstlane(tid >> 6), lane = tid & 63, wr = wid >> 2, wc = wid & 3, fr = lane & 15, fq = lane >> 4;
    const int K = g.K, nt = K / BK;
    unsigned voffA[2], voffB[2];
#pragma unroll
    for (int i = 0; i < 2; ++i) { int R, C; stage_rc(tid * 16 + i * 8192, R, C); const int Rb = Epi::PERM ? ((R & ~31) + perm32(R & 31)) : R;
        voffA[i] = (unsigned)(R * K + C) * 2u; voffB[i] = (unsigned)(Rb * K + C) * 2u; }
    const size_t kstep = (size_t)(BK * 2);
    const size_t hstep = (size_t)HALF * K * 2;
    const size_t tstep = 2 * hstep;
    const size_t hsB = NHALF ? 0 : hstep, tstepB = NHALF ? hstep : tstep; static_assert(!NHALF || SP2, "NHALF is implemented for the SP2 loop");
    const unsigned ldsw = (unsigned)wid * 1024u;
    const int aoff = lds_byte(wr * 64 + fr, fq * 8), boff = lds_byte(wc * 32 + fr, fq * 8);
#define PG8_SA(b, h) (((b) * 2 + (h)) * HTB)
#define PG8_SB(b, h) ((4 + (b) * 2 + (h)) * HTB)
#define PG8_STAGE(bufoff, gbase, voff) do { _Pragma("unroll") for (int _i = 0; _i < 2; ++_i) \
        __builtin_amdgcn_global_load_lds((const unsigned*)((const char*)(gbase) + (voff)[_i]), (PG8_LAS unsigned*)(lds + (bufoff) + ldsw + _i * 8192), 16, 0, 0); } while (0)
#define PG8_LDA(dst, b, h) do { _Pragma("unroll") for (int m = 0; m < 4; ++m) _Pragma("unroll") for (int k = 0; k < 2; ++k) dst[m][k] = *(const PG8_LAS bf16x8*)(lds + PG8_SA(b, h) + aoff + m * 2048 + k * 1024); } while (0)
#define PG8_LDB(dst, b, h) do { _Pragma("unroll") for (int n = 0; n < 2; ++n) _Pragma("unroll") for (int k = 0; k < 2; ++k) dst[n][k] = *(const PG8_LAS bf16x8*)(lds + PG8_SB(b, h) + boff + n * 2048 + k * 1024); } while (0)
#define PG8_MMA(ai, bj, At, Bt) do { __builtin_amdgcn_s_setprio(1); _Pragma("unroll") for (int m = 0; m < 4; ++m) _Pragma("unroll") for (int n = 0; n < 2; ++n) _Pragma("unroll") for (int k = 0; k < 2; ++k) \
        acc[ai][bj][m][n] = __builtin_amdgcn_mfma_f32_16x16x32_bf16(Bt[n][k], At[m][k], acc[ai][bj][m][n], 0, 0, 0); __builtin_amdgcn_s_setprio(0); } while (0)
#define PG8_WAIT_V(n) asm volatile("s_waitcnt vmcnt(" #n ")" ::: "memory")
#define PG8_WAIT_L(n) asm volatile("s_waitcnt lgkmcnt(" #n ")" ::: "memory")
#define PG8_BAR __builtin_amdgcn_s_barrier()
#define PG8_SCHED __builtin_amdgcn_sched_barrier(0)
    Unit cur, nxt; int ui = 0;
    if (!S.next(0, cur)) return;
    f32x4 acc[2][2][4][2];
#pragma unroll
    for (int a = 0; a < 2; ++a)
#pragma unroll
        for (int b = 0; b < 2; ++b)
#pragma unroll
            for (int m = 0; m < 4; ++m)
#pragma unroll
                for (int n = 0; n < 2; ++n) acc[a][b][m][n] = (f32x4){0.f, 0.f, 0.f, 0.f};
    bf16x8 At[4][2], B0[2][2], B1[2][2];
    const char* cA = (const char*)g.A + (size_t)cur.z * g.zA + (size_t)cur.pm * tstep; const char* cB = (const char*)g.Bt + (size_t)cur.z * g.zB + (size_t)cur.pn * tstepB;
    S.a_ready(cur);
    if constexpr (SP2) {
        PG8_STAGE(PG8_SB(0, 0), cB, voffB); PG8_STAGE(PG8_SB(0, 1), cB + hsB, voffB); PG8_STAGE(PG8_SA(0, 0), cA, voffA); PG8_STAGE(PG8_SA(0, 1), cA + hstep, voffA);
        if (wr == 1) PG8_BAR;
        PG8_WAIT_V(2); PG8_BAR;
        PG8_STAGE(PG8_SB(1, 0), cB + kstep, voffB); PG8_STAGE(PG8_SA(1, 0), cA + kstep, voffA); PG8_STAGE(PG8_SB(1, 1), cB + hsB + kstep, voffB);
        PG8_WAIT_V(6); PG8_BAR;
    } else {
        PG8_STAGE(PG8_SB(0, 0), cB, voffB); PG8_STAGE(PG8_SA(0, 0), cA, voffA); PG8_STAGE(PG8_SB(0, 1), cB + hstep, voffB); PG8_STAGE(PG8_SA(0, 1), cA + hstep, voffA);
        if (wr == 1) PG8_BAR;
        PG8_WAIT_V(4); PG8_BAR;
        PG8_STAGE(PG8_SB(1, 0), cB + kstep, voffB); PG8_STAGE(PG8_SA(1, 0), cA + kstep, voffA); PG8_STAGE(PG8_SB(1, 1), cB + hstep + kstep, voffB);
        PG8_WAIT_V(6); PG8_BAR;
    }
    for (;;) {
        const bool has_next = S.next(ui + 1, nxt);
        const char* nA = has_next ? (const char*)g.A + (size_t)nxt.z * g.zA + (size_t)nxt.pm * tstep : cA; const char* nB = has_next ? (const char*)g.Bt + (size_t)nxt.z * g.zB + (size_t)nxt.pn * tstepB : cB;
        for (int t = 0; t < nt; t += 2) {
            const bool last = (t == nt - 2);
            const char* a1 = cA + (size_t)(t + 1) * kstep;
            const char* a2 = last ? nA : cA + (size_t)(t + 2) * kstep; const char* b2 = last ? nB : cB + (size_t)(t + 2) * kstep;
            const char* a3 = a2 + kstep; const char* b3 = b2 + kstep;
            if (last && has_next) S.a_ready(nxt);
            if constexpr (SP2) {
            PG8_LDB(B0, 0, 0); if constexpr (!NHALF) PG8_LDB(B1, 0, 1); PG8_SCHED; PG8_LDA(At, 0, 0); PG8_STAGE(PG8_SA(1, 1), a1 + hstep, voffA);
            PG8_WAIT_V(8); PG8_WAIT_L(0); PG8_BAR; PG8_MMA(0, 0, At, B0); if constexpr (!NHALF) PG8_MMA(0, 1, At, B1); PG8_BAR; PG8_SCHED;
            PG8_LDA(At, 0, 1); PG8_STAGE(PG8_SB(0, 0), b2, voffB); PG8_STAGE(PG8_SB(0, 1), b2 + hsB, voffB); PG8_STAGE(PG8_SA(0, 0), a2, voffA);
            PG8_WAIT_V(8); PG8_WAIT_L(0); PG8_BAR; PG8_MMA(1, 0, At, B0); if constexpr (!NHALF) PG8_MMA(1, 1, At, B1); PG8_BAR; PG8_SCHED;
            PG8_LDB(B0, 1, 0); if constexpr (!NHALF) PG8_LDB(B1, 1, 1); PG8_SCHED; PG8_LDA(At, 1, 0); PG8_STAGE(PG8_SA(0, 1), a2 + hstep, voffA);
            PG8_WAIT_V(8); PG8_WAIT_L(0); PG8_BAR; PG8_MMA(0, 0, At, B0); if constexpr (!NHALF) PG8_MMA(0, 1, At, B1); PG8_BAR; PG8_SCHED;
            PG8_LDA(At, 1, 1); PG8_STAGE(PG8_SB(1, 0), b3, voffB); PG8_STAGE(PG8_SB(1, 1), b3 + hsB, voffB); PG8_STAGE(PG8_SA(1, 0), a3, voffA);
            PG8_WAIT_V(8); PG8_WAIT_L(0); PG8_BAR; PG8_MMA(1, 0, At, B0); if constexpr (!NHALF) PG8_MMA(1, 1, At, B1); PG8_BAR; PG8_SCHED;
            } else {
            PG8_LDB(B0, 0, 0); PG8_SCHED; PG8_LDA(At, 0, 0); PG8_STAGE(PG8_SA(1, 1), a1 + hstep, voffA);
            PG8_WAIT_L(8); PG8_BAR; PG8_WAIT_L(0); PG8_MMA(0, 0, At, B0); PG8_BAR; PG8_SCHED;
            PG8_LDB(B1, 0, 1); PG8_STAGE(PG8_SB(0, 0), b2, voffB);
            PG8_BAR; PG8_WAIT_L(0); PG8_MMA(0, 1, At, B1); PG8_BAR;
            PG8_LDA(At, 0, 1); PG8_STAGE(PG8_SA(0, 0), a2, voffA);
            PG8_BAR; PG8_WAIT_L(0); PG8_MMA(1, 0, At, B0); PG8_BAR; PG8_SCHED;
            PG8_STAGE(PG8_SB(0, 1), b2 + hstep, voffB);
            PG8_WAIT_V(6); PG8_BAR; PG8_MMA(1, 1, At, B1); PG8_BAR;
            PG8_LDB(B0, 1, 0); PG8_SCHED; PG8_LDA(At, 1, 0); PG8_STAGE(PG8_SA(0, 1), a2 + hstep, voffA);
            PG8_WAIT_L(8); PG8_BAR; PG8_WAIT_L(0); PG8_MMA(0, 0, At, B0); PG8_BAR; PG8_SCHED;
            PG8_LDB(B1, 1, 1); PG8_STAGE(PG8_SB(1, 0), b3, voffB);
            PG8_BAR; PG8_WAIT_L(0); PG8_MMA(0, 1, At, B1); PG8_BAR;
            PG8_LDA(At, 1, 1); PG8_STAGE(PG8_SA(1, 0), a3, voffA);
            PG8_BAR; PG8_WAIT_L(0); PG8_MMA(1, 0, At, B0); PG8_BAR; PG8_SCHED;
            PG8_STAGE(PG8_SB(1, 1), b3 + hstep, voffB);
            PG8_WAIT_V(6); PG8_BAR; PG8_MMA(1, 1, At, B1); PG8_BAR;
            }
        }
        if constexpr (ALIGN_EPI) { if (wr == 0) PG8_BAR; }
        if constexpr (!Epi::AFTER_DRAIN) { E(acc, cur, wr, wc, fr, fq); S.done(cur); }
        if (!has_next) break;
        bool clear = true; if constexpr (epi_chain<Epi>::value) clear = !Epi::keep(cur);
        if (clear) {
#pragma unroll
        for (int a = 0; a < 2; ++a)
#pragma unroll
            for (int b = 0; b < 2; ++b)
#pragma unroll
                for (int m = 0; m < 4; ++m)
#pragma unroll
                    for (int n = 0; n < 2; ++n) acc[a][b][m][n] = (f32x4){0.f, 0.f, 0.f, 0.f};
        }
        cur = nxt; cA = nA; cB = nB; ++ui;
        if constexpr (ALIGN_EPI) { if (wr == 1) PG8_BAR; }
    }
    PG8_WAIT_V(0);
    if constexpr (!ALIGN_EPI) { if (wr == 0) PG8_BAR; }
    PG8_BAR;
    if constexpr (Epi::AFTER_DRAIN) { E.fused(acc, cur, wr, wc, fr, fq, lds, wid, lane); S.done(cur); }
#undef PG8_SA
#undef PG8_SB
#undef PG8_STAGE
#undef PG8_LDA
#undef PG8_LDB
#undef PG8_MMA
#undef PG8_WAIT_V
#undef PG8_WAIT_L
#undef PG8_BAR
#undef PG8_SCHED
}
}

namespace att {
using bf16 = __hip_bfloat16;
constexpr int   D = 128, NW = 8, QBLK = 32, KVBLK = 64;
constexpr float SCALE = 0.088388347648318440f;
constexpr float THR = 8.f;
#ifndef ATT_SDEPTH
#define ATT_SDEPTH 1
#endif
constexpr int SDEPTH = ATT_SDEPTH;
constexpr int LDQ = NP, LDK = NP, LDO = DM;
constexpr size_t SHM_V = KVBLK * D * 2, SHM_K = KVBLK * D * 2, SHM_ATTN = 2 * SHM_V + 2 * SHM_K + NW * 64 * 4;
constexpr int OST_OFF = 69632, OST_END = OST_OFF + NW * 32 * 272;
using bf16x8 = __attribute__((ext_vector_type(8))) short;
using s16x4  = __attribute__((ext_vector_type(4))) short;
using f32x16 = __attribute__((ext_vector_type(16))) float;
using f32x4  = __attribute__((ext_vector_type(4))) float;
using u32x4  = __attribute__((ext_vector_type(4))) unsigned;
#define KSWZ(row, colB) ((row) * 256 + ((colB) ^ (((row) & 7) << 4)))
#define SBAR() __builtin_amdgcn_sched_barrier(0)
__device__ __forceinline__ int crow(int r, int hi) { return (r & 3) + 8 * (r >> 2) + 4 * hi; }
__device__ __forceinline__ unsigned cvtpk(float lo, float hi) { unsigned r; asm volatile("v_cvt_pk_bf16_f32 %0, %1, %2" : "=v"(r) : "v"(lo), "v"(hi)); return r; }
__device__ __forceinline__ bf16x8 ld8(const bf16* p) { return *reinterpret_cast<const bf16x8*>(p); }

__device__ __forceinline__ void partialSM(f32x16& p0, f32x16& p1, float& m_reg, float& mn, float& alpha) {
  constexpr float C = SCALE * 1.4426950408889634f;
  float pmax = p0[0];
#pragma unroll
  for (int r = 1; r < 16; ++r) pmax = fmaxf(pmax, p0[r]);
#pragma unroll
  for (int r = 0; r < 16; ++r) pmax = fmaxf(pmax, p1[r]);
  { auto rr = __builtin_amdgcn_permlane32_swap(__float_as_uint(pmax), __float_as_uint(pmax), false, false);
    pmax = fmaxf(__uint_as_float(rr[0]), __uint_as_float(rr[1])); }
  if (__builtin_expect(__all(pmax - m_reg <= THR / SCALE), 1)) { mn = m_reg; alpha = 1.f; }
  else { mn = fmaxf(m_reg, pmax); alpha = __builtin_amdgcn_exp2f((m_reg - mn) * C); m_reg = mn; }
  float mnC = -mn * C;
#pragma unroll
  for (int r = 0; r < 16; ++r) p0[r] = fmaf(p0[r], C, mnC);
#pragma unroll
  for (int r = 0; r < 16; ++r) p1[r] = fmaf(p1[r], C, mnC);
#pragma unroll
  for (int r = 0; r < 16; ++r) p0[r] = __builtin_amdgcn_exp2f(p0[r]);
}
__device__ __forceinline__ void finishSM(f32x16& p0, f32x16& p1, float alpha, float& l_reg, bf16x8& pa0, bf16x8& pa1, bf16x8& pa2, bf16x8& pa3) {
#pragma unroll
  for (int r = 0; r < 16; ++r) p1[r] = __builtin_amdgcn_exp2f(p1[r]);
  float ps = 0;
#pragma unroll
  for (int r = 0; r < 16; ++r) ps += p0[r];
#pragma unroll
  for (int r = 0; r < 16; ++r) ps += p1[r];
  { auto rr = __builtin_amdgcn_permlane32_swap(__float_as_uint(ps), __float_as_uint(ps), false, false);
    ps = __uint_as_float(rr[0]) + __uint_as_float(rr[1]); }
  l_reg = l_reg * alpha + ps;
#define PK4(P, BASE, OUT) do { unsigned a0 = cvtpk(P[BASE + 0], P[BASE + 1]), a1 = cvtpk(P[BASE + 2], P[BASE + 3]);   \
    unsigned b0 = cvtpk(P[BASE + 4], P[BASE + 5]), b1 = cvtpk(P[BASE + 6], P[BASE + 7]);                              \
    auto r0 = __builtin_amdgcn_permlane32_swap(a0, b0, false, false); auto r1 = __builtin_amdgcn_permlane32_swap(a1, b1, false, false); \
    u32x4 w = {r0[0], r1[0], r0[1], r1[1]}; OUT = *reinterpret_cast<bf16x8*>(&w); } while (0)
  PK4(p0, 0, pa0); PK4(p0, 8, pa1); PK4(p1, 0, pa2); PK4(p1, 8, pa3);
#undef PK4
}
__device__ __forceinline__ void qkt(f32x16& p0, f32x16& p1, const bf16* Ks, const bf16x8* qr, int r32, int hi) {
  p0 = f32x16{}; p1 = f32x16{};
#pragma unroll
  for (int d0 = 0; d0 < 8; ++d0) { int cb = (d0 * 16 + hi * 8) * 2;
    bf16x8 b0 = *reinterpret_cast<const bf16x8*>((const char*)Ks + KSWZ(r32, cb));
    bf16x8 b1 = *reinterpret_cast<const bf16x8*>((const char*)Ks + KSWZ(32 + r32, cb));
    p0 = __builtin_amdgcn_mfma_f32_32x32x16_bf16(b0, qr[d0], p0, 0, 0, 0);
    p1 = __builtin_amdgcn_mfma_f32_32x32x16_bf16(b1, qr[d0], p1, 0, 0, 0); }
}
__device__ __forceinline__ int v_st(int k, int c) { const int kk = (k & ~0xC) | ((k & 4) << 1) | ((k & 8) >> 1); return ((kk >> 3) * 4 + (c >> 5)) * 512 + ((kk & 7) * 32 + (c & 31)) * 2; }
__device__ __forceinline__ int v_rd_base(int lane) { return ((lane & 3) << 3) | (((lane >> 2) & 3) << 6) | (((lane >> 4) & 1) << 5) | (((lane >> 5) & 1) << 8); }
constexpr int v_rd_off(int d0, int ks, int half) { return d0 * 512 + ks * 4096 + half * 2048; }
template <int OFF> __device__ __forceinline__ s16x4 tr_read(int vb) {
  s16x4 r; asm volatile("ds_read_b64_tr_b16 %0, %1 offset:%2" : "=&v"(r) : "v"(vb), "i"(OFF) : "memory"); return r;
}
template <int D0> __device__ __forceinline__ void pv_one(f32x16& od, int vb, bf16x8 pa0, bf16x8 pa1, bf16x8 pa2, bf16x8 pa3) {
  const s16x4 l0 = tr_read<v_rd_off(D0, 0, 0)>(vb), h0 = tr_read<v_rd_off(D0, 0, 1)>(vb), l1 = tr_read<v_rd_off(D0, 1, 0)>(vb), h1 = tr_read<v_rd_off(D0, 1, 1)>(vb);
  const s16x4 l2 = tr_read<v_rd_off(D0, 2, 0)>(vb), h2 = tr_read<v_rd_off(D0, 2, 1)>(vb), l3 = tr_read<v_rd_off(D0, 3, 0)>(vb), h3 = tr_read<v_rd_off(D0, 3, 1)>(vb);
  asm volatile("s_waitcnt lgkmcnt(0)" ::: "memory"); SBAR();
#define PK(L, H) (bf16x8){L[0], L[1], L[2], L[3], H[0], H[1], H[2], H[3]}
  od = __builtin_amdgcn_mfma_f32_32x32x16_bf16(pa0, PK(l0, h0), od, 0, 0, 0);
  od = __builtin_amdgcn_mfma_f32_32x32x16_bf16(pa1, PK(l1, h1), od, 0, 0, 0);
  od = __builtin_amdgcn_mfma_f32_32x32x16_bf16(pa2, PK(l2, h2), od, 0, 0, 0);
  od = __builtin_amdgcn_mfma_f32_32x32x16_bf16(pa3, PK(l3, h3), od, 0, 0, 0);
#undef PK
}
__device__ __forceinline__ void pv_d0(f32x16* o, int vb, bf16x8 pa0, bf16x8 pa1, bf16x8 pa2, bf16x8 pa3) {
  pv_one<0>(o[0], vb, pa0, pa1, pa2, pa3); pv_one<1>(o[1], vb, pa0, pa1, pa2, pa3); pv_one<2>(o[2], vb, pa0, pa1, pa2, pa3); pv_one<3>(o[3], vb, pa0, pa1, pa2, pa3);
}

__device__ __forceinline__ void attn_unit(const bf16* __restrict__ Qb, const bf16* __restrict__ Kh, const bf16* __restrict__ Vh, const bf16* __restrict__ Zb,
                                          bf16* __restrict__ Ob, int seq, char* lds, const float* __restrict__ qn, const float* __restrict__ cs, const float* __restrict__ sn) {
  int tid = threadIdx.x; asm volatile("" : "+v"(tid));
  int wid = tid >> 6, lane = tid & 63, r32 = lane & 31, hi = lane >> 5;
  bf16* V_lds = (bf16*)lds; bf16* K_lds = (bf16*)(lds + 2 * SHM_V);
  float* ws = (float*)(lds + 2 * SHM_V + 2 * SHM_K) + wid * 64; float* li_l = ws; float* al_l = ws + 32;
  float m_reg = -1e30f, l_reg = 0; f32x16 o[4] = {}; bf16x8 qr[8];
  {
    const bf16* Qw = Qb + (long)(wid * QBLK + r32) * LDQ + hi * 8;
    float ss = 0.f;
#pragma unroll
    for (int d0 = 0; d0 < 8; ++d0) { const u32x4 w = *reinterpret_cast<const u32x4*>(Qw + d0 * 16); qr[d0] = __builtin_bit_cast(bf16x8, w);
#pragma unroll
      for (int e = 0; e < 4; ++e) { const float lo = __uint_as_float(w[e] << 16), hh = __uint_as_float(w[e] & 0xffff0000u); ss += lo * lo + hh * hh; } }
    { auto rr = __builtin_amdgcn_permlane32_swap(__float_as_uint(ss), __float_as_uint(ss), false, false); ss = __uint_as_float(rr[0]) + __uint_as_float(rr[1]); }
    const float rs = rsqrtf(ss * (1.f / 128.f) + EPS);
    const float* cp = cs ? cs + (long)(wid * QBLK + r32) * 64 + hi * 8 : nullptr; const float* sp = cs ? sn + (long)(wid * QBLK + r32) * 64 + hi * 8 : nullptr;
#pragma unroll
    for (int d0 = 0; d0 < 4; ++d0) {
      const u32x4 wa = __builtin_bit_cast(u32x4, qr[d0]), wb = __builtin_bit_cast(u32x4, qr[d0 + 4]); float x1[8], x2[8];
#pragma unroll
      for (int e = 0; e < 4; ++e) { x1[2 * e] = __uint_as_float(wa[e] << 16); x1[2 * e + 1] = __uint_as_float(wa[e] & 0xffff0000u); x2[2 * e] = __uint_as_float(wb[e] << 16); x2[2 * e + 1] = __uint_as_float(wb[e] & 0xffff0000u); }
      const f32x4 ga0 = *reinterpret_cast<const f32x4*>(qn + d0 * 16 + hi * 8), ga1 = *reinterpret_cast<const f32x4*>(qn + d0 * 16 + hi * 8 + 4);
      const f32x4 gb0 = *reinterpret_cast<const f32x4*>(qn + 64 + d0 * 16 + hi * 8), gb1 = *reinterpret_cast<const f32x4*>(qn + 64 + d0 * 16 + hi * 8 + 4);
#pragma unroll
      for (int e = 0; e < 8; ++e) { x1[e] *= rs * (e < 4 ? ga0[e & 3] : ga1[e & 3]); x2[e] *= rs * (e < 4 ? gb0[e & 3] : gb1[e & 3]); }
      if (cs) {
        const f32x4 c0 = *reinterpret_cast<const f32x4*>(cp + d0 * 16), c1 = *reinterpret_cast<const f32x4*>(cp + d0 * 16 + 4);
        const f32x4 s0 = *reinterpret_cast<const f32x4*>(sp + d0 * 16), s1 = *reinterpret_cast<const f32x4*>(sp + d0 * 16 + 4);
#pragma unroll
        for (int e = 0; e < 8; ++e) { const float c = e < 4 ? c0[e & 3] : c1[e & 3], sv = e < 4 ? s0[e & 3] : s1[e & 3];
          const float a = x1[e], bq = x2[e]; x1[e] = a * c - bq * sv; x2[e] = bq * c + a * sv; }
      }
      const u32x4 oa = {cvtpk(x1[0], x1[1]), cvtpk(x1[2], x1[3]), cvtpk(x1[4], x1[5]), cvtpk(x1[6], x1[7])}, ob = {cvtpk(x2[0], x2[1]), cvtpk(x2[2], x2[3]), cvtpk(x2[4], x2[5]), cvtpk(x2[6], x2[7])};
      qr[d0] = __builtin_bit_cast(bf16x8, oa); qr[d0 + 4] = __builtin_bit_cast(bf16x8, ob);
      asm volatile("" ::: "memory");
    }
  }
  const int sr = tid >> 4, sc = (tid & 15) * 8, vst0 = v_st(sr, sc), vst1 = v_st(32 + sr, sc);
  const int vb0 = (int)(uintptr_t)V_lds + v_rd_base(lane);
  struct { bf16x8 vs0, vs1, ks0, ks1; } sr_[SDEPTH];
#define SLOAD(i, k0) do { sr_[i].vs0 = ld8(&Vh[(long)((k0) + sr) * LDK + sc]); sr_[i].vs1 = ld8(&Vh[(long)((k0) + 32 + sr) * LDK + sc]); \
    sr_[i].ks0 = ld8(&Kh[(long)((k0) + sr) * LDK + sc]); sr_[i].ks1 = ld8(&Kh[(long)((k0) + 32 + sr) * LDK + sc]); } while (0)
#define SWRITE(b, i) do { *(bf16x8*)((char*)V_lds + (b) * SHM_V + vst0) = sr_[i].vs0;          \
    *(bf16x8*)((char*)V_lds + (b) * SHM_V + vst1) = sr_[i].vs1; int kc = sc * 2;               \
    *(bf16x8*)((char*)K_lds + (b) * SHM_K + KSWZ(sr, kc)) = sr_[i].ks0;                       \
    *(bf16x8*)((char*)K_lds + (b) * SHM_K + KSWZ(32 + sr, kc)) = sr_[i].ks1; } while (0)
#define SWAIT() do { if constexpr (SDEPTH == 2) asm volatile("s_waitcnt vmcnt(4)" ::: "memory"); else asm volatile("s_waitcnt vmcnt(0)" ::: "memory"); } while (0)
#define RESC(a) do { if (__any((a) < 1.f)) { if (hi == 0) al_l[r32] = (a); asm volatile("s_waitcnt lgkmcnt(0)" ::: "memory"); \
    _Pragma("unroll") for (int d = 0; d < 4; ++d) _Pragma("unroll") for (int r = 0; r < 16; ++r) o[d][r] *= al_l[crow(r, hi)]; } } while (0)
  f32x16 pA0, pA1, pB0, pB1; float mnA, mnB, alA, alB; bf16x8 pa0, pa1, pa2, pa3; const int NT = seq / KVBLK;
  constexpr int SE = 0, SO = SDEPTH - 1;
  SLOAD(SE, 0); asm volatile("s_waitcnt vmcnt(0)" ::: "memory"); SWRITE(0, SE); __syncthreads();
  qkt(pA0, pA1, K_lds, qr, r32, hi); partialSM(pA0, pA1, m_reg, mnA, alA);
  SLOAD(SO, KVBLK); if constexpr (SDEPTH == 2) { if (2 < NT) SLOAD(SE, 2 * KVBLK); }
  SWAIT(); SWRITE(1, SO); __syncthreads();
  for (int j = 1; j + 1 < NT; j += 2) {
    SBAR(); qkt(pB0, pB1, (bf16*)((char*)K_lds + SHM_K), qr, r32, hi);
    finishSM(pA0, pA1, alA, l_reg, pa0, pa1, pa2, pa3); SBAR();
    SLOAD(SO, (j + SDEPTH) * KVBLK); SBAR();
    pv_d0(o, vb0, pa0, pa1, pa2, pa3); partialSM(pB0, pB1, m_reg, mnB, alB);
    __syncthreads(); SWAIT(); SWRITE(0, SE);
    RESC(alB); __syncthreads();
    SBAR(); qkt(pA0, pA1, K_lds, qr, r32, hi);
    finishSM(pB0, pB1, alB, l_reg, pa0, pa1, pa2, pa3); SBAR();
    if (SDEPTH == 1 || j + 3 < NT) SLOAD(SE, (j + 1 + SDEPTH) * KVBLK); SBAR();
    pv_d0(o, vb0 + (int)SHM_V, pa0, pa1, pa2, pa3); partialSM(pA0, pA1, m_reg, mnA, alA);
    __syncthreads(); SWAIT(); SWRITE(1, SO);
    RESC(alA); __syncthreads();
  }
  SBAR(); qkt(pB0, pB1, (bf16*)((char*)K_lds + SHM_K), qr, r32, hi);
  finishSM(pA0, pA1, alA, l_reg, pa0, pa1, pa2, pa3); SBAR();
  pv_d0(o, vb0, pa0, pa1, pa2, pa3); partialSM(pB0, pB1, m_reg, mnB, alB);
  __syncthreads(); RESC(alB);
  finishSM(pB0, pB1, alB, l_reg, pa0, pa1, pa2, pa3); SBAR();
  pv_d0(o, vb0 + (int)SHM_V, pa0, pa1, pa2, pa3);
  if (hi == 0) li_l[r32] = l_reg; asm volatile("s_waitcnt lgkmcnt(0)" ::: "memory");
  { int tz = threadIdx.x; asm volatile("" : "+v"(tz)); wid = tz >> 6; lane = tz & 63; r32 = lane & 31; hi = lane >> 5; }
  float rli[16];
#pragma unroll
  for (int r = 0; r < 16; ++r) rli[r] = __builtin_amdgcn_rcpf(li_l[crow(r, hi)]);
  char* ost = lds + OST_OFF + wid * (32 * 272);
#pragma unroll
  for (int r = 0; r < 16; ++r) { const int orow = crow(r, hi);
#pragma unroll
    for (int d0 = 0; d0 < 4; ++d0) *(bf16*)(ost + orow * 272 + (d0 * 32 + r32) * 2) = __float2bfloat16(o[d0][r] * rli[r]); }
  asm volatile("s_waitcnt lgkmcnt(0)" ::: "memory");
  bf16* Ow = Ob + (long)(wid * QBLK) * LDO; const bf16* Zw = Zb + (long)(wid * QBLK) * LDQ;
#pragma unroll
  for (int hb = 0; hb < 2; ++hb) {
    u32x4 ov[4], zv[4];
#pragma unroll
    for (int i = 0; i < 4; ++i) { const int c = (hb * 4 + i) * 64 + lane, row = c >> 4, col = (c & 15) * 8;
      ov[i] = *reinterpret_cast<const u32x4*>(ost + row * 272 + col * 2); zv[i] = *reinterpret_cast<const u32x4*>(Zw + (long)row * LDQ + col); }
#pragma unroll
    for (int i = 0; i < 4; ++i) { const int c = (hb * 4 + i) * 64 + lane, row = c >> 4, col = (c & 15) * 8; u32x4 w;
#pragma unroll
      for (int e = 0; e < 4; ++e) { const unsigned a = ov[i][e], z = zv[i][e];
        w[e] = cvtpk(__uint_as_float(a << 16) * __uint_as_float(z << 16), __uint_as_float(a & 0xffff0000u) * __uint_as_float(z & 0xffff0000u)); }
      *reinterpret_cast<u32x4*>(Ow + (long)row * LDO + col) = w; }
  }
  __syncthreads();
#undef SLOAD
#undef SWRITE
#undef SWAIT
#undef RESC
}
}

constexpr int NWAVES = 8;
#ifndef MK_N_LAUNCHES
#define MK_N_LAUNCHES 1
#endif
constexpr int PH_PER_LAYER = 7, N_PHASES = 2 + DEPTH * PH_PER_LAYER;
constexpr size_t MiB = 1u << 20;
constexpr size_t WS_CTL = 0, CTL_ZERO_BYTES = 1 * MiB;
constexpr size_t WS_MOD = 1 * MiB;
constexpr size_t WS_ROPE = WS_MOD + MiB / 2;
constexpr size_t WS_WG = 3 * MiB;
constexpr size_t WS_WLRU = 4 * MiB;
constexpr size_t WS_WOUT = 12 * MiB;
constexpr size_t WS_WBR = 44 * MiB;
constexpr size_t WS_WIN = 140 * MiB;
constexpr size_t WS_X = 540 * MiB;
constexpr size_t WS_Y = 2112 * MiB;
constexpr size_t WS_H = 684 * MiB;
constexpr size_t WS_G2 = 1968 * MiB;
constexpr size_t WS_YB = 756 * MiB;
constexpr size_t WS_ACC = 864 * MiB;
constexpr size_t WS_GT = 936 * MiB;
constexpr size_t WS_MH = 938 * MiB;
constexpr size_t WS_P = 1082 * MiB;
constexpr size_t WS_LA = 1532 * MiB;
constexpr size_t WS_LB = 1676 * MiB;
constexpr size_t WS_X8 = WS_LB;
constexpr size_t WS_HL = 1820 * MiB;
constexpr size_t WS_GSC = 1964 * MiB;
constexpr size_t WS_END = 2328 * MiB;
constexpr int CW_BAR = 4096;
constexpr int RING_BYTES = 131072, LDS_BYTES = 147456, MISC_OFF = LDS_BYTES - 256;
static_assert(att::OST_END <= MISC_OFF, "LDS map");

#define GAS __attribute__((address_space(1)))
#define LAS __attribute__((address_space(3)))
typedef unsigned short bf16_t;
typedef unsigned v4u __attribute__((ext_vector_type(4)));
typedef unsigned v2u __attribute__((ext_vector_type(2)));
typedef float f32x4 __attribute__((ext_vector_type(4)));
#define LDS_WAIT() asm volatile("s_waitcnt lgkmcnt(0)" ::: "memory")
__device__ __forceinline__ unsigned f2bf(float f) { unsigned u = __builtin_bit_cast(unsigned, f); return (u + 0x7fffu + ((u >> 16) & 1u)) >> 16; }
__device__ __forceinline__ unsigned pk2(float lo, float hi) { unsigned r; asm("v_cvt_pk_bf16_f32 %0, %1, %2" : "=v"(r) : "v"(lo), "v"(hi)); return r; }
__device__ __forceinline__ float bf2f(bf16_t b) { return __uint_as_float((unsigned)b << 16); }
__device__ __forceinline__ float blo(unsigned w) { return __uint_as_float(w << 16); }
__device__ __forceinline__ float bhi(unsigned w) { return __uint_as_float(w & 0xffff0000u); }
__device__ __forceinline__ float lane_get(float v, int src) { return __builtin_bit_cast(float, __builtin_amdgcn_ds_bpermute(src << 2, __builtin_bit_cast(int, v))); }
__device__ __forceinline__ float lane_xor(float v, int mask, int lane) { return lane_get(v, lane ^ mask); }
__device__ __forceinline__ float lane_up(float v, int delta, int lane) { return lane_get(v, lane >= delta ? lane - delta : lane); }
__device__ __forceinline__ float wave_sum(float v, int lane) {
#pragma unroll
    for (int o = 1; o < 64; o <<= 1) v += lane_xor(v, o, lane);
    return v;
}
#define XB_TMO      128
#define XB_XCNT(j)  (256  + 64 * (j))
#define XB_XSUB(j)  (1280 + 64 * (j))
#define XB_XGEN(j)  (2304 + 64 * (j))
#define XB_TOP      3328
#define XB_TOPGEN   3392
#define XCD_BAR_WORDS 3456
#define XB_SPIN_CAP (1u << 18)

__device__ __forceinline__ unsigned xb_ld(unsigned* p)              { return __hip_atomic_load(p, __ATOMIC_RELAXED, __HIP_MEMORY_SCOPE_AGENT); }
__device__ __forceinline__ unsigned xb_add(unsigned* p, unsigned v) { return __hip_atomic_fetch_add(p, v, __ATOMIC_RELAXED, __HIP_MEMORY_SCOPE_AGENT); }
__device__ __forceinline__ unsigned xb_xcc_id() { return (unsigned)__builtin_amdgcn_s_getreg((3 << 11) | 20) & 0xFu; }
#define XB_SPIN(cond, bar) do { unsigned _sp = 0; while (cond) { __builtin_amdgcn_s_sleep(1); \
    if ((++_sp & 255u) == 0u) { if (xb_ld(&(bar)[XB_TMO])) break; if (_sp > XB_SPIN_CAP) { atomicAdd(&(bar)[XB_TMO], 1u); break; } } } } while (0)

struct XcdBarrier {
    unsigned* bar; unsigned x;
    volatile LAS unsigned* st;
};

__device__ __forceinline__ XcdBarrier xcd_barrier_post(unsigned* bar, volatile LAS unsigned* st) {
    XcdBarrier b; b.bar = bar; b.x = xb_xcc_id(); b.st = st;
    if (threadIdx.x == 0) (void)xb_add(&bar[XB_XCNT(b.x)], 1u);
    return b;
}
__device__ __forceinline__ void xcd_barrier_complete(unsigned* bar, unsigned x, unsigned& nloc, unsigned& nx) {
    const unsigned G = gridDim.x * gridDim.y * gridDim.z;
    unsigned sum, cnt, mine, sp = 0u;
    for (;;) {
        sum = 0u; cnt = 0u; mine = 0u;
#pragma unroll
        for (unsigned j = 0; j < 16; ++j) { const unsigned c = xb_ld(&bar[XB_XCNT(j)]); sum += c; cnt += (c > 0u) ? 1u : 0u; mine = (j == x) ? c : mine; }
        if (sum == G) break;
        __builtin_amdgcn_s_sleep(1);
        if ((++sp & 255u) == 0u) { if (xb_ld(&bar[XB_TMO])) break; if (sp > XB_SPIN_CAP) { atomicAdd(&bar[XB_TMO], 1u); break; } }
    }
    nloc = mine > 0u ? mine : 1u; nx = cnt > 0u ? cnt : 1u;
}

__device__ __forceinline__ void xcd_barrier(const XcdBarrier& b) {
    asm volatile("s_waitcnt vmcnt(0)" ::: "memory");
    __syncthreads();
    if (threadIdx.x == 0) {
        unsigned* bar = b.bar;
        __builtin_amdgcn_s_waitcnt(0);
        unsigned nloc = b.st[0], nx = b.st[1];
        if (nloc == 0u) { xcd_barrier_complete(bar, b.x, nloc, nx); b.st[0] = nloc; b.st[1] = nx; }
        const unsigned old = xb_add(&bar[XB_XSUB(b.x)], 1u);
        const unsigned gen = old / nloc;
        if (old + 1u == (gen + 1u) * nloc) {
            __builtin_amdgcn_fence(__ATOMIC_RELEASE, "agent");
            asm volatile("s_waitcnt vmcnt(0)" ::: "memory");
            const unsigned og = xb_add(&bar[XB_TOP], 1u);
            const unsigned tg = og / nx;
            if (og + 1u == (tg + 1u) * nx) xb_add(&bar[XB_TOPGEN], 1u);
            else XB_SPIN(xb_ld(&bar[XB_TOPGEN]) == tg, bar);
            __builtin_amdgcn_fence(__ATOMIC_ACQUIRE, "agent");
            xb_add(&bar[XB_XGEN(b.x)], 1u);
            asm volatile("s_waitcnt vmcnt(0)" ::: "memory");
        } else {
            XB_SPIN(xb_ld(&bar[XB_XGEN(b.x)]) == gen, bar);
            __builtin_amdgcn_fence(__ATOMIC_ACQUIRE, "agent");
            asm volatile("s_waitcnt vmcnt(0)" ::: "memory");
        }
    }
    __syncthreads();
}

struct Args { const float* in[22]; float* out; unsigned char* ws; int ph_lo, ph_hi; };
typedef const __attribute__((address_space(4))) Args CArgs;
#define KIN(k) ((const float*)ka->in[k])
#define WSF(off) ((float*)(ka->ws + (off)))
#define WSB(off) ((bf16_t*)(ka->ws + (off)))
#define KA() ({ CArgs* _k = ka0; asm volatile("" : "+s"(_k)); _k; })
__device__ __forceinline__ int tid_fresh() { int t = threadIdx.x; asm volatile("" : "+v"(t)); return t; }
struct Frame {
    LAS unsigned char* lds; char* ldsg;
    int tid, lane, wave, G, wg;
};

__device__ __forceinline__ void transpose_item(const float* W, int ldw, int col0, int k0, bf16_t* WT, int ldt, int drow0, LAS float* scr, int lane) {
    f32x4 v[8];
#pragma unroll
    for (int i = 0; i < 8; ++i) v[i] = __builtin_nontemporal_load((const f32x4*)(W + (size_t)(k0 + 8 * i + (lane >> 3)) * ldw + col0 + 4 * (lane & 7)));
#pragma unroll
    for (int i = 0; i < 8; ++i) { LAS float* d = scr + (8 * i + (lane >> 3)) * 33 + 4 * (lane & 7); d[0] = v[i][0]; d[1] = v[i][1]; d[2] = v[i][2]; d[3] = v[i][3]; }
    LDS_WAIT(); asm volatile("" ::: "memory");
    const int c = lane & 7;
#pragma unroll
    for (int j = 0; j < 4; ++j) { const int n = (lane >> 3) + 8 * j; const LAS float* s = scr + (8 * c) * 33 + n;
        v4u o; o.x = pk2(s[0 * 33], s[1 * 33]); o.y = pk2(s[2 * 33], s[3 * 33]); o.z = pk2(s[4 * 33], s[5 * 33]); o.w = pk2(s[6 * 33], s[7 * 33]);
        __builtin_nontemporal_store(o, (v4u*)(WT + (size_t)(drow0 + n) * ldt + k0 + 8 * c)); }
    LDS_WAIT(); asm volatile("" ::: "memory");
}
__device__ __forceinline__ void p_convert(Frame& F, CArgs* ka, int l, int wv, int nwv, int it0 = 0, int it1 = 1 << 30) {
    const int tid = tid_fresh(), lane = tid & 63, wave = __builtin_amdgcn_readfirstlane(tid >> 6);
    LAS float* scr = (LAS float*)(F.lds + wave * 8704);
    constexpr int I_IN = 32 * 800, I_G = 32, I_BR = 3 * 2048, I_OUT = 2048, I_LRU = 2 * 2 * 16 * 8, I_LAYER = I_IN + I_G + I_BR + I_OUT + I_LRU;
    if (it1 > I_LAYER) it1 = I_LAYER;
    for (int it = it0 + wv; it < it1; it += nwv) {
        int r = it;
        if (r < I_IN) { const int kb = r / 800, nb = r - kb * 800, n0 = nb * 32, sc = n0 < 14336 ? n0 : n0 + 32;
            transpose_item(KIN(8) + (size_t)l * DM * NIN, NIN, sc, kb * 64, WSB(WS_WIN) + (size_t)l * NP * DM, DM, n0, scr, lane); continue; }
        r -= I_IN;
        if (r < I_G) { transpose_item(KIN(8) + (size_t)l * DM * NIN, NIN, 14336, r * 64, WSB(WS_WG) + (size_t)l * 32 * DM, DM, 0, scr, lane); continue; }
        r -= I_G;
        if (r < I_BR) { const int z = r / 2048, q = r - z * 2048, kb = q / 64, nb = q - kb * 64;
            transpose_item(KIN(20) + ((size_t)l * 3 + z) * DM * DM, DM, nb * 32, kb * 64, WSB(WS_WBR) + ((size_t)l * 3 + z) * DM * DM, DM, nb * 32, scr, lane); continue; }
        r -= I_BR;
        if (r < I_OUT) { const int kb = r / 64, nb = r - kb * 64;
            transpose_item(KIN(21) + (size_t)l * DM * DM, DM, nb * 32, kb * 64, WSB(WS_WOUT) + (size_t)l * DM * DM, DM, nb * 32, scr, lane); continue; }
        r -= I_OUT;
        { const int q = r & 7, mt = r >> 3, blk = mt & 15, gate = (mt >> 4) & 1, dr = mt >> 5, kb = q >> 2, nb = q & 3;
          const float* src = (gate ? KIN(13) : KIN(11)) + (((size_t)l * 2 + dr) * 16 + blk) * 16384;
          transpose_item(src, 128, nb * 32, kb * 64, WSB(WS_WLRU) + ((((size_t)l * 2 + dr) * 2 + gate) * 16 + blk) * 16384, 128, nb * 32, scr, lane); }
    }
}
__device__ __forceinline__ void p_prologue(Frame& F, CArgs* ka) {
    const int tid = tid_fresh(), lane = tid & 63, wave = __builtin_amdgcn_readfirstlane(tid >> 6); (void)lane; (void)wave;
    for (int i = F.wg * 512 + tid; i < SEQ * 64; i += F.G * 512) { const int t = i >> 6, j = i & 63;
        const float inv = 1.0f / powf(10000.0f, (float)(j & 31) * (1.0f / 32.0f)); const float pos = (float)(j < 32 ? (t >> 6) : (t & 63)); const float ang = pos * inv;
        { const float rev = ang * 0.15915494309189535f; WSF(WS_ROPE)[i] = __builtin_amdgcn_cosf(rev); WSF(WS_ROPE)[SEQ * 64 + i] = __builtin_amdgcn_sinf(rev); } }
    __syncthreads();
    LAS float* sc = (LAS float*)(F.lds + 73728);
    LAS float* red = (LAS float*)(F.lds + 73728 + 5 * 2048 * 4);
    for (int i = tid; i < 5 * DM; i += 512) { const int bi = i >> 11, k = i & 2047; const float v = bi < 4 ? KIN(1)[bi * DM + k] : KIN(3)[k]; sc[i] = v / (1.f + expf(-v)); }
    __syncthreads();
    for (int it = F.wg; it < DEPTH * 192; it += F.G) { const int l = it / 192, j0 = (it - l * 192) * 32, cj = tid & 31, ks = tid >> 5;
        float a0 = 0.f, a1 = 0.f, a2 = 0.f, a3 = 0.f, a4 = 0.f; const float* w = KIN(4) + (size_t)l * DM * 3 * DM + j0 + cj;
        for (int k = ks * 128; k < ks * 128 + 128; ++k) { const float wv = w[(size_t)k * (3 * DM)]; a0 += sc[k] * wv; a1 += sc[2048 + k] * wv; a2 += sc[4096 + k] * wv; a3 += sc[6144 + k] * wv; a4 += sc[8192 + k] * wv; }
        red[(ks * 5 + 0) * 32 + cj] = a0; red[(ks * 5 + 1) * 32 + cj] = a1; red[(ks * 5 + 2) * 32 + cj] = a2; red[(ks * 5 + 3) * 32 + cj] = a3; red[(ks * 5 + 4) * 32 + cj] = a4;
        __syncthreads();
        if (tid < 160) { const int bi = tid >> 5, c = tid & 31; float s = KIN(5)[(size_t)l * 3 * DM + j0 + c];
            for (int q = 0; q < 16; ++q) s += red[(q * 5 + bi) * 32 + c];
            WSF(WS_MOD)[((size_t)l * 5 + bi) * (3 * DM) + j0 + c] = s; }
        __syncthreads();
    }
}

__device__ __forceinline__ void p_norm(Frame& F, CArgs* ka, int l, bool dry = false) {
    const int tid = tid_fresh(), lane = tid & 63, wave = __builtin_amdgcn_readfirstlane(tid >> 6); (void)lane; (void)wave;
    const int gw = F.wg * NWAVES + wave, NGW = F.G * NWAVES;
    for (int r = gw; r < MROWS; r += NGW) {
        const int b = r / TPB, t = r - b * TPB; const bool isctx = t >= SEQ; const int bi = isctx ? 4 : b;
        if (l == DEPTH && isctx) continue;
        f32x4 v[8];
        if (l == 0) { const float* src = isctx ? KIN(2) + ((size_t)b * CTXL + (t - SEQ)) * DM : KIN(0) + ((size_t)b * SEQ + t) * DM;
#pragma unroll
            for (int j = 0; j < 8; ++j) v[j] = *(const f32x4*)(src + j * 256 + lane * 4);
        } else {
            const float* xr = WSF(WS_X) + (size_t)r * DM; f32x4 y[8]; float ss = 0.f;
#if Y_BF16
            const bf16_t* yr = WSB(WS_Y) + (size_t)r * DM;
#define CVY(w_) ((f32x4){blo((w_).x), bhi((w_).x), blo((w_).y), bhi((w_).y)})
            { v2u yw[8];
#pragma unroll
              for (int j = 0; j < 8; ++j) yw[j] = *(const v2u*)(yr + j * 256 + lane * 4);
#pragma unroll
              for (int j = 0; j < 8; ++j) y[j] = CVY(yw[j]); }
            if (SPLIT_CTX && isctx && F.G == 256) { v2u s1[8], s2[8];
#pragma unroll
              for (int j = 0; j < 8; ++j) { s1[j] = *(const v2u*)(yr + (size_t)MROWS * DM + j * 256 + lane * 4); s2[j] = *(const v2u*)(yr + 2 * (size_t)MROWS * DM + j * 256 + lane * 4); }
#pragma unroll
              for (int j = 0; j < 8; ++j) y[j] = y[j] + CVY(s1[j]) + CVY(s2[j]); }
#undef CVY
#else
            const float* yr = WSF(WS_Y) + (size_t)r * DM;
#pragma unroll
            for (int j = 0; j < 8; ++j) y[j] = *(const f32x4*)(yr + j * 256 + lane * 4);
            if (SPLIT_CTX && isctx && F.G == 256) {
#pragma unroll
              for (int j = 0; j < 8; ++j) y[j] = y[j] + *(const f32x4*)(yr + (size_t)MROWS * DM + j * 256 + lane * 4) + *(const f32x4*)(yr + 2 * (size_t)MROWS * DM + j * 256 + lane * 4); }
#endif
#pragma unroll
            for (int j = 0; j < 8; ++j) ss += y[j].x * y[j].x + y[j].y * y[j].y + y[j].z * y[j].z + y[j].w * y[j].w;
            const float rs = rsqrtf(wave_sum(ss, lane) * (1.f / DM) + EPS);
            const float* gate = WSF(WS_MOD) + ((size_t)(l - 1) * 5 + bi) * (3 * DM) + 2 * DM; const float* npost = KIN(7) + (size_t)(l - 1) * DM;
#pragma unroll
            for (int j = 0; j < 8; ++j) { const int c = j * 256 + lane * 4; const f32x4 g = *(const f32x4*)(gate + c), w = *(const f32x4*)(npost + c), xv = *(const f32x4*)(xr + c);
                v[j] = xv + g * (y[j] * rs * w); }
        }
        if (l == DEPTH) { float* o = (ka->out) + ((size_t)b * SEQ + t) * DM;
#pragma unroll
            for (int j = 0; j < 8; ++j) *(f32x4*)(o + j * 256 + lane * 4) = v[j];
            continue; }
        float* xo = (dry ? WSF(WS_ACC) : WSF(WS_X)) + (size_t)r * DM; float ss = 0.f;
#pragma unroll
        for (int j = 0; j < 8; ++j) { *(f32x4*)(xo + j * 256 + lane * 4) = v[j]; ss += v[j].x * v[j].x + v[j].y * v[j].y + v[j].z * v[j].z + v[j].w * v[j].w; }
        const float rs = rsqrtf(wave_sum(ss, lane) * (1.f / DM) + EPS);
        const float* shift = WSF(WS_MOD) + ((size_t)l * 5 + bi) * (3 * DM); const float* scale = shift + DM; const float* npre = KIN(6) + (size_t)l * DM;
        bf16_t* ho = (dry ? WSB(WS_G2) : WSB(WS_H)) + (size_t)r * DM;
#pragma unroll
        for (int j = 0; j < 8; ++j) { const int c = j * 256 + lane * 4; const f32x4 sh = *(const f32x4*)(shift + c), scv = *(const f32x4*)(scale + c), w = *(const f32x4*)(npre + c);
            const f32x4 h = v[j] * rs * w * (scv + 1.f) + sh; v2u o; o.x = pk2(h.x, h.y); o.y = pk2(h.z, h.w); *(v2u*)(ho + c) = o; }
    }
}

__device__ __forceinline__ void p_gates(Frame& F, CArgs* ka, int l, int wk0, int nwk) {
    const int tid = tid_fresh(), lane = tid & 63, wave = __builtin_amdgcn_readfirstlane(tid >> 6), c16 = lane & 15, q = lane >> 4;
    typedef short bf16x8 __attribute__((ext_vector_type(8)));
    LAS float* GL = (LAS float*)F.lds;
    const bf16_t* H = WSB(WS_H); const bf16_t* WG = WSB(WS_WG) + (size_t)l * 32 * DM; float* GT = WSF(WS_GT); f32x4* GSC = (f32x4*)WSF(WS_GSC);
    for (int task = wk0; task < NBATCH * 36; task += nwk) { const int b = task / 36, chunk = task - b * 36; const size_t row0 = (size_t)b * TPB + chunk * 64;
        __syncthreads();
        { const int rb = wave & 3, kh = wave >> 2; f32x4 a0 = {0.f, 0.f, 0.f, 0.f}, a1 = {0.f, 0.f, 0.f, 0.f};
          const bf16_t* hp = H + (row0 + rb * 16 + c16) * DM + kh * 1024 + q * 8; const bf16_t* w0 = WG + (size_t)c16 * DM + kh * 1024 + q * 8; const bf16_t* w1 = w0 + 16 * DM;
#pragma unroll 1
          for (int kb = 0; kb < 32; kb += 8) { bf16x8 av[8], b0[8], b1[8];
#pragma unroll
              for (int i = 0; i < 8; ++i) { av[i] = *(const bf16x8*)(hp + (kb + i) * 32); b0[i] = *(const bf16x8*)(w0 + (kb + i) * 32); b1[i] = *(const bf16x8*)(w1 + (kb + i) * 32); }
#pragma unroll
              for (int i = 0; i < 8; ++i) { a0 = __builtin_amdgcn_mfma_f32_16x16x32_bf16(av[i], b0[i], a0, 0, 0, 0); a1 = __builtin_amdgcn_mfma_f32_16x16x32_bf16(av[i], b1[i], a1, 0, 0, 0); } }
#pragma unroll
          for (int j = 0; j < 4; ++j) { GL[(kh * 64 + rb * 16 + q * 4 + j) * 33 + c16] = a0[j]; GL[(kh * 64 + rb * 16 + q * 4 + j) * 33 + 16 + c16] = a1[j]; } }
        __syncthreads();
#pragma unroll
        for (int i = 0; i < 4; ++i) { const int idx = tid + 512 * i, r = idx >> 5, c = idx & 31; float s = GL[r * 33 + c] + GL[(64 + r) * 33 + c] + KIN(16)[l * 32 + c];
            if ((c >> 3) & 1) s = fminf(s, 0.f) - __logf(1.f + __expf(-fabsf(s)));
            GL[r * 33 + c] = s; GT[(row0 + r) * 32 + c] = s; }
        __syncthreads();
#pragma unroll
        for (int pi = 0; pi < 2; ++pi) { const int p = wave * 2 + pi, dir = p >> 3, h = p & 7, rl = dir ? 63 - lane : lane;
            const float gi = GL[rl * 33 + dir * 16 + h]; float bc = GL[rl * 33 + dir * 16 + 8 + h];
#pragma unroll
            for (int o = 1; o < 64; o <<= 1) { const float v = lane_up(bc, o, lane); if (lane >= o) bc += v; }
            const float g = gi - bc; float pm = g;
#pragma unroll
            for (int o = 1; o < 64; o <<= 1) { const float v = lane_up(pm, o, lane); if (lane >= o) pm = fmaxf(pm, v); }
            GSC[((((size_t)b * 2 + dir) * 8 + h) * 36 + chunk) * 64 + lane] = (f32x4){bc, g, pm, 0.f}; }
    }
    __syncthreads();
}
__device__ __forceinline__ void p_knorm(Frame& F, CArgs* ka, int l, bool dry = false) {
    const int tid = tid_fresh(), lane = tid & 63, wave = __builtin_amdgcn_readfirstlane(tid >> 6);
    const int gw = F.wg * NWAVES + wave, NGW = F.G * NWAVES; const int sub = lane & 15;
    f32x4 kn0 = *(const f32x4*)(KIN(19) + l * 128 + sub * 8), kn1 = *(const f32x4*)(KIN(19) + l * 128 + sub * 8 + 4);
    for (int r = gw; r < MROWS; r += NGW) { const int b = r / TPB, t = r - b * TPB;
        bf16_t* kp = WSB(WS_P) + (size_t)r * NP + C_AK + lane * 8; const v4u raw = *(const v4u*)kp; float v[8];
#pragma unroll
        for (int e = 0; e < 4; ++e) { v[2 * e] = blo(raw[e]); v[2 * e + 1] = bhi(raw[e]); }
        float ss = 0.f;
#pragma unroll
        for (int e = 0; e < 8; ++e) ss += v[e] * v[e];
        ss += lane_xor(ss, 1, lane); ss += lane_xor(ss, 2, lane); ss += lane_xor(ss, 4, lane); ss += lane_xor(ss, 8, lane);
        const float rs = rsqrtf(ss * (1.f / 128.f) + EPS);
#pragma unroll
        for (int e = 0; e < 8; ++e) v[e] *= rs * (e < 4 ? kn0[e & 3] : kn1[e & 3]);
        if (t < SEQ) { const int i0 = (sub & 7) * 8; const float* cp = WSF(WS_ROPE) + (size_t)t * 64 + i0; const float* sp = cp + SEQ * 64;
            const f32x4 c0 = *(const f32x4*)cp, c1 = *(const f32x4*)(cp + 4), s0 = *(const f32x4*)sp, s1 = *(const f32x4*)(sp + 4); const bool upper = (sub & 8) != 0;
#pragma unroll
            for (int e = 0; e < 8; ++e) { const float o = lane_xor(v[e], 8, lane), c = e < 4 ? c0[e & 3] : c1[e & 3], sn = e < 4 ? s0[e & 3] : s1[e & 3];
                v[e] = upper ? v[e] * c + o * sn : v[e] * c - o * sn; } }
        v4u ov; ov.x = pk2(v[0], v[1]); ov.y = pk2(v[2], v[3]); ov.z = pk2(v[4], v[5]); ov.w = pk2(v[6], v[7]);
        if (dry) *(v4u*)(WSB(WS_ACC) + (size_t)r * 512 + lane * 8) = ov; else *(v4u*)kp = ov; }
}

__device__ __forceinline__ void p_lru_gates_naive(Frame& F, CArgs* ka, int l) {
    const int tid = tid_fresh(); (void)tid;
    LAS float* xs = (LAS float*)F.lds;
    for (int it = F.wg; it < (MROWS / 16) * 16; it += F.G) { const int rt = it >> 4, blk = it & 15;
        __syncthreads();
#pragma unroll
        for (int j = 0; j < 4; ++j) { const int idx = tid + 512 * j, rr = idx >> 7, c = idx & 127, r = rt * 16 + rr, b = r / TPB, t = r - b * TPB, ch = blk * 128 + c;
            const int lo = t < SEQ ? 0 : SEQ, hi = t < SEQ ? SEQ : TPB; float a = KIN(10)[l * DM + ch];
#pragma unroll
            for (int k = 0; k < 4; ++k) { const int tt = t + k - 2; if (tt >= lo && tt < hi) a += KIN(9)[((size_t)l * 4 + k) * DM + ch] * bf2f(WSB(WS_P)[((size_t)b * TPB + tt) * NP + C_LX + ch]); }
            xs[rr * 128 + c] = a; }
        __syncthreads();
        const int co = tid & 127, r0 = tid >> 7, ch = blk * 128 + co;
#pragma unroll 1
        for (int dr = 0; dr < 2; ++dr) {
            const float* wr = KIN(11) + (((size_t)l * 2 + dr) * 16 + blk) * 16384 + co; const float* wi = KIN(13) + (((size_t)l * 2 + dr) * 16 + blk) * 16384 + co;
            float ar[4], ai[4];
#pragma unroll
            for (int j = 0; j < 4; ++j) { ar[j] = KIN(12)[((size_t)l * 2 + dr) * DM + ch]; ai[j] = KIN(14)[((size_t)l * 2 + dr) * DM + ch]; }
            for (int c = 0; c < 128; ++c) { const float w0 = wr[c * 128], w1 = wi[c * 128];
#pragma unroll
                for (int j = 0; j < 4; ++j) { const float xv = xs[(r0 + 4 * j) * 128 + c]; ar[j] += xv * w0; ai[j] += xv * w1; } }
            const float lam = KIN(15)[((size_t)l * 2 + dr) * DM + ch], sp = log1pf(expf(-lam));
#pragma unroll
            for (int j = 0; j < 4; ++j) { const int r = rt * 16 + r0 + 4 * j; const float rg = 1.f / (1.f + expf(-ar[j])), ig = 1.f / (1.f + expf(-ai[j]));
                const float log_a = -8.f * rg * sp, a = expf(log_a), mult = sqrtf(-expm1f(2.f * log_a));
                WSF(WS_LA)[((size_t)dr * MROWS + r) * DM + ch] = a; WSF(WS_LB)[((size_t)dr * MROWS + r) * DM + ch] = mult * ig * xs[(r0 + 4 * j) * 128 + co]; }
        }
    }
    __syncthreads();
}

__device__ __forceinline__ void p_attention(Frame& F, CArgs* ka, int l, bool need_ctx) {
    using att::bf16;
    const int n_lat = NBATCH * 16 * 8, n_all = n_lat + (need_ctx ? NBATCH * 16 : 0);
    for (int u = F.wg; u < n_all; u += F.G) {
        int b, h, q0, k0, seq; const float *cs = nullptr, *sn = nullptr;
        if (u < n_lat) { const int qb = u & 7; h = (u >> 3) & 15; b = u >> 7; q0 = qb * 256; k0 = 0; seq = TPB; cs = WSF(WS_ROPE) + (size_t)q0 * 64; sn = WSF(WS_ROPE) + (size_t)SEQ * 64 + (size_t)q0 * 64; }
        else { const int v = u - n_lat; h = v & 15; b = v >> 4; q0 = SEQ; k0 = SEQ; seq = CTXL; }
        const size_t rq = (size_t)b * TPB + q0, rk = (size_t)b * TPB + k0; const int kvh = h >> 2;
        att::attn_unit((const bf16*)(WSB(WS_P) + rq * NP + C_AQ + h * 128), (const bf16*)(WSB(WS_P) + rk * NP + C_AK + kvh * 128), (const bf16*)(WSB(WS_P) + rk * NP + C_AV + kvh * 128),
                       (const bf16*)(WSB(WS_P) + rq * NP + C_AZ + h * 128), (bf16*)(WSB(WS_YB) + ((size_t)2 * MROWS + rq) * DM + h * 128), seq, F.ldsg, KIN(18) + l * 128, cs, sn);
    }
}
__device__ __forceinline__ int seq_row(int s, int dir) { return s < CTXL ? SEQ + (dir ? CTXL - 1 - s : s) : (dir ? SEQ - 1 - (s - CTXL) : s - CTXL); }
__device__ __forceinline__ void p_mlstm_naive(Frame& F, CArgs* ka, int l) {
    const int tid = tid_fresh(), lane = tid & 63, wave = __builtin_amdgcn_readfirstlane(tid >> 6); (void)lane; (void)wave;
    LAS float* sq = (LAS float*)F.lds; LAS float* sk = sq + 256; LAS float* rn = sk + 256; LAS float* rd = rn + 512;
    const int e = tid & 63, dg = tid >> 6;
    for (int u = F.wg; u < 256; u += F.G) { const int es = u & 3, dir = (u >> 2) & 1, h = (u >> 3) & 7, b = u >> 6;
        float C[32], n[32];
#pragma unroll
        for (int i = 0; i < 32; ++i) { C[i] = 0.f; n[i] = 0.f; }
        float m = -1e30f;
        const int lcol = tid < 64 ? C_MQ + h * 256 + tid * 4 : C_MK + h * 256 + (tid - 64) * 4, vcol = C_MV + h * 256 + es * 64 + e;
        v2u pqk = {0u, 0u}; bf16_t pv; float gi, gf;
        { const size_t r = (size_t)b * TPB + seq_row(0, dir); if (tid < 128) pqk = *(const v2u*)(WSB(WS_P) + r * NP + lcol); pv = WSB(WS_P)[r * NP + vcol]; gi = WSF(WS_GT)[r * 32 + dir * 16 + h]; gf = WSF(WS_GT)[r * 32 + dir * 16 + 8 + h]; }
        __syncthreads();
        for (int s = 0; s < TPB; ++s) {
            const size_t r = (size_t)b * TPB + seq_row(s, dir);
            if (tid < 128) { LAS float* d = (tid < 64 ? sq : sk) + (tid & 63) * 4; d[0] = blo(pqk.x); d[1] = bhi(pqk.x); d[2] = blo(pqk.y); d[3] = bhi(pqk.y); }
            const float vv = bf2f(pv), iv = gi, lf = gf;
            __syncthreads();
            if (s + 1 < TPB) { const size_t r2 = (size_t)b * TPB + seq_row(s + 1, dir); if (tid < 128) pqk = *(const v2u*)(WSB(WS_P) + r2 * NP + lcol); pv = WSB(WS_P)[r2 * NP + vcol]; gi = WSF(WS_GT)[r2 * 32 + dir * 16 + h]; gf = WSF(WS_GT)[r2 * 32 + dir * 16 + 8 + h]; }
            const float mnew = fmaxf(lf + m, iv), fw = expf(lf + m - mnew), iw = expf(iv - mnew); m = mnew;
            float pn = 0.f, pd = 0.f;
#pragma unroll
            for (int dd = 0; dd < 32; ++dd) { const float kd = sk[dg * 32 + dd], qd = sq[dg * 32 + dd]; C[dd] = fw * C[dd] + iw * kd * vv; n[dd] = fw * n[dd] + iw * kd; pn += qd * C[dd]; pd += qd * n[dd]; }
            rn[dg * 64 + e] = pn; rd[dg * 64 + e] = pd;
            __syncthreads();
            if (dg == 0) { float num = 0.f, den = 0.f;
#pragma unroll
                for (int g = 0; g < 8; ++g) { num += rn[g * 64 + e]; den += rd[g * 64 + e]; }
                WSB(WS_MH)[((size_t)dir * MROWS + r) * DM + h * 256 + es * 64 + e] = (bf16_t)f2bf(num / fmaxf(fabsf(den), expf(-m))); }
        }
        __syncthreads();
    }
}
__device__ __forceinline__ void p_lru_scan_naive(Frame& F, CArgs* ka) {
    const int tid = tid_fresh(), lane = tid & 63, wave = __builtin_amdgcn_readfirstlane(tid >> 6); (void)lane; (void)wave;
    if (wave != 0) return;
    for (int cw = F.wg; cw < 256; cw += F.G) { const int combo = cw * 64 + lane, b = combo >> 12, dir = (combo >> 11) & 1, ch = combo & 2047;
        const float* A = WSF(WS_LA) + (size_t)dir * MROWS * DM + ch; const float* Bx = WSF(WS_LB) + (size_t)dir * MROWS * DM + ch; float* Ho = WSF(WS_HL) + (size_t)dir * MROWS * DM + ch; float h = 0.f;
#pragma unroll 8
        for (int s = 0; s < TPB; ++s) { const size_t r = (size_t)b * TPB + seq_row(s, dir); h = A[r * DM] * h + Bx[r * DM]; Ho[r * DM] = h; }
    }
}

__device__ __forceinline__ void p_mlout(Frame& F, CArgs* ka, int l, bool need_ctx) {
    const int tid = tid_fresh(), lane = tid & 63, wave = __builtin_amdgcn_readfirstlane(tid >> 6); (void)lane; (void)wave;
    const int gw = F.wg * NWAVES + wave, NGW = F.G * NWAVES, nrow = need_ctx ? MROWS : NBATCH * SEQ;
    for (int ri = gw; ri < nrow; ri += NGW) { const int r = need_ctx ? ri : (ri >> 11) * TPB + (ri & 2047);
        const bf16_t* pr = WSB(WS_P) + (size_t)r * NP;
        v2u ma[8], mb[8], ow[8], zw[8]; f32x4 g[8];
#pragma unroll
        for (int h = 0; h < 8; ++h) { const int col = h * 256 + lane * 4;
            ma[h] = *(const v2u*)(WSB(WS_MH) + (size_t)r * DM + col); mb[h] = *(const v2u*)(WSB(WS_MH) + ((size_t)MROWS + r) * DM + col);
            ow[h] = *(const v2u*)(pr + C_MO + col); zw[h] = *(const v2u*)(pr + C_MZ + col); g[h] = *(const f32x4*)(KIN(17) + (size_t)l * DM + col); }
#pragma unroll
        for (int h = 0; h < 8; ++h) { const int col = h * 256 + lane * 4;
            const f32x4 a = {blo(ma[h].x), bhi(ma[h].x), blo(ma[h].y), bhi(ma[h].y)}, bb = {blo(mb[h].x), bhi(mb[h].x), blo(mb[h].y), bhi(mb[h].y)};
            f32x4 v = a + bb; v.x *= blo(ow[h].x); v.y *= bhi(ow[h].x); v.z *= blo(ow[h].y); v.w *= bhi(ow[h].y);
            const float rs = rsqrtf(wave_sum(v.x * v.x + v.y * v.y + v.z * v.z + v.w * v.w, lane) * (1.f / 256.f) + EPS);
            v2u o; o.x = pk2(v.x * rs * g[h].x * blo(zw[h].x), v.y * rs * g[h].y * bhi(zw[h].x)); o.y = pk2(v.z * rs * g[h].z * blo(zw[h].y), v.w * rs * g[h].w * bhi(zw[h].y));
            *(v2u*)(WSB(WS_YB) + ((size_t)MROWS + r) * DM + col) = o; }
    }
}

__device__ __forceinline__ void p_lru_combine_naive(Frame& F, CArgs* ka) {
    const int tid = tid_fresh(), lane = tid & 63, wave = __builtin_amdgcn_readfirstlane(tid >> 6);
    const int gw = F.wg * NWAVES + wave, NGW = F.G * NWAVES;
    for (int r = gw; r < MROWS; r += NGW) {
        const bf16_t* pr = WSB(WS_P) + (size_t)r * NP;
#pragma unroll 2
        for (int j = 0; j < 8; ++j) { const int col = j * 256 + lane * 4;
            const f32x4 a = *(const f32x4*)(WSF(WS_HL) + (size_t)r * DM + col), bb = *(const f32x4*)(WSF(WS_HL) + ((size_t)MROWS + r) * DM + col); const v2u zw = *(const v2u*)(pr + C_LZ + col);
            const f32x4 v = a + bb; v2u o; o.x = pk2(v.x * blo(zw.x), v.y * bhi(zw.x)); o.y = pk2(v.z * blo(zw.y), v.w * bhi(zw.y));
            *(v2u*)(WSB(WS_YB) + (size_t)r * DM + col) = o; }
    }
}
#ifndef USE_NAIVE_ML
#define USE_NAIVE_ML 0
#endif
#ifndef USE_NAIVE_LRU
#define USE_NAIVE_LRU 0
#endif

namespace ml {
typedef short bf16x8 __attribute__((ext_vector_type(8)));
constexpr int KS_OFF = 0, KS_PITCH = 528;
constexpr int KT_OFF = KS_OFF + 64 * KS_PITCH, KT_PITCH = 144;
constexpr int VT_OFF = KT_OFF + 256 * KT_PITCH, VT_PITCH = 144;
constexpr int ST_OFF = VT_OFF + 80 * VT_PITCH, ST_PITCH = 144;
constexpr int CT_OFF = ST_OFF + 64 * ST_PITCH, CT_PITCH = 528;
constexpr int TAB_OFF = CT_OFF + 80 * CT_PITCH;
constexpr int END_OFF = TAB_OFF + 1024;
static_assert(END_OFF <= MISC_OFF, "mLSTM LDS map");
#define ML_MFMA(a, b, c) __builtin_amdgcn_mfma_f32_16x16x32_bf16((a), (b), (c), 0, 0, 0)
__device__ __forceinline__ int chunk_of(int k, int dir) { return k < 4 ? (dir ? 35 - k : 32 + k) : (dir ? 31 - (k - 4) : k - 4); }

__device__ __forceinline__ void mlstm_unit(Frame& F, CArgs* ka, int u, bool need_ctx) {
    const int tid = tid_fresh(), lane = tid & 63, w = __builtin_amdgcn_readfirstlane(tid >> 6), c16 = lane & 15, q = lane >> 4;
    const int es = u & 3, dir = (u >> 2) & 1, h = (u >> 3) & 7, b = u >> 6;
    LAS unsigned char* L = F.lds;
    const bf16_t* P = WSB(WS_P); bf16_t* MH = WSB(WS_MH) + (size_t)dir * MROWS * DM;
    const f32x4* GSC = (const f32x4*)WSF(WS_GSC) + (((size_t)b * 2 + dir) * 8 + h) * 36 * 64;
    LAS float* TABg = (LAS float*)(L + TAB_OFF); LAS float* TABmm = TABg + 64; LAS float* TABbc = TABg + 128;
    __syncthreads();
    { unsigned z0 = 0u; asm volatile("" : "+v"(z0)); const v4u zz = {z0, z0, z0, z0};
      for (int i = tid; i < 80 * CT_PITCH / 16; i += 512) *(LAS v4u*)(L + CT_OFF + i * 16) = zz; }
    for (int i = tid; i < 16 * 64; i += 512) { const int e = 64 + (i >> 6), s = i & 63; *(LAS bf16_t*)(L + VT_OFF + e * VT_PITCH + s * 2) = (bf16_t)(e == 64 ? 0x3F80 : 0); }
    f32x4 C[2][5];
#pragma unroll
    for (int a = 0; a < 2; ++a)
#pragma unroll
        for (int e = 0; e < 5; ++e) C[a][e] = (f32x4){0.f, 0.f, 0.f, 0.f};
    float m = -1e30f;
    const int tn = w & 3, wh = w >> 2;
    v4u kraw[4], vraw; bf16x8 Qf[8]; float gsc0, gsc1, gsc2;
#define ML_ROW(base, j) ((size_t)(base) + (dir ? 63 - (j) : (j)))
#define ML_LOAD_KVG(k) do { const int _c = chunk_of((k), dir), _base = b * TPB + _c * 64; const bf16_t* _rp = P + ML_ROW(_base, lane) * NP; \
        _Pragma("unroll") for (int i = 0; i < 4; ++i) kraw[i] = *(const v4u*)(_rp + C_MK + h * 256 + (w * 4 + i) * 8); \
        vraw = *(const v4u*)(_rp + C_MV + h * 256 + es * 64 + w * 8); { const float* _gp = (const float*)(GSC + _c * 64 + lane); gsc0 = _gp[0]; gsc1 = _gp[1]; gsc2 = _gp[2]; } } while (0)
#define ML_LOAD_Q(k) do { const int _base = b * TPB + chunk_of((k), dir) * 64; const bf16_t* _qp = P + ML_ROW(_base, tn * 16 + c16) * NP + C_MQ + h * 256 + q * 8; \
        _Pragma("unroll") for (int ks = 0; ks < 8; ++ks) Qf[ks] = *(const bf16x8*)(_qp + ks * 32); } while (0)
    ML_LOAD_KVG(0); ML_LOAD_Q(0);
    float bL = 0.f, mm63 = 0.f;
#pragma unroll 1
    for (int k = 0; k < 36; ++k) {
        const int base = b * TPB + chunk_of(k, dir) * 64; const bool do_out = need_ctx || k >= 4;
        if (k > 0) {
#pragma unroll
            for (int di = 0; di < 2; ++di)
#pragma unroll
                for (int en = 0; en < 5; ++en) { const f32x4 c = C[di][en]; v2u o; o.x = pk2(c[0], c[1]); o.y = pk2(c[2], c[3]);
                    *(LAS v2u*)(L + CT_OFF + (en * 16 + c16) * CT_PITCH + ((2 * w + di) * 16 + q * 4) * 2) = o; }
            m = bL + mm63; }
        const float bc = gsc0, g = gsc1, mm = fmaxf(gsc2, m), wk = __expf(g - lane_get(mm, 63));
        bL = lane_get(bc, 63); mm63 = lane_get(mm, 63);
        if (w == 0) { TABg[lane] = g; TABmm[lane] = mm; TABbc[lane] = bc; }
#pragma unroll
        for (int i = 0; i < 4; ++i) { *(LAS v4u*)(L + KS_OFF + lane * KS_PITCH + (w * 4 + i) * 16) = kraw[i];
#pragma unroll
            for (int e = 0; e < 4; ++e) { const unsigned x = kraw[i][e]; const unsigned pk = pk2(blo(x) * wk, bhi(x) * wk);
                *(LAS bf16_t*)(L + KT_OFF + ((w * 4 + i) * 8 + 2 * e) * KT_PITCH + lane * 2) = (bf16_t)(pk & 0xffffu); *(LAS bf16_t*)(L + KT_OFF + ((w * 4 + i) * 8 + 2 * e + 1) * KT_PITCH + lane * 2) = (bf16_t)(pk >> 16); } }
#pragma unroll
        for (int e = 0; e < 4; ++e) { const unsigned x = vraw[e];
            *(LAS bf16_t*)(L + VT_OFF + (w * 8 + 2 * e) * VT_PITCH + lane * 2) = (bf16_t)(x & 0xffffu); *(LAS bf16_t*)(L + VT_OFF + (w * 8 + 2 * e + 1) * VT_PITCH + lane * 2) = (bf16_t)(x >> 16); }
        __syncthreads();
        const int t = tn * 16 + c16; const int kn = k + 1 < 36 ? k + 1 : 35;
        if (do_out) {
            const float mmt = TABmm[t];
#pragma unroll
            for (int si = 0; si < 2; ++si) { const int sm = wh * 2 + si; v2u o = {0u, 0u};
                if (sm <= tn) { f32x4 acc = {0.f, 0.f, 0.f, 0.f};
#pragma unroll
                    for (int ks = 0; ks < 8; ++ks) { const bf16x8 a = *(const LAS bf16x8*)(L + KS_OFF + (sm * 16 + c16) * KS_PITCH + (ks * 32 + q * 8) * 2); acc = ML_MFMA(a, Qf[ks], acc); }
                    float v[4];
#pragma unroll
                    for (int j = 0; j < 4; ++j) { const int s = sm * 16 + q * 4 + j; v[j] = s <= t ? acc[j] * __expf(TABg[s] - mmt) : 0.f; }
                    o.x = pk2(v[0], v[1]); o.y = pk2(v[2], v[3]); }
                *(LAS v2u*)(L + ST_OFF + t * ST_PITCH + (sm * 16 + q * 4) * 2) = o; }
        }
        ML_LOAD_KVG(kn);
        __syncthreads();
        f32x4 num0 = {0.f, 0.f, 0.f, 0.f}, num1 = {0.f, 0.f, 0.f, 0.f}; float den = 1.f;
        if (do_out) {
            const float wi = __expf(m - TABmm[t]);
            bf16x8 sb[2];
#pragma unroll
            for (int ks = 0; ks < 2; ++ks) sb[ks] = *(const LAS bf16x8*)(L + ST_OFF + t * ST_PITCH + (ks * 32 + q * 8) * 2);
#pragma unroll
            for (int ei = 0; ei < 3; ++ei) { const int em = ei < 2 ? wh * 2 + ei : 4;
                f32x4 a1 = {0.f, 0.f, 0.f, 0.f}, a2 = {0.f, 0.f, 0.f, 0.f};
#pragma unroll
                for (int ks = 0; ks < 2; ++ks) { const bf16x8 a = *(const LAS bf16x8*)(L + VT_OFF + (em * 16 + c16) * VT_PITCH + (ks * 32 + q * 8) * 2); a1 = ML_MFMA(a, sb[ks], a1); }
#pragma unroll
                for (int ks = 0; ks < 8; ++ks) { const bf16x8 a = *(const LAS bf16x8*)(L + CT_OFF + (em * 16 + c16) * CT_PITCH + (ks * 32 + q * 8) * 2); a2 = ML_MFMA(a, Qf[ks], a2); }
                const f32x4 nv = a1 + a2 * wi;
                if (ei == 0) num0 = nv; else if (ei == 1) num1 = nv;
                else den = fmaxf(fabsf(lane_get(nv[0], c16)), __expf(-(TABbc[t] + TABmm[t]))); }
        }
        ML_LOAD_Q(kn);
        if (do_out) { const float rd = 1.f / den; bf16_t* op = MH + ML_ROW(base, t) * DM + h * 256 + es * 64 + q * 4; const f32x4 o0 = num0 * rd, o1 = num1 * rd;
            v2u w0, w1; w0.x = pk2(o0[0], o0[1]); w0.y = pk2(o0[2], o0[3]); w1.x = pk2(o1[0], o1[1]); w1.y = pk2(o1[2], o1[3]);
            *(v2u*)(op + (wh * 2) * 16) = w0; *(v2u*)(op + (wh * 2 + 1) * 16) = w1; }
        { const float decay = __expf(m - mm63);
          bf16x8 vb[5][2];
#pragma unroll
          for (int en = 0; en < 5; ++en)
#pragma unroll
              for (int ks = 0; ks < 2; ++ks) vb[en][ks] = *(const LAS bf16x8*)(L + VT_OFF + (en * 16 + c16) * VT_PITCH + (ks * 32 + q * 8) * 2);
#pragma unroll
          for (int di = 0; di < 2; ++di) {
            bf16x8 a[2];
#pragma unroll
            for (int ks = 0; ks < 2; ++ks) a[ks] = *(const LAS bf16x8*)(L + KT_OFF + ((2 * w + di) * 16 + c16) * KT_PITCH + (ks * 32 + q * 8) * 2);
#pragma unroll
            for (int en = 0; en < 5; ++en) { f32x4 c = C[di][en] * decay;
#pragma unroll
                for (int ks = 0; ks < 2; ++ks) c = ML_MFMA(a[ks], vb[en][ks], c);
                C[di][en] = c; } } }
        __syncthreads();
    }
#undef ML_ROW
#undef ML_LOAD_KVG
#undef ML_LOAD_Q
}
constexpr int ST2_OFF = TAB_OFF + 1024, TAB2_OFF = ST2_OFF + 64 * ST_PITCH, END2_OFF = TAB2_OFF + 1024;
static_assert(END2_OFF <= MISC_OFF, "mLSTM LDS map (pipelined)");
template <int VAR> __device__ __forceinline__ void mlstm_unit_pipe(Frame& F, CArgs* ka, int u, bool need_ctx) {
    const int tid = tid_fresh(), lane = tid & 63, w = __builtin_amdgcn_readfirstlane(tid >> 6), c16 = lane & 15, q = lane >> 4;
    const int es = u & 3, dir = (u >> 2) & 1, h = (u >> 3) & 7, b = u >> 6;
    LAS unsigned char* L = F.lds;
    const bf16_t* X8 = WSB(WS_X8); constexpr size_t X8_SEC = (size_t)MROWS * DM; bf16_t* MH = (VAR ? WSB(WS_ACC) : WSB(WS_MH)) + (size_t)dir * MROWS * DM;
    const f32x4* GSC = (const f32x4*)WSF(WS_GSC) + (((size_t)b * 2 + dir) * 8 + h) * 36 * 64;
    __syncthreads();
    { unsigned z0 = 0u; asm volatile("" : "+v"(z0)); const v4u zz = {z0, z0, z0, z0};
      for (int i = tid; i < 80 * CT_PITCH / 16; i += 512) *(LAS v4u*)(L + CT_OFF + i * 16) = zz; }
    for (int i = tid; i < 16 * 64; i += 512) { const int e = 64 + (i >> 6), s = i & 63; *(LAS bf16_t*)(L + VT_OFF + e * VT_PITCH + s * 2) = (bf16_t)(e == 64 ? 0x3F80 : 0); }
    f32x4 C[2][5];
#pragma unroll
    for (int a = 0; a < 2; ++a)
#pragma unroll
        for (int e = 0; e < 5; ++e) C[a][e] = (f32x4){0.f, 0.f, 0.f, 0.f};
    const int tn = w & 3, wh = w >> 2, t = tn * 16 + c16;
    const int kl = (dir ? 63 - lane : lane) * 8, ql = q * 512 + (dir ? 63 - t : t) * 8;
    v4u kc[4], kn[4], vc; bf16x8 Qc[8], Qn[8]; float gc0, gc1, gc2, gn0, gn1, gn2;
#define MLP_ROW(base, j) ((size_t)(base) + (dir ? 63 - (j) : (j)))
#define MLP_TAB(par) ((LAS float*)(L + ((par) ? TAB2_OFF : TAB_OFF)))
#define MLP_ST(par) ((par) ? ST2_OFF : ST_OFF)
#define MLP_XB(sec, c_) (X8 + (size_t)(sec) * X8_SEC + ((size_t)(b * 8 + h) * 36 + (c_)) * (32 * 64 * 8))
#define MLP_LOADK(dst, k) do { const bf16_t* _xb = MLP_XB(1, chunk_of((k), dir)) + w * 4 * 512; \
        _Pragma("unroll") for (int i = 0; i < 4; ++i) dst[i] = *(const v4u*)(_xb + i * 512 + kl); } while (0)
#define MLP_LOADV(dst, k) do { dst = *(const v4u*)(MLP_XB(2, chunk_of((k), dir)) + (es * 8 + w) * 512 + kl); } while (0)
#define MLP_LOADG(d0, d1, d2, k) do { const float* _gp = (const float*)(GSC + chunk_of((k), dir) * 64 + lane); d0 = _gp[0]; d1 = _gp[1]; d2 = _gp[2]; } while (0)
#define MLP_LOADQ(dst, k) do { const bf16_t* _xb = MLP_XB(0, chunk_of((k), dir)); \
        _Pragma("unroll") for (int ks = 0; ks < 8; ++ks) dst[ks] = *(const bf16x8*)(_xb + ks * 2048 + ql); } while (0)
#define MLP_STILE(QQ, TB, SO) do { const float _mmt = (TB)[64 + t]; \
        _Pragma("unroll") for (int si = 0; si < 2; ++si) { const int sm = wh * 2 + si; v2u o = {0u, 0u}; \
            if (sm <= tn) { f32x4 acc = {0.f, 0.f, 0.f, 0.f}; \
                bf16x8 ka_[8]; \
                _Pragma("unroll") for (int ks = 0; ks < 8; ++ks) ka_[ks] = *(const LAS bf16x8*)(L + KS_OFF + (sm * 16 + c16) * KS_PITCH + (ks * 32 + q * 8) * 2); \
                __builtin_amdgcn_sched_barrier(0); \
                _Pragma("unroll") for (int ks = 0; ks < 8; ++ks) acc = ML_MFMA(ka_[ks], QQ[ks], acc); \
                float v[4]; \
                _Pragma("unroll") for (int j = 0; j < 4; ++j) { const int s = sm * 16 + q * 4 + j; v[j] = s <= t ? acc[j] * __expf((TB)[s] - _mmt) : 0.f; } \
                o.x = pk2(v[0], v[1]); o.y = pk2(v[2], v[3]); } \
            *(LAS v2u*)(L + (SO) + t * ST_PITCH + (sm * 16 + q * 4) * 2) = o; } } while (0)
    MLP_LOADK(kc, 0); MLP_LOADV(vc, 0); MLP_LOADG(gc0, gc1, gc2, 0); MLP_LOADQ(Qc, 0); MLP_LOADK(kn, 1); MLP_LOADG(gn0, gn1, gn2, 1); MLP_LOADQ(Qn, 1);
    float m = -1e30f;
    {
      const float mm = fmaxf(gc2, m); LAS float* TB = MLP_TAB(0);
      if (w == 0) { TB[lane] = gc1; TB[64 + lane] = mm; TB[128 + lane] = gc0; }
#pragma unroll
      for (int i = 0; i < 4; ++i) *(LAS v4u*)(L + KS_OFF + lane * KS_PITCH + (w * 4 + i) * 16) = kc[i];
      __syncthreads();
      if (need_ctx) MLP_STILE(Qc, TB, MLP_ST(0));
      __syncthreads(); }
#pragma unroll 1
    for (int k = 0; k < 36; ++k) {
        const int par = k & 1, k1 = k + 1 < 36 ? k + 1 : 35, k2 = k + 2 < 36 ? k + 2 : 35;
        const bool do_out = need_ctx || k >= 4, s_next = (k + 1 < 36) && (need_ctx || k + 1 >= 4);
        const size_t base = (size_t)b * TPB + chunk_of(k, dir) * 64;
        if (k > 0 && VAR != 2) {
#pragma unroll
            for (int di = 0; di < 2; ++di)
#pragma unroll
                for (int en = 0; en < 5; ++en) { const f32x4 c = C[di][en]; v2u o; o.x = pk2(c[0], c[1]); o.y = pk2(c[2], c[3]);
                    *(LAS v2u*)(L + CT_OFF + (en * 16 + c16) * CT_PITCH + ((2 * w + di) * 16 + q * 4) * 2) = o; } }
        const float mm = fmaxf(gc2, m), bL = lane_get(gc0, 63), mm63 = lane_get(mm, 63), wk = __expf(gc1 - mm63), m_next = bL + mm63;
#pragma unroll
        for (int i = 0; i < (VAR == 2 ? 1 : 4); ++i) {
#pragma unroll
            for (int e = 0; e < (VAR == 2 ? 1 : 4); ++e) { const unsigned x = kc[i][e]; const unsigned pk = pk2(blo(x) * wk, bhi(x) * wk);
                *(LAS bf16_t*)(L + KT_OFF + ((w * 4 + i) * 8 + 2 * e) * KT_PITCH + lane * 2) = (bf16_t)(pk & 0xffffu); *(LAS bf16_t*)(L + KT_OFF + ((w * 4 + i) * 8 + 2 * e + 1) * KT_PITCH + lane * 2) = (bf16_t)(pk >> 16); } }
#pragma unroll
        for (int e = 0; e < 4; ++e) { const unsigned x = vc[e];
            *(LAS bf16_t*)(L + VT_OFF + (w * 8 + 2 * e) * VT_PITCH + lane * 2) = (bf16_t)(x & 0xffffu); *(LAS bf16_t*)(L + VT_OFF + (w * 8 + 2 * e + 1) * VT_PITCH + lane * 2) = (bf16_t)(x >> 16); }
        { const float mmn = fmaxf(gn2, m_next); LAS float* TBn = MLP_TAB(par ^ 1);
          if (w == 0) { TBn[lane] = gn1; TBn[64 + lane] = mmn; TBn[128 + lane] = gn0; }
#pragma unroll
          for (int i = 0; i < (VAR == 2 ? 1 : 4); ++i) *(LAS v4u*)(L + KS_OFF + lane * KS_PITCH + (w * 4 + i) * 16) = kn[i]; }
        __syncthreads();
#pragma unroll
        for (int i = 0; i < 4; ++i) kc[i] = kn[i];
        gc0 = gn0; gc1 = gn1; gc2 = gn2;
        if (VAR != 3) { MLP_LOADK(kn, k2); MLP_LOADV(vc, k1); MLP_LOADG(gn0, gn1, gn2, k2); }
        const LAS float* TB = MLP_TAB(par);
        if (do_out && VAR != 1) {
            const float wi = __expf(m - TB[64 + t]); f32x4 num0 = {0.f, 0.f, 0.f, 0.f}, num1 = {0.f, 0.f, 0.f, 0.f}; float den = 1.f;
            bf16x8 sb[2];
#pragma unroll
            for (int ks = 0; ks < 2; ++ks) sb[ks] = *(const LAS bf16x8*)(L + MLP_ST(par) + t * ST_PITCH + (ks * 32 + q * 8) * 2);
#pragma unroll
            for (int ei = 0; ei < 3; ++ei) { const int em = ei < 2 ? wh * 2 + ei : 4;
                f32x4 a1 = {0.f, 0.f, 0.f, 0.f}, a2 = {0.f, 0.f, 0.f, 0.f}; bf16x8 va_[2], ca_[8];
#pragma unroll
                for (int ks = 0; ks < 2; ++ks) va_[ks] = *(const LAS bf16x8*)(L + VT_OFF + (em * 16 + c16) * VT_PITCH + (ks * 32 + q * 8) * 2);
#pragma unroll
                for (int ks = 0; ks < 8; ++ks) ca_[ks] = *(const LAS bf16x8*)(L + CT_OFF + (em * 16 + c16) * CT_PITCH + (ks * 32 + q * 8) * 2);
                __builtin_amdgcn_sched_barrier(0);
#pragma unroll
                for (int ks = 0; ks < 2; ++ks) a1 = ML_MFMA(va_[ks], sb[ks], a1);
#pragma unroll
                for (int ks = 0; ks < 8; ++ks) a2 = ML_MFMA(ca_[ks], Qc[ks], a2);
                __builtin_amdgcn_sched_barrier(0);
                const f32x4 nv = a1 + a2 * wi;
                if (ei == 0) num0 = nv; else if (ei == 1) num1 = nv;
                else den = fmaxf(fabsf(lane_get(nv[0], c16)), __expf(-(TB[128 + t] + TB[64 + t]))); }
            const float rd = 1.f / den; bf16_t* op = MH + MLP_ROW(base, t) * DM + h * 256 + es * 64 + q * 4; const f32x4 o0 = num0 * rd, o1 = num1 * rd;
            v2u w0, w1; w0.x = pk2(o0[0], o0[1]); w0.y = pk2(o0[2], o0[3]); w1.x = pk2(o1[0], o1[1]); w1.y = pk2(o1[2], o1[3]);
            *(v2u*)(op + (wh * 2) * 16) = w0; *(v2u*)(op + (wh * 2 + 1) * 16) = w1;
        }
        if (VAR != 1) { const float decay = __expf(m - mm63); bf16x8 vb_[5][2], ka2_[2][2];
#pragma unroll
          for (int en = 0; en < 5; ++en)
#pragma unroll
              for (int ks = 0; ks < 2; ++ks) vb_[en][ks] = *(const LAS bf16x8*)(L + VT_OFF + (en * 16 + c16) * VT_PITCH + (ks * 32 + q * 8) * 2);
#pragma unroll
          for (int di = 0; di < 2; ++di)
#pragma unroll
              for (int ks = 0; ks < 2; ++ks) ka2_[di][ks] = *(const LAS bf16x8*)(L + KT_OFF + ((2 * w + di) * 16 + c16) * KT_PITCH + (ks * 32 + q * 8) * 2);
#pragma unroll
          for (int di = 0; di < 2; ++di)
#pragma unroll
              for (int en = 0; en < 5; ++en) C[di][en] = C[di][en] * decay;
          __builtin_amdgcn_sched_barrier(0);
#pragma unroll
          for (int di = 0; di < 2; ++di)
#pragma unroll
              for (int en = 0; en < 5; ++en)
#pragma unroll
                  for (int ks = 0; ks < 2; ++ks) C[di][en] = ML_MFMA(ka2_[di][ks], vb_[en][ks], C[di][en]);
          __builtin_amdgcn_sched_barrier(0); }
        if (s_next && VAR != 1) MLP_STILE(Qn, MLP_TAB(par ^ 1), MLP_ST(par ^ 1));
#pragma unroll
        for (int ks = 0; ks < 8; ++ks) Qc[ks] = Qn[ks];
        if (VAR != 3) MLP_LOADQ(Qn, k2);
        m = m_next;
        __syncthreads();
    }
#undef MLP_ROW
#undef MLP_TAB
#undef MLP_ST
#undef MLP_XB
#undef MLP_LOADK
#undef MLP_LOADV
#undef MLP_LOADG
#undef MLP_LOADQ
#undef MLP_STILE
}
constexpr int T_CT = 0, T_CT_ROWS = 65;
constexpr int T_KS0 = T_CT + T_CT_ROWS * CT_PITCH, T_KS1 = T_KS0 + 64 * KS_PITCH;
constexpr int T_VS = T_KS1 + 64 * KS_PITCH, T_VPITCH = 160, T_VSW = T_VS + 64 * T_VPITCH;
constexpr int T_ST0 = T_VSW + 64 * T_VPITCH, T_ST1 = T_ST0 + 64 * ST_PITCH, T_TAB0 = T_ST1 + 64 * ST_PITCH, T_TAB1 = T_TAB0 + 1024, T_END = T_TAB1 + 1024;
static_assert(T_END <= MISC_OFF && T_CT + 80 * CT_PITCH <= T_END && T_KS0 % 16 == 0, "mLSTM LDS map (transposed reads)");
typedef short s16x4 __attribute__((ext_vector_type(4)));
template <int OFF> __device__ __forceinline__ s16x4 tr4(unsigned addr) { s16x4 r; asm volatile("ds_read_b64_tr_b16 %0, %1 offset:%2" : "=&v"(r) : "v"(addr), "i"(OFF) : "memory"); return r; }
#define TR_FRAG(OUT, addr, OFF0, OFF1) do { const s16x4 _a = tr4<(OFF0)>(addr), _b = tr4<(OFF1)>(addr); OUT##_lo = _a; OUT##_hi = _b; } while (0)
#define TR_JOIN(lo, hi) ((bf16x8){lo[0], lo[1], lo[2], lo[3], hi[0], hi[1], hi[2], hi[3]})
__device__ __forceinline__ void mlstm_unit_tr(Frame& F, CArgs* ka, int u, bool need_ctx) {
    const int tid = tid_fresh(), lane = tid & 63, w = __builtin_amdgcn_readfirstlane(tid >> 6), c16 = lane & 15, q = lane >> 4;
    const int es = u & 3, dir = (u >> 2) & 1, h = (u >> 3) & 7, b = u >> 6;
    LAS unsigned char* L = F.lds;
    const bf16_t* X8 = WSB(WS_X8); constexpr size_t X8_SEC = (size_t)MROWS * DM; bf16_t* MH = WSB(WS_MH) + (size_t)dir * MROWS * DM;
    const f32x4* GSC = (const f32x4*)WSF(WS_GSC) + (((size_t)b * 2 + dir) * 8 + h) * 36 * 64;
    __syncthreads();
    { unsigned z0 = 0u; asm volatile("" : "+v"(z0)); const v4u zz = {z0, z0, z0, z0};
      for (int i = tid; i < T_CT_ROWS * CT_PITCH / 16; i += 512) *(LAS v4u*)(L + T_CT + i * 16) = zz;
      if (tid < 128) { const int s = tid & 63, hf = tid >> 6; v4u one = zz; if (hf == 0) one.x = 0x3F80u;
          *(LAS v4u*)(L + T_VS + s * T_VPITCH + 128 + hf * 16) = one; *(LAS v4u*)(L + T_VSW + s * T_VPITCH + 128 + hf * 16) = zz; } }
    f32x4 C[2][5];
#pragma unroll
    for (int a = 0; a < 2; ++a)
#pragma unroll
        for (int e = 0; e < 5; ++e) C[a][e] = (f32x4){0.f, 0.f, 0.f, 0.f};
    const int tn = w & 3, wh = w >> 2, t = tn * 16 + c16;
    const int kl = (dir ? 63 - lane : lane) * 8, ql = q * 512 + (dir ? 63 - t : t) * 8;
    const unsigned LB = (unsigned)(size_t)L;
    const unsigned trK = (unsigned)((8 * q + (c16 >> 2)) * KS_PITCH + 8 * (lane & 3) + 64 * w), trV = (unsigned)((8 * q + (c16 >> 2)) * T_VPITCH + 8 * (lane & 3));
    v4u kn[4], vc; bf16x8 Qc[8], Qn[8]; float gc0, gc1, gc2, gn0, gn1, gn2;
#define MLP_ROW(base, j) ((size_t)(base) + (dir ? 63 - (j) : (j)))
#define MLP_TAB(par) ((LAS float*)(L + ((par) ? T_TAB1 : T_TAB0)))
#define MLP_ST(par) ((par) ? T_ST1 : T_ST0)
#define MLP_KS(par) ((par) ? T_KS1 : T_KS0)
#define MLP_XB(sec, c_) (X8 + (size_t)(sec) * X8_SEC + ((size_t)(b * 8 + h) * 36 + (c_)) * (32 * 64 * 8))
#define MLP_LOADK(dst, k) do { const bf16_t* _xb = MLP_XB(1, chunk_of((k), dir)) + w * 4 * 512; \
        _Pragma("unroll") for (int i = 0; i < 4; ++i) dst[i] = *(const v4u*)(_xb + i * 512 + kl); } while (0)
#define MLP_LOADV(dst, k) do { dst = *(const v4u*)(MLP_XB(2, chunk_of((k), dir)) + (es * 8 + w) * 512 + kl); } while (0)
#define MLP_LOADG(d0, d1, d2, k) do { const float* _gp = (const float*)(GSC + chunk_of((k), dir) * 64 + lane); d0 = _gp[0]; d1 = _gp[1]; d2 = _gp[2]; } while (0)
#define MLP_LOADQ(dst, k) do { const bf16_t* _xb = MLP_XB(0, chunk_of((k), dir)); \
        _Pragma("unroll") for (int ks = 0; ks < 8; ++ks) dst[ks] = *(const bf16x8*)(_xb + ks * 2048 + ql); } while (0)
#define MLP_STILE(QQ, TB, SO, KSO) do { const float _mmt = (TB)[64 + t]; \
        _Pragma("unroll") for (int si = 0; si < 2; ++si) { const int sm = wh * 2 + si; v2u o = {0u, 0u}; \
            if (sm <= tn) { f32x4 acc = {0.f, 0.f, 0.f, 0.f}; \
                bf16x8 ka_[8]; \
                _Pragma("unroll") for (int ks = 0; ks < 8; ++ks) ka_[ks] = *(const LAS bf16x8*)(L + (KSO) + (sm * 16 + c16) * KS_PITCH + (ks * 32 + q * 8) * 2); \
                __builtin_amdgcn_sched_barrier(0); \
                _Pragma("unroll") for (int ks = 0; ks < 8; ++ks) acc = ML_MFMA(ka_[ks], QQ[ks], acc); \
                float v[4]; \
                _Pragma("unroll") for (int j = 0; j < 4; ++j) { const int s = sm * 16 + q * 4 + j; v[j] = s <= t ? acc[j] * __expf((TB)[s] - _mmt) : 0.f; } \
                o.x = pk2(v[0], v[1]); o.y = pk2(v[2], v[3]); } \
            *(LAS v2u*)(L + (SO) + t * ST_PITCH + (sm * 16 + q * 4) * 2) = o; } } while (0)
    MLP_LOADK(kn, 0); MLP_LOADV(vc, 0); MLP_LOADG(gc0, gc1, gc2, 0); MLP_LOADQ(Qc, 0); MLP_LOADG(gn0, gn1, gn2, 1); MLP_LOADQ(Qn, 1);
    float m = -1e30f;
    { const float mm = fmaxf(gc2, m); LAS float* TB = MLP_TAB(0);
      if (w == 0) { TB[lane] = gc1; TB[64 + lane] = mm; TB[128 + lane] = gc0; }
#pragma unroll
      for (int i = 0; i < 4; ++i) *(LAS v4u*)(L + T_KS0 + lane * KS_PITCH + (w * 4 + i) * 16) = kn[i];
      MLP_LOADK(kn, 1);
      __syncthreads();
      if (need_ctx) MLP_STILE(Qc, TB, MLP_ST(0), T_KS0);
      __syncthreads(); }
#pragma unroll 1
    for (int k = 0; k < 36; ++k) {
        const int par = k & 1, k1 = k + 1 < 36 ? k + 1 : 35, k2 = k + 2 < 36 ? k + 2 : 35;
        const bool do_out = need_ctx || k >= 4, s_next = (k + 1 < 36) && (need_ctx || k + 1 >= 4);
        const size_t base = (size_t)b * TPB + chunk_of(k, dir) * 64;
        if (k > 0) {
#pragma unroll
            for (int di = 0; di < 2; ++di)
#pragma unroll
                for (int en = 0; en < 5; ++en) { const f32x4 c = C[di][en]; v2u o; o.x = pk2(c[0], c[1]); o.y = pk2(c[2], c[3]);
                    if (en < 4 || c16 == 0) *(LAS v2u*)(L + T_CT + (en * 16 + c16) * CT_PITCH + ((2 * w + di) * 16 + q * 4) * 2) = o; } }
        const float mm = fmaxf(gc2, m), bL = lane_get(gc0, 63), mm63 = lane_get(mm, 63), wk = __expf(gc1 - mm63), m_next = bL + mm63;
        { *(LAS v4u*)(L + T_VS + lane * T_VPITCH + w * 16) = vc;
          v4u sv;
#pragma unroll
          for (int e = 0; e < 4; ++e) sv[e] = pk2(blo(vc[e]) * wk, bhi(vc[e]) * wk);
          *(LAS v4u*)(L + T_VSW + lane * T_VPITCH + w * 16) = sv;
          if (w == 0) *(LAS bf16_t*)(L + T_VSW + lane * T_VPITCH + 128) = (bf16_t)(pk2(wk, 0.f) & 0xffffu); }
        { const float mmn = fmaxf(gn2, m_next); LAS float* TBn = MLP_TAB(par ^ 1);
          if (w == 0) { TBn[lane] = gn1; TBn[64 + lane] = mmn; TBn[128 + lane] = gn0; }
#pragma unroll
          for (int i = 0; i < 4; ++i) *(LAS v4u*)(L + MLP_KS(par ^ 1) + lane * KS_PITCH + (w * 4 + i) * 16) = kn[i]; }
        __syncthreads();
        gc0 = gn0; gc1 = gn1; gc2 = gn2;
        MLP_LOADK(kn, k2); MLP_LOADV(vc, k1); MLP_LOADG(gn0, gn1, gn2, k2);
        const LAS float* TB = MLP_TAB(par);
        if (do_out) {
            const float wi = __expf(m - TB[64 + t]); f32x4 num0 = {0.f, 0.f, 0.f, 0.f}, num1 = {0.f, 0.f, 0.f, 0.f}; float den = 1.f;
            bf16x8 sb[2];
#pragma unroll
            for (int ks = 0; ks < 2; ++ks) sb[ks] = *(const LAS bf16x8*)(L + MLP_ST(par) + t * ST_PITCH + (ks * 32 + q * 8) * 2);
#pragma unroll
            for (int ei = 0; ei < 3; ++ei) { const int em = ei < 2 ? wh * 2 + ei : 4;
                f32x4 a1 = {0.f, 0.f, 0.f, 0.f}, a2 = {0.f, 0.f, 0.f, 0.f}; bf16x8 ca_[8];
                const unsigned va = LB + T_VS + trV + 32 * em;
                const s16x4 v00 = tr4<0>(va), v01 = tr4<4 * T_VPITCH>(va), v10 = tr4<32 * T_VPITCH>(va), v11 = tr4<36 * T_VPITCH>(va);
#pragma unroll
                for (int ks = 0; ks < 8; ++ks) ca_[ks] = *(const LAS bf16x8*)(L + T_CT + (em * 16 + c16) * CT_PITCH + (ks * 32 + q * 8) * 2);
                asm volatile("s_waitcnt lgkmcnt(0)" ::: "memory"); __builtin_amdgcn_sched_barrier(0);
                a1 = ML_MFMA(TR_JOIN(v00, v01), sb[0], a1); a1 = ML_MFMA(TR_JOIN(v10, v11), sb[1], a1);
#pragma unroll
                for (int ks = 0; ks < 8; ++ks) a2 = ML_MFMA(ca_[ks], Qc[ks], a2);
                __builtin_amdgcn_sched_barrier(0);
                const f32x4 nv = a1 + a2 * wi;
                if (ei == 0) num0 = nv; else if (ei == 1) num1 = nv;
                else den = fmaxf(fabsf(lane_get(nv[0], c16)), __expf(-(TB[128 + t] + TB[64 + t]))); }
            const float rd = 1.f / den; bf16_t* op = MH + MLP_ROW(base, t) * DM + h * 256 + es * 64 + q * 4; const f32x4 o0 = num0 * rd, o1 = num1 * rd;
            v2u w0, w1; w0.x = pk2(o0[0], o0[1]); w0.y = pk2(o0[2], o0[3]); w1.x = pk2(o1[0], o1[1]); w1.y = pk2(o1[2], o1[3]);
            *(v2u*)(op + (wh * 2) * 16) = w0; *(v2u*)(op + (wh * 2 + 1) * 16) = w1;
        }
        {
          const float decay = __expf(m - mm63);
          const unsigned ka_ = LB + MLP_KS(par) + trK, vb_ = LB + T_VSW + trV;
          const s16x4 k000 = tr4<0>(ka_), k001 = tr4<4 * KS_PITCH>(ka_), k010 = tr4<32 * KS_PITCH>(ka_), k011 = tr4<36 * KS_PITCH>(ka_);
          const s16x4 k100 = tr4<32>(ka_), k101 = tr4<4 * KS_PITCH + 32>(ka_), k110 = tr4<32 * KS_PITCH + 32>(ka_), k111 = tr4<36 * KS_PITCH + 32>(ka_);
          s16x4 vq[5][4];
#define TRV(en) do { vq[en][0] = tr4<32 * (en)>(vb_); vq[en][1] = tr4<4 * T_VPITCH + 32 * (en)>(vb_); vq[en][2] = tr4<32 * T_VPITCH + 32 * (en)>(vb_); vq[en][3] = tr4<36 * T_VPITCH + 32 * (en)>(vb_); } while (0)
          TRV(0); TRV(1); TRV(2); TRV(3); TRV(4);
#undef TRV
#pragma unroll
          for (int di = 0; di < 2; ++di)
#pragma unroll
              for (int en = 0; en < 5; ++en) C[di][en] = C[di][en] * decay;
          asm volatile("s_waitcnt lgkmcnt(0)" ::: "memory"); __builtin_amdgcn_sched_barrier(0);
#pragma unroll
          for (int en = 0; en < 5; ++en) { const bf16x8 b0 = TR_JOIN(vq[en][0], vq[en][1]), b1 = TR_JOIN(vq[en][2], vq[en][3]);
              C[0][en] = ML_MFMA(TR_JOIN(k000, k001), b0, C[0][en]); C[0][en] = ML_MFMA(TR_JOIN(k010, k011), b1, C[0][en]);
              C[1][en] = ML_MFMA(TR_JOIN(k100, k101), b0, C[1][en]); C[1][en] = ML_MFMA(TR_JOIN(k110, k111), b1, C[1][en]); }
          __builtin_amdgcn_sched_barrier(0); }
        if (s_next) MLP_STILE(Qn, MLP_TAB(par ^ 1), MLP_ST(par ^ 1), MLP_KS(par ^ 1));
#pragma unroll
        for (int ks = 0; ks < 8; ++ks) Qc[ks] = Qn[ks];
        MLP_LOADQ(Qn, k2);
        m = m_next;
        __syncthreads();
    }
#undef MLP_ROW
#undef MLP_TAB
#undef MLP_ST
#undef MLP_KS
#undef MLP_XB
#undef MLP_LOADK
#undef MLP_LOADV
#undef MLP_LOADG
#undef MLP_LOADQ
#undef MLP_STILE
}
}

namespace lru {
typedef short bf16x8 __attribute__((ext_vector_type(8)));
constexpr int XB_OFF = 0, XB_PITCH = 272;
constexpr int XF_OFF = XB_OFF + 64 * XB_PITCH, XF_PITCH = 528;
constexpr int YO_OFF = XF_OFF + 64 * XF_PITCH, YO_PITCH = 528;
constexpr int HIN_OFF = YO_OFF + 64 * YO_PITCH;
constexpr int CW_OFF = HIN_OFF + 9 * 2 * 128 * 4;
constexpr int END_OFF = CW_OFF + 5 * 128 * 4;
static_assert(END_OFF <= MISC_OFF, "LRU LDS map");
#define LRU_COMPOSE(A, B, a2, b2) do { B = (a2) * B + (b2); A = (a2) * A; } while (0)

template <bool FINAL, int VAR, class BcOf>
__device__ __forceinline__ void lru_run(Frame& F, CArgs* ka, int l, int blk, int NU, const BcOf& bc_of) {
    const int tid = tid_fresh(), lane = tid & 63, w = __builtin_amdgcn_readfirstlane(tid >> 6), c16 = lane & 15, q = lane >> 4;
    LAS unsigned char* L = F.lds; const bf16_t* P = WSB(WS_P);
    const int cg = tid & 15, rg = tid >> 4, chl = 16 * w + c16, ch = blk * 128 + chl;
    bf16x8 bw[4][4];
    { const bf16_t* Wt = WSB(WS_WLRU) + (size_t)l * 4 * 16 * 16384 + ((size_t)blk * 128 + chl) * 128 + q * 8;
#pragma unroll
      for (int g = 0; g < 4; ++g)
#pragma unroll
          for (int ks = 0; ks < 4; ++ks) bw[g][ks] = *(const bf16x8*)(Wt + (size_t)g * 16 * 16384 + ks * 32); }
    float cbr[2], cbi[2], csp[2];
#pragma unroll
    for (int dr = 0; dr < 2; ++dr) { cbr[dr] = KIN(12)[((size_t)l * 2 + dr) * DM + ch]; cbi[dr] = KIN(14)[((size_t)l * 2 + dr) * DM + ch]; csp[dr] = log1pf(__expf(-KIN(15)[((size_t)l * 2 + dr) * DM + ch])); }
    for (int i = tid; i < 5 * 128; i += 512) { const int kk = i >> 7, c = i & 127; ((LAS float*)(L + CW_OFF))[i] = kk < 4 ? KIN(9)[((size_t)l * 4 + kk) * DM + blk * 128 + c] : KIN(10)[(size_t)l * DM + blk * 128 + c]; }
    v4u raw[5];
#define LRU_LOAD(i) do { int _b, _c; bc_of((i), _b, _c); const int _t0 = _c * 64, _lo = _c < 32 ? 0 : SEQ, _hi = _c < 32 ? SEQ : TPB; const size_t _rb = (size_t)_b * TPB; \
        _Pragma("unroll") for (int x = 0; x < 5; ++x) { const int tt = _t0 + 2 * rg - 2 + x; raw[x] = (v4u){0u, 0u, 0u, 0u}; if (tt >= _lo && tt < _hi) raw[x] = *(const v4u*)(P + (_rb + tt) * NP + C_LX + blk * 128 + cg * 8); } \
        } while (0)
    LRU_LOAD(0);
#pragma unroll 1
    for (int ui = 0; ui < NU; ++ui) {
        int b, chunk; bc_of(ui, b, chunk); const size_t rb = (size_t)b * TPB; const int t0 = chunk * 64;
        __syncthreads();
        {
          float o0[8], o1[8]; const LAS float* cwl = (const LAS float*)(L + CW_OFF) + cg * 8;
#pragma unroll
          for (int e = 0; e < 8; ++e) { o0[e] = cwl[4 * 128 + e]; o1[e] = o0[e]; }
#pragma unroll
          for (int kk = 0; kk < 5; ++kk) { float xin[8];
#pragma unroll
              for (int e = 0; e < 4; ++e) { xin[2 * e] = blo(raw[kk][e]); xin[2 * e + 1] = bhi(raw[kk][e]); }
#pragma unroll
              for (int e = 0; e < 8; ++e) { if (kk < 4) o0[e] += cwl[kk * 128 + e] * xin[e]; if (kk > 0) o1[e] += cwl[(kk - 1) * 128 + e] * xin[e]; } }
          v4u p0, p1; p0.x = pk2(o0[0], o0[1]); p0.y = pk2(o0[2], o0[3]); p0.z = pk2(o0[4], o0[5]); p0.w = pk2(o0[6], o0[7]); p1.x = pk2(o1[0], o1[1]); p1.y = pk2(o1[2], o1[3]); p1.z = pk2(o1[4], o1[5]); p1.w = pk2(o1[6], o1[7]);
          *(LAS v4u*)(L + XB_OFF + (2 * rg) * XB_PITCH + cg * 16) = p0; *(LAS v4u*)(L + XB_OFF + (2 * rg + 1) * XB_PITCH + cg * 16) = p1;
          LAS float* f0 = (LAS float*)(L + XF_OFF + (2 * rg) * XF_PITCH + cg * 32); LAS float* f1 = (LAS float*)(L + XF_OFF + (2 * rg + 1) * XF_PITCH + cg * 32);
          *(LAS f32x4*)f0 = (f32x4){o0[0], o0[1], o0[2], o0[3]}; *(LAS f32x4*)(f0 + 4) = (f32x4){o0[4], o0[5], o0[6], o0[7]};
          *(LAS f32x4*)f1 = (f32x4){o1[0], o1[1], o1[2], o1[3]}; *(LAS f32x4*)(f1 + 4) = (f32x4){o1[4], o1[5], o1[6], o1[7]}; }
        __syncthreads();
        v4u zcur[2];
        if (FINAL) {
#pragma unroll
            for (int x = 0; x < 2; ++x) { const int cidx = tid + 512 * x; zcur[x] = *(const v4u*)(P + (rb + t0 + (cidx >> 4)) * NP + C_LZ + blk * 128 + (cidx & 15) * 8); } }
        if (ui + 1 < NU) LRU_LOAD(ui + 1);
#pragma unroll
        for (int dr = 0; dr < 2; ++dr) {
            f32x4 acc[2][4];
#pragma unroll
            for (int g = 0; g < 2; ++g)
#pragma unroll
                for (int tm = 0; tm < 4; ++tm) acc[g][tm] = (f32x4){0.f, 0.f, 0.f, 0.f};
            if (VAR < 2) {
#pragma unroll
            for (int ks = 0; ks < 4; ++ks) { bf16x8 a[4];
#pragma unroll
                for (int tm = 0; tm < 4; ++tm) a[tm] = *(const LAS bf16x8*)(L + XB_OFF + (tm * 16 + c16) * XB_PITCH + (ks * 32 + q * 8) * 2);
#pragma unroll
                for (int g = 0; g < 2; ++g)
#pragma unroll
                    for (int tm = 0; tm < 4; ++tm) acc[g][tm] = __builtin_amdgcn_mfma_f32_16x16x32_bf16(a[tm], bw[2 * dr + g][ks], acc[g][tm], 0, 0, 0); } }
            if (VAR < 1) {
                typedef float f32x2 __attribute__((ext_vector_type(2)));
                const float NL2E = -1.4426950408889634f; const float kr = cbr[dr] * NL2E, ki = cbi[dr] * NL2E, c16l = -16.f * csp[dr], c8l2 = -8.f * csp[dr] * 1.4426950408889634f;
#pragma unroll
                for (int tm = 0; tm < 4; ++tm)
#pragma unroll
                    for (int jp = 0; jp < 2; ++jp) { const int t = tm * 16 + q * 4 + 2 * jp;
                        const f32x2 xv = {*(const LAS float*)(L + XF_OFF + t * XF_PITCH + chl * 4), *(const LAS float*)(L + XF_OFF + (t + 1) * XF_PITCH + chl * 4)};
                        const f32x2 ar = {acc[0][tm][2 * jp], acc[0][tm][2 * jp + 1]}, ai = {acc[1][tm][2 * jp], acc[1][tm][2 * jp + 1]};
                        f32x2 tr = ar * NL2E + kr, ti = ai * NL2E + ki; tr.x = fminf(tr.x, 60.f); tr.y = fminf(tr.y, 60.f); ti.x = fminf(ti.x, 60.f); ti.y = fminf(ti.y, 60.f);
                        f32x2 er, ei; er.x = __builtin_amdgcn_exp2f(tr.x); er.y = __builtin_amdgcn_exp2f(tr.y); ei.x = __builtin_amdgcn_exp2f(ti.x); ei.y = __builtin_amdgcn_exp2f(ti.y);
                        const f32x2 pr = er + 1.f, pi = ei + 1.f, dn = pr * pi; f32x2 R; R.x = __builtin_amdgcn_rcpf(dn.x); R.y = __builtin_amdgcn_rcpf(dn.y);
                        const f32x2 rgt = R * pi, igt = R * pr, x2 = rgt * c16l, l2 = rgt * c8l2;
                        f32x2 av; av.x = __builtin_amdgcn_exp2f(l2.x); av.y = __builtin_amdgcn_exp2f(l2.y);
                        const f32x2 ser = -x2 * (x2 * (x2 * (x2 * (x2 * 0.0083333338f + 0.041666668f) + 0.16666667f) + 0.5f) + 1.f), dir_ = 1.f - av * av;
                        f32x2 om; om.x = x2.x > -0.1f ? ser.x : dir_.x; om.y = x2.y > -0.1f ? ser.y : dir_.y;
                        f32x2 sq; sq.x = __builtin_amdgcn_sqrtf(om.x); sq.y = __builtin_amdgcn_sqrtf(om.y);
                        const f32x2 bxv = sq * igt * xv;
                        acc[0][tm][2 * jp] = av.x; acc[0][tm][2 * jp + 1] = av.y; acc[1][tm][2 * jp] = bxv.x; acc[1][tm][2 * jp + 1] = bxv.y; } }
#define LRU_TM(i) (dr ? 3 - (i) : (i))
            if constexpr (!FINAL) { if (VAR < 3) {
                float2* AGG = (float2*)(VAR ? WSF(WS_ACC) : WSF(WS_LA)); float TA = 1.f, TB = 0.f;
#pragma unroll
                for (int ti = 0; ti < 4; ++ti) { const int tm = LRU_TM(ti); float sa = 1.f, sb = 0.f;
#pragma unroll
                    for (int ji = 0; ji < 4; ++ji) { const int j = LRU_TM(ji); LRU_COMPOSE(sa, sb, acc[0][tm][j], acc[1][tm][j]); }
#pragma unroll
                    for (int qi = 0; qi < 4; ++qi) { const int qq = LRU_TM(qi); const float xa = lane_get(sa, c16 + 16 * qq), xb = lane_get(sb, c16 + 16 * qq); LRU_COMPOSE(TA, TB, xa, xb); } }
                if (q == 0) AGG[(((size_t)b * 36 + chunk) * 2 + dr) * DM + ch] = make_float2(TA, TB); }
            } else {
                float H = ((const LAS float*)(L + HIN_OFF))[ui * 256 + dr * 128 + chl];
#pragma unroll
                for (int ti = 0; ti < 4; ++ti) { const int tm = LRU_TM(ti); float sa = 1.f, sb = 0.f;
#pragma unroll
                    for (int ji = 0; ji < 4; ++ji) { const int j = LRU_TM(ji); LRU_COMPOSE(sa, sb, acc[0][tm][j], acc[1][tm][j]); }
                    float ea = 1.f, eb = 0.f, ta = 1.f, tb = 0.f;
#pragma unroll
                    for (int qi = 0; qi < 4; ++qi) { const int qq = LRU_TM(qi); const float xa = lane_get(sa, c16 + 16 * qq), xb = lane_get(sb, c16 + 16 * qq); if (qq == q) { ea = ta; eb = tb; } LRU_COMPOSE(ta, tb, xa, xb); }
                    float hs = ea * H + eb;
#pragma unroll
                    for (int ji = 0; ji < 4; ++ji) { const int j = LRU_TM(ji); hs = acc[0][tm][j] * hs + acc[1][tm][j]; LAS float* yp = (LAS float*)(L + YO_OFF + (tm * 16 + q * 4 + j) * YO_PITCH + chl * 4);
                        if (dr == 0) *yp = hs; else *yp += hs; }
                    H = ta * H + tb; }
            }
#undef LRU_TM
        }
        if constexpr (FINAL) {
            __syncthreads();
            bf16_t* YB0 = WSB(WS_YB);
#pragma unroll
            for (int i = 0; i < 2; ++i) { const int cidx = tid + 512 * i, row = cidx >> 4, cgo = cidx & 15; const size_t rgl = rb + t0 + row;
                const f32x4 y0 = *(const LAS f32x4*)(L + YO_OFF + row * YO_PITCH + cgo * 32), y1 = *(const LAS f32x4*)(L + YO_OFF + row * YO_PITCH + cgo * 32 + 16);
                const v4u z = zcur[i];
                v4u o; o.x = pk2(y0[0] * blo(z.x), y0[1] * bhi(z.x)); o.y = pk2(y0[2] * blo(z.y), y0[3] * bhi(z.y)); o.z = pk2(y1[0] * blo(z.z), y1[1] * bhi(z.z)); o.w = pk2(y1[2] * blo(z.w), y1[3] * bhi(z.w));
                *(v4u*)(YB0 + rgl * DM + blk * 128 + cgo * 8) = o; }
        }
    }
#undef LRU_LOAD
}
constexpr int CW_LRUFLAG = 32768, LRU_FLAG_STRIDE = 16;
__device__ __forceinline__ void p_lru_lookback(Frame& F, CArgs* ka, int l) {
    const int tid = tid_fresh(), lane = tid & 63, w = __builtin_amdgcn_readfirstlane(tid >> 6), c16 = lane & 15, q = lane >> 4;
    const int npar = F.G / 36; if (F.wg >= npar * 36) return;
    const int slot = F.wg / 36, chunk = F.wg - slot * 36, cps = (64 + npar - 1) / npar;
    LAS unsigned char* L = F.lds; const bf16_t* P = WSB(WS_P);
    unsigned* ctl = (unsigned*)(ka->ws + WS_CTL); unsigned long long* AGG = (unsigned long long*)WSF(WS_LA) + (size_t)l * 64 * 36 * 2 * 128;
    const unsigned epoch = (unsigned)(l + 1);
    const int cg = tid & 15, rg = tid >> 4, chl = 16 * w + c16;
    const int t0 = chunk * 64, lo = chunk < 32 ? 0 : SEQ, hi = chunk < 32 ? SEQ : TPB;
    int cur_blk = -1;
    v4u raw[5];
#define LRU_LOADX(colx) do { const int _b = (colx) & 3, _blk = (colx) >> 2; const size_t _rb = (size_t)_b * TPB; \
        _Pragma("unroll") for (int x = 0; x < 5; ++x) { const int tt = t0 + 2 * rg - 2 + x; raw[x] = (v4u){0u, 0u, 0u, 0u}; if (tt >= lo && tt < hi) raw[x] = *(const v4u*)(P + (_rb + tt) * NP + C_LX + _blk * 128 + cg * 8); } } while (0)
    const int col0 = slot * cps, col1 = (col0 + cps) < 64 ? (col0 + cps) : 64;
    if (col0 < col1) LRU_LOADX(col0);
#pragma unroll 1
    for (int col = col0; col < col1; ++col) {
        const int b = col & 3, blk = col >> 2, ch = blk * 128 + chl; const size_t rb = (size_t)b * TPB;
        __syncthreads();
        bf16x8 bw[4][4]; float cbr[2], cbi[2], csp[2];
        { const bf16_t* Wt = WSB(WS_WLRU) + (size_t)l * 4 * 16 * 16384 + ((size_t)blk * 128 + chl) * 128 + q * 8;
#pragma unroll
          for (int g = 0; g < 4; ++g)
#pragma unroll
              for (int ks = 0; ks < 4; ++ks) bw[g][ks] = *(const bf16x8*)(Wt + (size_t)g * 16 * 16384 + ks * 32);
#pragma unroll
          for (int dr = 0; dr < 2; ++dr) { cbr[dr] = KIN(12)[((size_t)l * 2 + dr) * DM + ch]; cbi[dr] = KIN(14)[((size_t)l * 2 + dr) * DM + ch]; csp[dr] = log1pf(__expf(-KIN(15)[((size_t)l * 2 + dr) * DM + ch])); } }
        if (blk != cur_blk) { cur_blk = blk;
            for (int i = tid; i < 5 * 128; i += 512) { const int kk = i >> 7, c = i & 127; ((LAS float*)(L + CW_OFF))[i] = kk < 4 ? KIN(9)[((size_t)l * 4 + kk) * DM + blk * 128 + c] : KIN(10)[(size_t)l * DM + blk * 128 + c]; }
            __syncthreads(); }
        {
          float o0[8], o1[8]; const LAS float* cwl = (const LAS float*)(L + CW_OFF) + cg * 8;
#pragma unroll
          for (int e = 0; e < 8; ++e) { o0[e] = cwl[4 * 128 + e]; o1[e] = o0[e]; }
#pragma unroll
          for (int kk = 0; kk < 5; ++kk) { float xin[8];
#pragma unroll
              for (int e = 0; e < 4; ++e) { xin[2 * e] = blo(raw[kk][e]); xin[2 * e + 1] = bhi(raw[kk][e]); }
#pragma unroll
              for (int e = 0; e < 8; ++e) { if (kk < 4) o0[e] += cwl[kk * 128 + e] * xin[e]; if (kk > 0) o1[e] += cwl[(kk - 1) * 128 + e] * xin[e]; } }
          v4u p0, p1; p0.x = pk2(o0[0], o0[1]); p0.y = pk2(o0[2], o0[3]); p0.z = pk2(o0[4], o0[5]); p0.w = pk2(o0[6], o0[7]); p1.x = pk2(o1[0], o1[1]); p1.y = pk2(o1[2], o1[3]); p1.z = pk2(o1[4], o1[5]); p1.w = pk2(o1[6], o1[7]);
          *(LAS v4u*)(L + XB_OFF + (2 * rg) * XB_PITCH + cg * 16) = p0; *(LAS v4u*)(L + XB_OFF + (2 * rg + 1) * XB_PITCH + cg * 16) = p1;
          LAS float* f0 = (LAS float*)(L + XF_OFF + (2 * rg) * XF_PITCH + cg * 32); LAS float* f1 = (LAS float*)(L + XF_OFF + (2 * rg + 1) * XF_PITCH + cg * 32);
          *(LAS f32x4*)f0 = (f32x4){o0[0], o0[1], o0[2], o0[3]}; *(LAS f32x4*)(f0 + 4) = (f32x4){o0[4], o0[5], o0[6], o0[7]};
          *(LAS f32x4*)f1 = (f32x4){o1[0], o1[1], o1[2], o1[3]}; *(LAS f32x4*)(f1 + 4) = (f32x4){o1[4], o1[5], o1[6], o1[7]}; }
        __syncthreads();
        { const int coln = col + 1 < col1 ? col + 1 : col; LRU_LOADX(coln); }
        f32x4 av[2][4], bv[2][4];
#pragma unroll
        for (int dr = 0; dr < 2; ++dr) {
#pragma unroll
            for (int tm = 0; tm < 4; ++tm) { av[dr][tm] = (f32x4){0.f, 0.f, 0.f, 0.f}; bv[dr][tm] = (f32x4){0.f, 0.f, 0.f, 0.f}; }
#pragma unroll
            for (int ks = 0; ks < 4; ++ks) { bf16x8 a[4];
#pragma unroll
                for (int tm = 0; tm < 4; ++tm) a[tm] = *(const LAS bf16x8*)(L + XB_OFF + (tm * 16 + c16) * XB_PITCH + (ks * 32 + q * 8) * 2);
#pragma unroll
                for (int tm = 0; tm < 4; ++tm) { av[dr][tm] = __builtin_amdgcn_mfma_f32_16x16x32_bf16(a[tm], bw[2 * dr][ks], av[dr][tm], 0, 0, 0); bv[dr][tm] = __builtin_amdgcn_mfma_f32_16x16x32_bf16(a[tm], bw[2 * dr + 1][ks], bv[dr][tm], 0, 0, 0); } }
#pragma unroll
            for (int tm = 0; tm < 4; ++tm)
#pragma unroll
                for (int j = 0; j < 4; ++j) { const int t = tm * 16 + q * 4 + j; const float xv = *(const LAS float*)(L + XF_OFF + t * XF_PITCH + chl * 4);
                    const float rgt = pg8::sigmoid_f(av[dr][tm][j] + cbr[dr]), igt = pg8::sigmoid_f(bv[dr][tm][j] + cbi[dr]), la = -8.f * rgt * csp[dr], aa = __expf(la), x2 = 2.f * la;
                    const float om = x2 > -0.1f ? -x2 * (1.f + x2 * (0.5f + x2 * (0.16666667f + x2 * (0.041666668f + x2 * 0.0083333338f)))) : 1.f - aa * aa;
                    av[dr][tm][j] = aa; bv[dr][tm][j] = sqrtf(om) * igt * xv; }
#define LRU_TM(i) (dr ? 3 - (i) : (i))
            float TA = 1.f, TB = 0.f;
#pragma unroll
            for (int ti = 0; ti < 4; ++ti) { const int tm = LRU_TM(ti); float sa = 1.f, sb = 0.f;
#pragma unroll
                for (int ji = 0; ji < 4; ++ji) { const int j = LRU_TM(ji); LRU_COMPOSE(sa, sb, av[dr][tm][j], bv[dr][tm][j]); }
#pragma unroll
                for (int qi = 0; qi < 4; ++qi) { const int qq = LRU_TM(qi); const float xa = lane_get(sa, c16 + 16 * qq), xb = lane_get(sb, c16 + 16 * qq); LRU_COMPOSE(TA, TB, xa, xb); } }
            __builtin_amdgcn_sched_barrier(0);
            if (q == 0) __hip_atomic_store(AGG + (((size_t)col * 36 + chunk) * 2 + dr) * 128 + chl, ((unsigned long long)__float_as_uint(TB) << 32) | __float_as_uint(TA), __ATOMIC_RELAXED, __HIP_MEMORY_SCOPE_AGENT);
        }
        asm volatile("s_waitcnt vmcnt(0)" ::: "memory");
        __syncthreads();
        if (tid == 0) __hip_atomic_store(ctl + CW_LRUFLAG + (col * 36 + chunk) * LRU_FLAG_STRIDE, epoch, __ATOMIC_RELAXED, __HIP_MEMORY_SCOPE_AGENT);
        v4u zcur[2];
#pragma unroll
        for (int x = 0; x < 2; ++x) { const int cidx = tid + 512 * x; zcur[x] = *(const v4u*)(P + (rb + t0 + (cidx >> 4)) * NP + C_LZ + blk * 128 + (cidx & 15) * 8); }
        if (w == 0) {
            unsigned* fp = ctl + CW_LRUFLAG + (col * 36 + (lane < 36 ? lane : 0)) * LRU_FLAG_STRIDE; unsigned spins = 0;
            for (;;) { const bool ok = __hip_atomic_load(fp, __ATOMIC_RELAXED, __HIP_MEMORY_SCOPE_AGENT) >= epoch; if (__all(ok)) break;
                __builtin_amdgcn_s_sleep(1);
                if ((++spins & 255u) == 0u) { if (__hip_atomic_load(ctl, __ATOMIC_RELAXED, __HIP_MEMORY_SCOPE_AGENT) != 0u) break; if (spins > (1u << 20)) { if (lane == 0) __hip_atomic_store(ctl, 0x1200u + (unsigned)l, __ATOMIC_RELAXED, __HIP_MEMORY_SCOPE_AGENT); break; } } }
            __builtin_amdgcn_fence(__ATOMIC_ACQUIRE, "agent");
            asm volatile("s_waitcnt vmcnt(0)" ::: "memory"); }
        __syncthreads();
        if (tid < 256) {
            const int dirx = tid >> 7, cl = tid & 127; const unsigned long long* ap = AGG + ((size_t)col * 36 * 2 + dirx) * 128 + cl; float hcar = 0.f, hmine = 0.f;
#pragma unroll 12
            for (int k = 0; k < 36; ++k) { const int cidx = ml::chunk_of(k, dirx); const unsigned long long ab = ap[(size_t)cidx * 256];
                if (cidx == chunk) hmine = hcar;
                hcar = __uint_as_float((unsigned)ab) * hcar + __uint_as_float((unsigned)(ab >> 32)); }
            ((LAS float*)(L + HIN_OFF))[dirx * 128 + cl] = hmine; }
        __syncthreads();
#pragma unroll
        for (int dr = 0; dr < 2; ++dr) {
            float H = ((const LAS float*)(L + HIN_OFF))[dr * 128 + chl];
#pragma unroll
            for (int ti = 0; ti < 4; ++ti) { const int tm = LRU_TM(ti); float sa = 1.f, sb = 0.f;
#pragma unroll
                for (int ji = 0; ji < 4; ++ji) { const int j = LRU_TM(ji); LRU_COMPOSE(sa, sb, av[dr][tm][j], bv[dr][tm][j]); }
                float ea = 1.f, eb = 0.f, ta = 1.f, tb = 0.f;
#pragma unroll
                for (int qi = 0; qi < 4; ++qi) { const int qq = LRU_TM(qi); const float xa = lane_get(sa, c16 + 16 * qq), xb = lane_get(sb, c16 + 16 * qq); if (qq == q) { ea = ta; eb = tb; } LRU_COMPOSE(ta, tb, xa, xb); }
                float hs = ea * H + eb;
#pragma unroll
                for (int ji = 0; ji < 4; ++ji) { const int j = LRU_TM(ji); hs = av[dr][tm][j] * hs + bv[dr][tm][j]; LAS float* yp = (LAS float*)(L + YO_OFF + (tm * 16 + q * 4 + j) * YO_PITCH + chl * 4);
                    if (dr == 0) *yp = hs; else *yp += hs; }
                H = ta * H + tb; }
        }
#undef LRU_TM
        __syncthreads();
        bf16_t* YB0 = WSB(WS_YB);
#pragma unroll
        for (int i = 0; i < 2; ++i) { const int cidx = tid + 512 * i, row = cidx >> 4, cgo = cidx & 15; const size_t rgl = rb + t0 + row;
            const f32x4 y0 = *(const LAS f32x4*)(L + YO_OFF + row * YO_PITCH + cgo * 32), y1 = *(const LAS f32x4*)(L + YO_OFF + row * YO_PITCH + cgo * 32 + 16);
            const v4u z = zcur[i];
            v4u o; o.x = pk2(y0[0] * blo(z.x), y0[1] * bhi(z.x)); o.y = pk2(y0[2] * blo(z.y), y0[3] * bhi(z.y)); o.z = pk2(y1[0] * blo(z.z), y1[1] * bhi(z.z)); o.w = pk2(y1[2] * blo(z.w), y1[3] * bhi(z.w));
            *(v4u*)(YB0 + rgl * DM + blk * 128 + cgo * 8) = o; }
    }
#undef LRU_LOADX
}
template <int LV> __device__ __forceinline__ void p_lru_agg(Frame& F, CArgs* ka, int l) {
    for (int v = F.wg; v < 256; v += F.G) { const int blk = v & 15, c0 = v >> 4;
        lru_run<false, LV>(F, ka, l, blk, 9, [c0](int i, int& b, int& c) { const int x = c0 + 16 * i; b = x / 36; c = x - b * 36; }); }
}
__device__ __forceinline__ void p_lru_final(Frame& F, CArgs* ka, int l, bool need_ctx) {
    for (int v = F.wg; v < 256; v += F.G) { const int b = v >> 6, blk = (v >> 2) & 15, qt = v & 3;
        const int tid = tid_fresh();
        __syncthreads();
        if (tid < 256) { const int dirx = tid >> 7, chl = tid & 127; const float2* AGG = (const float2*)WSF(WS_LA) + ((size_t)b * 36 * 2 + dirx) * DM + blk * 128 + chl;
            LAS float* HIN = (LAS float*)(F.lds + HIN_OFF); float hcar = 0.f;
#pragma unroll 12
            for (int k = 0; k < 36; ++k) { const int cidx = ml::chunk_of(k, dirx); const float2 ab = AGG[(size_t)cidx * 2 * DM];
                const int sl = cidx - qt * 9; if (sl >= 0 && sl < 9) HIN[sl * 256 + dirx * 128 + chl] = hcar;
                hcar = ab.x * hcar + ab.y; } }
        lru_run<true, 0>(F, ka, l, blk, (need_ctx || qt < 3) ? 9 : 5, [b, qt](int i, int& bb, int& c) { bb = b; c = qt * 9 + i; });
    }
}
}

#ifndef GEMM_NHALF
#define GEMM_NHALF false
#endif
#ifndef CONVERT_AHEAD
#define CONVERT_AHEAD 1
#endif
#ifndef DUP_NORM
#define DUP_NORM 0
#endif
#ifndef DUP_KNORM
#define DUP_KNORM 0
#endif
#ifndef LRU_LOOKBACK
#define LRU_LOOKBACK 0
#endif
#ifndef DUP_G1NULL
#define DUP_G1NULL 0
#endif
#ifndef DUP_G1FIX
#define DUP_G1FIX 0
#endif
#ifndef DUP_BAR
#define DUP_BAR 0
#endif
#ifndef DUP_MLOUT
#define DUP_MLOUT 0
#endif
#ifndef DUP_LRU2
#define DUP_LRU2 0
#endif
#ifndef ML_PIPE
#define ML_PIPE 1
#endif
#ifndef ML_VAR
#define ML_VAR 0
#endif
#ifndef LRU_VAR
#define LRU_VAR -1
#endif
#ifndef CONV_SPLIT
#define CONV_SPLIT 0
#endif
#ifndef GEMM_STAGGER
#define GEMM_STAGGER 0
#endif
#ifndef HEAVY_MIX
#define HEAVY_MIX 0
#endif
#ifndef THIN_MIX
#define THIN_MIX 0
#endif
#ifndef CONV_HEAVY
#define CONV_HEAVY 1
#endif
#ifndef HEAVY_ROT
#define HEAVY_ROT 0
#endif
#ifndef PRETOUCH
#define PRETOUCH 1
#endif
#ifndef PT_STRIDE
#define PT_STRIDE 65536
#endif
#ifndef MERGE_CHAIN
#define MERGE_CHAIN 1
#endif
#ifndef CONV_WIN_M
#define CONV_WIN_M 4000
#endif
#ifndef CONV_AHEAD_ITEMS
#define CONV_AHEAD_ITEMS 8000
#endif
#ifndef CONV_HALF
#define CONV_HALF 17168
#endif
static_assert(!(SPLIT_CTX && GEMM_NHALF), "the split context tiles assume 256-column units");
#ifndef ML_TR
#define ML_TR 1
#endif
#ifndef DUP_PRO
#define DUP_PRO 0
#endif
#ifndef DUP_THIN
#define DUP_THIN 0
#endif
#ifndef DUP_G1
#define DUP_G1 0
#endif
#ifndef DUP_HEAVY
#define DUP_HEAVY 0
#endif
#ifndef DUP_ATT
#define DUP_ATT 0
#endif
#ifndef DUP_ML
#define DUP_ML 0
#endif
#ifndef DUP_LRU1
#define DUP_LRU1 0
#endif
#ifndef DUP_G23
#define DUP_G23 0
#endif
__global__ void __launch_bounds__(NWAVES * 64, 2) fwd(Args args) {
    extern __shared__ __attribute__((aligned(16))) unsigned char lds[];
    Frame F;
    F.lds = (LAS unsigned char*)lds; F.ldsg = (char*)lds;
    F.tid = threadIdx.x; F.lane = F.tid & 63; F.wave = __builtin_amdgcn_readfirstlane(F.tid >> 6); F.G = gridDim.x; F.wg = blockIdx.x;
    CArgs* const ka0 = (CArgs*)__builtin_amdgcn_kernarg_segment_ptr();
    unsigned char* ws; { CArgs* ka = ka0; ws = ka->ws; }
    volatile LAS unsigned* MISC = (volatile LAS unsigned*)(F.lds + MISC_OFF);
    if (F.tid < 64) ((LAS unsigned*)(F.lds + MISC_OFF))[F.tid] = 0u;
    __syncthreads();
    const int lo = ka0->ph_lo, hi = ka0->ph_hi;
    XcdBarrier bar; bar.bar = (unsigned*)(ws + WS_CTL) + CW_BAR; bar.x = 0; bar.st = nullptr;
    if (hi - lo > 1) bar = xcd_barrier_post((unsigned*)(ws + WS_CTL) + CW_BAR, MISC + 8);
#define IN(k) (lo <= (k) && (k) < hi)
#define SEAM(k) do { if ((k) + 1 < hi) { xcd_barrier(bar); if (DUP_BAR) xcd_barrier(bar); } } while (0)

    if (IN(0) && PRETOUCH) {
        CArgs* ka = KA(); const size_t gt = (size_t)F.wg * 512 + F.tid, GT = (size_t)F.G * 512; unsigned acc_ = 0u;
#define PT_RANGE(ptr, bytes) for (size_t p = gt; p < (size_t)(bytes) / PT_STRIDE; p += GT) acc_ += __builtin_nontemporal_load((const unsigned*)((const char*)(ptr) + p * PT_STRIDE))
        PT_RANGE(ka->ws, WS_END); PT_RANGE(KIN(8), (size_t)DEPTH * DM * NIN * 4); PT_RANGE(KIN(20), (size_t)DEPTH * 3 * DM * DM * 4); PT_RANGE(KIN(21), (size_t)DEPTH * DM * DM * 4);
        PT_RANGE(KIN(4), (size_t)DEPTH * DM * 3 * DM * 4); PT_RANGE(KIN(0), (size_t)NBATCH * SEQ * DM * 4); PT_RANGE(KIN(2), (size_t)NBATCH * CTXL * DM * 4); PT_RANGE(ka->out, (size_t)NBATCH * SEQ * DM * 4);
#undef PT_RANGE
        asm volatile("" :: "v"(acc_)); }
    if (IN(0)) { for (int rep = 0; rep <= DUP_PRO; ++rep) { const int wv = F.wg * NWAVES + F.wave, nwv = F.G * NWAVES;
            for (int lc = 0; lc < (CONV_HEAVY ? 1 : DEPTH); ++lc) p_convert(F, KA(), lc, wv, nwv, (CONVERT_AHEAD && lc > 0) ? CONV_AHEAD_ITEMS : 0);
            p_prologue(F, KA()); }
        SEAM(0); }
#pragma unroll 1
    for (int l = 0; l < DEPTH; ++l) {
        const int base = 1 + l * PH_PER_LAYER; const bool need_ctx = l < DEPTH - 1;
        if (IN(base + 0)) { p_norm(F, KA(), l); if (DUP_NORM) p_norm(F, KA(), l + 1 <= DEPTH - 1 && l > 0 ? l : l, true); SEAM(base + 0); }
        if (IN(base + 1)) {
            CArgs* ka = KA(); pg8::Gemm g{WSB(WS_H), WSB(WS_WIN) + (size_t)l * NP * DM, MROWS, NP, DM, 0, 0}; pg8::InOrder S; S.init(MROWS, NP, F.G, F.wg, 256, !need_ctx);
            typedef pg8::EpiIn<(long)((WS_X8 - WS_P) / 2)> EpiInT; EpiInT E{WSB(WS_P)};
            if (GEMM_STAGGER && need_ctx) {
                const int nu = (MROWS / 256) * (NP / 256), extra = nu % F.G;
                if (F.wg >= extra) { const unsigned long long t0 = __builtin_amdgcn_s_memrealtime(), dt = (unsigned long long)(((F.wg - extra) >> 3) & 15) * GEMM_STAGGER;
                    while (__builtin_amdgcn_s_memrealtime() - t0 < dt) __builtin_amdgcn_s_sleep(8); } }
            pg8::gemm_phase<EpiInT, pg8::InOrder, true, true>(F.lds, g, S, E);
            if (DUP_G1) pg8::gemm_phase<EpiInT, pg8::InOrder, true, true>(F.lds, g, S, E);
            if (DUP_G1NULL) { pg8::EpiNull EN{WSF(WS_ACC)}; pg8::gemm_phase<pg8::EpiNull, pg8::InOrder, true, true>(F.lds, g, S, EN); }
            if (DUP_G1FIX) { pg8::EpiNull EN{WSF(WS_ACC)}; pg8::FixedOrder SF; SF.init(MROWS, NP, F.G, F.wg); pg8::gemm_phase<pg8::EpiNull, pg8::FixedOrder, true, true>(F.lds, g, SF, EN); }
            if (need_ctx) {
                const int nu = (MROWS / 256) * (NP / 256), extra = nu % F.G;
                if (F.wg >= extra) { p_gates(F, KA(), l, F.wg - extra, F.G - extra);
                    if (CONVERT_AHEAD && l + 1 < DEPTH) p_convert(F, KA(), l + 1, (F.wg - extra) * NWAVES + F.wave, (F.G - extra) * NWAVES, 0, CONV_SPLIT); } }
            SEAM(base + 1);
        }
        if (IN(base + 2)) { if (!need_ctx) p_gates(F, KA(), l, F.wg, F.G); p_knorm(F, KA(), l); if (DUP_KNORM) p_knorm(F, KA(), l, true);
#if USE_NAIVE_LRU
            p_lru_gates_naive(F, KA(), l);
#endif
            SEAM(base + 2); }
        if (IN(base + 3)) {
#define ML_UNITS() do { for (int v = F.wg; v < 256; v += F.G) {    \
                const int u = (F.G % 8 == 0) ? (((v & 7) * 8 + ((v >> 3) >> 2)) * 4 + ((v >> 3) & 3)) : v; \
                if (ML_TR) ml::mlstm_unit_tr(F, KA(), u, need_ctx); else ml::mlstm_unit_pipe<0>(F, KA(), u, need_ctx); if (ML_VAR) ml::mlstm_unit_pipe<ML_VAR>(F, KA(), u, need_ctx); } } while (0)
            if (HEAVY_MIX && (F.wg & 1)) ML_UNITS();
#define CONV_H() do { if (CONV_HEAVY && l + 1 < DEPTH) { __syncthreads(); p_convert(F, KA(), l + 1, F.wg * NWAVES + F.wave, F.G * NWAVES, CONV_AHEAD_ITEMS, 1 << 30); __syncthreads(); } } while (0)
            if (!((F.wg >> 3) & 1)) CONV_H();
#if HEAVY_ROT
            { const int rot = (F.wg >> 3) % 3;
#pragma unroll 1
              for (int sl = 0; sl < 3; ++sl) { const int k = (sl + rot) % 3;
                  __syncthreads();
                  if (k == 0) p_attention(F, KA(), l, need_ctx);
                  else if (k == 1) ML_UNITS();
                  else lru::p_lru_agg<0>(F, KA(), l); }
              __syncthreads(); }
#else
            for (int r2 = 0; r2 <= DUP_ATT; ++r2) p_attention(F, KA(), l, need_ctx);
            if (!(HEAVY_MIX && (F.wg & 1))) ML_UNITS();
            lru::p_lru_agg<0>(F, KA(), l); if (LRU_VAR >= 0) lru::p_lru_agg<(LRU_VAR >= 0 ? LRU_VAR : 0)>(F, KA(), l);
#endif
#undef ML_UNITS
            if ((F.wg >> 3) & 1) CONV_H();
#undef CONV_H
            SEAM(base + 3); }
        if (IN(base + 4)) { for (int rep = 0; rep <= DUP_THIN; ++rep) {
            const bool lru_first = THIN_MIX && ((F.wg >> 3) & 1);
            if (!lru_first) { for (int r2 = 0; r2 <= DUP_MLOUT; ++r2) p_mlout(F, KA(), l, need_ctx); }
#if USE_NAIVE_LRU
            p_lru_combine_naive(F, KA());
#else
#if !LRU_LOOKBACK
            lru::p_lru_final(F, KA(), l, need_ctx); if (DUP_LRU2) lru::p_lru_final(F, KA(), l, need_ctx);
#endif
#endif
            if (lru_first) p_mlout(F, KA(), l, need_ctx);
            }
            SEAM(base + 4); }
        if (IN(base + 5)) {
            CArgs* ka = KA(); pg8::Gemm g{WSB(WS_YB), WSB(WS_WBR) + (size_t)l * 3 * DM * DM, MROWS, DM, DM, (size_t)MROWS * DM * 2, (size_t)DM * DM * 2}; pg8::MergeOrder S; S.init(MROWS, DM, F.G, F.wg, GEMM_NHALF ? 128 : 256, !need_ctx);
#if MERGE_CHAIN
            pg8::EpiMergeC E{WSB(WS_P), WSB(WS_G2)};
            pg8::gemm_phase<pg8::EpiMergeC, pg8::MergeOrder, true, true, false>(F.lds, g, S, E);
#else
            pg8::EpiMerge<GEMM_NHALF> E{WSB(WS_P), WSF(WS_ACC), WSB(WS_G2)};
            pg8::gemm_phase<pg8::EpiMerge<GEMM_NHALF>, pg8::MergeOrder, true, true, GEMM_NHALF>(F.lds, g, S, E);
#endif
            if (DUP_G23) pg8::gemm_phase<decltype(E), pg8::MergeOrder, true, true, false>(F.lds, g, S, E);
            if (CONVERT_AHEAD && l + 1 < DEPTH) {
                const int ntile_m = (MROWS / 256) * (DM / (GEMM_NHALF ? 128 : 256));
                if (SPLIT_CTX && F.G == 256) { const int busy2 = 96; if (F.wg >= busy2) p_convert(F, KA(), l + 1, (F.wg - busy2) * NWAVES + F.wave, (F.G - busy2) * NWAVES, 0, CONV_WIN_M); }
                else { const int ntile = ntile_m, busy2 = (ntile > F.G && ntile < 2 * F.G) ? ntile - F.G : 0;
                    if (F.wg >= busy2) p_convert(F, KA(), l + 1, (F.wg - busy2) * NWAVES + F.wave, (F.G - busy2) * NWAVES, 0, CONV_AHEAD_ITEMS); } }
            SEAM(base + 5);
        }
        if (IN(base + 6)) {
            CArgs* ka = KA(); pg8::Gemm g{WSB(WS_G2), WSB(WS_WOUT) + (size_t)l * DM * DM, MROWS, DM, DM, (size_t)MROWS * DM * 2, 0}; pg8::SplitOutOrder S; S.init(MROWS, DM, F.G, F.wg, GEMM_NHALF ? 128 : 256, !need_ctx);
#if Y_BF16
            pg8::EpiY16 E{WSB(WS_Y), (size_t)MROWS * DM};
#else
            pg8::EpiF32<GEMM_NHALF> E{WSF(WS_Y), DM, (size_t)MROWS * DM};
#endif
            pg8::gemm_phase<decltype(E), pg8::SplitOutOrder, true, true, false>(F.lds, g, S, E);
            if (DUP_G23) pg8::gemm_phase<decltype(E), pg8::SplitOutOrder, true, true, false>(F.lds, g, S, E);
            const int ntile_o = (MROWS / 256) * (DM / (GEMM_NHALF ? 128 : 256));
            if (CONVERT_AHEAD && l + 1 < DEPTH && SPLIT_CTX && F.G == 256) { const int busy2 = 96; (void)ntile_o;
                if (F.wg >= busy2) p_convert(F, KA(), l + 1, (F.wg - busy2) * NWAVES + F.wave, (F.G - busy2) * NWAVES, CONV_WIN_M, CONV_AHEAD_ITEMS); }
            SEAM(base + 6);
        }
    }
    if (IN(N_PHASES - 1)) p_norm(F, KA(), DEPTH);
#undef IN
#undef SEAM
}

extern "C" void kernel_launch(void* const* d_in, const int* in_sizes, int n_in, void* d_out, int out_size, void* d_ws, size_t ws_size, hipStream_t stream) {
    static int grid = 0;
    if (grid == 0) {
        if (n_in != 22 || in_sizes[0] != NBATCH * SEQ * DM || out_size != NBATCH * SEQ * DM || ws_size < WS_END) {
            fprintf(stderr, "kernel_launch: unexpected shapes: n_in %d in0 %d out %d ws %zu (need %zu)\n", n_in, n_in > 0 ? in_sizes[0] : -1, out_size, ws_size, (size_t)WS_END); grid = -1; return; }
        int dev = 0, cus = 0, per_cu = 0;
        if (hipGetDevice(&dev) != hipSuccess || hipDeviceGetAttribute(&cus, hipDeviceAttributeMultiprocessorCount, dev) != hipSuccess) { fprintf(stderr, "kernel_launch: device query failed\n"); grid = -1; return; }
        if (hipFuncSetAttribute((const void*)fwd, hipFuncAttributeMaxDynamicSharedMemorySize, LDS_BYTES) != hipSuccess) { fprintf(stderr, "kernel_launch: hipFuncSetAttribute failed\n"); grid = -1; return; }
        if (hipOccupancyMaxActiveBlocksPerMultiprocessor(&per_cu, (const void*)fwd, NWAVES * 64, LDS_BYTES) != hipSuccess || per_cu < 1)
            fprintf(stderr, "kernel_launch: note: occupancy query reports %d workgroups per CU\n", per_cu);
        (void)hipGetLastError();
        grid = cus;
    }
    if (grid < 0) return;
    if (hipMemsetAsync((char*)d_ws + WS_CTL, 0, CTL_ZERO_BYTES, stream) != hipSuccess) { fprintf(stderr, "kernel_launch: memset failed\n"); return; }
    Args a{};
    for (int i = 0; i < 22; ++i) a.in[i] = (const float*)d_in[i];
    a.out = (float*)d_out; a.ws = (unsigned char*)d_ws;
    if (MK_N_LAUNCHES == 1) { a.ph_lo = 0; a.ph_hi = N_PHASES; hipLaunchKernelGGL(fwd, dim3(grid), dim3(NWAVES * 64), LDS_BYTES, stream, a); }
    else for (int k = 0; k < N_PHASES; ++k) { a.ph_lo = k; a.ph_hi = k + 1; hipLaunchKernelGGL(fwd, dim3(grid), dim3(NWAVES * 64), LDS_BYTES, stream, a); }
    const hipError_t le = hipPeekAtLastError();
    if (le != hipSuccess) fprintf(stderr, "kernel_launch: launch failed: %s\n", hipGetErrorName(le));
}
```

```cpp
#include <hip/hip_runtime.h>
#include <hip/hip_bf16.h>
#include <cstdio>
#include <cstdint>

constexpr int DM = 2048, NBATCH = 4, SEQ = 2048, CTXL = 256, TPB = SEQ + CTXL  , MROWS = NBATCH * TPB  , DEPTH = 4;
constexpr int NIN = 25632, NP = 25600;
constexpr int C_LX = 0, C_LZ = 2048, C_MQ = 4096, C_MK = 6144, C_MV = 8192, C_MO = 10240, C_MZ = 12288, C_AQ = 14336, C_AK = 16384, C_AV = 16896, C_AZ = 17408, C_MG = 19456;
constexpr float EPS = 1e-6f;
#ifndef SPLIT_CTX
#define SPLIT_CTX 1
#endif
#ifndef Y_BF16
#define Y_BF16 1
#endif
#ifndef LRU_AB
#define LRU_AB 1
#define LRU_AB_LOAD 1
#endif

namespace pg8 {
#define PG8_LAS __attribute__((address_space(3)))
typedef unsigned short bf16_t;
typedef short bf16x8 __attribute__((ext_vector_type(8)));
typedef float f32x4 __attribute__((ext_vector_type(4)));
typedef unsigned u32x4 __attribute__((ext_vector_type(4)));
constexpr int BM = 256, BK = 64, HALF = 128, HTB = HALF * BK * 2  , STAGE_BYTES = 8 * HTB, NXCD = 8, WGM = 8;

__host__ __device__ __forceinline__ int lds_byte(int r, int c) { const int st = (r >> 4) * 2 + (c >> 5), rr = r & 15, cc = c & 31, ob = rr * 64 + cc * 2; return st * 1024 + (ob ^ (((ob >> 9) & 1) << 5)); }
__host__ __device__ __forceinline__ void stage_rc(int b, int& R, int& C) { const int st = b / 1024, sb = b % 1024, swz = sb ^ (((sb >> 9) & 1) << 5); R = (st >> 1) * 16 + swz / 64; C = (st & 1) * 32 + (swz % 64) / 2; }
__host__ __device__ __forceinline__ int perm32(int rho) { const int n = rho >> 4, i = rho & 15; return 8 * (i >> 2) + 4 * n + (i & 3); }

struct Unit { int pm, pn, z, sp; };
struct Gemm { const bf16_t* A; const bf16_t* Bt; int M, N, K; size_t zA, zB; };

struct StaticOrder {
    int nM, nN, nwg, G, c; bool lat;
    __host__ __device__ void init(int M, int N, int G_, int c_, int tileN = BM, bool lat_ = false) { lat = lat_; nM = lat ? (M / BM) * 8 / 9 : M / BM; nN = N / tileN; nwg = nM * nN; G = G_; c = c_; }
    __host__ __device__ bool map_x(long L, Unit& u, int nM_, int nwg_, bool lat_) const {
        if (L >= nwg_) return false;
        int wgid = (int)L; { const int q = nwg_ / NXCD, r = nwg_ % NXCD, xcd = wgid % NXCD, off = wgid / NXCD; wgid = (xcd < r ? xcd * (q + 1) : r * (q + 1) + (xcd - r) * q) + off; }
        const int nig = WGM * nN, gid = wgid / nig, fm = gid * WGM, gsz = (nM_ - fm) < WGM ? (nM_ - fm) : WGM;
        u.pm = fm + ((wgid % nig) % gsz); u.pn = (wgid % nig) / gsz; u.z = 0; u.sp = 0; if (lat_) u.pm = (u.pm >> 3) * 9 + (u.pm & 7); return true;
    }
    __host__ __device__ bool map(long L, Unit& u) const { return map_x(L, u, nM, nwg, lat); }
    __host__ __device__ bool next(int i, Unit& u) const { return map((long)i * G + c, u); }
    __device__ __forceinline__ void a_ready(const Unit&) const {}
    __device__ __forceinline__ void done(const Unit&) const {}
};
struct InOrder : StaticOrder {
    __host__ __device__ bool next(int i, Unit& u) const { const long L = (long)i * G + c; if (L < nwg) return map(L, u);
        if (!lat) return false; const int idx = (int)(L - nwg); if (idx >= 4 * 28) return false;
        const int bb = idx / 28, j = idx - bb * 28; u.pm = 9 * bb + 8; u.z = 0; u.sp = 0; u.pn = j < 8 ? j : j < 16 ? 16 + j : j < 24 ? 16 + j : j < 26 ? 40 + j : 40 + j; return true; }
};
struct FixedOrder : StaticOrder {
    __host__ __device__ bool next(int i, Unit& u) const { if (!StaticOrder::next(i, u)) return false; u.pm = 0; u.pn = 0; return true; }
};
struct MergeOrder : StaticOrder {
    __host__ __device__ bool split_ok() const { return SPLIT_CTX && !lat && nM == 36 && nN == 8 && G == 256; }
    __host__ __device__ bool next(int i, Unit& u) const {
        if (!split_ok()) { const int it = i / 3; if (!StaticOrder::next(it, u)) return false; u.z = i - 3 * it; return true; }
        if (i < 3) { if (!map_x((long)c, u, 32, 256, true)) return false; u.z = i; return true; }
        if (i > 3 || c >= 96) return false;
        const int s = c & 31; u.pm = 9 * (s >> 3) + 8; u.pn = s & 7; u.z = c >> 5; u.sp = 1; return true; }
};
struct SplitOutOrder : StaticOrder {
    __host__ __device__ bool split_ok() const { return SPLIT_CTX && !lat && nM == 36 && nN == 8 && G == 256; }
    __host__ __device__ bool next(int i, Unit& u) const {
        if (!split_ok()) return StaticOrder::next(i, u);
        if (i == 0) return map_x((long)c, u, 32, 256, true);
        if (i > 1 || c >= 96) return false;
        const int s = c & 31; u.pm = 9 * (s >> 3) + 8; u.pn = s & 7; u.z = 1 + (c >> 5); u.sp = 1; return true; }
};
__device__ __forceinline__ unsigned cvt_pk_bf16(float lo, float hi) { unsigned r; asm volatile("v_cvt_pk_bf16_f32 %0, %1, %2" : "=v"(r) : "v"(lo), "v"(hi)); return r; }
__device__ __forceinline__ float bflo(unsigned w) { return __uint_as_float(w << 16); }
__device__ __forceinline__ float bfhi(unsigned w) { return __uint_as_float(w & 0xffff0000u); }
__device__ __forceinline__ float sigmoid_f(float x) { return __builtin_amdgcn_rcpf(1.f + __expf(-x)); }

template <bool NHALF> struct EpiF32 {
    static constexpr bool PERM = false, AFTER_DRAIN = false;
    float* C; int ldc; size_t slab;
    __device__ __forceinline__ void operator()(const f32x4 (&acc)[2][2][4][2], const Unit& u, int wr, int wc, int fr, int fq) const {
        const int row0 = u.pm * BM + wr * 64 + fr, col0 = u.pn * (NHALF ? HALF : BM) + wc * 32 + 4 * fq;
        float* Cb = C + (u.sp ? (size_t)(u.z - 1) * slab : (size_t)0);
#pragma unroll
        for (int ai = 0; ai < 2; ++ai)
#pragma unroll
            for (int m = 0; m < 4; ++m) { float* rowp = Cb + (size_t)(row0 + ai * HALF + m * 16) * ldc + col0;
#pragma unroll
                for (int bj = 0; bj < (NHALF ? 1 : 2); ++bj)
#pragma unroll
                    for (int n = 0; n < 2; ++n) *(f32x4*)(rowp + bj * HALF + n * 16) = acc[ai][bj][m][n]; }
    }
};
struct EpiNull {
    static constexpr bool PERM = true, AFTER_DRAIN = false; float* sink;
    __device__ __forceinline__ void operator()(const f32x4 (&acc)[2][2][4][2], const Unit& u, int wr, int wc, int fr, int fq) const {
        float s = 0.f;
#pragma unroll
        for (int ai = 0; ai < 2; ++ai)
#pragma unroll
            for (int bj = 0; bj < 2; ++bj)
#pragma unroll
                for (int m = 0; m < 4; ++m)
#pragma unroll
                    for (int n = 0; n < 2; ++n) s += acc[ai][bj][m][n][0] + acc[ai][bj][m][n][1] + acc[ai][bj][m][n][2] + acc[ai][bj][m][n][3];
        if (s == 123.456f) sink[0] = s; }
};
template <long X8D> struct EpiIn {
    static constexpr bool PERM = true, AFTER_DRAIN = false;
    bf16_t* O;
    __device__ __forceinline__ void operator()(const f32x4 (&acc)[2][2][4][2], const Unit& u, int wr, int wc, int fr, int fq) const {
        const int pn = u.pn;
        int act = 0;
        if ((pn >= 8 && pn < 16) || (pn >= 48 && pn < 56) || (pn >= 68 && pn < 76)) act = 1;
        else if ((pn >= 40 && pn < 48) || pn >= 76) act = 2;
        else if (pn >= 24 && pn < 32) act = 3;
        const bool blocked = pn >= 16 && pn < 40;
        bf16_t* base = blocked ? O + X8D + (size_t)((pn - 16) >> 3) * MROWS * DM + ((size_t)((u.pm / 9) * 8 + ((pn - 16) & 7)) * 36 + (u.pm % 9) * 4) * (32 * 64 * 8)
                               : O + (size_t)u.pm * BM * NP + (size_t)pn * BM;
        const unsigned lane_off = blocked ? (unsigned)(wr * (32 * 64 * 8) + ((wc * 4 + fq) * 64 + fr) * 8) : (unsigned)((wr * 64 + fr) * NP + wc * 32 + 8 * fq);
        const unsigned sa = blocked ? 2u * 32 * 64 * 8 : (unsigned)HALF * NP, sm = blocked ? 16u * 8 : 16u * NP, sb = blocked ? 16u * 64 * 8 : (unsigned)HALF;
#pragma unroll
        for (int ai = 0; ai < 2; ++ai)
#pragma unroll
            for (int m = 0; m < 4; ++m) {
#pragma unroll
                for (int bj = 0; bj < 2; ++bj) { f32x4 v0 = acc[ai][bj][m][0], v1 = acc[ai][bj][m][1];
                    if (act == 1) {
#pragma unroll
                        for (int j = 0; j < 4; ++j) { v0[j] = v0[j] * sigmoid_f(v0[j]); v1[j] = v1[j] * sigmoid_f(v1[j]); } }
                    else if (act == 2) {
#pragma unroll
                        for (int j = 0; j < 4; ++j) { v0[j] = sigmoid_f(v0[j]); v1[j] = sigmoid_f(v1[j]); } }
                    else if (act == 3) { v0 = v0 * 0.0625f; v1 = v1 * 0.0625f; }
                    u32x4 w; w.x = cvt_pk_bf16(v0[0], v0[1]); w.y = cvt_pk_bf16(v0[2], v0[3]); w.z = cvt_pk_bf16(v1[0], v1[1]); w.w = cvt_pk_bf16(v1[2], v1[3]);
                    *(u32x4*)(base + (lane_off + ai * sa + m * sm + bj * sb)) = w; } }
    }
};
template <bool NHALF> struct EpiMerge {
    static constexpr bool PERM = true, AFTER_DRAIN = false;
    const bf16_t* P; float* ACC; bf16_t* G2;
    __device__ __forceinline__ void operator()(const f32x4 (&acc)[2][2][4][2], const Unit& u, int wr, int wc, int fr, int fq) const {
        const int row0 = u.pm * BM + wr * 64 + fr, col0 = u.pn * (NHALF ? HALF : BM) + wc * 32 + 8 * fq, z = u.z;
#pragma unroll
        for (int ai = 0; ai < 2; ++ai)
#pragma unroll
            for (int m = 0; m < 4; ++m) { const size_t r = (size_t)(row0 + ai * HALF + m * 16);
#pragma unroll
                for (int bj = 0; bj < (NHALF ? 1 : 2); ++bj) { const int c = col0 + bj * HALF;
                    const u32x4 g = *(const u32x4*)(P + r * NP + C_MG + z * DM + c);
                    f32x4 v0 = acc[ai][bj][m][0], v1 = acc[ai][bj][m][1];
                    v0[0] *= bflo(g.x); v0[1] *= bfhi(g.x); v0[2] *= bflo(g.y); v0[3] *= bfhi(g.y);
                    v1[0] *= bflo(g.z); v1[1] *= bfhi(g.z); v1[2] *= bflo(g.w); v1[3] *= bfhi(g.w);
                    if (u.sp) { u32x4 w; w.x = cvt_pk_bf16(v0[0], v0[1]); w.y = cvt_pk_bf16(v0[2], v0[3]); w.z = cvt_pk_bf16(v1[0], v1[1]); w.w = cvt_pk_bf16(v1[2], v1[3]);
                        *(u32x4*)(G2 + (size_t)(1 + z) * MROWS * DM + r * DM + c) = w;
                        continue; }
                    float* ap = ACC + r * DM + c;
                    if (z > 0) { v0 = v0 + *(const f32x4*)ap; v1 = v1 + *(const f32x4*)(ap + 4); }
                    if (z < 2) { *(f32x4*)ap = v0; *(f32x4*)(ap + 4) = v1; }
                    else { u32x4 w; w.x = cvt_pk_bf16(v0[0], v0[1]); w.y = cvt_pk_bf16(v0[2], v0[3]); w.z = cvt_pk_bf16(v1[0], v1[1]); w.w = cvt_pk_bf16(v1[2], v1[3]);
                        *(u32x4*)(G2 + r * DM + c) = w; } } }
    }
};
struct EpiMergeC {
    static constexpr bool PERM = true, AFTER_DRAIN = false, CHAIN = true;
    static constexpr int DEPTH_PF = 4;
    const bf16_t* P; bf16_t* G2;
    __device__ __forceinline__ static bool keep(const Unit& u) { return !u.sp && u.z < 2; }
    __device__ __forceinline__ static void unpack8(const u32x4 g, float (&s)[8]) { s[0] = bflo(g.x); s[1] = bfhi(g.x); s[2] = bflo(g.y); s[3] = bfhi(g.y); s[4] = bflo(g.z); s[5] = bfhi(g.z); s[6] = bflo(g.w); s[7] = bfhi(g.w); }
    __device__ __forceinline__ void operator()(f32x4 (&acc)[2][2][4][2], const Unit& u, int wr, int wc, int fr, int fq) const {
        const int row0 = u.pm * BM + wr * 64 + fr, col0 = u.pn * BM + wc * 32 + 8 * fq, z = u.z;
        constexpr float FLOOR = 1e-12f;
        const bf16_t* gp0 = P + (size_t)row0 * NP + C_MG + z * DM + col0;
        const bool chain = !u.sp && z < 2;
        bf16_t* O = G2 + (u.sp ? (size_t)(1 + z) * MROWS * DM : (size_t)0) + (size_t)row0 * DM + col0;
        u32x4 gq[DEPTH_PF], hq[DEPTH_PF];
#define EMC_OFF(t) ((size_t)((((t) >> 3) & 1) * HALF + (((t) >> 1) & 3) * 16) * NP + ((t) & 1) * HALF)
#define EMC_LOAD(t) do { gq[(t) % DEPTH_PF] = *(const u32x4*)(gp0 + EMC_OFF(t)); if (chain) hq[(t) % DEPTH_PF] = *(const u32x4*)(gp0 + EMC_OFF(t) + DM); } while (0)
#pragma unroll
        for (int t = 0; t < DEPTH_PF - 1; ++t) EMC_LOAD(t);
#pragma unroll
        for (int t = 0; t < 16; ++t) { const int ai = (t >> 3) & 1, m = (t >> 1) & 3, bj = t & 1;
            if (t + DEPTH_PF - 1 < 16) EMC_LOAD(t + DEPTH_PF - 1);
            float s[8]; unpack8(gq[t % DEPTH_PF], s);
            if (chain) { float d[8]; unpack8(hq[t % DEPTH_PF], d);
#pragma unroll
                for (int j = 0; j < 8; ++j) s[j] = fmaxf(s[j], FLOOR) * __builtin_amdgcn_rcpf(fmaxf(d[j], FLOOR));
#pragma unroll
                for (int j = 0; j < 4; ++j) { acc[ai][bj][m][0][j] *= s[j]; acc[ai][bj][m][1][j] *= s[4 + j]; } }
            else { if (!u.sp) {
#pragma unroll
                    for (int j = 0; j < 8; ++j) s[j] = fmaxf(s[j], FLOOR); }
                f32x4 v0 = acc[ai][bj][m][0], v1 = acc[ai][bj][m][1];
#pragma unroll
                for (int j = 0; j < 4; ++j) { v0[j] *= s[j]; v1[j] *= s[4 + j]; }
                u32x4 w; w.x = cvt_pk_bf16(v0[0], v0[1]); w.y = cvt_pk_bf16(v0[2], v0[3]); w.z = cvt_pk_bf16(v1[0], v1[1]); w.w = cvt_pk_bf16(v1[2], v1[3]);
                *(u32x4*)(O + (size_t)(ai * HALF + m * 16) * DM + bj * HALF) = w; } }
#undef EMC_OFF
#undef EMC_LOAD
    }
};
struct EpiY16 {
    static constexpr bool PERM = true, AFTER_DRAIN = false;
    bf16_t* Y; size_t slab;
    __device__ __forceinline__ void operator()(const f32x4 (&acc)[2][2][4][2], const Unit& u, int wr, int wc, int fr, int fq) const {
        const int row0 = u.pm * BM + wr * 64 + fr, col0 = u.pn * BM + wc * 32 + 8 * fq;
        bf16_t* Yb = Y + (u.sp ? (size_t)(u.z - 1) * slab : (size_t)0);
#pragma unroll
        for (int ai = 0; ai < 2; ++ai)
#pragma unroll
            for (int m = 0; m < 4; ++m) { bf16_t* rowp = Yb + (size_t)(row0 + ai * HALF + m * 16) * DM + col0;
#pragma unroll
                for (int bj = 0; bj < 2; ++bj) { const f32x4 v0 = acc[ai][bj][m][0], v1 = acc[ai][bj][m][1];
                    u32x4 w; w.x = cvt_pk_bf16(v0[0], v0[1]); w.y = cvt_pk_bf16(v0[2], v0[3]); w.z = cvt_pk_bf16(v1[0], v1[1]); w.w = cvt_pk_bf16(v1[2], v1[3]);
                    *(u32x4*)(rowp + bj * HALF) = w; } }
    }
};
template <class T, class = void> struct epi_chain { static constexpr bool value = false; };
template <class T> struct epi_chain<T, decltype((void)T::CHAIN)> { static constexpr bool value = T::CHAIN; };
template <class Epi, class Sched, bool ALIGN_EPI = false, bool SP2 = false, bool NHALF = false>
__device__ __forceinline__ void gemm_phase(PG8_LAS unsigned char* lds, const Gemm g, const Sched& S, const Epi& E) {
    int tid = threadIdx.x; asm volatile("" : "+v"(tid));
    const int wid = __builtin_amdgcn_readfirstlane(tid >> 6), lane = tid & 63, wr = wid >> 2, wc = wid & 3, fr = lane & 15, fq = lane >> 4;
    const int K = g.K, nt = K / BK;
    unsigned voffA[2], voffB[2];
#pragma unroll
    for (int i = 0; i < 2; ++i) { int R, C; stage_rc(tid * 16 + i * 8192, R, C); const int Rb = Epi::PERM ? ((R & ~31) + perm32(R & 31)) : R;
        voffA[i] = (unsigned)(R * K + C) * 2u; voffB[i] = (unsigned)(Rb * K + C) * 2u; }
    const size_t kstep = (size_t)(BK * 2);
    const size_t hstep = (size_t)HALF * K * 2;
    const size_t tstep = 2 * hstep;
    const size_t hsB = NHALF ? 0 : hstep, tstepB = NHALF ? hstep : tstep; static_assert(!NHALF || SP2, "NHALF is implemented for the SP2 loop");
    const unsigned ldsw = (unsigned)wid * 1024u;
    const int aoff = lds_byte(wr * 64 + fr, fq * 8), boff = lds_byte(wc * 32 + fr, fq * 8);
#define PG8_SA(b, h) (((b) * 2 + (h)) * HTB)
#define PG8_SB(b, h) ((4 + (b) * 2 + (h)) * HTB)
#define PG8_STAGE(bufoff, gbase, voff) do { _Pragma("unroll") for (int _i = 0; _i < 2; ++_i) \
        __builtin_amdgcn_global_load_lds((const unsigned*)((const char*)(gbase) + (voff)[_i]), (PG8_LAS unsigned*)(lds + (bufoff) + ldsw + _i * 8192), 16, 0, 0); } while (0)
#define PG8_LDA(dst, b, h) do { _Pragma("unroll") for (int m = 0; m < 4; ++m) _Pragma("unroll") for (int k = 0; k < 2; ++k) dst[m][k] = *(const PG8_LAS bf16x8*)(lds + PG8_SA(b, h) + aoff + m * 2048 + k * 1024); } while (0)
#define PG8_LDB(dst, b, h) do { _Pragma("unroll") for (int n = 0; n < 2; ++n) _Pragma("unroll") for (int k = 0; k < 2; ++k) dst[n][k] = *(const PG8_LAS bf16x8*)(lds + PG8_SB(b, h) + boff + n * 2048 + k * 1024); } while (0)
#define PG8_MMA(ai, bj, At, Bt) do { __builtin_amdgcn_s_setprio(1); _Pragma("unroll") for (int m = 0; m < 4; ++m) _Pragma("unroll") for (int n = 0; n < 2; ++n) _Pragma("unroll") for (int k = 0; k < 2; ++k) \
        acc[ai][bj][m][n] = __builtin_amdgcn_mfma_f32_16x16x32_bf16(Bt[n][k], At[m][k], acc[ai][bj][m][n], 0, 0, 0); __builtin_amdgcn_s_setprio(0); } while (0)
#define PG8_WAIT_V(n) asm volatile("s_waitcnt vmcnt(" #n ")" ::: "memory")
#define PG8_WAIT_L(n) asm volatile("s_waitcnt lgkmcnt(" #n ")" ::: "memory")
#define PG8_BAR __builtin_amdgcn_s_barrier()
#define PG8_SCHED __builtin_amdgcn_sched_barrier(0)
    Unit cur, nxt; int ui = 0;
    if (!S.next(0, cur)) return;
    f32x4 acc[2][2][4][2];
#pragma unroll
    for (int a = 0; a < 2; ++a)
#pragma unroll
        for (int b = 0; b < 2; ++b)
#pragma unroll
            for (int m = 0; m < 4; ++m)
#pragma unroll
                for (int n = 0; n < 2; ++n) acc[a][b][m][n] = (f32x4){0.f, 0.f, 0.f, 0.f};
    bf16x8 At[4][2], B0[2][2], B1[2][2];
    const char* cA = (const char*)g.A + (size_t)cur.z * g.zA + (size_t)cur.pm * tstep; const char* cB = (const char*)g.Bt + (size_t)cur.z * g.zB + (size_t)cur.pn * tstepB;
    S.a_ready(cur);
    if constexpr (SP2) {
        PG8_STAGE(PG8_SB(0, 0), cB, voffB); PG8_STAGE(PG8_SB(0, 1), cB + hsB, voffB); PG8_STAGE(PG8_SA(0, 0), cA, voffA); PG8_STAGE(PG8_SA(0, 1), cA + hstep, voffA);
        if (wr == 1) PG8_BAR;
        PG8_WAIT_V(2); PG8_BAR;
        PG8_STAGE(PG8_SB(1, 0), cB + kstep, voffB); PG8_STAGE(PG8_SA(1, 0), cA + kstep, voffA); PG8_STAGE(PG8_SB(1, 1), cB + hsB + kstep, voffB);
        PG8_WAIT_V(6); PG8_BAR;
    } else {
        PG8_STAGE(PG8_SB(0, 0), cB, voffB); PG8_STAGE(PG8_SA(0, 0), cA, voffA); PG8_STAGE(PG8_SB(0, 1), cB + hstep, voffB); PG8_STAGE(PG8_SA(0, 1), cA + hstep, voffA);
        if (wr == 1) PG8_BAR;
        PG8_WAIT_V(4); PG8_BAR;
        PG8_STAGE(PG8_SB(1, 0), cB + kstep, voffB); PG8_STAGE(PG8_SA(1, 0), cA + kstep, voffA); PG8_STAGE(PG8_SB(1, 1), cB + hstep + kstep, voffB);
        PG8_WAIT_V(6); PG8_BAR;
    }
    for (;;) {
        const bool has_next = S.next(ui + 1, nxt);
        const char* nA = has_next ? (const char*)g.A + (size_t)nxt.z * g.zA + (size_t)nxt.pm * tstep : cA; const char* nB = has_next ? (const char*)g.Bt + (size_t)nxt.z * g.zB + (size_t)nxt.pn * tstepB : cB;
        for (int t = 0; t < nt; t += 2) {
            const bool last = (t == nt - 2);
            const char* a1 = cA + (size_t)(t + 1) * kstep;
            const char* a2 = last ? nA : cA + (size_t)(t + 2) * kstep; const char* b2 = last ? nB : cB + (size_t)(t + 2) * kstep;
            const char* a3 = a2 + kstep; const char* b3 = b2 + kstep;
            if (last && has_next) S.a_ready(nxt);
            if constexpr (SP2) {
            PG8_LDB(B0, 0, 0); if constexpr (!NHALF) PG8_LDB(B1, 0, 1); PG8_SCHED; PG8_LDA(At, 0, 0); PG8_STAGE(PG8_SA(1, 1), a1 + hstep, voffA);
            PG8_WAIT_V(8); PG8_WAIT_L(0); PG8_BAR; PG8_MMA(0, 0, At, B0); if constexpr (!NHALF) PG8_MMA(0, 1, At, B1); PG8_BAR; PG8_SCHED;
            PG8_LDA(At, 0, 1); PG8_STAGE(PG8_SB(0, 0), b2, voffB); PG8_STAGE(PG8_SB(0, 1), b2 + hsB, voffB); PG8_STAGE(PG8_SA(0, 0), a2, voffA);
            PG8_WAIT_V(8); PG8_WAIT_L(0); PG8_BAR; PG8_MMA(1, 0, At, B0); if constexpr (!NHALF) PG8_MMA(1, 1, At, B1); PG8_BAR; PG8_SCHED;
            PG8_LDB(B0, 1, 0); if constexpr (!NHALF) PG8_LDB(B1, 1, 1); PG8_SCHED; PG8_LDA(At, 1, 0); PG8_STAGE(PG8_SA(0, 1), a2 + hstep, voffA);
            PG8_WAIT_V(8); PG8_WAIT_L(0); PG8_BAR; PG8_MMA(0, 0, At, B0); if constexpr (!NHALF) PG8_MMA(0, 1, At, B1); PG8_BAR; PG8_SCHED;
            PG8_LDA(At, 1, 1); PG8_STAGE(PG8_SB(1, 0), b3, voffB); PG8_STAGE(PG8_SB(1, 1), b3 + hsB, voffB); PG8_STAGE(PG8_SA(1, 0), a3, voffA);
            PG8_WAIT_V(8); PG8_WAIT_L(0); PG8_BAR; PG8_MMA(1, 0, At, B0); if constexpr (!NHALF) PG8_MMA(1, 1, At, B1); PG8_BAR; PG8_SCHED;
            } else {
            PG8_LDB(B0, 0, 0); PG8_SCHED; PG8_LDA(At, 0, 0); PG8_STAGE(PG8_SA(1, 1), a1 + hstep, voffA);
            PG8_WAIT_L(8); PG8_BAR; PG8_WAIT_L(0); PG8_MMA(0, 0, At, B0); PG8_BAR; PG8_SCHED;
            PG8_LDB(B1, 0, 1); PG8_STAGE(PG8_SB(0, 0), b2, voffB);
            PG8_BAR; PG8_WAIT_L(0); PG8_MMA(0, 1, At, B1); PG8_BAR;
            PG8_LDA(At, 0, 1); PG8_STAGE(PG8_SA(0, 0), a2, voffA);
            PG8_BAR; PG8_WAIT_L(0); PG8_MMA(1, 0, At, B0); PG8_BAR; PG8_SCHED;
            PG8_STAGE(PG8_SB(0, 1), b2 + hstep, voffB);
            PG8_WAIT_V(6); PG8_BAR; PG8_MMA(1, 1, At, B1); PG8_BAR;
            PG8_LDB(B0, 1, 0); PG8_SCHED; PG8_LDA(At, 1, 0); PG8_STAGE(PG8_SA(0, 1), a2 + hstep, voffA);
            PG8_WAIT_L(8); PG8_BAR; PG8_WAIT_L(0); PG8_MMA(0, 0, At, B0); PG8_BAR; PG8_SCHED;
            PG8_LDB(B1, 1, 1); PG8_STAGE(PG8_SB(1, 0), b3, voffB);
            PG8_BAR; PG8_WAIT_L(0); PG8_MMA(0, 1, At, B1); PG8_BAR;
            PG8_LDA(At, 1, 1); PG8_STAGE(PG8_SA(1, 0), a3, voffA);
            PG8_BAR; PG8_WAIT_L(0); PG8_MMA(1, 0, At, B0); PG8_BAR; PG8_SCHED;
            PG8_STAGE(PG8_SB(1, 1), b3 + hstep, voffB);
            PG8_WAIT_V(6); PG8_BAR; PG8_MMA(1, 1, At, B1); PG8_BAR;
            }
        }
        if constexpr (ALIGN_EPI) { if (wr == 0) PG8_BAR; }
        if constexpr (!Epi::AFTER_DRAIN) { E(acc, cur, wr, wc, fr, fq); S.done(cur); }
        if (!has_next) break;
        bool clear = true; if constexpr (epi_chain<Epi>::value) clear = !Epi::keep(cur);
        if (clear) {
#pragma unroll
        for (int a = 0; a < 2; ++a)
#pragma unroll
            for (int b = 0; b < 2; ++b)
#pragma unroll
                for (int m = 0; m < 4; ++m)
#pragma unroll
                    for (int n = 0; n < 2; ++n) acc[a][b][m][n] = (f32x4){0.f, 0.f, 0.f, 0.f};
        }
        cur = nxt; cA = nA; cB = nB; ++ui;
        if constexpr (ALIGN_EPI) { if (wr == 1) PG8_BAR; }
    }
    PG8_WAIT_V(0);
    if constexpr (!ALIGN_EPI) { if (wr == 0) PG8_BAR; }
    PG8_BAR;
    if constexpr (Epi::AFTER_DRAIN) { E.fused(acc, cur, wr, wc, fr, fq, lds, wid, lane); S.done(cur); }
#undef PG8_SA
#undef PG8_SB
#undef PG8_STAGE
#undef PG8_LDA
#undef PG8_LDB
#undef PG8_MMA
#undef PG8_WAIT_V
#undef PG8_WAIT_L
#undef PG8_BAR
#undef PG8_SCHED
}
}

namespace att {
using bf16 = __hip_bfloat16;
constexpr int   D = 128, NW = 8, QBLK = 32, KVBLK = 64;
constexpr float SCALE = 0.088388347648318440f;
constexpr float THR = 8.f;
#ifndef ATT_SDEPTH
#define ATT_SDEPTH 1
#endif
constexpr int SDEPTH = ATT_SDEPTH;
constexpr int LDQ = NP, LDK = NP, LDO = DM;
constexpr size_t SHM_V = KVBLK * D * 2, SHM_K = KVBLK * D * 2, SHM_ATTN = 2 * SHM_V + 2 * SHM_K + NW * 64 * 4;
constexpr int OST_OFF = 69632, OST_END = OST_OFF + NW * 32 * 272;
using bf16x8 = __attribute__((ext_vector_type(8))) short;
using s16x4  = __attribute__((ext_vector_type(4))) short;
using f32x16 = __attribute__((ext_vector_type(16))) float;
using f32x4  = __attribute__((ext_vector_type(4))) float;
using u32x4  = __attribute__((ext_vector_type(4))) unsigned;
#define KSWZ(row, colB) ((row) * 256 + ((colB) ^ (((row) & 7) << 4)))
#define SBAR() __builtin_amdgcn_sched_barrier(0)
__device__ __forceinline__ int crow(int r, int hi) { return (r & 3) + 8 * (r >> 2) + 4 * hi; }
__device__ __forceinline__ unsigned cvtpk(float lo, float hi) { unsigned r; asm volatile("v_cvt_pk_bf16_f32 %0, %1, %2" : "=v"(r) : "v"(lo), "v"(hi)); return r; }
__device__ __forceinline__ bf16x8 ld8(const bf16* p) { return *reinterpret_cast<const bf16x8*>(p); }

__device__ __forceinline__ void partialSM(f32x16& p0, f32x16& p1, float& m_reg, float& mn, float& alpha) {
  constexpr float C = SCALE * 1.4426950408889634f;
  float pmax = p0[0];
#pragma unroll
  for (int r = 1; r < 16; ++r) pmax = fmaxf(pmax, p0[r]);
#pragma unroll
  for (int r = 0; r < 16; ++r) pmax = fmaxf(pmax, p1[r]);
  { auto rr = __builtin_amdgcn_permlane32_swap(__float_as_uint(pmax), __float_as_uint(pmax), false, false);
    pmax = fmaxf(__uint_as_float(rr[0]), __uint_as_float(rr[1])); }
  if (__builtin_expect(__all(pmax - m_reg <= THR / SCALE), 1)) { mn = m_reg; alpha = 1.f; }
  else { mn = fmaxf(m_reg, pmax); alpha = __builtin_amdgcn_exp2f((m_reg - mn) * C); m_reg = mn; }
  float mnC = -mn * C;
#pragma unroll
  for (int r = 0; r < 16; ++r) p0[r] = fmaf(p0[r], C, mnC);
#pragma unroll
  for (int r = 0; r < 16; ++r) p1[r] = fmaf(p1[r], C, mnC);
#pragma unroll
  for (int r = 0; r < 16; ++r) p0[r] = __builtin_amdgcn_exp2f(p0[r]);
}
__device__ __forceinline__ void finishSM(f32x16& p0, f32x16& p1, float alpha, float& l_reg, bf16x8& pa0, bf16x8& pa1, bf16x8& pa2, bf16x8& pa3) {
#pragma unroll
  for (int r = 0; r < 16; ++r) p1[r] = __builtin_amdgcn_exp2f(p1[r]);
  float ps = 0;
#pragma unroll
  for (int r = 0; r < 16; ++r) ps += p0[r];
#pragma unroll
  for (int r = 0; r < 16; ++r) ps += p1[r];
  { auto rr = __builtin_amdgcn_permlane32_swap(__float_as_uint(ps), __float_as_uint(ps), false, false);
    ps = __uint_as_float(rr[0]) + __uint_as_float(rr[1]); }
  l_reg = l_reg * alpha + ps;
#define PK4(P, BASE, OUT) do { unsigned a0 = cvtpk(P[BASE + 0], P[BASE + 1]), a1 = cvtpk(P[BASE + 2], P[BASE + 3]);   \
    unsigned b0 = cvtpk(P[BASE + 4], P[BASE + 5]), b1 = cvtpk(P[BASE + 6], P[BASE + 7]);                              \
    auto r0 = __builtin_amdgcn_permlane32_swap(a0, b0, false, false); auto r1 = __builtin_amdgcn_permlane32_swap(a1, b1, false, false); \
    u32x4 w = {r0[0], r1[0], r0[1], r1[1]}; OUT = *reinterpret_cast<bf16x8*>(&w); } while (0)
  PK4(p0, 0, pa0); PK4(p0, 8, pa1); PK4(p1, 0, pa2); PK4(p1, 8, pa3);
#undef PK4
}
__device__ __forceinline__ void qkt(f32x16& p0, f32x16& p1, const bf16* Ks, const bf16x8* qr, int r32, int hi) {
  p0 = f32x16{}; p1 = f32x16{};
#pragma unroll
  for (int d0 = 0; d0 < 8; ++d0) { int cb = (d0 * 16 + hi * 8) * 2;
    bf16x8 b0 = *reinterpret_cast<const bf16x8*>((const char*)Ks + KSWZ(r32, cb));
    bf16x8 b1 = *reinterpret_cast<const bf16x8*>((const char*)Ks + KSWZ(32 + r32, cb));
    p0 = __builtin_amdgcn_mfma_f32_32x32x16_bf16(b0, qr[d0], p0, 0, 0, 0);
    p1 = __builtin_amdgcn_mfma_f32_32x32x16_bf16(b1, qr[d0], p1, 0, 0, 0); }
}
__device__ __forceinline__ int v_st(int k, int c) { const int kk = (k & ~0xC) | ((k & 4) << 1) | ((k & 8) >> 1); return ((kk >> 3) * 4 + (c >> 5)) * 512 + ((kk & 7) * 32 + (c & 31)) * 2; }
__device__ __forceinline__ int v_rd_base(int lane) { return ((lane & 3) << 3) | (((lane >> 2) & 3) << 6) | (((lane >> 4) & 1) << 5) | (((lane >> 5) & 1) << 8); }
constexpr int v_rd_off(int d0, int ks, int half) { return d0 * 512 + ks * 4096 + half * 2048; }
template <int OFF> __device__ __forceinline__ s16x4 tr_read(int vb) {
  s16x4 r; asm volatile("ds_read_b64_tr_b16 %0, %1 offset:%2" : "=&v"(r) : "v"(vb), "i"(OFF) : "memory"); return r;
}
template <int D0> __device__ __forceinline__ void pv_one(f32x16& od, int vb, bf16x8 pa0, bf16x8 pa1, bf16x8 pa2, bf16x8 pa3) {
  const s16x4 l0 = tr_read<v_rd_off(D0, 0, 0)>(vb), h0 = tr_read<v_rd_off(D0, 0, 1)>(vb), l1 = tr_read<v_rd_off(D0, 1, 0)>(vb), h1 = tr_read<v_rd_off(D0, 1, 1)>(vb);
  const s16x4 l2 = tr_read<v_rd_off(D0, 2, 0)>(vb), h2 = tr_read<v_rd_off(D0, 2, 1)>(vb), l3 = tr_read<v_rd_off(D0, 3, 0)>(vb), h3 = tr_read<v_rd_off(D0, 3, 1)>(vb);
  asm volatile("s_waitcnt lgkmcnt(0)" ::: "memory"); SBAR();
#define PK(L, H) (bf16x8){L[0], L[1], L[2], L[3], H[0], H[1], H[2], H[3]}
  od = __builtin_amdgcn_mfma_f32_32x32x16_bf16(pa0, PK(l0, h0), od, 0, 0, 0);
  od = __builtin_amdgcn_mfma_f32_32x32x16_bf16(pa1, PK(l1, h1), od, 0, 0, 0);
  od = __builtin_amdgcn_mfma_f32_32x32x16_bf16(pa2, PK(l2, h2), od, 0, 0, 0);
  od = __builtin_amdgcn_mfma_f32_32x32x16_bf16(pa3, PK(l3, h3), od, 0, 0, 0);
#undef PK
}
__device__ __forceinline__ void pv_d0(f32x16* o, int vb, bf16x8 pa0, bf16x8 pa1, bf16x8 pa2, bf16x8 pa3) {
  pv_one<0>(o[0], vb, pa0, pa1, pa2, pa3); pv_one<1>(o[1], vb, pa0, pa1, pa2, pa3); pv_one<2>(o[2], vb, pa0, pa1, pa2, pa3); pv_one<3>(o[3], vb, pa0, pa1, pa2, pa3);
}

__device__ __forceinline__ void attn_unit(const bf16* __restrict__ Qb, const bf16* __restrict__ Kh, const bf16* __restrict__ Vh, const bf16* __restrict__ Zb,
                                          bf16* __restrict__ Ob, int seq, char* lds, const float* __restrict__ qn, const float* __restrict__ cs, const float* __restrict__ sn) {
  int tid = threadIdx.x; asm volatile("" : "+v"(tid));
  int wid = tid >> 6, lane = tid & 63, r32 = lane & 31, hi = lane >> 5;
  bf16* V_lds = (bf16*)lds; bf16* K_lds = (bf16*)(lds + 2 * SHM_V);
  float* ws = (float*)(lds + 2 * SHM_V + 2 * SHM_K) + wid * 64; float* li_l = ws; float* al_l = ws + 32;
  float m_reg = -1e30f, l_reg = 0; f32x16 o[4] = {}; bf16x8 qr[8];
  {
    const bf16* Qw = Qb + (long)(wid * QBLK + r32) * LDQ + hi * 8;
    float ss = 0.f;
#pragma unroll
    for (int d0 = 0; d0 < 8; ++d0) { const u32x4 w = *reinterpret_cast<const u32x4*>(Qw + d0 * 16); qr[d0] = __builtin_bit_cast(bf16x8, w);
#pragma unroll
      for (int e = 0; e < 4; ++e) { const float lo = __uint_as_float(w[e] << 16), hh = __uint_as_float(w[e] & 0xffff0000u); ss += lo * lo + hh * hh; } }
    { auto rr = __builtin_amdgcn_permlane32_swap(__float_as_uint(ss), __float_as_uint(ss), false, false); ss = __uint_as_float(rr[0]) + __uint_as_float(rr[1]); }
    const float rs = rsqrtf(ss * (1.f / 128.f) + EPS);
    const float* cp = cs ? cs + (long)(wid * QBLK + r32) * 64 + hi * 8 : nullptr; const float* sp = cs ? sn + (long)(wid * QBLK + r32) * 64 + hi * 8 : nullptr;
#pragma unroll
    for (int d0 = 0; d0 < 4; ++d0) {
      const u32x4 wa = __builtin_bit_cast(u32x4, qr[d0]), wb = __builtin_bit_cast(u32x4, qr[d0 + 4]); float x1[8], x2[8];
#pragma unroll
      for (int e = 0; e < 4; ++e) { x1[2 * e] = __uint_as_float(wa[e] << 16); x1[2 * e + 1] = __uint_as_float(wa[e] & 0xffff0000u); x2[2 * e] = __uint_as_float(wb[e] << 16); x2[2 * e + 1] = __uint_as_float(wb[e] & 0xffff0000u); }
      const f32x4 ga0 = *reinterpret_cast<const f32x4*>(qn + d0 * 16 + hi * 8), ga1 = *reinterpret_cast<const f32x4*>(qn + d0 * 16 + hi * 8 + 4);
      const f32x4 gb0 = *reinterpret_cast<const f32x4*>(qn + 64 + d0 * 16 + hi * 8), gb1 = *reinterpret_cast<const f32x4*>(qn + 64 + d0 * 16 + hi * 8 + 4);
#pragma unroll
      for (int e = 0; e < 8; ++e) { x1[e] *= rs * (e < 4 ? ga0[e & 3] : ga1[e & 3]); x2[e] *= rs * (e < 4 ? gb0[e & 3] : gb1[e & 3]); }
      if (cs) {
        const f32x4 c0 = *reinterpret_cast<const f32x4*>(cp + d0 * 16), c1 = *reinterpret_cast<const f32x4*>(cp + d0 * 16 + 4);
        const f32x4 s0 = *reinterpret_cast<const f32x4*>(sp + d0 * 16), s1 = *reinterpret_cast<const f32x4*>(sp + d0 * 16 + 4);
#pragma unroll
        for (int e = 0; e < 8; ++e) { const float c = e < 4 ? c0[e & 3] : c1[e & 3], sv = e < 4 ? s0[e & 3] : s1[e & 3];
          const float a = x1[e], bq = x2[e]; x1[e] = a * c - bq * sv; x2[e] = bq * c + a * sv; }
      }
      const u32x4 oa = {cvtpk(x1[0], x1[1]), cvtpk(x1[2], x1[3]), cvtpk(x1[4], x1[5]), cvtpk(x1[6], x1[7])}, ob = {cvtpk(x2[0], x2[1]), cvtpk(x2[2], x2[3]), cvtpk(x2[4], x2[5]), cvtpk(x2[6], x2[7])};
      qr[d0] = __builtin_bit_cast(bf16x8, oa); qr[d0 + 4] = __builtin_bit_cast(bf16x8, ob);
      asm volatile("" ::: "memory");
    }
  }
  const int sr = tid >> 4, sc = (tid & 15) * 8, vst0 = v_st(sr, sc), vst1 = v_st(32 + sr, sc);
  const int vb0 = (int)(uintptr_t)V_lds + v_rd_base(lane);
  struct { bf16x8 vs0, vs1, ks0, ks1; } sr_[SDEPTH];
#define SLOAD(i, k0) do { sr_[i].vs0 = ld8(&Vh[(long)((k0) + sr) * LDK + sc]); sr_[i].vs1 = ld8(&Vh[(long)((k0) + 32 + sr) * LDK + sc]); \
    sr_[i].ks0 = ld8(&Kh[(long)((k0) + sr) * LDK + sc]); sr_[i].ks1 = ld8(&Kh[(long)((k0) + 32 + sr) * LDK + sc]); } while (0)
#define SWRITE(b, i) do { *(bf16x8*)((char*)V_lds + (b) * SHM_V + vst0) = sr_[i].vs0;          \
    *(bf16x8*)((char*)V_lds + (b) * SHM_V + vst1) = sr_[i].vs1; int kc = sc * 2;               \
    *(bf16x8*)((char*)K_lds + (b) * SHM_K + KSWZ(sr, kc)) = sr_[i].ks0;                       \
    *(bf16x8*)((char*)K_lds + (b) * SHM_K + KSWZ(32 + sr, kc)) = sr_[i].ks1; } while (0)
#define SWAIT() do { if constexpr (SDEPTH == 2) asm volatile("s_waitcnt vmcnt(4)" ::: "memory"); else asm volatile("s_waitcnt vmcnt(0)" ::: "memory"); } while (0)
#define RESC(a) do { if (__any((a) < 1.f)) { if (hi == 0) al_l[r32] = (a); asm volatile("s_waitcnt lgkmcnt(0)" ::: "memory"); \
    _Pragma("unroll") for (int d = 0; d < 4; ++d) _Pragma("unroll") for (int r = 0; r < 16; ++r) o[d][r] *= al_l[crow(r, hi)]; } } while (0)
  f32x16 pA0, pA1, pB0, pB1; float mnA, mnB, alA, alB; bf16x8 pa0, pa1, pa2, pa3; const int NT = seq / KVBLK;
  constexpr int SE = 0, SO = SDEPTH - 1;
  SLOAD(SE, 0); asm volatile("s_waitcnt vmcnt(0)" ::: "memory"); SWRITE(0, SE); __syncthreads();
  qkt(pA0, pA1, K_lds, qr, r32, hi); partialSM(pA0, pA1, m_reg, mnA, alA);
  SLOAD(SO, KVBLK); if constexpr (SDEPTH == 2) { if (2 < NT) SLOAD(SE, 2 * KVBLK); }
  SWAIT(); SWRITE(1, SO); __syncthreads();
  for (int j = 1; j + 1 < NT; j += 2) {
    SBAR(); qkt(pB0, pB1, (bf16*)((char*)K_lds + SHM_K), qr, r32, hi);
    finishSM(pA0, pA1, alA, l_reg, pa0, pa1, pa2, pa3); SBAR();
    SLOAD(SO, (j + SDEPTH) * KVBLK); SBAR();
    pv_d0(o, vb0, pa0, pa1, pa2, pa3); partialSM(pB0, pB1, m_reg, mnB, alB);
    __syncthreads(); SWAIT(); SWRITE(0, SE);
    RESC(alB); __syncthreads();
    SBAR(); qkt(pA0, pA1, K_lds, qr, r32, hi);
    finishSM(pB0, pB1, alB, l_reg, pa0, pa1, pa2, pa3); SBAR();
    if (SDEPTH == 1 || j + 3 < NT) SLOAD(SE, (j + 1 + SDEPTH) * KVBLK); SBAR();
    pv_d0(o, vb0 + (int)SHM_V, pa0, pa1, pa2, pa3); partialSM(pA0, pA1, m_reg, mnA, alA);
    __syncthreads(); SWAIT(); SWRITE(1, SO);
    RESC(alA); __syncthreads();
  }
  SBAR(); qkt(pB0, pB1, (bf16*)((char*)K_lds + SHM_K), qr, r32, hi);
  finishSM(pA0, pA1, alA, l_reg, pa0, pa1, pa2, pa3); SBAR();
  pv_d0(o, vb0, pa0, pa1, pa2, pa3); partialSM(pB0, pB1, m_reg, mnB, alB);
  __syncthreads(); RESC(alB);
  finishSM(pB0, pB1, alB, l_reg, pa0, pa1, pa2, pa3); SBAR();
  pv_d0(o, vb0 + (int)SHM_V, pa0, pa1, pa2, pa3);
  if (hi == 0) li_l[r32] = l_reg; asm volatile("s_waitcnt lgkmcnt(0)" ::: "memory");
  { int tz = threadIdx.x; asm volatile("" : "+v"(tz)); wid = tz >> 6; lane = tz & 63; r32 = lane & 31; hi = lane >> 5; }
  float rli[16];
#pragma unroll
  for (int r = 0; r < 16; ++r) rli[r] = __builtin_amdgcn_rcpf(li_l[crow(r, hi)]);
  char* ost = lds + OST_OFF + wid * (32 * 272);
#pragma unroll
  for (int r = 0; r < 16; ++r) { const int orow = crow(r, hi);
#pragma unroll
    for (int d0 = 0; d0 < 4; ++d0) *(bf16*)(ost + orow * 272 + (d0 * 32 + r32) * 2) = __float2bfloat16(o[d0][r] * rli[r]); }
  asm volatile("s_waitcnt lgkmcnt(0)" ::: "memory");
  bf16* Ow = Ob + (long)(wid * QBLK) * LDO; const bf16* Zw = Zb + (long)(wid * QBLK) * LDQ;
#pragma unroll
  for (int hb = 0; hb < 2; ++hb) {
    u32x4 ov[4], zv[4];
#pragma unroll
    for (int i = 0; i < 4; ++i) { const int c = (hb * 4 + i) * 64 + lane, row = c >> 4, col = (c & 15) * 8;
      ov[i] = *reinterpret_cast<const u32x4*>(ost + row * 272 + col * 2); zv[i] = *reinterpret_cast<const u32x4*>(Zw + (long)row * LDQ + col); }
#pragma unroll
    for (int i = 0; i < 4; ++i) { const int c = (hb * 4 + i) * 64 + lane, row = c >> 4, col = (c & 15) * 8; u32x4 w;
#pragma unroll
      for (int e = 0; e < 4; ++e) { const unsigned a = ov[i][e], z = zv[i][e];
        w[e] = cvtpk(__uint_as_float(a << 16) * __uint_as_float(z << 16), __uint_as_float(a & 0xffff0000u) * __uint_as_float(z & 0xffff0000u)); }
      *reinterpret_cast<u32x4*>(Ow + (long)row * LDO + col) = w; }
  }
  __syncthreads();
#undef SLOAD
#undef SWRITE
#undef SWAIT
#undef RESC
}
}

constexpr int NWAVES = 8;
#ifndef MK_N_LAUNCHES
#define MK_N_LAUNCHES 1
#endif
constexpr int PH_PER_LAYER = 7, N_PHASES = 2 + DEPTH * PH_PER_LAYER;
constexpr size_t MiB = 1u << 20;
constexpr size_t WS_CTL = 0, CTL_ZERO_BYTES = 1 * MiB;
constexpr size_t WS_MOD = 1 * MiB;
constexpr size_t WS_ROPE = WS_MOD + MiB / 2;
constexpr size_t WS_WG = 3 * MiB;
constexpr size_t WS_WLRU = 4 * MiB;
constexpr size_t WS_WOUT = 12 * MiB;
constexpr size_t WS_WBR = 44 * MiB;
constexpr size_t WS_WIN = 140 * MiB;
constexpr size_t WS_X = 540 * MiB;
constexpr size_t WS_Y = 2112 * MiB;
constexpr size_t WS_H = 684 * MiB;
constexpr size_t WS_G2 = 1968 * MiB;
constexpr size_t WS_YB = 756 * MiB;
constexpr size_t WS_ACC = 864 * MiB;
constexpr size_t WS_GT = 936 * MiB;
constexpr size_t WS_MH = 938 * MiB;
constexpr size_t WS_P = 1082 * MiB;
constexpr size_t WS_LA = 1532 * MiB;
constexpr size_t WS_LB = 1676 * MiB;
constexpr size_t WS_X8 = WS_LB;
constexpr size_t WS_HL = 1820 * MiB;
constexpr size_t WS_GSC = 1964 * MiB;
constexpr size_t WS_END = 2328 * MiB;
constexpr int CW_BAR = 4096;
constexpr int RING_BYTES = 131072, LDS_BYTES = 147456, MISC_OFF = LDS_BYTES - 256;
static_assert(att::OST_END <= MISC_OFF, "LDS map");

#define GAS __attribute__((address_space(1)))
#define LAS __attribute__((address_space(3)))
typedef unsigned short bf16_t;
typedef unsigned v4u __attribute__((ext_vector_type(4)));
typedef unsigned v2u __attribute__((ext_vector_type(2)));
typedef float f32x4 __attribute__((ext_vector_type(4)));
#define LDS_WAIT() asm volatile("s_waitcnt lgkmcnt(0)" ::: "memory")
__device__ __forceinline__ unsigned f2bf(float f) { unsigned u = __builtin_bit_cast(unsigned, f); return (u + 0x7fffu + ((u >> 16) & 1u)) >> 16; }
__device__ __forceinline__ unsigned pk2(float lo, float hi) { unsigned r; asm("v_cvt_pk_bf16_f32 %0, %1, %2" : "=v"(r) : "v"(lo), "v"(hi)); return r; }
__device__ __forceinline__ float bf2f(bf16_t b) { return __uint_as_float((unsigned)b << 16); }
__device__ __forceinline__ float blo(unsigned w) { return __uint_as_float(w << 16); }
__device__ __forceinline__ float bhi(unsigned w) { return __uint_as_float(w & 0xffff0000u); }
__device__ __forceinline__ float lane_get(float v, int src) { return __builtin_bit_cast(float, __builtin_amdgcn_ds_bpermute(src << 2, __builtin_bit_cast(int, v))); }
__device__ __forceinline__ float lane_xor(float v, int mask, int lane) { return lane_get(v, lane ^ mask); }
__device__ __forceinline__ float lane_up(float v, int delta, int lane) { return lane_get(v, lane >= delta ? lane - delta : lane); }
__device__ __forceinline__ float wave_sum(float v, int lane) {
#pragma unroll
    for (int o = 1; o < 64; o <<= 1) v += lane_xor(v, o, lane);
    return v;
}
#define XB_TMO      128
#define XB_XCNT(j)  (256  + 64 * (j))
#define XB_XSUB(j)  (1280 + 64 * (j))
#define XB_XGEN(j)  (2304 + 64 * (j))
#define XB_TOP      3328
#define XB_TOPGEN   3392
#define XCD_BAR_WORDS 3456
#define XB_SPIN_CAP (1u << 18)

__device__ __forceinline__ unsigned xb_ld(unsigned* p)              { return __hip_atomic_load(p, __ATOMIC_RELAXED, __HIP_MEMORY_SCOPE_AGENT); }
__device__ __forceinline__ unsigned xb_add(unsigned* p, unsigned v) { return __hip_atomic_fetch_add(p, v, __ATOMIC_RELAXED, __HIP_MEMORY_SCOPE_AGENT); }
__device__ __forceinline__ unsigned xb_xcc_id() { return (unsigned)__builtin_amdgcn_s_getreg((3 << 11) | 20) & 0xFu; }
#define XB_SPIN(cond, bar) do { unsigned _sp = 0; while (cond) { __builtin_amdgcn_s_sleep(1); \
    if ((++_sp & 255u) == 0u) { if (xb_ld(&(bar)[XB_TMO])) break; if (_sp > XB_SPIN_CAP) { atomicAdd(&(bar)[XB_TMO], 1u); break; } } } } while (0)

struct XcdBarrier {
    unsigned* bar; unsigned x;
    volatile LAS unsigned* st;
};

__device__ __forceinline__ XcdBarrier xcd_barrier_post(unsigned* bar, volatile LAS unsigned* st) {
    XcdBarrier b; b.bar = bar; b.x = xb_xcc_id(); b.st = st;
    if (threadIdx.x == 0) (void)xb_add(&bar[XB_XCNT(b.x)], 1u);
    return b;
}
__device__ __forceinline__ void xcd_barrier_complete(unsigned* bar, unsigned x, unsigned& nloc, unsigned& nx) {
    const unsigned G = gridDim.x * gridDim.y * gridDim.z;
    unsigned sum, cnt, mine, sp = 0u;
    for (;;) {
        sum = 0u; cnt = 0u; mine = 0u;
#pragma unroll
        for (unsigned j = 0; j < 16; ++j) { const unsigned c = xb_ld(&bar[XB_XCNT(j)]); sum += c; cnt += (c > 0u) ? 1u : 0u; mine = (j == x) ? c : mine; }
        if (sum == G) break;
        __builtin_amdgcn_s_sleep(1);
        if ((++sp & 255u) == 0u) { if (xb_ld(&bar[XB_TMO])) break; if (sp > XB_SPIN_CAP) { atomicAdd(&bar[XB_TMO], 1u); break; } }
    }
    nloc = mine > 0u ? mine : 1u; nx = cnt > 0u ? cnt : 1u;
}

__device__ __forceinline__ void xcd_barrier(const XcdBarrier& b) {
    asm volatile("s_waitcnt vmcnt(0)" ::: "memory");
    __syncthreads();
    if (threadIdx.x == 0) {
        unsigned* bar = b.bar;
        __builtin_amdgcn_s_waitcnt(0);
        unsigned nloc = b.st[0], nx = b.st[1];
        if (nloc == 0u) { xcd_barrier_complete(bar, b.x, nloc, nx); b.st[0] = nloc; b.st[1] = nx; }
        const unsigned old = xb_add(&bar[XB_XSUB(b.x)], 1u);
        const unsigned gen = old / nloc;
        if (old + 1u == (gen + 1u) * nloc) {
            __builtin_amdgcn_fence(__ATOMIC_RELEASE, "agent");
            asm volatile("s_waitcnt vmcnt(0)" ::: "memory");
            const unsigned og = xb_add(&bar[XB_TOP], 1u);
            const unsigned tg = og / nx;
            if (og + 1u == (tg + 1u) * nx) xb_add(&bar[XB_TOPGEN], 1u);
            else XB_SPIN(xb_ld(&bar[XB_TOPGEN]) == tg, bar);
            __builtin_amdgcn_fence(__ATOMIC_ACQUIRE, "agent");
            xb_add(&bar[XB_XGEN(b.x)], 1u);
            asm volatile("s_waitcnt vmcnt(0)" ::: "memory");
        } else {
            XB_SPIN(xb_ld(&bar[XB_XGEN(b.x)]) == gen, bar);
            __builtin_amdgcn_fence(__ATOMIC_ACQUIRE, "agent");
            asm volatile("s_waitcnt vmcnt(0)" ::: "memory");
        }
    }
    __syncthreads();
}

struct Args { const float* in[22]; float* out; unsigned char* ws; int ph_lo, ph_hi; };
typedef const __attribute__((address_space(4))) Args CArgs;
#define KIN(k) ((const float*)ka->in[k])
#define WSF(off) ((float*)(ka->ws + (off)))
#define WSB(off) ((bf16_t*)(ka->ws + (off)))
#define KA() ({ CArgs* _k = ka0; asm volatile("" : "+s"(_k)); _k; })
__device__ __forceinline__ int tid_fresh() { int t = threadIdx.x; asm volatile("" : "+v"(t)); return t; }
struct Frame {
    LAS unsigned char* lds; char* ldsg;
    int tid, lane, wave, G, wg;
};

__device__ __forceinline__ void transpose_item(const float* W, int ldw, int col0, int k0, bf16_t* WT, int ldt, int drow0, LAS float* scr, int lane) {
    f32x4 v[8];
#pragma unroll
    for (int i = 0; i < 8; ++i) v[i] = __builtin_nontemporal_load((const f32x4*)(W + (size_t)(k0 + 8 * i + (lane >> 3)) * ldw + col0 + 4 * (lane & 7)));
#pragma unroll
    for (int i = 0; i < 8; ++i) { LAS float* d = scr + (8 * i + (lane >> 3)) * 33 + 4 * (lane & 7); d[0] = v[i][0]; d[1] = v[i][1]; d[2] = v[i][2]; d[3] = v[i][3]; }
    LDS_WAIT(); asm volatile("" ::: "memory");
    const int c = lane & 7;
#pragma unroll
    for (int j = 0; j < 4; ++j) { const int n = (lane >> 3) + 8 * j; const LAS float* s = scr + (8 * c) * 33 + n;
        v4u o; o.x = pk2(s[0 * 33], s[1 * 33]); o.y = pk2(s[2 * 33], s[3 * 33]); o.z = pk2(s[4 * 33], s[5 * 33]); o.w = pk2(s[6 * 33], s[7 * 33]);
        __builtin_nontemporal_store(o, (v4u*)(WT + (size_t)(drow0 + n) * ldt + k0 + 8 * c)); }
    LDS_WAIT(); asm volatile("" ::: "memory");
}
__device__ __forceinline__ void p_convert(Frame& F, CArgs* ka, int l, int wv, int nwv, int it0 = 0, int it1 = 1 << 30) {
    const int tid = tid_fresh(), lane = tid & 63, wave = __builtin_amdgcn_readfirstlane(tid >> 6);
    LAS float* scr = (LAS float*)(F.lds + wave * 8704);
    constexpr int I_IN = 32 * 800, I_G = 32, I_BR = 3 * 2048, I_OUT = 2048, I_LRU = 2 * 2 * 16 * 8, I_LAYER = I_IN + I_G + I_BR + I_OUT + I_LRU;
    if (it1 > I_LAYER) it1 = I_LAYER;
    for (int it = it0 + wv; it < it1; it += nwv) {
        int r = it;
        if (r < I_IN) { const int kb = r / 800, nb = r - kb * 800, n0 = nb * 32, sc = n0 < 14336 ? n0 : n0 + 32;
            transpose_item(KIN(8) + (size_t)l * DM * NIN, NIN, sc, kb * 64, WSB(WS_WIN) + (size_t)l * NP * DM, DM, n0, scr, lane); continue; }
        r -= I_IN;
        if (r < I_G) { transpose_item(KIN(8) + (size_t)l * DM * NIN, NIN, 14336, r * 64, WSB(WS_WG) + (size_t)l * 32 * DM, DM, 0, scr, lane); continue; }
        r -= I_G;
        if (r < I_BR) { const int z = r / 2048, q = r - z * 2048, kb = q / 64, nb = q - kb * 64;
            transpose_item(KIN(20) + ((size_t)l * 3 + z) * DM * DM, DM, nb * 32, kb * 64, WSB(WS_WBR) + ((size_t)l * 3 + z) * DM * DM, DM, nb * 32, scr, lane); continue; }
        r -= I_BR;
        if (r < I_OUT) { const int kb = r / 64, nb = r - kb * 64;
            transpose_item(KIN(21) + (size_t)l * DM * DM, DM, nb * 32, kb * 64, WSB(WS_WOUT) + (size_t)l * DM * DM, DM, nb * 32, scr, lane); continue; }
        r -= I_OUT;
        { const int q = r & 7, mt = r >> 3, blk = mt & 15, gate = (mt >> 4) & 1, dr = mt >> 5, kb = q >> 2, nb = q & 3;
          const float* src = (gate ? KIN(13) : KIN(11)) + (((size_t)l * 2 + dr) * 16 + blk) * 16384;
          transpose_item(src, 128, nb * 32, kb * 64, WSB(WS_WLRU) + ((((size_t)l * 2 + dr) * 2 + gate) * 16 + blk) * 16384, 128, nb * 32, scr, lane); }
    }
}
__device__ __forceinline__ void p_prologue(Frame& F, CArgs* ka) {
    const int tid = tid_fresh(), lane = tid & 63, wave = __builtin_amdgcn_readfirstlane(tid >> 6); (void)lane; (void)wave;
    for (int i = F.wg * 512 + tid; i < SEQ * 64; i += F.G * 512) { const int t = i >> 6, j = i & 63;
        const float inv = 1.0f / powf(10000.0f, (float)(j & 31) * (1.0f / 32.0f)); const float pos = (float)(j < 32 ? (t >> 6) : (t & 63)); const float ang = pos * inv;
        { const float rev = ang * 0.15915494309189535f; WSF(WS_ROPE)[i] = __builtin_amdgcn_cosf(rev); WSF(WS_ROPE)[SEQ * 64 + i] = __builtin_amdgcn_sinf(rev); } }
    __syncthreads();
    LAS float* sc = (LAS float*)(F.lds + 73728);
    LAS float* red = (LAS float*)(F.lds + 73728 + 5 * 2048 * 4);
    for (int i = tid; i < 5 * DM; i += 512) { const int bi = i >> 11, k = i & 2047; const float v = bi < 4 ? KIN(1)[bi * DM + k] : KIN(3)[k]; sc[i] = v / (1.f + expf(-v)); }
    __syncthreads();
    for (int it = F.wg; it < DEPTH * 192; it += F.G) { const int l = it / 192, j0 = (it - l * 192) * 32, cj = tid & 31, ks = tid >> 5;
        float a0 = 0.f, a1 = 0.f, a2 = 0.f, a3 = 0.f, a4 = 0.f; const float* w = KIN(4) + (size_t)l * DM * 3 * DM + j0 + cj;
        for (int k = ks * 128; k < ks * 128 + 128; ++k) { const float wv = w[(size_t)k * (3 * DM)]; a0 += sc[k] * wv; a1 += sc[2048 + k] * wv; a2 += sc[4096 + k] * wv; a3 += sc[6144 + k] * wv; a4 += sc[8192 + k] * wv; }
        red[(ks * 5 + 0) * 32 + cj] = a0; red[(ks * 5 + 1) * 32 + cj] = a1; red[(ks * 5 + 2) * 32 + cj] = a2; red[(ks * 5 + 3) * 32 + cj] = a3; red[(ks * 5 + 4) * 32 + cj] = a4;
        __syncthreads();
        if (tid < 160) { const int bi = tid >> 5, c = tid & 31; float s = KIN(5)[(size_t)l * 3 * DM + j0 + c];
            for (int q = 0; q < 16; ++q) s += red[(q * 5 + bi) * 32 + c];
            WSF(WS_MOD)[((size_t)l * 5 + bi) * (3 * DM) + j0 + c] = s; }
        __syncthreads();
    }
}

__device__ __forceinline__ void p_norm(Frame& F, CArgs* ka, int l, bool dry = false) {
    const int tid = tid_fresh(), lane = tid & 63, wave = __builtin_amdgcn_readfirstlane(tid >> 6); (void)lane; (void)wave;
    const int gw = F.wg * NWAVES + wave, NGW = F.G * NWAVES;
    for (int r = gw; r < MROWS; r += NGW) {
        const int b = r / TPB, t = r - b * TPB; const bool isctx = t >= SEQ; const int bi = isctx ? 4 : b;
        if (l == DEPTH && isctx) continue;
        f32x4 v[8];
        if (l == 0) { const float* src = isctx ? KIN(2) + ((size_t)b * CTXL + (t - SEQ)) * DM : KIN(0) + ((size_t)b * SEQ + t) * DM;
#pragma unroll
            for (int j = 0; j < 8; ++j) v[j] = *(const f32x4*)(src + j * 256 + lane * 4);
        } else {
            const float* xr = WSF(WS_X) + (size_t)r * DM; f32x4 y[8]; float ss = 0.f;
#if Y_BF16
            const bf16_t* yr = WSB(WS_Y) + (size_t)r * DM;
#define CVY(w_) ((f32x4){blo((w_).x), bhi((w_).x), blo((w_).y), bhi((w_).y)})
            { v2u yw[8];
#pragma unroll
              for (int j = 0; j < 8; ++j) yw[j] = *(const v2u*)(yr + j * 256 + lane * 4);
#pragma unroll
              for (int j = 0; j < 8; ++j) y[j] = CVY(yw[j]); }
            if (SPLIT_CTX && isctx && F.G == 256) { v2u s1[8], s2[8];
#pragma unroll
              for (int j = 0; j < 8; ++j) { s1[j] = *(const v2u*)(yr + (size_t)MROWS * DM + j * 256 + lane * 4); s2[j] = *(const v2u*)(yr + 2 * (size_t)MROWS * DM + j * 256 + lane * 4); }
#pragma unroll
              for (int j = 0; j < 8; ++j) y[j] = y[j] + CVY(s1[j]) + CVY(s2[j]); }
#undef CVY
#else
            const float* yr = WSF(WS_Y) + (size_t)r * DM;
#pragma unroll
            for (int j = 0; j < 8; ++j) y[j] = *(const f32x4*)(yr + j * 256 + lane * 4);
            if (SPLIT_CTX && isctx && F.G == 256) {
#pragma unroll
              for (int j = 0; j < 8; ++j) y[j] = y[j] + *(const f32x4*)(yr + (size_t)MROWS * DM + j * 256 + lane * 4) + *(const f32x4*)(yr + 2 * (size_t)MROWS * DM + j * 256 + lane * 4); }
#endif
#pragma unroll
            for (int j = 0; j < 8; ++j) ss += y[j].x * y[j].x + y[j].y * y[j].y + y[j].z * y[j].z + y[j].w * y[j].w;
            const float rs = rsqrtf(wave_sum(ss, lane) * (1.f / DM) + EPS);
            const float* gate = WSF(WS_MOD) + ((size_t)(l - 1) * 5 + bi) * (3 * DM) + 2 * DM; const float* npost = KIN(7) + (size_t)(l - 1) * DM;
#pragma unroll
            for (int j = 0; j < 8; ++j) { const int c = j * 256 + lane * 4; const f32x4 g = *(const f32x4*)(gate + c), w = *(const f32x4*)(npost + c), xv = *(const f32x4*)(xr + c);
                v[j] = xv + g * (y[j] * rs * w); }
        }
        if (l == DEPTH) { float* o = (ka->out) + ((size_t)b * SEQ + t) * DM;
#pragma unroll
            for (int j = 0; j < 8; ++j) *(f32x4*)(o + j * 256 + lane * 4) = v[j];
            continue; }
        float* xo = (dry ? WSF(WS_ACC) : WSF(WS_X)) + (size_t)r * DM; float ss = 0.f;
#pragma unroll
        for (int j = 0; j < 8; ++j) { *(f32x4*)(xo + j * 256 + lane * 4) = v[j]; ss += v[j].x * v[j].x + v[j].y * v[j].y + v[j].z * v[j].z + v[j].w * v[j].w; }
        const float rs = rsqrtf(wave_sum(ss, lane) * (1.f / DM) + EPS);
        const float* shift = WSF(WS_MOD) + ((size_t)l * 5 + bi) * (3 * DM); const float* scale = shift + DM; const float* npre = KIN(6) + (size_t)l * DM;
        bf16_t* ho = (dry ? WSB(WS_G2) : WSB(WS_H)) + (size_t)r * DM;
#pragma unroll
        for (int j = 0; j < 8; ++j) { const int c = j * 256 + lane * 4; const f32x4 sh = *(const f32x4*)(shift + c), scv = *(const f32x4*)(scale + c), w = *(const f32x4*)(npre + c);
            const f32x4 h = v[j] * rs * w * (scv + 1.f) + sh; v2u o; o.x = pk2(h.x, h.y); o.y = pk2(h.z, h.w); *(v2u*)(ho + c) = o; }
    }
}

__device__ __forceinline__ void p_gates(Frame& F, CArgs* ka, int l, int wk0, int nwk) {
    const int tid = tid_fresh(), lane = tid & 63, wave = __builtin_amdgcn_readfirstlane(tid >> 6), c16 = lane & 15, q = lane >> 4;
    typedef short bf16x8 __attribute__((ext_vector_type(8)));
    LAS float* GL = (LAS float*)F.lds;
    const bf16_t* H = WSB(WS_H); const bf16_t* WG = WSB(WS_WG) + (size_t)l * 32 * DM; float* GT = WSF(WS_GT); f32x4* GSC = (f32x4*)WSF(WS_GSC);
    for (int task = wk0; task < NBATCH * 36; task += nwk) { const int b = task / 36, chunk = task - b * 36; const size_t row0 = (size_t)b * TPB + chunk * 64;
        __syncthreads();
        { const int rb = wave & 3, kh = wave >> 2; f32x4 a0 = {0.f, 0.f, 0.f, 0.f}, a1 = {0.f, 0.f, 0.f, 0.f};
          const bf16_t* hp = H + (row0 + rb * 16 + c16) * DM + kh * 1024 + q * 8; const bf16_t* w0 = WG + (size_t)c16 * DM + kh * 1024 + q * 8; const bf16_t* w1 = w0 + 16 * DM;
#pragma unroll 1
          for (int kb = 0; kb < 32; kb += 8) { bf16x8 av[8], b0[8], b1[8];
#pragma unroll
              for (int i = 0; i < 8; ++i) { av[i] = *(const bf16x8*)(hp + (kb + i) * 32); b0[i] = *(const bf16x8*)(w0 + (kb + i) * 32); b1[i] = *(const bf16x8*)(w1 + (kb + i) * 32); }
#pragma unroll
              for (int i = 0; i < 8; ++i) { a0 = __builtin_amdgcn_mfma_f32_16x16x32_bf16(av[i], b0[i], a0, 0, 0, 0); a1 = __builtin_amdgcn_mfma_f32_16x16x32_bf16(av[i], b1[i], a1, 0, 0, 0); } }
#pragma unroll
          for (int j = 0; j < 4; ++j) { GL[(kh * 64 + rb * 16 + q * 4 + j) * 33 + c16] = a0[j]; GL[(kh * 64 + rb * 16 + q * 4 + j) * 33 + 16 + c16] = a1[j]; } }
        __syncthreads();
#pragma unroll
        for (int i = 0; i < 4; ++i) { const int idx = tid + 512 * i, r = idx >> 5, c = idx & 31; float s = GL[r * 33 + c] + GL[(64 + r) * 33 + c] + KIN(16)[l * 32 + c];
            if ((c >> 3) & 1) s = fminf(s, 0.f) - __logf(1.f + __expf(-fabsf(s)));
            GL[r * 33 + c] = s; GT[(row0 + r) * 32 + c] = s; }
        __syncthreads();
#pragma unroll
        for (int pi = 0; pi < 2; ++pi) { const int p = wave * 2 + pi, dir = p >> 3, h = p & 7, rl = dir ? 63 - lane : lane;
            const float gi = GL[rl * 33 + dir * 16 + h]; float bc = GL[rl * 33 + dir * 16 + 8 + h];
#pragma unroll
            for (int o = 1; o < 64; o <<= 1) { const float v = lane_up(bc, o, lane); if (lane >= o) bc += v; }
            const float g = gi - bc; float pm = g;
#pragma unroll
            for (int o = 1; o < 64; o <<= 1) { const float v = lane_up(pm, o, lane); if (lane >= o) pm = fmaxf(pm, v); }
            GSC[((((size_t)b * 2 + dir) * 8 + h) * 36 + chunk) * 64 + lane] = (f32x4){bc, g, pm, 0.f}; }
    }
    __syncthreads();
}
__device__ __forceinline__ void p_knorm(Frame& F, CArgs* ka, int l, bool dry = false) {
    const int tid = tid_fresh(), lane = tid & 63, wave = __builtin_amdgcn_readfirstlane(tid >> 6);
    const int gw = F.wg * NWAVES + wave, NGW = F.G * NWAVES; const int sub = lane & 15;
    f32x4 kn0 = *(const f32x4*)(KIN(19) + l * 128 + sub * 8), kn1 = *(const f32x4*)(KIN(19) + l * 128 + sub * 8 + 4);
    for (int r = gw; r < MROWS; r += NGW) { const int b = r / TPB, t = r - b * TPB;
        bf16_t* kp = WSB(WS_P) + (size_t)r * NP + C_AK + lane * 8; const v4u raw = *(const v4u*)kp; float v[8];
#pragma unroll
        for (int e = 0; e < 4; ++e) { v[2 * e] = blo(raw[e]); v[2 * e + 1] = bhi(raw[e]); }
        float ss = 0.f;
#pragma unroll
        for (int e = 0; e < 8; ++e) ss += v[e] * v[e];
        ss += lane_xor(ss, 1, lane); ss += lane_xor(ss, 2, lane); ss += lane_xor(ss, 4, lane); ss += lane_xor(ss, 8, lane);
        const float rs = rsqrtf(ss * (1.f / 128.f) + EPS);
#pragma unroll
        for (int e = 0; e < 8; ++e) v[e] *= rs * (e < 4 ? kn0[e & 3] : kn1[e & 3]);
        if (t < SEQ) { const int i0 = (sub & 7) * 8; const float* cp = WSF(WS_ROPE) + (size_t)t * 64 + i0; const float* sp = cp + SEQ * 64;
            const f32x4 c0 = *(const f32x4*)cp, c1 = *(const f32x4*)(cp + 4), s0 = *(const f32x4*)sp, s1 = *(const f32x4*)(sp + 4); const bool upper = (sub & 8) != 0;
#pragma unroll
            for (int e = 0; e < 8; ++e) { const float o = lane_xor(v[e], 8, lane), c = e < 4 ? c0[e & 3] : c1[e & 3], sn = e < 4 ? s0[e & 3] : s1[e & 3];
                v[e] = upper ? v[e] * c + o * sn : v[e] * c - o * sn; } }
        v4u ov; ov.x = pk2(v[0], v[1]); ov.y = pk2(v[2], v[3]); ov.z = pk2(v[4], v[5]); ov.w = pk2(v[6], v[7]);
        if (dry) *(v4u*)(WSB(WS_ACC) + (size_t)r * 512 + lane * 8) = ov; else *(v4u*)kp = ov; }
}

__device__ __forceinline__ void p_lru_gates_naive(Frame& F, CArgs* ka, int l) {
    const int tid = tid_fresh(); (void)tid;
    LAS float* xs = (LAS float*)F.lds;
    for (int it = F.wg; it < (MROWS / 16) * 16; it += F.G) { const int rt = it >> 4, blk = it & 15;
        __syncthreads();
#pragma unroll
        for (int j = 0; j < 4; ++j) { const int idx = tid + 512 * j, rr = idx >> 7, c = idx & 127, r = rt * 16 + rr, b = r / TPB, t = r - b * TPB, ch = blk * 128 + c;
            const int lo = t < SEQ ? 0 : SEQ, hi = t < SEQ ? SEQ : TPB; float a = KIN(10)[l * DM + ch];
#pragma unroll
            for (int k = 0; k < 4; ++k) { const int tt = t + k - 2; if (tt >= lo && tt < hi) a += KIN(9)[((size_t)l * 4 + k) * DM + ch] * bf2f(WSB(WS_P)[((size_t)b * TPB + tt) * NP + C_LX + ch]); }
            xs[rr * 128 + c] = a; }
        __syncthreads();
        const int co = tid & 127, r0 = tid >> 7, ch = blk * 128 + co;
#pragma unroll 1
        for (int dr = 0; dr < 2; ++dr) {
            const float* wr = KIN(11) + (((size_t)l * 2 + dr) * 16 + blk) * 16384 + co; const float* wi = KIN(13) + (((size_t)l * 2 + dr) * 16 + blk) * 16384 + co;
            float ar[4], ai[4];
#pragma unroll
            for (int j = 0; j < 4; ++j) { ar[j] = KIN(12)[((size_t)l * 2 + dr) * DM + ch]; ai[j] = KIN(14)[((size_t)l * 2 + dr) * DM + ch]; }
            for (int c = 0; c < 128; ++c) { const float w0 = wr[c * 128], w1 = wi[c * 128];
#pragma unroll
                for (int j = 0; j < 4; ++j) { const float xv = xs[(r0 + 4 * j) * 128 + c]; ar[j] += xv * w0; ai[j] += xv * w1; } }
            const float lam = KIN(15)[((size_t)l * 2 + dr) * DM + ch], sp = log1pf(expf(-lam));
#pragma unroll
            for (int j = 0; j < 4; ++j) { const int r = rt * 16 + r0 + 4 * j; const float rg = 1.f / (1.f + expf(-ar[j])), ig = 1.f / (1.f + expf(-ai[j]));
                const float log_a = -8.f * rg * sp, a = expf(log_a), mult = sqrtf(-expm1f(2.f * log_a));
                WSF(WS_LA)[((size_t)dr * MROWS + r) * DM + ch] = a; WSF(WS_LB)[((size_t)dr * MROWS + r) * DM + ch] = mult * ig * xs[(r0 + 4 * j) * 128 + co]; }
        }
    }
    __syncthreads();
}

__device__ __forceinline__ void p_attention(Frame& F, CArgs* ka, int l, bool need_ctx) {
    using att::bf16;
    const int n_lat = NBATCH * 16 * 8, n_all = n_lat + (need_ctx ? NBATCH * 16 : 0);
    for (int u = F.wg; u < n_all; u += F.G) {
        int b, h, q0, k0, seq; const float *cs = nullptr, *sn = nullptr;
        if (u < n_lat) { const int qb = u & 7; h = (u >> 3) & 15; b = u >> 7; q0 = qb * 256; k0 = 0; seq = TPB; cs = WSF(WS_ROPE) + (size_t)q0 * 64; sn = WSF(WS_ROPE) + (size_t)SEQ * 64 + (size_t)q0 * 64; }
        else { const int v = u - n_lat; h = v & 15; b = v >> 4; q0 = SEQ; k0 = SEQ; seq = CTXL; }
        const size_t rq = (size_t)b * TPB + q0, rk = (size_t)b * TPB + k0; const int kvh = h >> 2;
        att::attn_unit((const bf16*)(WSB(WS_P) + rq * NP + C_AQ + h * 128), (const bf16*)(WSB(WS_P) + rk * NP + C_AK + kvh * 128), (const bf16*)(WSB(WS_P) + rk * NP + C_AV + kvh * 128),
                       (const bf16*)(WSB(WS_P) + rq * NP + C_AZ + h * 128), (bf16*)(WSB(WS_YB) + ((size_t)2 * MROWS + rq) * DM + h * 128), seq, F.ldsg, KIN(18) + l * 128, cs, sn);
    }
}
__device__ __forceinline__ int seq_row(int s, int dir) { return s < CTXL ? SEQ + (dir ? CTXL - 1 - s : s) : (dir ? SEQ - 1 - (s - CTXL) : s - CTXL); }
__device__ __forceinline__ void p_mlstm_naive(Frame& F, CArgs* ka, int l) {
    const int tid = tid_fresh(), lane = tid & 63, wave = __builtin_amdgcn_readfirstlane(tid >> 6); (void)lane; (void)wave;
    LAS float* sq = (LAS float*)F.lds; LAS float* sk = sq + 256; LAS float* rn = sk + 256; LAS float* rd = rn + 512;
    const int e = tid & 63, dg = tid >> 6;
    for (int u = F.wg; u < 256; u += F.G) { const int es = u & 3, dir = (u >> 2) & 1, h = (u >> 3) & 7, b = u >> 6;
        float C[32], n[32];
#pragma unroll
        for (int i = 0; i < 32; ++i) { C[i] = 0.f; n[i] = 0.f; }
        float m = -1e30f;
        const int lcol = tid < 64 ? C_MQ + h * 256 + tid * 4 : C_MK + h * 256 + (tid - 64) * 4, vcol = C_MV + h * 256 + es * 64 + e;
        v2u pqk = {0u, 0u}; bf16_t pv; float gi, gf;
        { const size_t r = (size_t)b * TPB + seq_row(0, dir); if (tid < 128) pqk = *(const v2u*)(WSB(WS_P) + r * NP + lcol); pv = WSB(WS_P)[r * NP + vcol]; gi = WSF(WS_GT)[r * 32 + dir * 16 + h]; gf = WSF(WS_GT)[r * 32 + dir * 16 + 8 + h]; }
        __syncthreads();
        for (int s = 0; s < TPB; ++s) {
            const size_t r = (size_t)b * TPB + seq_row(s, dir);
            if (tid < 128) { LAS float* d = (tid < 64 ? sq : sk) + (tid & 63) * 4; d[0] = blo(pqk.x); d[1] = bhi(pqk.x); d[2] = blo(pqk.y); d[3] = bhi(pqk.y); }
            const float vv = bf2f(pv), iv = gi, lf = gf;
            __syncthreads();
            if (s + 1 < TPB) { const size_t r2 = (size_t)b * TPB + seq_row(s + 1, dir); if (tid < 128) pqk = *(const v2u*)(WSB(WS_P) + r2 * NP + lcol); pv = WSB(WS_P)[r2 * NP + vcol]; gi = WSF(WS_GT)[r2 * 32 + dir * 16 + h]; gf = WSF(WS_GT)[r2 * 32 + dir * 16 + 8 + h]; }
            const float mnew = fmaxf(lf + m, iv), fw = expf(lf + m - mnew), iw = expf(iv - mnew); m = mnew;
            float pn = 0.f, pd = 0.f;
#pragma unroll
            for (int dd = 0; dd < 32; ++dd) { const float kd = sk[dg * 32 + dd], qd = sq[dg * 32 + dd]; C[dd] = fw * C[dd] + iw * kd * vv; n[dd] = fw * n[dd] + iw * kd; pn += qd * C[dd]; pd += qd * n[dd]; }
            rn[dg * 64 + e] = pn; rd[dg * 64 + e] = pd;
            __syncthreads();
            if (dg == 0) { float num = 0.f, den = 0.f;
#pragma unroll
                for (int g = 0; g < 8; ++g) { num += rn[g * 64 + e]; den += rd[g * 64 + e]; }
                WSB(WS_MH)[((size_t)dir * MROWS + r) * DM + h * 256 + es * 64 + e] = (bf16_t)f2bf(num / fmaxf(fabsf(den), expf(-m))); }
        }
        __syncthreads();
    }
}
__device__ __forceinline__ void p_lru_scan_naive(Frame& F, CArgs* ka) {
    const int tid = tid_fresh(), lane = tid & 63, wave = __builtin_amdgcn_readfirstlane(tid >> 6); (void)lane; (void)wave;
    if (wave != 0) return;
    for (int cw = F.wg; cw < 256; cw += F.G) { const int combo = cw * 64 + lane, b = combo >> 12, dir = (combo >> 11) & 1, ch = combo & 2047;
        const float* A = WSF(WS_LA) + (size_t)dir * MROWS * DM + ch; const float* Bx = WSF(WS_LB) + (size_t)dir * MROWS * DM + ch; float* Ho = WSF(WS_HL) + (size_t)dir * MROWS * DM + ch; float h = 0.f;
#pragma unroll 8
        for (int s = 0; s < TPB; ++s) { const size_t r = (size_t)b * TPB + seq_row(s, dir); h = A[r * DM] * h + Bx[r * DM]; Ho[r * DM] = h; }
    }
}

__device__ __forceinline__ void p_mlout(Frame& F, CArgs* ka, int l, bool need_ctx) {
    const int tid = tid_fresh(), lane = tid & 63, wave = __builtin_amdgcn_readfirstlane(tid >> 6); (void)lane; (void)wave;
    const int gw = F.wg * NWAVES + wave, NGW = F.G * NWAVES, nrow = need_ctx ? MROWS : NBATCH * SEQ;
    for (int ri = gw; ri < nrow; ri += NGW) { const int r = need_ctx ? ri : (ri >> 11) * TPB + (ri & 2047);
        const bf16_t* pr = WSB(WS_P) + (size_t)r * NP;
        v2u ma[8], mb[8], ow[8], zw[8]; f32x4 g[8];
#pragma unroll
        for (int h = 0; h < 8; ++h) { const int col = h * 256 + lane * 4;
            ma[h] = *(const v2u*)(WSB(WS_MH) + (size_t)r * DM + col); mb[h] = *(const v2u*)(WSB(WS_MH) + ((size_t)MROWS + r) * DM + col);
            ow[h] = *(const v2u*)(pr + C_MO + col); zw[h] = *(const v2u*)(pr + C_MZ + col); g[h] = *(const f32x4*)(KIN(17) + (size_t)l * DM + col); }
#pragma unroll
        for (int h = 0; h < 8; ++h) { const int col = h * 256 + lane * 4;
            const f32x4 a = {blo(ma[h].x), bhi(ma[h].x), blo(ma[h].y), bhi(ma[h].y)}, bb = {blo(mb[h].x), bhi(mb[h].x), blo(mb[h].y), bhi(mb[h].y)};
            f32x4 v = a + bb; v.x *= blo(ow[h].x); v.y *= bhi(ow[h].x); v.z *= blo(ow[h].y); v.w *= bhi(ow[h].y);
            const float rs = rsqrtf(wave_sum(v.x * v.x + v.y * v.y + v.z * v.z + v.w * v.w, lane) * (1.f / 256.f) + EPS);
            v2u o; o.x = pk2(v.x * rs * g[h].x * blo(zw[h].x), v.y * rs * g[h].y * bhi(zw[h].x)); o.y = pk2(v.z * rs * g[h].z * blo(zw[h].y), v.w * rs * g[h].w * bhi(zw[h].y));
            *(v2u*)(WSB(WS_YB) + ((size_t)MROWS + r) * DM + col) = o; }
    }
}

__device__ __forceinline__ void p_lru_combine_naive(Frame& F, CArgs* ka) {
    const int tid = tid_fresh(), lane = tid & 63, wave = __builtin_amdgcn_readfirstlane(tid >> 6);
    const int gw = F.wg * NWAVES + wave, NGW = F.G * NWAVES;
    for (int r = gw; r < MROWS; r += NGW) {
        const bf16_t* pr = WSB(WS_P) + (size_t)r * NP;
#pragma unroll 2
        for (int j = 0; j < 8; ++j) { const int col = j * 256 + lane * 4;
            const f32x4 a = *(const f32x4*)(WSF(WS_HL) + (size_t)r * DM + col), bb = *(const f32x4*)(WSF(WS_HL) + ((size_t)MROWS + r) * DM + col); const v2u zw = *(const v2u*)(pr + C_LZ + col);
            const f32x4 v = a + bb; v2u o; o.x = pk2(v.x * blo(zw.x), v.y * bhi(zw.x)); o.y = pk2(v.z * blo(zw.y), v.w * bhi(zw.y));
            *(v2u*)(WSB(WS_YB) + (size_t)r * DM + col) = o; }
    }
}
#ifndef USE_NAIVE_ML
#define USE_NAIVE_ML 0
#endif
#ifndef USE_NAIVE_LRU
#define USE_NAIVE_LRU 0
#endif

namespace ml {
typedef short bf16x8 __attribute__((ext_vector_type(8)));
constexpr int KS_OFF = 0, KS_PITCH = 528;
constexpr int KT_OFF = KS_OFF + 64 * KS_PITCH, KT_PITCH = 144;
constexpr int VT_OFF = KT_OFF + 256 * KT_PITCH, VT_PITCH = 144;
constexpr int ST_OFF = VT_OFF + 80 * VT_PITCH, ST_PITCH = 144;
constexpr int CT_OFF = ST_OFF + 64 * ST_PITCH, CT_PITCH = 528;
constexpr int TAB_OFF = CT_OFF + 80 * CT_PITCH;
constexpr int END_OFF = TAB_OFF + 1024;
static_assert(END_OFF <= MISC_OFF, "mLSTM LDS map");
#define ML_MFMA(a, b, c) __builtin_amdgcn_mfma_f32_16x16x32_bf16((a), (b), (c), 0, 0, 0)
__device__ __forceinline__ int chunk_of(int k, int dir) { return k < 4 ? (dir ? 35 - k : 32 + k) : (dir ? 31 - (k - 4) : k - 4); }

__device__ __forceinline__ void mlstm_unit(Frame& F, CArgs* ka, int u, bool need_ctx) {
    const int tid = tid_fresh(), lane = tid & 63, w = __builtin_amdgcn_readfirstlane(tid >> 6), c16 = lane & 15, q = lane >> 4;
    const int es = u & 3, dir = (u >> 2) & 1, h = (u >> 3) & 7, b = u >> 6;
    LAS unsigned char* L = F.lds;
    const bf16_t* P = WSB(WS_P); bf16_t* MH = WSB(WS_MH) + (size_t)dir * MROWS * DM;
    const f32x4* GSC = (const f32x4*)WSF(WS_GSC) + (((size_t)b * 2 + dir) * 8 + h) * 36 * 64;
    LAS float* TABg = (LAS float*)(L + TAB_OFF); LAS float* TABmm = TABg + 64; LAS float* TABbc = TABg + 128;
    __syncthreads();
    { unsigned z0 = 0u; asm volatile("" : "+v"(z0)); const v4u zz = {z0, z0, z0, z0};
      for (int i = tid; i < 80 * CT_PITCH / 16; i += 512) *(LAS v4u*)(L + CT_OFF + i * 16) = zz; }
    for (int i = tid; i < 16 * 64; i += 512) { const int e = 64 + (i >> 6), s = i & 63; *(LAS bf16_t*)(L + VT_OFF + e * VT_PITCH + s * 2) = (bf16_t)(e == 64 ? 0x3F80 : 0); }
    f32x4 C[2][5];
#pragma unroll
    for (int a = 0; a < 2; ++a)
#pragma unroll
        for (int e = 0; e < 5; ++e) C[a][e] = (f32x4){0.f, 0.f, 0.f, 0.f};
    float m = -1e30f;
    const int tn = w & 3, wh = w >> 2;
    v4u kraw[4], vraw; bf16x8 Qf[8]; float gsc0, gsc1, gsc2;
#define ML_ROW(base, j) ((size_t)(base) + (dir ? 63 - (j) : (j)))
#define ML_LOAD_KVG(k) do { const int _c = chunk_of((k), dir), _base = b * TPB + _c * 64; const bf16_t* _rp = P + ML_ROW(_base, lane) * NP; \
        _Pragma("unroll") for (int i = 0; i < 4; ++i) kraw[i] = *(const v4u*)(_rp + C_MK + h * 256 + (w * 4 + i) * 8); \
        vraw = *(const v4u*)(_rp + C_MV + h * 256 + es * 64 + w * 8); { const float* _gp = (const float*)(GSC + _c * 64 + lane); gsc0 = _gp[0]; gsc1 = _gp[1]; gsc2 = _gp[2]; } } while (0)
#define ML_LOAD_Q(k) do { const int _base = b * TPB + chunk_of((k), dir) * 64; const bf16_t* _qp = P + ML_ROW(_base, tn * 16 + c16) * NP + C_MQ + h * 256 + q * 8; \
        _Pragma("unroll") for (int ks = 0; ks < 8; ++ks) Qf[ks] = *(const bf16x8*)(_qp + ks * 32); } while (0)
    ML_LOAD_KVG(0); ML_LOAD_Q(0);
    float bL = 0.f, mm63 = 0.f;
#pragma unroll 1
    for (int k = 0; k < 36; ++k) {
        const int base = b * TPB + chunk_of(k, dir) * 64; const bool do_out = need_ctx || k >= 4;
        if (k > 0) {
#pragma unroll
            for (int di = 0; di < 2; ++di)
#pragma unroll
                for (int en = 0; en < 5; ++en) { const f32x4 c = C[di][en]; v2u o; o.x = pk2(c[0], c[1]); o.y = pk2(c[2], c[3]);
                    *(LAS v2u*)(L + CT_OFF + (en * 16 + c16) * CT_PITCH + ((2 * w + di) * 16 + q * 4) * 2) = o; }
            m = bL + mm63; }
        const float bc = gsc0, g = gsc1, mm = fmaxf(gsc2, m), wk = __expf(g - lane_get(mm, 63));
        bL = lane_get(bc, 63); mm63 = lane_get(mm, 63);
        if (w == 0) { TABg[lane] = g; TABmm[lane] = mm; TABbc[lane] = bc; }
#pragma unroll
        for (int i = 0; i < 4; ++i) { *(LAS v4u*)(L + KS_OFF + lane * KS_PITCH + (w * 4 + i) * 16) = kraw[i];
#pragma unroll
            for (int e = 0; e < 4; ++e) { const unsigned x = kraw[i][e]; const unsigned pk = pk2(blo(x) * wk, bhi(x) * wk);
                *(LAS bf16_t*)(L + KT_OFF + ((w * 4 + i) * 8 + 2 * e) * KT_PITCH + lane * 2) = (bf16_t)(pk & 0xffffu); *(LAS bf16_t*)(L + KT_OFF + ((w * 4 + i) * 8 + 2 * e + 1) * KT_PITCH + lane * 2) = (bf16_t)(pk >> 16); } }
#pragma unroll
        for (int e = 0; e < 4; ++e) { const unsigned x = vraw[e];
            *(LAS bf16_t*)(L + VT_OFF + (w * 8 + 2 * e) * VT_PITCH + lane * 2) = (bf16_t)(x & 0xffffu); *(LAS bf16_t*)(L + VT_OFF + (w * 8 + 2 * e + 1) * VT_PITCH + lane * 2) = (bf16_t)(x >> 16); }
        __syncthreads();
        const int t = tn * 16 + c16; const int kn = k + 1 < 36 ? k + 1 : 35;
        if (do_out) {
            const float mmt = TABmm[t];
#pragma unroll
            for (int si = 0; si < 2; ++si) { const int sm = wh * 2 + si; v2u o = {0u, 0u};
                if (sm <= tn) { f32x4 acc = {0.f, 0.f, 0.f, 0.f};
#pragma unroll
                    for (int ks = 0; ks < 8; ++ks) { const bf16x8 a = *(const LAS bf16x8*)(L + KS_OFF + (sm * 16 + c16) * KS_PITCH + (ks * 32 + q * 8) * 2); acc = ML_MFMA(a, Qf[ks], acc); }
                    float v[4];
#pragma unroll
                    for (int j = 0; j < 4; ++j) { const int s = sm * 16 + q * 4 + j; v[j] = s <= t ? acc[j] * __expf(TABg[s] - mmt) : 0.f; }
                    o.x = pk2(v[0], v[1]); o.y = pk2(v[2], v[3]); }
                *(LAS v2u*)(L + ST_OFF + t * ST_PITCH + (sm * 16 + q * 4) * 2) = o; }
        }
        ML_LOAD_KVG(kn);
        __syncthreads();
        f32x4 num0 = {0.f, 0.f, 0.f, 0.f}, num1 = {0.f, 0.f, 0.f, 0.f}; float den = 1.f;
        if (do_out) {
            const float wi = __expf(m - TABmm[t]);
            bf16x8 sb[2];
#pragma unroll
            for (int ks = 0; ks < 2; ++ks) sb[ks] = *(const LAS bf16x8*)(L + ST_OFF + t * ST_PITCH + (ks * 32 + q * 8) * 2);
#pragma unroll
            for (int ei = 0; ei < 3; ++ei) { const int em = ei < 2 ? wh * 2 + ei : 4;
                f32x4 a1 = {0.f, 0.f, 0.f, 0.f}, a2 = {0.f, 0.f, 0.f, 0.f};
#pragma unroll
                for (int ks = 0; ks < 2; ++ks) { const bf16x8 a = *(const LAS bf16x8*)(L + VT_OFF + (em * 16 + c16) * VT_PITCH + (ks * 32 + q * 8) * 2); a1 = ML_MFMA(a, sb[ks], a1); }
#pragma unroll
                for (int ks = 0; ks < 8; ++ks) { const bf16x8 a = *(const LAS bf16x8*)(L + CT_OFF + (em * 16 + c16) * CT_PITCH + (ks * 32 + q * 8) * 2); a2 = ML_MFMA(a, Qf[ks], a2); }
                const f32x4 nv = a1 + a2 * wi;
                if (ei == 0) num0 = nv; else if (ei == 1) num1 = nv;
                else den = fmaxf(fabsf(lane_get(nv[0], c16)), __expf(-(TABbc[t] + TABmm[t]))); }
        }
        ML_LOAD_Q(kn);
        if (do_out) { const float rd = 1.f / den; bf16_t* op = MH + ML_ROW(base, t) * DM + h * 256 + es * 64 + q * 4; const f32x4 o0 = num0 * rd, o1 = num1 * rd;
            v2u w0, w1; w0.x = pk2(o0[0], o0[1]); w0.y = pk2(o0[2], o0[3]); w1.x = pk2(o1[0], o1[1]); w1.y = pk2(o1[2], o1[3]);
            *(v2u*)(op + (wh * 2) * 16) = w0; *(v2u*)(op + (wh * 2 + 1) * 16) = w1; }
        { const float decay = __expf(m - mm63);
          bf16x8 vb[5][2];
#pragma unroll
          for (int en = 0; en < 5; ++en)
#pragma unroll
              for (int ks = 0; ks < 2; ++ks) vb[en][ks] = *(const LAS bf16x8*)(L + VT_OFF + (en * 16 + c16) * VT_PITCH + (ks * 32 + q * 8) * 2);
#pragma unroll
          for (int di = 0; di < 2; ++di) {
            bf16x8 a[2];
#pragma unroll
            for (int ks = 0; ks < 2; ++ks) a[ks] = *(const LAS bf16x8*)(L + KT_OFF + ((2 * w + di) * 16 + c16) * KT_PITCH + (ks * 32 + q * 8) * 2);
#pragma unroll
            for (int en = 0; en < 5; ++en) { f32x4 c = C[di][en] * decay;
#pragma unroll
                for (int ks = 0; ks < 2; ++ks) c = ML_MFMA(a[ks], vb[en][ks], c);
                C[di][en] = c; } } }
        __syncthreads();
    }
#undef ML_ROW
#undef ML_LOAD_KVG
#undef ML_LOAD_Q
}
constexpr int ST2_OFF = TAB_OFF + 1024, TAB2_OFF = ST2_OFF + 64 * ST_PITCH, END2_OFF = TAB2_OFF + 1024;
static_assert(END2_OFF <= MISC_OFF, "mLSTM LDS map (pipelined)");
template <int VAR> __device__ __forceinline__ void mlstm_unit_pipe(Frame& F, CArgs* ka, int u, bool need_ctx) {
    const int tid = tid_fresh(), lane = tid & 63, w = __builtin_amdgcn_readfirstlane(tid >> 6), c16 = lane & 15, q = lane >> 4;
    const int es = u & 3, dir = (u >> 2) & 1, h = (u >> 3) & 7, b = u >> 6;
    LAS unsigned char* L = F.lds;
    const bf16_t* X8 = WSB(WS_X8); constexpr size_t X8_SEC = (size_t)MROWS * DM; bf16_t* MH = (VAR ? WSB(WS_ACC) : WSB(WS_MH)) + (size_t)dir * MROWS * DM;
    const f32x4* GSC = (const f32x4*)WSF(WS_GSC) + (((size_t)b * 2 + dir) * 8 + h) * 36 * 64;
    __syncthreads();
    { unsigned z0 = 0u; asm volatile("" : "+v"(z0)); const v4u zz = {z0, z0, z0, z0};
      for (int i = tid; i < 80 * CT_PITCH / 16; i += 512) *(LAS v4u*)(L + CT_OFF + i * 16) = zz; }
    for (int i = tid; i < 16 * 64; i += 512) { const int e = 64 + (i >> 6), s = i & 63; *(LAS bf16_t*)(L + VT_OFF + e * VT_PITCH + s * 2) = (bf16_t)(e == 64 ? 0x3F80 : 0); }
    f32x4 C[2][5];
#pragma unroll
    for (int a = 0; a < 2; ++a)
#pragma unroll
        for (int e = 0; e < 5; ++e) C[a][e] = (f32x4){0.f, 0.f, 0.f, 0.f};
    const int tn = w & 3, wh = w >> 2, t = tn * 16 + c16;
    const int kl = (dir ? 63 - lane : lane) * 8, ql = q * 512 + (dir ? 63 - t : t) * 8;
    v4u kc[4], kn[4], vc; bf16x8 Qc[8], Qn[8]; float gc0, gc1, gc2, gn0, gn1, gn2;
#define MLP_ROW(base, j) ((size_t)(base) + (dir ? 63 - (j) : (j)))
#define MLP_TAB(par) ((LAS float*)(L + ((par) ? TAB2_OFF : TAB_OFF)))
#define MLP_ST(par) ((par) ? ST2_OFF : ST_OFF)
#define MLP_XB(sec, c_) (X8 + (size_t)(sec) * X8_SEC + ((size_t)(b * 8 + h) * 36 + (c_)) * (32 * 64 * 8))
#define MLP_LOADK(dst, k) do { const bf16_t* _xb = MLP_XB(1, chunk_of((k), dir)) + w * 4 * 512; \
        _Pragma("unroll") for (int i = 0; i < 4; ++i) dst[i] = *(const v4u*)(_xb + i * 512 + kl); } while (0)
#define MLP_LOADV(dst, k) do { dst = *(const v4u*)(MLP_XB(2, chunk_of((k), dir)) + (es * 8 + w) * 512 + kl); } while (0)
#define MLP_LOADG(d0, d1, d2, k) do { const float* _gp = (const float*)(GSC + chunk_of((k), dir) * 64 + lane); d0 = _gp[0]; d1 = _gp[1]; d2 = _gp[2]; } while (0)
#define MLP_LOADQ(dst, k) do { const bf16_t* _xb = MLP_XB(0, chunk_of((k), dir)); \
        _Pragma("unroll") for (int ks = 0; ks < 8; ++ks) dst[ks] = *(const bf16x8*)(_xb + ks * 2048 + ql); } while (0)
#define MLP_STILE(QQ, TB, SO) do { const float _mmt = (TB)[64 + t]; \
        _Pragma("unroll") for (int si = 0; si < 2; ++si) { const int sm = wh * 2 + si; v2u o = {0u, 0u}; \
            if (sm <= tn) { f32x4 acc = {0.f, 0.f, 0.f, 0.f}; \
                bf16x8 ka_[8]; \
                _Pragma("unroll") for (int ks = 0; ks < 8; ++ks) ka_[ks] = *(const LAS bf16x8*)(L + KS_OFF + (sm * 16 + c16) * KS_PITCH + (ks * 32 + q * 8) * 2); \
                __builtin_amdgcn_sched_barrier(0); \
                _Pragma("unroll") for (int ks = 0; ks < 8; ++ks) acc = ML_MFMA(ka_[ks], QQ[ks], acc); \
                float v[4]; \
                _Pragma("unroll") for (int j = 0; j < 4; ++j) { const int s = sm * 16 + q * 4 + j; v[j] = s <= t ? acc[j] * __expf((TB)[s] - _mmt) : 0.f; } \
                o.x = pk2(v[0], v[1]); o.y = pk2(v[2], v[3]); } \
            *(LAS v2u*)(L + (SO) + t * ST_PITCH + (sm * 16 + q * 4) * 2) = o; } } while (0)
    MLP_LOADK(kc, 0); MLP_LOADV(vc, 0); MLP_LOADG(gc0, gc1, gc2, 0); MLP_LOADQ(Qc, 0); MLP_LOADK(kn, 1); MLP_LOADG(gn0, gn1, gn2, 1); MLP_LOADQ(Qn, 1);
    float m = -1e30f;
    {
      const float mm = fmaxf(gc2, m); LAS float* TB = MLP_TAB(0);
      if (w == 0) { TB[lane] = gc1; TB[64 + lane] = mm; TB[128 + lane] = gc0; }
#pragma unroll
      for (int i = 0; i < 4; ++i) *(LAS v4u*)(L + KS_OFF + lane * KS_PITCH + (w * 4 + i) * 16) = kc[i];
      __syncthreads();
      if (need_ctx) MLP_STILE(Qc, TB, MLP_ST(0));
      __syncthreads(); }
#pragma unroll 1
    for (int k = 0; k < 36; ++k) {
        const int par = k & 1, k1 = k + 1 < 36 ? k + 1 : 35, k2 = k + 2 < 36 ? k + 2 : 35;
        const bool do_out = need_ctx || k >= 4, s_next = (k + 1 < 36) && (need_ctx || k + 1 >= 4);
        const size_t base = (size_t)b * TPB + chunk_of(k, dir) * 64;
        if (k > 0 && VAR != 2) {
#pragma unroll
            for (int di = 0; di < 2; ++di)
#pragma unroll
                for (int en = 0; en < 5; ++en) { const f32x4 c = C[di][en]; v2u o; o.x = pk2(c[0], c[1]); o.y = pk2(c[2], c[3]);
                    *(LAS v2u*)(L + CT_OFF + (en * 16 + c16) * CT_PITCH + ((2 * w + di) * 16 + q * 4) * 2) = o; } }
        const float mm = fmaxf(gc2, m), bL = lane_get(gc0, 63), mm63 = lane_get(mm, 63), wk = __expf(gc1 - mm63), m_next = bL + mm63;
#pragma unroll
        for (int i = 0; i < (VAR == 2 ? 1 : 4); ++i) {
#pragma unroll
            for (int e = 0; e < (VAR == 2 ? 1 : 4); ++e) { const unsigned x = kc[i][e]; const unsigned pk = pk2(blo(x) * wk, bhi(x) * wk);
                *(LAS bf16_t*)(L + KT_OFF + ((w * 4 + i) * 8 + 2 * e) * KT_PITCH + lane * 2) = (bf16_t)(pk & 0xffffu); *(LAS bf16_t*)(L + KT_OFF + ((w * 4 + i) * 8 + 2 * e + 1) * KT_PITCH + lane * 2) = (bf16_t)(pk >> 16); } }
#pragma unroll
        for (int e = 0; e < 4; ++e) { const unsigned x = vc[e];
            *(LAS bf16_t*)(L + VT_OFF + (w * 8 + 2 * e) * VT_PITCH + lane * 2) = (bf16_t)(x & 0xffffu); *(LAS bf16_t*)(L + VT_OFF + (w * 8 + 2 * e + 1) * VT_PITCH + lane * 2) = (bf16_t)(x >> 16); }
        { const float mmn = fmaxf(gn2, m_next); LAS float* TBn = MLP_TAB(par ^ 1);
          if (w == 0) { TBn[lane] = gn1; TBn[64 + lane] = mmn; TBn[128 + lane] = gn0; }
#pragma unroll
          for (int i = 0; i < (VAR == 2 ? 1 : 4); ++i) *(LAS v4u*)(L + KS_OFF + lane * KS_PITCH + (w * 4 + i) * 16) = kn[i]; }
        __syncthreads();
#pragma unroll
        for (int i = 0; i < 4; ++i) kc[i] = kn[i];
        gc0 = gn0; gc1 = gn1; gc2 = gn2;
        if (VAR != 3) { MLP_LOADK(kn, k2); MLP_LOADV(vc, k1); MLP_LOADG(gn0, gn1, gn2, k2); }
        const LAS float* TB = MLP_TAB(par);
        if (do_out && VAR != 1) {
            const float wi = __expf(m - TB[64 + t]); f32x4 num0 = {0.f, 0.f, 0.f, 0.f}, num1 = {0.f, 0.f, 0.f, 0.f}; float den = 1.f;
            bf16x8 sb[2];
#pragma unroll
            for (int ks = 0; ks < 2; ++ks) sb[ks] = *(const LAS bf16x8*)(L + MLP_ST(par) + t * ST_PITCH + (ks * 32 + q * 8) * 2);
#pragma unroll
            for (int ei = 0; ei < 3; ++ei) { const int em = ei < 2 ? wh * 2 + ei : 4;
                f32x4 a1 = {0.f, 0.f, 0.f, 0.f}, a2 = {0.f, 0.f, 0.f, 0.f}; bf16x8 va_[2], ca_[8];
#pragma unroll
                for (int ks = 0; ks < 2; ++ks) va_[ks] = *(const LAS bf16x8*)(L + VT_OFF + (em * 16 + c16) * VT_PITCH + (ks * 32 + q * 8) * 2);
#pragma unroll
                for (int ks = 0; ks < 8; ++ks) ca_[ks] = *(const LAS bf16x8*)(L + CT_OFF + (em * 16 + c16) * CT_PITCH + (ks * 32 + q * 8) * 2);
                __builtin_amdgcn_sched_barrier(0);
#pragma unroll
                for (int ks = 0; ks < 2; ++ks) a1 = ML_MFMA(va_[ks], sb[ks], a1);
#pragma unroll
                for (int ks = 0; ks < 8; ++ks) a2 = ML_MFMA(ca_[ks], Qc[ks], a2);
                __builtin_amdgcn_sched_barrier(0);
                const f32x4 nv = a1 + a2 * wi;
                if (ei == 0) num0 = nv; else if (ei == 1) num1 = nv;
                else den = fmaxf(fabsf(lane_get(nv[0], c16)), __expf(-(TB[128 + t] + TB[64 + t]))); }
            const float rd = 1.f / den; bf16_t* op = MH + MLP_ROW(base, t) * DM + h * 256 + es * 64 + q * 4; const f32x4 o0 = num0 * rd, o1 = num1 * rd;
            v2u w0, w1; w0.x = pk2(o0[0], o0[1]); w0.y = pk2(o0[2], o0[3]); w1.x = pk2(o1[0], o1[1]); w1.y = pk2(o1[2], o1[3]);
            *(v2u*)(op + (wh * 2) * 16) = w0; *(v2u*)(op + (wh * 2 + 1) * 16) = w1;
        }
        if (VAR != 1) { const float decay = __expf(m - mm63); bf16x8 vb_[5][2], ka2_[2][2];
#pragma unroll
          for (int en = 0; en < 5; ++en)
#pragma unroll
              for (int ks = 0; ks < 2; ++ks) vb_[en][ks] = *(const LAS bf16x8*)(L + VT_OFF + (en * 16 + c16) * VT_PITCH + (ks * 32 + q * 8) * 2);
#pragma unroll
          for (int di = 0; di < 2; ++di)
#pragma unroll
              for (int ks = 0; ks < 2; ++ks) ka2_[di][ks] = *(const LAS bf16x8*)(L + KT_OFF + ((2 * w + di) * 16 + c16) * KT_PITCH + (ks * 32 + q * 8) * 2);
#pragma unroll
          for (int di = 0; di < 2; ++di)
#pragma unroll
              for (int en = 0; en < 5; ++en) C[di][en] = C[di][en] * decay;
          __builtin_amdgcn_sched_barrier(0);
#pragma unroll
          for (int di = 0; di < 2; ++di)
#pragma unroll
              for (int en = 0; en < 5; ++en)
#pragma unroll
                  for (int ks = 0; ks < 2; ++ks) C[di][en] = ML_MFMA(ka2_[di][ks], vb_[en][ks], C[di][en]);
          __builtin_amdgcn_sched_barrier(0); }
        if (s_next && VAR != 1) MLP_STILE(Qn, MLP_TAB(par ^ 1), MLP_ST(par ^ 1));
#pragma unroll
        for (int ks = 0; ks < 8; ++ks) Qc[ks] = Qn[ks];
        if (VAR != 3) MLP_LOADQ(Qn, k2);
        m = m_next;
        __syncthreads();
    }
#undef MLP_ROW
#undef MLP_TAB
#undef MLP_ST
#undef MLP_XB
#undef MLP_LOADK
#undef MLP_LOADV
#undef MLP_LOADG
#undef MLP_LOADQ
#undef MLP_STILE
}
constexpr int T_CT = 0, T_CT_ROWS = 65;
constexpr int T_KS0 = T_CT + T_CT_ROWS * CT_PITCH, T_KS1 = T_KS0 + 64 * KS_PITCH;
constexpr int T_VS = T_KS1 + 64 * KS_PITCH, T_VPITCH = 160, T_VSW = T_VS + 64 * T_VPITCH;
constexpr int T_ST0 = T_VSW + 64 * T_VPITCH, T_ST1 = T_ST0 + 64 * ST_PITCH, T_TAB0 = T_ST1 + 64 * ST_PITCH, T_TAB1 = T_TAB0 + 1024, T_END = T_TAB1 + 1024;
static_assert(T_END <= MISC_OFF && T_CT + 80 * CT_PITCH <= T_END && T_KS0 % 16 == 0, "mLSTM LDS map (transposed reads)");
typedef short s16x4 __attribute__((ext_vector_type(4)));
template <int OFF> __device__ __forceinline__ s16x4 tr4(unsigned addr) { s16x4 r; asm volatile("ds_read_b64_tr_b16 %0, %1 offset:%2" : "=&v"(r) : "v"(addr), "i"(OFF) : "memory"); return r; }
#define TR_FRAG(OUT, addr, OFF0, OFF1) do { const s16x4 _a = tr4<(OFF0)>(addr), _b = tr4<(OFF1)>(addr); OUT##_lo = _a; OUT##_hi = _b; } while (0)
#define TR_JOIN(lo, hi) ((bf16x8){lo[0], lo[1], lo[2], lo[3], hi[0], hi[1], hi[2], hi[3]})
__device__ __forceinline__ void mlstm_unit_tr(Frame& F, CArgs* ka, int u, bool need_ctx) {
    const int tid = tid_fresh(), lane = tid & 63, w = __builtin_amdgcn_readfirstlane(tid >> 6), c16 = lane & 15, q = lane >> 4;
    const int es = u & 3, dir = (u >> 2) & 1, h = (u >> 3) & 7, b = u >> 6;
    LAS unsigned char* L = F.lds;
    const bf16_t* X8 = WSB(WS_X8); constexpr size_t X8_SEC = (size_t)MROWS * DM; bf16_t* MH = WSB(WS_MH) + (size_t)dir * MROWS * DM;
    const f32x4* GSC = (const f32x4*)WSF(WS_GSC) + (((size_t)b * 2 + dir) * 8 + h) * 36 * 64;
    __syncthreads();
    { unsigned z0 = 0u; asm volatile("" : "+v"(z0)); const v4u zz = {z0, z0, z0, z0};
      for (int i = tid; i < T_CT_ROWS * CT_PITCH / 16; i += 512) *(LAS v4u*)(L + T_CT + i * 16) = zz;
      if (tid < 128) { const int s = tid & 63, hf = tid >> 6; v4u one = zz; if (hf == 0) one.x = 0x3F80u;
          *(LAS v4u*)(L + T_VS + s * T_VPITCH + 128 + hf * 16) = one; *(LAS v4u*)(L + T_VSW + s * T_VPITCH + 128 + hf * 16) = zz; } }
    f32x4 C[2][5];
#pragma unroll
    for (int a = 0; a < 2; ++a)
#pragma unroll
        for (int e = 0; e < 5; ++e) C[a][e] = (f32x4){0.f, 0.f, 0.f, 0.f};
    const int tn = w & 3, wh = w >> 2, t = tn * 16 + c16;
    const int kl = (dir ? 63 - lane : lane) * 8, ql = q * 512 + (dir ? 63 - t : t) * 8;
    const unsigned LB = (unsigned)(size_t)L;
    const unsigned trK = (unsigned)((8 * q + (c16 >> 2)) * KS_PITCH + 8 * (lane & 3) + 64 * w), trV = (unsigned)((8 * q + (c16 >> 2)) * T_VPITCH + 8 * (lane & 3));
    v4u kn[4], vc; bf16x8 Qc[8], Qn[8]; float gc0, gc1, gc2, gn0, gn1, gn2;
#define MLP_ROW(base, j) ((size_t)(base) + (dir ? 63 - (j) : (j)))
#define MLP_TAB(par) ((LAS float*)(L + ((par) ? T_TAB1 : T_TAB0)))
#define MLP_ST(par) ((par) ? T_ST1 : T_ST0)
#define MLP_KS(par) ((par) ? T_KS1 : T_KS0)
#define MLP_XB(sec, c_) (X8 + (size_t)(sec) * X8_SEC + ((size_t)(b * 8 + h) * 36 + (c_)) * (32 * 64 * 8))
#define MLP_LOADK(dst, k) do { const bf16_t* _xb = MLP_XB(1, chunk_of((k), dir)) + w * 4 * 512; \
        _Pragma("unroll") for (int i = 0; i < 4; ++i) dst[i] = *(const v4u*)(_xb + i * 512 + kl); } while (0)
#define MLP_LOADV(dst, k) do { dst = *(const v4u*)(MLP_XB(2, chunk_of((k), dir)) + (es * 8 + w) * 512 + kl); } while (0)
#define MLP_LOADG(d0, d1, d2, k) do { const float* _gp = (const float*)(GSC + chunk_of((k), dir) * 64 + lane); d0 = _gp[0]; d1 = _gp[1]; d2 = _gp[2]; } while (0)
#define MLP_LOADQ(dst, k) do { const bf16_t* _xb = MLP_XB(0, chunk_of((k), dir)); \
        _Pragma("unroll") for (int ks = 0; ks < 8; ++ks) dst[ks] = *(const bf16x8*)(_xb + ks * 2048 + ql); } while (0)
#define MLP_STILE(QQ, TB, SO, KSO) do { const float _mmt = (TB)[64 + t]; \
        _Pragma("unroll") for (int si = 0; si < 2; ++si) { const int sm = wh * 2 + si; v2u o = {0u, 0u}; \
            if (sm <= tn) { f32x4 acc = {0.f, 0.f, 0.f, 0.f}; \
                bf16x8 ka_[8]; \
                _Pragma("unroll") for (int ks = 0; ks < 8; ++ks) ka_[ks] = *(const LAS bf16x8*)(L + (KSO) + (sm * 16 + c16) * KS_PITCH + (ks * 32 + q * 8) * 2); \
                __builtin_amdgcn_sched_barrier(0); \
                _Pragma("unroll") for (int ks = 0; ks < 8; ++ks) acc = ML_MFMA(ka_[ks], QQ[ks], acc); \
                float v[4]; \
                _Pragma("unroll") for (int j = 0; j < 4; ++j) { const int s = sm * 16 + q * 4 + j; v[j] = s <= t ? acc[j] * __expf((TB)[s] - _mmt) : 0.f; } \
                o.x = pk2(v[0], v[1]); o.y = pk2(v[2], v[3]); } \
            *(LAS v2u*)(L + (SO) + t * ST_PITCH + (sm * 16 + q * 4) * 2) = o; } } while (0)
    MLP_LOADK(kn, 0); MLP_LOADV(vc, 0); MLP_LOADG(gc0, gc1, gc2, 0); MLP_LOADQ(Qc, 0); MLP_LOADG(gn0, gn1, gn2, 1); MLP_LOADQ(Qn, 1);
    float m = -1e30f;
    { const float mm = fmaxf(gc2, m); LAS float* TB = MLP_TAB(0);
      if (w == 0) { TB[lane] = gc1; TB[64 + lane] = mm; TB[128 + lane] = gc0; }
#pragma unroll
      for (int i = 0; i < 4; ++i) *(LAS v4u*)(L + T_KS0 + lane * KS_PITCH + (w * 4 + i) * 16) = kn[i];
      MLP_LOADK(kn, 1);
      __syncthreads();
      if (need_ctx) MLP_STILE(Qc, TB, MLP_ST(0), T_KS0);
      __syncthreads(); }
#pragma unroll 1
    for (int k = 0; k < 36; ++k) {
        const int par = k & 1, k1 = k + 1 < 36 ? k + 1 : 35, k2 = k + 2 < 36 ? k + 2 : 35;
        const bool do_out = need_ctx || k >= 4, s_next = (k + 1 < 36) && (need_ctx || k + 1 >= 4);
        const size_t base = (size_t)b * TPB + chunk_of(k, dir) * 64;
        if (k > 0) {
#pragma unroll
            for (int di = 0; di < 2; ++di)
#pragma unroll
                for (int en = 0; en < 5; ++en) { const f32x4 c = C[di][en]; v2u o; o.x = pk2(c[0], c[1]); o.y = pk2(c[2], c[3]);
                    if (en < 4 || c16 == 0) *(LAS v2u*)(L + T_CT + (en * 16 + c16) * CT_PITCH + ((2 * w + di) * 16 + q * 4) * 2) = o; } }
        const float mm = fmaxf(gc2, m), bL = lane_get(gc0, 63), mm63 = lane_get(mm, 63), wk = __expf(gc1 - mm63), m_next = bL + mm63;
        { *(LAS v4u*)(L + T_VS + lane * T_VPITCH + w * 16) = vc;
          v4u sv;
#pragma unroll
          for (int e = 0; e < 4; ++e) sv[e] = pk2(blo(vc[e]) * wk, bhi(vc[e]) * wk);
          *(LAS v4u*)(L + T_VSW + lane * T_VPITCH + w * 16) = sv;
          if (w == 0) *(LAS bf16_t*)(L + T_VSW + lane * T_VPITCH + 128) = (bf16_t)(pk2(wk, 0.f) & 0xffffu); }
        { const float mmn = fmaxf(gn2, m_next); LAS float* TBn = MLP_TAB(par ^ 1);
          if (w == 0) { TBn[lane] = gn1; TBn[64 + lane] = mmn; TBn[128 + lane] = gn0; }
#pragma unroll
          for (int i = 0; i < 4; ++i) *(LAS v4u*)(L + MLP_KS(par ^ 1) + lane * KS_PITCH + (w * 4 + i) * 16) = kn[i]; }
        __syncthreads();
        gc0 = gn0; gc1 = gn1; gc2 = gn2;
        MLP_LOADK(kn, k2); MLP_LOADV(vc, k1); MLP_LOADG(gn0, gn1, gn2, k2);
        const LAS float* TB = MLP_TAB(par);
        if (do_out) {
            const float wi = __expf(m - TB[64 + t]); f32x4 num0 = {0.f, 0.f, 0.f, 0.f}, num1 = {0.f, 0.f, 0.f, 0.f}; float den = 1.f;
            bf16x8 sb[2];
#pragma unroll
            for (int ks = 0; ks < 2; ++ks) sb[ks] = *(const LAS bf16x8*)(L + MLP_ST(par) + t * ST_PITCH + (ks * 32 + q * 8) * 2);
#pragma unroll
            for (int ei = 0; ei < 3; ++ei) { const int em = ei < 2 ? wh * 2 + ei : 4;
                f32x4 a1 = {0.f, 0.f, 0.f, 0.f}, a2 = {0.f, 0.f, 0.f, 0.f}; bf16x8 ca_[8];
                const unsigned va = LB + T_VS + trV + 32 * em;
                const s16x4 v00 = tr4<0>(va), v01 = tr4<4 * T_VPITCH>(va), v10 = tr4<32 * T_VPITCH>(va), v11 = tr4<36 * T_VPITCH>(va);
#pragma unroll
                for (int ks = 0; ks < 8; ++ks) ca_[ks] = *(const LAS bf16x8*)(L + T_CT + (em * 16 + c16) * CT_PITCH + (ks * 32 + q * 8) * 2);
                asm volatile("s_waitcnt lgkmcnt(0)" ::: "memory"); __builtin_amdgcn_sched_barrier(0);
                a1 = ML_MFMA(TR_JOIN(v00, v01), sb[0], a1); a1 = ML_MFMA(TR_JOIN(v10, v11), sb[1], a1);
#pragma unroll
                for (int ks = 0; ks < 8; ++ks) a2 = ML_MFMA(ca_[ks], Qc[ks], a2);
                __builtin_amdgcn_sched_barrier(0);
                const f32x4 nv = a1 + a2 * wi;
                if (ei == 0) num0 = nv; else if (ei == 1) num1 = nv;
                else den = fmaxf(fabsf(lane_get(nv[0], c16)), __expf(-(TB[128 + t] + TB[64 + t]))); }
            const float rd = 1.f / den; bf16_t* op = MH + MLP_ROW(base, t) * DM + h * 256 + es * 64 + q * 4; const f32x4 o0 = num0 * rd, o1 = num1 * rd;
            v2u w0, w1; w0.x = pk2(o0[0], o0[1]); w0.y = pk2(o0[2], o0[3]); w1.x = pk2(o1[0], o1[1]); w1.y = pk2(o1[2], o1[3]);
            *(v2u*)(op + (wh * 2) * 16) = w0; *(v2u*)(op + (wh * 2 + 1) * 16) = w1;
        }
        {
          const float decay = __expf(m - mm63);
          const unsigned ka_ = LB + MLP_KS(par) + trK, vb_ = LB + T_VSW + trV;
          const s16x4 k000 = tr4<0>(ka_), k001 = tr4<4 * KS_PITCH>(ka_), k010 = tr4<32 * KS_PITCH>(ka_), k011 = tr4<36 * KS_PITCH>(ka_);
          const s16x4 k100 = tr4<32>(ka_), k101 = tr4<4 * KS_PITCH + 32>(ka_), k110 = tr4<32 * KS_PITCH + 32>(ka_), k111 = tr4<36 * KS_PITCH + 32>(ka_);
          s16x4 vq[5][4];
#define TRV(en) do { vq[en][0] = tr4<32 * (en)>(vb_); vq[en][1] = tr4<4 * T_VPITCH + 32 * (en)>(vb_); vq[en][2] = tr4<32 * T_VPITCH + 32 * (en)>(vb_); vq[en][3] = tr4<36 * T_VPITCH + 32 * (en)>(vb_); } while (0)
          TRV(0); TRV(1); TRV(2); TRV(3); TRV(4);
#undef TRV
#pragma unroll
          for (int di = 0; di < 2; ++di)
#pragma unroll
              for (int en = 0; en < 5; ++en) C[di][en] = C[di][en] * decay;
          asm volatile("s_waitcnt lgkmcnt(0)" ::: "memory"); __builtin_amdgcn_sched_barrier(0);
#pragma unroll
          for (int en = 0; en < 5; ++en) { const bf16x8 b0 = TR_JOIN(vq[en][0], vq[en][1]), b1 = TR_JOIN(vq[en][2], vq[en][3]);
              C[0][en] = ML_MFMA(TR_JOIN(k000, k001), b0, C[0][en]); C[0][en] = ML_MFMA(TR_JOIN(k010, k011), b1, C[0][en]);
              C[1][en] = ML_MFMA(TR_JOIN(k100, k101), b0, C[1][en]); C[1][en] = ML_MFMA(TR_JOIN(k110, k111), b1, C[1][en]); }
          __builtin_amdgcn_sched_barrier(0); }
        if (s_next) MLP_STILE(Qn, MLP_TAB(par ^ 1), MLP_ST(par ^ 1), MLP_KS(par ^ 1));
#pragma unroll
        for (int ks = 0; ks < 8; ++ks) Qc[ks] = Qn[ks];
        MLP_LOADQ(Qn, k2);
        m = m_next;
        __syncthreads();
    }
#undef MLP_ROW
#undef MLP_TAB
#undef MLP_ST
#undef MLP_KS
#undef MLP_XB
#undef MLP_LOADK
#undef MLP_LOADV
#undef MLP_LOADG
#undef MLP_LOADQ
#undef MLP_STILE
}
}

namespace lru {
typedef short bf16x8 __attribute__((ext_vector_type(8)));
constexpr int XB_OFF = 0, XB_PITCH = 272;
constexpr int XF_OFF = XB_OFF + 64 * XB_PITCH, XF_PITCH = 528;
constexpr int YO_OFF = XF_OFF + 64 * XF_PITCH, YO_PITCH = 528;
constexpr int HIN_OFF = YO_OFF + 64 * YO_PITCH;
constexpr int CW_OFF = HIN_OFF + 9 * 2 * 128 * 4;
constexpr int END_OFF = CW_OFF + 5 * 128 * 4;
static_assert(END_OFF <= MISC_OFF, "LRU LDS map");
#define LRU_COMPOSE(A, B, a2, b2) do { B = (a2) * B + (b2); A = (a2) * A; } while (0)

template <bool FINAL, int VAR, class BcOf>
__device__ __forceinline__ void lru_run(Frame& F, CArgs* ka, int l, int blk, int NU, const BcOf& bc_of) {
    const int tid = tid_fresh(), lane = tid & 63, w = __builtin_amdgcn_readfirstlane(tid >> 6), c16 = lane & 15, q = lane >> 4;
    LAS unsigned char* L = F.lds; const bf16_t* P = WSB(WS_P);
    const int cg = tid & 15, rg = tid >> 4, chl = 16 * w + c16, ch = blk * 128 + chl;
    constexpr bool LOADAB = FINAL && LRU_AB && LRU_AB_LOAD, STOREAB = !FINAL && LRU_AB && VAR == 0;
    v4u* ABG = (v4u*)WSF(WS_HL);
    bf16x8 bw[4][4];
    if constexpr (!LOADAB) { const bf16_t* Wt = WSB(WS_WLRU) + (size_t)l * 4 * 16 * 16384 + ((size_t)blk * 128 + chl) * 128 + q * 8;
#pragma unroll
      for (int g = 0; g < 4; ++g)
#pragma unroll
          for (int ks = 0; ks < 4; ++ks) bw[g][ks] = *(const bf16x8*)(Wt + (size_t)g * 16 * 16384 + ks * 32); }
    float cbr[2] = {0.f, 0.f}, cbi[2] = {0.f, 0.f}, csp[2] = {0.f, 0.f};
    if constexpr (!LOADAB) {
#pragma unroll
    for (int dr = 0; dr < 2; ++dr) { cbr[dr] = KIN(12)[((size_t)l * 2 + dr) * DM + ch]; cbi[dr] = KIN(14)[((size_t)l * 2 + dr) * DM + ch]; csp[dr] = log1pf(__expf(-KIN(15)[((size_t)l * 2 + dr) * DM + ch])); } }
    if constexpr (!LOADAB) for (int i = tid; i < 5 * 128; i += 512) { const int kk = i >> 7, c = i & 127; ((LAS float*)(L + CW_OFF))[i] = kk < 4 ? KIN(9)[((size_t)l * 4 + kk) * DM + blk * 128 + c] : KIN(10)[(size_t)l * DM + blk * 128 + c]; }
    v4u raw[5];
#define LRU_LOAD(i) do { int _b, _c; bc_of((i), _b, _c); const int _t0 = _c * 64, _lo = _c < 32 ? 0 : SEQ, _hi = _c < 32 ? SEQ : TPB; const size_t _rb = (size_t)_b * TPB; \
        _Pragma("unroll") for (int x = 0; x < 5; ++x) { const int tt = _t0 + 2 * rg - 2 + x; raw[x] = (v4u){0u, 0u, 0u, 0u}; if (tt >= _lo && tt < _hi) raw[x] = *(const v4u*)(P + (_rb + tt) * NP + C_LX + blk * 128 + cg * 8); } \
        } while (0)
    v4u abn[2][4];
#define LRU_LOADAB(i) do { int _b, _c; bc_of((i), _b, _c); const size_t _u = ((size_t)_b * 36 + _c) * 16 + blk; \
        _Pragma("unroll") for (int d_ = 0; d_ < 2; ++d_) _Pragma("unroll") for (int m_ = 0; m_ < 4; ++m_) abn[d_][m_] = ABG[((_u * 2 + d_) * 4 + m_) * 512 + tid]; } while (0)
    if constexpr (LOADAB) LRU_LOADAB(0); else LRU_LOAD(0);
#pragma unroll 1
    for (int ui = 0; ui < NU; ++ui) {
        int b, chunk; bc_of(ui, b, chunk); const size_t rb = (size_t)b * TPB; const int t0 = chunk * 64;
        __syncthreads();
        if constexpr (!LOADAB) {
          float o0[8], o1[8]; const LAS float* cwl = (const LAS float*)(L + CW_OFF) + cg * 8;
#pragma unroll
          for (int e = 0; e < 8; ++e) { o0[e] = cwl[4 * 128 + e]; o1[e] = o0[e]; }
#pragma unroll
          for (int kk = 0; kk < 5; ++kk) { float xin[8];
#pragma unroll
              for (int e = 0; e < 4; ++e) { xin[2 * e] = blo(raw[kk][e]); xin[2 * e + 1] = bhi(raw[kk][e]); }
#pragma unroll
              for (int e = 0; e < 8; ++e) { if (kk < 4) o0[e] += cwl[kk * 128 + e] * xin[e]; if (kk > 0) o1[e] += cwl[(kk - 1) * 128 + e] * xin[e]; } }
          v4u p0, p1; p0.x = pk2(o0[0], o0[1]); p0.y = pk2(o0[2], o0[3]); p0.z = pk2(o0[4], o0[5]); p0.w = pk2(o0[6], o0[7]); p1.x = pk2(o1[0], o1[1]); p1.y = pk2(o1[2], o1[3]); p1.z = pk2(o1[4], o1[5]); p1.w = pk2(o1[6], o1[7]);
          *(LAS v4u*)(L + XB_OFF + (2 * rg) * XB_PITCH + cg * 16) = p0; *(LAS v4u*)(L + XB_OFF + (2 * rg + 1) * XB_PITCH + cg * 16) = p1;
          LAS float* f0 = (LAS float*)(L + XF_OFF + (2 * rg) * XF_PITCH + cg * 32); LAS float* f1 = (LAS float*)(L + XF_OFF + (2 * rg + 1) * XF_PITCH + cg * 32);
          *(LAS f32x4*)f0 = (f32x4){o0[0], o0[1], o0[2], o0[3]}; *(LAS f32x4*)(f0 + 4) = (f32x4){o0[4], o0[5], o0[6], o0[7]};
          *(LAS f32x4*)f1 = (f32x4){o1[0], o1[1], o1[2], o1[3]}; *(LAS f32x4*)(f1 + 4) = (f32x4){o1[4], o1[5], o1[6], o1[7]}; }
        __syncthreads();
        v4u zcur[2];
        if (FINAL) {
#pragma unroll
            for (int x = 0; x < 2; ++x) { const int cidx = tid + 512 * x; zcur[x] = *(const v4u*)(P + (rb + t0 + (cidx >> 4)) * NP + C_LZ + blk * 128 + (cidx & 15) * 8); } }
        v4u abc[2][4];
        if constexpr (LOADAB) {
#pragma unroll
            for (int d_ = 0; d_ < 2; ++d_)
#pragma unroll
                for (int m_ = 0; m_ < 4; ++m_) abc[d_][m_] = abn[d_][m_];
            if (ui + 1 < NU) LRU_LOADAB(ui + 1); }
        else { if (ui + 1 < NU) LRU_LOAD(ui + 1); }
        const size_t uidx = ((size_t)b * 36 + chunk) * 16 + blk; (void)uidx;
#pragma unroll
        for (int dr = 0; dr < 2; ++dr) {
            f32x4 acc[2][4];
#pragma unroll
            for (int g = 0; g < 2; ++g)
#pragma unroll
                for (int tm = 0; tm < 4; ++tm) acc[g][tm] = (f32x4){0.f, 0.f, 0.f, 0.f};
            if constexpr (LOADAB) {
                typedef _Float16 h2_t __attribute__((ext_vector_type(2)));
#pragma unroll
                for (int tm = 0; tm < 4; ++tm)
#pragma unroll
                    for (int j = 0; j < 4; ++j) { const unsigned wj_ = abc[dr][tm][j]; const h2_t hv = __builtin_bit_cast(h2_t, wj_);   acc[0][tm][j] = __builtin_amdgcn_exp2f((float)hv.x); acc[1][tm][j] = (float)hv.y; }
            } else {
            if (VAR < 2) {
#pragma unroll
            for (int ks = 0; ks < 4; ++ks) { bf16x8 a[4];
#pragma unroll
                for (int tm = 0; tm < 4; ++tm) a[tm] = *(const LAS bf16x8*)(L + XB_OFF + (tm * 16 + c16) * XB_PITCH + (ks * 32 + q * 8) * 2);
#pragma unroll
                for (int g = 0; g < 2; ++g)
#pragma unroll
                    for (int tm = 0; tm < 4; ++tm) acc[g][tm] = __builtin_amdgcn_mfma_f32_16x16x32_bf16(a[tm], bw[2 * dr + g][ks], acc[g][tm], 0, 0, 0); } }
            if (VAR < 1) {
                typedef float f32x2 __attribute__((ext_vector_type(2)));
                const float NL2E = -1.4426950408889634f; const float kr = cbr[dr] * NL2E, ki = cbi[dr] * NL2E, c16l = -16.f * csp[dr], c8l2 = -8.f * csp[dr] * 1.4426950408889634f;
#pragma unroll
                for (int tm = 0; tm < 4; ++tm) { float l2t[4];
#pragma unroll
                    for (int jp = 0; jp < 2; ++jp) { const int t = tm * 16 + q * 4 + 2 * jp;
                        const f32x2 xv = {*(const LAS float*)(L + XF_OFF + t * XF_PITCH + chl * 4), *(const LAS float*)(L + XF_OFF + (t + 1) * XF_PITCH + chl * 4)};
                        const f32x2 ar = {acc[0][tm][2 * jp], acc[0][tm][2 * jp + 1]}, ai = {acc[1][tm][2 * jp], acc[1][tm][2 * jp + 1]};
                        f32x2 tr = ar * NL2E + kr, ti = ai * NL2E + ki; tr.x = fminf(tr.x, 60.f); tr.y = fminf(tr.y, 60.f); ti.x = fminf(ti.x, 60.f); ti.y = fminf(ti.y, 60.f);
                        f32x2 er, ei; er.x = __builtin_amdgcn_exp2f(tr.x); er.y = __builtin_amdgcn_exp2f(tr.y); ei.x = __builtin_amdgcn_exp2f(ti.x); ei.y = __builtin_amdgcn_exp2f(ti.y);
                        const f32x2 pr = er + 1.f, pi = ei + 1.f, dn = pr * pi; f32x2 R; R.x = __builtin_amdgcn_rcpf(dn.x); R.y = __builtin_amdgcn_rcpf(dn.y);
                        const f32x2 rgt = R * pi, igt = R * pr, x2 = rgt * c16l, l2 = rgt * c8l2;
                        f32x2 av; av.x = __builtin_amdgcn_exp2f(l2.x); av.y = __builtin_amdgcn_exp2f(l2.y);
                        const f32x2 ser = -x2 * (x2 * (x2 * (x2 * (x2 * 0.0083333338f + 0.041666668f) + 0.16666667f) + 0.5f) + 1.f), dir_ = 1.f - av * av;
                        f32x2 om; om.x = x2.x > -0.1f ? ser.x : dir_.x; om.y = x2.y > -0.1f ? ser.y : dir_.y;
                        f32x2 sq; sq.x = __builtin_amdgcn_sqrtf(om.x); sq.y = __builtin_amdgcn_sqrtf(om.y);
                        const f32x2 bxv = sq * igt * xv;
                        l2t[2 * jp] = l2.x; l2t[2 * jp + 1] = l2.y;
                        acc[0][tm][2 * jp] = av.x; acc[0][tm][2 * jp + 1] = av.y; acc[1][tm][2 * jp] = bxv.x; acc[1][tm][2 * jp + 1] = bxv.y; }
                    if constexpr (STOREAB) { v4u wv_;
#pragma unroll
                        for (int j = 0; j < 4; ++j) wv_[j] = __builtin_bit_cast(unsigned, __builtin_amdgcn_cvt_pkrtz(l2t[j], acc[1][tm][j]));
                        ABG[((uidx * 2 + dr) * 4 + tm) * 512 + tid] = wv_; } } }
            }
#define LRU_TM(i) (dr ? 3 - (i) : (i))
            if constexpr (!FINAL) { if (VAR < 3) {
                float2* AGG = (float2*)(VAR ? WSF(WS_ACC) : WSF(WS_LA)); float TA = 1.f, TB = 0.f;
#pragma unroll
                for (int ti = 0; ti < 4; ++ti) { const int tm = LRU_TM(ti); float sa = 1.f, sb = 0.f;
#pragma unroll
                    for (int ji = 0; ji < 4; ++ji) { const int j = LRU_TM(ji); LRU_COMPOSE(sa, sb, acc[0][tm][j], acc[1][tm][j]); }
#pragma unroll
                    for (int qi = 0; qi < 4; ++qi) { const int qq = LRU_TM(qi); const float xa = lane_get(sa, c16 + 16 * qq), xb = lane_get(sb, c16 + 16 * qq); LRU_COMPOSE(TA, TB, xa, xb); } }
                if (q == 0) AGG[(((size_t)b * 36 + chunk) * 2 + dr) * DM + ch] = make_float2(TA, TB); }
            } else {
                float H = ((const LAS float*)(L + HIN_OFF))[ui * 256 + dr * 128 + chl];
#pragma unroll
                for (int ti = 0; ti < 4; ++ti) { const int tm = LRU_TM(ti); float sa = 1.f, sb = 0.f;
#pragma unroll
                    for (int ji = 0; ji < 4; ++ji) { const int j = LRU_TM(ji); LRU_COMPOSE(sa, sb, acc[0][tm][j], acc[1][tm][j]); }
                    float ea = 1.f, eb = 0.f, ta = 1.f, tb = 0.f;
#pragma unroll
                    for (int qi = 0; qi < 4; ++qi) { const int qq = LRU_TM(qi); const float xa = lane_get(sa, c16 + 16 * qq), xb = lane_get(sb, c16 + 16 * qq); if (qq == q) { ea = ta; eb = tb; } LRU_COMPOSE(ta, tb, xa, xb); }
                    float hs = ea * H + eb;
#pragma unroll
                    for (int ji = 0; ji < 4; ++ji) { const int j = LRU_TM(ji); hs = acc[0][tm][j] * hs + acc[1][tm][j]; LAS float* yp = (LAS float*)(L + YO_OFF + (tm * 16 + q * 4 + j) * YO_PITCH + chl * 4);
                        if (dr == 0) *yp = hs; else *yp += hs; }
                    H = ta * H + tb; }
            }
#undef LRU_TM
        }
        if constexpr (FINAL) {
            __syncthreads();
            bf16_t* YB0 = WSB(WS_YB);
#pragma unroll
            for (int i = 0; i < 2; ++i) { const int cidx = tid + 512 * i, row = cidx >> 4, cgo = cidx & 15; const size_t rgl = rb + t0 + row;
                const f32x4 y0 = *(const LAS f32x4*)(L + YO_OFF + row * YO_PITCH + cgo * 32), y1 = *(const LAS f32x4*)(L + YO_OFF + row * YO_PITCH + cgo * 32 + 16);
                const v4u z = zcur[i];
                v4u o; o.x = pk2(y0[0] * blo(z.x), y0[1] * bhi(z.x)); o.y = pk2(y0[2] * blo(z.y), y0[3] * bhi(z.y)); o.z = pk2(y1[0] * blo(z.z), y1[1] * bhi(z.z)); o.w = pk2(y1[2] * blo(z.w), y1[3] * bhi(z.w));
                *(v4u*)(YB0 + rgl * DM + blk * 128 + cgo * 8) = o; }
        }
    }
#undef LRU_LOAD
#undef LRU_LOADAB
}
constexpr int CW_LRUFLAG = 32768, LRU_FLAG_STRIDE = 16;
__device__ __forceinline__ void p_lru_lookback(Frame& F, CArgs* ka, int l) {
    const int tid = tid_fresh(), lane = tid & 63, w = __builtin_amdgcn_readfirstlane(tid >> 6), c16 = lane & 15, q = lane >> 4;
    const int npar = F.G / 36; if (F.wg >= npar * 36) return;
    const int slot = F.wg / 36, chunk = F.wg - slot * 36, cps = (64 + npar - 1) / npar;
    LAS unsigned char* L = F.lds; const bf16_t* P = WSB(WS_P);
    unsigned* ctl = (unsigned*)(ka->ws + WS_CTL); unsigned long long* AGG = (unsigned long long*)WSF(WS_LA) + (size_t)l * 64 * 36 * 2 * 128;
    const unsigned epoch = (unsigned)(l + 1);
    const int cg = tid & 15, rg = tid >> 4, chl = 16 * w + c16;
    const int t0 = chunk * 64, lo = chunk < 32 ? 0 : SEQ, hi = chunk < 32 ? SEQ : TPB;
    int cur_blk = -1;
    v4u raw[5];
#define LRU_LOADX(colx) do { const int _b = (colx) & 3, _blk = (colx) >> 2; const size_t _rb = (size_t)_b * TPB; \
        _Pragma("unroll") for (int x = 0; x < 5; ++x) { const int tt = t0 + 2 * rg - 2 + x; raw[x] = (v4u){0u, 0u, 0u, 0u}; if (tt >= lo && tt < hi) raw[x] = *(const v4u*)(P + (_rb + tt) * NP + C_LX + _blk * 128 + cg * 8); } } while (0)
    const int col0 = slot * cps, col1 = (col0 + cps) < 64 ? (col0 + cps) : 64;
    if (col0 < col1) LRU_LOADX(col0);
#pragma unroll 1
    for (int col = col0; col < col1; ++col) {
        const int b = col & 3, blk = col >> 2, ch = blk * 128 + chl; const size_t rb = (size_t)b * TPB;
        __syncthreads();
        bf16x8 bw[4][4]; float cbr[2], cbi[2], csp[2];
        { const bf16_t* Wt = WSB(WS_WLRU) + (size_t)l * 4 * 16 * 16384 + ((size_t)blk * 128 + chl) * 128 + q * 8;
#pragma unroll
          for (int g = 0; g < 4; ++g)
#pragma unroll
              for (int ks = 0; ks < 4; ++ks) bw[g][ks] = *(const bf16x8*)(Wt + (size_t)g * 16 * 16384 + ks * 32);
#pragma unroll
          for (int dr = 0; dr < 2; ++dr) { cbr[dr] = KIN(12)[((size_t)l * 2 + dr) * DM + ch]; cbi[dr] = KIN(14)[((size_t)l * 2 + dr) * DM + ch]; csp[dr] = log1pf(__expf(-KIN(15)[((size_t)l * 2 + dr) * DM + ch])); } }
        if (blk != cur_blk) { cur_blk = blk;
            for (int i = tid; i < 5 * 128; i += 512) { const int kk = i >> 7, c = i & 127; ((LAS float*)(L + CW_OFF))[i] = kk < 4 ? KIN(9)[((size_t)l * 4 + kk) * DM + blk * 128 + c] : KIN(10)[(size_t)l * DM + blk * 128 + c]; }
            __syncthreads(); }
        {
          float o0[8], o1[8]; const LAS float* cwl = (const LAS float*)(L + CW_OFF) + cg * 8;
#pragma unroll
          for (int e = 0; e < 8; ++e) { o0[e] = cwl[4 * 128 + e]; o1[e] = o0[e]; }
#pragma unroll
          for (int kk = 0; kk < 5; ++kk) { float xin[8];
#pragma unroll
              for (int e = 0; e < 4; ++e) { xin[2 * e] = blo(raw[kk][e]); xin[2 * e + 1] = bhi(raw[kk][e]); }
#pragma unroll
              for (int e = 0; e < 8; ++e) { if (kk < 4) o0[e] += cwl[kk * 128 + e] * xin[e]; if (kk > 0) o1[e] += cwl[(kk - 1) * 128 + e] * xin[e]; } }
          v4u p0, p1; p0.x = pk2(o0[0], o0[1]); p0.y = pk2(o0[2], o0[3]); p0.z = pk2(o0[4], o0[5]); p0.w = pk2(o0[6], o0[7]); p1.x = pk2(o1[0], o1[1]); p1.y = pk2(o1[2], o1[3]); p1.z = pk2(o1[4], o1[5]); p1.w = pk2(o1[6], o1[7]);
          *(LAS v4u*)(L + XB_OFF + (2 * rg) * XB_PITCH + cg * 16) = p0; *(LAS v4u*)(L + XB_OFF + (2 * rg + 1) * XB_PITCH + cg * 16) = p1;
          LAS float* f0 = (LAS float*)(L + XF_OFF + (2 * rg) * XF_PITCH + cg * 32); LAS float* f1 = (LAS float*)(L + XF_OFF + (2 * rg + 1) * XF_PITCH + cg * 32);
          *(LAS f32x4*)f0 = (f32x4){o0[0], o0[1], o0[2], o0[3]}; *(LAS f32x4*)(f0 + 4) = (f32x4){o0[4], o0[5], o0[6], o0[7]};
          *(LAS f32x4*)f1 = (f32x4){o1[0], o1[1], o1[2], o1[3]}; *(LAS f32x4*)(f1 + 4) = (f32x4){o1[4], o1[5], o1[6], o1[7]}; }
        __syncthreads();
        { const int coln = col + 1 < col1 ? col + 1 : col; LRU_LOADX(coln); }
        f32x4 av[2][4], bv[2][4];
#pragma unroll
        for (int dr = 0; dr < 2; ++dr) {
#pragma unroll
            for (int tm = 0; tm < 4; ++tm) { av[dr][tm] = (f32x4){0.f, 0.f, 0.f, 0.f}; bv[dr][tm] = (f32x4){0.f, 0.f, 0.f, 0.f}; }
#pragma unroll
            for (int ks = 0; ks < 4; ++ks) { bf16x8 a[4];
#pragma unroll
                for (int tm = 0; tm < 4; ++tm) a[tm] = *(const LAS bf16x8*)(L + XB_OFF + (tm * 16 + c16) * XB_PITCH + (ks * 32 + q * 8) * 2);
#pragma unroll
                for (int tm = 0; tm < 4; ++tm) { av[dr][tm] = __builtin_amdgcn_mfma_f32_16x16x32_bf16(a[tm], bw[2 * dr][ks], av[dr][tm], 0, 0, 0); bv[dr][tm] = __builtin_amdgcn_mfma_f32_16x16x32_bf16(a[tm], bw[2 * dr + 1][ks], bv[dr][tm], 0, 0, 0); } }
#pragma unroll
            for (int tm = 0; tm < 4; ++tm)
#pragma unroll
                for (int j = 0; j < 4; ++j) { const int t = tm * 16 + q * 4 + j; const float xv = *(const LAS float*)(L + XF_OFF + t * XF_PITCH + chl * 4);
                    const float rgt = pg8::sigmoid_f(av[dr][tm][j] + cbr[dr]), igt = pg8::sigmoid_f(bv[dr][tm][j] + cbi[dr]), la = -8.f * rgt * csp[dr], aa = __expf(la), x2 = 2.f * la;
                    const float om = x2 > -0.1f ? -x2 * (1.f + x2 * (0.5f + x2 * (0.16666667f + x2 * (0.041666668f + x2 * 0.0083333338f)))) : 1.f - aa * aa;
                    av[dr][tm][j] = aa; bv[dr][tm][j] = sqrtf(om) * igt * xv; }
#define LRU_TM(i) (dr ? 3 - (i) : (i))
            float TA = 1.f, TB = 0.f;
#pragma unroll
            for (int ti = 0; ti < 4; ++ti) { const int tm = LRU_TM(ti); float sa = 1.f, sb = 0.f;
#pragma unroll
                for (int ji = 0; ji < 4; ++ji) { const int j = LRU_TM(ji); LRU_COMPOSE(sa, sb, av[dr][tm][j], bv[dr][tm][j]); }
#pragma unroll
                for (int qi = 0; qi < 4; ++qi) { const int qq = LRU_TM(qi); const float xa = lane_get(sa, c16 + 16 * qq), xb = lane_get(sb, c16 + 16 * qq); LRU_COMPOSE(TA, TB, xa, xb); } }
            __builtin_amdgcn_sched_barrier(0);
            if (q == 0) __hip_atomic_store(AGG + (((size_t)col * 36 + chunk) * 2 + dr) * 128 + chl, ((unsigned long long)__float_as_uint(TB) << 32) | __float_as_uint(TA), __ATOMIC_RELAXED, __HIP_MEMORY_SCOPE_AGENT);
        }
        asm volatile("s_waitcnt vmcnt(0)" ::: "memory");
        __syncthreads();
        if (tid == 0) __hip_atomic_store(ctl + CW_LRUFLAG + (col * 36 + chunk) * LRU_FLAG_STRIDE, epoch, __ATOMIC_RELAXED, __HIP_MEMORY_SCOPE_AGENT);
        v4u zcur[2];
#pragma unroll
        for (int x = 0; x < 2; ++x) { const int cidx = tid + 512 * x; zcur[x] = *(const v4u*)(P + (rb + t0 + (cidx >> 4)) * NP + C_LZ + blk * 128 + (cidx & 15) * 8); }
        if (w == 0) {
            unsigned* fp = ctl + CW_LRUFLAG + (col * 36 + (lane < 36 ? lane : 0)) * LRU_FLAG_STRIDE; unsigned spins = 0;
            for (;;) { const bool ok = __hip_atomic_load(fp, __ATOMIC_RELAXED, __HIP_MEMORY_SCOPE_AGENT) >= epoch; if (__all(ok)) break;
                __builtin_amdgcn_s_sleep(1);
                if ((++spins & 255u) == 0u) { if (__hip_atomic_load(ctl, __ATOMIC_RELAXED, __HIP_MEMORY_SCOPE_AGENT) != 0u) break; if (spins > (1u << 20)) { if (lane == 0) __hip_atomic_store(ctl, 0x1200u + (unsigned)l, __ATOMIC_RELAXED, __HIP_MEMORY_SCOPE_AGENT); break; } } }
            __builtin_amdgcn_fence(__ATOMIC_ACQUIRE, "agent");
            asm volatile("s_waitcnt vmcnt(0)" ::: "memory"); }
        __syncthreads();
        if (tid < 256) {
            const int dirx = tid >> 7, cl = tid & 127; const unsigned long long* ap = AGG + ((size_t)col * 36 * 2 + dirx) * 128 + cl; float hcar = 0.f, hmine = 0.f;
#pragma unroll 12
            for (int k = 0; k < 36; ++k) { const int cidx = ml::chunk_of(k, dirx); const unsigned long long ab = ap[(size_t)cidx * 256];
                if (cidx == chunk) hmine = hcar;
                hcar = __uint_as_float((unsigned)ab) * hcar + __uint_as_float((unsigned)(ab >> 32)); }
            ((LAS float*)(L + HIN_OFF))[dirx * 128 + cl] = hmine; }
        __syncthreads();
#pragma unroll
        for (int dr = 0; dr < 2; ++dr) {
            float H = ((const LAS float*)(L + HIN_OFF))[dr * 128 + chl];
#pragma unroll
            for (int ti = 0; ti < 4; ++ti) { const int tm = LRU_TM(ti); float sa = 1.f, sb = 0.f;
#pragma unroll
                for (int ji = 0; ji < 4; ++ji) { const int j = LRU_TM(ji); LRU_COMPOSE(sa, sb, av[dr][tm][j], bv[dr][tm][j]); }
                float ea = 1.f, eb = 0.f, ta = 1.f, tb = 0.f;
#pragma unroll
                for (int qi = 0; qi < 4; ++qi) { const int qq = LRU_TM(qi); const float xa = lane_get(sa, c16 + 16 * qq), xb = lane_get(sb, c16 + 16 * qq); if (qq == q) { ea = ta; eb = tb; } LRU_COMPOSE(ta, tb, xa, xb); }
                float hs = ea * H + eb;
#pragma unroll
                for (int ji = 0; ji < 4; ++ji) { const int j = LRU_TM(ji); hs = av[dr][tm][j] * hs + bv[dr][tm][j]; LAS float* yp = (LAS float*)(L + YO_OFF + (tm * 16 + q * 4 + j) * YO_PITCH + chl * 4);
                    if (dr == 0) *yp = hs; else *yp += hs; }
                H = ta * H + tb; }
        }
#undef LRU_TM
        __syncthreads();
        bf16_t* YB0 = WSB(WS_YB);
#pragma unroll
        for (int i = 0; i < 2; ++i) { const int cidx = tid + 512 * i, row = cidx >> 4, cgo = cidx & 15; const size_t rgl = rb + t0 + row;
            const f32x4 y0 = *(const LAS f32x4*)(L + YO_OFF + row * YO_PITCH + cgo * 32), y1 = *(const LAS f32x4*)(L + YO_OFF + row * YO_PITCH + cgo * 32 + 16);
            const v4u z = zcur[i];
            v4u o; o.x = pk2(y0[0] * blo(z.x), y0[1] * bhi(z.x)); o.y = pk2(y0[2] * blo(z.y), y0[3] * bhi(z.y)); o.z = pk2(y1[0] * blo(z.z), y1[1] * bhi(z.z)); o.w = pk2(y1[2] * blo(z.w), y1[3] * bhi(z.w));
            *(v4u*)(YB0 + rgl * DM + blk * 128 + cgo * 8) = o; }
    }
#undef LRU_LOADX
}
template <int LV> __device__ __forceinline__ void p_lru_agg(Frame& F, CArgs* ka, int l) {
    for (int v = F.wg; v < 256; v += F.G) { const int blk = v & 15, c0 = v >> 4;
        lru_run<false, LV>(F, ka, l, blk, 9, [c0](int i, int& b, int& c) { const int x = c0 + 16 * i; b = x / 36; c = x - b * 36; }); }
}
__device__ __forceinline__ void p_lru_final(Frame& F, CArgs* ka, int l, bool need_ctx) {
    for (int v = F.wg; v < 256; v += F.G) { const int b = v >> 6, blk = (v >> 2) & 15, qt = v & 3;
        const int tid = tid_fresh();
        __syncthreads();
        if (tid < 256) { const int dirx = tid >> 7, chl = tid & 127; const float2* AGG = (const float2*)WSF(WS_LA) + ((size_t)b * 36 * 2 + dirx) * DM + blk * 128 + chl;
            LAS float* HIN = (LAS float*)(F.lds + HIN_OFF); float hcar = 0.f;
#pragma unroll 12
            for (int k = 0; k < 36; ++k) { const int cidx = ml::chunk_of(k, dirx); const float2 ab = AGG[(size_t)cidx * 2 * DM];
                const int sl = cidx - qt * 9; if (sl >= 0 && sl < 9) HIN[sl * 256 + dirx * 128 + chl] = hcar;
                hcar = ab.x * hcar + ab.y; } }
        lru_run<true, 0>(F, ka, l, blk, (need_ctx || qt < 3) ? 9 : 5, [b, qt](int i, int& bb, int& c) { bb = b; c = qt * 9 + i; });
    }
}
}

#ifndef GEMM_NHALF
#define GEMM_NHALF false
#endif
#ifndef CONVERT_AHEAD
#define CONVERT_AHEAD 1
#endif
#ifndef DUP_NORM
#define DUP_NORM 0
#endif
#ifndef DUP_KNORM
#define DUP_KNORM 0
#endif
#ifndef LRU_LOOKBACK
#define LRU_LOOKBACK 0
#endif
#ifndef DUP_G1NULL
#define DUP_G1NULL 0
#endif
#ifndef DUP_G1FIX
#define DUP_G1FIX 0
#endif
#ifndef DUP_BAR
#define DUP_BAR 0
#endif
#ifndef DUP_MLOUT
#define DUP_MLOUT 0
#endif
#ifndef DUP_LRU2
#define DUP_LRU2 0
#endif
#ifndef ML_PIPE
#define ML_PIPE 1
#endif
#ifndef ML_VAR
#define ML_VAR 0
#endif
#ifndef LRU_VAR
#define LRU_VAR -1
#endif
#ifndef CONV_SPLIT
#define CONV_SPLIT 0
#endif
#ifndef GEMM_STAGGER
#define GEMM_STAGGER 0
#endif
#ifndef HEAVY_MIX
#define HEAVY_MIX 0
#endif
#ifndef THIN_MIX
#define THIN_MIX 0
#endif
#ifndef CONV_HEAVY
#define CONV_HEAVY 1
#endif
#ifndef HEAVY_ROT
#define HEAVY_ROT 0
#endif
#ifndef PRETOUCH
#define PRETOUCH 1
#endif
#ifndef PT_STRIDE
#define PT_STRIDE 65536
#endif
#ifndef MERGE_CHAIN
#define MERGE_CHAIN 1
#endif
#ifndef CONV_WIN_M
#define CONV_WIN_M 4000
#endif
#ifndef CONV_AHEAD_ITEMS
#define CONV_AHEAD_ITEMS 8000
#endif
#ifndef CONV_HALF
#define CONV_HALF 17168
#endif
static_assert(!(SPLIT_CTX && GEMM_NHALF), "the split context tiles assume 256-column units");
#ifndef ML_TR
#define ML_TR 1
#endif
#ifndef DUP_PRO
#define DUP_PRO 0
#endif
#ifndef DUP_THIN
#define DUP_THIN 0
#endif
#ifndef DUP_G1
#define DUP_G1 0
#endif
#ifndef DUP_HEAVY
#define DUP_HEAVY 0
#endif
#ifndef DUP_ATT
#define DUP_ATT 0
#endif
#ifndef DUP_ML
#define DUP_ML 0
#endif
#ifndef DUP_LRU1
#define DUP_LRU1 0
#endif
#ifndef DUP_G23
#define DUP_G23 0
#endif
__global__ void __launch_bounds__(NWAVES * 64, 2) fwd(Args args) {
    extern __shared__ __attribute__((aligned(16))) unsigned char lds[];
    Frame F;
    F.lds = (LAS unsigned char*)lds; F.ldsg = (char*)lds;
    F.tid = threadIdx.x; F.lane = F.tid & 63; F.wave = __builtin_amdgcn_readfirstlane(F.tid >> 6); F.G = gridDim.x; F.wg = blockIdx.x;
    CArgs* const ka0 = (CArgs*)__builtin_amdgcn_kernarg_segment_ptr();
    unsigned char* ws; { CArgs* ka = ka0; ws = ka->ws; }
    volatile LAS unsigned* MISC = (volatile LAS unsigned*)(F.lds + MISC_OFF);
    if (F.tid < 64) ((LAS unsigned*)(F.lds + MISC_OFF))[F.tid] = 0u;
    __syncthreads();
    const int lo = ka0->ph_lo, hi = ka0->ph_hi;
    XcdBarrier bar; bar.bar = (unsigned*)(ws + WS_CTL) + CW_BAR; bar.x = 0; bar.st = nullptr;
    if (hi - lo > 1) bar = xcd_barrier_post((unsigned*)(ws + WS_CTL) + CW_BAR, MISC + 8);
#define IN(k) (lo <= (k) && (k) < hi)
#define SEAM(k) do { if ((k) + 1 < hi) { xcd_barrier(bar); if (DUP_BAR) xcd_barrier(bar); } } while (0)

    if (IN(0) && PRETOUCH) {
        CArgs* ka = KA(); const size_t gt = (size_t)F.wg * 512 + F.tid, GT = (size_t)F.G * 512; unsigned acc_ = 0u;
#define PT_RANGE(ptr, bytes) for (size_t p = gt; p < (size_t)(bytes) / PT_STRIDE; p += GT) acc_ += __builtin_nontemporal_load((const unsigned*)((const char*)(ptr) + p * PT_STRIDE))
        PT_RANGE(ka->ws, WS_END); PT_RANGE(KIN(8), (size_t)DEPTH * DM * NIN * 4); PT_RANGE(KIN(20), (size_t)DEPTH * 3 * DM * DM * 4); PT_RANGE(KIN(21), (size_t)DEPTH * DM * DM * 4);
        PT_RANGE(KIN(4), (size_t)DEPTH * DM * 3 * DM * 4); PT_RANGE(KIN(0), (size_t)NBATCH * SEQ * DM * 4); PT_RANGE(KIN(2), (size_t)NBATCH * CTXL * DM * 4); PT_RANGE(ka->out, (size_t)NBATCH * SEQ * DM * 4);
#undef PT_RANGE
        asm volatile("" :: "v"(acc_)); }
    if (IN(0)) { for (int rep = 0; rep <= DUP_PRO; ++rep) { const int wv = F.wg * NWAVES + F.wave, nwv = F.G * NWAVES;
            for (int lc = 0; lc < (CONV_HEAVY ? 1 : DEPTH); ++lc) p_convert(F, KA(), lc, wv, nwv, (CONVERT_AHEAD && lc > 0) ? CONV_AHEAD_ITEMS : 0);
            p_prologue(F, KA()); }
        SEAM(0); }
#pragma unroll 1
    for (int l = 0; l < DEPTH; ++l) {
        const int base = 1 + l * PH_PER_LAYER; const bool need_ctx = l < DEPTH - 1;
        if (IN(base + 0)) { p_norm(F, KA(), l); if (DUP_NORM) p_norm(F, KA(), l + 1 <= DEPTH - 1 && l > 0 ? l : l, true); SEAM(base + 0); }
        if (IN(base + 1)) {
            CArgs* ka = KA(); pg8::Gemm g{WSB(WS_H), WSB(WS_WIN) + (size_t)l * NP * DM, MROWS, NP, DM, 0, 0}; pg8::InOrder S; S.init(MROWS, NP, F.G, F.wg, 256, !need_ctx);
            typedef pg8::EpiIn<(long)((WS_X8 - WS_P) / 2)> EpiInT; EpiInT E{WSB(WS_P)};
            if (GEMM_STAGGER && need_ctx) {
                const int nu = (MROWS / 256) * (NP / 256), extra = nu % F.G;
                if (F.wg >= extra) { const unsigned long long t0 = __builtin_amdgcn_s_memrealtime(), dt = (unsigned long long)(((F.wg - extra) >> 3) & 15) * GEMM_STAGGER;
                    while (__builtin_amdgcn_s_memrealtime() - t0 < dt) __builtin_amdgcn_s_sleep(8); } }
            pg8::gemm_phase<EpiInT, pg8::InOrder, true, true>(F.lds, g, S, E);
            if (DUP_G1) pg8::gemm_phase<EpiInT, pg8::InOrder, true, true>(F.lds, g, S, E);
            if (DUP_G1NULL) { pg8::EpiNull EN{WSF(WS_ACC)}; pg8::gemm_phase<pg8::EpiNull, pg8::InOrder, true, true>(F.lds, g, S, EN); }
            if (DUP_G1FIX) { pg8::EpiNull EN{WSF(WS_ACC)}; pg8::FixedOrder SF; SF.init(MROWS, NP, F.G, F.wg); pg8::gemm_phase<pg8::EpiNull, pg8::FixedOrder, true, true>(F.lds, g, SF, EN); }
            if (need_ctx) {
                const int nu = (MROWS / 256) * (NP / 256), extra = nu % F.G;
                if (F.wg >= extra) { p_gates(F, KA(), l, F.wg - extra, F.G - extra);
                    if (CONVERT_AHEAD && l + 1 < DEPTH) p_convert(F, KA(), l + 1, (F.wg - extra) * NWAVES + F.wave, (F.G - extra) * NWAVES, 0, CONV_SPLIT); } }
            SEAM(base + 1);
        }
        if (IN(base + 2)) { if (!need_ctx) p_gates(F, KA(), l, F.wg, F.G); p_knorm(F, KA(), l); if (DUP_KNORM) p_knorm(F, KA(), l, true);
#if USE_NAIVE_LRU
            p_lru_gates_naive(F, KA(), l);
#endif
            SEAM(base + 2); }
        if (IN(base + 3)) {
#define ML_UNITS() do { for (int v = F.wg; v < 256; v += F.G) {    \
                const int u = (F.G % 8 == 0) ? (((v & 7) * 8 + ((v >> 3) >> 2)) * 4 + ((v >> 3) & 3)) : v; \
                if (ML_TR) ml::mlstm_unit_tr(F, KA(), u, need_ctx); else ml::mlstm_unit_pipe<0>(F, KA(), u, need_ctx); if (ML_VAR) ml::mlstm_unit_pipe<ML_VAR>(F, KA(), u, need_ctx); } } while (0)
            if (HEAVY_MIX && (F.wg & 1)) ML_UNITS();
#define CONV_H() do { if (CONV_HEAVY && l + 1 < DEPTH) { __syncthreads(); p_convert(F, KA(), l + 1, F.wg * NWAVES + F.wave, F.G * NWAVES, CONV_AHEAD_ITEMS, 1 << 30); __syncthreads(); } } while (0)
            if (!((F.wg >> 3) & 1)) CONV_H();
#if HEAVY_ROT
            { const int rot = (F.wg >> 3) % 3;
#pragma unroll 1
              for (int sl = 0; sl < 3; ++sl) { const int k = (sl + rot) % 3;
                  __syncthreads();
                  if (k == 0) p_attention(F, KA(), l, need_ctx);
                  else if (k == 1) ML_UNITS();
                  else lru::p_lru_agg<0>(F, KA(), l); }
              __syncthreads(); }
#else
            for (int r2 = 0; r2 <= DUP_ATT; ++r2) p_attention(F, KA(), l, need_ctx);
            if (!(HEAVY_MIX && (F.wg & 1))) ML_UNITS();
            lru::p_lru_agg<0>(F, KA(), l); if (LRU_VAR >= 0) lru::p_lru_agg<(LRU_VAR >= 0 ? LRU_VAR : 0)>(F, KA(), l);
#endif
#undef ML_UNITS
            if ((F.wg >> 3) & 1) CONV_H();
#undef CONV_H
            SEAM(base + 3); }
        if (IN(base + 4)) { for (int rep = 0; rep <= DUP_THIN; ++rep) {
            const bool lru_first = THIN_MIX && ((F.wg >> 3) & 1);
            if (!lru_first) { for (int r2 = 0; r2 <= DUP_MLOUT; ++r2) p_mlout(F, KA(), l, need_ctx); }
#if USE_NAIVE_LRU
            p_lru_combine_naive(F, KA());
#else
#if !LRU_LOOKBACK
            lru::p_lru_final(F, KA(), l, need_ctx); if (DUP_LRU2) lru::p_lru_final(F, KA(), l, need_ctx);
#endif
#endif
            if (lru_first) p_mlout(F, KA(), l, need_ctx);
            }
            SEAM(base + 4); }
        if (IN(base + 5)) {
            CArgs* ka = KA(); pg8::Gemm g{WSB(WS_YB), WSB(WS_WBR) + (size_t)l * 3 * DM * DM, MROWS, DM, DM, (size_t)MROWS * DM * 2, (size_t)DM * DM * 2}; pg8::MergeOrder S; S.init(MROWS, DM, F.G, F.wg, GEMM_NHALF ? 128 : 256, !need_ctx);
#if MERGE_CHAIN
            pg8::EpiMergeC E{WSB(WS_P), WSB(WS_G2)};
            pg8::gemm_phase<pg8::EpiMergeC, pg8::MergeOrder, true, true, false>(F.lds, g, S, E);
#else
            pg8::EpiMerge<GEMM_NHALF> E{WSB(WS_P), WSF(WS_ACC), WSB(WS_G2)};
            pg8::gemm_phase<pg8::EpiMerge<GEMM_NHALF>, pg8::MergeOrder, true, true, GEMM_NHALF>(F.lds, g, S, E);
#endif
            if (DUP_G23) pg8::gemm_phase<decltype(E), pg8::MergeOrder, true, true, false>(F.lds, g, S, E);
            if (CONVERT_AHEAD && l + 1 < DEPTH) {
                const int ntile_m = (MROWS / 256) * (DM / (GEMM_NHALF ? 128 : 256));
                if (SPLIT_CTX && F.G == 256) { const int busy2 = 96; if (F.wg >= busy2) p_convert(F, KA(), l + 1, (F.wg - busy2) * NWAVES + F.wave, (F.G - busy2) * NWAVES, 0, CONV_WIN_M); }
                else { const int ntile = ntile_m, busy2 = (ntile > F.G && ntile < 2 * F.G) ? ntile - F.G : 0;
                    if (F.wg >= busy2) p_convert(F, KA(), l + 1, (F.wg - busy2) * NWAVES + F.wave, (F.G - busy2) * NWAVES, 0, CONV_AHEAD_ITEMS); } }
            SEAM(base + 5);
        }
        if (IN(base + 6)) {
            CArgs* ka = KA(); pg8::Gemm g{WSB(WS_G2), WSB(WS_WOUT) + (size_t)l * DM * DM, MROWS, DM, DM, (size_t)MROWS * DM * 2, 0}; pg8::SplitOutOrder S; S.init(MROWS, DM, F.G, F.wg, GEMM_NHALF ? 128 : 256, !need_ctx);
#if Y_BF16
            pg8::EpiY16 E{WSB(WS_Y), (size_t)MROWS * DM};
#else
            pg8::EpiF32<GEMM_NHALF> E{WSF(WS_Y), DM, (size_t)MROWS * DM};
#endif
            pg8::gemm_phase<decltype(E), pg8::SplitOutOrder, true, true, false>(F.lds, g, S, E);
            if (DUP_G23) pg8::gemm_phase<decltype(E), pg8::SplitOutOrder, true, true, false>(F.lds, g, S, E);
            const int ntile_o = (MROWS / 256) * (DM / (GEMM_NHALF ? 128 : 256));
            if (CONVERT_AHEAD && l + 1 < DEPTH && SPLIT_CTX && F.G == 256) { const int busy2 = 96; (void)ntile_o;
                if (F.wg >= busy2) p_convert(F, KA(), l + 1, (F.wg - busy2) * NWAVES + F.wave, (F.G - busy2) * NWAVES, CONV_WIN_M, CONV_AHEAD_ITEMS); }
            SEAM(base + 6);
        }
    }
    if (IN(N_PHASES - 1)) p_norm(F, KA(), DEPTH);
#undef IN
#undef SEAM
}

extern "C" void kernel_launch(void* const* d_in, const int* in_sizes, int n_in, void* d_out, int out_size, void* d_ws, size_t ws_size, hipStream_t stream) {
    static int grid = 0;
    if (grid == 0) {
        if (n_in != 22 || in_sizes[0] != NBATCH * SEQ * DM || out_size != NBATCH * SEQ * DM || ws_size < WS_END) {
            fprintf(stderr, "kernel_launch: unexpected shapes: n_in %d in0 %d out %d ws %zu (need %zu)\n", n_in, n_in > 0 ? in_sizes[0] : -1, out_size, ws_size, (size_t)WS_END); grid = -1; return; }
        int dev = 0, cus = 0, per_cu = 0;
        if (hipGetDevice(&dev) != hipSuccess || hipDeviceGetAttribute(&cus, hipDeviceAttributeMultiprocessorCount, dev) != hipSuccess) { fprintf(stderr, "kernel_launch: device query failed\n"); grid = -1; return; }
        if (hipFuncSetAttribute((const void*)fwd, hipFuncAttributeMaxDynamicSharedMemorySize, LDS_BYTES) != hipSuccess) { fprintf(stderr, "kernel_launch: hipFuncSetAttribute failed\n"); grid = -1; return; }
        if (hipOccupancyMaxActiveBlocksPerMultiprocessor(&per_cu, (const void*)fwd, NWAVES * 64, LDS_BYTES) != hipSuccess || per_cu < 1)
            fprintf(stderr, "kernel_launch: note: occupancy query reports %d workgroups per CU\n", per_cu);
        (void)hipGetLastError();
        grid = cus;
    }
    if (grid < 0) return;
    if (hipMemsetAsync((char*)d_ws + WS_CTL, 0, CTL_ZERO_BYTES, stream) != hipSuccess) { fprintf(stderr, "kernel_launch: memset failed\n"); return; }
    Args a{};
    for (int i = 0; i < 22; ++i) a.in[i] = (const float*)d_in[i];
    a.out = (float*)d_out; a.ws = (unsigned char*)d_ws;
    if (MK_N_LAUNCHES == 1) { a.ph_lo = 0; a.ph_hi = N_PHASES; hipLaunchKernelGGL(fwd, dim3(grid), dim3(NWAVES * 64), LDS_BYTES, stream, a); }
    else for (int k = 0; k < N_PHASES; ++k) { a.ph_lo = k; a.ph_hi = k + 1; hipLaunchKernelGGL(fwd, dim3(grid), dim3(NWAVES * 64), LDS_BYTES, stream, a); }
    const hipError_t le = hipPeekAtLastError();
    if (le != hipSuccess) fprintf(stderr, "kernel_launch: launch failed: %s\n", hipGetErrorName(le));
}
```

```cpp
#include <hip/hip_runtime.h>
#include <hip/hip_bf16.h>
#include <cstdio>
#include <cstdint>

constexpr int DM = 2048, NBATCH = 4, SEQ = 2048, CTXL = 256, TPB = SEQ + CTXL  , MROWS = NBATCH * TPB  , DEPTH = 4;
constexpr int NIN = 25632, NP = 25600;
constexpr int C_LX = 0, C_LZ = 2048, C_MQ = 4096, C_MK = 6144, C_MV = 8192, C_MO = 10240, C_MZ = 12288, C_AQ = 14336, C_AK = 16384, C_AV = 16896, C_AZ = 17408, C_MG = 19456;
constexpr float EPS = 1e-6f;
#ifndef SPLIT_CTX
#define SPLIT_CTX 1
#endif
#ifndef Y_BF16
#define Y_BF16 1
#endif
#ifndef LRU_AB
#define LRU_AB 1
#define LRU_AB_LOAD 1
#endif

namespace pg8 {
#define PG8_LAS __attribute__((address_space(3)))
typedef unsigned short bf16_t;
typedef short bf16x8 __attribute__((ext_vector_type(8)));
typedef float f32x4 __attribute__((ext_vector_type(4)));
typedef unsigned u32x4 __attribute__((ext_vector_type(4)));
constexpr int BM = 256, BK = 64, HALF = 128, HTB = HALF * BK * 2  , STAGE_BYTES = 8 * HTB, NXCD = 8, WGM = 8;

__host__ __device__ __forceinline__ int lds_byte(int r, int c) { const int st = (r >> 4) * 2 + (c >> 5), rr = r & 15, cc = c & 31, ob = rr * 64 + cc * 2; return st * 1024 + (ob ^ (((ob >> 9) & 1) << 5)); }
__host__ __device__ __forceinline__ void stage_rc(int b, int& R, int& C) { const int st = b / 1024, sb = b % 1024, swz = sb ^ (((sb >> 9) & 1) << 5); R = (st >> 1) * 16 + swz / 64; C = (st & 1) * 32 + (swz % 64) / 2; }
__host__ __device__ __forceinline__ int perm32(int rho) { const int n = rho >> 4, i = rho & 15; return 8 * (i >> 2) + 4 * n + (i & 3); }

struct Unit { int pm, pn, z, sp; };
struct Gemm { const bf16_t* A; const bf16_t* Bt; int M, N, K; size_t zA, zB; };

struct StaticOrder {
    int nM, nN, nwg, G, c; bool lat;
    __host__ __device__ void init(int M, int N, int G_, int c_, int tileN = BM, bool lat_ = false) { lat = lat_; nM = lat ? (M / BM) * 8 / 9 : M / BM; nN = N / tileN; nwg = nM * nN; G = G_; c = c_; }
    __host__ __device__ bool map_x(long L, Unit& u, int nM_, int nwg_, bool lat_) const {
        if (L >= nwg_) return false;
        int wgid = (int)L; { const int q = nwg_ / NXCD, r = nwg_ % NXCD, xcd = wgid % NXCD, off = wgid / NXCD; wgid = (xcd < r ? xcd * (q + 1) : r * (q + 1) + (xcd - r) * q) + off; }
        const int nig = WGM * nN, gid = wgid / nig, fm = gid * WGM, gsz = (nM_ - fm) < WGM ? (nM_ - fm) : WGM;
        u.pm = fm + ((wgid % nig) % gsz); u.pn = (wgid % nig) / gsz; u.z = 0; u.sp = 0; if (lat_) u.pm = (u.pm >> 3) * 9 + (u.pm & 7); return true;
    }
    __host__ __device__ bool map(long L, Unit& u) const { return map_x(L, u, nM, nwg, lat); }
    __host__ __device__ bool next(int i, Unit& u) const { return map((long)i * G + c, u); }
    __device__ __forceinline__ void a_ready(const Unit&) const {}
    __device__ __forceinline__ void done(const Unit&) const {}
};
struct InOrder : StaticOrder {
    __host__ __device__ bool next(int i, Unit& u) const { const long L = (long)i * G + c; if (L < nwg) return map(L, u);
        if (!lat) return false; const int idx = (int)(L - nwg); if (idx >= 4 * 28) return false;
        const int bb = idx / 28, j = idx - bb * 28; u.pm = 9 * bb + 8; u.z = 0; u.sp = 0; u.pn = j < 8 ? j : j < 16 ? 16 + j : j < 24 ? 16 + j : j < 26 ? 40 + j : 40 + j; return true; }
};
struct FixedOrder : StaticOrder {
    __host__ __device__ bool next(int i, Unit& u) const { if (!StaticOrder::next(i, u)) return false; u.pm = 0; u.pn = 0; return true; }
};
struct MergeOrder : StaticOrder {
    __host__ __device__ bool split_ok() const { return SPLIT_CTX && !lat && nM == 36 && nN == 8 && G == 256; }
    __host__ __device__ bool next(int i, Unit& u) const {
        if (!split_ok()) { const int it = i / 3; if (!StaticOrder::next(it, u)) return false; u.z = i - 3 * it; return true; }
        if (i < 3) { if (!map_x((long)c, u, 32, 256, true)) return false; u.z = i; return true; }
        if (i > 3 || c >= 96) return false;
        const int s = c & 31; u.pm = 9 * (s >> 3) + 8; u.pn = s & 7; u.z = c >> 5; u.sp = 1; return true; }
};
struct SplitOutOrder : StaticOrder {
    __host__ __device__ bool split_ok() const { return SPLIT_CTX && !lat && nM == 36 && nN == 8 && G == 256; }
    __host__ __device__ bool next(int i, Unit& u) const {
        if (!split_ok()) return StaticOrder::next(i, u);
        if (i == 0) return map_x((long)c, u, 32, 256, true);
        if (i > 1 || c >= 96) return false;
        const int s = c & 31; u.pm = 9 * (s >> 3) + 8; u.pn = s & 7; u.z = 1 + (c >> 5); u.sp = 1; return true; }
};
__device__ __forceinline__ unsigned cvt_pk_bf16(float lo, float hi) { unsigned r; asm volatile("v_cvt_pk_bf16_f32 %0, %1, %2" : "=v"(r) : "v"(lo), "v"(hi)); return r; }
__device__ __forceinline__ float bflo(unsigned w) { return __uint_as_float(w << 16); }
__device__ __forceinline__ float bfhi(unsigned w) { return __uint_as_float(w & 0xffff0000u); }
__device__ __forceinline__ float sigmoid_f(float x) { return __builtin_amdgcn_rcpf(1.f + __expf(-x)); }

template <bool NHALF> struct EpiF32 {
    static constexpr bool PERM = false, AFTER_DRAIN = false;
    float* C; int ldc; size_t slab;
    __device__ __forceinline__ void operator()(const f32x4 (&acc)[2][2][4][2], const Unit& u, int wr, int wc, int fr, int fq) const {
        const int row0 = u.pm * BM + wr * 64 + fr, col0 = u.pn * (NHALF ? HALF : BM) + wc * 32 + 4 * fq;
        float* Cb = C + (u.sp ? (size_t)(u.z - 1) * slab : (size_t)0);
#pragma unroll
        for (int ai = 0; ai < 2; ++ai)
#pragma unroll
            for (int m = 0; m < 4; ++m) { float* rowp = Cb + (size_t)(row0 + ai * HALF + m * 16) * ldc + col0;
#pragma unroll
                for (int bj = 0; bj < (NHALF ? 1 : 2); ++bj)
#pragma unroll
                    for (int n = 0; n < 2; ++n) *(f32x4*)(rowp + bj * HALF + n * 16) = acc[ai][bj][m][n]; }
    }
};
struct EpiNull {
    static constexpr bool PERM = true, AFTER_DRAIN = false; float* sink;
    __device__ __forceinline__ void operator()(const f32x4 (&acc)[2][2][4][2], const Unit& u, int wr, int wc, int fr, int fq) const {
        float s = 0.f;
#pragma unroll
        for (int ai = 0; ai < 2; ++ai)
#pragma unroll
            for (int bj = 0; bj < 2; ++bj)
#pragma unroll
                for (int m = 0; m < 4; ++m)
#pragma unroll
                    for (int n = 0; n < 2; ++n) s += acc[ai][bj][m][n][0] + acc[ai][bj][m][n][1] + acc[ai][bj][m][n][2] + acc[ai][bj][m][n][3];
        if (s == 123.456f) sink[0] = s; }
};
template <long X8D> struct EpiIn {
    static constexpr bool PERM = true, AFTER_DRAIN = false;
    bf16_t* O;
    __device__ __forceinline__ void operator()(const f32x4 (&acc)[2][2][4][2], const Unit& u, int wr, int wc, int fr, int fq) const {
        const int pn = u.pn;
        int act = 0;
        if ((pn >= 8 && pn < 16) || (pn >= 48 && pn < 56) || (pn >= 68 && pn < 76)) act = 1;
        else if ((pn >= 40 && pn < 48) || pn >= 76) act = 2;
        else if (pn >= 24 && pn < 32) act = 3;
        const bool blocked = pn >= 16 && pn < 40;
        bf16_t* base = blocked ? O + X8D + (size_t)((pn - 16) >> 3) * MROWS * DM + ((size_t)((u.pm / 9) * 8 + ((pn - 16) & 7)) * 36 + (u.pm % 9) * 4) * (32 * 64 * 8)
                               : O + (size_t)u.pm * BM * NP + (size_t)pn * BM;
        const unsigned lane_off = blocked ? (unsigned)(wr * (32 * 64 * 8) + ((wc * 4 + fq) * 64 + fr) * 8) : (unsigned)((wr * 64 + fr) * NP + wc * 32 + 8 * fq);
        const unsigned sa = blocked ? 2u * 32 * 64 * 8 : (unsigned)HALF * NP, sm = blocked ? 16u * 8 : 16u * NP, sb = blocked ? 16u * 64 * 8 : (unsigned)HALF;
#pragma unroll
        for (int ai = 0; ai < 2; ++ai)
#pragma unroll
            for (int m = 0; m < 4; ++m) {
#pragma unroll
                for (int bj = 0; bj < 2; ++bj) { f32x4 v0 = acc[ai][bj][m][0], v1 = acc[ai][bj][m][1];
                    if (act == 1) {
#pragma unroll
                        for (int j = 0; j < 4; ++j) { v0[j] = v0[j] * sigmoid_f(v0[j]); v1[j] = v1[j] * sigmoid_f(v1[j]); } }
                    else if (act == 2) {
#pragma unroll
                        for (int j = 0; j < 4; ++j) { v0[j] = sigmoid_f(v0[j]); v1[j] = sigmoid_f(v1[j]); } }
                    else if (act == 3) { v0 = v0 * 0.0625f; v1 = v1 * 0.0625f; }
                    u32x4 w; w.x = cvt_pk_bf16(v0[0], v0[1]); w.y = cvt_pk_bf16(v0[2], v0[3]); w.z = cvt_pk_bf16(v1[0], v1[1]); w.w = cvt_pk_bf16(v1[2], v1[3]);
                    *(u32x4*)(base + (lane_off + ai * sa + m * sm + bj * sb)) = w; } }
    }
};
template <bool NHALF> struct EpiMerge {
    static constexpr bool PERM = true, AFTER_DRAIN = false;
    const bf16_t* P; float* ACC; bf16_t* G2;
    __device__ __forceinline__ void operator()(const f32x4 (&acc)[2][2][4][2], const Unit& u, int wr, int wc, int fr, int fq) const {
        const int row0 = u.pm * BM + wr * 64 + fr, col0 = u.pn * (NHALF ? HALF : BM) + wc * 32 + 8 * fq, z = u.z;
#pragma unroll
        for (int ai = 0; ai < 2; ++ai)
#pragma unroll
            for (int m = 0; m < 4; ++m) { const size_t r = (size_t)(row0 + ai * HALF + m * 16);
#pragma unroll
                for (int bj = 0; bj < (NHALF ? 1 : 2); ++bj) { const int c = col0 + bj * HALF;
                    const u32x4 g = *(const u32x4*)(P + r * NP + C_MG + z * DM + c);
                    f32x4 v0 = acc[ai][bj][m][0], v1 = acc[ai][bj][m][1];
                    v0[0] *= bflo(g.x); v0[1] *= bfhi(g.x); v0[2] *= bflo(g.y); v0[3] *= bfhi(g.y);
                    v1[0] *= bflo(g.z); v1[1] *= bfhi(g.z); v1[2] *= bflo(g.w); v1[3] *= bfhi(g.w);
                    if (u.sp) { u32x4 w; w.x = cvt_pk_bf16(v0[0], v0[1]); w.y = cvt_pk_bf16(v0[2], v0[3]); w.z = cvt_pk_bf16(v1[0], v1[1]); w.w = cvt_pk_bf16(v1[2], v1[3]);
                        *(u32x4*)(G2 + (size_t)(1 + z) * MROWS * DM + r * DM + c) = w;
                        continue; }
                    float* ap = ACC + r * DM + c;
                    if (z > 0) { v0 = v0 + *(const f32x4*)ap; v1 = v1 + *(const f32x4*)(ap + 4); }
                    if (z < 2) { *(f32x4*)ap = v0; *(f32x4*)(ap + 4) = v1; }
                    else { u32x4 w; w.x = cvt_pk_bf16(v0[0], v0[1]); w.y = cvt_pk_bf16(v0[2], v0[3]); w.z = cvt_pk_bf16(v1[0], v1[1]); w.w = cvt_pk_bf16(v1[2], v1[3]);
                        *(u32x4*)(G2 + r * DM + c) = w; } } }
    }
};
struct EpiMergeC {
    static constexpr bool PERM = true, AFTER_DRAIN = false, CHAIN = true;
    static constexpr int DEPTH_PF = 4;
    const bf16_t* P; bf16_t* G2;
    __device__ __forceinline__ static bool keep(const Unit& u) { return !u.sp && u.z < 2; }
    __device__ __forceinline__ static void unpack8(const u32x4 g, float (&s)[8]) { s[0] = bflo(g.x); s[1] = bfhi(g.x); s[2] = bflo(g.y); s[3] = bfhi(g.y); s[4] = bflo(g.z); s[5] = bfhi(g.z); s[6] = bflo(g.w); s[7] = bfhi(g.w); }
    __device__ __forceinline__ void operator()(f32x4 (&acc)[2][2][4][2], const Unit& u, int wr, int wc, int fr, int fq) const {
        const int row0 = u.pm * BM + wr * 64 + fr, col0 = u.pn * BM + wc * 32 + 8 * fq, z = u.z;
        constexpr float FLOOR = 1e-12f;
        const bf16_t* gp0 = P + (size_t)row0 * NP + C_MG + z * DM + col0;
        const bool chain = !u.sp && z < 2;
        bf16_t* O = G2 + (u.sp ? (size_t)(1 + z) * MROWS * DM : (size_t)0) + (size_t)row0 * DM + col0;
        u32x4 gq[DEPTH_PF], hq[DEPTH_PF];
#define EMC_OFF(t) ((size_t)((((t) >> 3) & 1) * HALF + (((t) >> 1) & 3) * 16) * NP + ((t) & 1) * HALF)
#define EMC_LOAD(t) do { gq[(t) % DEPTH_PF] = *(const u32x4*)(gp0 + EMC_OFF(t)); if (chain) hq[(t) % DEPTH_PF] = *(const u32x4*)(gp0 + EMC_OFF(t) + DM); } while (0)
#pragma unroll
        for (int t = 0; t < DEPTH_PF - 1; ++t) EMC_LOAD(t);
#pragma unroll
        for (int t = 0; t < 16; ++t) { const int ai = (t >> 3) & 1, m = (t >> 1) & 3, bj = t & 1;
            if (t + DEPTH_PF - 1 < 16) EMC_LOAD(t + DEPTH_PF - 1);
            float s[8]; unpack8(gq[t % DEPTH_PF], s);
            if (chain) { float d[8]; unpack8(hq[t % DEPTH_PF], d);
#pragma unroll
                for (int j = 0; j < 8; ++j) s[j] = fmaxf(s[j], FLOOR) * __builtin_amdgcn_rcpf(fmaxf(d[j], FLOOR));
#pragma unroll
                for (int j = 0; j < 4; ++j) { acc[ai][bj][m][0][j] *= s[j]; acc[ai][bj][m][1][j] *= s[4 + j]; } }
            else { if (!u.sp) {
#pragma unroll
                    for (int j = 0; j < 8; ++j) s[j] = fmaxf(s[j], FLOOR); }
                f32x4 v0 = acc[ai][bj][m][0], v1 = acc[ai][bj][m][1];
#pragma unroll
                for (int j = 0; j < 4; ++j) { v0[j] *= s[j]; v1[j] *= s[4 + j]; }
                u32x4 w; w.x = cvt_pk_bf16(v0[0], v0[1]); w.y = cvt_pk_bf16(v0[2], v0[3]); w.z = cvt_pk_bf16(v1[0], v1[1]); w.w = cvt_pk_bf16(v1[2], v1[3]);
                *(u32x4*)(O + (size_t)(ai * HALF + m * 16) * DM + bj * HALF) = w; } }
#undef EMC_OFF
#undef EMC_LOAD
    }
};
struct EpiY16 {
    static constexpr bool PERM = true, AFTER_DRAIN = false;
    bf16_t* Y; size_t slab;
    __device__ __forceinline__ void operator()(const f32x4 (&acc)[2][2][4][2], const Unit& u, int wr, int wc, int fr, int fq) const {
        const int row0 = u.pm * BM + wr * 64 + fr, col0 = u.pn * BM + wc * 32 + 8 * fq;
        bf16_t* Yb = Y + (u.sp ? (size_t)(u.z - 1) * slab : (size_t)0);
#pragma unroll
        for (int ai = 0; ai < 2; ++ai)
#pragma unroll
            for (int m = 0; m < 4; ++m) { bf16_t* rowp = Yb + (size_t)(row0 + ai * HALF + m * 16) * DM + col0;
#pragma unroll
                for (int bj = 0; bj < 2; ++bj) { const f32x4 v0 = acc[ai][bj][m][0], v1 = acc[ai][bj][m][1];
                    u32x4 w; w.x = cvt_pk_bf16(v0[0], v0[1]); w.y = cvt_pk_bf16(v0[2], v0[3]); w.z = cvt_pk_bf16(v1[0], v1[1]); w.w = cvt_pk_bf16(v1[2], v1[3]);
                    *(u32x4*)(rowp + bj * HALF) = w; } }
    }
};
template <class T, class = void> struct epi_chain { static constexpr bool value = false; };
template <class T> struct epi_chain<T, decltype((void)T::CHAIN)> { static constexpr bool value = T::CHAIN; };
template <class Epi, class Sched, bool ALIGN_EPI = false, bool SP2 = false, bool NHALF = false>
__device__ __forceinline__ void gemm_phase(PG8_LAS unsigned char* lds, const Gemm g, const Sched& S, const Epi& E) {
    int tid = threadIdx.x; asm volatile("" : "+v"(tid));
    const int wid = __builtin_amdgcn_readfirstlane(tid >> 6), lane = tid & 63, wr = wid >> 2, wc = wid & 3, fr = lane & 15, fq = lane >> 4;
    const int K = g.K, nt = K / BK;
    unsigned voffA[2], voffB[2];
#pragma unroll
    for (int i = 0; i < 2; ++i) { int R, C; stage_rc(tid * 16 + i * 8192, R, C); const int Rb = Epi::PERM ? ((R & ~31) + perm32(R & 31)) : R;
        voffA[i] = (unsigned)(R * K + C) * 2u; voffB[i] = (unsigned)(Rb * K + C) * 2u; }
    const size_t kstep = (size_t)(BK * 2);
    const size_t hstep = (size_t)HALF * K * 2;
    const size_t tstep = 2 * hstep;
    const size_t hsB = NHALF ? 0 : hstep, tstepB = NHALF ? hstep : tstep; static_assert(!NHALF || SP2, "NHALF is implemented for the SP2 loop");
    const unsigned ldsw = (unsigned)wid * 1024u;
    const int aoff = lds_byte(wr * 64 + fr, fq * 8), boff = lds_byte(wc * 32 + fr, fq * 8);
#define PG8_SA(b, h) (((b) * 2 + (h)) * HTB)
#define PG8_SB(b, h) ((4 + (b) * 2 + (h)) * HTB)
#define PG8_STAGE(bufoff, gbase, voff) do { _Pragma("unroll") for (int _i = 0; _i < 2; ++_i) \
        __builtin_amdgcn_global_load_lds((const unsigned*)((const char*)(gbase) + (voff)[_i]), (PG8_LAS unsigned*)(lds + (bufoff) + ldsw + _i * 8192), 16, 0, 0); } while (0)
#define PG8_LDA(dst, b, h) do { _Pragma("unroll") for (int m = 0; m < 4; ++m) _Pragma("unroll") for (int k = 0; k < 2; ++k) dst[m][k] = *(const PG8_LAS bf16x8*)(lds + PG8_SA(b, h) + aoff + m * 2048 + k * 1024); } while (0)
#define PG8_LDB(dst, b, h) do { _Pragma("unroll") for (int n = 0; n < 2; ++n) _Pragma("unroll") for (int k = 0; k < 2; ++k) dst[n][k] = *(const PG8_LAS bf16x8*)(lds + PG8_SB(b, h) + boff + n * 2048 + k * 1024); } while (0)
#define PG8_MMA(ai, bj, At, Bt) do { __builtin_amdgcn_s_setprio(1); _Pragma("unroll") for (int m = 0; m < 4; ++m) _Pragma("unroll") for (int n = 0; n < 2; ++n) _Pragma("unroll") for (int k = 0; k < 2; ++k) \
        acc[ai][bj][m][n] = __builtin_amdgcn_mfma_f32_16x16x32_bf16(Bt[n][k], At[m][k], acc[ai][bj][m][n], 0, 0, 0); __builtin_amdgcn_s_setprio(0); } while (0)
#define PG8_WAIT_V(n) asm volatile("s_waitcnt vmcnt(" #n ")" ::: "memory")
#define PG8_WAIT_L(n) asm volatile("s_waitcnt lgkmcnt(" #n ")" ::: "memory")
#define PG8_BAR __builtin_amdgcn_s_barrier()
#define PG8_SCHED __builtin_amdgcn_sched_barrier(0)
    Unit cur, nxt; int ui = 0;
    if (!S.next(0, cur)) return;
    f32x4 acc[2][2][4][2];
#pragma unroll
    for (int a = 0; a < 2; ++a)
#pragma unroll
        for (int b = 0; b < 2; ++b)
#pragma unroll
            for (int m = 0; m < 4; ++m)
#pragma unroll
                for (int n = 0; n < 2; ++n) acc[a][b][m][n] = (f32x4){0.f, 0.f, 0.f, 0.f};
    bf16x8 At[4][2], B0[2][2], B1[2][2];
    const char* cA = (const char*)g.A + (size_t)cur.z * g.zA + (size_t)cur.pm * tstep; const char* cB = (const char*)g.Bt + (size_t)cur.z * g.zB + (size_t)cur.pn * tstepB;
    S.a_ready(cur);
    if constexpr (SP2) {
        PG8_STAGE(PG8_SB(0, 0), cB, voffB); PG8_STAGE(PG8_SB(0, 1), cB + hsB, voffB); PG8_STAGE(PG8_SA(0, 0), cA, voffA); PG8_STAGE(PG8_SA(0, 1), cA + hstep, voffA);
        if (wr == 1) PG8_BAR;
        PG8_WAIT_V(2); PG8_BAR;
        PG8_STAGE(PG8_SB(1, 0), cB + kstep, voffB); PG8_STAGE(PG8_SA(1, 0), cA + kstep, voffA); PG8_STAGE(PG8_SB(1, 1), cB + hsB + kstep, voffB);
        PG8_WAIT_V(6); PG8_BAR;
    } else {
        PG8_STAGE(PG8_SB(0, 0), cB, voffB); PG8_STAGE(PG8_SA(0, 0), cA, voffA); PG8_STAGE(PG8_SB(0, 1), cB + hstep, voffB); PG8_STAGE(PG8_SA(0, 1), cA + hstep, voffA);
        if (wr == 1) PG8_BAR;
        PG8_WAIT_V(4); PG8_BAR;
        PG8_STAGE(PG8_SB(1, 0), cB + kstep, voffB); PG8_STAGE(PG8_SA(1, 0), cA + kstep, voffA); PG8_STAGE(PG8_SB(1, 1), cB + hstep + kstep, voffB);
        PG8_WAIT_V(6); PG8_BAR;
    }
    for (;;) {
        const bool has_next = S.next(ui + 1, nxt);
        const char* nA = has_next ? (const char*)g.A + (size_t)nxt.z * g.zA + (size_t)nxt.pm * tstep : cA; const char* nB = has_next ? (const char*)g.Bt + (size_t)nxt.z * g.zB + (size_t)nxt.pn * tstepB : cB;
        for (int t = 0; t < nt; t += 2) {
            const bool last = (t == nt - 2);
            const char* a1 = cA + (size_t)(t + 1) * kstep;
            const char* a2 = last ? nA : cA + (size_t)(t + 2) * kstep; const char* b2 = last ? nB : cB + (size_t)(t + 2) * kstep;
            const char* a3 = a2 + kstep; const char* b3 = b2 + kstep;
            if (last && has_next) S.a_ready(nxt);
            if constexpr (SP2) {
            PG8_LDB(B0, 0, 0); if constexpr (!NHALF) PG8_LDB(B1, 0, 1); PG8_SCHED; PG8_LDA(At, 0, 0); PG8_STAGE(PG8_SA(1, 1), a1 + hstep, voffA);
            PG8_WAIT_V(8); PG8_WAIT_L(0); PG8_BAR; PG8_MMA(0, 0, At, B0); if constexpr (!NHALF) PG8_MMA(0, 1, At, B1); PG8_BAR; PG8_SCHED;
            PG8_LDA(At, 0, 1); PG8_STAGE(PG8_SB(0, 0), b2, voffB); PG8_STAGE(PG8_SB(0, 1), b2 + hsB, voffB); PG8_STAGE(PG8_SA(0, 0), a2, voffA);
            PG8_WAIT_V(8); PG8_WAIT_L(0); PG8_BAR; PG8_MMA(1, 0, At, B0); if constexpr (!NHALF) PG8_MMA(1, 1, At, B1); PG8_BAR; PG8_SCHED;
            PG8_LDB(B0, 1, 0); if constexpr (!NHALF) PG8_LDB(B1, 1, 1); PG8_SCHED; PG8_LDA(At, 1, 0); PG8_STAGE(PG8_SA(0, 1), a2 + hstep, voffA);
            PG8_WAIT_V(8); PG8_WAIT_L(0); PG8_BAR; PG8_MMA(0, 0, At, B0); if constexpr (!NHALF) PG8_MMA(0, 1, At, B1); PG8_BAR; PG8_SCHED;
            PG8_LDA(At, 1, 1); PG8_STAGE(PG8_SB(1, 0), b3, voffB); PG8_STAGE(PG8_SB(1, 1), b3 + hsB, voffB); PG8_STAGE(PG8_SA(1, 0), a3, voffA);
            PG8_WAIT_V(8); PG8_WAIT_L(0); PG8_BAR; PG8_MMA(1, 0, At, B0); if constexpr (!NHALF) PG8_MMA(1, 1, At, B1); PG8_BAR; PG8_SCHED;
            } else {
            PG8_LDB(B0, 0, 0); PG8_SCHED; PG8_LDA(At, 0, 0); PG8_STAGE(PG8_SA(1, 1), a1 + hstep, voffA);
            PG8_WAIT_L(8); PG8_BAR; PG8_WAIT_L(0); PG8_MMA(0, 0, At, B0); PG8_BAR; PG8_SCHED;
            PG8_LDB(B1, 0, 1); PG8_STAGE(PG8_SB(0, 0), b2, voffB);
            PG8_BAR; PG8_WAIT_L(0); PG8_MMA(0, 1, At, B1); PG8_BAR;
            PG8_LDA(At, 0, 1); PG8_STAGE(PG8_SA(0, 0), a2, voffA);
            PG8_BAR; PG8_WAIT_L(0); PG8_MMA(1, 0, At, B0); PG8_BAR; PG8_SCHED;
            PG8_STAGE(PG8_SB(0, 1), b2 + hstep, voffB);
            PG8_WAIT_V(6); PG8_BAR; PG8_MMA(1, 1, At, B1); PG8_BAR;
            PG8_LDB(B0, 1, 0); PG8_SCHED; PG8_LDA(At, 1, 0); PG8_STAGE(PG8_SA(0, 1), a2 + hstep, voffA);
            PG8_WAIT_L(8); PG8_BAR; PG8_WAIT_L(0); PG8_MMA(0, 0, At, B0); PG8_BAR; PG8_SCHED;
            PG8_LDB(B1, 1, 1); PG8_STAGE(PG8_SB(1, 0), b3, voffB);
            PG8_BAR; PG8_WAIT_L(0); PG8_MMA(0, 1, At, B1); PG8_BAR;
            PG8_LDA(At, 1, 1); PG8_STAGE(PG8_SA(1, 0), a3, voffA);
            PG8_BAR; PG8_WAIT_L(0); PG8_MMA(1, 0, At, B0); PG8_BAR; PG8_SCHED;
            PG8_STAGE(PG8_SB(1, 1), b3 + hstep, voffB);
            PG8_WAIT_V(6); PG8_BAR; PG8_MMA(1, 1, At, B1); PG8_BAR;
            }
        }
        if constexpr (ALIGN_EPI) { if (wr == 0) PG8_BAR; }
        if constexpr (!Epi::AFTER_DRAIN) { E(acc, cur, wr, wc, fr, fq); S.done(cur); }
        if (!has_next) break;
        bool clear = true; if constexpr (epi_chain<Epi>::value) clear = !Epi::keep(cur);
        if (clear) {
#pragma unroll
        for (int a = 0; a < 2; ++a)
#pragma unroll
            for (int b = 0; b < 2; ++b)
#pragma unroll
                for (int m = 0; m < 4; ++m)
#pragma unroll
                    for (int n = 0; n < 2; ++n) acc[a][b][m][n] = (f32x4){0.f, 0.f, 0.f, 0.f};
        }
        cur = nxt; cA = nA; cB = nB; ++ui;
        if constexpr (ALIGN_EPI) { if (wr == 1) PG8_BAR; }
    }
    PG8_WAIT_V(0);
    if constexpr (!ALIGN_EPI) { if (wr == 0) PG8_BAR; }
    PG8_BAR;
    if constexpr (Epi::AFTER_DRAIN) { E.fused(acc, cur, wr, wc, fr, fq, lds, wid, lane); S.done(cur); }
#undef PG8_SA
#undef PG8_SB
#undef PG8_STAGE
#undef PG8_LDA
#undef PG8_LDB
#undef PG8_MMA
#undef PG8_WAIT_V
#undef PG8_WAIT_L
#undef PG8_BAR
#undef PG8_SCHED
}
}

namespace att {
using bf16 = __hip_bfloat16;
constexpr int   D = 128, NW = 8, QBLK = 32, KVBLK = 64;
constexpr float SCALE = 0.088388347648318440f;
constexpr float THR = 8.f;
#ifndef ATT_SDEPTH
#define ATT_SDEPTH 1
#endif
constexpr int SDEPTH = ATT_SDEPTH;
constexpr int LDQ = NP, LDK = NP, LDO = DM;
constexpr size_t SHM_V = KVBLK * D * 2, SHM_K = KVBLK * D * 2, SHM_ATTN = 2 * SHM_V + 2 * SHM_K + NW * 64 * 4;
constexpr int OST_OFF = 69632, OST_END = OST_OFF + NW * 32 * 272;
using bf16x8 = __attribute__((ext_vector_type(8))) short;
using s16x4  = __attribute__((ext_vector_type(4))) short;
using f32x16 = __attribute__((ext_vector_type(16))) float;
using f32x4  = __attribute__((ext_vector_type(4))) float;
using u32x4  = __attribute__((ext_vector_type(4))) unsigned;
#define KSWZ(row, colB) ((row) * 256 + ((colB) ^ (((row) & 7) << 4)))
#define SBAR() __builtin_amdgcn_sched_barrier(0)
__device__ __forceinline__ int crow(int r, int hi) { return (r & 3) + 8 * (r >> 2) + 4 * hi; }
__device__ __forceinline__ unsigned cvtpk(float lo, float hi) { unsigned r; asm volatile("v_cvt_pk_bf16_f32 %0, %1, %2" : "=v"(r) : "v"(lo), "v"(hi)); return r; }
__device__ __forceinline__ bf16x8 ld8(const bf16* p) { return *reinterpret_cast<const bf16x8*>(p); }

__device__ __forceinline__ void partialSM(f32x16& p0, f32x16& p1, float& m_reg, float& mn, float& alpha) {
  constexpr float C = SCALE * 1.4426950408889634f;
  float pmax = p0[0];
#pragma unroll
  for (int r = 1; r < 16; ++r) pmax = fmaxf(pmax, p0[r]);
#pragma unroll
  for (int r = 0; r < 16; ++r) pmax = fmaxf(pmax, p1[r]);
  { auto rr = __builtin_amdgcn_permlane32_swap(__float_as_uint(pmax), __float_as_uint(pmax), false, false);
    pmax = fmaxf(__uint_as_float(rr[0]), __uint_as_float(rr[1])); }
  if (__builtin_expect(__all(pmax - m_reg <= THR / SCALE), 1)) { mn = m_reg; alpha = 1.f; }
  else { mn = fmaxf(m_reg, pmax); alpha = __builtin_amdgcn_exp2f((m_reg - mn) * C); m_reg = mn; }
  float mnC = -mn * C;
#pragma unroll
  for (int r = 0; r < 16; ++r) p0[r] = fmaf(p0[r], C, mnC);
#pragma unroll
  for (int r = 0; r < 16; ++r) p1[r] = fmaf(p1[r], C, mnC);
#pragma unroll
  for (int r = 0; r < 16; ++r) p0[r] = __builtin_amdgcn_exp2f(p0[r]);
}
__device__ __forceinline__ void finishSM(f32x16& p0, f32x16& p1, float alpha, float& l_reg, bf16x8& pa0, bf16x8& pa1, bf16x8& pa2, bf16x8& pa3) {
#pragma unroll
  for (int r = 0; r < 16; ++r) p1[r] = __builtin_amdgcn_exp2f(p1[r]);
  float ps = 0;
#pragma unroll
  for (int r = 0; r < 16; ++r) ps += p0[r];
#pragma unroll
  for (int r = 0; r < 16; ++r) ps += p1[r];
  { auto rr = __builtin_amdgcn_permlane32_swap(__float_as_uint(ps), __float_as_uint(ps), false, false);
    ps = __uint_as_float(rr[0]) + __uint_as_float(rr[1]); }
  l_reg = l_reg * alpha + ps;
#define PK4(P, BASE, OUT) do { unsigned a0 = cvtpk(P[BASE + 0], P[BASE + 1]), a1 = cvtpk(P[BASE + 2], P[BASE + 3]);   \
    unsigned b0 = cvtpk(P[BASE + 4], P[BASE + 5]), b1 = cvtpk(P[BASE + 6], P[BASE + 7]);                              \
    auto r0 = __builtin_amdgcn_permlane32_swap(a0, b0, false, false); auto r1 = __builtin_amdgcn_permlane32_swap(a1, b1, false, false); \
    u32x4 w = {r0[0], r1[0], r0[1], r1[1]}; OUT = *reinterpret_cast<bf16x8*>(&w); } while (0)
  PK4(p0, 0, pa0); PK4(p0, 8, pa1); PK4(p1, 0, pa2); PK4(p1, 8, pa3);
#undef PK4
}
__device__ __forceinline__ void qkt(f32x16& p0, f32x16& p1, const bf16* Ks, const bf16x8* qr, int r32, int hi) {
  p0 = f32x16{}; p1 = f32x16{};
#pragma unroll
  for (int d0 = 0; d0 < 8; ++d0) { int cb = (d0 * 16 + hi * 8) * 2;
    bf16x8 b0 = *reinterpret_cast<const bf16x8*>((const char*)Ks + KSWZ(r32, cb));
    bf16x8 b1 = *reinterpret_cast<const bf16x8*>((const char*)Ks + KSWZ(32 + r32, cb));
    p0 = __builtin_amdgcn_mfma_f32_32x32x16_bf16(b0, qr[d0], p0, 0, 0, 0);
    p1 = __builtin_amdgcn_mfma_f32_32x32x16_bf16(b1, qr[d0], p1, 0, 0, 0); }
}
__device__ __forceinline__ int v_st(int k, int c) { const int kk = (k & ~0xC) | ((k & 4) << 1) | ((k & 8) >> 1); return ((kk >> 3) * 4 + (c >> 5)) * 512 + ((kk & 7) * 32 + (c & 31)) * 2; }
__device__ __forceinline__ int v_rd_base(int lane) { return ((lane & 3) << 3) | (((lane >> 2) & 3) << 6) | (((lane >> 4) & 1) << 5) | (((lane >> 5) & 1) << 8); }
constexpr int v_rd_off(int d0, int ks, int half) { return d0 * 512 + ks * 4096 + half * 2048; }
template <int OFF> __device__ __forceinline__ s16x4 tr_read(int vb) {
  s16x4 r; asm volatile("ds_read_b64_tr_b16 %0, %1 offset:%2" : "=&v"(r) : "v"(vb), "i"(OFF) : "memory"); return r;
}
template <int D0> __device__ __forceinline__ void pv_one(f32x16& od, int vb, bf16x8 pa0, bf16x8 pa1, bf16x8 pa2, bf16x8 pa3) {
  const s16x4 l0 = tr_read<v_rd_off(D0, 0, 0)>(vb), h0 = tr_read<v_rd_off(D0, 0, 1)>(vb), l1 = tr_read<v_rd_off(D0, 1, 0)>(vb), h1 = tr_read<v_rd_off(D0, 1, 1)>(vb);
  const s16x4 l2 = tr_read<v_rd_off(D0, 2, 0)>(vb), h2 = tr_read<v_rd_off(D0, 2, 1)>(vb), l3 = tr_read<v_rd_off(D0, 3, 0)>(vb), h3 = tr_read<v_rd_off(D0, 3, 1)>(vb);
  asm volatile("s_waitcnt lgkmcnt(0)" ::: "memory"); SBAR();
#define PK(L, H) (bf16x8){L[0], L[1], L[2], L[3], H[0], H[1], H[2], H[3]}
  od = __builtin_amdgcn_mfma_f32_32x32x16_bf16(pa0, PK(l0, h0), od, 0, 0, 0);
  od = __builtin_amdgcn_mfma_f32_32x32x16_bf16(pa1, PK(l1, h1), od, 0, 0, 0);
  od = __builtin_amdgcn_mfma_f32_32x32x16_bf16(pa2, PK(l2, h2), od, 0, 0, 0);
  od = __builtin_amdgcn_mfma_f32_32x32x16_bf16(pa3, PK(l3, h3), od, 0, 0, 0);
#undef PK
}
__device__ __forceinline__ void pv_d0(f32x16* o, int vb, bf16x8 pa0, bf16x8 pa1, bf16x8 pa2, bf16x8 pa3) {
  pv_one<0>(o[0], vb, pa0, pa1, pa2, pa3); pv_one<1>(o[1], vb, pa0, pa1, pa2, pa3); pv_one<2>(o[2], vb, pa0, pa1, pa2, pa3); pv_one<3>(o[3], vb, pa0, pa1, pa2, pa3);
}

__device__ __forceinline__ void attn_unit(const bf16* __restrict__ Qb, const bf16* __restrict__ Kh, const bf16* __restrict__ Vh, const bf16* __restrict__ Zb,
                                          bf16* __restrict__ Ob, int seq, char* lds, const float* __restrict__ qn, const float* __restrict__ cs, const float* __restrict__ sn) {
  int tid = threadIdx.x; asm volatile("" : "+v"(tid));
  int wid = tid >> 6, lane = tid & 63, r32 = lane & 31, hi = lane >> 5;
  bf16* V_lds = (bf16*)lds; bf16* K_lds = (bf16*)(lds + 2 * SHM_V);
  float* ws = (float*)(lds + 2 * SHM_V + 2 * SHM_K) + wid * 64; float* li_l = ws; float* al_l = ws + 32;
  float m_reg = -1e30f, l_reg = 0; f32x16 o[4] = {}; bf16x8 qr[8];
  {
    const bf16* Qw = Qb + (long)(wid * QBLK + r32) * LDQ + hi * 8;
    float ss = 0.f;
#pragma unroll
    for (int d0 = 0; d0 < 8; ++d0) { const u32x4 w = *reinterpret_cast<const u32x4*>(Qw + d0 * 16); qr[d0] = __builtin_bit_cast(bf16x8, w);
#pragma unroll
      for (int e = 0; e < 4; ++e) { const float lo = __uint_as_float(w[e] << 16), hh = __uint_as_float(w[e] & 0xffff0000u); ss += lo * lo + hh * hh; } }
    { auto rr = __builtin_amdgcn_permlane32_swap(__float_as_uint(ss), __float_as_uint(ss), false, false); ss = __uint_as_float(rr[0]) + __uint_as_float(rr[1]); }
    const float rs = rsqrtf(ss * (1.f / 128.f) + EPS);
    const float* cp = cs ? cs + (long)(wid * QBLK + r32) * 64 + hi * 8 : nullptr; const float* sp = cs ? sn + (long)(wid * QBLK + r32) * 64 + hi * 8 : nullptr;
#pragma unroll
    for (int d0 = 0; d0 < 4; ++d0) {
      const u32x4 wa = __builtin_bit_cast(u32x4, qr[d0]), wb = __builtin_bit_cast(u32x4, qr[d0 + 4]); float x1[8], x2[8];
#pragma unroll
      for (int e = 0; e < 4; ++e) { x1[2 * e] = __uint_as_float(wa[e] << 16); x1[2 * e + 1] = __uint_as_float(wa[e] & 0xffff0000u); x2[2 * e] = __uint_as_float(wb[e] << 16); x2[2 * e + 1] = __uint_as_float(wb[e] & 0xffff0000u); }
      const f32x4 ga0 = *reinterpret_cast<const f32x4*>(qn + d0 * 16 + hi * 8), ga1 = *reinterpret_cast<const f32x4*>(qn + d0 * 16 + hi * 8 + 4);
      const f32x4 gb0 = *reinterpret_cast<const f32x4*>(qn + 64 + d0 * 16 + hi * 8), gb1 = *reinterpret_cast<const f32x4*>(qn + 64 + d0 * 16 + hi * 8 + 4);
#pragma unroll
      for (int e = 0; e < 8; ++e) { x1[e] *= rs * (e < 4 ? ga0[e & 3] : ga1[e & 3]); x2[e] *= rs * (e < 4 ? gb0[e & 3] : gb1[e & 3]); }
      if (cs) {
        const f32x4 c0 = *reinterpret_cast<const f32x4*>(cp + d0 * 16), c1 = *reinterpret_cast<const f32x4*>(cp + d0 * 16 + 4);
        const f32x4 s0 = *reinterpret_cast<const f32x4*>(sp + d0 * 16), s1 = *reinterpret_cast<const f32x4*>(sp + d0 * 16 + 4);
#pragma unroll
        for (int e = 0; e < 8; ++e) { const float c = e < 4 ? c0[e & 3] : c1[e & 3], sv = e < 4 ? s0[e & 3] : s1[e & 3];
          const float a = x1[e], bq = x2[e]; x1[e] = a * c - bq * sv; x2[e] = bq * c + a * sv; }
      }
      const u32x4 oa = {cvtpk(x1[0], x1[1]), cvtpk(x1[2], x1[3]), cvtpk(x1[4], x1[5]), cvtpk(x1[6], x1[7])}, ob = {cvtpk(x2[0], x2[1]), cvtpk(x2[2], x2[3]), cvtpk(x2[4], x2[5]), cvtpk(x2[6], x2[7])};
      qr[d0] = __builtin_bit_cast(bf16x8, oa); qr[d0 + 4] = __builtin_bit_cast(bf16x8, ob);
      asm volatile("" ::: "memory");
    }
  }
  const int sr = tid >> 4, sc = (tid & 15) * 8, vst0 = v_st(sr, sc), vst1 = v_st(32 + sr, sc);
  const int vb0 = (int)(uintptr_t)V_lds + v_rd_base(lane);
  struct { bf16x8 vs0, vs1, ks0, ks1; } sr_[SDEPTH];
#define SLOAD(i, k0) do { sr_[i].vs0 = ld8(&Vh[(long)((k0) + sr) * LDK + sc]); sr_[i].vs1 = ld8(&Vh[(long)((k0) + 32 + sr) * LDK + sc]); \
    sr_[i].ks0 = ld8(&Kh[(long)((k0) + sr) * LDK + sc]); sr_[i].ks1 = ld8(&Kh[(long)((k0) + 32 + sr) * LDK + sc]); } while (0)
#define SWRITE(b, i) do { *(bf16x8*)((char*)V_lds + (b) * SHM_V + vst0) = sr_[i].vs0;          \
    *(bf16x8*)((char*)V_lds + (b) * SHM_V + vst1) = sr_[i].vs1; int kc = sc * 2;               \
    *(bf16x8*)((char*)K_lds + (b) * SHM_K + KSWZ(sr, kc)) = sr_[i].ks0;                       \
    *(bf16x8*)((char*)K_lds + (b) * SHM_K + KSWZ(32 + sr, kc)) = sr_[i].ks1; } while (0)
#define SWAIT() do { if constexpr (SDEPTH == 2) asm volatile("s_waitcnt vmcnt(4)" ::: "memory"); else asm volatile("s_waitcnt vmcnt(0)" ::: "memory"); } while (0)
#define RESC(a) do { if (__any((a) < 1.f)) { if (hi == 0) al_l[r32] = (a); asm volatile("s_waitcnt lgkmcnt(0)" ::: "memory"); \
    _Pragma("unroll") for (int d = 0; d < 4; ++d) _Pragma("unroll") for (int r = 0; r < 16; ++r) o[d][r] *= al_l[crow(r, hi)]; } } while (0)
  f32x16 pA0, pA1, pB0, pB1; float mnA, mnB, alA, alB; bf16x8 pa0, pa1, pa2, pa3; const int NT = seq / KVBLK;
  constexpr int SE = 0, SO = SDEPTH - 1;
  SLOAD(SE, 0); asm volatile("s_waitcnt vmcnt(0)" ::: "memory"); SWRITE(0, SE); __syncthreads();
  qkt(pA0, pA1, K_lds, qr, r32, hi); partialSM(pA0, pA1, m_reg, mnA, alA);
  SLOAD(SO, KVBLK); if constexpr (SDEPTH == 2) { if (2 < NT) SLOAD(SE, 2 * KVBLK); }
  SWAIT(); SWRITE(1, SO); __syncthreads();
  for (int j = 1; j + 1 < NT; j += 2) {
    SBAR(); qkt(pB0, pB1, (bf16*)((char*)K_lds + SHM_K), qr, r32, hi);
    finishSM(pA0, pA1, alA, l_reg, pa0, pa1, pa2, pa3); SBAR();
    SLOAD(SO, (j + SDEPTH) * KVBLK); SBAR();
    pv_d0(o, vb0, pa0, pa1, pa2, pa3); partialSM(pB0, pB1, m_reg, mnB, alB);
    __syncthreads(); SWAIT(); SWRITE(0, SE);
    RESC(alB); __syncthreads();
    SBAR(); qkt(pA0, pA1, K_lds, qr, r32, hi);
    finishSM(pB0, pB1, alB, l_reg, pa0, pa1, pa2, pa3); SBAR();
    if (SDEPTH == 1 || j + 3 < NT) SLOAD(SE, (j + 1 + SDEPTH) * KVBLK); SBAR();
    pv_d0(o, vb0 + (int)SHM_V, pa0, pa1, pa2, pa3); partialSM(pA0, pA1, m_reg, mnA, alA);
    __syncthreads(); SWAIT(); SWRITE(1, SO);
    RESC(alA); __syncthreads();
  }
  SBAR(); qkt(pB0, pB1, (bf16*)((char*)K_lds + SHM_K), qr, r32, hi);
  finishSM(pA0, pA1, alA, l_reg, pa0, pa1, pa2, pa3); SBAR();
  pv_d0(o, vb0, pa0, pa1, pa2, pa3); partialSM(pB0, pB1, m_reg, mnB, alB);
  __syncthreads(); RESC(alB);
  finishSM(pB0, pB1, alB, l_reg, pa0, pa1, pa2, pa3); SBAR();
  pv_d0(o, vb0 + (int)SHM_V, pa0, pa1, pa2, pa3);
  if (hi == 0) li_l[r32] = l_reg; asm volatile("s_waitcnt lgkmcnt(0)" ::: "memory");
  { int tz = threadIdx.x; asm volatile("" : "+v"(tz)); wid = tz >> 6; lane = tz & 63; r32 = lane & 31; hi = lane >> 5; }
  float rli[16];
#pragma unroll
  for (int r = 0; r < 16; ++r) rli[r] = __builtin_amdgcn_rcpf(li_l[crow(r, hi)]);
  char* ost = lds + OST_OFF + wid * (32 * 272);
#pragma unroll
  for (int r = 0; r < 16; ++r) { const int orow = crow(r, hi);
#pragma unroll
    for (int d0 = 0; d0 < 4; ++d0) *(bf16*)(ost + orow * 272 + (d0 * 32 + r32) * 2) = __float2bfloat16(o[d0][r] * rli[r]); }
  asm volatile("s_waitcnt lgkmcnt(0)" ::: "memory");
  bf16* Ow = Ob + (long)(wid * QBLK) * LDO; const bf16* Zw = Zb + (long)(wid * QBLK) * LDQ;
#pragma unroll
  for (int hb = 0; hb < 2; ++hb) {
    u32x4 ov[4], zv[4];
#pragma unroll
    for (int i = 0; i < 4; ++i) { const int c = (hb * 4 + i) * 64 + lane, row = c >> 4, col = (c & 15) * 8;
      ov[i] = *reinterpret_cast<const u32x4*>(ost + row * 272 + col * 2); zv[i] = *reinterpret_cast<const u32x4*>(Zw + (long)row * LDQ + col); }
#pragma unroll
    for (int i = 0; i < 4; ++i) { const int c = (hb * 4 + i) * 64 + lane, row = c >> 4, col = (c & 15) * 8; u32x4 w;
#pragma unroll
      for (int e = 0; e < 4; ++e) { const unsigned a = ov[i][e], z = zv[i][e];
        w[e] = cvtpk(__uint_as_float(a << 16) * __uint_as_float(z << 16), __uint_as_float(a & 0xffff0000u) * __uint_as_float(z & 0xffff0000u)); }
      *reinterpret_cast<u32x4*>(Ow + (long)row * LDO + col) = w; }
  }
  __syncthreads();
#undef SLOAD
#undef SWRITE
#undef SWAIT
#undef RESC
}
}

constexpr int NWAVES = 8;
#ifndef MK_N_LAUNCHES
#define MK_N_LAUNCHES 1
#endif
constexpr int PH_PER_LAYER = 7, N_PHASES = 2 + DEPTH * PH_PER_LAYER;
constexpr size_t MiB = 1u << 20;
constexpr size_t WS_CTL = 0, CTL_ZERO_BYTES = 1 * MiB;
constexpr size_t WS_MOD = 1 * MiB;
constexpr size_t WS_ROPE = WS_MOD + MiB / 2;
constexpr size_t WS_WG = 3 * MiB;
constexpr size_t WS_WLRU = 4 * MiB;
constexpr size_t WS_WOUT = 12 * MiB;
constexpr size_t WS_WBR = 44 * MiB;
constexpr size_t WS_WIN = 140 * MiB;
constexpr size_t WS_X = 540 * MiB;
constexpr size_t WS_Y = 2112 * MiB;
constexpr size_t WS_H = 684 * MiB;
constexpr size_t WS_G2 = 1968 * MiB;
constexpr size_t WS_YB = 756 * MiB;
constexpr size_t WS_ACC = 864 * MiB;
constexpr size_t WS_GT = 936 * MiB;
constexpr size_t WS_MH = 938 * MiB;
constexpr size_t WS_P = 1082 * MiB;
constexpr size_t WS_LA = 1532 * MiB;
constexpr size_t WS_LB = 1676 * MiB;
constexpr size_t WS_X8 = WS_LB;
constexpr size_t WS_HL = 1820 * MiB;
constexpr size_t WS_GSC = 1964 * MiB;
constexpr size_t WS_END = 2328 * MiB;
constexpr int CW_BAR = 4096;
constexpr int RING_BYTES = 131072, LDS_BYTES = 147456, MISC_OFF = LDS_BYTES - 256;
static_assert(att::OST_END <= MISC_OFF, "LDS map");

#define GAS __attribute__((address_space(1)))
#define LAS __attribute__((address_space(3)))
typedef unsigned short bf16_t;
typedef unsigned v4u __attribute__((ext_vector_type(4)));
typedef unsigned v2u __attribute__((ext_vector_type(2)));
typedef float f32x4 __attribute__((ext_vector_type(4)));
#define LDS_WAIT() asm volatile("s_waitcnt lgkmcnt(0)" ::: "memory")
__device__ __forceinline__ unsigned f2bf(float f) { unsigned u = __builtin_bit_cast(unsigned, f); return (u + 0x7fffu + ((u >> 16) & 1u)) >> 16; }
__device__ __forceinline__ unsigned pk2(float lo, float hi) { unsigned r; asm("v_cvt_pk_bf16_f32 %0, %1, %2" : "=v"(r) : "v"(lo), "v"(hi)); return r; }
__device__ __forceinline__ float bf2f(bf16_t b) { return __uint_as_float((unsigned)b << 16); }
__device__ __forceinline__ float blo(unsigned w) { return __uint_as_float(w << 16); }
__device__ __forceinline__ float bhi(unsigned w) { return __uint_as_float(w & 0xffff0000u); }
__device__ __forceinline__ float lane_get(float v, int src) { return __builtin_bit_cast(float, __builtin_amdgcn_ds_bpermute(src << 2, __builtin_bit_cast(int, v))); }
__device__ __forceinline__ float lane_xor(float v, int mask, int lane) { return lane_get(v, lane ^ mask); }
__device__ __forceinline__ float lane_up(float v, int delta, int lane) { return lane_get(v, lane >= delta ? lane - delta : lane); }
__device__ __forceinline__ float wave_sum(float v, int lane) {
#pragma unroll
    for (int o = 1; o < 64; o <<= 1) v += lane_xor(v, o, lane);
    return v;
}
#define XB_TMO      128
#define XB_XCNT(j)  (256  + 64 * (j))
#define XB_XSUB(j)  (1280 + 64 * (j))
#define XB_XGEN(j)  (2304 + 64 * (j))
#define XB_TOP      3328
#define XB_TOPGEN   3392
#define XCD_BAR_WORDS 3456
#define XB_SPIN_CAP (1u << 18)

__device__ __forceinline__ unsigned xb_ld(unsigned* p)              { return __hip_atomic_load(p, __ATOMIC_RELAXED, __HIP_MEMORY_SCOPE_AGENT); }
__device__ __forceinline__ unsigned xb_add(unsigned* p, unsigned v) { return __hip_atomic_fetch_add(p, v, __ATOMIC_RELAXED, __HIP_MEMORY_SCOPE_AGENT); }
__device__ __forceinline__ unsigned xb_xcc_id() { return (unsigned)__builtin_amdgcn_s_getreg((3 << 11) | 20) & 0xFu; }
#define XB_SPIN(cond, bar) do { unsigned _sp = 0; while (cond) { __builtin_amdgcn_s_sleep(1); \
    if ((++_sp & 255u) == 0u) { if (xb_ld(&(bar)[XB_TMO])) break; if (_sp > XB_SPIN_CAP) { atomicAdd(&(bar)[XB_TMO], 1u); break; } } } } while (0)

struct XcdBarrier {
    unsigned* bar; unsigned x;
    volatile LAS unsigned* st;
};

__device__ __forceinline__ XcdBarrier xcd_barrier_post(unsigned* bar, volatile LAS unsigned* st) {
    XcdBarrier b; b.bar = bar; b.x = xb_xcc_id(); b.st = st;
    if (threadIdx.x == 0) (void)xb_add(&bar[XB_XCNT(b.x)], 1u);
    return b;
}
__device__ __forceinline__ void xcd_barrier_complete(unsigned* bar, unsigned x, unsigned& nloc, unsigned& nx) {
    const unsigned G = gridDim.x * gridDim.y * gridDim.z;
    unsigned sum, cnt, mine, sp = 0u;
    for (;;) {
        sum = 0u; cnt = 0u; mine = 0u;
#pragma unroll
        for (unsigned j = 0; j < 16; ++j) { const unsigned c = xb_ld(&bar[XB_XCNT(j)]); sum += c; cnt += (c > 0u) ? 1u : 0u; mine = (j == x) ? c : mine; }
        if (sum == G) break;
        __builtin_amdgcn_s_sleep(1);
        if ((++sp & 255u) == 0u) { if (xb_ld(&bar[XB_TMO])) break; if (sp > XB_SPIN_CAP) { atomicAdd(&bar[XB_TMO], 1u); break; } }
    }
    nloc = mine > 0u ? mine : 1u; nx = cnt > 0u ? cnt : 1u;
}

__device__ __forceinline__ void xcd_barrier(const XcdBarrier& b) {
    asm volatile("s_waitcnt vmcnt(0)" ::: "memory");
    __syncthreads();
    if (threadIdx.x == 0) {
        unsigned* bar = b.bar;
        __builtin_amdgcn_s_waitcnt(0);
        unsigned nloc = b.st[0], nx = b.st[1];
        if (nloc == 0u) { xcd_barrier_complete(bar, b.x, nloc, nx); b.st[0] = nloc; b.st[1] = nx; }
        const unsigned old = xb_add(&bar[XB_XSUB(b.x)], 1u);
        const unsigned gen = old / nloc;
        if (old + 1u == (gen + 1u) * nloc) {
            __builtin_amdgcn_fence(__ATOMIC_RELEASE, "agent");
            asm volatile("s_waitcnt vmcnt(0)" ::: "memory");
            const unsigned og = xb_add(&bar[XB_TOP], 1u);
            const unsigned tg = og / nx;
            if (og + 1u == (tg + 1u) * nx) xb_add(&bar[XB_TOPGEN], 1u);
            else XB_SPIN(xb_ld(&bar[XB_TOPGEN]) == tg, bar);
            __builtin_amdgcn_fence(__ATOMIC_ACQUIRE, "agent");
            xb_add(&bar[XB_XGEN(b.x)], 1u);
            asm volatile("s_waitcnt vmcnt(0)" ::: "memory");
        } else {
            XB_SPIN(xb_ld(&bar[XB_XGEN(b.x)]) == gen, bar);
            __builtin_amdgcn_fence(__ATOMIC_ACQUIRE, "agent");
            asm volatile("s_waitcnt vmcnt(0)" ::: "memory");
        }
    }
    __syncthreads();
}

struct Args { const float* in[22]; float* out; unsigned char* ws; int ph_lo, ph_hi; };
typedef const __attribute__((address_space(4))) Args CArgs;
#define KIN(k) ((const float*)ka->in[k])
#define WSF(off) ((float*)(ka->ws + (off)))
#define WSB(off) ((bf16_t*)(ka->ws + (off)))
#define KA() ({ CArgs* _k = ka0; asm volatile("" : "+s"(_k)); _k; })
__device__ __forceinline__ int tid_fresh() { int t = threadIdx.x; asm volatile("" : "+v"(t)); return t; }
struct Frame {
    LAS unsigned char* lds; char* ldsg;
    int tid, lane, wave, G, wg;
};

__device__ __forceinline__ void transpose_item(const float* W, int ldw, int col0, int k0, bf16_t* WT, int ldt, int drow0, LAS float* scr, int lane) {
    f32x4 v[8];
#pragma unroll
    for (int i = 0; i < 8; ++i) v[i] = __builtin_nontemporal_load((const f32x4*)(W + (size_t)(k0 + 8 * i + (lane >> 3)) * ldw + col0 + 4 * (lane & 7)));
#pragma unroll
    for (int i = 0; i < 8; ++i) { LAS float* d = scr + (8 * i + (lane >> 3)) * 33 + 4 * (lane & 7); d[0] = v[i][0]; d[1] = v[i][1]; d[2] = v[i][2]; d[3] = v[i][3]; }
    LDS_WAIT(); asm volatile("" ::: "memory");
    const int c = lane & 7;
#pragma unroll
    for (int j = 0; j < 4; ++j) { const int n = (lane >> 3) + 8 * j; const LAS float* s = scr + (8 * c) * 33 + n;
        v4u o; o.x = pk2(s[0 * 33], s[1 * 33]); o.y = pk2(s[2 * 33], s[3 * 33]); o.z = pk2(s[4 * 33], s[5 * 33]); o.w = pk2(s[6 * 33], s[7 * 33]);
        __builtin_nontemporal_store(o, (v4u*)(WT + (size_t)(drow0 + n) * ldt + k0 + 8 * c)); }
    LDS_WAIT(); asm volatile("" ::: "memory");
}
__device__ __forceinline__ void p_convert(Frame& F, CArgs* ka, int l, int wv, int nwv, int it0 = 0, int it1 = 1 << 30) {
    const int tid = tid_fresh(), lane = tid & 63, wave = __builtin_amdgcn_readfirstlane(tid >> 6);
    LAS float* scr = (LAS float*)(F.lds + wave * 8704);
    constexpr int I_IN = 32 * 800, I_G = 32, I_BR = 3 * 2048, I_OUT = 2048, I_LRU = 2 * 2 * 16 * 8, I_LAYER = I_IN + I_G + I_BR + I_OUT + I_LRU;
    if (it1 > I_LAYER) it1 = I_LAYER;
    for (int it = it0 + wv; it < it1; it += nwv) {
        int r = it;
        if (r < I_IN) { const int kb = r / 800, nb = r - kb * 800, n0 = nb * 32, sc = n0 < 14336 ? n0 : n0 + 32;
            transpose_item(KIN(8) + (size_t)l * DM * NIN, NIN, sc, kb * 64, WSB(WS_WIN) + (size_t)l * NP * DM, DM, n0, scr, lane); continue; }
        r -= I_IN;
        if (r < I_G) { transpose_item(KIN(8) + (size_t)l * DM * NIN, NIN, 14336, r * 64, WSB(WS_WG) + (size_t)l * 32 * DM, DM, 0, scr, lane); continue; }
        r -= I_G;
        if (r < I_BR) { const int z = r / 2048, q = r - z * 2048, kb = q / 64, nb = q - kb * 64;
            transpose_item(KIN(20) + ((size_t)l * 3 + z) * DM * DM, DM, nb * 32, kb * 64, WSB(WS_WBR) + ((size_t)l * 3 + z) * DM * DM, DM, nb * 32, scr, lane); continue; }
        r -= I_BR;
        if (r < I_OUT) { const int kb = r / 64, nb = r - kb * 64;
            transpose_item(KIN(21) + (size_t)l * DM * DM, DM, nb * 32, kb * 64, WSB(WS_WOUT) + (size_t)l * DM * DM, DM, nb * 32, scr, lane); continue; }
        r -= I_OUT;
        { const int q = r & 7, mt = r >> 3, blk = mt & 15, gate = (mt >> 4) & 1, dr = mt >> 5, kb = q >> 2, nb = q & 3;
          const float* src = (gate ? KIN(13) : KIN(11)) + (((size_t)l * 2 + dr) * 16 + blk) * 16384;
          transpose_item(src, 128, nb * 32, kb * 64, WSB(WS_WLRU) + ((((size_t)l * 2 + dr) * 2 + gate) * 16 + blk) * 16384, 128, nb * 32, scr, lane); }
    }
}
__device__ __forceinline__ void p_prologue(Frame& F, CArgs* ka) {
    const int tid = tid_fresh(), lane = tid & 63, wave = __builtin_amdgcn_readfirstlane(tid >> 6); (void)lane; (void)wave;
    for (int i = F.wg * 512 + tid; i < SEQ * 64; i += F.G * 512) { const int t = i >> 6, j = i & 63;
        const float inv = 1.0f / powf(10000.0f, (float)(j & 31) * (1.0f / 32.0f)); const float pos = (float)(j < 32 ? (t >> 6) : (t & 63)); const float ang = pos * inv;
        { const float rev = ang * 0.15915494309189535f; WSF(WS_ROPE)[i] = __builtin_amdgcn_cosf(rev); WSF(WS_ROPE)[SEQ * 64 + i] = __builtin_amdgcn_sinf(rev); } }
    __syncthreads();
    LAS float* sc = (LAS float*)(F.lds + 73728);
    LAS float* red = (LAS float*)(F.lds + 73728 + 5 * 2048 * 4);
    for (int i = tid; i < 5 * DM; i += 512) { const int bi = i >> 11, k = i & 2047; const float v = bi < 4 ? KIN(1)[bi * DM + k] : KIN(3)[k]; sc[i] = v / (1.f + expf(-v)); }
    __syncthreads();
    for (int it = F.wg; it < DEPTH * 192; it += F.G) { const int l = it / 192, j0 = (it - l * 192) * 32, cj = tid & 31, ks = tid >> 5;
        float a0 = 0.f, a1 = 0.f, a2 = 0.f, a3 = 0.f, a4 = 0.f; const float* w = KIN(4) + (size_t)l * DM * 3 * DM + j0 + cj;
        for (int k = ks * 128; k < ks * 128 + 128; ++k) { const float wv = w[(size_t)k * (3 * DM)]; a0 += sc[k] * wv; a1 += sc[2048 + k] * wv; a2 += sc[4096 + k] * wv; a3 += sc[6144 + k] * wv; a4 += sc[8192 + k] * wv; }
        red[(ks * 5 + 0) * 32 + cj] = a0; red[(ks * 5 + 1) * 32 + cj] = a1; red[(ks * 5 + 2) * 32 + cj] = a2; red[(ks * 5 + 3) * 32 + cj] = a3; red[(ks * 5 + 4) * 32 + cj] = a4;
        __syncthreads();
        if (tid < 160) { const int bi = tid >> 5, c = tid & 31; float s = KIN(5)[(size_t)l * 3 * DM + j0 + c];
            for (int q = 0; q < 16; ++q) s += red[(q * 5 + bi) * 32 + c];
            WSF(WS_MOD)[((size_t)l * 5 + bi) * (3 * DM) + j0 + c] = s; }
        __syncthreads();
    }
}

__device__ __forceinline__ void p_norm(Frame& F, CArgs* ka, int l, bool dry = false) {
    const int tid = tid_fresh(), lane = tid & 63, wave = __builtin_amdgcn_readfirstlane(tid >> 6); (void)lane; (void)wave;
    const int gw = F.wg * NWAVES + wave, NGW = F.G * NWAVES;
    for (int r = gw; r < MROWS; r += NGW) {
        const int b = r / TPB, t = r - b * TPB; const bool isctx = t >= SEQ; const int bi = isctx ? 4 : b;
        if (l == DEPTH && isctx) continue;
        f32x4 v[8];
        if (l == 0) { const float* src = isctx ? KIN(2) + ((size_t)b * CTXL + (t - SEQ)) * DM : KIN(0) + ((size_t)b * SEQ + t) * DM;
#pragma unroll
            for (int j = 0; j < 8; ++j) v[j] = *(const f32x4*)(src + j * 256 + lane * 4);
        } else {
            const float* xr = WSF(WS_X) + (size_t)r * DM; f32x4 y[8]; float ss = 0.f;
#if Y_BF16
            const bf16_t* yr = WSB(WS_Y) + (size_t)r * DM;
#define CVY(w_) ((f32x4){blo((w_).x), bhi((w_).x), blo((w_).y), bhi((w_).y)})
            { v2u yw[8];
#pragma unroll
              for (int j = 0; j < 8; ++j) yw[j] = *(const v2u*)(yr + j * 256 + lane * 4);
#pragma unroll
              for (int j = 0; j < 8; ++j) y[j] = CVY(yw[j]); }
            if (SPLIT_CTX && isctx && F.G == 256) { v2u s1[8], s2[8];
#pragma unroll
              for (int j = 0; j < 8; ++j) { s1[j] = *(const v2u*)(yr + (size_t)MROWS * DM + j * 256 + lane * 4); s2[j] = *(const v2u*)(yr + 2 * (size_t)MROWS * DM + j * 256 + lane * 4); }
#pragma unroll
              for (int j = 0; j < 8; ++j) y[j] = y[j] + CVY(s1[j]) + CVY(s2[j]); }
#undef CVY
#else
            const float* yr = WSF(WS_Y) + (size_t)r * DM;
#pragma unroll
            for (int j = 0; j < 8; ++j) y[j] = *(const f32x4*)(yr + j * 256 + lane * 4);
            if (SPLIT_CTX && isctx && F.G == 256) {
#pragma unroll
              for (int j = 0; j < 8; ++j) y[j] = y[j] + *(const f32x4*)(yr + (size_t)MROWS * DM + j * 256 + lane * 4) + *(const f32x4*)(yr + 2 * (size_t)MROWS * DM + j * 256 + lane * 4); }
#endif
#pragma unroll
            for (int j = 0; j < 8; ++j) ss += y[j].x * y[j].x + y[j].y * y[j].y + y[j].z * y[j].z + y[j].w * y[j].w;
            const float rs = rsqrtf(wave_sum(ss, lane) * (1.f / DM) + EPS);
            const float* gate = WSF(WS_MOD) + ((size_t)(l - 1) * 5 + bi) * (3 * DM) + 2 * DM; const float* npost = KIN(7) + (size_t)(l - 1) * DM;
#pragma unroll
            for (int j = 0; j < 8; ++j) { const int c = j * 256 + lane * 4; const f32x4 g = *(const f32x4*)(gate + c), w = *(const f32x4*)(npost + c), xv = *(const f32x4*)(xr + c);
                v[j] = xv + g * (y[j] * rs * w); }
        }
        if (l == DEPTH) { float* o = (ka->out) + ((size_t)b * SEQ + t) * DM;
#pragma unroll
            for (int j = 0; j < 8; ++j) *(f32x4*)(o + j * 256 + lane * 4) = v[j];
            continue; }
        float* xo = (dry ? WSF(WS_ACC) : WSF(WS_X)) + (size_t)r * DM; float ss = 0.f;
#pragma unroll
        for (int j = 0; j < 8; ++j) { *(f32x4*)(xo + j * 256 + lane * 4) = v[j]; ss += v[j].x * v[j].x + v[j].y * v[j].y + v[j].z * v[j].z + v[j].w * v[j].w; }
        const float rs = rsqrtf(wave_sum(ss, lane) * (1.f / DM) + EPS);
        const float* shift = WSF(WS_MOD) + ((size_t)l * 5 + bi) * (3 * DM); const float* scale = shift + DM; const float* npre = KIN(6) + (size_t)l * DM;
        bf16_t* ho = (dry ? WSB(WS_G2) : WSB(WS_H)) + (size_t)r * DM;
#pragma unroll
        for (int j = 0; j < 8; ++j) { const int c = j * 256 + lane * 4; const f32x4 sh = *(const f32x4*)(shift + c), scv = *(const f32x4*)(scale + c), w = *(const f32x4*)(npre + c);
            const f32x4 h = v[j] * rs * w * (scv + 1.f) + sh; v2u o; o.x = pk2(h.x, h.y); o.y = pk2(h.z, h.w); *(v2u*)(ho + c) = o; }
    }
}

__device__ __forceinline__ void p_gates(Frame& F, CArgs* ka, int l, int wk0, int nwk) {
    const int tid = tid_fresh(), lane = tid & 63, wave = __builtin_amdgcn_readfirstlane(tid >> 6), c16 = lane & 15, q = lane >> 4;
    typedef short bf16x8 __attribute__((ext_vector_type(8)));
    LAS float* GL = (LAS float*)F.lds;
    const bf16_t* H = WSB(WS_H); const bf16_t* WG = WSB(WS_WG) + (size_t)l * 32 * DM; float* GT = WSF(WS_GT); f32x4* GSC = (f32x4*)WSF(WS_GSC);
    for (int task = wk0; task < NBATCH * 36; task += nwk) { const int b = task / 36, chunk = task - b * 36; const size_t row0 = (size_t)b * TPB + chunk * 64;
        __syncthreads();
        { const int rb = wave & 3, kh = wave >> 2; f32x4 a0 = {0.f, 0.f, 0.f, 0.f}, a1 = {0.f, 0.f, 0.f, 0.f};
          const bf16_t* hp = H + (row0 + rb * 16 + c16) * DM + kh * 1024 + q * 8; const bf16_t* w0 = WG + (size_t)c16 * DM + kh * 1024 + q * 8; const bf16_t* w1 = w0 + 16 * DM;
#pragma unroll 1
          for (int kb = 0; kb < 32; kb += 8) { bf16x8 av[8], b0[8], b1[8];
#pragma unroll
              for (int i = 0; i < 8; ++i) { av[i] = *(const bf16x8*)(hp + (kb + i) * 32); b0[i] = *(const bf16x8*)(w0 + (kb + i) * 32); b1[i] = *(const bf16x8*)(w1 + (kb + i) * 32); }
#pragma unroll
              for (int i = 0; i < 8; ++i) { a0 = __builtin_amdgcn_mfma_f32_16x16x32_bf16(av[i], b0[i], a0, 0, 0, 0); a1 = __builtin_amdgcn_mfma_f32_16x16x32_bf16(av[i], b1[i], a1, 0, 0, 0); } }
#pragma unroll
          for (int j = 0; j < 4; ++j) { GL[(kh * 64 + rb * 16 + q * 4 + j) * 33 + c16] = a0[j]; GL[(kh * 64 + rb * 16 + q * 4 + j) * 33 + 16 + c16] = a1[j]; } }
        __syncthreads();
#pragma unroll
        for (int i = 0; i < 4; ++i) { const int idx = tid + 512 * i, r = idx >> 5, c = idx & 31; float s = GL[r * 33 + c] + GL[(64 + r) * 33 + c] + KIN(16)[l * 32 + c];
            if ((c >> 3) & 1) s = fminf(s, 0.f) - __logf(1.f + __expf(-fabsf(s)));
            GL[r * 33 + c] = s; GT[(row0 + r) * 32 + c] = s; }
        __syncthreads();
#pragma unroll
        for (int pi = 0; pi < 2; ++pi) { const int p = wave * 2 + pi, dir = p >> 3, h = p & 7, rl = dir ? 63 - lane : lane;
            const float gi = GL[rl * 33 + dir * 16 + h]; float bc = GL[rl * 33 + dir * 16 + 8 + h];
#pragma unroll
            for (int o = 1; o < 64; o <<= 1) { const float v = lane_up(bc, o, lane); if (lane >= o) bc += v; }
            const float g = gi - bc; float pm = g;
#pragma unroll
            for (int o = 1; o < 64; o <<= 1) { const float v = lane_up(pm, o, lane); if (lane >= o) pm = fmaxf(pm, v); }
            GSC[((((size_t)b * 2 + dir) * 8 + h) * 36 + chunk) * 64 + lane] = (f32x4){bc, g, pm, 0.f}; }
    }
    __syncthreads();
}
__device__ __forceinline__ void p_knorm(Frame& F, CArgs* ka, int l, bool dry = false) {
    const int tid = tid_fresh(), lane = tid & 63, wave = __builtin_amdgcn_readfirstlane(tid >> 6);
    const int gw = F.wg * NWAVES + wave, NGW = F.G * NWAVES; const int sub = lane & 15;
    f32x4 kn0 = *(const f32x4*)(KIN(19) + l * 128 + sub * 8), kn1 = *(const f32x4*)(KIN(19) + l * 128 + sub * 8 + 4);
    for (int r = gw; r < MROWS; r += NGW) { const int b = r / TPB, t = r - b * TPB;
        bf16_t* kp = WSB(WS_P) + (size_t)r * NP + C_AK + lane * 8; const v4u raw = *(const v4u*)kp; float v[8];
#pragma unroll
        for (int e = 0; e < 4; ++e) { v[2 * e] = blo(raw[e]); v[2 * e + 1] = bhi(raw[e]); }
        float ss = 0.f;
#pragma unroll
        for (int e = 0; e < 8; ++e) ss += v[e] * v[e];
        ss += lane_xor(ss, 1, lane); ss += lane_xor(ss, 2, lane); ss += lane_xor(ss, 4, lane); ss += lane_xor(ss, 8, lane);
        const float rs = rsqrtf(ss * (1.f / 128.f) + EPS);
#pragma unroll
        for (int e = 0; e < 8; ++e) v[e] *= rs * (e < 4 ? kn0[e & 3] : kn1[e & 3]);
        if (t < SEQ) { const int i0 = (sub & 7) * 8; const float* cp = WSF(WS_ROPE) + (size_t)t * 64 + i0; const float* sp = cp + SEQ * 64;
            const f32x4 c0 = *(const f32x4*)cp, c1 = *(const f32x4*)(cp + 4), s0 = *(const f32x4*)sp, s1 = *(const f32x4*)(sp + 4); const bool upper = (sub & 8) != 0;
#pragma unroll
            for (int e = 0; e < 8; ++e) { const float o = lane_xor(v[e], 8, lane), c = e < 4 ? c0[e & 3] : c1[e & 3], sn = e < 4 ? s0[e & 3] : s1[e & 3];
                v[e] = upper ? v[e] * c + o * sn : v[e] * c - o * sn; } }
        v4u ov; ov.x = pk2(v[0], v[1]); ov.y = pk2(v[2], v[3]); ov.z = pk2(v[4], v[5]); ov.w = pk2(v[6], v[7]);
        if (dry) *(v4u*)(WSB(WS_ACC) + (size_t)r * 512 + lane * 8) = ov; else *(v4u*)kp = ov; }
}

__device__ __forceinline__ void p_lru_gates_naive(Frame& F, CArgs* ka, int l) {
    const int tid = tid_fresh(); (void)tid;
    LAS float* xs = (LAS float*)F.lds;
    for (int it = F.wg; it < (MROWS / 16) * 16; it += F.G) { const int rt = it >> 4, blk = it & 15;
        __syncthreads();
#pragma unroll
        for (int j = 0; j < 4; ++j) { const int idx = tid + 512 * j, rr = idx >> 7, c = idx & 127, r = rt * 16 + rr, b = r / TPB, t = r - b * TPB, ch = blk * 128 + c;
            const int lo = t < SEQ ? 0 : SEQ, hi = t < SEQ ? SEQ : TPB; float a = KIN(10)[l * DM + ch];
#pragma unroll
            for (int k = 0; k < 4; ++k) { const int tt = t + k - 2; if (tt >= lo && tt < hi) a += KIN(9)[((size_t)l * 4 + k) * DM + ch] * bf2f(WSB(WS_P)[((size_t)b * TPB + tt) * NP + C_LX + ch]); }
            xs[rr * 128 + c] = a; }
        __syncthreads();
        const int co = tid & 127, r0 = tid >> 7, ch = blk * 128 + co;
#pragma unroll 1
        for (int dr = 0; dr < 2; ++dr) {
            const float* wr = KIN(11) + (((size_t)l * 2 + dr) * 16 + blk) * 16384 + co; const float* wi = KIN(13) + (((size_t)l * 2 + dr) * 16 + blk) * 16384 + co;
            float ar[4], ai[4];
#pragma unroll
            for (int j = 0; j < 4; ++j) { ar[j] = KIN(12)[((size_t)l * 2 + dr) * DM + ch]; ai[j] = KIN(14)[((size_t)l * 2 + dr) * DM + ch]; }
            for (int c = 0; c < 128; ++c) { const float w0 = wr[c * 128], w1 = wi[c * 128];
#pragma unroll
                for (int j = 0; j < 4; ++j) { const float xv = xs[(r0 + 4 * j) * 128 + c]; ar[j] += xv * w0; ai[j] += xv * w1; } }
            const float lam = KIN(15)[((size_t)l * 2 + dr) * DM + ch], sp = log1pf(expf(-lam));
#pragma unroll
            for (int j = 0; j < 4; ++j) { const int r = rt * 16 + r0 + 4 * j; const float rg = 1.f / (1.f + expf(-ar[j])), ig = 1.f / (1.f + expf(-ai[j]));
                const float log_a = -8.f * rg * sp, a = expf(log_a), mult = sqrtf(-expm1f(2.f * log_a));
                WSF(WS_LA)[((size_t)dr * MROWS + r) * DM + ch] = a; WSF(WS_LB)[((size_t)dr * MROWS + r) * DM + ch] = mult * ig * xs[(r0 + 4 * j) * 128 + co]; }
        }
    }
    __syncthreads();
}

__device__ __forceinline__ void p_attention(Frame& F, CArgs* ka, int l, bool need_ctx) {
    using att::bf16;
    const int n_lat = NBATCH * 16 * 8, n_all = n_lat + (need_ctx ? NBATCH * 16 : 0);
    for (int u = F.wg; u < n_all; u += F.G) {
        int b, h, q0, k0, seq; const float *cs = nullptr, *sn = nullptr;
        if (u < n_lat) { const int qb = u & 7; h = (u >> 3) & 15; b = u >> 7; q0 = qb * 256; k0 = 0; seq = TPB; cs = WSF(WS_ROPE) + (size_t)q0 * 64; sn = WSF(WS_ROPE) + (size_t)SEQ * 64 + (size_t)q0 * 64; }
        else { const int v = u - n_lat; h = v & 15; b = v >> 4; q0 = SEQ; k0 = SEQ; seq = CTXL; }
        const size_t rq = (size_t)b * TPB + q0, rk = (size_t)b * TPB + k0; const int kvh = h >> 2;
        att::attn_unit((const bf16*)(WSB(WS_P) + rq * NP + C_AQ + h * 128), (const bf16*)(WSB(WS_P) + rk * NP + C_AK + kvh * 128), (const bf16*)(WSB(WS_P) + rk * NP + C_AV + kvh * 128),
                       (const bf16*)(WSB(WS_P) + rq * NP + C_AZ + h * 128), (bf16*)(WSB(WS_YB) + ((size_t)2 * MROWS + rq) * DM + h * 128), seq, F.ldsg, KIN(18) + l * 128, cs, sn);
    }
}
__device__ __forceinline__ int seq_row(int s, int dir) { return s < CTXL ? SEQ + (dir ? CTXL - 1 - s : s) : (dir ? SEQ - 1 - (s - CTXL) : s - CTXL); }
__device__ __forceinline__ void p_mlstm_naive(Frame& F, CArgs* ka, int l) {
    const int tid = tid_fresh(), lane = tid & 63, wave = __builtin_amdgcn_readfirstlane(tid >> 6); (void)lane; (void)wave;
    LAS float* sq = (LAS float*)F.lds; LAS float* sk = sq + 256; LAS float* rn = sk + 256; LAS float* rd = rn + 512;
    const int e = tid & 63, dg = tid >> 6;
    for (int u = F.wg; u < 256; u += F.G) { const int es = u & 3, dir = (u >> 2) & 1, h = (u >> 3) & 7, b = u >> 6;
        float C[32], n[32];
#pragma unroll
        for (int i = 0; i < 32; ++i) { C[i] = 0.f; n[i] = 0.f; }
        float m = -1e30f;
        const int lcol = tid < 64 ? C_MQ + h * 256 + tid * 4 : C_MK + h * 256 + (tid - 64) * 4, vcol = C_MV + h * 256 + es * 64 + e;
        v2u pqk = {0u, 0u}; bf16_t pv; float gi, gf;
        { const size_t r = (size_t)b * TPB + seq_row(0, dir); if (tid < 128) pqk = *(const v2u*)(WSB(WS_P) + r * NP + lcol); pv = WSB(WS_P)[r * NP + vcol]; gi = WSF(WS_GT)[r * 32 + dir * 16 + h]; gf = WSF(WS_GT)[r * 32 + dir * 16 + 8 + h]; }
        __syncthreads();
        for (int s = 0; s < TPB; ++s) {
            const size_t r = (size_t)b * TPB + seq_row(s, dir);
            if (tid < 128) { LAS float* d = (tid < 64 ? sq : sk) + (tid & 63) * 4; d[0] = blo(pqk.x); d[1] = bhi(pqk.x); d[2] = blo(pqk.y); d[3] = bhi(pqk.y); }
            const float vv = bf2f(pv), iv = gi, lf = gf;
            __syncthreads();
            if (s + 1 < TPB) { const size_t r2 = (size_t)b * TPB + seq_row(s + 1, dir); if (tid < 128) pqk = *(const v2u*)(WSB(WS_P) + r2 * NP + lcol); pv = WSB(WS_P)[r2 * NP + vcol]; gi = WSF(WS_GT)[r2 * 32 + dir * 16 + h]; gf = WSF(WS_GT)[r2 * 32 + dir * 16 + 8 + h]; }
            const float mnew = fmaxf(lf + m, iv), fw = expf(lf + m - mnew), iw = expf(iv - mnew); m = mnew;
            float pn = 0.f, pd = 0.f;
#pragma unroll
            for (int dd = 0; dd < 32; ++dd) { const float kd = sk[dg * 32 + dd], qd = sq[dg * 32 + dd]; C[dd] = fw * C[dd] + iw * kd * vv; n[dd] = fw * n[dd] + iw * kd; pn += qd * C[dd]; pd += qd * n[dd]; }
            rn[dg * 64 + e] = pn; rd[dg * 64 + e] = pd;
            __syncthreads();
            if (dg == 0) { float num = 0.f, den = 0.f;
#pragma unroll
                for (int g = 0; g < 8; ++g) { num += rn[g * 64 + e]; den += rd[g * 64 + e]; }
                WSB(WS_MH)[((size_t)dir * MROWS + r) * DM + h * 256 + es * 64 + e] = (bf16_t)f2bf(num / fmaxf(fabsf(den), expf(-m))); }
        }
        __syncthreads();
    }
}
__device__ __forceinline__ void p_lru_scan_naive(Frame& F, CArgs* ka) {
    const int tid = tid_fresh(), lane = tid & 63, wave = __builtin_amdgcn_readfirstlane(tid >> 6); (void)lane; (void)wave;
    if (wave != 0) return;
    for (int cw = F.wg; cw < 256; cw += F.G) { const int combo = cw * 64 + lane, b = combo >> 12, dir = (combo >> 11) & 1, ch = combo & 2047;
        const float* A = WSF(WS_LA) + (size_t)dir * MROWS * DM + ch; const float* Bx = WSF(WS_LB) + (size_t)dir * MROWS * DM + ch; float* Ho = WSF(WS_HL) + (size_t)dir * MROWS * DM + ch; float h = 0.f;
#pragma unroll 8
        for (int s = 0; s < TPB; ++s) { const size_t r = (size_t)b * TPB + seq_row(s, dir); h = A[r * DM] * h + Bx[r * DM]; Ho[r * DM] = h; }
    }
}

__device__ __forceinline__ void p_mlout(Frame& F, CArgs* ka, int l, bool need_ctx) {
    const int tid = tid_fresh(), lane = tid & 63, wave = __builtin_amdgcn_readfirstlane(tid >> 6); (void)lane; (void)wave;
    const int gw = F.wg * NWAVES + wave, NGW = F.G * NWAVES, nrow = need_ctx ? MROWS : NBATCH * SEQ;
    for (int ri = gw; ri < nrow; ri += NGW) { const int r = need_ctx ? ri : (ri >> 11) * TPB + (ri & 2047);
        const bf16_t* pr = WSB(WS_P) + (size_t)r * NP;
        v2u ma[8], mb[8], ow[8], zw[8]; f32x4 g[8];
#pragma unroll
        for (int h = 0; h < 8; ++h) { const int col = h * 256 + lane * 4;
            ma[h] = *(const v2u*)(WSB(WS_MH) + (size_t)r * DM + col); mb[h] = *(const v2u*)(WSB(WS_MH) + ((size_t)MROWS + r) * DM + col);
            ow[h] = *(const v2u*)(pr + C_MO + col); zw[h] = *(const v2u*)(pr + C_MZ + col); g[h] = *(const f32x4*)(KIN(17) + (size_t)l * DM + col); }
#pragma unroll
        for (int h = 0; h < 8; ++h) { const int col = h * 256 + lane * 4;
            const f32x4 a = {blo(ma[h].x), bhi(ma[h].x), blo(ma[h].y), bhi(ma[h].y)}, bb = {blo(mb[h].x), bhi(mb[h].x), blo(mb[h].y), bhi(mb[h].y)};
            f32x4 v = a + bb; v.x *= blo(ow[h].x); v.y *= bhi(ow[h].x); v.z *= blo(ow[h].y); v.w *= bhi(ow[h].y);
            const float rs = rsqrtf(wave_sum(v.x * v.x + v.y * v.y + v.z * v.z + v.w * v.w, lane) * (1.f / 256.f) + EPS);
            v2u o; o.x = pk2(v.x * rs * g[h].x * blo(zw[h].x), v.y * rs * g[h].y * bhi(zw[h].x)); o.y = pk2(v.z * rs * g[h].z * blo(zw[h].y), v.w * rs * g[h].w * bhi(zw[h].y));
            *(v2u*)(WSB(WS_YB) + ((size_t)MROWS + r) * DM + col) = o; }
    }
}

__device__ __forceinline__ void p_lru_combine_naive(Frame& F, CArgs* ka) {
    const int tid = tid_fresh(), lane = tid & 63, wave = __builtin_amdgcn_readfirstlane(tid >> 6);
    const int gw = F.wg * NWAVES + wave, NGW = F.G * NWAVES;
    for (int r = gw; r < MROWS; r += NGW) {
        const bf16_t* pr = WSB(WS_P) + (size_t)r * NP;
#pragma unroll 2
        for (int j = 0; j < 8; ++j) { const int col = j * 256 + lane * 4;
            const f32x4 a = *(const f32x4*)(WSF(WS_HL) + (size_t)r * DM + col), bb = *(const f32x4*)(WSF(WS_HL) + ((size_t)MROWS + r) * DM + col); const v2u zw = *(const v2u*)(pr + C_LZ + col);
            const f32x4 v = a + bb; v2u o; o.x = pk2(v.x * blo(zw.x), v.y * bhi(zw.x)); o.y = pk2(v.z * blo(zw.y), v.w * bhi(zw.y));
            *(v2u*)(WSB(WS_YB) + (size_t)r * DM + col) = o; }
    }
}
#ifndef USE_NAIVE_ML
#define USE_NAIVE_ML 0
#endif
#ifndef USE_NAIVE_LRU
#define USE_NAIVE_LRU 0
#endif

namespace ml {
typedef short bf16x8 __attribute__((ext_vector_type(8)));
constexpr int KS_OFF = 0, KS_PITCH = 528;
constexpr int KT_OFF = KS_OFF + 64 * KS_PITCH, KT_PITCH = 144;
constexpr int VT_OFF = KT_OFF + 256 * KT_PITCH, VT_PITCH = 144;
constexpr int ST_OFF = VT_OFF + 80 * VT_PITCH, ST_PITCH = 144;
constexpr int CT_OFF = ST_OFF + 64 * ST_PITCH, CT_PITCH = 528;
constexpr int TAB_OFF = CT_OFF + 80 * CT_PITCH;
constexpr int END_OFF = TAB_OFF + 1024;
static_assert(END_OFF <= MISC_OFF, "mLSTM LDS map");
#define ML_MFMA(a, b, c) __builtin_amdgcn_mfma_f32_16x16x32_bf16((a), (b), (c), 0, 0, 0)
__device__ __forceinline__ int chunk_of(int k, int dir) { return k < 4 ? (dir ? 35 - k : 32 + k) : (dir ? 31 - (k - 4) : k - 4); }

__device__ __forceinline__ void mlstm_unit(Frame& F, CArgs* ka, int u, bool need_ctx) {
    const int tid = tid_fresh(), lane = tid & 63, w = __builtin_amdgcn_readfirstlane(tid >> 6), c16 = lane & 15, q = lane >> 4;
    const int es = u & 3, dir = (u >> 2) & 1, h = (u >> 3) & 7, b = u >> 6;
    LAS unsigned char* L = F.lds;
    const bf16_t* P = WSB(WS_P); bf16_t* MH = WSB(WS_MH) + (size_t)dir * MROWS * DM;
    const f32x4* GSC = (const f32x4*)WSF(WS_GSC) + (((size_t)b * 2 + dir) * 8 + h) * 36 * 64;
    LAS float* TABg = (LAS float*)(L + TAB_OFF); LAS float* TABmm = TABg + 64; LAS float* TABbc = TABg + 128;
    __syncthreads();
    { unsigned z0 = 0u; asm volatile("" : "+v"(z0)); const v4u zz = {z0, z0, z0, z0};
      for (int i = tid; i < 80 * CT_PITCH / 16; i += 512) *(LAS v4u*)(L + CT_OFF + i * 16) = zz; }
    for (int i = tid; i < 16 * 64; i += 512) { const int e = 64 + (i >> 6), s = i & 63; *(LAS bf16_t*)(L + VT_OFF + e * VT_PITCH + s * 2) = (bf16_t)(e == 64 ? 0x3F80 : 0); }
    f32x4 C[2][5];
#pragma unroll
    for (int a = 0; a < 2; ++a)
#pragma unroll
        for (int e = 0; e < 5; ++e) C[a][e] = (f32x4){0.f, 0.f, 0.f, 0.f};
    float m = -1e30f;
    const int tn = w & 3, wh = w >> 2;
    v4u kraw[4], vraw; bf16x8 Qf[8]; float gsc0, gsc1, gsc2;
#define ML_ROW(base, j) ((size_t)(base) + (dir ? 63 - (j) : (j)))
#define ML_LOAD_KVG(k) do { const int _c = chunk_of((k), dir), _base = b * TPB + _c * 64; const bf16_t* _rp = P + ML_ROW(_base, lane) * NP; \
        _Pragma("unroll") for (int i = 0; i < 4; ++i) kraw[i] = *(const v4u*)(_rp + C_MK + h * 256 + (w * 4 + i) * 8); \
        vraw = *(const v4u*)(_rp + C_MV + h * 256 + es * 64 + w * 8); { const float* _gp = (const float*)(GSC + _c * 64 + lane); gsc0 = _gp[0]; gsc1 = _gp[1]; gsc2 = _gp[2]; } } while (0)
#define ML_LOAD_Q(k) do { const int _base = b * TPB + chunk_of((k), dir) * 64; const bf16_t* _qp = P + ML_ROW(_base, tn * 16 + c16) * NP + C_MQ + h * 256 + q * 8; \
        _Pragma("unroll") for (int ks = 0; ks < 8; ++ks) Qf[ks] = *(const bf16x8*)(_qp + ks * 32); } while (0)
    ML_LOAD_KVG(0); ML_LOAD_Q(0);
    float bL = 0.f, mm63 = 0.f;
#pragma unroll 1
    for (int k = 0; k < 36; ++k) {
        const int base = b * TPB + chunk_of(k, dir) * 64; const bool do_out = need_ctx || k >= 4;
        if (k > 0) {
#pragma unroll
            for (int di = 0; di < 2; ++di)
#pragma unroll
                for (int en = 0; en < 5; ++en) { const f32x4 c = C[di][en]; v2u o; o.x = pk2(c[0], c[1]); o.y = pk2(c[2], c[3]);
                    *(LAS v2u*)(L + CT_OFF + (en * 16 + c16) * CT_PITCH + ((2 * w + di) * 16 + q * 4) * 2) = o; }
            m = bL + mm63; }
        const float bc = gsc0, g = gsc1, mm = fmaxf(gsc2, m), wk = __expf(g - lane_get(mm, 63));
        bL = lane_get(bc, 63); mm63 = lane_get(mm, 63);
        if (w == 0) { TABg[lane] = g; TABmm[lane] = mm; TABbc[lane] = bc; }
#pragma unroll
        for (int i = 0; i < 4; ++i) { *(LAS v4u*)(L + KS_OFF + lane * KS_PITCH + (w * 4 + i) * 16) = kraw[i];
#pragma unroll
            for (int e = 0; e < 4; ++e) { const unsigned x = kraw[i][e]; const unsigned pk = pk2(blo(x) * wk, bhi(x) * wk);
                *(LAS bf16_t*)(L + KT_OFF + ((w * 4 + i) * 8 + 2 * e) * KT_PITCH + lane * 2) = (bf16_t)(pk & 0xffffu); *(LAS bf16_t*)(L + KT_OFF + ((w * 4 + i) * 8 + 2 * e + 1) * KT_PITCH + lane * 2) = (bf16_t)(pk >> 16); } }
#pragma unroll
        for (int e = 0; e < 4; ++e) { const unsigned x = vraw[e];
            *(LAS bf16_t*)(L + VT_OFF + (w * 8 + 2 * e) * VT_PITCH + lane * 2) = (bf16_t)(x & 0xffffu); *(LAS bf16_t*)(L + VT_OFF + (w * 8 + 2 * e + 1) * VT_PITCH + lane * 2) = (bf16_t)(x >> 16); }
        __syncthreads();
        const int t = tn * 16 + c16; const int kn = k + 1 < 36 ? k + 1 : 35;
        if (do_out) {
            const float mmt = TABmm[t];
#pragma unroll
            for (int si = 0; si < 2; ++si) { const int sm = wh * 2 + si; v2u o = {0u, 0u};
                if (sm <= tn) { f32x4 acc = {0.f, 0.f, 0.f, 0.f};
#pragma unroll
                    for (int ks = 0; ks < 8; ++ks) { const bf16x8 a = *(const LAS bf16x8*)(L + KS_OFF + (sm * 16 + c16) * KS_PITCH + (ks * 32 + q * 8) * 2); acc = ML_MFMA(a, Qf[ks], acc); }
                    float v[4];
#pragma unroll
                    for (int j = 0; j < 4; ++j) { const int s = sm * 16 + q * 4 + j; v[j] = s <= t ? acc[j] * __expf(TABg[s] - mmt) : 0.f; }
                    o.x = pk2(v[0], v[1]); o.y = pk2(v[2], v[3]); }
                *(LAS v2u*)(L + ST_OFF + t * ST_PITCH + (sm * 16 + q * 4) * 2) = o; }
        }
        ML_LOAD_KVG(kn);
        __syncthreads();
        f32x4 num0 = {0.f, 0.f, 0.f, 0.f}, num1 = {0.f, 0.f, 0.f, 0.f}; float den = 1.f;
        if (do_out) {
            const float wi = __expf(m - TABmm[t]);
            bf16x8 sb[2];
#pragma unroll
            for (int ks = 0; ks < 2; ++ks) sb[ks] = *(const LAS bf16x8*)(L + ST_OFF + t * ST_PITCH + (ks * 32 + q * 8) * 2);
#pragma unroll
            for (int ei = 0; ei < 3; ++ei) { const int em = ei < 2 ? wh * 2 + ei : 4;
                f32x4 a1 = {0.f, 0.f, 0.f, 0.f}, a2 = {0.f, 0.f, 0.f, 0.f};
#pragma unroll
                for (int ks = 0; ks < 2; ++ks) { const bf16x8 a = *(const LAS bf16x8*)(L + VT_OFF + (em * 16 + c16) * VT_PITCH + (ks * 32 + q * 8) * 2); a1 = ML_MFMA(a, sb[ks], a1); }
#pragma unroll
                for (int ks = 0; ks < 8; ++ks) { const bf16x8 a = *(const LAS bf16x8*)(L + CT_OFF + (em * 16 + c16) * CT_PITCH + (ks * 32 + q * 8) * 2); a2 = ML_MFMA(a, Qf[ks], a2); }
                const f32x4 nv = a1 + a2 * wi;
                if (ei == 0) num0 = nv; else if (ei == 1) num1 = nv;
                else den = fmaxf(fabsf(lane_get(nv[0], c16)), __expf(-(TABbc[t] + TABmm[t]))); }
        }
        ML_LOAD_Q(kn);
        if (do_out) { const float rd = 1.f / den; bf16_t* op = MH + ML_ROW(base, t) * DM + h * 256 + es * 64 + q * 4; const f32x4 o0 = num0 * rd, o1 = num1 * rd;
            v2u w0, w1; w0.x = pk2(o0[0], o0[1]); w0.y = pk2(o0[2], o0[3]); w1.x = pk2(o1[0], o1[1]); w1.y = pk2(o1[2], o1[3]);
            *(v2u*)(op + (wh * 2) * 16) = w0; *(v2u*)(op + (wh * 2 + 1) * 16) = w1; }
        { const float decay = __expf(m - mm63);
          bf16x8 vb[5][2];
#pragma unroll
          for (int en = 0; en < 5; ++en)
#pragma unroll
              for (int ks = 0; ks < 2; ++ks) vb[en][ks] = *(const LAS bf16x8*)(L + VT_OFF + (en * 16 + c16) * VT_PITCH + (ks * 32 + q * 8) * 2);
#pragma unroll
          for (int di = 0; di < 2; ++di) {
            bf16x8 a[2];
#pragma unroll
            for (int ks = 0; ks < 2; ++ks) a[ks] = *(const LAS bf16x8*)(L + KT_OFF + ((2 * w + di) * 16 + c16) * KT_PITCH + (ks * 32 + q * 8) * 2);
#pragma unroll
            for (int en = 0; en < 5; ++en) { f32x4 c = C[di][en] * decay;
#pragma unroll
                for (int ks = 0; ks < 2; ++ks) c = ML_MFMA(a[ks], vb[en][ks], c);
                C[di][en] = c; } } }
        __syncthreads();
    }
#undef ML_ROW
#undef ML_LOAD_KVG
#undef ML_LOAD_Q
}
constexpr int ST2_OFF = TAB_OFF + 1024, TAB2_OFF = ST2_OFF + 64 * ST_PITCH, END2_OFF = TAB2_OFF + 1024;
static_assert(END2_OFF <= MISC_OFF, "mLSTM LDS map (pipelined)");
template <int VAR> __device__ __forceinline__ void mlstm_unit_pipe(Frame& F, CArgs* ka, int u, bool need_ctx) {
    const int tid = tid_fresh(), lane = tid & 63, w = __builtin_amdgcn_readfirstlane(tid >> 6), c16 = lane & 15, q = lane >> 4;
    const int es = u & 3, dir = (u >> 2) & 1, h = (u >> 3) & 7, b = u >> 6;
    LAS unsigned char* L = F.lds;
    const bf16_t* X8 = WSB(WS_X8); constexpr size_t X8_SEC = (size_t)MROWS * DM; bf16_t* MH = (VAR ? WSB(WS_ACC) : WSB(WS_MH)) + (size_t)dir * MROWS * DM;
    const f32x4* GSC = (const f32x4*)WSF(WS_GSC) + (((size_t)b * 2 + dir) * 8 + h) * 36 * 64;
    __syncthreads();
    { unsigned z0 = 0u; asm volatile("" : "+v"(z0)); const v4u zz = {z0, z0, z0, z0};
      for (int i = tid; i < 80 * CT_PITCH / 16; i += 512) *(LAS v4u*)(L + CT_OFF + i * 16) = zz; }
    for (int i = tid; i < 16 * 64; i += 512) { const int e = 64 + (i >> 6), s = i & 63; *(LAS bf16_t*)(L + VT_OFF + e * VT_PITCH + s * 2) = (bf16_t)(e == 64 ? 0x3F80 : 0); }
    f32x4 C[2][5];
#pragma unroll
    for (int a = 0; a < 2; ++a)
#pragma unroll
        for (int e = 0; e < 5; ++e) C[a][e] = (f32x4){0.f, 0.f, 0.f, 0.f};
    const int tn = w & 3, wh = w >> 2, t = tn * 16 + c16;
    const int kl = (dir ? 63 - lane : lane) * 8, ql = q * 512 + (dir ? 63 - t : t) * 8;
    v4u kc[4], kn[4], vc; bf16x8 Qc[8], Qn[8]; float gc0, gc1, gc2, gn0, gn1, gn2;
#define MLP_ROW(base, j) ((size_t)(base) + (dir ? 63 - (j) : (j)))
#define MLP_TAB(par) ((LAS float*)(L + ((par) ? TAB2_OFF : TAB_OFF)))
#define MLP_ST(par) ((par) ? ST2_OFF : ST_OFF)
#define MLP_XB(sec, c_) (X8 + (size_t)(sec) * X8_SEC + ((size_t)(b * 8 + h) * 36 + (c_)) * (32 * 64 * 8))
#define MLP_LOADK(dst, k) do { const bf16_t* _xb = MLP_XB(1, chunk_of((k), dir)) + w * 4 * 512; \
        _Pragma("unroll") for (int i = 0; i < 4; ++i) dst[i] = *(const v4u*)(_xb + i * 512 + kl); } while (0)
#define MLP_LOADV(dst, k) do { dst = *(const v4u*)(MLP_XB(2, chunk_of((k), dir)) + (es * 8 + w) * 512 + kl); } while (0)
#define MLP_LOADG(d0, d1, d2, k) do { const float* _gp = (const float*)(GSC + chunk_of((k), dir) * 64 + lane); d0 = _gp[0]; d1 = _gp[1]; d2 = _gp[2]; } while (0)
#define MLP_LOADQ(dst, k) do { const bf16_t* _xb = MLP_XB(0, chunk_of((k), dir)); \
        _Pragma("unroll") for (int ks = 0; ks < 8; ++ks) dst[ks] = *(const bf16x8*)(_xb + ks * 2048 + ql); } while (0)
#define MLP_STILE(QQ, TB, SO) do { const float _mmt = (TB)[64 + t]; \
        _Pragma("unroll") for (int si = 0; si < 2; ++si) { const int sm = wh * 2 + si; v2u o = {0u, 0u}; \
            if (sm <= tn) { f32x4 acc = {0.f, 0.f, 0.f, 0.f}; \
                bf16x8 ka_[8]; \
                _Pragma("unroll") for (int ks = 0; ks < 8; ++ks) ka_[ks] = *(const LAS bf16x8*)(L + KS_OFF + (sm * 16 + c16) * KS_PITCH + (ks * 32 + q * 8) * 2); \
                __builtin_amdgcn_sched_barrier(0); \
                _Pragma("unroll") for (int ks = 0; ks < 8; ++ks) acc = ML_MFMA(ka_[ks], QQ[ks], acc); \
                float v[4]; \
                _Pragma("unroll") for (int j = 0; j < 4; ++j) { const int s = sm * 16 + q * 4 + j; v[j] = s <= t ? acc[j] * __expf((TB)[s] - _mmt) : 0.f; } \
                o.x = pk2(v[0], v[1]); o.y = pk2(v[2], v[3]); } \
            *(LAS v2u*)(L + (SO) + t * ST_PITCH + (sm * 16 + q * 4) * 2) = o; } } while (0)
    MLP_LOADK(kc, 0); MLP_LOADV(vc, 0); MLP_LOADG(gc0, gc1, gc2, 0); MLP_LOADQ(Qc, 0); MLP_LOADK(kn, 1); MLP_LOADG(gn0, gn1, gn2, 1); MLP_LOADQ(Qn, 1);
    float m = -1e30f;
    {
      const float mm = fmaxf(gc2, m); LAS float* TB = MLP_TAB(0);
      if (w == 0) { TB[lane] = gc1; TB[64 + lane] = mm; TB[128 + lane] = gc0; }
#pragma unroll
      for (int i = 0; i < 4; ++i) *(LAS v4u*)(L + KS_OFF + lane * KS_PITCH + (w * 4 + i) * 16) = kc[i];
      __syncthreads();
      if (need_ctx) MLP_STILE(Qc, TB, MLP_ST(0));
      __syncthreads(); }
#pragma unroll 1
    for (int k = 0; k < 36; ++k) {
        const int par = k & 1, k1 = k + 1 < 36 ? k + 1 : 35, k2 = k + 2 < 36 ? k + 2 : 35;
        const bool do_out = need_ctx || k >= 4, s_next = (k + 1 < 36) && (need_ctx || k + 1 >= 4);
        const size_t base = (size_t)b * TPB + chunk_of(k, dir) * 64;
        if (k > 0 && VAR != 2) {
#pragma unroll
            for (int di = 0; di < 2; ++di)
#pragma unroll
                for (int en = 0; en < 5; ++en) { const f32x4 c = C[di][en]; v2u o; o.x = pk2(c[0], c[1]); o.y = pk2(c[2], c[3]);
                    *(LAS v2u*)(L + CT_OFF + (en * 16 + c16) * CT_PITCH + ((2 * w + di) * 16 + q * 4) * 2) = o; } }
        const float mm = fmaxf(gc2, m), bL = lane_get(gc0, 63), mm63 = lane_get(mm, 63), wk = __expf(gc1 - mm63), m_next = bL + mm63;
#pragma unroll
        for (int i = 0; i < (VAR == 2 ? 1 : 4); ++i) {
#pragma unroll
            for (int e = 0; e < (VAR == 2 ? 1 : 4); ++e) { const unsigned x = kc[i][e]; const unsigned pk = pk2(blo(x) * wk, bhi(x) * wk);
                *(LAS bf16_t*)(L + KT_OFF + ((w * 4 + i) * 8 + 2 * e) * KT_PITCH + lane * 2) = (bf16_t)(pk & 0xffffu); *(LAS bf16_t*)(L + KT_OFF + ((w * 4 + i) * 8 + 2 * e + 1) * KT_PITCH + lane * 2) = (bf16_t)(pk >> 16); } }
#pragma unroll
        for (int e = 0; e < 4; ++e) { const unsigned x = vc[e];
            *(LAS bf16_t*)(L + VT_OFF + (w * 8 + 2 * e) * VT_PITCH + lane * 2) = (bf16_t)(x & 0xffffu); *(LAS bf16_t*)(L + VT_OFF + (w * 8 + 2 * e + 1) * VT_PITCH + lane * 2) = (bf16_t)(x >> 16); }
        { const float mmn = fmaxf(gn2, m_next); LAS float* TBn = MLP_TAB(par ^ 1);
          if (w == 0) { TBn[lane] = gn1; TBn[64 + lane] = mmn; TBn[128 + lane] = gn0; }
#pragma unroll
          for (int i = 0; i < (VAR == 2 ? 1 : 4); ++i) *(LAS v4u*)(L + KS_OFF + lane * KS_PITCH + (w * 4 + i) * 16) = kn[i]; }
        __syncthreads();
#pragma unroll
        for (int i = 0; i < 4; ++i) kc[i] = kn[i];
        gc0 = gn0; gc1 = gn1; gc2 = gn2;
        if (VAR != 3) { MLP_LOADK(kn, k2); MLP_LOADV(vc, k1); MLP_LOADG(gn0, gn1, gn2, k2); }
        const LAS float* TB = MLP_TAB(par);
        if (do_out && VAR != 1) {
            const float wi = __expf(m - TB[64 + t]); f32x4 num0 = {0.f, 0.f, 0.f, 0.f}, num1 = {0.f, 0.f, 0.f, 0.f}; float den = 1.f;
            bf16x8 sb[2];
#pragma unroll
            for (int ks = 0; ks < 2; ++ks) sb[ks] = *(const LAS bf16x8*)(L + MLP_ST(par) + t * ST_PITCH + (ks * 32 + q * 8) * 2);
#pragma unroll
            for (int ei = 0; ei < 3; ++ei) { const int em = ei < 2 ? wh * 2 + ei : 4;
                f32x4 a1 = {0.f, 0.f, 0.f, 0.f}, a2 = {0.f, 0.f, 0.f, 0.f}; bf16x8 va_[2], ca_[8];
#pragma unroll
                for (int ks = 0; ks < 2; ++ks) va_[ks] = *(const LAS bf16x8*)(L + VT_OFF + (em * 16 + c16) * VT_PITCH + (ks * 32 + q * 8) * 2);
#pragma unroll
                for (int ks = 0; ks < 8; ++ks) ca_[ks] = *(const LAS bf16x8*)(L + CT_OFF + (em * 16 + c16) * CT_PITCH + (ks * 32 + q * 8) * 2);
                __builtin_amdgcn_sched_barrier(0);
#pragma unroll
                for (int ks = 0; ks < 2; ++ks) a1 = ML_MFMA(va_[ks], sb[ks], a1);
#pragma unroll
                for (int ks = 0; ks < 8; ++ks) a2 = ML_MFMA(ca_[ks], Qc[ks], a2);
                __builtin_amdgcn_sched_barrier(0);
                const f32x4 nv = a1 + a2 * wi;
                if (ei == 0) num0 = nv; else if (ei == 1) num1 = nv;
                else den = fmaxf(fabsf(lane_get(nv[0], c16)), __expf(-(TB[128 + t] + TB[64 + t]))); }
            const float rd = 1.f / den; bf16_t* op = MH + MLP_ROW(base, t) * DM + h * 256 + es * 64 + q * 4; const f32x4 o0 = num0 * rd, o1 = num1 * rd;
            v2u w0, w1; w0.x = pk2(o0[0], o0[1]); w0.y = pk2(o0[2], o0[3]); w1.x = pk2(o1[0], o1[1]); w1.y = pk2(o1[2], o1[3]);
            *(v2u*)(op + (wh * 2) * 16) = w0; *(v2u*)(op + (wh * 2 + 1) * 16) = w1;
        }
        if (VAR != 1) { const float decay = __expf(m - mm63); bf16x8 vb_[5][2], ka2_[2][2];
#pragma unroll
          for (int en = 0; en < 5; ++en)
#pragma unroll
              for (int ks = 0; ks < 2; ++ks) vb_[en][ks] = *(const LAS bf16x8*)(L + VT_OFF + (en * 16 + c16) * VT_PITCH + (ks * 32 + q * 8) * 2);
#pragma unroll
          for (int di = 0; di < 2; ++di)
#pragma unroll
              for (int ks = 0; ks < 2; ++ks) ka2_[di][ks] = *(const LAS bf16x8*)(L + KT_OFF + ((2 * w + di) * 16 + c16) * KT_PITCH + (ks * 32 + q * 8) * 2);
#pragma unroll
          for (int di = 0; di < 2; ++di)
#pragma unroll
              for (int en = 0; en < 5; ++en) C[di][en] = C[di][en] * decay;
          __builtin_amdgcn_sched_barrier(0);
#pragma unroll
          for (int di = 0; di < 2; ++di)
#pragma unroll
              for (int en = 0; en < 5; ++en)
#pragma unroll
                  for (int ks = 0; ks < 2; ++ks) C[di][en] = ML_MFMA(ka2_[di][ks], vb_[en][ks], C[di][en]);
          __builtin_amdgcn_sched_barrier(0); }
        if (s_next && VAR != 1) MLP_STILE(Qn, MLP_TAB(par ^ 1), MLP_ST(par ^ 1));
#pragma unroll
        for (int ks = 0; ks < 8; ++ks) Qc[ks] = Qn[ks];
        if (VAR != 3) MLP_LOADQ(Qn, k2);
        m = m_next;
        __syncthreads();
    }
#undef MLP_ROW
#undef MLP_TAB
#undef MLP_ST
#undef MLP_XB
#undef MLP_LOADK
#undef MLP_LOADV
#undef MLP_LOADG
#undef MLP_LOADQ
#undef MLP_STILE
}
constexpr int T_CT = 0, T_CT_ROWS = 65;
constexpr int T_KS0 = T_CT + T_CT_ROWS * CT_PITCH, T_KS1 = T_KS0 + 64 * KS_PITCH;
constexpr int T_VS = T_KS1 + 64 * KS_PITCH, T_VPITCH = 160, T_VSW = T_VS + 64 * T_VPITCH;
constexpr int T_ST0 = T_VSW + 64 * T_VPITCH, T_ST1 = T_ST0 + 64 * ST_PITCH, T_TAB0 = T_ST1 + 64 * ST_PITCH, T_TAB1 = T_TAB0 + 1024, T_END = T_TAB1 + 1024;
static_assert(T_END <= MISC_OFF && T_CT + 80 * CT_PITCH <= T_END && T_KS0 % 16 == 0, "mLSTM LDS map (transposed reads)");
typedef short s16x4 __attribute__((ext_vector_type(4)));
template <int OFF> __device__ __forceinline__ s16x4 tr4(unsigned addr) { s16x4 r; asm volatile("ds_read_b64_tr_b16 %0, %1 offset:%2" : "=&v"(r) : "v"(addr), "i"(OFF) : "memory"); return r; }
#define TR_FRAG(OUT, addr, OFF0, OFF1) do { const s16x4 _a = tr4<(OFF0)>(addr), _b = tr4<(OFF1)>(addr); OUT##_lo = _a; OUT##_hi = _b; } while (0)
#define TR_JOIN(lo, hi) ((bf16x8){lo[0], lo[1], lo[2], lo[3], hi[0], hi[1], hi[2], hi[3]})
__device__ __forceinline__ void mlstm_unit_tr(Frame& F, CArgs* ka, int u, bool need_ctx) {
    const int tid = tid_fresh(), lane = tid & 63, w = __builtin_amdgcn_readfirstlane(tid >> 6), c16 = lane & 15, q = lane >> 4;
    const int es = u & 3, dir = (u >> 2) & 1, h = (u >> 3) & 7, b = u >> 6;
    LAS unsigned char* L = F.lds;
    const bf16_t* X8 = WSB(WS_X8); constexpr size_t X8_SEC = (size_t)MROWS * DM; bf16_t* MH = WSB(WS_MH) + (size_t)dir * MROWS * DM;
    const f32x4* GSC = (const f32x4*)WSF(WS_GSC) + (((size_t)b * 2 + dir) * 8 + h) * 36 * 64;
    __syncthreads();
    { unsigned z0 = 0u; asm volatile("" : "+v"(z0)); const v4u zz = {z0, z0, z0, z0};
      for (int i = tid; i < T_CT_ROWS * CT_PITCH / 16; i += 512) *(LAS v4u*)(L + T_CT + i * 16) = zz;
      if (tid < 128) { const int s = tid & 63, hf = tid >> 6; v4u one = zz; if (hf == 0) one.x = 0x3F80u;
          *(LAS v4u*)(L + T_VS + s * T_VPITCH + 128 + hf * 16) = one; *(LAS v4u*)(L + T_VSW + s * T_VPITCH + 128 + hf * 16) = zz; } }
    f32x4 C[2][5];
#pragma unroll
    for (int a = 0; a < 2; ++a)
#pragma unroll
        for (int e = 0; e < 5; ++e) C[a][e] = (f32x4){0.f, 0.f, 0.f, 0.f};
    const int tn = w & 3, wh = w >> 2, t = tn * 16 + c16;
    const int kl = (dir ? 63 - lane : lane) * 8, ql = q * 512 + (dir ? 63 - t : t) * 8;
    const unsigned LB = (unsigned)(size_t)L;
    const unsigned trK = (unsigned)((8 * q + (c16 >> 2)) * KS_PITCH + 8 * (lane & 3) + 64 * w), trV = (unsigned)((8 * q + (c16 >> 2)) * T_VPITCH + 8 * (lane & 3));
    v4u kn[4], vc; bf16x8 Qc[8], Qn[8]; float gc0, gc1, gc2, gn0, gn1, gn2;
#define MLP_ROW(base, j) ((size_t)(base) + (dir ? 63 - (j) : (j)))
#define MLP_TAB(par) ((LAS float*)(L + ((par) ? T_TAB1 : T_TAB0)))
#define MLP_ST(par) ((par) ? T_ST1 : T_ST0)
#define MLP_KS(par) ((par) ? T_KS1 : T_KS0)
#define MLP_XB(sec, c_) (X8 + (size_t)(sec) * X8_SEC + ((size_t)(b * 8 + h) * 36 + (c_)) * (32 * 64 * 8))
#define MLP_LOADK(dst, k) do { const bf16_t* _xb = MLP_XB(1, chunk_of((k), dir)) + w * 4 * 512; \
        _Pragma("unroll") for (int i = 0; i < 4; ++i) dst[i] = *(const v4u*)(_xb + i * 512 + kl); } while (0)
#define MLP_LOADV(dst, k) do { dst = *(const v4u*)(MLP_XB(2, chunk_of((k), dir)) + (es * 8 + w) * 512 + kl); } while (0)
#define MLP_LOADG(d0, d1, d2, k) do { const float* _gp = (const float*)(GSC + chunk_of((k), dir) * 64 + lane); d0 = _gp[0]; d1 = _gp[1]; d2 = _gp[2]; } while (0)
#define MLP_LOADQ(dst, k) do { const bf16_t* _xb = MLP_XB(0, chunk_of((k), dir)); \
        _Pragma("unroll") for (int ks = 0; ks < 8; ++ks) dst[ks] = *(const bf16x8*)(_xb + ks * 2048 + ql); } while (0)
#define MLP_STILE(QQ, TB, SO, KSO) do { const float _mmt = (TB)[64 + t]; \
        _Pragma("unroll") for (int si = 0; si < 2; ++si) { const int sm = wh * 2 + si; v2u o = {0u, 0u}; \
            if (sm <= tn) { f32x4 acc = {0.f, 0.f, 0.f, 0.f}; \
                bf16x8 ka_[8]; \
                _Pragma("unroll") for (int ks = 0; ks < 8; ++ks) ka_[ks] = *(const LAS bf16x8*)(L + (KSO) + (sm * 16 + c16) * KS_PITCH + (ks * 32 + q * 8) * 2); \
                __builtin_amdgcn_sched_barrier(0); \
                _Pragma("unroll") for (int ks = 0; ks < 8; ++ks) acc = ML_MFMA(ka_[ks], QQ[ks], acc); \
                float v[4]; \
                _Pragma("unroll") for (int j = 0; j < 4; ++j) { const int s = sm * 16 + q * 4 + j; v[j] = s <= t ? acc[j] * __expf((TB)[s] - _mmt) : 0.f; } \
                o.x = pk2(v[0], v[1]); o.y = pk2(v[2], v[3]); } \
            *(LAS v2u*)(L + (SO) + t * ST_PITCH + (sm * 16 + q * 4) * 2) = o; } } while (0)
    MLP_LOADK(kn, 0); MLP_LOADV(vc, 0); MLP_LOADG(gc0, gc1, gc2, 0); MLP_LOADQ(Qc, 0); MLP_LOADG(gn0, gn1, gn2, 1); MLP_LOADQ(Qn, 1);
    float m = -1e30f;
    { const float mm = fmaxf(gc2, m); LAS float* TB = MLP_TAB(0);
      if (w == 0) { TB[lane] = gc1; TB[64 + lane] = mm; TB[128 + lane] = gc0; }
#pragma unroll
      for (int i = 0; i < 4; ++i) *(LAS v4u*)(L + T_KS0 + lane * KS_PITCH + (w * 4 + i) * 16) = kn[i];
      MLP_LOADK(kn, 1);
      __syncthreads();
      if (need_ctx) MLP_STILE(Qc, TB, MLP_ST(0), T_KS0);
      __syncthreads(); }
#pragma unroll 1
    for (int k = 0; k < 36; ++k) {
        const int par = k & 1, k1 = k + 1 < 36 ? k + 1 : 35, k2 = k + 2 < 36 ? k + 2 : 35;
        const bool do_out = need_ctx || k >= 4, s_next = (k + 1 < 36) && (need_ctx || k + 1 >= 4);
        const size_t base = (size_t)b * TPB + chunk_of(k, dir) * 64;
        if (k > 0) {
#pragma unroll
            for (int di = 0; di < 2; ++di)
#pragma unroll
                for (int en = 0; en < 5; ++en) { const f32x4 c = C[di][en]; v2u o; o.x = pk2(c[0], c[1]); o.y = pk2(c[2], c[3]);
                    if (en < 4 || c16 == 0) *(LAS v2u*)(L + T_CT + (en * 16 + c16) * CT_PITCH + ((2 * w + di) * 16 + q * 4) * 2) = o; } }
        const float mm = fmaxf(gc2, m), bL = lane_get(gc0, 63), mm63 = lane_get(mm, 63), wk = __expf(gc1 - mm63), m_next = bL + mm63;
        { *(LAS v4u*)(L + T_VS + lane * T_VPITCH + w * 16) = vc;
          v4u sv;
#pragma unroll
          for (int e = 0; e < 4; ++e) sv[e] = pk2(blo(vc[e]) * wk, bhi(vc[e]) * wk);
          *(LAS v4u*)(L + T_VSW + lane * T_VPITCH + w * 16) = sv;
          if (w == 0) *(LAS bf16_t*)(L + T_VSW + lane * T_VPITCH + 128) = (bf16_t)(pk2(wk, 0.f) & 0xffffu); }
        { const float mmn = fmaxf(gn2, m_next); LAS float* TBn = MLP_TAB(par ^ 1);
          if (w == 0) { TBn[lane] = gn1; TBn[64 + lane] = mmn; TBn[128 + lane] = gn0; }
#pragma unroll
          for (int i = 0; i < 4; ++i) *(LAS v4u*)(L + MLP_KS(par ^ 1) + lane * KS_PITCH + (w * 4 + i) * 16) = kn[i]; }
        __syncthreads();
        gc0 = gn0; gc1 = gn1; gc2 = gn2;
        MLP_LOADK(kn, k2); MLP_LOADV(vc, k1); MLP_LOADG(gn0, gn1, gn2, k2);
        const LAS float* TB = MLP_TAB(par);
        if (do_out) {
            const float wi = __expf(m - TB[64 + t]); f32x4 num0 = {0.f, 0.f, 0.f, 0.f}, num1 = {0.f, 0.f, 0.f, 0.f}; float den = 1.f;
            bf16x8 sb[2];
#pragma unroll
            for (int ks = 0; ks < 2; ++ks) sb[ks] = *(const LAS bf16x8*)(L + MLP_ST(par) + t * ST_PITCH + (ks * 32 + q * 8) * 2);
#pragma unroll
            for (int ei = 0; ei < 3; ++ei) { const int em = ei < 2 ? wh * 2 + ei : 4;
                f32x4 a1 = {0.f, 0.f, 0.f, 0.f}, a2 = {0.f, 0.f, 0.f, 0.f}; bf16x8 ca_[8];
                const unsigned va = LB + T_VS + trV + 32 * em;
                const s16x4 v00 = tr4<0>(va), v01 = tr4<4 * T_VPITCH>(va), v10 = tr4<32 * T_VPITCH>(va), v11 = tr4<36 * T_VPITCH>(va);
#pragma unroll
                for (int ks = 0; ks < 8; ++ks) ca_[ks] = *(const LAS bf16x8*)(L + T_CT + (em * 16 + c16) * CT_PITCH + (ks * 32 + q * 8) * 2);
                asm volatile("s_waitcnt lgkmcnt(0)" ::: "memory"); __builtin_amdgcn_sched_barrier(0);
                a1 = ML_MFMA(TR_JOIN(v00, v01), sb[0], a1); a1 = ML_MFMA(TR_JOIN(v10, v11), sb[1], a1);
#pragma unroll
                for (int ks = 0; ks < 8; ++ks) a2 = ML_MFMA(ca_[ks], Qc[ks], a2);
                __builtin_amdgcn_sched_barrier(0);
                const f32x4 nv = a1 + a2 * wi;
                if (ei == 0) num0 = nv; else if (ei == 1) num1 = nv;
                else den = fmaxf(fabsf(lane_get(nv[0], c16)), __expf(-(TB[128 + t] + TB[64 + t]))); }
            const float rd = 1.f / den; bf16_t* op = MH + MLP_ROW(base, t) * DM + h * 256 + es * 64 + q * 4; const f32x4 o0 = num0 * rd, o1 = num1 * rd;
            v2u w0, w1; w0.x = pk2(o0[0], o0[1]); w0.y = pk2(o0[2], o0[3]); w1.x = pk2(o1[0], o1[1]); w1.y = pk2(o1[2], o1[3]);
            *(v2u*)(op + (wh * 2) * 16) = w0; *(v2u*)(op + (wh * 2 + 1) * 16) = w1;
        }
        {
          const float decay = __expf(m - mm63);
          const unsigned ka_ = LB + MLP_KS(par) + trK, vb_ = LB + T_VSW + trV;
          const s16x4 k000 = tr4<0>(ka_), k001 = tr4<4 * KS_PITCH>(ka_), k010 = tr4<32 * KS_PITCH>(ka_), k011 = tr4<36 * KS_PITCH>(ka_);
          const s16x4 k100 = tr4<32>(ka_), k101 = tr4<4 * KS_PITCH + 32>(ka_), k110 = tr4<32 * KS_PITCH + 32>(ka_), k111 = tr4<36 * KS_PITCH + 32>(ka_);
          s16x4 vq[5][4];
#define TRV(en) do { vq[en][0] = tr4<32 * (en)>(vb_); vq[en][1] = tr4<4 * T_VPITCH + 32 * (en)>(vb_); vq[en][2] = tr4<32 * T_VPITCH + 32 * (en)>(vb_); vq[en][3] = tr4<36 * T_VPITCH + 32 * (en)>(vb_); } while (0)
          TRV(0); TRV(1); TRV(2); TRV(3); TRV(4);
#undef TRV
#pragma unroll
          for (int di = 0; di < 2; ++di)
#pragma unroll
              for (int en = 0; en < 5; ++en) C[di][en] = C[di][en] * decay;
          asm volatile("s_waitcnt lgkmcnt(0)" ::: "memory"); __builtin_amdgcn_sched_barrier(0);
#pragma unroll
          for (int en = 0; en < 5; ++en) { const bf16x8 b0 = TR_JOIN(vq[en][0], vq[en][1]), b1 = TR_JOIN(vq[en][2], vq[en][3]);
              C[0][en] = ML_MFMA(TR_JOIN(k000, k001), b0, C[0][en]); C[0][en] = ML_MFMA(TR_JOIN(k010, k011), b1, C[0][en]);
              C[1][en] = ML_MFMA(TR_JOIN(k100, k101), b0, C[1][en]); C[1][en] = ML_MFMA(TR_JOIN(k110, k111), b1, C[1][en]); }
          __builtin_amdgcn_sched_barrier(0); }
        if (s_next) MLP_STILE(Qn, MLP_TAB(par ^ 1), MLP_ST(par ^ 1), MLP_KS(par ^ 1));
#pragma unroll
        for (int ks = 0; ks < 8; ++ks) Qc[ks] = Qn[ks];
        MLP_LOADQ(Qn, k2);
        m = m_next;
        __syncthreads();
    }
#undef MLP_ROW
#undef MLP_TAB
#undef MLP_ST
#undef MLP_KS
#undef MLP_XB
#undef MLP_LOADK
#undef MLP_LOADV
#undef MLP_LOADG
#undef MLP_LOADQ
#undef MLP_STILE
}
}

namespace lru {
typedef short bf16x8 __attribute__((ext_vector_type(8)));
constexpr int XB_OFF = 0, XB_PITCH = 272;
constexpr int XF_OFF = XB_OFF + 64 * XB_PITCH, XF_PITCH = 528;
constexpr int YO_OFF = XF_OFF + 64 * XF_PITCH, YO_PITCH = 528;
constexpr int HIN_OFF = YO_OFF + 64 * YO_PITCH;
constexpr int CW_OFF = HIN_OFF + 9 * 2 * 128 * 4;
constexpr int END_OFF = CW_OFF + 5 * 128 * 4;
static_assert(END_OFF <= MISC_OFF, "LRU LDS map");
#define LRU_COMPOSE(A, B, a2, b2) do { B = (a2) * B + (b2); A = (a2) * A; } while (0)

template <bool FINAL, int VAR, class BcOf>
__device__ __forceinline__ void lru_run(Frame& F, CArgs* ka, int l, int blk, int NU, const BcOf& bc_of) {
    const int tid = tid_fresh(), lane = tid & 63, w = __builtin_amdgcn_readfirstlane(tid >> 6), c16 = lane & 15, q = lane >> 4;
    LAS unsigned char* L = F.lds; const bf16_t* P = WSB(WS_P);
    const int cg = tid & 15, rg = tid >> 4, chl = 16 * w + c16, ch = blk * 128 + chl;
    constexpr bool LOADAB = FINAL && LRU_AB && LRU_AB_LOAD, STOREAB = !FINAL && LRU_AB && VAR == 0;
    v4u* ABG = (v4u*)WSF(WS_HL);
    bf16x8 bw[4][4];
    if constexpr (!LOADAB) { const bf16_t* Wt = WSB(WS_WLRU) + (size_t)l * 4 * 16 * 16384 + ((size_t)blk * 128 + chl) * 128 + q * 8;
#pragma unroll
      for (int g = 0; g < 4; ++g)
#pragma unroll
          for (int ks = 0; ks < 4; ++ks) bw[g][ks] = *(const bf16x8*)(Wt + (size_t)g * 16 * 16384 + ks * 32); }
    float cbr[2] = {0.f, 0.f}, cbi[2] = {0.f, 0.f}, csp[2] = {0.f, 0.f};
    if constexpr (!LOADAB) {
#pragma unroll
    for (int dr = 0; dr < 2; ++dr) { cbr[dr] = KIN(12)[((size_t)l * 2 + dr) * DM + ch]; cbi[dr] = KIN(14)[((size_t)l * 2 + dr) * DM + ch]; csp[dr] = log1pf(__expf(-KIN(15)[((size_t)l * 2 + dr) * DM + ch])); } }
    if constexpr (!LOADAB) for (int i = tid; i < 5 * 128; i += 512) { const int kk = i >> 7, c = i & 127; ((LAS float*)(L + CW_OFF))[i] = kk < 4 ? KIN(9)[((size_t)l * 4 + kk) * DM + blk * 128 + c] : KIN(10)[(size_t)l * DM + blk * 128 + c]; }
    v4u raw[5];
#define LRU_LOAD(i) do { int _b, _c; bc_of((i), _b, _c); const int _t0 = _c * 64, _lo = _c < 32 ? 0 : SEQ, _hi = _c < 32 ? SEQ : TPB; const size_t _rb = (size_t)_b * TPB; \
        _Pragma("unroll") for (int x = 0; x < 5; ++x) { const int tt = _t0 + 2 * rg - 2 + x; raw[x] = (v4u){0u, 0u, 0u, 0u}; if (tt >= _lo && tt < _hi) raw[x] = *(const v4u*)(P + (_rb + tt) * NP + C_LX + blk * 128 + cg * 8); } \
        } while (0)
    v4u abn[2][4];
#define LRU_LOADAB(i) do { int _b, _c; bc_of((i), _b, _c); const size_t _u = ((size_t)_b * 36 + _c) * 16 + blk; \
        _Pragma("unroll") for (int d_ = 0; d_ < 2; ++d_) _Pragma("unroll") for (int m_ = 0; m_ < 4; ++m_) abn[d_][m_] = ABG[((_u * 2 + d_) * 4 + m_) * 512 + tid]; } while (0)
    if constexpr (LOADAB) LRU_LOADAB(0); else LRU_LOAD(0);
#pragma unroll 1
    for (int ui = 0; ui < NU; ++ui) {
        int b, chunk; bc_of(ui, b, chunk); const size_t rb = (size_t)b * TPB; const int t0 = chunk * 64;
        __syncthreads();
        if constexpr (!LOADAB) {
          float o0[8], o1[8]; const LAS float* cwl = (const LAS float*)(L + CW_OFF) + cg * 8;
#pragma unroll
          for (int e = 0; e < 8; ++e) { o0[e] = cwl[4 * 128 + e]; o1[e] = o0[e]; }
#pragma unroll
          for (int kk = 0; kk < 5; ++kk) { float xin[8];
#pragma unroll
              for (int e = 0; e < 4; ++e) { xin[2 * e] = blo(raw[kk][e]); xin[2 * e + 1] = bhi(raw[kk][e]); }
#pragma unroll
              for (int e = 0; e < 8; ++e) { if (kk < 4) o0[e] += cwl[kk * 128 + e] * xin[e]; if (kk > 0) o1[e] += cwl[(kk - 1) * 128 + e] * xin[e]; } }
          v4u p0, p1; p0.x = pk2(o0[0], o0[1]); p0.y = pk2(o0[2], o0[3]); p0.z = pk2(o0[4], o0[5]); p0.w = pk2(o0[6], o0[7]); p1.x = pk2(o1[0], o1[1]); p1.y = pk2(o1[2], o1[3]); p1.z = pk2(o1[4], o1[5]); p1.w = pk2(o1[6], o1[7]);
          *(LAS v4u*)(L + XB_OFF + (2 * rg) * XB_PITCH + cg * 16) = p0; *(LAS v4u*)(L + XB_OFF + (2 * rg + 1) * XB_PITCH + cg * 16) = p1;
          LAS float* f0 = (LAS float*)(L + XF_OFF + (2 * rg) * XF_PITCH + cg * 32); LAS float* f1 = (LAS float*)(L + XF_OFF + (2 * rg + 1) * XF_PITCH + cg * 32);
          *(LAS f32x4*)f0 = (f32x4){o0[0], o0[1], o0[2], o0[3]}; *(LAS f32x4*)(f0 + 4) = (f32x4){o0[4], o0[5], o0[6], o0[7]};
          *(LAS f32x4*)f1 = (f32x4){o1[0], o1[1], o1[2], o1[3]}; *(LAS f32x4*)(f1 + 4) = (f32x4){o1[4], o1[5], o1[6], o1[7]}; }
        __syncthreads();
        v4u zcur[2];
        if (FINAL) {
#pragma unroll
            for (int x = 0; x < 2; ++x) { const int cidx = tid + 512 * x; zcur[x] = *(const v4u*)(P + (rb + t0 + (cidx >> 4)) * NP + C_LZ + blk * 128 + (cidx & 15) * 8); } }
        v4u abc[2][4];
        if constexpr (LOADAB) {
#pragma unroll
            for (int d_ = 0; d_ < 2; ++d_)
#pragma unroll
                for (int m_ = 0; m_ < 4; ++m_) abc[d_][m_] = abn[d_][m_];
            if (ui + 1 < NU) LRU_LOADAB(ui + 1); }
        else { if (ui + 1 < NU) LRU_LOAD(ui + 1); }
        const size_t uidx = ((size_t)b * 36 + chunk) * 16 + blk; (void)uidx;
#pragma unroll
        for (int dr = 0; dr < 2; ++dr) {
            f32x4 acc[2][4];
#pragma unroll
            for (int g = 0; g < 2; ++g)
#pragma unroll
                for (int tm = 0; tm < 4; ++tm) acc[g][tm] = (f32x4){0.f, 0.f, 0.f, 0.f};
            if constexpr (LOADAB) {
                typedef _Float16 h2_t __attribute__((ext_vector_type(2)));
#pragma unroll
                for (int tm = 0; tm < 4; ++tm)
#pragma unroll
                    for (int j = 0; j < 4; ++j) { const unsigned wj_ = abc[dr][tm][j]; const h2_t hv = __builtin_bit_cast(h2_t, wj_);   acc[0][tm][j] = __builtin_amdgcn_exp2f((float)hv.x); acc[1][tm][j] = (float)hv.y; }
            } else {
            if (VAR < 2) {
#pragma unroll
            for (int ks = 0; ks < 4; ++ks) { bf16x8 a[4];
#pragma unroll
                for (int tm = 0; tm < 4; ++tm) a[tm] = *(const LAS bf16x8*)(L + XB_OFF + (tm * 16 + c16) * XB_PITCH + (ks * 32 + q * 8) * 2);
#pragma unroll
                for (int g = 0; g < 2; ++g)
#pragma unroll
                    for (int tm = 0; tm < 4; ++tm) acc[g][tm] = __builtin_amdgcn_mfma_f32_16x16x32_bf16(a[tm], bw[2 * dr + g][ks], acc[g][tm], 0, 0, 0); } }
            if (VAR < 1) {
                typedef float f32x2 __attribute__((ext_vector_type(2)));
                const float NL2E = -1.4426950408889634f; const float kr = cbr[dr] * NL2E, ki = cbi[dr] * NL2E, c16l = -16.f * csp[dr], c8l2 = -8.f * csp[dr] * 1.4426950408889634f;
#pragma unroll
                for (int tm = 0; tm < 4; ++tm) { float l2t[4];
#pragma unroll
                    for (int jp = 0; jp < 2; ++jp) { const int t = tm * 16 + q * 4 + 2 * jp;
                        const f32x2 xv = {*(const LAS float*)(L + XF_OFF + t * XF_PITCH + chl * 4), *(const LAS float*)(L + XF_OFF + (t + 1) * XF_PITCH + chl * 4)};
                        const f32x2 ar = {acc[0][tm][2 * jp], acc[0][tm][2 * jp + 1]}, ai = {acc[1][tm][2 * jp], acc[1][tm][2 * jp + 1]};
                        f32x2 tr = ar * NL2E + kr, ti = ai * NL2E + ki; tr.x = fminf(tr.x, 60.f); tr.y = fminf(tr.y, 60.f); ti.x = fminf(ti.x, 60.f); ti.y = fminf(ti.y, 60.f);
                        f32x2 er, ei; er.x = __builtin_amdgcn_exp2f(tr.x); er.y = __builtin_amdgcn_exp2f(tr.y); ei.x = __builtin_amdgcn_exp2f(ti.x); ei.y = __builtin_amdgcn_exp2f(ti.y);
                        const f32x2 pr = er + 1.f, pi = ei + 1.f, dn = pr * pi; f32x2 R; R.x = __builtin_amdgcn_rcpf(dn.x); R.y = __builtin_amdgcn_rcpf(dn.y);
                        const f32x2 rgt = R * pi, igt = R * pr, x2 = rgt * c16l, l2 = rgt * c8l2;
                        f32x2 av; av.x = __builtin_amdgcn_exp2f(l2.x); av.y = __builtin_amdgcn_exp2f(l2.y);
                        const f32x2 ser = -x2 * (x2 * (x2 * (x2 * (x2 * 0.0083333338f + 0.041666668f) + 0.16666667f) + 0.5f) + 1.f), dir_ = 1.f - av * av;
                        f32x2 om; om.x = x2.x > -0.1f ? ser.x : dir_.x; om.y = x2.y > -0.1f ? ser.y : dir_.y;
                        f32x2 sq; sq.x = __builtin_amdgcn_sqrtf(om.x); sq.y = __builtin_amdgcn_sqrtf(om.y);
                        const f32x2 bxv = sq * igt * xv;
                        l2t[2 * jp] = l2.x; l2t[2 * jp + 1] = l2.y;
                        acc[0][tm][2 * jp] = av.x; acc[0][tm][2 * jp + 1] = av.y; acc[1][tm][2 * jp] = bxv.x; acc[1][tm][2 * jp + 1] = bxv.y; }
                    if constexpr (STOREAB) { v4u wv_;
#pragma unroll
                        for (int j = 0; j < 4; ++j) wv_[j] = __builtin_bit_cast(unsigned, __builtin_amdgcn_cvt_pkrtz(l2t[j], acc[1][tm][j]));
                        ABG[((uidx * 2 + dr) * 4 + tm) * 512 + tid] = wv_; } } }
            }
#define LRU_TM(i) (dr ? 3 - (i) : (i))
            if constexpr (!FINAL) { if (VAR < 3) {
                float2* AGG = (float2*)(VAR ? WSF(WS_ACC) : WSF(WS_LA)); float TA = 1.f, TB = 0.f;
#pragma unroll
                for (int ti = 0; ti < 4; ++ti) { const int tm = LRU_TM(ti); float sa = 1.f, sb = 0.f;
#pragma unroll
                    for (int ji = 0; ji < 4; ++ji) { const int j = LRU_TM(ji); LRU_COMPOSE(sa, sb, acc[0][tm][j], acc[1][tm][j]); }
#pragma unroll
                    for (int qi = 0; qi < 4; ++qi) { const int qq = LRU_TM(qi); const float xa = lane_get(sa, c16 + 16 * qq), xb = lane_get(sb, c16 + 16 * qq); LRU_COMPOSE(TA, TB, xa, xb); } }
                if (q == 0) AGG[(((size_t)b * 36 + chunk) * 2 + dr) * DM + ch] = make_float2(TA, TB); }
            } else {
                float H = ((const LAS float*)(L + HIN_OFF))[ui * 256 + dr * 128 + chl];
#pragma unroll
                for (int ti = 0; ti < 4; ++ti) { const int tm = LRU_TM(ti); float sa = 1.f, sb = 0.f;
#pragma unroll
                    for (int ji = 0; ji < 4; ++ji) { const int j = LRU_TM(ji); LRU_COMPOSE(sa, sb, acc[0][tm][j], acc[1][tm][j]); }
                    float ea = 1.f, eb = 0.f, ta = 1.f, tb = 0.f;
#pragma unroll
                    for (int qi = 0; qi < 4; ++qi) { const int qq = LRU_TM(qi); const float xa = lane_get(sa, c16 + 16 * qq), xb = lane_get(sb, c16 + 16 * qq); if (qq == q) { ea = ta; eb = tb; } LRU_COMPOSE(ta, tb, xa, xb); }
                    float hs = ea * H + eb;
#pragma unroll
                    for (int ji = 0; ji < 4; ++ji) { const int j = LRU_TM(ji); hs = acc[0][tm][j] * hs + acc[1][tm][j]; LAS float* yp = (LAS float*)(L + YO_OFF + (tm * 16 + q * 4 + j) * YO_PITCH + chl * 4);
                        if (dr == 0) *yp = hs; else *yp += hs; }
                    H = ta * H + tb; }
            }
#undef LRU_TM
        }
        if constexpr (FINAL) {
            __syncthreads();
            bf16_t* YB0 = WSB(WS_YB);
#pragma unroll
            for (int i = 0; i < 2; ++i) { const int cidx = tid + 512 * i, row = cidx >> 4, cgo = cidx & 15; const size_t rgl = rb + t0 + row;
                const f32x4 y0 = *(const LAS f32x4*)(L + YO_OFF + row * YO_PITCH + cgo * 32), y1 = *(const LAS f32x4*)(L + YO_OFF + row * YO_PITCH + cgo * 32 + 16);
                const v4u z = zcur[i];
                v4u o; o.x = pk2(y0[0] * blo(z.x), y0[1] * bhi(z.x)); o.y = pk2(y0[2] * blo(z.y), y0[3] * bhi(z.y)); o.z = pk2(y1[0] * blo(z.z), y1[1] * bhi(z.z)); o.w = pk2(y1[2] * blo(z.w), y1[3] * bhi(z.w));
                *(v4u*)(YB0 + rgl * DM + blk * 128 + cgo * 8) = o; }
        }
    }
#undef LRU_LOAD
#undef LRU_LOADAB
}
constexpr int CW_LRUFLAG = 32768, LRU_FLAG_STRIDE = 16;
__device__ __forceinline__ void p_lru_lookback(Frame& F, CArgs* ka, int l) {
    const int tid = tid_fresh(), lane = tid & 63, w = __builtin_amdgcn_readfirstlane(tid >> 6), c16 = lane & 15, q = lane >> 4;
    const int npar = F.G / 36; if (F.wg >= npar * 36) return;
    const int slot = F.wg / 36, chunk = F.wg - slot * 36, cps = (64 + npar - 1) / npar;
    LAS unsigned char* L = F.lds; const bf16_t* P = WSB(WS_P);
    unsigned* ctl = (unsigned*)(ka->ws + WS_CTL); unsigned long long* AGG = (unsigned long long*)WSF(WS_LA) + (size_t)l * 64 * 36 * 2 * 128;
    const unsigned epoch = (unsigned)(l + 1);
    const int cg = tid & 15, rg = tid >> 4, chl = 16 * w + c16;
    const int t0 = chunk * 64, lo = chunk < 32 ? 0 : SEQ, hi = chunk < 32 ? SEQ : TPB;
    int cur_blk = -1;
    v4u raw[5];
#define LRU_LOADX(colx) do { const int _b = (colx) & 3, _blk = (colx) >> 2; const size_t _rb = (size_t)_b * TPB; \
        _Pragma("unroll") for (int x = 0; x < 5; ++x) { const int tt = t0 + 2 * rg - 2 + x; raw[x] = (v4u){0u, 0u, 0u, 0u}; if (tt >= lo && tt < hi) raw[x] = *(const v4u*)(P + (_rb + tt) * NP + C_LX + _blk * 128 + cg * 8); } } while (0)
    const int col0 = slot * cps, col1 = (col0 + cps) < 64 ? (col0 + cps) : 64;
    if (col0 < col1) LRU_LOADX(col0);
#pragma unroll 1
    for (int col = col0; col < col1; ++col) {
        const int b = col & 3, blk = col >> 2, ch = blk * 128 + chl; const size_t rb = (size_t)b * TPB;
        __syncthreads();
        bf16x8 bw[4][4]; float cbr[2], cbi[2], csp[2];
        { const bf16_t* Wt = WSB(WS_WLRU) + (size_t)l * 4 * 16 * 16384 + ((size_t)blk * 128 + chl) * 128 + q * 8;
#pragma unroll
          for (int g = 0; g < 4; ++g)
#pragma unroll
              for (int ks = 0; ks < 4; ++ks) bw[g][ks] = *(const bf16x8*)(Wt + (size_t)g * 16 * 16384 + ks * 32);
#pragma unroll
          for (int dr = 0; dr < 2; ++dr) { cbr[dr] = KIN(12)[((size_t)l * 2 + dr) * DM + ch]; cbi[dr] = KIN(14)[((size_t)l * 2 + dr) * DM + ch]; csp[dr] = log1pf(__expf(-KIN(15)[((size_t)l * 2 + dr) * DM + ch])); } }
        if (blk != cur_blk) { cur_blk = blk;
            for (int i = tid; i < 5 * 128; i += 512) { const int kk = i >> 7, c = i & 127; ((LAS float*)(L + CW_OFF))[i] = kk < 4 ? KIN(9)[((size_t)l * 4 + kk) * DM + blk * 128 + c] : KIN(10)[(size_t)l * DM + blk * 128 + c]; }
            __syncthreads(); }
        {
          float o0[8], o1[8]; const LAS float* cwl = (const LAS float*)(L + CW_OFF) + cg * 8;
#pragma unroll
          for (int e = 0; e < 8; ++e) { o0[e] = cwl[4 * 128 + e]; o1[e] = o0[e]; }
#pragma unroll
          for (int kk = 0; kk < 5; ++kk) { float xin[8];
#pragma unroll
              for (int e = 0; e < 4; ++e) { xin[2 * e] = blo(raw[kk][e]); xin[2 * e + 1] = bhi(raw[kk][e]); }
#pragma unroll
              for (int e = 0; e < 8; ++e) { if (kk < 4) o0[e] += cwl[kk * 128 + e] * xin[e]; if (kk > 0) o1[e] += cwl[(kk - 1) * 128 + e] * xin[e]; } }
          v4u p0, p1; p0.x = pk2(o0[0], o0[1]); p0.y = pk2(o0[2], o0[3]); p0.z = pk2(o0[4], o0[5]); p0.w = pk2(o0[6], o0[7]); p1.x = pk2(o1[0], o1[1]); p1.y = pk2(o1[2], o1[3]); p1.z = pk2(o1[4], o1[5]); p1.w = pk2(o1[6], o1[7]);
          *(LAS v4u*)(L + XB_OFF + (2 * rg) * XB_PITCH + cg * 16) = p0; *(LAS v4u*)(L + XB_OFF + (2 * rg + 1) * XB_PITCH + cg * 16) = p1;
          LAS float* f0 = (LAS float*)(L + XF_OFF + (2 * rg) * XF_PITCH + cg * 32); LAS float* f1 = (LAS float*)(L + XF_OFF + (2 * rg + 1) * XF_PITCH + cg * 32);
          *(LAS f32x4*)f0 = (f32x4){o0[0], o0[1], o0[2], o0[3]}; *(LAS f32x4*)(f0 + 4) = (f32x4){o0[4], o0[5], o0[6], o0[7]};
          *(LAS f32x4*)f1 = (f32x4){o1[0], o1[1], o1[2], o1[3]}; *(LAS f32x4*)(f1 + 4) = (f32x4){o1[4], o1[5], o1[6], o1[7]}; }
        __syncthreads();
        { const int coln = col + 1 < col1 ? col + 1 : col; LRU_LOADX(coln); }
        f32x4 av[2][4], bv[2][4];
#pragma unroll
        for (int dr = 0; dr < 2; ++dr) {
#pragma unroll
            for (int tm = 0; tm < 4; ++tm) { av[dr][tm] = (f32x4){0.f, 0.f, 0.f, 0.f}; bv[dr][tm] = (f32x4){0.f, 0.f, 0.f, 0.f}; }
#pragma unroll
            for (int ks = 0; ks < 4; ++ks) { bf16x8 a[4];
#pragma unroll
                for (int tm = 0; tm < 4; ++tm) a[tm] = *(const LAS bf16x8*)(L + XB_OFF + (tm * 16 + c16) * XB_PITCH + (ks * 32 + q * 8) * 2);
#pragma unroll
                for (int tm = 0; tm < 4; ++tm) { av[dr][tm] = __builtin_amdgcn_mfma_f32_16x16x32_bf16(a[tm], bw[2 * dr][ks], av[dr][tm], 0, 0, 0); bv[dr][tm] = __builtin_amdgcn_mfma_f32_16x16x32_bf16(a[tm], bw[2 * dr + 1][ks], bv[dr][tm], 0, 0, 0); } }
#pragma unroll
            for (int tm = 0; tm < 4; ++tm)
#pragma unroll
                for (int j = 0; j < 4; ++j) { const int t = tm * 16 + q * 4 + j; const float xv = *(const LAS float*)(L + XF_OFF + t * XF_PITCH + chl * 4);
                    const float rgt = pg8::sigmoid_f(av[dr][tm][j] + cbr[dr]), igt = pg8::sigmoid_f(bv[dr][tm][j] + cbi[dr]), la = -8.f * rgt * csp[dr], aa = __expf(la), x2 = 2.f * la;
                    const float om = x2 > -0.1f ? -x2 * (1.f + x2 * (0.5f + x2 * (0.16666667f + x2 * (0.041666668f + x2 * 0.0083333338f)))) : 1.f - aa * aa;
                    av[dr][tm][j] = aa; bv[dr][tm][j] = sqrtf(om) * igt * xv; }
#define LRU_TM(i) (dr ? 3 - (i) : (i))
            float TA = 1.f, TB = 0.f;
#pragma unroll
            for (int ti = 0; ti < 4; ++ti) { const int tm = LRU_TM(ti); float sa = 1.f, sb = 0.f;
#pragma unroll
                for (int ji = 0; ji < 4; ++ji) { const int j = LRU_TM(ji); LRU_COMPOSE(sa, sb, av[dr][tm][j], bv[dr][tm][j]); }
#pragma unroll
                for (int qi = 0; qi < 4; ++qi) { const int qq = LRU_TM(qi); const float xa = lane_get(sa, c16 + 16 * qq), xb = lane_get(sb, c16 + 16 * qq); LRU_COMPOSE(TA, TB, xa, xb); } }
            __builtin_amdgcn_sched_barrier(0);
            if (q == 0) __hip_atomic_store(AGG + (((size_t)col * 36 + chunk) * 2 + dr) * 128 + chl, ((unsigned long long)__float_as_uint(TB) << 32) | __float_as_uint(TA), __ATOMIC_RELAXED, __HIP_MEMORY_SCOPE_AGENT);
        }
        asm volatile("s_waitcnt vmcnt(0)" ::: "memory");
        __syncthreads();
        if (tid == 0) __hip_atomic_store(ctl + CW_LRUFLAG + (col * 36 + chunk) * LRU_FLAG_STRIDE, epoch, __ATOMIC_RELAXED, __HIP_MEMORY_SCOPE_AGENT);
        v4u zcur[2];
#pragma unroll
        for (int x = 0; x < 2; ++x) { const int cidx = tid + 512 * x; zcur[x] = *(const v4u*)(P + (rb + t0 + (cidx >> 4)) * NP + C_LZ + blk * 128 + (cidx & 15) * 8); }
        if (w == 0) {
            unsigned* fp = ctl + CW_LRUFLAG + (col * 36 + (lane < 36 ? lane : 0)) * LRU_FLAG_STRIDE; unsigned spins = 0;
            for (;;) { const bool ok = __hip_atomic_load(fp, __ATOMIC_RELAXED, __HIP_MEMORY_SCOPE_AGENT) >= epoch; if (__all(ok)) break;
                __builtin_amdgcn_s_sleep(1);
                if ((++spins & 255u) == 0u) { if (__hip_atomic_load(ctl, __ATOMIC_RELAXED, __HIP_MEMORY_SCOPE_AGENT) != 0u) break; if (spins > (1u << 20)) { if (lane == 0) __hip_atomic_store(ctl, 0x1200u + (unsigned)l, __ATOMIC_RELAXED, __HIP_MEMORY_SCOPE_AGENT); break; } } }
            __builtin_amdgcn_fence(__ATOMIC_ACQUIRE, "agent");
            asm volatile("s_waitcnt vmcnt(0)" ::: "memory"); }
        __syncthreads();
        if (tid < 256) {
            const int dirx = tid >> 7, cl = tid & 127; const unsigned long long* ap = AGG + ((size_t)col * 36 * 2 + dirx) * 128 + cl; float hcar = 0.f, hmine = 0.f;
#pragma unroll 12
            for (int k = 0; k < 36; ++k) { const int cidx = ml::chunk_of(k, dirx); const unsigned long long ab = ap[(size_t)cidx * 256];
                if (cidx == chunk) hmine = hcar;
                hcar = __uint_as_float((unsigned)ab) * hcar + __uint_as_float((unsigned)(ab >> 32)); }
            ((LAS float*)(L + HIN_OFF))[dirx * 128 + cl] = hmine; }
        __syncthreads();
#pragma unroll
        for (int dr = 0; dr < 2; ++dr) {
            float H = ((const LAS float*)(L + HIN_OFF))[dr * 128 + chl];
#pragma unroll
            for (int ti = 0; ti < 4; ++ti) { const int tm = LRU_TM(ti); float sa = 1.f, sb = 0.f;
#pragma unroll
                for (int ji = 0; ji < 4; ++ji) { const int j = LRU_TM(ji); LRU_COMPOSE(sa, sb, av[dr][tm][j], bv[dr][tm][j]); }
                float ea = 1.f, eb = 0.f, ta = 1.f, tb = 0.f;
#pragma unroll
                for (int qi = 0; qi < 4; ++qi) { const int qq = LRU_TM(qi); const float xa = lane_get(sa, c16 + 16 * qq), xb = lane_get(sb, c16 + 16 * qq); if (qq == q) { ea = ta; eb = tb; } LRU_COMPOSE(ta, tb, xa, xb); }
                float hs = ea * H + eb;
#pragma unroll
                for (int ji = 0; ji < 4; ++ji) { const int j = LRU_TM(ji); hs = av[dr][tm][j] * hs + bv[dr][tm][j]; LAS float* yp = (LAS float*)(L + YO_OFF + (tm * 16 + q * 4 + j) * YO_PITCH + chl * 4);
                    if (dr == 0) *yp = hs; else *yp += hs; }
                H = ta * H + tb; }
        }
#undef LRU_TM
        __syncthreads();
        bf16_t* YB0 = WSB(WS_YB);
#pragma unroll
        for (int i = 0; i < 2; ++i) { const int cidx = tid + 512 * i, row = cidx >> 4, cgo = cidx & 15; const size_t rgl = rb + t0 + row;
            const f32x4 y0 = *(const LAS f32x4*)(L + YO_OFF + row * YO_PITCH + cgo * 32), y1 = *(const LAS f32x4*)(L + YO_OFF + row * YO_PITCH + cgo * 32 + 16);
            const v4u z = zcur[i];
            v4u o; o.x = pk2(y0[0] * blo(z.x), y0[1] * bhi(z.x)); o.y = pk2(y0[2] * blo(z.y), y0[3] * bhi(z.y)); o.z = pk2(y1[0] * blo(z.z), y1[1] * bhi(z.z)); o.w = pk2(y1[2] * blo(z.w), y1[3] * bhi(z.w));
            *(v4u*)(YB0 + rgl * DM + blk * 128 + cgo * 8) = o; }
    }
#undef LRU_LOADX
}
template <int LV> __device__ __forceinline__ void p_lru_agg(Frame& F, CArgs* ka, int l) {
    for (int v = F.wg; v < 256; v += F.G) { const int blk = v & 15, c0 = v >> 4;
        lru_run<false, LV>(F, ka, l, blk, 9, [c0](int i, int& b, int& c) { const int x = c0 + 16 * i; b = x / 36; c = x - b * 36; }); }
}
__device__ __forceinline__ void p_lru_final(Frame& F, CArgs* ka, int l, bool need_ctx) {
    for (int v = F.wg; v < 256; v += F.G) { const int b = v >> 6, blk = (v >> 2) & 15, qt = v & 3;
        const int tid = tid_fresh();
        __syncthreads();
        if (tid < 256) { const int dirx = tid >> 7, chl = tid & 127; const float2* AGG = (const float2*)WSF(WS_LA) + ((size_t)b * 36 * 2 + dirx) * DM + blk * 128 + chl;
            LAS float* HIN = (LAS float*)(F.lds + HIN_OFF); float hcar = 0.f;
#pragma unroll 12
            for (int k = 0; k < 36; ++k) { const int cidx = ml::chunk_of(k, dirx); const float2 ab = AGG[(size_t)cidx * 2 * DM];
                const int sl = cidx - qt * 9; if (sl >= 0 && sl < 9) HIN[sl * 256 + dirx * 128 + chl] = hcar;
                hcar = ab.x * hcar + ab.y; } }
        lru_run<true, 0>(F, ka, l, blk, (need_ctx || qt < 3) ? 9 : 5, [b, qt](int i, int& bb, int& c) { bb = b; c = qt * 9 + i; });
    }
}
}

#ifndef GEMM_NHALF
#define GEMM_NHALF false
#endif
#ifndef CONVERT_AHEAD
#define CONVERT_AHEAD 1
#endif
#ifndef DUP_NORM
#define DUP_NORM 0
#endif
#ifndef DUP_KNORM
#define DUP_KNORM 0
#endif
#ifndef LRU_LOOKBACK
#define LRU_LOOKBACK 0
#endif
#ifndef DUP_G1NULL
#define DUP_G1NULL 0
#endif
#ifndef DUP_G1FIX
#define DUP_G1FIX 0
#endif
#ifndef DUP_BAR
#define DUP_BAR 0
#endif
#ifndef DUP_MLOUT
#define DUP_MLOUT 0
#endif
#ifndef DUP_LRU2
#define DUP_LRU2 0
#endif
#ifndef ML_PIPE
#define ML_PIPE 1
#endif
#ifndef ML_VAR
#define ML_VAR 0
#endif
#ifndef LRU_VAR
#define LRU_VAR -1
#endif
#ifndef CONV_SPLIT
#define CONV_SPLIT 0
#endif
#ifndef GEMM_STAGGER
#define GEMM_STAGGER 0
#endif
#ifndef HEAVY_MIX
#define HEAVY_MIX 0
#endif
#ifndef THIN_MIX
#define THIN_MIX 0
#endif
#ifndef CONV_HEAVY
#define CONV_HEAVY 1
#endif
#ifndef HEAVY_ROT
#define HEAVY_ROT 0
#endif
#ifndef PRETOUCH
#define PRETOUCH 1
#endif
#ifndef PT_STRIDE
#define PT_STRIDE 65536
#endif
#ifndef CONV_BAL
#define CONV_BAL 20896
#endif
#ifndef MERGE_CHAIN
#define MERGE_CHAIN 1
#endif
#ifndef CONV_WIN_M
#define CONV_WIN_M 4000
#endif
#ifndef CONV_AHEAD_ITEMS
#define CONV_AHEAD_ITEMS 8000
#endif
#ifndef CONV_HALF
#define CONV_HALF 17168
#endif
static_assert(!(SPLIT_CTX && GEMM_NHALF), "the split context tiles assume 256-column units");
#ifndef ML_TR
#define ML_TR 1
#endif
#ifndef DUP_PRO
#define DUP_PRO 0
#endif
#ifndef DUP_THIN
#define DUP_THIN 0
#endif
#ifndef DUP_G1
#define DUP_G1 0
#endif
#ifndef DUP_HEAVY
#define DUP_HEAVY 0
#endif
#ifndef DUP_ATT
#define DUP_ATT 0
#endif
#ifndef DUP_ML
#define DUP_ML 0
#endif
#ifndef DUP_LRU1
#define DUP_LRU1 0
#endif
#ifndef DUP_G23
#define DUP_G23 0
#endif
__global__ void __launch_bounds__(NWAVES * 64, 2) fwd(Args args) {
    extern __shared__ __attribute__((aligned(16))) unsigned char lds[];
    Frame F;
    F.lds = (LAS unsigned char*)lds; F.ldsg = (char*)lds;
    F.tid = threadIdx.x; F.lane = F.tid & 63; F.wave = __builtin_amdgcn_readfirstlane(F.tid >> 6); F.G = gridDim.x; F.wg = blockIdx.x;
    CArgs* const ka0 = (CArgs*)__builtin_amdgcn_kernarg_segment_ptr();
    unsigned char* ws; { CArgs* ka = ka0; ws = ka->ws; }
    volatile LAS unsigned* MISC = (volatile LAS unsigned*)(F.lds + MISC_OFF);
    if (F.tid < 64) ((LAS unsigned*)(F.lds + MISC_OFF))[F.tid] = 0u;
    __syncthreads();
    const int lo = ka0->ph_lo, hi = ka0->ph_hi;
    XcdBarrier bar; bar.bar = (unsigned*)(ws + WS_CTL) + CW_BAR; bar.x = 0; bar.st = nullptr;
    if (hi - lo > 1) bar = xcd_barrier_post((unsigned*)(ws + WS_CTL) + CW_BAR, MISC + 8);
#define IN(k) (lo <= (k) && (k) < hi)
#define SEAM(k) do { if ((k) + 1 < hi) { xcd_barrier(bar); if (DUP_BAR) xcd_barrier(bar); } } while (0)

    if (IN(0) && PRETOUCH) {
        CArgs* ka = KA(); const size_t gt = (size_t)F.wg * 512 + F.tid, GT = (size_t)F.G * 512; unsigned acc_ = 0u;
#define PT_RANGE(ptr, bytes) for (size_t p = gt; p < (size_t)(bytes) / PT_STRIDE; p += GT) acc_ += __builtin_nontemporal_load((const unsigned*)((const char*)(ptr) + p * PT_STRIDE))
        PT_RANGE(ka->ws, WS_END); PT_RANGE(KIN(8), (size_t)DEPTH * DM * NIN * 4); PT_RANGE(KIN(20), (size_t)DEPTH * 3 * DM * DM * 4); PT_RANGE(KIN(21), (size_t)DEPTH * DM * DM * 4);
        PT_RANGE(KIN(4), (size_t)DEPTH * DM * 3 * DM * 4); PT_RANGE(KIN(0), (size_t)NBATCH * SEQ * DM * 4); PT_RANGE(KIN(2), (size_t)NBATCH * CTXL * DM * 4); PT_RANGE(ka->out, (size_t)NBATCH * SEQ * DM * 4);
#undef PT_RANGE
        asm volatile("" :: "v"(acc_)); }
    if (IN(0)) { for (int rep = 0; rep <= DUP_PRO; ++rep) { const int wv = F.wg * NWAVES + F.wave, nwv = F.G * NWAVES;
            for (int lc = 0; lc < (CONV_HEAVY ? 1 : DEPTH); ++lc) p_convert(F, KA(), lc, wv, nwv, (CONVERT_AHEAD && lc > 0) ? CONV_AHEAD_ITEMS : 0);
            p_prologue(F, KA()); }
        SEAM(0); }
#pragma unroll 1
    for (int l = 0; l < DEPTH; ++l) {
        const int base = 1 + l * PH_PER_LAYER; const bool need_ctx = l < DEPTH - 1;
        if (IN(base + 0)) { p_norm(F, KA(), l); if (DUP_NORM) p_norm(F, KA(), l + 1 <= DEPTH - 1 && l > 0 ? l : l, true); SEAM(base + 0); }
        if (IN(base + 1)) {
            CArgs* ka = KA(); pg8::Gemm g{WSB(WS_H), WSB(WS_WIN) + (size_t)l * NP * DM, MROWS, NP, DM, 0, 0}; pg8::InOrder S; S.init(MROWS, NP, F.G, F.wg, 256, !need_ctx);
            typedef pg8::EpiIn<(long)((WS_X8 - WS_P) / 2)> EpiInT; EpiInT E{WSB(WS_P)};
            if (GEMM_STAGGER && need_ctx) {
                const int nu = (MROWS / 256) * (NP / 256), extra = nu % F.G;
                if (F.wg >= extra) { const unsigned long long t0 = __builtin_amdgcn_s_memrealtime(), dt = (unsigned long long)(((F.wg - extra) >> 3) & 15) * GEMM_STAGGER;
                    while (__builtin_amdgcn_s_memrealtime() - t0 < dt) __builtin_amdgcn_s_sleep(8); } }
            pg8::gemm_phase<EpiInT, pg8::InOrder, true, true>(F.lds, g, S, E);
            if (DUP_G1) pg8::gemm_phase<EpiInT, pg8::InOrder, true, true>(F.lds, g, S, E);
            if (DUP_G1NULL) { pg8::EpiNull EN{WSF(WS_ACC)}; pg8::gemm_phase<pg8::EpiNull, pg8::InOrder, true, true>(F.lds, g, S, EN); }
            if (DUP_G1FIX) { pg8::EpiNull EN{WSF(WS_ACC)}; pg8::FixedOrder SF; SF.init(MROWS, NP, F.G, F.wg); pg8::gemm_phase<pg8::EpiNull, pg8::FixedOrder, true, true>(F.lds, g, SF, EN); }
            if (need_ctx) {
                const int nu = (MROWS / 256) * (NP / 256), extra = nu % F.G;
                if (F.wg >= extra) { p_gates(F, KA(), l, F.wg - extra, F.G - extra);
                    if (CONVERT_AHEAD && l + 1 < DEPTH) p_convert(F, KA(), l + 1, (F.wg - extra) * NWAVES + F.wave, (F.G - extra) * NWAVES, 0, CONV_SPLIT); } }
            SEAM(base + 1);
        }
        if (IN(base + 2)) { if (!need_ctx) p_gates(F, KA(), l, F.wg, F.G); p_knorm(F, KA(), l); if (DUP_KNORM) p_knorm(F, KA(), l, true);
#if USE_NAIVE_LRU
            p_lru_gates_naive(F, KA(), l);
#endif
            SEAM(base + 2); }
        if (IN(base + 3)) {
#define ML_UNITS() do { for (int v = F.wg; v < 256; v += F.G) {    \
                const int u = (F.G % 8 == 0) ? (((v & 7) * 8 + ((v >> 3) >> 2)) * 4 + ((v >> 3) & 3)) : v; \
                if (ML_TR) ml::mlstm_unit_tr(F, KA(), u, need_ctx); else ml::mlstm_unit_pipe<0>(F, KA(), u, need_ctx); if (ML_VAR) ml::mlstm_unit_pipe<ML_VAR>(F, KA(), u, need_ctx); } } while (0)
            if (HEAVY_MIX && (F.wg & 1)) ML_UNITS();
#define CONV_H() do { if (CONV_HEAVY && l + 1 < DEPTH) { __syncthreads(); \
                if (F.G == 256) {    \
                    p_convert(F, KA(), l + 1, F.wg * NWAVES + F.wave, F.G * NWAVES, CONV_AHEAD_ITEMS, CONV_AHEAD_ITEMS + CONV_BAL); \
                    if (F.wg >= 64) p_convert(F, KA(), l + 1, (F.wg - 64) * NWAVES + F.wave, (F.G - 64) * NWAVES, CONV_AHEAD_ITEMS + CONV_BAL, 1 << 30); } \
                else p_convert(F, KA(), l + 1, F.wg * NWAVES + F.wave, F.G * NWAVES, CONV_AHEAD_ITEMS, 1 << 30); \
                __syncthreads(); } } while (0)
            if (!((F.wg >> 3) & 1)) CONV_H();
#if HEAVY_ROT
            { const int rot = (F.wg >> 3) % 3;
#pragma unroll 1
              for (int sl = 0; sl < 3; ++sl) { const int k = (sl + rot) % 3;
                  __syncthreads();
                  if (k == 0) p_attention(F, KA(), l, need_ctx);
                  else if (k == 1) ML_UNITS();
                  else lru::p_lru_agg<0>(F, KA(), l); }
              __syncthreads(); }
#else
            for (int r2 = 0; r2 <= DUP_ATT; ++r2) p_attention(F, KA(), l, need_ctx);
            if (!(HEAVY_MIX && (F.wg & 1))) ML_UNITS();
            lru::p_lru_agg<0>(F, KA(), l); if (LRU_VAR >= 0) lru::p_lru_agg<(LRU_VAR >= 0 ? LRU_VAR : 0)>(F, KA(), l);
#endif
#undef ML_UNITS
            if ((F.wg >> 3) & 1) CONV_H();
#undef CONV_H
            SEAM(base + 3); }
        if (IN(base + 4)) { for (int rep = 0; rep <= DUP_THIN; ++rep) {
            const bool lru_first = THIN_MIX && ((F.wg >> 3) & 1);
            if (!lru_first) { for (int r2 = 0; r2 <= DUP_MLOUT; ++r2) p_mlout(F, KA(), l, need_ctx); }
#if USE_NAIVE_LRU
            p_lru_combine_naive(F, KA());
#else
#if !LRU_LOOKBACK
            lru::p_lru_final(F, KA(), l, need_ctx); if (DUP_LRU2) lru::p_lru_final(F, KA(), l, need_ctx);
#endif
#endif
            if (lru_first) p_mlout(F, KA(), l, need_ctx);
            }
            SEAM(base + 4); }
        if (IN(base + 5)) {
            CArgs* ka = KA(); pg8::Gemm g{WSB(WS_YB), WSB(WS_WBR) + (size_t)l * 3 * DM * DM, MROWS, DM, DM, (size_t)MROWS * DM * 2, (size_t)DM * DM * 2}; pg8::MergeOrder S; S.init(MROWS, DM, F.G, F.wg, GEMM_NHALF ? 128 : 256, !need_ctx);
#if MERGE_CHAIN
            pg8::EpiMergeC E{WSB(WS_P), WSB(WS_G2)};
            pg8::gemm_phase<pg8::EpiMergeC, pg8::MergeOrder, true, true, false>(F.lds, g, S, E);
#else
            pg8::EpiMerge<GEMM_NHALF> E{WSB(WS_P), WSF(WS_ACC), WSB(WS_G2)};
            pg8::gemm_phase<pg8::EpiMerge<GEMM_NHALF>, pg8::MergeOrder, true, true, GEMM_NHALF>(F.lds, g, S, E);
#endif
            if (DUP_G23) pg8::gemm_phase<decltype(E), pg8::MergeOrder, true, true, false>(F.lds, g, S, E);
            if (CONVERT_AHEAD && l + 1 < DEPTH) {
                const int ntile_m = (MROWS / 256) * (DM / (GEMM_NHALF ? 128 : 256));
                if (SPLIT_CTX && F.G == 256) { const int busy2 = 96; if (F.wg >= busy2) p_convert(F, KA(), l + 1, (F.wg - busy2) * NWAVES + F.wave, (F.G - busy2) * NWAVES, 0, CONV_WIN_M); }
                else { const int ntile = ntile_m, busy2 = (ntile > F.G && ntile < 2 * F.G) ? ntile - F.G : 0;
                    if (F.wg >= busy2) p_convert(F, KA(), l + 1, (F.wg - busy2) * NWAVES + F.wave, (F.G - busy2) * NWAVES, 0, CONV_AHEAD_ITEMS); } }
            SEAM(base + 5);
        }
        if (IN(base + 6)) {
            CArgs* ka = KA(); pg8::Gemm g{WSB(WS_G2), WSB(WS_WOUT) + (size_t)l * DM * DM, MROWS, DM, DM, (size_t)MROWS * DM * 2, 0}; pg8::SplitOutOrder S; S.init(MROWS, DM, F.G, F.wg, GEMM_NHALF ? 128 : 256, !need_ctx);
#if Y_BF16
            pg8::EpiY16 E{WSB(WS_Y), (size_t)MROWS * DM};
#else
            pg8::EpiF32<GEMM_NHALF> E{WSF(WS_Y), DM, (size_t)MROWS * DM};
#endif
            pg8::gemm_phase<decltype(E), pg8::SplitOutOrder, true, true, false>(F.lds, g, S, E);
            if (DUP_G23) pg8::gemm_phase<decltype(E), pg8::SplitOutOrder, true, true, false>(F.lds, g, S, E);
            const int ntile_o = (MROWS / 256) * (DM / (GEMM_NHALF ? 128 : 256));
            if (CONVERT_AHEAD && l + 1 < DEPTH && SPLIT_CTX && F.G == 256) { const int busy2 = 96; (void)ntile_o;
                if (F.wg >= busy2) p_convert(F, KA(), l + 1, (F.wg - busy2) * NWAVES + F.wave, (F.G - busy2) * NWAVES, CONV_WIN_M, CONV_AHEAD_ITEMS); }
            SEAM(base + 6);
        }
    }
    if (IN(N_PHASES - 1)) p_norm(F, KA(), DEPTH);
#undef IN
#undef SEAM
}

extern "C" void kernel_launch(void* const* d_in, const int* in_sizes, int n_in, void* d_out, int out_size, void* d_ws, size_t ws_size, hipStream_t stream) {
    static int grid = 0;
    if (grid == 0) {
        if (n_in != 22 || in_sizes[0] != NBATCH * SEQ * DM || out_size != NBATCH * SEQ * DM || ws_size < WS_END) {
            fprintf(stderr, "kernel_launch: unexpected shapes: n_in %d in0 %d out %d ws %zu (need %zu)\n", n_in, n_in > 0 ? in_sizes[0] : -1, out_size, ws_size, (size_t)WS_END); grid = -1; return; }
        int dev = 0, cus = 0, per_cu = 0;
        if (hipGetDevice(&dev) != hipSuccess || hipDeviceGetAttribute(&cus, hipDeviceAttributeMultiprocessorCount, dev) != hipSuccess) { fprintf(stderr, "kernel_launch: device query failed\n"); grid = -1; return; }
        if (hipFuncSetAttribute((const void*)fwd, hipFuncAttributeMaxDynamicSharedMemorySize, LDS_BYTES) != hipSuccess) { fprintf(stderr, "kernel_launch: hipFuncSetAttribute failed\n"); grid = -1; return; }
        if (hipOccupancyMaxActiveBlocksPerMultiprocessor(&per_cu, (const void*)fwd, NWAVES * 64, LDS_BYTES) != hipSuccess || per_cu < 1)
            fprintf(stderr, "kernel_launch: note: occupancy query reports %d workgroups per CU\n", per_cu);
        (void)hipGetLastError();
        grid = cus;
    }
    if (grid < 0) return;
    if (hipMemsetAsync((char*)d_ws + WS_CTL, 0, CTL_ZERO_BYTES, stream) != hipSuccess) { fprintf(stderr, "kernel_launch: memset failed\n"); return; }
    Args a{};
    for (int i = 0; i < 22; ++i) a.in[i] = (const float*)d_in[i];
    a.out = (float*)d_out; a.ws = (unsigned char*)d_ws;
    if (MK_N_LAUNCHES == 1) { a.ph_lo = 0; a.ph_hi = N_PHASES; hipLaunchKernelGGL(fwd, dim3(grid), dim3(NWAVES * 64), LDS_BYTES, stream, a); }
    else for (int k = 0; k < N_PHASES; ++k) { a.ph_lo = k; a.ph_hi = k + 1; hipLaunchKernelGGL(fwd, dim3(grid), dim3(NWAVES * 64), LDS_BYTES, stream, a); }
    const hipError_t le = hipPeekAtLastError();
    if (le != hipSuccess) fprintf(stderr, "kernel_launch: launch failed: %s\n", hipGetErrorName(le));
}
```
